# Optimizing an MI355X kernel written in HIP

```python
import jax, jax.numpy as jnp
from jax import lax
import numpy as np

D_MODEL = 4096
BATCH = 1
SEQ = 8192
DEPTH = 1

N_MEM = 256
D_MIX = D_MODEL
HEAD_DIM = 128
ATT_WIDTH = D_MIX // 2
ATT_HEADS = ATT_WIDTH // HEAD_DIM
ATT_KV_HEADS = 4
KV_WIDTH = ATT_KV_HEADS * HEAD_DIM
WINDOW = 128
BLOCK = 128
ROPE_THETA = 500000.0
ROT_DIM = HEAD_DIM // 4
LRU_WIDTH = D_MIX // 4
LRU_BLOCKS = 8
LRU_BLOCK_DIM = LRU_WIDTH // LRU_BLOCKS
CONV_WIDTH = 4
CONV_PAD = (2, 1)
LRU_C = 8.0
MEM_HEADS = 4
MEM_WIDTH = D_MIX // 4
MEM_HEAD_DIM = MEM_WIDTH // MEM_HEADS
EPS = 1e-6
SPLIT_WIDTHS = [ATT_WIDTH, KV_WIDTH, KV_WIDTH, LRU_WIDTH, MEM_WIDTH, ATT_WIDTH, LRU_WIDTH, MEM_WIDTH]
IN_WIDTH = sum(SPLIT_WIDTHS)

kernel_name = "hymba_bidir_swa_rglru_memxattn"


def rmsnorm(t, g):
    tf = t.astype(jnp.float32)
    y = tf * lax.rsqrt(jnp.mean(tf * tf, axis=-1, keepdims=True) + EPS)
    return (y * g.astype(jnp.float32)).astype(t.dtype)


def partial_rope(t, pos):
    half = ROT_DIM // 2
    inv_freq = jnp.power(jnp.float32(ROPE_THETA), -jnp.arange(half, dtype=jnp.float32) * 2.0 / ROT_DIM)
    ang = pos.astype(jnp.float32)[:, None] * inv_freq[None, :]
    cos = jnp.cos(ang)[None, :, None, :]
    sin = jnp.sin(ang)[None, :, None, :]
    tf = t.astype(jnp.float32)
    x1 = tf[..., :half]
    x2 = tf[..., half:ROT_DIM]
    out = jnp.concatenate([x1 * cos - x2 * sin, x2 * cos + x1 * sin, tf[..., ROT_DIM:]], axis=-1)
    return out.astype(t.dtype)


def windowed_gqa_sink(q, k, v, sink):
    B, S, H, D = q.shape
    KVH = k.shape[2]
    G = H // KVH
    nb = S // BLOCK
    qb = q.reshape(B, nb, BLOCK, KVH, G, D)

    def band(t):
        tp = jnp.pad(t, ((0, 0), (BLOCK, BLOCK), (0, 0), (0, 0)))
        tb = tp.reshape(B, nb + 2, BLOCK, KVH, D)
        return jnp.concatenate([tb[:, :-2], tb[:, 1:-1], tb[:, 2:]], axis=2)

    kw = band(k)
    vw = band(v)
    s = jnp.einsum('bnqhgd,bnkhd->bnhgqk', qb, kw).astype(jnp.float32) * (D ** -0.5)
    qpos = jnp.arange(nb)[:, None, None] * BLOCK + jnp.arange(BLOCK)[None, :, None]
    kpos = (jnp.arange(nb)[:, None, None] - 1) * BLOCK + jnp.arange(3 * BLOCK)[None, None, :]
    valid = (jnp.abs(kpos - qpos) <= WINDOW) & (kpos >= 0) & (kpos < S)
    s = jnp.where(valid[None, :, None, None, :, :], s, jnp.finfo(jnp.float32).min)
    sk = sink.astype(jnp.float32).reshape(KVH, G)[None, None, :, :, None, None]
    m = jnp.maximum(jnp.max(s, axis=-1, keepdims=True), sk)
    p = jnp.exp(s - m)
    denom = jnp.sum(p, axis=-1, keepdims=True) + jnp.exp(sk - m)
    attn = (p / denom).astype(v.dtype)
    out = jnp.einsum('bnhgqk,bnkhd->bnqhgd', attn, vw)
    return out.reshape(B, S, H * D)


def centred_depthwise_conv(t, w, b):
    C = t.shape[-1]
    y = lax.conv_general_dilated(t, w[:, None, :], window_strides=(1,), padding=[CONV_PAD],
                                 dimension_numbers=('NWC', 'WIO', 'NWC'), feature_group_count=C)
    return y + b


def _linear_combine(e1, e2):
    a1, b1 = e1
    a2, b2 = e2
    return a1 * a2, a2 * b1 + b2


def rglru_direction(xc, w_a, b_a, w_x, b_x, lam, reverse):
    B, S, C = xc.shape
    xb = xc.reshape(B, S, LRU_BLOCKS, LRU_BLOCK_DIM)
    r = jax.nn.sigmoid((jnp.einsum('bsnc,ncd->bsnd', xb, w_a).reshape(B, S, C) + b_a).astype(jnp.float32))
    i = jax.nn.sigmoid((jnp.einsum('bsnc,ncd->bsnd', xb, w_x).reshape(B, S, C) + b_x).astype(jnp.float32))
    log_a = -LRU_C * r * jax.nn.softplus(-lam.astype(jnp.float32))
    a = jnp.exp(log_a)
    mult = jnp.sqrt(-jnp.expm1(2.0 * log_a))
    b_in = mult * i * xc.astype(jnp.float32)
    _, h = lax.associative_scan(_linear_combine, (a, b_in), reverse=reverse, axis=1)
    return h


def memory_cross_attention(q, mem, mem_g, w_mem_kv):
    B, S, _ = q.shape
    M = mem.shape[1]
    kv = rmsnorm(mem, mem_g) @ w_mem_kv
    km, vm = jnp.split(kv, 2, axis=-1)
    qh = q.reshape(B, S, MEM_HEADS, MEM_HEAD_DIM)
    km = km.reshape(B, M, MEM_HEADS, MEM_HEAD_DIM)
    vm = vm.reshape(B, M, MEM_HEADS, MEM_HEAD_DIM)
    s = jnp.einsum('bshd,bmhd->bhsm', qh, km).astype(jnp.float32) * (MEM_HEAD_DIM ** -0.5)
    p = jax.nn.softmax(s, axis=-1).astype(vm.dtype)
    return jnp.einsum('bhsm,bmhd->bshd', p, vm).reshape(B, S, MEM_WIDTH)


def hybrid_layer(h, mem, pos, pre_g, w_in, sink, conv_w, conv_b, w_a, b_a, w_x, b_x, lam,
                 mem_g, w_mem_kv, g_att, g_lru, g_mem, w_out, post_g):
    B, S, _ = h.shape
    u = rmsnorm(h, pre_g)
    proj = u @ w_in
    idx = list(np.cumsum(SPLIT_WIDTHS)[:-1])
    q_att, k_att, v_att, x_lru, q_mem, z_att, z_lru, z_mem = jnp.split(proj, idx, axis=-1)
    q_att = partial_rope(q_att.reshape(B, S, ATT_HEADS, HEAD_DIM), pos)
    k_att = partial_rope(k_att.reshape(B, S, ATT_KV_HEADS, HEAD_DIM), pos)
    v_att = v_att.reshape(B, S, ATT_KV_HEADS, HEAD_DIM)
    y_att = windowed_gqa_sink(q_att, k_att, v_att, sink)
    xc = centred_depthwise_conv(x_lru, conv_w, conv_b)
    h_fwd = rglru_direction(xc, w_a[0], b_a[0], w_x[0], b_x[0], lam[0], reverse=False)
    h_bwd = rglru_direction(xc, w_a[1], b_a[1], w_x[1], b_x[1], lam[1], reverse=True)
    y_lru = (h_fwd + h_bwd).astype(h.dtype)
    y_mem = memory_cross_attention(q_mem, mem, mem_g, w_mem_kv)
    y = jnp.concatenate([rmsnorm(y_att, g_att) * jax.nn.silu(z_att),
                         rmsnorm(y_lru, g_lru) * jax.nn.silu(z_lru),
                         rmsnorm(y_mem, g_mem) * jax.nn.silu(z_mem)], axis=-1)
    out = y @ w_out
    return h + rmsnorm(out, post_g)


def setup_inputs(seed: int = 0) -> dict:
    key = jax.random.key(seed)
    ks = jax.random.split(key, 20)
    f32 = jnp.float32
    nrm = lambda k, shape, scale: jax.random.normal(k, shape, f32) * scale
    gain = lambda k, shape: 1.0 + 0.1 * jax.random.normal(k, shape, f32)
    u = jax.random.uniform(ks[11], (DEPTH, 2, LRU_WIDTH), f32, 0.9, 0.999)
    a0 = jnp.power(u, 1.0 / LRU_C)
    lam = jnp.log(a0) - jnp.log1p(-a0)
    return {
        "x": nrm(ks[0], (BATCH, SEQ, D_MODEL), 1.0),
        "mem": nrm(ks[1], (BATCH, N_MEM, D_MODEL), 1.0),
        "pre_norm_gain": gain(ks[2], (DEPTH, D_MODEL)),
        "w_in": nrm(ks[3], (DEPTH, D_MODEL, IN_WIDTH), D_MODEL ** -0.5),
        "att_sink": nrm(ks[4], (DEPTH, ATT_HEADS), 0.5),
        "conv_w": nrm(ks[5], (DEPTH, CONV_WIDTH, LRU_WIDTH), CONV_WIDTH ** -0.5),
        "conv_b": nrm(ks[6], (DEPTH, LRU_WIDTH), 0.02),
        "lru_w_a": nrm(ks[7], (DEPTH, 2, LRU_BLOCKS, LRU_BLOCK_DIM, LRU_BLOCK_DIM), LRU_BLOCK_DIM ** -0.5),
        "lru_b_a": nrm(ks[8], (DEPTH, 2, LRU_WIDTH), 0.02),
        "lru_w_x": nrm(ks[9], (DEPTH, 2, LRU_BLOCKS, LRU_BLOCK_DIM, LRU_BLOCK_DIM), LRU_BLOCK_DIM ** -0.5),
        "lru_b_x": nrm(ks[10], (DEPTH, 2, LRU_WIDTH), 0.02),
        "lru_lambda": lam,
        "mem_norm_gain": gain(ks[12], (DEPTH, D_MODEL)),
        "w_mem_kv": nrm(ks[13], (DEPTH, D_MODEL, 2 * MEM_WIDTH), D_MODEL ** -0.5),
        "att_out_gain": gain(ks[14], (DEPTH, ATT_WIDTH)),
        "lru_out_gain": gain(ks[15], (DEPTH, LRU_WIDTH)),
        "mem_out_gain": gain(ks[16], (DEPTH, MEM_WIDTH)),
        "w_out": nrm(ks[17], (DEPTH, D_MIX, D_MODEL), D_MIX ** -0.5),
        "post_norm_gain": gain(ks[18], (DEPTH, D_MODEL)),
    }


def reference(x, mem, pre_norm_gain, w_in, att_sink, conv_w, conv_b, lru_w_a, lru_b_a, lru_w_x,
              lru_b_x, lru_lambda, mem_norm_gain, w_mem_kv, att_out_gain, lru_out_gain,
              mem_out_gain, w_out, post_norm_gain):
    S = x.shape[1]
    pos = jnp.arange(S, dtype=jnp.int32)
    h = x
    for l in range(DEPTH):
        h = hybrid_layer(h, mem, pos, pre_norm_gain[l], w_in[l], att_sink[l], conv_w[l], conv_b[l],
                         lru_w_a[l], lru_b_a[l], lru_w_x[l], lru_b_x[l], lru_lambda[l],
                         mem_norm_gain[l], w_mem_kv[l], att_out_gain[l], lru_out_gain[l],
                         mem_out_gain[l], w_out[l], post_norm_gain[l])
    return h
```

```cpp
#include <hip/hip_runtime.h>
#include <hip/hip_cooperative_groups.h>
#include <cstdio>
#include <cstdint>
namespace cg = cooperative_groups;
#define N_LAUNCHES 1
namespace pg8 {
#define PG8_LAS __attribute__((address_space(3)))
typedef unsigned short bf16_t;
typedef short bf16x8 __attribute__((ext_vector_type(8)));
typedef float f32x4 __attribute__((ext_vector_type(4)));
typedef unsigned u32x4 __attribute__((ext_vector_type(4)));
constexpr int BM = 256, BK = 64, HALF = 128, HTB = HALF * BK * 2  , STAGE_BYTES = 8 * HTB, NXCD = 8, WGM = 8;

__host__ __device__ __forceinline__ int lds_byte(int r, int c) { const int st = (r >> 4) * 2 + (c >> 5), rr = r & 15, cc = c & 31, ob = rr * 64 + cc * 2; return st * 1024 + (ob ^ (((ob >> 9) & 1) << 5)); }
__host__ __device__ __forceinline__ void stage_rc(int b, int& R, int& C) { const int st = b / 1024, sb = b % 1024, swz = sb ^ (((sb >> 9) & 1) << 5); R = (st >> 1) * 16 + swz / 64; C = (st & 1) * 32 + (swz % 64) / 2; }
__host__ __device__ __forceinline__ int perm32(int rho) { const int n = rho >> 4, i = rho & 15; return 8 * (i >> 2) + 4 * n + (i & 3); }

struct Unit { int pm, pn; };
struct Gemm { const bf16_t* A; const bf16_t* Bt; int M, N, K; };

struct StaticOrder {
    int nM, nN, nwg, G, c;
    __host__ __device__ void init(int M, int N, int G_, int c_) { nM = M / BM; nN = N / BM; nwg = nM * nN; G = G_; c = c_; }
    __host__ __device__ bool next(int i, Unit& u) const {
        const long L = (long)i * G + c; if (L >= nwg) return false;
        int wgid = (int)L; { const int q = nwg / NXCD, r = nwg % NXCD, xcd = wgid % NXCD, off = wgid / NXCD; wgid = (xcd < r ? xcd * (q + 1) : r * (q + 1) + (xcd - r) * q) + off; }
        const int nig = WGM * nN, gid = wgid / nig, fm = gid * WGM, gsz = (nM - fm) < WGM ? (nM - fm) : WGM;
        u.pm = fm + ((wgid % nig) % gsz); u.pn = (wgid % nig) / gsz; return true;
    }
    __device__ __forceinline__ void a_ready(const Unit&) const {}
    __device__ __forceinline__ void done(const Unit&) const {}
};

__device__ __forceinline__ unsigned cvt_pk_bf16(float lo, float hi) { unsigned r; asm volatile("v_cvt_pk_bf16_f32 %0, %1, %2" : "=v"(r) : "v"(lo), "v"(hi)); return r; }
typedef float f32x2 __attribute__((ext_vector_type(2)));
__device__ __forceinline__ f32x2 gelu_pk(f32x2 v) {
    const f32x2 av = __builtin_elementwise_abs(v), d = av * 0.2316418882f + 1.0f;
    f32x2 t; t.x = __builtin_amdgcn_rcpf(d.x); t.y = __builtin_amdgcn_rcpf(d.y);
    f32x2 q = t * 0.5307027145f + (-0.7265760135f); q = q * t + 0.7107068705f; q = q * t + (-0.142248368f); q = q * t + 0.127414796f; q = q * t;
    const f32x2 s = (v * v) * (-0.72134752044f);
    f32x2 e; e.x = __builtin_amdgcn_exp2f(s.x); e.y = __builtin_amdgcn_exp2f(s.y);
    const f32x2 m = v * (q * e), r = v - m;
    f32x2 o; o.x = v.x < 0.f ? m.x : r.x; o.y = v.y < 0.f ? m.y : r.y; return o;
}

template <int ACT  > struct EpiBf16 {
    static constexpr bool PERM = true, AFTER_DRAIN = false; static_assert(ACT == 0 || ACT == 1, "EpiBf16: ACT is 0 (none) or 1 (gelu_pk)");
    bf16_t* O; int ldc; const float* bias; int split_cols; size_t split_stride; float scale0;
    __device__ __forceinline__ void operator()(const f32x4 (&acc)[2][2][4][2], const Unit& u, int wr, int wc, int fr, int fq) const {
        const int row0 = u.pm * BM + wr * 64 + fr; int colt = u.pn * BM; bf16_t* base = O;
        float sc = 1.f; if (split_cols) { const int t = colt / split_cols; base += (size_t)t * split_stride; colt -= t * split_cols; if (t == 0) sc = scale0; }
        const int col0 = colt + wc * 32 + 8 * fq, bcol0 = u.pn * BM + wc * 32 + 8 * fq;
        f32x4 bv[2][2];
#pragma unroll
        for (int bj = 0; bj < 2; ++bj)
#pragma unroll
            for (int n = 0; n < 2; ++n) bv[bj][n] = bias ? *(const f32x4*)(bias + bcol0 + bj * HALF + 4 * n) : (f32x4){0.f, 0.f, 0.f, 0.f};
#pragma unroll
        for (int ai = 0; ai < 2; ++ai)
#pragma unroll
            for (int m = 0; m < 4; ++m) { bf16_t* rowp = base + (size_t)(row0 + ai * HALF + m * 16) * ldc + col0;
#pragma unroll
                for (int bj = 0; bj < 2; ++bj) { f32x4 v0 = acc[ai][bj][m][0] + bv[bj][0], v1 = acc[ai][bj][m][1] + bv[bj][1];
                    if (ACT == 1) { f32x2 a = gelu_pk((f32x2){v0[0], v0[1]}), b = gelu_pk((f32x2){v0[2], v0[3]}), c = gelu_pk((f32x2){v1[0], v1[1]}), d = gelu_pk((f32x2){v1[2], v1[3]});
                        v0 = (f32x4){a.x, a.y, b.x, b.y}; v1 = (f32x4){c.x, c.y, d.x, d.y}; }
                    v0 = v0 * sc; v1 = v1 * sc; u32x4 w; w.x = cvt_pk_bf16(v0[0], v0[1]); w.y = cvt_pk_bf16(v0[2], v0[3]); w.z = cvt_pk_bf16(v1[0], v1[1]); w.w = cvt_pk_bf16(v1[2], v1[3]);
                    *(u32x4*)(rowp + bj * HALF) = w; } }
    }
};
template <class Epi, class Sched, bool ALIGN_EPI = false, bool SP2 = false>
__device__ __forceinline__ void gemm_phase(PG8_LAS unsigned char* lds, const Gemm g, const Sched& S, const Epi& E) {
    const int tid = threadIdx.x, wid = __builtin_amdgcn_readfirstlane(tid >> 6), lane = tid & 63, wr = wid >> 2, wc = wid & 3, fr = lane & 15, fq = lane >> 4;
    const int K = g.K, nt = K / BK;
    unsigned voffA[2], voffB[2];
#pragma unroll
    for (int i = 0; i < 2; ++i) { int R, C; stage_rc(tid * 16 + i * 8192, R, C); const int Rb = Epi::PERM ? ((R & ~31) + perm32(R & 31)) : R;
        voffA[i] = (unsigned)(R * K + C) * 2u; voffB[i] = (unsigned)(Rb * K + C) * 2u; }
    const size_t kstep = (size_t)(BK * 2);
    const size_t hstep = (size_t)HALF * K * 2;
    const size_t tstep = 2 * hstep;
    const unsigned ldsw = (unsigned)wid * 1024u;
    const int aoff = lds_byte(wr * 64 + fr, fq * 8), boff = lds_byte(wc * 32 + fr, fq * 8);
#define PG8_SA(b, h) (((b) * 2 + (h)) * HTB)
#define PG8_SB(b, h) ((4 + (b) * 2 + (h)) * HTB)
#define PG8_STAGE(bufoff, gbase, voff) do { _Pragma("unroll") for (int _i = 0; _i < 2; ++_i) \
        __builtin_amdgcn_global_load_lds((const unsigned*)((const char*)(gbase) + (voff)[_i]), (PG8_LAS unsigned*)(lds + (bufoff) + ldsw + _i * 8192), 16, 0, 0); } while (0)
#define PG8_LDA(dst, b, h) do { _Pragma("unroll") for (int m = 0; m < 4; ++m) _Pragma("unroll") for (int k = 0; k < 2; ++k) dst[m][k] = *(const PG8_LAS bf16x8*)(lds + PG8_SA(b, h) + aoff + m * 2048 + k * 1024); } while (0)
#define PG8_LDB(dst, b, h) do { _Pragma("unroll") for (int n = 0; n < 2; ++n) _Pragma("unroll") for (int k = 0; k < 2; ++k) dst[n][k] = *(const PG8_LAS bf16x8*)(lds + PG8_SB(b, h) + boff + n * 2048 + k * 1024); } while (0)
#define PG8_MMA(ai, bj, At, Bt) do { __builtin_amdgcn_s_setprio(1); _Pragma("unroll") for (int m = 0; m < 4; ++m) _Pragma("unroll") for (int n = 0; n < 2; ++n) _Pragma("unroll") for (int k = 0; k < 2; ++k) \
        acc[ai][bj][m][n] = __builtin_amdgcn_mfma_f32_16x16x32_bf16(Bt[n][k], At[m][k], acc[ai][bj][m][n], 0, 0, 0); __builtin_amdgcn_s_setprio(0); } while (0)
#define PG8_WAIT_V(n) asm volatile("s_waitcnt vmcnt(" #n ")" ::: "memory")
#define PG8_WAIT_L(n) asm volatile("s_waitcnt lgkmcnt(" #n ")" ::: "memory")
#define PG8_BAR __builtin_amdgcn_s_barrier()
#define PG8_SCHED __builtin_amdgcn_sched_barrier(0)
    Unit cur, nxt; int ui = 0;
    if (!S.next(0, cur)) return;
    f32x4 acc[2][2][4][2];
#pragma unroll
    for (int a = 0; a < 2; ++a)
#pragma unroll
        for (int b = 0; b < 2; ++b)
#pragma unroll
            for (int m = 0; m < 4; ++m)
#pragma unroll
                for (int n = 0; n < 2; ++n) acc[a][b][m][n] = (f32x4){0.f, 0.f, 0.f, 0.f};
    bf16x8 At[4][2], B0[2][2], B1[2][2];
    const char* cA = (const char*)g.A + (size_t)cur.pm * tstep; const char* cB = (const char*)g.Bt + (size_t)cur.pn * tstep;
    S.a_ready(cur);
    if constexpr (SP2) {
        PG8_STAGE(PG8_SB(0, 0), cB, voffB); PG8_STAGE(PG8_SB(0, 1), cB + hstep, voffB); PG8_STAGE(PG8_SA(0, 0), cA, voffA); PG8_STAGE(PG8_SA(0, 1), cA + hstep, voffA);
        if (wr == 1) PG8_BAR;
        PG8_WAIT_V(2); PG8_BAR;
        PG8_STAGE(PG8_SB(1, 0), cB + kstep, voffB); PG8_STAGE(PG8_SA(1, 0), cA + kstep, voffA); PG8_STAGE(PG8_SB(1, 1), cB + hstep + kstep, voffB);
        PG8_WAIT_V(6); PG8_BAR;
    } else {
        PG8_STAGE(PG8_SB(0, 0), cB, voffB); PG8_STAGE(PG8_SA(0, 0), cA, voffA); PG8_STAGE(PG8_SB(0, 1), cB + hstep, voffB); PG8_STAGE(PG8_SA(0, 1), cA + hstep, voffA);
        if (wr == 1) PG8_BAR;
        PG8_WAIT_V(4); PG8_BAR;
        PG8_STAGE(PG8_SB(1, 0), cB + kstep, voffB); PG8_STAGE(PG8_SA(1, 0), cA + kstep, voffA); PG8_STAGE(PG8_SB(1, 1), cB + hstep + kstep, voffB);
        PG8_WAIT_V(6); PG8_BAR;
    }
    for (;;) {
        const bool has_next = S.next(ui + 1, nxt);
        const char* nA = has_next ? (const char*)g.A + (size_t)nxt.pm * tstep : cA; const char* nB = has_next ? (const char*)g.Bt + (size_t)nxt.pn * tstep : cB;
        for (int t = 0; t < nt; t += 2) {
            const bool last = (t == nt - 2);
            const char* a1 = cA + (size_t)(t + 1) * kstep;
            const char* a2 = last ? nA : cA + (size_t)(t + 2) * kstep; const char* b2 = last ? nB : cB + (size_t)(t + 2) * kstep;
            const char* a3 = a2 + kstep; const char* b3 = b2 + kstep;
            if (last && has_next) S.a_ready(nxt);
            if constexpr (SP2) {
            PG8_LDB(B0, 0, 0); PG8_LDB(B1, 0, 1); PG8_SCHED; PG8_LDA(At, 0, 0); PG8_STAGE(PG8_SA(1, 1), a1 + hstep, voffA);
            PG8_WAIT_V(8); PG8_WAIT_L(0); PG8_BAR; PG8_MMA(0, 0, At, B0); PG8_MMA(0, 1, At, B1); PG8_BAR; PG8_SCHED;
            PG8_LDA(At, 0, 1); PG8_STAGE(PG8_SB(0, 0), b2, voffB); PG8_STAGE(PG8_SB(0, 1), b2 + hstep, voffB); PG8_STAGE(PG8_SA(0, 0), a2, voffA);
            PG8_WAIT_V(8); PG8_WAIT_L(0); PG8_BAR; PG8_MMA(1, 0, At, B0); PG8_MMA(1, 1, At, B1); PG8_BAR; PG8_SCHED;
            PG8_LDB(B0, 1, 0); PG8_LDB(B1, 1, 1); PG8_SCHED; PG8_LDA(At, 1, 0); PG8_STAGE(PG8_SA(0, 1), a2 + hstep, voffA);
            PG8_WAIT_V(8); PG8_WAIT_L(0); PG8_BAR; PG8_MMA(0, 0, At, B0); PG8_MMA(0, 1, At, B1); PG8_BAR; PG8_SCHED;
            PG8_LDA(At, 1, 1); PG8_STAGE(PG8_SB(1, 0), b3, voffB); PG8_STAGE(PG8_SB(1, 1), b3 + hstep, voffB); PG8_STAGE(PG8_SA(1, 0), a3, voffA);
            PG8_WAIT_V(8); PG8_WAIT_L(0); PG8_BAR; PG8_MMA(1, 0, At, B0); PG8_MMA(1, 1, At, B1); PG8_BAR; PG8_SCHED;
            } else {
            PG8_LDB(B0, 0, 0); PG8_SCHED; PG8_LDA(At, 0, 0); PG8_STAGE(PG8_SA(1, 1), a1 + hstep, voffA);
            PG8_WAIT_L(8); PG8_BAR; PG8_WAIT_L(0); PG8_MMA(0, 0, At, B0); PG8_BAR; PG8_SCHED;
            PG8_LDB(B1, 0, 1); PG8_STAGE(PG8_SB(0, 0), b2, voffB);
            PG8_BAR; PG8_WAIT_L(0); PG8_MMA(0, 1, At, B1); PG8_BAR;
            PG8_LDA(At, 0, 1); PG8_STAGE(PG8_SA(0, 0), a2, voffA);
            PG8_BAR; PG8_WAIT_L(0); PG8_MMA(1, 0, At, B0); PG8_BAR; PG8_SCHED;
            PG8_STAGE(PG8_SB(0, 1), b2 + hstep, voffB);
            PG8_WAIT_V(6); PG8_BAR; PG8_MMA(1, 1, At, B1); PG8_BAR;
            PG8_LDB(B0, 1, 0); PG8_SCHED; PG8_LDA(At, 1, 0); PG8_STAGE(PG8_SA(0, 1), a2 + hstep, voffA);
            PG8_WAIT_L(8); PG8_BAR; PG8_WAIT_L(0); PG8_MMA(0, 0, At, B0); PG8_BAR; PG8_SCHED;
            PG8_LDB(B1, 1, 1); PG8_STAGE(PG8_SB(1, 0), b3, voffB);
            PG8_BAR; PG8_WAIT_L(0); PG8_MMA(0, 1, At, B1); PG8_BAR;
            PG8_LDA(At, 1, 1); PG8_STAGE(PG8_SA(1, 0), a3, voffA);
            PG8_BAR; PG8_WAIT_L(0); PG8_MMA(1, 0, At, B0); PG8_BAR; PG8_SCHED;
            PG8_STAGE(PG8_SB(1, 1), b3 + hstep, voffB);
            PG8_WAIT_V(6); PG8_BAR; PG8_MMA(1, 1, At, B1); PG8_BAR;
            }
        }
        if constexpr (ALIGN_EPI) { if (wr == 0) PG8_BAR; }
        if constexpr (!Epi::AFTER_DRAIN) { E(acc, cur, wr, wc, fr, fq); S.done(cur); }
        if (!has_next) break;
#pragma unroll
        for (int a = 0; a < 2; ++a)
#pragma unroll
            for (int b = 0; b < 2; ++b)
#pragma unroll
                for (int m = 0; m < 4; ++m)
#pragma unroll
                    for (int n = 0; n < 2; ++n) acc[a][b][m][n] = (f32x4){0.f, 0.f, 0.f, 0.f};
        cur = nxt; cA = nA; cB = nB; ++ui;
        if constexpr (ALIGN_EPI) { if (wr == 1) PG8_BAR; }
    }
    PG8_WAIT_V(0);
    if constexpr (!ALIGN_EPI) { if (wr == 0) PG8_BAR; }
    PG8_BAR;
    if constexpr (Epi::AFTER_DRAIN) { E.fused(acc, cur, wr, wc, fr, fq, lds, wid, lane); S.done(cur); }
#undef PG8_SA
#undef PG8_SB
#undef PG8_STAGE
#undef PG8_LDA
#undef PG8_LDB
#undef PG8_MMA
#undef PG8_WAIT_V
#undef PG8_WAIT_L
#undef PG8_BAR
#undef PG8_SCHED
}
}

#ifndef PHMASK
#define PHMASK 127
#endif
#ifndef P2MASK
#define P2MASK 7
#endif
#ifndef N_LAUNCHES
#define N_LAUNCHES 1
#endif
using pg8::bf16_t; using pg8::bf16x8; using pg8::f32x4; using pg8::u32x4;
#define LAS __attribute__((address_space(3)))
typedef unsigned u32x2 __attribute__((ext_vector_type(2)));
typedef float f32x2 __attribute__((ext_vector_type(2)));

constexpr int SEQ = 8192, DMODEL = 4096, INW = 9216, NMEM = 256;
constexpr int C_QA = 0, C_KA = 2048, C_VA = 2560, C_XL = 3072, C_QM = 4096, C_ZA = 5120, C_ZL = 7168, C_ZM = 8192;
constexpr float EPSN = 1e-6f;
constexpr float LOG2E = 1.4426950408889634f;
constexpr float SC_ATT = 0.08838834764831845f * LOG2E;
constexpr float SC_MEM = 0.0625f * LOG2E;
constexpr int NPH = 7;
constexpr int LDS_BYTES = 147456;

constexpr size_t MiB = 1u << 20;
constexpr size_t WS_CTL = 0, WS_LRUW = 1 * MiB, WS_ROPE = 2 * MiB, WS_MK = 3 * MiB, WS_MVT = 3 * MiB + 512 * 1024, WS_SS = 4 * MiB,
                 WS_AGG1 = 6 * MiB, WS_AGG2 = 10 * MiB, WS_VT = 12 * MiB, WS_WOUT = 20 * MiB, WS_WT = 52 * MiB, WS_U = 140 * MiB,
                 WS_PROJ = 206 * MiB, WS_AB = 350 * MiB, WS_END = 478 * MiB;
constexpr size_t WS_Y = WS_U;
constexpr size_t ABSZ = (size_t)SEQ * 1024;

struct Args { const float* in[19]; float* out; unsigned char* ws; int ph_lo, ph_hi; };

__device__ __forceinline__ unsigned pk2(float lo, float hi) { return pg8::cvt_pk_bf16(lo, hi); }
__device__ __forceinline__ float bflo(unsigned u) { return __builtin_bit_cast(float, u << 16); }
__device__ __forceinline__ float bfhi(unsigned u) { return __builtin_bit_cast(float, u & 0xffff0000u); }
__device__ __forceinline__ float wave_sum(float v) {
#pragma unroll
    for (int o = 1; o < 64; o <<= 1) v += __shfl_xor(v, o);
    return v;
}
__device__ __forceinline__ float fexp2(float x) { return __builtin_amdgcn_exp2f(x); }
__device__ __forceinline__ float sigmoidf_(float x) { return 1.f / (1.f + __expf(-x)); }
__device__ __forceinline__ f32x4 mfma16(bf16x8 a, bf16x8 b, f32x4 c) { return __builtin_amdgcn_mfma_f32_16x16x32_bf16(a, b, c, 0, 0, 0); }

__device__ __forceinline__ void p0_transpose_item(const float* W, int K, int N, bf16_t* WT, int row_off, LAS float* scr, int item, int lane) {
    const int nblk = N / 32, kb = item / nblk, nb = item % nblk, k0 = 64 * kb, n0 = 32 * nb;
#pragma unroll 8
    for (int i = 0; i < 32; ++i) { const int kk = 2 * i + (lane >> 5); scr[kk * 33 + (lane & 31)] = W[(size_t)(k0 + kk) * N + n0 + (lane & 31)]; }
    asm volatile("s_waitcnt lgkmcnt(0)" ::: "memory");
    const int c = lane & 7;
#pragma unroll
    for (int j = 0; j < 4; ++j) { const int n = (lane >> 3) + 8 * j; const LAS float* s = scr + (8 * c) * 33 + n;
        u32x4 o; o.x = pk2(s[0 * 33], s[1 * 33]); o.y = pk2(s[2 * 33], s[3 * 33]); o.z = pk2(s[4 * 33], s[5 * 33]); o.w = pk2(s[6 * 33], s[7 * 33]);
        *(u32x4*)(WT + (size_t)(row_off + n0 + n) * K + k0 + 8 * c) = o; }
    asm volatile("s_waitcnt lgkmcnt(0)" ::: "memory");
}
__device__ __forceinline__ void rms_row_to_bf16(const float* xrow, const float* gain, bf16_t* orow, int lane) {
    const f32x4* xr = (const f32x4*)xrow + lane;
    f32x4 v[16]; float s = 0.f;
#pragma unroll
    for (int k = 0; k < 16; ++k) { v[k] = xr[64 * k]; s += (v[k].x * v[k].x + v[k].y * v[k].y) + (v[k].z * v[k].z + v[k].w * v[k].w); }
    const float rs = 1.f / sqrtf(wave_sum(s) * (1.f / 4096.f) + EPSN);
    const f32x4* gr = (const f32x4*)gain + lane; u32x2* o8 = (u32x2*)orow + lane;
#pragma unroll
    for (int k = 0; k < 16; ++k) { const f32x4 g4 = gr[64 * k]; u32x2 o; o.x = pk2(v[k].x * rs * g4.x, v[k].y * rs * g4.y); o.y = pk2(v[k].z * rs * g4.z, v[k].w * rs * g4.w); o8[64 * k] = o; }
}

__device__ __forceinline__ void phase0(const Args& a, LAS unsigned char* lds) {
    const int tid = threadIdx.x, lane = tid & 63, w = tid >> 6, G = gridDim.x;
    const int gw = blockIdx.x * 8 + w, NGW = G * 8;
    unsigned char* ws = a.ws;
    LAS float* scr = (LAS float*)(lds + w * 16384);
    bf16_t* WT = (bf16_t*)(ws + WS_WT); bf16_t* WOUT = (bf16_t*)(ws + WS_WOUT); bf16_t* LRUW = (bf16_t*)(ws + WS_LRUW);
    constexpr int I_IN = 64 * (INW / 32), I_MKV = 64 * (2048 / 32), I_OUT = 64 * (4096 / 32), I_LRU = 32 * 8;
    constexpr int NITEMS = I_IN + I_MKV + I_OUT + I_LRU;
    for (int it = gw; it < NITEMS; it += NGW) {
        int r = it;
        if (r < I_IN) { p0_transpose_item(a.in[3], 4096, INW, WT, 0, scr, r, lane); continue; } r -= I_IN;
        if (r < I_MKV) { p0_transpose_item(a.in[13], 4096, 2048, WT, INW, scr, r, lane); continue; } r -= I_MKV;
        if (r < I_OUT) { p0_transpose_item(a.in[17], 4096, 4096, WOUT, 0, scr, r, lane); continue; } r -= I_OUT;
        { const int mat = r >> 3, sub = r & 7, gate = mat >> 4, dn = mat & 15;
          const float* src = (gate ? a.in[9] : a.in[7]) + (size_t)dn * 16384;
          p0_transpose_item(src, 128, 128, LRUW + (size_t)mat * 16384, 0, scr, sub, lane); }
    }
    bf16_t* U = (bf16_t*)(ws + WS_U);
    for (int m = gw; m < SEQ + NMEM; m += NGW) {
        if (m < SEQ) rms_row_to_bf16(a.in[0] + (size_t)m * 4096, a.in[2], U + (size_t)m * 4096, lane);
        else rms_row_to_bf16(a.in[1] + (size_t)(m - SEQ) * 4096, a.in[12], U + (size_t)m * 4096, lane);
    }
    f32x2* rope = (f32x2*)(ws + WS_ROPE);
    for (int e = blockIdx.x * 512 + tid; e < SEQ * 16; e += G * 512) {
        const int pos = e >> 4, i = e & 15;
        const float inv = powf(500000.0f, -(float)i * (1.0f / 16.0f));
        const float ang = (float)pos * inv;
        rope[e] = (f32x2){cosf(ang), sinf(ang)};
    }
}

struct Sched1 {
    pg8::StaticOrder so; int G, c;
    __device__ void init(int G_, int c_) { so.init(SEQ, INW, G_, c_); G = G_; c = c_; }
    __device__ bool next(int i, pg8::Unit& u) const {
        const long L = (long)i * G + c;
        if (L < 1152) return so.next(i, u);
        if (L < 1160) { u.pm = 32; u.pn = 36 + (int)(L - 1152); return true; }
        return false;
    }
    __device__ __forceinline__ void a_ready(const pg8::Unit&) const {}
    __device__ __forceinline__ void done(const pg8::Unit&) const {}
};
struct Epi1 {
    static constexpr bool PERM = true, AFTER_DRAIN = false;
    bf16_t* proj; bf16_t* vt; bf16_t* mk; bf16_t* mvt; const float* rope;
    __device__ __forceinline__ void operator()(const f32x4 (&acc)[2][2][4][2], const pg8::Unit& u, int wr, int wc, int fr, int fq) const {
        const int rloc = wr * 64 + fr, cloc = wc * 32 + 8 * fq;
        if (u.pm == 32) {
            const int t = u.pn - 36;
            if (t < 4) {
#pragma unroll
                for (int ai = 0; ai < 2; ++ai)
#pragma unroll
                    for (int m = 0; m < 4; ++m) { const int row = rloc + ai * 128 + m * 16;
#pragma unroll
                        for (int bj = 0; bj < 2; ++bj) { const f32x4 v0 = acc[ai][bj][m][0], v1 = acc[ai][bj][m][1];
                            u32x4 wv; wv.x = pk2(v0[0], v0[1]); wv.y = pk2(v0[2], v0[3]); wv.z = pk2(v1[0], v1[1]); wv.w = pk2(v1[2], v1[3]);
                            *(u32x4*)(mk + (size_t)row * 1024 + t * 256 + bj * 128 + cloc) = wv; } asm volatile("" ::: "memory"); }
            } else {
#pragma unroll
                for (int ai = 0; ai < 2; ++ai)
#pragma unroll
                    for (int m = 0; m < 4; ++m) { const int row = rloc + ai * 128 + m * 16;
#pragma unroll
                        for (int bj = 0; bj < 2; ++bj)
#pragma unroll
                            for (int n = 0; n < 2; ++n)
#pragma unroll
                                for (int i = 0; i < 4; ++i) { const int col = (t - 4) * 256 + bj * 128 + cloc + 4 * n + i;
                                    mvt[(size_t)col * 256 + row] = (bf16_t)(pk2(acc[ai][bj][m][n][i], 0.f) & 0xffffu); } asm volatile("" ::: "memory"); }
            }
            return;
        }
        const int pn = u.pn, row0 = u.pm * 256 + rloc;
        if (pn == 10 || pn == 11) {
#pragma unroll
            for (int ai = 0; ai < 2; ++ai)
#pragma unroll
                for (int m = 0; m < 4; ++m) { const int row = row0 + ai * 128 + m * 16;
#pragma unroll
                    for (int bj = 0; bj < 2; ++bj)
#pragma unroll
                        for (int n = 0; n < 2; ++n)
#pragma unroll
                            for (int i = 0; i < 4; ++i) { const int col = (pn - 10) * 256 + bj * 128 + cloc + 4 * n + i;
                                vt[(size_t)col * SEQ + row] = (bf16_t)(pk2(acc[ai][bj][m][n][i], 0.f) & 0xffffu); } asm volatile("" ::: "memory"); }
            return;
        }
        float sc = 1.f; if (pn < 8) sc = SC_ATT; else if (pn >= 16 && pn < 20) sc = SC_MEM;
        const bool do_rope = (pn < 10) && (wc == 0);
        const float sgn = (fq < 2) ? -1.f : 1.f;
#pragma unroll
        for (int ai = 0; ai < 2; ++ai)
#pragma unroll
            for (int m = 0; m < 4; ++m) { const int row = row0 + ai * 128 + m * 16;
                f32x4 cs[2][2];
                if (do_rope) {
#pragma unroll
                    for (int n = 0; n < 2; ++n) { const float* rp = rope + ((size_t)row * 16 + 8 * (fq & 1) + 4 * n) * 2; cs[n][0] = *(const f32x4*)rp; cs[n][1] = *(const f32x4*)(rp + 4); }
                }
#pragma unroll
                for (int bj = 0; bj < 2; ++bj) { f32x4 v[2]; v[0] = acc[ai][bj][m][0]; v[1] = acc[ai][bj][m][1];
                    if (do_rope) {
#pragma unroll
                        for (int n = 0; n < 2; ++n) { f32x4 p; p[0] = __shfl_xor(v[n][0], 32); p[1] = __shfl_xor(v[n][1], 32); p[2] = __shfl_xor(v[n][2], 32); p[3] = __shfl_xor(v[n][3], 32);
                            f32x4 r; r[0] = v[n][0] * cs[n][0][0] + sgn * p[0] * cs[n][0][1]; r[1] = v[n][1] * cs[n][0][2] + sgn * p[1] * cs[n][0][3];
                            r[2] = v[n][2] * cs[n][1][0] + sgn * p[2] * cs[n][1][1]; r[3] = v[n][3] * cs[n][1][2] + sgn * p[3] * cs[n][1][3]; v[n] = r; }
                    }
                    u32x4 wv; wv.x = pk2(v[0][0] * sc, v[0][1] * sc); wv.y = pk2(v[0][2] * sc, v[0][3] * sc); wv.z = pk2(v[1][0] * sc, v[1][1] * sc); wv.w = pk2(v[1][2] * sc, v[1][3] * sc);
                    *(u32x4*)(proj + (size_t)row * INW + pn * 256 + bj * 128 + cloc) = wv; } asm volatile("" ::: "memory"); }
    }
};

template <int DH, bool PF>
__device__ __forceinline__ void attn_unit(LAS unsigned char* lds, bf16_t* Qp, int ldq, const bf16_t* Kg, int ldk, const bf16_t* Vtg, int ldv,
                                          int cb_lo, int cb_hi, int cb_self, float m_init, float l_init) {
    constexpr int PR = DH / 8, KROW = DH * 2, KT = 128 * KROW, VROW = 272, NKI = (128 * PR) / 512, NVI = (DH * 16) / 512, NS = DH / 32, NDT = DH / 16;
    const int tid = threadIdx.x, lane = tid & 63, w = tid >> 6, q = lane & 15, g = lane >> 4;
    bf16x8 qf[NS];
    { const bf16_t* qrow = Qp + (size_t)(16 * w + q) * ldq + 8 * g;
#pragma unroll
      for (int s = 0; s < NS; ++s) qf[s] = *(const bf16x8*)(qrow + 32 * s); }
    f32x4 o[NDT];
#pragma unroll
    for (int dt = 0; dt < NDT; ++dt) o[dt] = (f32x4){0.f, 0.f, 0.f, 0.f};
    float m_run = m_init, l_run = l_init;
    u32x4 kreg[NKI], vreg[NVI];
#define ATT_LOAD(cb) do { const int k0_ = (cb) * 128; \
        _Pragma("unroll") for (int it = 0; it < NKI; ++it) { const int e = tid + 512 * it; const int key = e / PR, pc = e % PR; \
            kreg[it] = *(const u32x4*)(Kg + (size_t)(k0_ + key) * ldk + pc * 8); } \
        _Pragma("unroll") for (int it = 0; it < NVI; ++it) { const int e = tid + 512 * it; const int d = e >> 4, pc = e & 15; \
            vreg[it] = *(const u32x4*)(Vtg + (size_t)d * ldv + k0_ + pc * 8); } } while (0)
#define ATT_STORE() do { \
        _Pragma("unroll") for (int it = 0; it < NKI; ++it) { const int e = tid + 512 * it; const int key = e / PR, pc = e % PR; \
            *(LAS u32x4*)(lds + key * KROW + ((pc ^ (key & 15)) * 16)) = kreg[it]; } \
        _Pragma("unroll") for (int it = 0; it < NVI; ++it) { const int e = tid + 512 * it; const int d = e >> 4, pc = e & 15; \
            *(LAS u32x4*)(lds + KT + d * VROW + pc * 16) = vreg[it]; } } while (0)
    if (PF) ATT_LOAD(cb_lo);
    for (int cb = cb_lo; cb < cb_hi; ++cb) {
        if (!PF) ATT_LOAD(cb);
        __syncthreads();
        ATT_STORE();
        __syncthreads();
        if (PF) { if (cb + 1 < cb_hi) ATT_LOAD(cb + 1); }
        f32x4 s[8];
#pragma unroll
        for (int kt = 0; kt < 8; ++kt) { s[kt] = (f32x4){0.f, 0.f, 0.f, 0.f};
#pragma unroll
            for (int ss = 0; ss < NS; ++ss) {
                const bf16x8 ka = *(const LAS bf16x8*)(lds + (16 * kt + q) * KROW + (((4 * ss + g) ^ q) * 16));
                s[kt] = mfma16(ka, qf[ss], s[kt]); } }
        const int qq = 16 * w + q;
        if (cb == cb_self - 1) {
#pragma unroll
            for (int kt = 0; kt < 8; ++kt)
#pragma unroll
                for (int j = 0; j < 4; ++j) { if (16 * kt + 4 * g + j < qq) s[kt][j] = -1e30f; }
        } else if (cb == cb_self + 1) {
#pragma unroll
            for (int kt = 0; kt < 8; ++kt)
#pragma unroll
                for (int j = 0; j < 4; ++j) { if (16 * kt + 4 * g + j > qq) s[kt][j] = -1e30f; }
        }
        float mx = s[0][0];
#pragma unroll
        for (int kt = 0; kt < 8; ++kt)
#pragma unroll
            for (int j = 0; j < 4; ++j) mx = fmaxf(mx, s[kt][j]);
        mx = fmaxf(mx, __shfl_xor(mx, 16)); mx = fmaxf(mx, __shfl_xor(mx, 32));
        const float m_new = fmaxf(m_run, mx), alpha = fexp2(m_run - m_new); m_run = m_new;
        float rs = 0.f;
#pragma unroll
        for (int kt = 0; kt < 8; ++kt)
#pragma unroll
            for (int j = 0; j < 4; ++j) { const float p = fexp2(s[kt][j] - m_new); s[kt][j] = p; rs += p; }
        rs += __shfl_xor(rs, 16); rs += __shfl_xor(rs, 32);
        l_run = l_run * alpha + rs;
        bf16x8 pb[4];
#pragma unroll
        for (int u = 0; u < 4; ++u) { u32x4 t; t.x = pk2(s[2 * u][0], s[2 * u][1]); t.y = pk2(s[2 * u][2], s[2 * u][3]); t.z = pk2(s[2 * u + 1][0], s[2 * u + 1][1]); t.w = pk2(s[2 * u + 1][2], s[2 * u + 1][3]);
            pb[u] = __builtin_bit_cast(bf16x8, t); }
#pragma unroll
        for (int dt = 0; dt < NDT; ++dt) { o[dt] = o[dt] * alpha;
#pragma unroll
            for (int u = 0; u < 4; ++u) {
                const LAS unsigned char* vp = lds + KT + (16 * dt + q) * VROW + (32 * u + 4 * g) * 2;
                const u32x2 lo = *(const LAS u32x2*)vp, hi = *(const LAS u32x2*)(vp + 32);
                u32x4 t; t.x = lo.x; t.y = lo.y; t.z = hi.x; t.w = hi.y;
                o[dt] = mfma16(__builtin_bit_cast(bf16x8, t), pb[u], o[dt]); } }
    }
#undef ATT_LOAD
#undef ATT_STORE
    const float inv = 1.f / l_run;
    bf16_t* orow = Qp + (size_t)(16 * w + q) * ldq + 4 * g;
#pragma unroll
    for (int dt = 0; dt < NDT; ++dt) { u32x2 pkv; pkv.x = pk2(o[dt][0] * inv, o[dt][1] * inv); pkv.y = pk2(o[dt][2] * inv, o[dt][3] * inv); *(u32x2*)(orow + 16 * dt) = pkv; }
}

__device__ __forceinline__ void lru_gate_unit(LAS unsigned char* lds, const Args& a, int tt, int n) {
    const int tid = threadIdx.x, lane = tid & 63, w = tid >> 6, q = lane & 15, g = lane >> 4;
    unsigned char* ws = a.ws;
    const bf16_t* proj = (const bf16_t*)(ws + WS_PROJ);
    LAS unsigned char* xcb = lds;
    LAS float* xcf = (LAS float*)(lds + 32768);
    const int t0 = tt * 128;
    __syncthreads();
    {
        const int cg8 = tid & 15, t4 = tid >> 4, ch0 = n * 128 + cg8 * 8;
        float xin[7][8];
#pragma unroll
        for (int r = 0; r < 7; ++r) { const int t = t0 + 4 * t4 - 2 + r;
            u32x4 v = (u32x4){0u, 0u, 0u, 0u};
            if (t >= 0 && t < SEQ) v = *(const u32x4*)(proj + (size_t)t * INW + C_XL + ch0);
            xin[r][0] = bflo(v.x); xin[r][1] = bfhi(v.x); xin[r][2] = bflo(v.y); xin[r][3] = bfhi(v.y); xin[r][4] = bflo(v.z); xin[r][5] = bfhi(v.z); xin[r][6] = bflo(v.w); xin[r][7] = bfhi(v.w); }
        float wv[4][8], bias[8];
#pragma unroll
        for (int j = 0; j < 4; ++j) { const f32x4 w0 = *(const f32x4*)(a.in[5] + j * 1024 + ch0), w1 = *(const f32x4*)(a.in[5] + j * 1024 + ch0 + 4);
            wv[j][0] = w0[0]; wv[j][1] = w0[1]; wv[j][2] = w0[2]; wv[j][3] = w0[3]; wv[j][4] = w1[0]; wv[j][5] = w1[1]; wv[j][6] = w1[2]; wv[j][7] = w1[3]; }
        { const f32x4 b0 = *(const f32x4*)(a.in[6] + ch0), b1 = *(const f32x4*)(a.in[6] + ch0 + 4);
          bias[0] = b0[0]; bias[1] = b0[1]; bias[2] = b0[2]; bias[3] = b0[3]; bias[4] = b1[0]; bias[5] = b1[1]; bias[6] = b1[2]; bias[7] = b1[3]; }
#pragma unroll
        for (int o = 0; o < 4; ++o) { float y[8];
#pragma unroll
            for (int e = 0; e < 8; ++e) { float v = bias[e];
#pragma unroll
                for (int j = 0; j < 4; ++j) v += wv[j][e] * xin[o + j][e];
                y[e] = v; }
            const int tok = 4 * t4 + o;
            *(LAS f32x4*)(xcf + tok * 132 + cg8 * 8) = (f32x4){y[0], y[1], y[2], y[3]};
            *(LAS f32x4*)(xcf + tok * 132 + cg8 * 8 + 4) = (f32x4){y[4], y[5], y[6], y[7]};
            u32x4 pk; pk.x = pk2(y[0], y[1]); pk.y = pk2(y[2], y[3]); pk.z = pk2(y[4], y[5]); pk.w = pk2(y[6], y[7]);
            *(LAS u32x4*)(xcb + tok * 256 + ((cg8 ^ (tok & 15)) * 16)) = pk; }
    }
    __syncthreads();
    const bf16_t* lruw = (const bf16_t*)(ws + WS_LRUW);
    float* AB = (float*)(ws + WS_AB);
#pragma unroll 1
    for (int dir = 0; dir < 2; ++dir) {
        const bf16_t* wa = lruw + (size_t)((0 * 2 + dir) * 8 + n) * 16384 + (16 * w + q) * 128 + 8 * g;
        const bf16_t* wx = lruw + (size_t)((1 * 2 + dir) * 8 + n) * 16384 + (16 * w + q) * 128 + 8 * g;
        bf16x8 fa[4], fx[4];
#pragma unroll
        for (int s = 0; s < 4; ++s) { fa[s] = *(const bf16x8*)(wa + 32 * s); fx[s] = *(const bf16x8*)(wx + 32 * s); }
        const int chl = 16 * w + 4 * g, chg = n * 128 + chl;
        const f32x4 ba = *(const f32x4*)(a.in[8] + dir * 1024 + chg), bx = *(const f32x4*)(a.in[10] + dir * 1024 + chg), lam = *(const f32x4*)(a.in[11] + dir * 1024 + chg);
        f32x4 sp;
#pragma unroll
        for (int j = 0; j < 4; ++j) { const float xl = -lam[j]; sp[j] = fmaxf(xl, 0.f) + log1pf(expf(-fabsf(xl))); }
        float* Ap = AB + (size_t)(dir * 2 + 0) * ABSZ; float* Bp = AB + (size_t)(dir * 2 + 1) * ABSZ;
#pragma unroll 1
        for (int tk = 0; tk < 8; ++tk) { const int tok = 16 * tk + q;
            f32x4 ar = (f32x4){0.f, 0.f, 0.f, 0.f}, ai = (f32x4){0.f, 0.f, 0.f, 0.f};
#pragma unroll
            for (int s = 0; s < 4; ++s) {
                const bf16x8 xb = *(const LAS bf16x8*)(xcb + tok * 256 + (((4 * s + g) ^ q) * 16));
                ar = mfma16(fa[s], xb, ar); ai = mfma16(fx[s], xb, ai); }
            const f32x4 xc4 = *(const LAS f32x4*)(xcf + tok * 132 + chl);
            f32x4 av, bv;
#pragma unroll
            for (int j = 0; j < 4; ++j) { const float r = sigmoidf_(ar[j] + ba[j]), ii = sigmoidf_(ai[j] + bx[j]);
                const float la = -8.0f * r * sp[j]; av[j] = expf(la); bv[j] = sqrtf(-expm1f(2.0f * la)) * ii * xc4[j]; }
            *(f32x4*)(Ap + (size_t)(t0 + tok) * 1024 + chg) = av; *(f32x4*)(Bp + (size_t)(t0 + tok) * 1024 + chg) = bv; }
    }
}

__device__ __forceinline__ void phase2(const Args& a, LAS unsigned char* lds) {
    unsigned char* ws = a.ws;
    bf16_t* proj = (bf16_t*)(ws + WS_PROJ); const bf16_t* vt = (const bf16_t*)(ws + WS_VT);
    const bf16_t* mk = (const bf16_t*)(ws + WS_MK); const bf16_t* mvt = (const bf16_t*)(ws + WS_MVT);
    if (P2MASK & 1)
    for (int u = blockIdx.x; u < 256; u += gridDim.x) {
        const int qblk = u >> 2, hm = u & 3;
        attn_unit<256, false>(lds, proj + (size_t)(qblk * 128) * INW + C_QM + hm * 256, INW, mk + hm * 256, 1024, mvt + (size_t)(hm * 256) * 256, 256, 0, 2, -100, -1e30f, 0.f);
    }
    if (P2MASK & 2)
    for (int v = blockIdx.x; v < 1024; v += gridDim.x) {
        const int qblk = v >> 4, hq = v & 15, kvh = hq >> 2;
        const int lo = qblk > 0 ? qblk - 1 : 0, hi = qblk < 63 ? qblk + 2 : 64;
        const float sink2 = a.in[4][hq] * LOG2E;
        attn_unit<128, true>(lds, proj + (size_t)(qblk * 128) * INW + C_QA + hq * 128, INW, proj + C_KA + kvh * 128, INW, vt + (size_t)(kvh * 128) * SEQ, SEQ, lo, hi, qblk, sink2, 1.f);
    }
    if (P2MASK & 4)
    for (int v = blockIdx.x; v < 512; v += gridDim.x) lru_gate_unit(lds, a, v >> 3, v & 7);
}

__device__ __forceinline__ void phase3(const Args& a, LAS unsigned char* lds) {
    unsigned char* ws = a.ws; const float* AB = (const float*)(ws + WS_AB);
    f32x2* agg1 = (f32x2*)(ws + WS_AGG1); f32x2* agg2 = (f32x2*)(ws + WS_AGG2);
    LAS f32x2* sagg = (LAS f32x2*)lds;
    const int tid = threadIdx.x, chl = tid & 31, dir = (tid >> 5) & 1, cj = tid >> 6;
    for (int u = blockIdx.x; u < 1024; u += gridDim.x) {
        const int sc = u >> 5, cgp = u & 31, ch = cgp * 32 + chl, ck = sc * 8 + cj;
        const float* Ap = AB + (size_t)(dir * 2 + 0) * ABSZ + (size_t)(ck * 32) * 1024 + ch;
        const float* Bp = AB + (size_t)(dir * 2 + 1) * ABSZ + (size_t)(ck * 32) * 1024 + ch;
        float av[32], bv[32];
#pragma unroll
        for (int t = 0; t < 32; ++t) { av[t] = Ap[(size_t)t * 1024]; bv[t] = Bp[(size_t)t * 1024]; }
        float A = 1.f, H = 0.f;
        if (dir == 0) {
#pragma unroll
            for (int t = 0; t < 32; ++t) { H = av[t] * H + bv[t]; A *= av[t]; }
        } else {
#pragma unroll
            for (int t = 31; t >= 0; --t) { H = av[t] * H + bv[t]; A *= av[t]; }
        }
        agg1[(size_t)(dir * 256 + ck) * 1024 + ch] = (f32x2){A, H};
        __syncthreads();
        sagg[(cj * 2 + dir) * 32 + chl] = (f32x2){A, H};
        __syncthreads();
        if (cj == 0) {
            float A2 = 1.f, H2 = 0.f;
#pragma unroll
            for (int j = 0; j < 8; ++j) { const int jj = dir ? 7 - j : j; const f32x2 e = sagg[(jj * 2 + dir) * 32 + chl]; H2 = e.x * H2 + e.y; A2 *= e.x; }
            agg2[(size_t)(dir * 32 + sc) * 1024 + ch] = (f32x2){A2, H2};
        }
    }
}

__device__ __forceinline__ float silu_(float z) { return z / (1.f + __expf(-z)); }
__device__ __forceinline__ void phase4(const Args& a, LAS unsigned char* lds) {
    unsigned char* ws = a.ws; const float* AB = (const float*)(ws + WS_AB);
    const f32x2* agg1 = (const f32x2*)(ws + WS_AGG1); const f32x2* agg2 = (const f32x2*)(ws + WS_AGG2);
    const bf16_t* proj = (const bf16_t*)(ws + WS_PROJ); bf16_t* Y = (bf16_t*)(ws + WS_Y);
    LAS float* ylds = (LAS float*)lds;
    const int tid = threadIdx.x, lane = tid & 63, w = tid >> 6;
    for (int ck = blockIdx.x; ck < 256; ck += gridDim.x) {
        const int sc = ck >> 3;
        __syncthreads();
#pragma unroll 1
        for (int half = 0; half < 2; ++half) {
            const int c = tid + 512 * half;
            float hf = 0.f, hb = 0.f;
            for (int s2 = 0; s2 < sc; ++s2) { const f32x2 e = agg2[(size_t)(0 * 32 + s2) * 1024 + c]; hf = e.x * hf + e.y; }
            for (int c1 = sc * 8; c1 < ck; ++c1) { const f32x2 e = agg1[(size_t)(0 * 256 + c1) * 1024 + c]; hf = e.x * hf + e.y; }
            for (int s2 = 31; s2 > sc; --s2) { const f32x2 e = agg2[(size_t)(1 * 32 + s2) * 1024 + c]; hb = e.x * hb + e.y; }
            for (int c1 = sc * 8 + 7; c1 > ck; --c1) { const f32x2 e = agg1[(size_t)(1 * 256 + c1) * 1024 + c]; hb = e.x * hb + e.y; }
            const float* Af = AB + (size_t)0 * ABSZ + (size_t)(ck * 32) * 1024 + c; const float* Bf = AB + (size_t)1 * ABSZ + (size_t)(ck * 32) * 1024 + c;
            const float* Ab = AB + (size_t)2 * ABSZ + (size_t)(ck * 32) * 1024 + c; const float* Bb = AB + (size_t)3 * ABSZ + (size_t)(ck * 32) * 1024 + c;
            float yv[32];
#pragma unroll
            for (int t = 0; t < 32; ++t) { hf = Af[(size_t)t * 1024] * hf + Bf[(size_t)t * 1024]; yv[t] = hf; }
#pragma unroll
            for (int t = 31; t >= 0; --t) { hb = Ab[(size_t)t * 1024] * hb + Bb[(size_t)t * 1024]; yv[t] += hb; }
#pragma unroll
            for (int t = 0; t < 32; ++t) ylds[t * 1024 + c] = yv[t];
        }
        __syncthreads();
#pragma unroll 1
        for (int tk = 0; tk < 4; ++tk) {
            const int tl = 4 * w + tk, t = ck * 32 + tl;
            const bf16_t* prow = proj + (size_t)t * INW; bf16_t* yrow = Y + (size_t)t * 4096;
            { f32x4 v[4]; float ss = 0.f;
#pragma unroll
              for (int k = 0; k < 4; ++k) { v[k] = *(const LAS f32x4*)(ylds + tl * 1024 + 4 * lane + 256 * k); ss += (v[k][0] * v[k][0] + v[k][1] * v[k][1]) + (v[k][2] * v[k][2] + v[k][3] * v[k][3]); }
              const float rs = 1.f / sqrtf(wave_sum(ss) * (1.f / 1024.f) + EPSN);
#pragma unroll
              for (int k = 0; k < 4; ++k) { const int c = 4 * lane + 256 * k; const f32x4 g4 = *(const f32x4*)(a.in[15] + c); const u32x2 z = *(const u32x2*)(prow + C_ZL + c);
                  u32x2 o; o.x = pk2(v[k][0] * rs * g4[0] * silu_(bflo(z.x)), v[k][1] * rs * g4[1] * silu_(bfhi(z.x))); o.y = pk2(v[k][2] * rs * g4[2] * silu_(bflo(z.y)), v[k][3] * rs * g4[3] * silu_(bfhi(z.y)));
                  *(u32x2*)(yrow + 2048 + c) = o; } }
            { u32x4 v[4]; float ss = 0.f;
#pragma unroll
              for (int k = 0; k < 4; ++k) { v[k] = *(const u32x4*)(prow + C_QA + 8 * lane + 512 * k);
                  const float f0 = bflo(v[k].x), f1 = bfhi(v[k].x), f2 = bflo(v[k].y), f3 = bfhi(v[k].y), f4 = bflo(v[k].z), f5 = bfhi(v[k].z), f6 = bflo(v[k].w), f7 = bfhi(v[k].w);
                  ss += ((f0 * f0 + f1 * f1) + (f2 * f2 + f3 * f3)) + ((f4 * f4 + f5 * f5) + (f6 * f6 + f7 * f7)); }
              const float rs = 1.f / sqrtf(wave_sum(ss) * (1.f / 2048.f) + EPSN);
#pragma unroll
              for (int k = 0; k < 4; ++k) { const int c = 8 * lane + 512 * k; const f32x4 g0 = *(const f32x4*)(a.in[14] + c), g1 = *(const f32x4*)(a.in[14] + c + 4); const u32x4 z = *(const u32x4*)(prow + C_ZA + c);
                  u32x4 o; o.x = pk2(bflo(v[k].x) * rs * g0[0] * silu_(bflo(z.x)), bfhi(v[k].x) * rs * g0[1] * silu_(bfhi(z.x)));
                  o.y = pk2(bflo(v[k].y) * rs * g0[2] * silu_(bflo(z.y)), bfhi(v[k].y) * rs * g0[3] * silu_(bfhi(z.y)));
                  o.z = pk2(bflo(v[k].z) * rs * g1[0] * silu_(bflo(z.z)), bfhi(v[k].z) * rs * g1[1] * silu_(bfhi(z.z)));
                  o.w = pk2(bflo(v[k].w) * rs * g1[2] * silu_(bflo(z.w)), bfhi(v[k].w) * rs * g1[3] * silu_(bfhi(z.w)));
                  *(u32x4*)(yrow + c) = o; } }
            { u32x4 v[2]; float ss = 0.f;
#pragma unroll
              for (int k = 0; k < 2; ++k) { v[k] = *(const u32x4*)(prow + C_QM + 8 * lane + 512 * k);
                  const float f0 = bflo(v[k].x), f1 = bfhi(v[k].x), f2 = bflo(v[k].y), f3 = bfhi(v[k].y), f4 = bflo(v[k].z), f5 = bfhi(v[k].z), f6 = bflo(v[k].w), f7 = bfhi(v[k].w);
                  ss += ((f0 * f0 + f1 * f1) + (f2 * f2 + f3 * f3)) + ((f4 * f4 + f5 * f5) + (f6 * f6 + f7 * f7)); }
              const float rs = 1.f / sqrtf(wave_sum(ss) * (1.f / 1024.f) + EPSN);
#pragma unroll
              for (int k = 0; k < 2; ++k) { const int c = 8 * lane + 512 * k; const f32x4 g0 = *(const f32x4*)(a.in[16] + c), g1 = *(const f32x4*)(a.in[16] + c + 4); const u32x4 z = *(const u32x4*)(prow + C_ZM + c);
                  u32x4 o; o.x = pk2(bflo(v[k].x) * rs * g0[0] * silu_(bflo(z.x)), bfhi(v[k].x) * rs * g0[1] * silu_(bfhi(z.x)));
                  o.y = pk2(bflo(v[k].y) * rs * g0[2] * silu_(bflo(z.y)), bfhi(v[k].y) * rs * g0[3] * silu_(bfhi(z.y)));
                  o.z = pk2(bflo(v[k].z) * rs * g1[0] * silu_(bflo(z.z)), bfhi(v[k].z) * rs * g1[1] * silu_(bfhi(z.z)));
                  o.w = pk2(bflo(v[k].w) * rs * g1[2] * silu_(bflo(z.w)), bfhi(v[k].w) * rs * g1[3] * silu_(bfhi(z.w)));
                  *(u32x4*)(yrow + 3072 + c) = o; } }
        }
    }
}

struct Epi2 {
    static constexpr bool PERM = false, AFTER_DRAIN = false;
    float* out; float* sspart;
    __device__ __forceinline__ void operator()(const f32x4 (&acc)[2][2][4][2], const pg8::Unit& u, int wr, int wc, int fr, int fq) const {
#pragma unroll
        for (int ai = 0; ai < 2; ++ai)
#pragma unroll
            for (int m = 0; m < 4; ++m) { const int row = u.pm * 256 + ai * 128 + wr * 64 + m * 16 + fr; float ss = 0.f;
#pragma unroll
                for (int bj = 0; bj < 2; ++bj)
#pragma unroll
                    for (int n = 0; n < 2; ++n) { const f32x4 v = acc[ai][bj][m][n]; const int col = u.pn * 256 + bj * 128 + wc * 32 + n * 16 + 4 * fq;
                        *(f32x4*)(out + (size_t)row * 4096 + col) = v; ss += (v[0] * v[0] + v[1] * v[1]) + (v[2] * v[2] + v[3] * v[3]); }
                ss += __shfl_xor(ss, 16); ss += __shfl_xor(ss, 32);
                if (fq == 0) sspart[(size_t)row * 64 + u.pn * 4 + wc] = ss; }
    }
};
__device__ __forceinline__ void phase6(const Args& a) {
    const int tid = threadIdx.x, lane = tid & 63, w = tid >> 6;
    const float* sspart = (const float*)(a.ws + WS_SS);
    for (int row = blockIdx.x * 8 + w; row < SEQ; row += gridDim.x * 8) {
        const float ss = wave_sum(sspart[(size_t)row * 64 + lane]);
        const float rs = 1.f / sqrtf(ss * (1.f / 4096.f) + EPSN);
        f32x4* o4 = (f32x4*)(a.out + (size_t)row * 4096) + lane; const f32x4* x4 = (const f32x4*)(a.in[0] + (size_t)row * 4096) + lane; const f32x4* g4 = (const f32x4*)a.in[18] + lane;
#pragma unroll
        for (int k = 0; k < 16; ++k) { const f32x4 ov = o4[64 * k], xv = x4[64 * k], gv = g4[64 * k]; o4[64 * k] = xv + ov * rs * gv; }
    }
}

__global__ void __launch_bounds__(512, 2) mega(Args a) {
    extern __shared__ __attribute__((aligned(16))) unsigned char lds_raw[];
    LAS unsigned char* lds = (LAS unsigned char*)lds_raw;
    cg::grid_group grid = cg::this_grid();
    unsigned char* ws = a.ws;
    const int lo = a.ph_lo, hi = a.ph_hi;
#define IN(k) (lo <= (k) && (k) < hi)
#define SEAM(k) do { if (IN(k) && IN((k) + 1)) { __syncthreads(); grid.sync(); } } while (0)
    if (IN(0)) { if (PHMASK & 1) phase0(a, lds); }
    SEAM(0);
    if (IN(1)) { if (PHMASK & 2) {
        pg8::Gemm g{(const bf16_t*)(ws + WS_U), (const bf16_t*)(ws + WS_WT), SEQ + NMEM, INW + 2048, 4096};
        Sched1 S; S.init((int)gridDim.x, (int)blockIdx.x);
        Epi1 E{(bf16_t*)(ws + WS_PROJ), (bf16_t*)(ws + WS_VT), (bf16_t*)(ws + WS_MK), (bf16_t*)(ws + WS_MVT), (const float*)(ws + WS_ROPE)};
        pg8::gemm_phase<Epi1, Sched1, true, true>(lds, g, S, E);
    } }
    SEAM(1);
    if (IN(2)) { if (PHMASK & 4) phase2(a, lds); }
    SEAM(2);
    if (IN(3)) { if (PHMASK & 8) phase3(a, lds); }
    SEAM(3);
    if (IN(4)) { if (PHMASK & 16) phase4(a, lds); }
    SEAM(4);
    if (IN(5)) { if (PHMASK & 32) {
        pg8::Gemm g{(const bf16_t*)(ws + WS_Y), (const bf16_t*)(ws + WS_WOUT), SEQ, 4096, 4096};
        pg8::StaticOrder S; S.init(SEQ, 4096, (int)gridDim.x, (int)blockIdx.x);
        Epi2 E{a.out, (float*)(ws + WS_SS)};
        pg8::gemm_phase<Epi2, pg8::StaticOrder, true, true>(lds, g, S, E);
    } }
    SEAM(5);
    if (IN(6)) { if (PHMASK & 64) phase6(a); }
#undef IN
#undef SEAM
}

extern "C" void kernel_launch(void* const* d_in, const int* in_sizes, int n_in, void* d_out, int out_size, void* d_ws, size_t ws_size, hipStream_t stream) {
    static int grid = 0;
    if (grid == 0) {
        if (n_in != 19 || ws_size < WS_END) { fprintf(stderr, "kernel_launch: unexpected n_in %d or ws_size %zu (need %zu)\n", n_in, ws_size, (size_t)WS_END); grid = -1; return; }
        int dev = 0, cus = 0, per_cu = 0;
        hipGetDevice(&dev); hipDeviceGetAttribute(&cus, hipDeviceAttributeMultiprocessorCount, dev);
        if (hipFuncSetAttribute((const void*)mega, hipFuncAttributeMaxDynamicSharedMemorySize, LDS_BYTES) != hipSuccess) { fprintf(stderr, "kernel_launch: hipFuncSetAttribute failed\n"); grid = -1; return; }
        if (hipOccupancyMaxActiveBlocksPerMultiprocessor(&per_cu, (const void*)mega, 512, LDS_BYTES) != hipSuccess || per_cu < 1) { fprintf(stderr, "kernel_launch: occupancy query says %d\n", per_cu); per_cu = 1; }
        (void)hipGetLastError();
        grid = cus * 1;
        if (grid <= 0) grid = 256;
    }
    if (grid < 0) return;
    Args a{};
    for (int i = 0; i < 19; ++i) a.in[i] = (const float*)d_in[i];
    a.out = (float*)d_out; a.ws = (unsigned char*)d_ws;
#if N_LAUNCHES == 1
    a.ph_lo = 0; a.ph_hi = NPH;
    void* args[] = {&a};
    hipError_t e = hipLaunchCooperativeKernel((const void*)mega, dim3(grid), dim3(512), args, LDS_BYTES, stream);
    if (e != hipSuccess) fprintf(stderr, "cooperative launch failed: %s (grid %d)\n", hipGetErrorString(e), grid);
#else
    for (int ph = 0; ph < NPH; ++ph) { a.ph_lo = ph; a.ph_hi = ph + 1; hipLaunchKernelGGL(mega, dim3(grid), dim3(512), LDS_BYTES, stream, a); }
#endif
}
```

```cpp
#include <hip/hip_runtime.h>
#include <hip/hip_cooperative_groups.h>
#include <cstdio>
#include <cstdint>
namespace cg = cooperative_groups;
#define N_LAUNCHES 1
namespace pg8 {
#define PG8_LAS __attribute__((address_space(3)))
typedef unsigned short bf16_t;
typedef short bf16x8 __attribute__((ext_vector_type(8)));
typedef float f32x4 __attribute__((ext_vector_type(4)));
typedef unsigned u32x4 __attribute__((ext_vector_type(4)));
constexpr int BM = 256, BK = 64, HALF = 128, HTB = HALF * BK * 2  , STAGE_BYTES = 8 * HTB, NXCD = 8, WGM = 8;

__host__ __device__ __forceinline__ int lds_byte(int r, int c) { const int st = (r >> 4) * 2 + (c >> 5), rr = r & 15, cc = c & 31, ob = rr * 64 + cc * 2; return st * 1024 + (ob ^ (((ob >> 9) & 1) << 5)); }
__host__ __device__ __forceinline__ void stage_rc(int b, int& R, int& C) { const int st = b / 1024, sb = b % 1024, swz = sb ^ (((sb >> 9) & 1) << 5); R = (st >> 1) * 16 + swz / 64; C = (st & 1) * 32 + (swz % 64) / 2; }
__host__ __device__ __forceinline__ int perm32(int rho) { const int n = rho >> 4, i = rho & 15; return 8 * (i >> 2) + 4 * n + (i & 3); }

struct Unit { int pm, pn; };
struct Gemm { const bf16_t* A; const bf16_t* Bt; int M, N, K; };

struct StaticOrder {
    int nM, nN, nwg, G, c;
    __host__ __device__ void init(int M, int N, int G_, int c_) { nM = M / BM; nN = N / BM; nwg = nM * nN; G = G_; c = c_; }
    __host__ __device__ bool next(int i, Unit& u) const {
        const long L = (long)i * G + c; if (L >= nwg) return false;
        int wgid = (int)L; { const int q = nwg / NXCD, r = nwg % NXCD, xcd = wgid % NXCD, off = wgid / NXCD; wgid = (xcd < r ? xcd * (q + 1) : r * (q + 1) + (xcd - r) * q) + off; }
        const int nig = WGM * nN, gid = wgid / nig, fm = gid * WGM, gsz = (nM - fm) < WGM ? (nM - fm) : WGM;
        u.pm = fm + ((wgid % nig) % gsz); u.pn = (wgid % nig) / gsz; return true;
    }
    __device__ __forceinline__ void a_ready(const Unit&) const {}
    __device__ __forceinline__ void done(const Unit&) const {}
};

__device__ __forceinline__ unsigned cvt_pk_bf16(float lo, float hi) { unsigned r; asm volatile("v_cvt_pk_bf16_f32 %0, %1, %2" : "=v"(r) : "v"(lo), "v"(hi)); return r; }
typedef float f32x2 __attribute__((ext_vector_type(2)));
__device__ __forceinline__ f32x2 gelu_pk(f32x2 v) {
    const f32x2 av = __builtin_elementwise_abs(v), d = av * 0.2316418882f + 1.0f;
    f32x2 t; t.x = __builtin_amdgcn_rcpf(d.x); t.y = __builtin_amdgcn_rcpf(d.y);
    f32x2 q = t * 0.5307027145f + (-0.7265760135f); q = q * t + 0.7107068705f; q = q * t + (-0.142248368f); q = q * t + 0.127414796f; q = q * t;
    const f32x2 s = (v * v) * (-0.72134752044f);
    f32x2 e; e.x = __builtin_amdgcn_exp2f(s.x); e.y = __builtin_amdgcn_exp2f(s.y);
    const f32x2 m = v * (q * e), r = v - m;
    f32x2 o; o.x = v.x < 0.f ? m.x : r.x; o.y = v.y < 0.f ? m.y : r.y; return o;
}

template <int ACT  > struct EpiBf16 {
    static constexpr bool PERM = true, AFTER_DRAIN = false; static_assert(ACT == 0 || ACT == 1, "EpiBf16: ACT is 0 (none) or 1 (gelu_pk)");
    bf16_t* O; int ldc; const float* bias; int split_cols; size_t split_stride; float scale0;
    __device__ __forceinline__ void operator()(const f32x4 (&acc)[2][2][4][2], const Unit& u, int wr, int wc, int fr, int fq) const {
        const int row0 = u.pm * BM + wr * 64 + fr; int colt = u.pn * BM; bf16_t* base = O;
        float sc = 1.f; if (split_cols) { const int t = colt / split_cols; base += (size_t)t * split_stride; colt -= t * split_cols; if (t == 0) sc = scale0; }
        const int col0 = colt + wc * 32 + 8 * fq, bcol0 = u.pn * BM + wc * 32 + 8 * fq;
        f32x4 bv[2][2];
#pragma unroll
        for (int bj = 0; bj < 2; ++bj)
#pragma unroll
            for (int n = 0; n < 2; ++n) bv[bj][n] = bias ? *(const f32x4*)(bias + bcol0 + bj * HALF + 4 * n) : (f32x4){0.f, 0.f, 0.f, 0.f};
#pragma unroll
        for (int ai = 0; ai < 2; ++ai)
#pragma unroll
            for (int m = 0; m < 4; ++m) { bf16_t* rowp = base + (size_t)(row0 + ai * HALF + m * 16) * ldc + col0;
#pragma unroll
                for (int bj = 0; bj < 2; ++bj) { f32x4 v0 = acc[ai][bj][m][0] + bv[bj][0], v1 = acc[ai][bj][m][1] + bv[bj][1];
                    if (ACT == 1) { f32x2 a = gelu_pk((f32x2){v0[0], v0[1]}), b = gelu_pk((f32x2){v0[2], v0[3]}), c = gelu_pk((f32x2){v1[0], v1[1]}), d = gelu_pk((f32x2){v1[2], v1[3]});
                        v0 = (f32x4){a.x, a.y, b.x, b.y}; v1 = (f32x4){c.x, c.y, d.x, d.y}; }
                    v0 = v0 * sc; v1 = v1 * sc; u32x4 w; w.x = cvt_pk_bf16(v0[0], v0[1]); w.y = cvt_pk_bf16(v0[2], v0[3]); w.z = cvt_pk_bf16(v1[0], v1[1]); w.w = cvt_pk_bf16(v1[2], v1[3]);
                    *(u32x4*)(rowp + bj * HALF) = w; } }
    }
};
template <class Epi, class Sched, bool ALIGN_EPI = false, bool SP2 = false>
__device__ __forceinline__ void gemm_phase(PG8_LAS unsigned char* lds, const Gemm g, const Sched& S, const Epi& E) {
    const int tid = threadIdx.x, wid = __builtin_amdgcn_readfirstlane(tid >> 6), lane = tid & 63, wr = wid >> 2, wc = wid & 3, fr = lane & 15, fq = lane >> 4;
    const int K = g.K, nt = K / BK;
    unsigned voffA[2], voffB[2];
#pragma unroll
    for (int i = 0; i < 2; ++i) { int R, C; stage_rc(tid * 16 + i * 8192, R, C); const int Rb = Epi::PERM ? ((R & ~31) + perm32(R & 31)) : R;
        voffA[i] = (unsigned)(R * K + C) * 2u; voffB[i] = (unsigned)(Rb * K + C) * 2u; }
    const size_t kstep = (size_t)(BK * 2);
    const size_t hstep = (size_t)HALF * K * 2;
    const size_t tstep = 2 * hstep;
    const unsigned ldsw = (unsigned)wid * 1024u;
    const int aoff = lds_byte(wr * 64 + fr, fq * 8), boff = lds_byte(wc * 32 + fr, fq * 8);
#define PG8_SA(b, h) (((b) * 2 + (h)) * HTB)
#define PG8_SB(b, h) ((4 + (b) * 2 + (h)) * HTB)
#define PG8_STAGE(bufoff, gbase, voff) do { _Pragma("unroll") for (int _i = 0; _i < 2; ++_i) \
        __builtin_amdgcn_global_load_lds((const unsigned*)((const char*)(gbase) + (voff)[_i]), (PG8_LAS unsigned*)(lds + (bufoff) + ldsw + _i * 8192), 16, 0, 0); } while (0)
#define PG8_LDA(dst, b, h) do { _Pragma("unroll") for (int m = 0; m < 4; ++m) _Pragma("unroll") for (int k = 0; k < 2; ++k) dst[m][k] = *(const PG8_LAS bf16x8*)(lds + PG8_SA(b, h) + aoff + m * 2048 + k * 1024); } while (0)
#define PG8_LDB(dst, b, h) do { _Pragma("unroll") for (int n = 0; n < 2; ++n) _Pragma("unroll") for (int k = 0; k < 2; ++k) dst[n][k] = *(const PG8_LAS bf16x8*)(lds + PG8_SB(b, h) + boff + n * 2048 + k * 1024); } while (0)
#define PG8_MMA(ai, bj, At, Bt) do { __builtin_amdgcn_s_setprio(1); _Pragma("unroll") for (int m = 0; m < 4; ++m) _Pragma("unroll") for (int n = 0; n < 2; ++n) _Pragma("unroll") for (int k = 0; k < 2; ++k) \
        acc[ai][bj][m][n] = __builtin_amdgcn_mfma_f32_16x16x32_bf16(Bt[n][k], At[m][k], acc[ai][bj][m][n], 0, 0, 0); __builtin_amdgcn_s_setprio(0); } while (0)
#define PG8_WAIT_V(n) asm volatile("s_waitcnt vmcnt(" #n ")" ::: "memory")
#define PG8_WAIT_L(n) asm volatile("s_waitcnt lgkmcnt(" #n ")" ::: "memory")
#define PG8_BAR __builtin_amdgcn_s_barrier()
#define PG8_SCHED __builtin_amdgcn_sched_barrier(0)
    Unit cur, nxt; int ui = 0;
    if (!S.next(0, cur)) return;
    f32x4 acc[2][2][4][2];
#pragma unroll
    for (int a = 0; a < 2; ++a)
#pragma unroll
        for (int b = 0; b < 2; ++b)
#pragma unroll
            for (int m = 0; m < 4; ++m)
#pragma unroll
                for (int n = 0; n < 2; ++n) acc[a][b][m][n] = (f32x4){0.f, 0.f, 0.f, 0.f};
    bf16x8 At[4][2], B0[2][2], B1[2][2];
    const char* cA = (const char*)g.A + (size_t)cur.pm * tstep; const char* cB = (const char*)g.Bt + (size_t)cur.pn * tstep;
    S.a_ready(cur);
    if constexpr (SP2) {
        PG8_STAGE(PG8_SB(0, 0), cB, voffB); PG8_STAGE(PG8_SB(0, 1), cB + hstep, voffB); PG8_STAGE(PG8_SA(0, 0), cA, voffA); PG8_STAGE(PG8_SA(0, 1), cA + hstep, voffA);
        if (wr == 1) PG8_BAR;
        PG8_WAIT_V(2); PG8_BAR;
        PG8_STAGE(PG8_SB(1, 0), cB + kstep, voffB); PG8_STAGE(PG8_SA(1, 0), cA + kstep, voffA); PG8_STAGE(PG8_SB(1, 1), cB + hstep + kstep, voffB);
        PG8_WAIT_V(6); PG8_BAR;
    } else {
        PG8_STAGE(PG8_SB(0, 0), cB, voffB); PG8_STAGE(PG8_SA(0, 0), cA, voffA); PG8_STAGE(PG8_SB(0, 1), cB + hstep, voffB); PG8_STAGE(PG8_SA(0, 1), cA + hstep, voffA);
        if (wr == 1) PG8_BAR;
        PG8_WAIT_V(4); PG8_BAR;
        PG8_STAGE(PG8_SB(1, 0), cB + kstep, voffB); PG8_STAGE(PG8_SA(1, 0), cA + kstep, voffA); PG8_STAGE(PG8_SB(1, 1), cB + hstep + kstep, voffB);
        PG8_WAIT_V(6); PG8_BAR;
    }
    for (;;) {
        const bool has_next = S.next(ui + 1, nxt);
        const char* nA = has_next ? (const char*)g.A + (size_t)nxt.pm * tstep : cA; const char* nB = has_next ? (const char*)g.Bt + (size_t)nxt.pn * tstep : cB;
        for (int t = 0; t < nt; t += 2) {
            const bool last = (t == nt - 2);
            const char* a1 = cA + (size_t)(t + 1) * kstep;
            const char* a2 = last ? nA : cA + (size_t)(t + 2) * kstep; const char* b2 = last ? nB : cB + (size_t)(t + 2) * kstep;
            const char* a3 = a2 + kstep; const char* b3 = b2 + kstep;
            if (last && has_next) S.a_ready(nxt);
            if constexpr (SP2) {
            PG8_LDB(B0, 0, 0); PG8_LDB(B1, 0, 1); PG8_SCHED; PG8_LDA(At, 0, 0); PG8_STAGE(PG8_SA(1, 1), a1 + hstep, voffA);
            PG8_WAIT_V(8); PG8_WAIT_L(0); PG8_BAR; PG8_MMA(0, 0, At, B0); PG8_MMA(0, 1, At, B1); PG8_BAR; PG8_SCHED;
            PG8_LDA(At, 0, 1); PG8_STAGE(PG8_SB(0, 0), b2, voffB); PG8_STAGE(PG8_SB(0, 1), b2 + hstep, voffB); PG8_STAGE(PG8_SA(0, 0), a2, voffA);
            PG8_WAIT_V(8); PG8_WAIT_L(0); PG8_BAR; PG8_MMA(1, 0, At, B0); PG8_MMA(1, 1, At, B1); PG8_BAR; PG8_SCHED;
            PG8_LDB(B0, 1, 0); PG8_LDB(B1, 1, 1); PG8_SCHED; PG8_LDA(At, 1, 0); PG8_STAGE(PG8_SA(0, 1), a2 + hstep, voffA);
            PG8_WAIT_V(8); PG8_WAIT_L(0); PG8_BAR; PG8_MMA(0, 0, At, B0); PG8_MMA(0, 1, At, B1); PG8_BAR; PG8_SCHED;
            PG8_LDA(At, 1, 1); PG8_STAGE(PG8_SB(1, 0), b3, voffB); PG8_STAGE(PG8_SB(1, 1), b3 + hstep, voffB); PG8_STAGE(PG8_SA(1, 0), a3, voffA);
            PG8_WAIT_V(8); PG8_WAIT_L(0); PG8_BAR; PG8_MMA(1, 0, At, B0); PG8_MMA(1, 1, At, B1); PG8_BAR; PG8_SCHED;
            } else {
            PG8_LDB(B0, 0, 0); PG8_SCHED; PG8_LDA(At, 0, 0); PG8_STAGE(PG8_SA(1, 1), a1 + hstep, voffA);
            PG8_WAIT_L(8); PG8_BAR; PG8_WAIT_L(0); PG8_MMA(0, 0, At, B0); PG8_BAR; PG8_SCHED;
            PG8_LDB(B1, 0, 1); PG8_STAGE(PG8_SB(0, 0), b2, voffB);
            PG8_BAR; PG8_WAIT_L(0); PG8_MMA(0, 1, At, B1); PG8_BAR;
            PG8_LDA(At, 0, 1); PG8_STAGE(PG8_SA(0, 0), a2, voffA);
            PG8_BAR; PG8_WAIT_L(0); PG8_MMA(1, 0, At, B0); PG8_BAR; PG8_SCHED;
            PG8_STAGE(PG8_SB(0, 1), b2 + hstep, voffB);
            PG8_WAIT_V(6); PG8_BAR; PG8_MMA(1, 1, At, B1); PG8_BAR;
            PG8_LDB(B0, 1, 0); PG8_SCHED; PG8_LDA(At, 1, 0); PG8_STAGE(PG8_SA(0, 1), a2 + hstep, voffA);
            PG8_WAIT_L(8); PG8_BAR; PG8_WAIT_L(0); PG8_MMA(0, 0, At, B0); PG8_BAR; PG8_SCHED;
            PG8_LDB(B1, 1, 1); PG8_STAGE(PG8_SB(1, 0), b3, voffB);
            PG8_BAR; PG8_WAIT_L(0); PG8_MMA(0, 1, At, B1); PG8_BAR;
            PG8_LDA(At, 1, 1); PG8_STAGE(PG8_SA(1, 0), a3, voffA);
            PG8_BAR; PG8_WAIT_L(0); PG8_MMA(1, 0, At, B0); PG8_BAR; PG8_SCHED;
            PG8_STAGE(PG8_SB(1, 1), b3 + hstep, voffB);
            PG8_WAIT_V(6); PG8_BAR; PG8_MMA(1, 1, At, B1); PG8_BAR;
            }
        }
        if constexpr (ALIGN_EPI) { if (wr == 0) PG8_BAR; }
        if constexpr (!Epi::AFTER_DRAIN) { E(acc, cur, wr, wc, fr, fq); S.done(cur); }
        if (!has_next) break;
#pragma unroll
        for (int a = 0; a < 2; ++a)
#pragma unroll
            for (int b = 0; b < 2; ++b)
#pragma unroll
                for (int m = 0; m < 4; ++m)
#pragma unroll
                    for (int n = 0; n < 2; ++n) acc[a][b][m][n] = (f32x4){0.f, 0.f, 0.f, 0.f};
        cur = nxt; cA = nA; cB = nB; ++ui;
        if constexpr (ALIGN_EPI) { if (wr == 1) PG8_BAR; }
    }
    PG8_WAIT_V(0);
    if constexpr (!ALIGN_EPI) { if (wr == 0) PG8_BAR; }
    PG8_BAR;
    if constexpr (Epi::AFTER_DRAIN) { E.fused(acc, cur, wr, wc, fr, fq, lds, wid, lane); S.done(cur); }
#undef PG8_SA
#undef PG8_SB
#undef PG8_STAGE
#undef PG8_LDA
#undef PG8_LDB
#undef PG8_MMA
#undef PG8_WAIT_V
#undef PG8_WAIT_L
#undef PG8_BAR
#undef PG8_SCHED
}
}

#ifndef PHMASK
#define PHMASK 127
#endif
#ifndef REPMASK
#define REPMASK 0
#endif
#ifndef P2MASK
#define P2MASK 7
#endif
#ifndef N_LAUNCHES
#define N_LAUNCHES 1
#endif
using pg8::bf16_t; using pg8::bf16x8; using pg8::f32x4; using pg8::u32x4;
#define LAS __attribute__((address_space(3)))
typedef unsigned u32x2 __attribute__((ext_vector_type(2)));
typedef float f32x2 __attribute__((ext_vector_type(2)));

constexpr int SEQ = 8192, DMODEL = 4096, INW = 9216, NMEM = 256;
constexpr int C_QA = 0, C_KA = 2048, C_VA = 2560, C_XL = 3072, C_QM = 4096, C_ZA = 5120, C_ZL = 7168, C_ZM = 8192;
constexpr float EPSN = 1e-6f;
constexpr float LOG2E = 1.4426950408889634f;
constexpr float SC_ATT = 0.08838834764831845f * LOG2E;
constexpr float SC_MEM = 0.0625f * LOG2E;
constexpr int NPH = 7;
constexpr int LDS_BYTES = 147456;

constexpr size_t MiB = 1u << 20;
constexpr size_t WS_CTL = 0, WS_LRUW = 1 * MiB, WS_ROPE = 2 * MiB, WS_MK = 3 * MiB, WS_MVT = 3 * MiB + 512 * 1024, WS_SS = 4 * MiB,
                 WS_AGG1 = 6 * MiB, WS_AGG2 = 10 * MiB, WS_VT = 12 * MiB, WS_WOUT = 20 * MiB, WS_WT = 52 * MiB, WS_U = 140 * MiB,
                 WS_PROJ = 206 * MiB, WS_AB = 350 * MiB, WS_YATT = 478 * MiB, WS_YMEM = 510 * MiB, WS_END = 526 * MiB;
constexpr size_t WS_Y = WS_U;
constexpr size_t ABSZ = (size_t)SEQ * 1024;

struct Args { const float* in[19]; float* out; unsigned char* ws; int ph_lo, ph_hi; };

__device__ __forceinline__ unsigned pk2(float lo, float hi) { return pg8::cvt_pk_bf16(lo, hi); }
__device__ __forceinline__ float bflo(unsigned u) { return __builtin_bit_cast(float, u << 16); }
__device__ __forceinline__ float bfhi(unsigned u) { return __builtin_bit_cast(float, u & 0xffff0000u); }
__device__ __forceinline__ float wave_sum(float v) {
#pragma unroll
    for (int o = 1; o < 64; o <<= 1) v += __shfl_xor(v, o);
    return v;
}
__device__ __forceinline__ float fexp2(float x) { return __builtin_amdgcn_exp2f(x); }
__device__ __forceinline__ float sigmoidf_(float x) { return 1.f / (1.f + __expf(-x)); }
__device__ __forceinline__ float fsigmoid(float x) { return __builtin_amdgcn_rcpf(1.f + __builtin_amdgcn_exp2f(-x * 1.4426950408889634f)); }
__device__ __forceinline__ f32x4 mfma16(bf16x8 a, bf16x8 b, f32x4 c) { return __builtin_amdgcn_mfma_f32_16x16x32_bf16(a, b, c, 0, 0, 0); }

__device__ __forceinline__ void p0_transpose_item(const float* W, int K, int N, bf16_t* WT, int row_off, LAS float* scr, int item, int lane) {
    const int nblk = N / 32, kb = item / nblk, nb = item % nblk, k0 = 64 * kb, n0 = 32 * nb;
#pragma unroll 8
    for (int i = 0; i < 32; ++i) { const int kk = 2 * i + (lane >> 5); scr[kk * 33 + (lane & 31)] = W[(size_t)(k0 + kk) * N + n0 + (lane & 31)]; }
    asm volatile("s_waitcnt lgkmcnt(0)" ::: "memory");
    const int c = lane & 7;
#pragma unroll
    for (int j = 0; j < 4; ++j) { const int n = (lane >> 3) + 8 * j; const LAS float* s = scr + (8 * c) * 33 + n;
        u32x4 o; o.x = pk2(s[0 * 33], s[1 * 33]); o.y = pk2(s[2 * 33], s[3 * 33]); o.z = pk2(s[4 * 33], s[5 * 33]); o.w = pk2(s[6 * 33], s[7 * 33]);
        *(u32x4*)(WT + (size_t)(row_off + n0 + n) * K + k0 + 8 * c) = o; }
    asm volatile("s_waitcnt lgkmcnt(0)" ::: "memory");
}
__device__ __forceinline__ void rms_row_to_bf16(const float* xrow, const float* gain, bf16_t* orow, int lane) {
    const f32x4* xr = (const f32x4*)xrow + lane;
    f32x4 v[16]; float s = 0.f;
#pragma unroll
    for (int k = 0; k < 16; ++k) { v[k] = xr[64 * k]; s += (v[k].x * v[k].x + v[k].y * v[k].y) + (v[k].z * v[k].z + v[k].w * v[k].w); }
    const float rs = 1.f / sqrtf(wave_sum(s) * (1.f / 4096.f) + EPSN);
    const f32x4* gr = (const f32x4*)gain + lane; u32x2* o8 = (u32x2*)orow + lane;
#pragma unroll
    for (int k = 0; k < 16; ++k) { const f32x4 g4 = gr[64 * k]; u32x2 o; o.x = pk2(v[k].x * rs * g4.x, v[k].y * rs * g4.y); o.y = pk2(v[k].z * rs * g4.z, v[k].w * rs * g4.w); o8[64 * k] = o; }
}

__device__ __forceinline__ void phase0(const Args& a, LAS unsigned char* lds) {
    const int tid = threadIdx.x, lane = tid & 63, w = tid >> 6, G = gridDim.x;
    const int gw = blockIdx.x * 8 + w, NGW = G * 8;
    unsigned char* ws = a.ws;
    LAS float* scr = (LAS float*)(lds + w * 16384);
    bf16_t* WT = (bf16_t*)(ws + WS_WT); bf16_t* WOUT = (bf16_t*)(ws + WS_WOUT); bf16_t* LRUW = (bf16_t*)(ws + WS_LRUW);
    constexpr int I_IN = 64 * (INW / 32), I_MKV = 64 * (2048 / 32), I_OUT = 64 * (4096 / 32), I_LRU = 32 * 8;
    constexpr int NITEMS = I_IN + I_MKV + I_OUT + I_LRU;
    for (int it = gw; it < NITEMS; it += NGW) {
        int r = it;
        if (r < I_IN) { p0_transpose_item(a.in[3], 4096, INW, WT, 0, scr, r, lane); continue; } r -= I_IN;
        if (r < I_MKV) { p0_transpose_item(a.in[13], 4096, 2048, WT, INW, scr, r, lane); continue; } r -= I_MKV;
        if (r < I_OUT) { p0_transpose_item(a.in[17], 4096, 4096, WOUT, 0, scr, r, lane); continue; } r -= I_OUT;
        { const int mat = r >> 3, sub = r & 7, gate = mat >> 4, dn = mat & 15;
          const float* src = (gate ? a.in[9] : a.in[7]) + (size_t)dn * 16384;
          p0_transpose_item(src, 128, 128, LRUW + (size_t)mat * 16384, 0, scr, sub, lane); }
    }
    bf16_t* U = (bf16_t*)(ws + WS_U);
    for (int m = gw; m < SEQ + NMEM; m += NGW) {
        if (m < SEQ) rms_row_to_bf16(a.in[0] + (size_t)m * 4096, a.in[2], U + (size_t)m * 4096, lane);
        else rms_row_to_bf16(a.in[1] + (size_t)(m - SEQ) * 4096, a.in[12], U + (size_t)m * 4096, lane);
    }
    f32x2* rope = (f32x2*)(ws + WS_ROPE);
    for (int e = blockIdx.x * 512 + tid; e < SEQ * 16; e += G * 512) {
        const int pos = e >> 4, i = e & 15;
        const float inv = powf(500000.0f, -(float)i * (1.0f / 16.0f));
        const float ang = (float)pos * inv;
        rope[e] = (f32x2){cosf(ang), sinf(ang)};
    }
}

struct Sched1 {
    pg8::StaticOrder so; int G, c;
    __device__ void init(int G_, int c_) { so.init(SEQ, INW, G_, c_); G = G_; c = c_; }
    __device__ bool next(int i, pg8::Unit& u) const {
        const long L = (long)i * G + c;
        if (L < 1152) return so.next(i, u);
        if (L < 1160) { u.pm = 32; u.pn = 36 + (int)(L - 1152); return true; }
        return false;
    }
    __device__ __forceinline__ void a_ready(const pg8::Unit&) const {}
    __device__ __forceinline__ void done(const pg8::Unit&) const {}
};
struct Epi1 {
    static constexpr bool PERM = true, AFTER_DRAIN = false;
    bf16_t* proj; bf16_t* vt; bf16_t* mk; bf16_t* mvt; const float* rope;
    __device__ __forceinline__ void operator()(const f32x4 (&acc)[2][2][4][2], const pg8::Unit& u, int wr, int wc, int fr, int fq) const {
        const int rloc = wr * 64 + fr, cloc = wc * 32 + 8 * fq;
        if (u.pm == 32) {
            const int t = u.pn - 36;
            if (t < 4) {
#pragma unroll
                for (int ai = 0; ai < 2; ++ai)
#pragma unroll
                    for (int m = 0; m < 4; ++m) { const int row = rloc + ai * 128 + m * 16;
#pragma unroll
                        for (int bj = 0; bj < 2; ++bj) { const f32x4 v0 = acc[ai][bj][m][0], v1 = acc[ai][bj][m][1];
                            u32x4 wv; wv.x = pk2(v0[0], v0[1]); wv.y = pk2(v0[2], v0[3]); wv.z = pk2(v1[0], v1[1]); wv.w = pk2(v1[2], v1[3]);
                            *(u32x4*)(mk + (size_t)row * 1024 + t * 256 + bj * 128 + cloc) = wv; } asm volatile("" ::: "memory"); }
            } else {
#pragma unroll
                for (int ai = 0; ai < 2; ++ai)
#pragma unroll
                    for (int m = 0; m < 4; ++m) { const int row = rloc + ai * 128 + m * 16;
#pragma unroll
                        for (int bj = 0; bj < 2; ++bj)
#pragma unroll
                            for (int n = 0; n < 2; ++n)
#pragma unroll
                                for (int i = 0; i < 4; ++i) { const int col = (t - 4) * 256 + bj * 128 + cloc + 4 * n + i;
                                    mvt[(size_t)col * 256 + row] = (bf16_t)(pk2(acc[ai][bj][m][n][i], 0.f) & 0xffffu); } asm volatile("" ::: "memory"); }
            }
            return;
        }
        const int pn = u.pn, row0 = u.pm * 256 + rloc;
        if (pn == 10 || pn == 11) {
#pragma unroll
            for (int ai = 0; ai < 2; ++ai)
#pragma unroll
                for (int m = 0; m < 4; ++m) { const int row = row0 + ai * 128 + m * 16;
#pragma unroll
                    for (int bj = 0; bj < 2; ++bj)
#pragma unroll
                        for (int n = 0; n < 2; ++n)
#pragma unroll
                            for (int i = 0; i < 4; ++i) { const int col = (pn - 10) * 256 + bj * 128 + cloc + 4 * n + i;
                                vt[(size_t)col * SEQ + row] = (bf16_t)(pk2(acc[ai][bj][m][n][i], 0.f) & 0xffffu); } asm volatile("" ::: "memory"); }
            return;
        }
        float sc = 1.f; if (pn < 8) sc = SC_ATT; else if (pn >= 16 && pn < 20) sc = SC_MEM;
        const bool do_rope = (pn < 10) && (wc == 0);
        const float sgn = (fq < 2) ? -1.f : 1.f;
#pragma unroll
        for (int ai = 0; ai < 2; ++ai)
#pragma unroll
            for (int m = 0; m < 4; ++m) { const int row = row0 + ai * 128 + m * 16;
                f32x4 cs[2][2];
                if (do_rope) {
#pragma unroll
                    for (int n = 0; n < 2; ++n) { const float* rp = rope + ((size_t)row * 16 + 8 * (fq & 1) + 4 * n) * 2; cs[n][0] = *(const f32x4*)rp; cs[n][1] = *(const f32x4*)(rp + 4); }
                }
#pragma unroll
                for (int bj = 0; bj < 2; ++bj) { f32x4 v[2]; v[0] = acc[ai][bj][m][0]; v[1] = acc[ai][bj][m][1];
                    if (do_rope) {
#pragma unroll
                        for (int n = 0; n < 2; ++n) { f32x4 p; p[0] = __shfl_xor(v[n][0], 32); p[1] = __shfl_xor(v[n][1], 32); p[2] = __shfl_xor(v[n][2], 32); p[3] = __shfl_xor(v[n][3], 32);
                            f32x4 r; r[0] = v[n][0] * cs[n][0][0] + sgn * p[0] * cs[n][0][1]; r[1] = v[n][1] * cs[n][0][2] + sgn * p[1] * cs[n][0][3];
                            r[2] = v[n][2] * cs[n][1][0] + sgn * p[2] * cs[n][1][1]; r[3] = v[n][3] * cs[n][1][2] + sgn * p[3] * cs[n][1][3]; v[n] = r; }
                    }
                    u32x4 wv; wv.x = pk2(v[0][0] * sc, v[0][1] * sc); wv.y = pk2(v[0][2] * sc, v[0][3] * sc); wv.z = pk2(v[1][0] * sc, v[1][1] * sc); wv.w = pk2(v[1][2] * sc, v[1][3] * sc);
                    *(u32x4*)(proj + (size_t)row * INW + pn * 256 + bj * 128 + cloc) = wv; } asm volatile("" ::: "memory"); }
    }
};

template <int DH, bool PF, bool DB>
__device__ __forceinline__ void attn_unit(LAS unsigned char* lds, const bf16_t* Qp, int ldq, bf16_t* Op, int ldo, const bf16_t* Kg, int ldk, const bf16_t* Vtg, int ldv,
                                          int cb_lo, int cb_hi, int cb_self, float m_init, float l_init) {
    constexpr int PR = DH / 8, KROW = DH * 2, KT = 128 * KROW, VROW = 272, NKI = (128 * PR) / 512, NVI = (DH * 16) / 512, NS = DH / 32, NDT = DH / 16;
    const int tid = threadIdx.x, lane = tid & 63, w = tid >> 6, q = lane & 15, g = lane >> 4;
    bf16x8 qf[NS];
    { const bf16_t* qrow = Qp + (size_t)(16 * w + q) * ldq + 8 * g;
#pragma unroll
      for (int s = 0; s < NS; ++s) qf[s] = *(const bf16x8*)(qrow + 32 * s); }
    f32x4 o[NDT];
#pragma unroll
    for (int dt = 0; dt < NDT; ++dt) o[dt] = (f32x4){0.f, 0.f, 0.f, 0.f};
    float m_run = m_init, l_run = l_init;
    u32x4 kreg[NKI], vreg[NVI];
#define ATT_LOAD(cb) do { const int k0_ = (cb) * 128; \
        _Pragma("unroll") for (int it = 0; it < NKI; ++it) { const int e = tid + 512 * it; const int key = e / PR, pc = e % PR; \
            kreg[it] = *(const u32x4*)(Kg + (size_t)(k0_ + key) * ldk + pc * 8); } \
        _Pragma("unroll") for (int it = 0; it < NVI; ++it) { const int e = tid + 512 * it; const int d = e >> 4, pc = e & 15; \
            vreg[it] = *(const u32x4*)(Vtg + (size_t)d * ldv + k0_ + pc * 8); } } while (0)
#define ATT_STORE() do { \
        _Pragma("unroll") for (int it = 0; it < NKI; ++it) { const int e = tid + 512 * it; const int key = e / PR, pc = e % PR; \
            *(LAS u32x4*)(lds + key * KROW + ((pc ^ (key & 15)) * 16)) = kreg[it]; } \
        _Pragma("unroll") for (int it = 0; it < NVI; ++it) { const int e = tid + 512 * it; const int d = e >> 4, pc = e & 15; \
            *(LAS u32x4*)(lds + KT + d * VROW + pc * 16) = vreg[it]; } } while (0)
    if (PF) ATT_LOAD(cb_lo);
    for (int cb = cb_lo; cb < cb_hi; ++cb) {
        if (!PF) ATT_LOAD(cb);
        __syncthreads();
        ATT_STORE();
        __syncthreads();
        if (PF) { if (cb + 1 < cb_hi) ATT_LOAD(cb + 1); }
        f32x4 s[8];
#pragma unroll
        for (int kt = 0; kt < 8; ++kt) s[kt] = (f32x4){0.f, 0.f, 0.f, 0.f};
        {
            bf16x8 ka[DB ? 2 : 1][8];
            if (DB) {
#pragma unroll
                for (int kt = 0; kt < 8; ++kt) ka[0][kt] = *(const LAS bf16x8*)(lds + (16 * kt + q) * KROW + (((0 + g) ^ q) * 16));
            }
#pragma unroll
            for (int ss = 0; ss < NS; ++ss) {
                if (DB) { if (ss + 1 < NS) {
#pragma unroll
                    for (int kt = 0; kt < 8; ++kt) ka[(ss + 1) & 1][kt] = *(const LAS bf16x8*)(lds + (16 * kt + q) * KROW + (((4 * (ss + 1) + g) ^ q) * 16)); }
                } else {
#pragma unroll
                    for (int kt = 0; kt < 8; ++kt) ka[0][kt] = *(const LAS bf16x8*)(lds + (16 * kt + q) * KROW + (((4 * ss + g) ^ q) * 16));
                }
                __builtin_amdgcn_sched_barrier(0);
#pragma unroll
                for (int kt = 0; kt < 8; ++kt) s[kt] = mfma16(ka[DB ? (ss & 1) : 0][kt], qf[ss], s[kt]);
                __builtin_amdgcn_sched_barrier(0);
            }
        }
        const int qq = 16 * w + q;
        if (cb == cb_self - 1) {
#pragma unroll
            for (int kt = 0; kt < 8; ++kt)
#pragma unroll
                for (int j = 0; j < 4; ++j) { if (16 * kt + 4 * g + j < qq) s[kt][j] = -1e30f; }
        } else if (cb == cb_self + 1) {
#pragma unroll
            for (int kt = 0; kt < 8; ++kt)
#pragma unroll
                for (int j = 0; j < 4; ++j) { if (16 * kt + 4 * g + j > qq) s[kt][j] = -1e30f; }
        }
        float mx = s[0][0];
#pragma unroll
        for (int kt = 0; kt < 8; ++kt)
#pragma unroll
            for (int j = 0; j < 4; ++j) mx = fmaxf(mx, s[kt][j]);
        mx = fmaxf(mx, __shfl_xor(mx, 16)); mx = fmaxf(mx, __shfl_xor(mx, 32));
        const float m_new = fmaxf(m_run, mx), alpha = fexp2(m_run - m_new); m_run = m_new;
        float rs = 0.f;
#pragma unroll
        for (int kt = 0; kt < 8; ++kt)
#pragma unroll
            for (int j = 0; j < 4; ++j) { const float p = fexp2(s[kt][j] - m_new); s[kt][j] = p; rs += p; }
        rs += __shfl_xor(rs, 16); rs += __shfl_xor(rs, 32);
        l_run = l_run * alpha + rs;
        bf16x8 pb[4];
#pragma unroll
        for (int u = 0; u < 4; ++u) { u32x4 t; t.x = pk2(s[2 * u][0], s[2 * u][1]); t.y = pk2(s[2 * u][2], s[2 * u][3]); t.z = pk2(s[2 * u + 1][0], s[2 * u + 1][1]); t.w = pk2(s[2 * u + 1][2], s[2 * u + 1][3]);
            pb[u] = __builtin_bit_cast(bf16x8, t); }
#pragma unroll
        for (int dt = 0; dt < NDT; ++dt) o[dt] = o[dt] * alpha;
        {
            constexpr int NG = (NDT / 8) * 4;
            u32x4 va[DB ? 2 : 1][8];
#define ATT_VLOAD(buf, gi) do { const int u_ = (gi) & 3, d0_ = 8 * ((gi) >> 2); \
            _Pragma("unroll") for (int i = 0; i < 8; ++i) { const LAS unsigned char* vp = lds + KT + (16 * (d0_ + i) + q) * VROW + (32 * u_ + 4 * g) * 2; \
                const u32x2 lo_ = *(const LAS u32x2*)vp, hi_ = *(const LAS u32x2*)(vp + 32); va[buf][i] = (u32x4){lo_.x, lo_.y, hi_.x, hi_.y}; } } while (0)
            if (DB) ATT_VLOAD(0, 0);
#pragma unroll
            for (int gi = 0; gi < NG; ++gi) {
                if (DB) { if (gi + 1 < NG) ATT_VLOAD((gi + 1) & 1, gi + 1); } else ATT_VLOAD(0, gi);
                __builtin_amdgcn_sched_barrier(0);
#pragma unroll
                for (int i = 0; i < 8; ++i) o[8 * (gi >> 2) + i] = mfma16(__builtin_bit_cast(bf16x8, va[DB ? (gi & 1) : 0][i]), pb[gi & 3], o[8 * (gi >> 2) + i]);
                __builtin_amdgcn_sched_barrier(0);
            }
#undef ATT_VLOAD
        }
    }
#undef ATT_LOAD
#undef ATT_STORE
    const float inv = 1.f / l_run;
    bf16_t* orow = Op + (size_t)(16 * w + q) * ldo + 4 * g;
#pragma unroll
    for (int dt = 0; dt < NDT; ++dt) { u32x2 pkv; pkv.x = pk2(o[dt][0] * inv, o[dt][1] * inv); pkv.y = pk2(o[dt][2] * inv, o[dt][3] * inv); *(u32x2*)(orow + 16 * dt) = pkv; }
}

__device__ __forceinline__ void lru_gate_unit(LAS unsigned char* lds, const Args& a, int tt, int n) {
    const int tid = threadIdx.x, lane = tid & 63, w = tid >> 6, q = lane & 15, g = lane >> 4;
    unsigned char* ws = a.ws;
    const bf16_t* proj = (const bf16_t*)(ws + WS_PROJ);
    LAS unsigned char* xcb = lds;
    LAS float* xcf = (LAS float*)(lds + 32768);
    const int t0 = tt * 128;
    __syncthreads();
    {
        const int cg8 = tid & 15, t4 = tid >> 4, ch0 = n * 128 + cg8 * 8;
        float xin[7][8];
#pragma unroll
        for (int r = 0; r < 7; ++r) { const int t = t0 + 4 * t4 - 2 + r;
            u32x4 v = (u32x4){0u, 0u, 0u, 0u};
            if (t >= 0 && t < SEQ) v = *(const u32x4*)(proj + (size_t)t * INW + C_XL + ch0);
            xin[r][0] = bflo(v.x); xin[r][1] = bfhi(v.x); xin[r][2] = bflo(v.y); xin[r][3] = bfhi(v.y); xin[r][4] = bflo(v.z); xin[r][5] = bfhi(v.z); xin[r][6] = bflo(v.w); xin[r][7] = bfhi(v.w); }
        float wv[4][8], bias[8];
#pragma unroll
        for (int j = 0; j < 4; ++j) { const f32x4 w0 = *(const f32x4*)(a.in[5] + j * 1024 + ch0), w1 = *(const f32x4*)(a.in[5] + j * 1024 + ch0 + 4);
            wv[j][0] = w0[0]; wv[j][1] = w0[1]; wv[j][2] = w0[2]; wv[j][3] = w0[3]; wv[j][4] = w1[0]; wv[j][5] = w1[1]; wv[j][6] = w1[2]; wv[j][7] = w1[3]; }
        { const f32x4 b0 = *(const f32x4*)(a.in[6] + ch0), b1 = *(const f32x4*)(a.in[6] + ch0 + 4);
          bias[0] = b0[0]; bias[1] = b0[1]; bias[2] = b0[2]; bias[3] = b0[3]; bias[4] = b1[0]; bias[5] = b1[1]; bias[6] = b1[2]; bias[7] = b1[3]; }
#pragma unroll
        for (int o = 0; o < 4; ++o) { float y[8];
#pragma unroll
            for (int e = 0; e < 8; ++e) { float v = bias[e];
#pragma unroll
                for (int j = 0; j < 4; ++j) v += wv[j][e] * xin[o + j][e];
                y[e] = v; }
            const int tok = 4 * t4 + o;
            *(LAS f32x4*)(xcf + tok * 132 + cg8 * 8) = (f32x4){y[0], y[1], y[2], y[3]};
            *(LAS f32x4*)(xcf + tok * 132 + cg8 * 8 + 4) = (f32x4){y[4], y[5], y[6], y[7]};
            u32x4 pk; pk.x = pk2(y[0], y[1]); pk.y = pk2(y[2], y[3]); pk.z = pk2(y[4], y[5]); pk.w = pk2(y[6], y[7]);
            *(LAS u32x4*)(xcb + tok * 256 + ((cg8 ^ (tok & 15)) * 16)) = pk; }
    }
    __syncthreads();
    const bf16_t* lruw = (const bf16_t*)(ws + WS_LRUW);
    float* AB = (float*)(ws + WS_AB);
#pragma unroll 1
    for (int dir = 0; dir < 2; ++dir) {
        const bf16_t* wa = lruw + (size_t)((0 * 2 + dir) * 8 + n) * 16384 + (16 * w + q) * 128 + 8 * g;
        const bf16_t* wx = lruw + (size_t)((1 * 2 + dir) * 8 + n) * 16384 + (16 * w + q) * 128 + 8 * g;
        bf16x8 fa[4], fx[4];
#pragma unroll
        for (int s = 0; s < 4; ++s) { fa[s] = *(const bf16x8*)(wa + 32 * s); fx[s] = *(const bf16x8*)(wx + 32 * s); }
        const int chl = 16 * w + 4 * g, chg = n * 128 + chl;
        const f32x4 ba = *(const f32x4*)(a.in[8] + dir * 1024 + chg), bx = *(const f32x4*)(a.in[10] + dir * 1024 + chg), lam = *(const f32x4*)(a.in[11] + dir * 1024 + chg);
        f32x4 sp;
#pragma unroll
        for (int j = 0; j < 4; ++j) { const float xl = -lam[j]; sp[j] = fmaxf(xl, 0.f) + log1pf(expf(-fabsf(xl))); }
        float* Ap = AB + (size_t)(dir * 2 + 0) * ABSZ; float* Bp = AB + (size_t)(dir * 2 + 1) * ABSZ;
#pragma unroll 1
        for (int tk = 0; tk < 8; ++tk) { const int tok = 16 * tk + q;
            f32x4 ar = (f32x4){0.f, 0.f, 0.f, 0.f}, ai = (f32x4){0.f, 0.f, 0.f, 0.f};
#pragma unroll
            for (int s = 0; s < 4; ++s) {
                const bf16x8 xb = *(const LAS bf16x8*)(xcb + tok * 256 + (((4 * s + g) ^ q) * 16));
                ar = mfma16(fa[s], xb, ar); ai = mfma16(fx[s], xb, ai); }
            const f32x4 xc4 = *(const LAS f32x4*)(xcf + tok * 132 + chl);
            f32x4 av, bv;
#pragma unroll
            for (int j = 0; j < 4; ++j) { const float r = fsigmoid(ar[j] + ba[j]), ii = fsigmoid(ai[j] + bx[j]);
                const float la = -8.0f * r * sp[j]; const float aa = fexp2(la * LOG2E); av[j] = aa;
                const float x2 = 2.0f * la;
                const float poly = x2 * (1.f + x2 * (0.5f + x2 * ((1.f / 6.f) + x2 * ((1.f / 24.f) + x2 * ((1.f / 120.f) + x2 * (1.f / 720.f))))));
                const float om = (x2 > -0.25f) ? -poly : (1.f - aa * aa);
                bv[j] = __builtin_amdgcn_sqrtf(om) * ii * xc4[j]; }
            *(f32x4*)(Ap + (size_t)(t0 + tok) * 1024 + chg) = av; *(f32x4*)(Bp + (size_t)(t0 + tok) * 1024 + chg) = bv; }
    }
}

__device__ __forceinline__ void phase2(const Args& a, LAS unsigned char* lds, int p2mask) {
    unsigned char* ws = a.ws;
    bf16_t* proj = (bf16_t*)(ws + WS_PROJ); const bf16_t* vt = (const bf16_t*)(ws + WS_VT);
    const bf16_t* mk = (const bf16_t*)(ws + WS_MK); const bf16_t* mvt = (const bf16_t*)(ws + WS_MVT);
    bf16_t* yatt = (bf16_t*)(ws + WS_YATT); bf16_t* ymem = (bf16_t*)(ws + WS_YMEM);
    if (p2mask & 1)
    for (int u = blockIdx.x; u < 256; u += gridDim.x) {
        const int qblk = u >> 2, hm = u & 3;
        attn_unit<256, false, false>(lds, proj + (size_t)(qblk * 128) * INW + C_QM + hm * 256, INW, ymem + (size_t)(qblk * 128) * 1024 + hm * 256, 1024, mk + hm * 256, 1024, mvt + (size_t)(hm * 256) * 256, 256, 0, 2, -100, -1e30f, 0.f);
    }
    if (p2mask & 2)
    for (int v = blockIdx.x; v < 1024; v += gridDim.x) {
        const int qblk = v >> 4, hq = v & 15, kvh = hq >> 2;
        const int lo = qblk > 0 ? qblk - 1 : 0, hi = qblk < 63 ? qblk + 2 : 64;
        const float sink2 = a.in[4][hq] * LOG2E;
        attn_unit<128, true, true>(lds, proj + (size_t)(qblk * 128) * INW + C_QA + hq * 128, INW, yatt + (size_t)(qblk * 128) * 2048 + hq * 128, 2048, proj + C_KA + kvh * 128, INW, vt + (size_t)(kvh * 128) * SEQ, SEQ, lo, hi, qblk, sink2, 1.f);
    }
    if (p2mask & 4)
    for (int v = blockIdx.x; v < 512; v += gridDim.x) lru_gate_unit(lds, a, v >> 3, v & 7);
}

__device__ __forceinline__ void phase3(const Args& a, LAS unsigned char* lds) {
    unsigned char* ws = a.ws; const float* AB = (const float*)(ws + WS_AB);
    f32x2* agg1 = (f32x2*)(ws + WS_AGG1); f32x2* agg2 = (f32x2*)(ws + WS_AGG2);
    LAS f32x2* sagg = (LAS f32x2*)lds;
    const int tid = threadIdx.x, chl = tid & 31, dir = (tid >> 5) & 1, cj = tid >> 6;
    for (int u = blockIdx.x; u < 1024; u += gridDim.x) {
        const int sc = u >> 5, cgp = u & 31, ch = cgp * 32 + chl, ck = sc * 8 + cj;
        const float* Ap = AB + (size_t)(dir * 2 + 0) * ABSZ + (size_t)(ck * 32) * 1024 + ch;
        const float* Bp = AB + (size_t)(dir * 2 + 1) * ABSZ + (size_t)(ck * 32) * 1024 + ch;
        float av[32], bv[32];
#pragma unroll
        for (int t = 0; t < 32; ++t) { av[t] = Ap[(size_t)t * 1024]; bv[t] = Bp[(size_t)t * 1024]; }
        float A = 1.f, H = 0.f;
        if (dir == 0) {
#pragma unroll
            for (int t = 0; t < 32; ++t) { H = av[t] * H + bv[t]; A *= av[t]; }
        } else {
#pragma unroll
            for (int t = 31; t >= 0; --t) { H = av[t] * H + bv[t]; A *= av[t]; }
        }
        agg1[(size_t)(dir * 1024 + ch) * 256 + ck] = (f32x2){A, H};
        __syncthreads();
        sagg[(cj * 2 + dir) * 32 + chl] = (f32x2){A, H};
        __syncthreads();
        if (cj == 0) {
            float A2 = 1.f, H2 = 0.f;
#pragma unroll
            for (int j = 0; j < 8; ++j) { const int jj = dir ? 7 - j : j; const f32x2 e = sagg[(jj * 2 + dir) * 32 + chl]; H2 = e.x * H2 + e.y; A2 *= e.x; }
            agg2[(size_t)(dir * 1024 + ch) * 32 + sc] = (f32x2){A2, H2};
        }
    }
}

__device__ __forceinline__ float silu_(float z) { return z / (1.f + __expf(-z)); }
__device__ __forceinline__ void phase4(const Args& a, LAS unsigned char* lds) {
    unsigned char* ws = a.ws; const float* AB = (const float*)(ws + WS_AB);
    const f32x2* agg1 = (const f32x2*)(ws + WS_AGG1); const f32x2* agg2 = (const f32x2*)(ws + WS_AGG2);
    const bf16_t* proj = (const bf16_t*)(ws + WS_PROJ); bf16_t* Y = (bf16_t*)(ws + WS_Y);
    const bf16_t* yatt = (const bf16_t*)(ws + WS_YATT); const bf16_t* ymem = (const bf16_t*)(ws + WS_YMEM);
    LAS float* ylds = (LAS float*)lds;
    const int tid = threadIdx.x, lane = tid & 63, w = tid >> 6;
    for (int ck = blockIdx.x; ck < 256; ck += gridDim.x) {
        const int sc = ck >> 3;
        __syncthreads();
#pragma unroll 1
        for (int half = 0; half < 2; ++half) {
            const int c = tid + 512 * half;
            float hf = 0.f, hb = 0.f;
            { const int cj = ck & 7;
              { const f32x4* p2 = (const f32x4*)(agg2 + (size_t)c * 32); const f32x4* p1 = (const f32x4*)(agg1 + (size_t)c * 256 + sc * 8);
                f32x4 e2[16], e1[4];
#pragma unroll
                for (int i = 0; i < 16; ++i) e2[i] = p2[i];
#pragma unroll
                for (int i = 0; i < 4; ++i) e1[i] = p1[i];
#pragma unroll
                for (int i = 0; i < 16; ++i) { if (2 * i < sc) hf = e2[i][0] * hf + e2[i][1]; if (2 * i + 1 < sc) hf = e2[i][2] * hf + e2[i][3]; }
#pragma unroll
                for (int i = 0; i < 4; ++i) { if (2 * i < cj) hf = e1[i][0] * hf + e1[i][1]; if (2 * i + 1 < cj) hf = e1[i][2] * hf + e1[i][3]; } }
              { const f32x4* p2 = (const f32x4*)(agg2 + (size_t)(1024 + c) * 32); const f32x4* p1 = (const f32x4*)(agg1 + (size_t)(1024 + c) * 256 + sc * 8);
                f32x4 e2[16], e1[4];
#pragma unroll
                for (int i = 0; i < 16; ++i) e2[i] = p2[i];
#pragma unroll
                for (int i = 0; i < 4; ++i) e1[i] = p1[i];
#pragma unroll
                for (int i = 15; i >= 0; --i) { if (2 * i + 1 > sc) hb = e2[i][2] * hb + e2[i][3]; if (2 * i > sc) hb = e2[i][0] * hb + e2[i][1]; }
#pragma unroll
                for (int i = 3; i >= 0; --i) { if (2 * i + 1 > cj) hb = e1[i][2] * hb + e1[i][3]; if (2 * i > cj) hb = e1[i][0] * hb + e1[i][1]; } }
            }
            const float* Af = AB + (size_t)0 * ABSZ + (size_t)(ck * 32) * 1024 + c; const float* Bf = AB + (size_t)1 * ABSZ + (size_t)(ck * 32) * 1024 + c;
            const float* Ab = AB + (size_t)2 * ABSZ + (size_t)(ck * 32) * 1024 + c; const float* Bb = AB + (size_t)3 * ABSZ + (size_t)(ck * 32) * 1024 + c;
            float yv[32];
#pragma unroll
            for (int t = 0; t < 32; ++t) { hf = Af[(size_t)t * 1024] * hf + Bf[(size_t)t * 1024]; yv[t] = hf; }
#pragma unroll
            for (int t = 31; t >= 0; --t) { hb = Ab[(size_t)t * 1024] * hb + Bb[(size_t)t * 1024]; yv[t] += hb; }
#pragma unroll
            for (int t = 0; t < 32; ++t) ylds[t * 1024 + c] = yv[t];
        }
        __syncthreads();
#pragma unroll 2
        for (int tk = 0; tk < 4; ++tk) {
            const int tl = 4 * w + tk, t = ck * 32 + tl;
            const bf16_t* prow = proj + (size_t)t * INW; bf16_t* yrow = Y + (size_t)t * 4096;
            { f32x4 v[4]; float ss = 0.f;
#pragma unroll
              for (int k = 0; k < 4; ++k) { v[k] = *(const LAS f32x4*)(ylds + tl * 1024 + 4 * lane + 256 * k); ss += (v[k][0] * v[k][0] + v[k][1] * v[k][1]) + (v[k][2] * v[k][2] + v[k][3] * v[k][3]); }
              const float rs = 1.f / sqrtf(wave_sum(ss) * (1.f / 1024.f) + EPSN);
#pragma unroll
              for (int k = 0; k < 4; ++k) { const int c = 4 * lane + 256 * k; const f32x4 g4 = *(const f32x4*)(a.in[15] + c); const u32x2 z = *(const u32x2*)(prow + C_ZL + c);
                  u32x2 o; o.x = pk2(v[k][0] * rs * g4[0] * silu_(bflo(z.x)), v[k][1] * rs * g4[1] * silu_(bfhi(z.x))); o.y = pk2(v[k][2] * rs * g4[2] * silu_(bflo(z.y)), v[k][3] * rs * g4[3] * silu_(bfhi(z.y)));
                  *(u32x2*)(yrow + 2048 + c) = o; } }
            { u32x4 v[4]; float ss = 0.f;
#pragma unroll
              for (int k = 0; k < 4; ++k) { v[k] = *(const u32x4*)(yatt + (size_t)t * 2048 + 8 * lane + 512 * k);
                  const float f0 = bflo(v[k].x), f1 = bfhi(v[k].x), f2 = bflo(v[k].y), f3 = bfhi(v[k].y), f4 = bflo(v[k].z), f5 = bfhi(v[k].z), f6 = bflo(v[k].w), f7 = bfhi(v[k].w);
                  ss += ((f0 * f0 + f1 * f1) + (f2 * f2 + f3 * f3)) + ((f4 * f4 + f5 * f5) + (f6 * f6 + f7 * f7)); }
              const float rs = 1.f / sqrtf(wave_sum(ss) * (1.f / 2048.f) + EPSN);
#pragma unroll
              for (int k = 0; k < 4; ++k) { const int c = 8 * lane + 512 * k; const f32x4 g0 = *(const f32x4*)(a.in[14] + c), g1 = *(const f32x4*)(a.in[14] + c + 4); const u32x4 z = *(const u32x4*)(prow + C_ZA + c);
                  u32x4 o; o.x = pk2(bflo(v[k].x) * rs * g0[0] * silu_(bflo(z.x)), bfhi(v[k].x) * rs * g0[1] * silu_(bfhi(z.x)));
                  o.y = pk2(bflo(v[k].y) * rs * g0[2] * silu_(bflo(z.y)), bfhi(v[k].y) * rs * g0[3] * silu_(bfhi(z.y)));
                  o.z = pk2(bflo(v[k].z) * rs * g1[0] * silu_(bflo(z.z)), bfhi(v[k].z) * rs * g1[1] * silu_(bfhi(z.z)));
                  o.w = pk2(bflo(v[k].w) * rs * g1[2] * silu_(bflo(z.w)), bfhi(v[k].w) * rs * g1[3] * silu_(bfhi(z.w)));
                  *(u32x4*)(yrow + c) = o; } }
            { u32x4 v[2]; float ss = 0.f;
#pragma unroll
              for (int k = 0; k < 2; ++k) { v[k] = *(const u32x4*)(ymem + (size_t)t * 1024 + 8 * lane + 512 * k);
                  const float f0 = bflo(v[k].x), f1 = bfhi(v[k].x), f2 = bflo(v[k].y), f3 = bfhi(v[k].y), f4 = bflo(v[k].z), f5 = bfhi(v[k].z), f6 = bflo(v[k].w), f7 = bfhi(v[k].w);
                  ss += ((f0 * f0 + f1 * f1) + (f2 * f2 + f3 * f3)) + ((f4 * f4 + f5 * f5) + (f6 * f6 + f7 * f7)); }
              const float rs = 1.f / sqrtf(wave_sum(ss) * (1.f / 1024.f) + EPSN);
#pragma unroll
              for (int k = 0; k < 2; ++k) { const int c = 8 * lane + 512 * k; const f32x4 g0 = *(const f32x4*)(a.in[16] + c), g1 = *(const f32x4*)(a.in[16] + c + 4); const u32x4 z = *(const u32x4*)(prow + C_ZM + c);
                  u32x4 o; o.x = pk2(bflo(v[k].x) * rs * g0[0] * silu_(bflo(z.x)), bfhi(v[k].x) * rs * g0[1] * silu_(bfhi(z.x)));
                  o.y = pk2(bflo(v[k].y) * rs * g0[2] * silu_(bflo(z.y)), bfhi(v[k].y) * rs * g0[3] * silu_(bfhi(z.y)));
                  o.z = pk2(bflo(v[k].z) * rs * g1[0] * silu_(bflo(z.z)), bfhi(v[k].z) * rs * g1[1] * silu_(bfhi(z.z)));
                  o.w = pk2(bflo(v[k].w) * rs * g1[2] * silu_(bflo(z.w)), bfhi(v[k].w) * rs * g1[3] * silu_(bfhi(z.w)));
                  *(u32x4*)(yrow + 3072 + c) = o; } }
        }
    }
}

struct Epi2 {
    static constexpr bool PERM = false, AFTER_DRAIN = false;
    float* out; float* sspart;
    __device__ __forceinline__ void operator()(const f32x4 (&acc)[2][2][4][2], const pg8::Unit& u, int wr, int wc, int fr, int fq) const {
#pragma unroll
        for (int ai = 0; ai < 2; ++ai)
#pragma unroll
            for (int m = 0; m < 4; ++m) { const int row = u.pm * 256 + ai * 128 + wr * 64 + m * 16 + fr; float ss = 0.f;
#pragma unroll
                for (int bj = 0; bj < 2; ++bj)
#pragma unroll
                    for (int n = 0; n < 2; ++n) { const f32x4 v = acc[ai][bj][m][n]; const int col = u.pn * 256 + bj * 128 + wc * 32 + n * 16 + 4 * fq;
                        *(f32x4*)(out + (size_t)row * 4096 + col) = v; ss += (v[0] * v[0] + v[1] * v[1]) + (v[2] * v[2] + v[3] * v[3]); }
                ss += __shfl_xor(ss, 16); ss += __shfl_xor(ss, 32);
                if (fq == 0) sspart[(size_t)row * 64 + u.pn * 4 + wc] = ss; }
    }
};
__device__ __forceinline__ void phase6(const Args& a) {
    const int tid = threadIdx.x, lane = tid & 63, w = tid >> 6;
    const float* sspart = (const float*)(a.ws + WS_SS);
    for (int row = blockIdx.x * 8 + w; row < SEQ; row += gridDim.x * 8) {
        const float ss = wave_sum(sspart[(size_t)row * 64 + lane]);
        const float rs = 1.f / sqrtf(ss * (1.f / 4096.f) + EPSN);
        f32x4* o4 = (f32x4*)(a.out + (size_t)row * 4096) + lane; const f32x4* x4 = (const f32x4*)(a.in[0] + (size_t)row * 4096) + lane; const f32x4* g4 = (const f32x4*)a.in[18] + lane;
#pragma unroll
        for (int k = 0; k < 16; ++k) { const f32x4 ov = o4[64 * k], xv = x4[64 * k], gv = g4[64 * k]; o4[64 * k] = xv + ov * rs * gv; }
    }
}

#define XB_TMO      128
#define XB_XCNT(j)  (256  + 64 * (j))
#define XB_XSUB(j)  (1280 + 64 * (j))
#define XB_XGEN(j)  (2304 + 64 * (j))
#define XB_TOP      3328
#define XB_TOPGEN   3392
#define XCD_BAR_WORDS 3456
#define XB_SPIN_CAP (1u << 18)

__device__ __forceinline__ unsigned xb_ld(unsigned* p)              { return __hip_atomic_load(p, __ATOMIC_RELAXED, __HIP_MEMORY_SCOPE_AGENT); }
__device__ __forceinline__ unsigned xb_add(unsigned* p, unsigned v) { return __hip_atomic_fetch_add(p, v, __ATOMIC_RELAXED, __HIP_MEMORY_SCOPE_AGENT); }
__device__ __forceinline__ unsigned xb_xcc_id() { return (unsigned)__builtin_amdgcn_s_getreg((3 << 11) | 20) & 0xFu; }
#define XB_SPIN(cond, bar) do { unsigned _sp = 0; while (cond) { __builtin_amdgcn_s_sleep(1); \
    if ((++_sp & 255u) == 0u) { if (xb_ld(&(bar)[XB_TMO])) break; if (_sp > XB_SPIN_CAP) { atomicAdd(&(bar)[XB_TMO], 1u); break; } } } } while (0)

struct XcdBarrier {
    unsigned* bar; unsigned x;
    volatile LAS unsigned* st;
};

__device__ __forceinline__ XcdBarrier xcd_barrier_post(unsigned* bar, volatile LAS unsigned* st) {
    XcdBarrier b; b.bar = bar; b.x = xb_xcc_id(); b.st = st;
    if (threadIdx.x == 0) (void)xb_add(&bar[XB_XCNT(b.x)], 1u);
    return b;
}
__device__ __forceinline__ void xcd_barrier_complete(unsigned* bar, unsigned x, unsigned& nloc, unsigned& nx) {
    const unsigned G = gridDim.x * gridDim.y * gridDim.z;
    unsigned sum, cnt, mine, sp = 0u;
    for (;;) {
        sum = 0u; cnt = 0u; mine = 0u;
#pragma unroll
        for (unsigned j = 0; j < 16; ++j) { const unsigned c = xb_ld(&bar[XB_XCNT(j)]); sum += c; cnt += (c > 0u) ? 1u : 0u; mine = (j == x) ? c : mine; }
        if (sum == G) break;
        __builtin_amdgcn_s_sleep(1);
        if ((++sp & 255u) == 0u) { if (xb_ld(&bar[XB_TMO])) break; if (sp > XB_SPIN_CAP) { atomicAdd(&bar[XB_TMO], 1u); break; } }
    }
    nloc = mine > 0u ? mine : 1u; nx = cnt > 0u ? cnt : 1u;
}

__device__ __forceinline__ void xcd_barrier(const XcdBarrier& b) {
    asm volatile("s_waitcnt vmcnt(0)" ::: "memory");
    __syncthreads();
    if (threadIdx.x == 0) {
        unsigned* bar = b.bar;
        __builtin_amdgcn_s_waitcnt(0);
        unsigned nloc = b.st[0], nx = b.st[1];
        if (nloc == 0u) { xcd_barrier_complete(bar, b.x, nloc, nx); b.st[0] = nloc; b.st[1] = nx; }
        const unsigned old = xb_add(&bar[XB_XSUB(b.x)], 1u);
        const unsigned gen = old / nloc;
        if (old + 1u == (gen + 1u) * nloc) {
            __builtin_amdgcn_fence(__ATOMIC_RELEASE, "agent");
            asm volatile("s_waitcnt vmcnt(0)" ::: "memory");
            const unsigned og = xb_add(&bar[XB_TOP], 1u);
            const unsigned tg = og / nx;
            if (og + 1u == (tg + 1u) * nx) xb_add(&bar[XB_TOPGEN], 1u);
            else XB_SPIN(xb_ld(&bar[XB_TOPGEN]) == tg, bar);
            __builtin_amdgcn_fence(__ATOMIC_ACQUIRE, "agent");
            xb_add(&bar[XB_XGEN(b.x)], 1u);
            asm volatile("s_waitcnt vmcnt(0)" ::: "memory");
        } else {
            XB_SPIN(xb_ld(&bar[XB_XGEN(b.x)]) == gen, bar);
            __builtin_amdgcn_fence(__ATOMIC_ACQUIRE, "agent");
            asm volatile("s_waitcnt vmcnt(0)" ::: "memory");
        }
    }
    __syncthreads();
}

__global__ void __launch_bounds__(512, 2) mega(Args a) {
    extern __shared__ __attribute__((aligned(16))) unsigned char lds_raw[];
    LAS unsigned char* lds = (LAS unsigned char*)lds_raw;
    cg::grid_group grid = cg::this_grid();
    unsigned char* ws = a.ws;
    volatile LAS unsigned* xst = (volatile LAS unsigned*)(lds + LDS_BYTES - 64);
    if (threadIdx.x < 16) xst[threadIdx.x] = 0u;
    __syncthreads();
    XcdBarrier xbar; xbar.bar = (unsigned*)(ws + WS_CTL); xbar.x = 0; xbar.st = nullptr;
#if N_LAUNCHES == 1
    xbar = xcd_barrier_post((unsigned*)(ws + WS_CTL), xst);
#endif
    const int lo = a.ph_lo, hi = a.ph_hi;
#define IN(k) (lo <= (k) && (k) < hi)
#define SEAM(k) do { if (IN(k) && IN((k) + 1)) { if ((k) == 0) { __syncthreads(); grid.sync(); } else xcd_barrier(xbar); } } while (0)
    if (IN(0)) { if (PHMASK & 1) phase0(a, lds); if (REPMASK & 1) { __syncthreads(); phase0(a, lds); } }
    SEAM(0);
    if (IN(1)) { if (PHMASK & 2) {
        pg8::Gemm g{(const bf16_t*)(ws + WS_U), (const bf16_t*)(ws + WS_WT), SEQ + NMEM, INW + 2048, 4096};
        Sched1 S; S.init((int)gridDim.x, (int)blockIdx.x);
        Epi1 E{(bf16_t*)(ws + WS_PROJ), (bf16_t*)(ws + WS_VT), (bf16_t*)(ws + WS_MK), (bf16_t*)(ws + WS_MVT), (const float*)(ws + WS_ROPE)};
        pg8::gemm_phase<Epi1, Sched1, true, true>(lds, g, S, E);
        if (REPMASK & 2) { __syncthreads(); pg8::gemm_phase<Epi1, Sched1, true, true>(lds, g, S, E); }
    } }
    SEAM(1);
    if (IN(2)) { if (PHMASK & 4) phase2(a, lds, P2MASK); }
    SEAM(2);
    if (IN(3)) { if (PHMASK & 8) phase3(a, lds); if (REPMASK & 8) { __syncthreads(); phase3(a, lds); } }
    SEAM(3);
    if (IN(4)) { if (PHMASK & 16) phase4(a, lds); if (REPMASK & 16) { __syncthreads(); phase4(a, lds); } }
    SEAM(4);
    if (IN(5)) { if (PHMASK & 32) {
        pg8::Gemm g{(const bf16_t*)(ws + WS_Y), (const bf16_t*)(ws + WS_WOUT), SEQ, 4096, 4096};
        pg8::StaticOrder S; S.init(SEQ, 4096, (int)gridDim.x, (int)blockIdx.x);
        Epi2 E{a.out, (float*)(ws + WS_SS)};
        pg8::gemm_phase<Epi2, pg8::StaticOrder, true, true>(lds, g, S, E);
        if (REPMASK & 32) { __syncthreads(); pg8::gemm_phase<Epi2, pg8::StaticOrder, true, true>(lds, g, S, E); }
    } }
    SEAM(5);
    if (IN(6)) { if (PHMASK & 64) phase6(a); }
#if N_LAUNCHES != 1
    if (lo >= 7) phase2(a, lds, 1 << (lo - 7));
#endif
#undef IN
#undef SEAM
}

extern "C" void kernel_launch(void* const* d_in, const int* in_sizes, int n_in, void* d_out, int out_size, void* d_ws, size_t ws_size, hipStream_t stream) {
    static int grid = 0;
    if (grid == 0) {
        if (n_in != 19 || ws_size < WS_END) { fprintf(stderr, "kernel_launch: unexpected n_in %d or ws_size %zu (need %zu)\n", n_in, ws_size, (size_t)WS_END); grid = -1; return; }
        int dev = 0, cus = 0, per_cu = 0;
        hipGetDevice(&dev); hipDeviceGetAttribute(&cus, hipDeviceAttributeMultiprocessorCount, dev);
        if (hipFuncSetAttribute((const void*)mega, hipFuncAttributeMaxDynamicSharedMemorySize, LDS_BYTES) != hipSuccess) { fprintf(stderr, "kernel_launch: hipFuncSetAttribute failed\n"); grid = -1; return; }
        if (hipOccupancyMaxActiveBlocksPerMultiprocessor(&per_cu, (const void*)mega, 512, LDS_BYTES) != hipSuccess || per_cu < 1) { fprintf(stderr, "kernel_launch: occupancy query says %d\n", per_cu); per_cu = 1; }
        (void)hipGetLastError();
        grid = cus * 1;
        if (grid <= 0) grid = 256;
    }
    if (grid < 0) return;
    Args a{};
    for (int i = 0; i < 19; ++i) a.in[i] = (const float*)d_in[i];
    a.out = (float*)d_out; a.ws = (unsigned char*)d_ws;
#if N_LAUNCHES == 1
    (void)hipMemsetAsync((char*)d_ws + WS_CTL, 0, 65536, stream);
    a.ph_lo = 0; a.ph_hi = NPH;
    void* args[] = {&a};
    hipError_t e = hipLaunchCooperativeKernel((const void*)mega, dim3(grid), dim3(512), args, LDS_BYTES, stream);
    if (e != hipSuccess) fprintf(stderr, "cooperative launch failed: %s (grid %d)\n", hipGetErrorString(e), grid);
#else
#ifndef PHSEQ
#define PHSEQ 0,1,2,3,4,5,6
#endif
    { const int seq[] = {PHSEQ};
      for (unsigned i = 0; i < sizeof(seq) / sizeof(int); ++i) { a.ph_lo = seq[i]; a.ph_hi = seq[i] + 1; hipLaunchKernelGGL(mega, dim3(grid), dim3(512), LDS_BYTES, stream, a); } }
#endif
}
```

```cpp
#include <hip/hip_runtime.h>
#include <hip/hip_cooperative_groups.h>
#include <cstdio>
#include <cstdint>
namespace cg = cooperative_groups;
#define N_LAUNCHES 1
namespace pg8 {
#define PG8_LAS __attribute__((address_space(3)))
typedef unsigned short bf16_t;
typedef short bf16x8 __attribute__((ext_vector_type(8)));
typedef float f32x4 __attribute__((ext_vector_type(4)));
typedef unsigned u32x4 __attribute__((ext_vector_type(4)));
constexpr int BM = 256, BK = 64, HALF = 128, HTB = HALF * BK * 2  , STAGE_BYTES = 8 * HTB, NXCD = 8, WGM = 8;

__host__ __device__ __forceinline__ int lds_byte(int r, int c) { const int st = (r >> 4) * 2 + (c >> 5), rr = r & 15, cc = c & 31, ob = rr * 64 + cc * 2; return st * 1024 + (ob ^ (((ob >> 9) & 1) << 5)); }
__host__ __device__ __forceinline__ void stage_rc(int b, int& R, int& C) { const int st = b / 1024, sb = b % 1024, swz = sb ^ (((sb >> 9) & 1) << 5); R = (st >> 1) * 16 + swz / 64; C = (st & 1) * 32 + (swz % 64) / 2; }
__host__ __device__ __forceinline__ int perm32(int rho) { const int n = rho >> 4, i = rho & 15; return 8 * (i >> 2) + 4 * n + (i & 3); }

struct Unit { int pm, pn; };
struct Gemm { const bf16_t* A; const bf16_t* Bt; int M, N, K; };

struct StaticOrder {
    int nM, nN, nwg, G, c;
    __host__ __device__ void init(int M, int N, int G_, int c_) { nM = M / BM; nN = N / BM; nwg = nM * nN; G = G_; c = c_; }
    __host__ __device__ bool next(int i, Unit& u) const {
        const long L = (long)i * G + c; if (L >= nwg) return false;
        int wgid = (int)L; { const int q = nwg / NXCD, r = nwg % NXCD, xcd = wgid % NXCD, off = wgid / NXCD; wgid = (xcd < r ? xcd * (q + 1) : r * (q + 1) + (xcd - r) * q) + off; }
        const int nig = WGM * nN, gid = wgid / nig, fm = gid * WGM, gsz = (nM - fm) < WGM ? (nM - fm) : WGM;
        u.pm = fm + ((wgid % nig) % gsz); u.pn = (wgid % nig) / gsz; return true;
    }
    __device__ __forceinline__ void a_ready(const Unit&) const {}
    __device__ __forceinline__ void done(const Unit&) const {}
};

__device__ __forceinline__ unsigned cvt_pk_bf16(float lo, float hi) { unsigned r; asm volatile("v_cvt_pk_bf16_f32 %0, %1, %2" : "=v"(r) : "v"(lo), "v"(hi)); return r; }
typedef float f32x2 __attribute__((ext_vector_type(2)));
__device__ __forceinline__ f32x2 gelu_pk(f32x2 v) {
    const f32x2 av = __builtin_elementwise_abs(v), d = av * 0.2316418882f + 1.0f;
    f32x2 t; t.x = __builtin_amdgcn_rcpf(d.x); t.y = __builtin_amdgcn_rcpf(d.y);
    f32x2 q = t * 0.5307027145f + (-0.7265760135f); q = q * t + 0.7107068705f; q = q * t + (-0.142248368f); q = q * t + 0.127414796f; q = q * t;
    const f32x2 s = (v * v) * (-0.72134752044f);
    f32x2 e; e.x = __builtin_amdgcn_exp2f(s.x); e.y = __builtin_amdgcn_exp2f(s.y);
    const f32x2 m = v * (q * e), r = v - m;
    f32x2 o; o.x = v.x < 0.f ? m.x : r.x; o.y = v.y < 0.f ? m.y : r.y; return o;
}

template <int ACT  > struct EpiBf16 {
    static constexpr bool PERM = true, AFTER_DRAIN = false, HOLD_LAST = false; static_assert(ACT == 0 || ACT == 1, "EpiBf16: ACT is 0 (none) or 1 (gelu_pk)");
    bf16_t* O; int ldc; const float* bias; int split_cols; size_t split_stride; float scale0;
    __device__ __forceinline__ void operator()(const f32x4 (&acc)[2][2][4][2], const Unit& u, int wr, int wc, int fr, int fq) const {
        const int row0 = u.pm * BM + wr * 64 + fr; int colt = u.pn * BM; bf16_t* base = O;
        float sc = 1.f; if (split_cols) { const int t = colt / split_cols; base += (size_t)t * split_stride; colt -= t * split_cols; if (t == 0) sc = scale0; }
        const int col0 = colt + wc * 32 + 8 * fq, bcol0 = u.pn * BM + wc * 32 + 8 * fq;
        f32x4 bv[2][2];
#pragma unroll
        for (int bj = 0; bj < 2; ++bj)
#pragma unroll
            for (int n = 0; n < 2; ++n) bv[bj][n] = bias ? *(const f32x4*)(bias + bcol0 + bj * HALF + 4 * n) : (f32x4){0.f, 0.f, 0.f, 0.f};
#pragma unroll
        for (int ai = 0; ai < 2; ++ai)
#pragma unroll
            for (int m = 0; m < 4; ++m) { bf16_t* rowp = base + (size_t)(row0 + ai * HALF + m * 16) * ldc + col0;
#pragma unroll
                for (int bj = 0; bj < 2; ++bj) { f32x4 v0 = acc[ai][bj][m][0] + bv[bj][0], v1 = acc[ai][bj][m][1] + bv[bj][1];
                    if (ACT == 1) { f32x2 a = gelu_pk((f32x2){v0[0], v0[1]}), b = gelu_pk((f32x2){v0[2], v0[3]}), c = gelu_pk((f32x2){v1[0], v1[1]}), d = gelu_pk((f32x2){v1[2], v1[3]});
                        v0 = (f32x4){a.x, a.y, b.x, b.y}; v1 = (f32x4){c.x, c.y, d.x, d.y}; }
                    v0 = v0 * sc; v1 = v1 * sc; u32x4 w; w.x = cvt_pk_bf16(v0[0], v0[1]); w.y = cvt_pk_bf16(v0[2], v0[3]); w.z = cvt_pk_bf16(v1[0], v1[1]); w.w = cvt_pk_bf16(v1[2], v1[3]);
                    *(u32x4*)(rowp + bj * HALF) = w; } }
    }
};
template <class Epi, class Sched, bool ALIGN_EPI = false, bool SP2 = false>
__device__ __forceinline__ void gemm_phase(PG8_LAS unsigned char* lds, const Gemm g, const Sched& S, const Epi& E) {
    int tid_ = threadIdx.x; asm volatile("" : "+v"(tid_)); const int tid = tid_, wid = __builtin_amdgcn_readfirstlane(tid >> 6), lane = tid & 63, wr = wid >> 2, wc = wid & 3, fr = lane & 15, fq = lane >> 4;
    const int K = g.K, nt = K / BK;
    unsigned voffA[2], voffB[2];
#pragma unroll
    for (int i = 0; i < 2; ++i) { int R, C; stage_rc(tid * 16 + i * 8192, R, C); const int Rb = Epi::PERM ? ((R & ~31) + perm32(R & 31)) : R;
        voffA[i] = (unsigned)(R * K + C) * 2u; voffB[i] = (unsigned)(Rb * K + C) * 2u; }
    const size_t kstep = (size_t)(BK * 2);
    const size_t hstep = (size_t)HALF * K * 2;
    const size_t tstep = 2 * hstep;
    const unsigned ldsw = (unsigned)wid * 1024u;
    const int aoff = lds_byte(wr * 64 + fr, fq * 8), boff = lds_byte(wc * 32 + fr, fq * 8);
#define PG8_SA(b, h) (((b) * 2 + (h)) * HTB)
#define PG8_SB(b, h) ((4 + (b) * 2 + (h)) * HTB)
#define PG8_STAGE(bufoff, gbase, voff) do { _Pragma("unroll") for (int _i = 0; _i < 2; ++_i) \
        __builtin_amdgcn_global_load_lds((const unsigned*)((const char*)(gbase) + (voff)[_i]), (PG8_LAS unsigned*)(lds + (bufoff) + ldsw + _i * 8192), 16, 0, 0); } while (0)
#define PG8_LDA(dst, b, h) do { _Pragma("unroll") for (int m = 0; m < 4; ++m) _Pragma("unroll") for (int k = 0; k < 2; ++k) dst[m][k] = *(const PG8_LAS bf16x8*)(lds + PG8_SA(b, h) + aoff + m * 2048 + k * 1024); } while (0)
#define PG8_LDB(dst, b, h) do { _Pragma("unroll") for (int n = 0; n < 2; ++n) _Pragma("unroll") for (int k = 0; k < 2; ++k) dst[n][k] = *(const PG8_LAS bf16x8*)(lds + PG8_SB(b, h) + boff + n * 2048 + k * 1024); } while (0)
#define PG8_MMA(ai, bj, At, Bt) do { __builtin_amdgcn_s_setprio(1); _Pragma("unroll") for (int m = 0; m < 4; ++m) _Pragma("unroll") for (int n = 0; n < 2; ++n) _Pragma("unroll") for (int k = 0; k < 2; ++k) \
        acc[ai][bj][m][n] = __builtin_amdgcn_mfma_f32_16x16x32_bf16(Bt[n][k], At[m][k], acc[ai][bj][m][n], 0, 0, 0); __builtin_amdgcn_s_setprio(0); } while (0)
#define PG8_WAIT_V(n) asm volatile("s_waitcnt vmcnt(" #n ")" ::: "memory")
#define PG8_WAIT_L(n) asm volatile("s_waitcnt lgkmcnt(" #n ")" ::: "memory")
#define PG8_BAR __builtin_amdgcn_s_barrier()
#define PG8_SCHED __builtin_amdgcn_sched_barrier(0)
    Unit cur, nxt; int ui = 0;
    if (!S.next(0, cur)) return;
    f32x4 acc[2][2][4][2];
#pragma unroll
    for (int a = 0; a < 2; ++a)
#pragma unroll
        for (int b = 0; b < 2; ++b)
#pragma unroll
            for (int m = 0; m < 4; ++m)
#pragma unroll
                for (int n = 0; n < 2; ++n) acc[a][b][m][n] = (f32x4){0.f, 0.f, 0.f, 0.f};
    bf16x8 At[4][2], B0[2][2], B1[2][2];
    const char* cA = (const char*)g.A + (size_t)cur.pm * tstep; const char* cB = (const char*)g.Bt + (size_t)cur.pn * tstep;
    S.a_ready(cur);
    if constexpr (SP2) {
        PG8_STAGE(PG8_SB(0, 0), cB, voffB); PG8_STAGE(PG8_SB(0, 1), cB + hstep, voffB); PG8_STAGE(PG8_SA(0, 0), cA, voffA); PG8_STAGE(PG8_SA(0, 1), cA + hstep, voffA);
        if (wr == 1) PG8_BAR;
        PG8_WAIT_V(2); PG8_BAR;
        PG8_STAGE(PG8_SB(1, 0), cB + kstep, voffB); PG8_STAGE(PG8_SA(1, 0), cA + kstep, voffA); PG8_STAGE(PG8_SB(1, 1), cB + hstep + kstep, voffB);
        PG8_WAIT_V(6); PG8_BAR;
    } else {
        PG8_STAGE(PG8_SB(0, 0), cB, voffB); PG8_STAGE(PG8_SA(0, 0), cA, voffA); PG8_STAGE(PG8_SB(0, 1), cB + hstep, voffB); PG8_STAGE(PG8_SA(0, 1), cA + hstep, voffA);
        if (wr == 1) PG8_BAR;
        PG8_WAIT_V(4); PG8_BAR;
        PG8_STAGE(PG8_SB(1, 0), cB + kstep, voffB); PG8_STAGE(PG8_SA(1, 0), cA + kstep, voffA); PG8_STAGE(PG8_SB(1, 1), cB + hstep + kstep, voffB);
        PG8_WAIT_V(6); PG8_BAR;
    }
    for (;;) {
        const bool has_next = S.next(ui + 1, nxt);
        const char* nA = has_next ? (const char*)g.A + (size_t)nxt.pm * tstep : cA; const char* nB = has_next ? (const char*)g.Bt + (size_t)nxt.pn * tstep : cB;
        for (int t = 0; t < nt; t += 2) {
            const bool last = (t == nt - 2);
            const char* a1 = cA + (size_t)(t + 1) * kstep;
            const char* a2 = last ? nA : cA + (size_t)(t + 2) * kstep; const char* b2 = last ? nB : cB + (size_t)(t + 2) * kstep;
            const char* a3 = a2 + kstep; const char* b3 = b2 + kstep;
            if (last && has_next) S.a_ready(nxt);
            if constexpr (SP2) {
            PG8_LDB(B0, 0, 0); PG8_LDB(B1, 0, 1); PG8_SCHED; PG8_LDA(At, 0, 0); PG8_STAGE(PG8_SA(1, 1), a1 + hstep, voffA);
            PG8_WAIT_V(8); PG8_WAIT_L(0); PG8_BAR; PG8_MMA(0, 0, At, B0); PG8_MMA(0, 1, At, B1); PG8_BAR; PG8_SCHED;
            PG8_LDA(At, 0, 1); PG8_STAGE(PG8_SB(0, 0), b2, voffB); PG8_STAGE(PG8_SB(0, 1), b2 + hstep, voffB); PG8_STAGE(PG8_SA(0, 0), a2, voffA);
            PG8_WAIT_V(8); PG8_WAIT_L(0); PG8_BAR; PG8_MMA(1, 0, At, B0); PG8_MMA(1, 1, At, B1); PG8_BAR; PG8_SCHED;
            PG8_LDB(B0, 1, 0); PG8_LDB(B1, 1, 1); PG8_SCHED; PG8_LDA(At, 1, 0); PG8_STAGE(PG8_SA(0, 1), a2 + hstep, voffA);
            PG8_WAIT_V(8); PG8_WAIT_L(0); PG8_BAR; PG8_MMA(0, 0, At, B0); PG8_MMA(0, 1, At, B1); PG8_BAR; PG8_SCHED;
            PG8_LDA(At, 1, 1); PG8_STAGE(PG8_SB(1, 0), b3, voffB); PG8_STAGE(PG8_SB(1, 1), b3 + hstep, voffB); PG8_STAGE(PG8_SA(1, 0), a3, voffA);
            PG8_WAIT_V(8); PG8_WAIT_L(0); PG8_BAR; PG8_MMA(1, 0, At, B0); PG8_MMA(1, 1, At, B1); PG8_BAR; PG8_SCHED;
            } else {
            PG8_LDB(B0, 0, 0); PG8_SCHED; PG8_LDA(At, 0, 0); PG8_STAGE(PG8_SA(1, 1), a1 + hstep, voffA);
            PG8_WAIT_L(8); PG8_BAR; PG8_WAIT_L(0); PG8_MMA(0, 0, At, B0); PG8_BAR; PG8_SCHED;
            PG8_LDB(B1, 0, 1); PG8_STAGE(PG8_SB(0, 0), b2, voffB);
            PG8_BAR; PG8_WAIT_L(0); PG8_MMA(0, 1, At, B1); PG8_BAR;
            PG8_LDA(At, 0, 1); PG8_STAGE(PG8_SA(0, 0), a2, voffA);
            PG8_BAR; PG8_WAIT_L(0); PG8_MMA(1, 0, At, B0); PG8_BAR; PG8_SCHED;
            PG8_STAGE(PG8_SB(0, 1), b2 + hstep, voffB);
            PG8_WAIT_V(6); PG8_BAR; PG8_MMA(1, 1, At, B1); PG8_BAR;
            PG8_LDB(B0, 1, 0); PG8_SCHED; PG8_LDA(At, 1, 0); PG8_STAGE(PG8_SA(0, 1), a2 + hstep, voffA);
            PG8_WAIT_L(8); PG8_BAR; PG8_WAIT_L(0); PG8_MMA(0, 0, At, B0); PG8_BAR; PG8_SCHED;
            PG8_LDB(B1, 1, 1); PG8_STAGE(PG8_SB(1, 0), b3, voffB);
            PG8_BAR; PG8_WAIT_L(0); PG8_MMA(0, 1, At, B1); PG8_BAR;
            PG8_LDA(At, 1, 1); PG8_STAGE(PG8_SA(1, 0), a3, voffA);
            PG8_BAR; PG8_WAIT_L(0); PG8_MMA(1, 0, At, B0); PG8_BAR; PG8_SCHED;
            PG8_STAGE(PG8_SB(1, 1), b3 + hstep, voffB);
            PG8_WAIT_V(6); PG8_BAR; PG8_MMA(1, 1, At, B1); PG8_BAR;
            }
        }
        if constexpr (ALIGN_EPI) { if (wr == 0) PG8_BAR; }
        if constexpr (!Epi::AFTER_DRAIN) { if (!Epi::HOLD_LAST || has_next) { E(acc, cur, wr, wc, fr, fq); S.done(cur); } }
        if (!has_next) break;
#pragma unroll
        for (int a = 0; a < 2; ++a)
#pragma unroll
            for (int b = 0; b < 2; ++b)
#pragma unroll
                for (int m = 0; m < 4; ++m)
#pragma unroll
                    for (int n = 0; n < 2; ++n) acc[a][b][m][n] = (f32x4){0.f, 0.f, 0.f, 0.f};
        cur = nxt; cA = nA; cB = nB; ++ui;
        if constexpr (ALIGN_EPI) { if (wr == 1) PG8_BAR; }
    }
    PG8_WAIT_V(0);
    if constexpr (!ALIGN_EPI) { if (wr == 0) PG8_BAR; }
    PG8_BAR;
    if constexpr (Epi::AFTER_DRAIN || Epi::HOLD_LAST) { E.fused(acc, cur, wr, wc, fr, fq, lds, wid, lane); S.done(cur); }
#undef PG8_SA
#undef PG8_SB
#undef PG8_STAGE
#undef PG8_LDA
#undef PG8_LDB
#undef PG8_MMA
#undef PG8_WAIT_V
#undef PG8_WAIT_L
#undef PG8_BAR
#undef PG8_SCHED
}
}

#ifndef PHMASK
#define PHMASK 127
#endif
#ifndef REPMASK
#define REPMASK 0
#endif
#ifndef P2MASK
#define P2MASK 7
#endif
#ifndef N_LAUNCHES
#define N_LAUNCHES 1
#endif
using pg8::bf16_t; using pg8::bf16x8; using pg8::f32x4; using pg8::u32x4;
#define LAS __attribute__((address_space(3)))
typedef unsigned u32x2 __attribute__((ext_vector_type(2)));
typedef float f32x2 __attribute__((ext_vector_type(2)));

constexpr int SEQ = 8192, DMODEL = 4096, INW = 9216, NMEM = 256;
constexpr int C_QA = 0, C_KA = 2048, C_VA = 2560, C_XL = 3072, C_QM = 4096, C_ZA = 5120, C_ZL = 7168, C_ZM = 8192;
constexpr float EPSN = 1e-6f;
constexpr float LOG2E = 1.4426950408889634f;
constexpr float SC_ATT = 0.08838834764831845f * LOG2E;
constexpr float SC_MEM = 0.0625f * LOG2E;
constexpr int NPH = 7;
constexpr int LDS_BYTES = 147456;

constexpr size_t MiB = 1u << 20;
constexpr size_t WS_CTL = 0, WS_LRUW = 1 * MiB, WS_ROPE = 2 * MiB, WS_MK = 3 * MiB, WS_MVT = 3 * MiB + 512 * 1024, WS_SS = 4 * MiB,
                 WS_AGG1 = 6 * MiB, WS_AGG2 = 10 * MiB, WS_VT = 12 * MiB, WS_WOUT = 20 * MiB, WS_WT = 52 * MiB, WS_U = 140 * MiB,
                 WS_PROJ = 206 * MiB, WS_HS = 350 * MiB, WS_PP = 382 * MiB, WS_YATT = 414 * MiB, WS_YMEM = 446 * MiB, WS_T0 = 462 * MiB, WS_END = 494 * MiB;
constexpr size_t WS_Y = WS_U;

struct Args { const float* in[19]; float* out; unsigned char* ws; int ph_lo, ph_hi; };

__device__ __forceinline__ unsigned pk2(float lo, float hi) { return pg8::cvt_pk_bf16(lo, hi); }
__device__ __forceinline__ float bflo(unsigned u) { return __builtin_bit_cast(float, u << 16); }
__device__ __forceinline__ float bfhi(unsigned u) { return __builtin_bit_cast(float, u & 0xffff0000u); }
__device__ __forceinline__ float wave_sum(float v) {
#pragma unroll
    for (int o = 1; o < 64; o <<= 1) v += __shfl_xor(v, o);
    return v;
}
__device__ __forceinline__ float fexp2(float x) { return __builtin_amdgcn_exp2f(x); }
__device__ __forceinline__ float sigmoidf_(float x) { return 1.f / (1.f + __expf(-x)); }
__device__ __forceinline__ float fsigmoid(float x) { return __builtin_amdgcn_rcpf(1.f + __builtin_amdgcn_exp2f(-x * 1.4426950408889634f)); }
__device__ __forceinline__ f32x4 mfma16(bf16x8 a, bf16x8 b, f32x4 c) { return __builtin_amdgcn_mfma_f32_16x16x32_bf16(a, b, c, 0, 0, 0); }

__device__ __forceinline__ void p0_transpose_item(const float* W, int K, int N, bf16_t* WT, int row_off, LAS float* scr, int item, int lane) {
    const int nblk = N / 32, kb = item / nblk, nb = item % nblk, k0 = 64 * kb, n0 = 32 * nb;
#pragma unroll 8
    for (int i = 0; i < 32; ++i) { const int kk = 2 * i + (lane >> 5); scr[kk * 33 + (lane & 31)] = W[(size_t)(k0 + kk) * N + n0 + (lane & 31)]; }
    asm volatile("s_waitcnt lgkmcnt(0)" ::: "memory");
    const int c = lane & 7;
#pragma unroll
    for (int j = 0; j < 4; ++j) { const int n = (lane >> 3) + 8 * j; const LAS float* s = scr + (8 * c) * 33 + n;
        u32x4 o; o.x = pk2(s[0 * 33], s[1 * 33]); o.y = pk2(s[2 * 33], s[3 * 33]); o.z = pk2(s[4 * 33], s[5 * 33]); o.w = pk2(s[6 * 33], s[7 * 33]);
        *(u32x4*)(WT + (size_t)(row_off + n0 + n) * K + k0 + 8 * c) = o; }
    asm volatile("s_waitcnt lgkmcnt(0)" ::: "memory");
}
__device__ __forceinline__ void rms_row_to_bf16(const float* xrow, const float* gain, bf16_t* orow, int lane) {
    const f32x4* xr = (const f32x4*)xrow + lane;
    f32x4 v[16]; float s = 0.f;
#pragma unroll
    for (int k = 0; k < 16; ++k) { v[k] = xr[64 * k]; s += (v[k].x * v[k].x + v[k].y * v[k].y) + (v[k].z * v[k].z + v[k].w * v[k].w); }
    const float rs = 1.f / sqrtf(wave_sum(s) * (1.f / 4096.f) + EPSN);
    const f32x4* gr = (const f32x4*)gain + lane; u32x2* o8 = (u32x2*)orow + lane;
#pragma unroll
    for (int k = 0; k < 16; ++k) { const f32x4 g4 = gr[64 * k]; u32x2 o; o.x = pk2(v[k].x * rs * g4.x, v[k].y * rs * g4.y); o.y = pk2(v[k].z * rs * g4.z, v[k].w * rs * g4.w); o8[64 * k] = o; }
}

__device__ __forceinline__ void phase0(const Args& a, LAS unsigned char* lds) {
    int tid = threadIdx.x; asm volatile("" : "+v"(tid)); const int lane = tid & 63, w = tid >> 6, G = gridDim.x;
    const int gw = blockIdx.x * 8 + w, NGW = G * 8;
    unsigned char* ws = a.ws;
    LAS float* scr = (LAS float*)(lds + w * 16384);
    bf16_t* WT = (bf16_t*)(ws + WS_WT); bf16_t* WOUT = (bf16_t*)(ws + WS_WOUT); bf16_t* LRUW = (bf16_t*)(ws + WS_LRUW);
    constexpr int I_IN = 64 * (INW / 32), I_MKV = 64 * (2048 / 32), I_OUT = 64 * (4096 / 32), I_LRU = 32 * 8;
    constexpr int NITEMS = I_IN + I_MKV + I_LRU;
    for (int it = gw; it < NITEMS; it += NGW) {
        int r = it;
        if (r < I_IN) { p0_transpose_item(a.in[3], 4096, INW, WT, 0, scr, r, lane); continue; } r -= I_IN;
        if (r < I_MKV) { p0_transpose_item(a.in[13], 4096, 2048, WT, INW, scr, r, lane); continue; } r -= I_MKV;
        { const int mat = r >> 3, sub = r & 7, gate = mat >> 4, dn = mat & 15;
          const float* src = (gate ? a.in[9] : a.in[7]) + (size_t)dn * 16384;
          p0_transpose_item(src, 128, 128, LRUW + (size_t)mat * 16384, 0, scr, sub, lane); }
    }
    bf16_t* U = (bf16_t*)(ws + WS_U);
    for (int m = gw; m < SEQ + NMEM; m += NGW) {
        if (m < SEQ) rms_row_to_bf16(a.in[0] + (size_t)m * 4096, a.in[2], U + (size_t)m * 4096, lane);
        else rms_row_to_bf16(a.in[1] + (size_t)(m - SEQ) * 4096, a.in[12], U + (size_t)m * 4096, lane);
    }
    f32x2* rope = (f32x2*)(ws + WS_ROPE);
    for (int e = blockIdx.x * 512 + tid; e < SEQ * 16; e += G * 512) {
        const int pos = e >> 4, i = e & 15;
        const float inv = powf(500000.0f, -(float)i * (1.0f / 16.0f));
        const float ang = (float)pos * inv;
        rope[e] = (f32x2){cosf(ang), sinf(ang)};
    }
}

struct Sched1 {
    pg8::StaticOrder so; int G, c;
    __device__ void init(int G_, int c_) { so.init(SEQ, INW, G_, c_); G = G_; c = c_; }
    __device__ bool next(int i, pg8::Unit& u) const {
        const long L = (long)i * G + c;
        if (L < 1152) return so.next(i, u);
        if (L < 1160) { u.pm = 32; u.pn = 36 + (int)(L - 1152); return true; }
        return false;
    }
    __device__ __forceinline__ void a_ready(const pg8::Unit&) const {}
    __device__ __forceinline__ void done(const pg8::Unit&) const {}
};
struct Epi1 {
    static constexpr bool PERM = true, AFTER_DRAIN = false, HOLD_LAST = false;
    bf16_t* proj; bf16_t* vt; bf16_t* mk; bf16_t* mvt; const float* rope;
    __device__ __forceinline__ void operator()(const f32x4 (&acc)[2][2][4][2], const pg8::Unit& u, int wr, int wc, int fr, int fq) const {
        const int rloc = wr * 64 + fr, cloc = wc * 32 + 8 * fq;
        if (u.pm == 32) {
            const int t = u.pn - 36;
            if (t < 4) {
#pragma unroll
                for (int ai = 0; ai < 2; ++ai)
#pragma unroll
                    for (int m = 0; m < 4; ++m) { const int row = rloc + ai * 128 + m * 16;
#pragma unroll
                        for (int bj = 0; bj < 2; ++bj) { const f32x4 v0 = acc[ai][bj][m][0], v1 = acc[ai][bj][m][1];
                            u32x4 wv; wv.x = pk2(v0[0], v0[1]); wv.y = pk2(v0[2], v0[3]); wv.z = pk2(v1[0], v1[1]); wv.w = pk2(v1[2], v1[3]);
                            *(u32x4*)(mk + (size_t)row * 1024 + t * 256 + bj * 128 + cloc) = wv; } asm volatile("" ::: "memory"); }
            } else {
#pragma unroll
                for (int ai = 0; ai < 2; ++ai)
#pragma unroll
                    for (int m = 0; m < 4; ++m) { const int row = rloc + ai * 128 + m * 16;
#pragma unroll
                        for (int bj = 0; bj < 2; ++bj)
#pragma unroll
                            for (int n = 0; n < 2; ++n)
#pragma unroll
                                for (int i = 0; i < 4; ++i) { const int col = (t - 4) * 256 + bj * 128 + cloc + 4 * n + i;
                                    mvt[(size_t)col * 256 + row] = (bf16_t)(pk2(acc[ai][bj][m][n][i], 0.f) & 0xffffu); } asm volatile("" ::: "memory"); }
            }
            return;
        }
        const int pn = u.pn, row0 = u.pm * 256 + rloc;
        if (pn == 10 || pn == 11) {
#pragma unroll
            for (int ai = 0; ai < 2; ++ai)
#pragma unroll
                for (int m = 0; m < 4; ++m) { const int row = row0 + ai * 128 + m * 16;
#pragma unroll
                    for (int bj = 0; bj < 2; ++bj)
#pragma unroll
                        for (int n = 0; n < 2; ++n)
#pragma unroll
                            for (int i = 0; i < 4; ++i) { const int col = (pn - 10) * 256 + bj * 128 + cloc + 4 * n + i;
                                vt[(size_t)col * SEQ + row] = (bf16_t)(pk2(acc[ai][bj][m][n][i], 0.f) & 0xffffu); } asm volatile("" ::: "memory"); }
            return;
        }
        float sc = 1.f; if (pn < 8) sc = SC_ATT; else if (pn >= 16 && pn < 20) sc = SC_MEM;
        const bool do_rope = (pn < 10) && (wc == 0);
        const float sgn = (fq < 2) ? -1.f : 1.f;
#pragma unroll
        for (int ai = 0; ai < 2; ++ai)
#pragma unroll
            for (int m = 0; m < 4; ++m) { const int row = row0 + ai * 128 + m * 16;
                f32x4 cs[2][2];
                if (do_rope) {
#pragma unroll
                    for (int n = 0; n < 2; ++n) { const float* rp = rope + ((size_t)row * 16 + 8 * (fq & 1) + 4 * n) * 2; cs[n][0] = *(const f32x4*)rp; cs[n][1] = *(const f32x4*)(rp + 4); }
                }
#pragma unroll
                for (int bj = 0; bj < 2; ++bj) { f32x4 v[2]; v[0] = acc[ai][bj][m][0]; v[1] = acc[ai][bj][m][1];
                    if (do_rope) {
#pragma unroll
                        for (int n = 0; n < 2; ++n) { f32x4 p; p[0] = __shfl_xor(v[n][0], 32); p[1] = __shfl_xor(v[n][1], 32); p[2] = __shfl_xor(v[n][2], 32); p[3] = __shfl_xor(v[n][3], 32);
                            f32x4 r; r[0] = v[n][0] * cs[n][0][0] + sgn * p[0] * cs[n][0][1]; r[1] = v[n][1] * cs[n][0][2] + sgn * p[1] * cs[n][0][3];
                            r[2] = v[n][2] * cs[n][1][0] + sgn * p[2] * cs[n][1][1]; r[3] = v[n][3] * cs[n][1][2] + sgn * p[3] * cs[n][1][3]; v[n] = r; }
                    }
                    u32x4 wv; wv.x = pk2(v[0][0] * sc, v[0][1] * sc); wv.y = pk2(v[0][2] * sc, v[0][3] * sc); wv.z = pk2(v[1][0] * sc, v[1][1] * sc); wv.w = pk2(v[1][2] * sc, v[1][3] * sc);
                    *(u32x4*)(proj + (size_t)row * INW + pn * 256 + bj * 128 + cloc) = wv; } asm volatile("" ::: "memory"); }
    }
};

template <int DH, bool PF, bool DB>
__device__ __forceinline__ void attn_unit(LAS unsigned char* lds, const bf16_t* Qp, int ldq, bf16_t* Op, int ldo, const bf16_t* Kg, int ldk, const bf16_t* Vtg, int ldv,
                                          int cb_lo, int cb_hi, int cb_self, float m_init, float l_init) {
    constexpr int PR = DH / 8, KROW = DH * 2, KT = 128 * KROW, VROW = 288, NKI = (128 * PR) / 512, NVI = (DH * 16) / 512, NS = DH / 32, NDT = DH / 16;
    int tid = threadIdx.x; asm volatile("" : "+v"(tid)); const int lane = tid & 63, w = tid >> 6, q = lane & 15, g = lane >> 4;
    const int krow = 8 * (q >> 2) + (q & 3);
    bf16x8 qf[NS];
    { const unsigned qoff = (unsigned)(((16 * w + q) * ldq + 8 * g) * 2);
#pragma unroll
      for (int s = 0; s < NS; ++s) qf[s] = *(const bf16x8*)((const char*)Qp + qoff + 64 * s); }
    f32x4 o[NDT];
#pragma unroll
    for (int dt = 0; dt < NDT; ++dt) o[dt] = (f32x4){0.f, 0.f, 0.f, 0.f};
    float m_run = m_init, l_run = l_init;
    u32x4 kreg[NKI], vreg[NVI];
#define ATT_LOAD(cb) do { const int k0_ = (cb) * 128; \
        const char* kb_ = (const char*)Kg + (size_t)k0_ * ldk * 2; const char* vb_ = (const char*)Vtg + (size_t)k0_ * 2; \
        _Pragma("unroll") for (int it = 0; it < NKI; ++it) { const int e = tid + 512 * it; const int key = e / PR, pc = e % PR; \
            kreg[it] = *(const u32x4*)(kb_ + (unsigned)((key * ldk + pc * 8) * 2)); } \
        _Pragma("unroll") for (int it = 0; it < NVI; ++it) { const int e = tid + 512 * it; const int d = e >> 4, pc = e & 15; \
            vreg[it] = *(const u32x4*)(vb_ + (unsigned)((d * ldv + pc * 8) * 2)); } } while (0)
#define ATT_STORE() do { \
        _Pragma("unroll") for (int it = 0; it < NKI; ++it) { const int e = tid + 512 * it; const int key = e / PR, pc = e % PR; \
            *(LAS u32x4*)(lds + key * KROW + ((pc ^ ((((key >> 3) & 3) << 2) | (key & 3))) * 16)) = kreg[it]; } \
        _Pragma("unroll") for (int it = 0; it < NVI; ++it) { const int e = tid + 512 * it; const int d = e >> 4, pc = e & 15; \
            *(LAS u32x4*)(lds + KT + d * VROW + pc * 16) = vreg[it]; } } while (0)
    if (PF) ATT_LOAD(cb_lo);
    for (int cb = cb_lo; cb < cb_hi; ++cb) {
        if (!PF) ATT_LOAD(cb);
        __syncthreads();
        ATT_STORE();
        __syncthreads();
        if (PF) { if (cb + 1 < cb_hi) ATT_LOAD(cb + 1); }
        f32x4 s[8];
#pragma unroll
        for (int kt = 0; kt < 8; ++kt) s[kt] = (f32x4){0.f, 0.f, 0.f, 0.f};
        {
            bf16x8 ka[DB ? 2 : 1][8];
            if (DB) {
#pragma unroll
                for (int kt = 0; kt < 8; ++kt) ka[0][kt] = *(const LAS bf16x8*)(lds + (32 * (kt >> 1) + 4 * (kt & 1) + krow) * KROW + (((0 + g) ^ q) * 16));
            }
#pragma unroll
            for (int ss = 0; ss < NS; ++ss) {
                if (DB) { if (ss + 1 < NS) {
#pragma unroll
                    for (int kt = 0; kt < 8; ++kt) ka[(ss + 1) & 1][kt] = *(const LAS bf16x8*)(lds + (32 * (kt >> 1) + 4 * (kt & 1) + krow) * KROW + (((4 * (ss + 1) + g) ^ q) * 16)); }
                } else {
#pragma unroll
                    for (int kt = 0; kt < 8; ++kt) ka[0][kt] = *(const LAS bf16x8*)(lds + (32 * (kt >> 1) + 4 * (kt & 1) + krow) * KROW + (((4 * ss + g) ^ q) * 16));
                }
                __builtin_amdgcn_sched_barrier(0);
#pragma unroll
                for (int kt = 0; kt < 8; ++kt) s[kt] = mfma16(ka[DB ? (ss & 1) : 0][kt], qf[ss], s[kt]);
                __builtin_amdgcn_sched_barrier(0);
            }
        }
        if (cb != cb_self && cb_self >= 0) {
            const float sg = (cb < cb_self) ? 1.f : -1.f;
            const float dq = (float)(16 * w + q - 8 * g);
#pragma unroll
            for (int kt = 0; kt < 8; ++kt)
#pragma unroll
                for (int j = 0; j < 4; ++j) { const float v = sg * ((float)(32 * (kt >> 1) + 4 * (kt & 1) + j) - dq); s[kt][j] += fminf(v, 0.f) * 1e30f; }
        }
        float mx = s[0][0];
#pragma unroll
        for (int kt = 0; kt < 8; ++kt)
#pragma unroll
            for (int j = 0; j < 4; ++j) mx = fmaxf(mx, s[kt][j]);
        mx = fmaxf(mx, __shfl_xor(mx, 16)); mx = fmaxf(mx, __shfl_xor(mx, 32));
        const float m_new = fmaxf(m_run, mx), alpha = fexp2(m_run - m_new); m_run = m_new;
        float rs = 0.f;
#pragma unroll
        for (int kt = 0; kt < 8; ++kt)
#pragma unroll
            for (int j = 0; j < 4; ++j) { const float p = fexp2(s[kt][j] - m_new); s[kt][j] = p; rs += p; }
        rs += __shfl_xor(rs, 16); rs += __shfl_xor(rs, 32);
        l_run = l_run * alpha + rs;
        bf16x8 pb[4];
#pragma unroll
        for (int u = 0; u < 4; ++u) { u32x4 t; t.x = pk2(s[2 * u][0], s[2 * u][1]); t.y = pk2(s[2 * u][2], s[2 * u][3]); t.z = pk2(s[2 * u + 1][0], s[2 * u + 1][1]); t.w = pk2(s[2 * u + 1][2], s[2 * u + 1][3]);
            pb[u] = __builtin_bit_cast(bf16x8, t); }
#pragma unroll
        for (int dt = 0; dt < NDT; ++dt) o[dt] = o[dt] * alpha;
        {
            constexpr int NG = (NDT / 8) * 4;
            u32x4 va[DB ? 2 : 1][8];
#define ATT_VLOAD(buf, gi) do { const int u_ = (gi) & 3, d0_ = 8 * ((gi) >> 2); \
            _Pragma("unroll") for (int i = 0; i < 8; ++i) { va[buf][i] = *(const LAS u32x4*)(lds + KT + (16 * (d0_ + i) + q) * VROW + (32 * u_ + 8 * g) * 2); } } while (0)
            if (DB) ATT_VLOAD(0, 0);
#pragma unroll
            for (int gi = 0; gi < NG; ++gi) {
                if (DB) { if (gi + 1 < NG) ATT_VLOAD((gi + 1) & 1, gi + 1); } else ATT_VLOAD(0, gi);
                __builtin_amdgcn_sched_barrier(0);
#pragma unroll
                for (int i = 0; i < 8; ++i) o[8 * (gi >> 2) + i] = mfma16(__builtin_bit_cast(bf16x8, va[DB ? (gi & 1) : 0][i]), pb[gi & 3], o[8 * (gi >> 2) + i]);
                __builtin_amdgcn_sched_barrier(0);
            }
#undef ATT_VLOAD
        }
    }
#undef ATT_LOAD
#undef ATT_STORE
    const float inv = 1.f / l_run;
    const unsigned ooff = (unsigned)(((16 * w + q) * ldo + 4 * g) * 2);
#pragma unroll
    for (int dt = 0; dt < NDT; ++dt) { u32x2 pkv; pkv.x = pk2(o[dt][0] * inv, o[dt][1] * inv); pkv.y = pk2(o[dt][2] * inv, o[dt][3] * inv); *(u32x2*)((char*)Op + ooff + 32 * dt) = pkv; }
}

constexpr int LR_XCB = 0, LR_TA = 16384, LR_TB = LR_TA + 64 * 528, LR_TH = LR_TB + 64 * 528, LR_AGS = LR_TH + 64 * 528;
__device__ __forceinline__ void lru_phase(LAS unsigned char* lds, const Args& a, const int n, const int tt_first, const int tt_step) {
    int tid = threadIdx.x; asm volatile("" : "+v"(tid)); const int lane = tid & 63, w = tid >> 6, q = lane & 15, g = lane >> 4;
    unsigned char* ws = a.ws;
    const bf16_t* proj = (const bf16_t*)(ws + WS_PROJ);
    LAS unsigned char* xcb = lds + LR_XCB;
    LAS float* TA = (LAS float*)(lds + LR_TA); LAS float* TB = (LAS float*)(lds + LR_TB); LAS float* TH = (LAS float*)(lds + LR_TH);
    LAS f32x2* AGS = (LAS f32x2*)(lds + LR_AGS);
    const bf16_t* lruw = (const bf16_t*)(ws + WS_LRUW);
    f32x2* agg1 = (f32x2*)(ws + WS_AGG1);
    bf16_t* Pout = (bf16_t*)(ws + WS_PP);
    bf16x8 fa[2][4], fx[2][4];
    const int chl = 16 * w + 4 * g;
#pragma unroll
    for (int dir = 0; dir < 2; ++dir) {
        const bf16_t* wa = lruw + (size_t)((0 * 2 + dir) * 8 + n) * 16384 + (16 * w + q) * 128 + 8 * g;
        const bf16_t* wx = lruw + (size_t)((1 * 2 + dir) * 8 + n) * 16384 + (16 * w + q) * 128 + 8 * g;
#pragma unroll
        for (int s = 0; s < 4; ++s) { fa[dir][s] = *(const bf16x8*)(wa + 32 * s); fx[dir][s] = *(const bf16x8*)(wx + 32 * s); }
    }
    const int cg8 = tid & 15, t2 = tid >> 4, ch0 = n * 128 + cg8 * 8;
    LAS float* CW = (LAS float*)(lds + LR_AGS + 4096);
    __syncthreads();
    if (tid < 128) {
#pragma unroll
        for (int j = 0; j < 4; ++j) CW[j * 128 + tid] = a.in[5][j * 1024 + n * 128 + tid];
        CW[512 + tid] = a.in[6][n * 128 + tid];
    } else if (tid < 384) {
        const int d2 = (tid - 128) >> 7, c = tid & 127, cg = d2 * 1024 + n * 128 + c;
        const float xl = -a.in[11][cg];
        CW[640 + (d2 * 3 + 0) * 128 + c] = a.in[8][cg]; CW[640 + (d2 * 3 + 1) * 128 + c] = a.in[10][cg];
        CW[640 + (d2 * 3 + 2) * 128 + c] = fmaxf(xl, 0.f) + log1pf(expf(-fabsf(xl)));
    }
    u32x4 xr[5];
#define LRU_XLOAD(tt_) do { _Pragma("unroll") for (int r = 0; r < 5; ++r) { const int t = (tt_) * 64 + 2 * t2 - 2 + r; xr[r] = (u32x4){0u, 0u, 0u, 0u}; \
        if (t >= 0 && t < SEQ) xr[r] = *(const u32x4*)((const char*)proj + (unsigned)((t * INW + C_XL + ch0) * 2)); } } while (0)
    if (tt_first < 128) LRU_XLOAD(tt_first);
#pragma unroll 1
    for (int tt = tt_first; tt < 128; tt += tt_step) {
    const int t0 = tt * 64;
    __syncthreads();
    {
        float xin[5][8];
#pragma unroll
        for (int r = 0; r < 5; ++r) { const u32x4 v = xr[r];
            xin[r][0] = bflo(v.x); xin[r][1] = bfhi(v.x); xin[r][2] = bflo(v.y); xin[r][3] = bfhi(v.y); xin[r][4] = bflo(v.z); xin[r][5] = bfhi(v.z); xin[r][6] = bflo(v.w); xin[r][7] = bfhi(v.w); }
        float wv[4][8], bias[8];
#pragma unroll
        for (int j = 0; j < 4; ++j) { const f32x4 w0 = *(const LAS f32x4*)(CW + j * 128 + cg8 * 8), w1 = *(const LAS f32x4*)(CW + j * 128 + cg8 * 8 + 4);
            wv[j][0] = w0[0]; wv[j][1] = w0[1]; wv[j][2] = w0[2]; wv[j][3] = w0[3]; wv[j][4] = w1[0]; wv[j][5] = w1[1]; wv[j][6] = w1[2]; wv[j][7] = w1[3]; }
        { const f32x4 b0 = *(const LAS f32x4*)(CW + 512 + cg8 * 8), b1 = *(const LAS f32x4*)(CW + 512 + cg8 * 8 + 4);
          bias[0] = b0[0]; bias[1] = b0[1]; bias[2] = b0[2]; bias[3] = b0[3]; bias[4] = b1[0]; bias[5] = b1[1]; bias[6] = b1[2]; bias[7] = b1[3]; }
#pragma unroll
        for (int o = 0; o < 2; ++o) { float y[8];
#pragma unroll
            for (int e = 0; e < 8; ++e) { float v = bias[e];
#pragma unroll
                for (int j = 0; j < 4; ++j) v += wv[j][e] * xin[o + j][e];
                y[e] = v; }
            const int tok = 2 * t2 + o;
            u32x4 pk; pk.x = pk2(y[0], y[1]); pk.y = pk2(y[2], y[3]); pk.z = pk2(y[4], y[5]); pk.w = pk2(y[6], y[7]);
            *(LAS u32x4*)(xcb + tok * 256 + ((cg8 ^ (tok & 15)) * 16)) = pk; }
    }
    if (tt + tt_step < 128) LRU_XLOAD(tt + tt_step);
    __syncthreads();
#pragma unroll
    for (int dir = 0; dir < 2; ++dir) {
        {
            const f32x4 ba = *(const LAS f32x4*)(CW + 640 + (dir * 3 + 0) * 128 + chl), bx = *(const LAS f32x4*)(CW + 640 + (dir * 3 + 1) * 128 + chl), sp = *(const LAS f32x4*)(CW + 640 + (dir * 3 + 2) * 128 + chl);
#pragma unroll
            for (int tk = 0; tk < 4; ++tk) { const int tok = 16 * tk + q;
                f32x4 ar = (f32x4){0.f, 0.f, 0.f, 0.f}, ai = (f32x4){0.f, 0.f, 0.f, 0.f};
#pragma unroll
                for (int s = 0; s < 4; ++s) {
                    const bf16x8 xb = *(const LAS bf16x8*)(xcb + tok * 256 + (((4 * s + g) ^ q) * 16));
                    ar = mfma16(fa[dir][s], xb, ar); ai = mfma16(fx[dir][s], xb, ai); }
                const u32x2 xr2 = *(const LAS u32x2*)(xcb + tok * 256 + ((((chl >> 3)) ^ q) * 16) + (chl & 7) * 2);
                const float xc0 = bflo(xr2.x), xc1 = bfhi(xr2.x), xc2 = bflo(xr2.y), xc3 = bfhi(xr2.y);
                f32x4 av, bv;
#pragma unroll
                for (int j = 0; j < 4; ++j) { const float r = fsigmoid(ar[j] + ba[j]), ii = fsigmoid(ai[j] + bx[j]);
                    const float la = -8.0f * r * sp[j]; const float aa = fexp2(la * LOG2E); av[j] = aa;
                    const float x2 = 2.0f * la;
                    const float poly = x2 * (1.f + x2 * (0.5f + x2 * ((1.f / 6.f) + x2 * ((1.f / 24.f) + x2 * ((1.f / 120.f) + x2 * (1.f / 720.f))))));
                    const float om = (x2 > -0.25f) ? -poly : (1.f - aa * aa);
                    const float xcj = j == 0 ? xc0 : (j == 1 ? xc1 : (j == 2 ? xc2 : xc3));
                    bv[j] = __builtin_amdgcn_sqrtf(om) * ii * xcj; }
                *(LAS f32x4*)(TA + tok * 132 + chl) = av; *(LAS f32x4*)(TB + tok * 132 + chl) = bv; }
        }
        __syncthreads();
        const int ch = tid & 127, sub = tid >> 7;
        {
            float h = 0.f, P = 1.f;
#pragma unroll
            for (int i = 0; i < 16; ++i) { const int t = 16 * sub + (dir ? 15 - i : i);
                const float av = TA[t * 132 + ch], bv = TB[t * 132 + ch]; h = av * h + bv; P *= av; TB[t * 132 + ch] = h; TA[t * 132 + ch] = P; }
            AGS[sub * 128 + ch] = (f32x2){P, h};
        }
        __syncthreads();
        {
            float hc = 0.f, Pp = 1.f, At = 1.f, Ht = 0.f;
#pragma unroll
            for (int s = 0; s < 4; ++s) { const int s2 = dir ? 3 - s : s; const f32x2 e = AGS[s2 * 128 + ch];
                const bool before = dir ? (s2 > sub) : (s2 < sub);
                if (before) { hc = e.x * hc + e.y; Pp *= e.x; }
                Ht = e.x * Ht + e.y; At *= e.x; }
            bf16_t* pp = Pout + (size_t)dir * ((size_t)SEQ * 1024) + (size_t)(t0 + 16 * sub) * 1024 + n * 128 + ch;
#pragma unroll
            for (int i = 0; i < 16; ++i) { const int t = 16 * sub + i;
                const float Pl = TA[t * 132 + ch], hl = TB[t * 132 + ch];
                const float hfull = hl + Pl * hc;
                if (dir == 0) TH[t * 132 + ch] = hfull; else TH[t * 132 + ch] += hfull;
                pp[(size_t)i * 1024] = (bf16_t)(pk2(Pl * Pp, 0.f) & 0xffffu); }
            if (sub == 0) agg1[(size_t)(dir * 1024 + n * 128 + ch) * 128 + tt] = (f32x2){At, Ht};
        }
        __syncthreads();
    }
    {
        float* hs = (float*)(ws + WS_HS);
#pragma unroll
        for (int i = 0; i < 4; ++i) { const int e = tid + 512 * i, t = e >> 5, c4 = e & 31;
            *(f32x4*)(hs + (size_t)(t0 + t) * 1024 + n * 128 + 4 * c4) = *(const LAS f32x4*)(TH + t * 132 + 4 * c4); }
    }
    }
#undef LRU_XLOAD
}

__device__ __forceinline__ void phase2(const Args& a, LAS unsigned char* lds, int p2mask) {
    unsigned char* ws = a.ws;
    bf16_t* proj = (bf16_t*)(ws + WS_PROJ); const bf16_t* vt = (const bf16_t*)(ws + WS_VT);
    const bf16_t* mk = (const bf16_t*)(ws + WS_MK); const bf16_t* mvt = (const bf16_t*)(ws + WS_MVT);
    bf16_t* yatt = (bf16_t*)(ws + WS_YATT); bf16_t* ymem = (bf16_t*)(ws + WS_YMEM);
    if (p2mask & 1)
    for (int u = blockIdx.x; u < 256; u += gridDim.x) {
        const int qblk = u >> 2, hm = u & 3;
        attn_unit<256, false, false>(lds, proj + (size_t)(qblk * 128) * INW + C_QM + hm * 256, INW, ymem + (size_t)(qblk * 128) * 1024 + hm * 256, 1024, mk + hm * 256, 1024, mvt + (size_t)(hm * 256) * 256, 256, 0, 2, -100, -1e30f, 0.f);
    }
    if (p2mask & 2)
    for (int v = blockIdx.x; v < 1024; v += gridDim.x) {
        const int qblk = v >> 4, hq = v & 15, kvh = hq >> 2;
        const int lo = qblk > 0 ? qblk - 1 : 0, hi = qblk < 63 ? qblk + 2 : 64;
        const float sink2 = a.in[4][hq] * LOG2E;
        attn_unit<128, true, true>(lds, proj + (size_t)(qblk * 128) * INW + C_QA + hq * 128, INW, yatt + (size_t)(qblk * 128) * 2048 + hq * 128, 2048, proj + C_KA + kvh * 128, INW, vt + (size_t)(kvh * 128) * SEQ, SEQ, lo, hi, qblk, sink2, 1.f);
    }
    if (p2mask & 4)
    { const int G = gridDim.x; const bool al = (G & 7) == 0; const int nrep = al ? 1 : 8;
#pragma unroll 1
      for (int rep = 0; rep < nrep; ++rep) lru_phase(lds, a, al ? (int)(blockIdx.x & 7) : rep, al ? (int)(blockIdx.x >> 3) : (int)blockIdx.x, al ? (G >> 3) : G); }
}

__device__ __forceinline__ void phase3(const Args& a, LAS unsigned char* lds) {
    unsigned char* ws = a.ws;
    const f32x2* agg1 = (const f32x2*)(ws + WS_AGG1); f32x2* agg2 = (f32x2*)(ws + WS_AGG2);
    for (int e = blockIdx.x * 512 + threadIdx.x; e < 2 * 1024 * 16; e += gridDim.x * 512) {
        const int sc = e & 15, dc = e >> 4, dir = dc >> 10;
        const f32x4* p = (const f32x4*)(agg1 + (size_t)dc * 128 + sc * 8);
        f32x4 v[4];
#pragma unroll
        for (int i = 0; i < 4; ++i) v[i] = p[i];
        float A = 1.f, H = 0.f;
        if (dir == 0) {
#pragma unroll
            for (int i = 0; i < 4; ++i) { H = v[i][0] * H + v[i][1]; A *= v[i][0]; H = v[i][2] * H + v[i][3]; A *= v[i][2]; }
        } else {
#pragma unroll
            for (int i = 3; i >= 0; --i) { H = v[i][2] * H + v[i][3]; A *= v[i][2]; H = v[i][0] * H + v[i][1]; A *= v[i][0]; }
        }
        agg2[(size_t)dc * 16 + sc] = (f32x2){A, H};
    }
}

__device__ __forceinline__ float silu_(float z) { return z * __builtin_amdgcn_rcpf(1.f + __builtin_amdgcn_exp2f(-z * 1.4426950408889634f)); }
__device__ __forceinline__ void phase4(const Args& a, LAS unsigned char* lds) {
    unsigned char* ws = a.ws;
    const f32x2* agg1 = (const f32x2*)(ws + WS_AGG1); const f32x2* agg2 = (const f32x2*)(ws + WS_AGG2);
    const bf16_t* proj = (const bf16_t*)(ws + WS_PROJ); bf16_t* Y = (bf16_t*)(ws + WS_Y);
    const bf16_t* yatt = (const bf16_t*)(ws + WS_YATT); const bf16_t* ymem = (const bf16_t*)(ws + WS_YMEM);
    const float* hs = (const float*)(ws + WS_HS); const bf16_t* Pf = (const bf16_t*)(ws + WS_PP); const bf16_t* Pb = Pf + (size_t)SEQ * 1024;
    LAS float* car = (LAS float*)lds;
    int tid = threadIdx.x; asm volatile("" : "+v"(tid)); const int lane = tid & 63, w = tid >> 6;
    for (int u = blockIdx.x; u < 256; u += gridDim.x) {
        const int tile = u >> 1, sc = tile >> 3, cj = tile & 7;
        __syncthreads();
#pragma unroll 1
        for (int half = 0; half < 2; ++half) {
            const int c = tid + 512 * half;
            float hf = 0.f, hb = 0.f;
            { const f32x4* p2 = (const f32x4*)(agg2 + (size_t)c * 16); const f32x4* p1 = (const f32x4*)(agg1 + (size_t)c * 128 + sc * 8);
              f32x4 e2[8], e1[4];
#pragma unroll
              for (int i = 0; i < 8; ++i) e2[i] = p2[i];
#pragma unroll
              for (int i = 0; i < 4; ++i) e1[i] = p1[i];
#pragma unroll
              for (int i = 0; i < 8; ++i) { if (2 * i < sc) hf = e2[i][0] * hf + e2[i][1]; if (2 * i + 1 < sc) hf = e2[i][2] * hf + e2[i][3]; }
#pragma unroll
              for (int i = 0; i < 4; ++i) { if (2 * i < cj) hf = e1[i][0] * hf + e1[i][1]; if (2 * i + 1 < cj) hf = e1[i][2] * hf + e1[i][3]; } }
            { const f32x4* p2 = (const f32x4*)(agg2 + (size_t)(1024 + c) * 16); const f32x4* p1 = (const f32x4*)(agg1 + (size_t)(1024 + c) * 128 + sc * 8);
              f32x4 e2[8], e1[4];
#pragma unroll
              for (int i = 0; i < 8; ++i) e2[i] = p2[i];
#pragma unroll
              for (int i = 0; i < 4; ++i) e1[i] = p1[i];
#pragma unroll
              for (int i = 7; i >= 0; --i) { if (2 * i + 1 > sc) hb = e2[i][2] * hb + e2[i][3]; if (2 * i > sc) hb = e2[i][0] * hb + e2[i][1]; }
#pragma unroll
              for (int i = 3; i >= 0; --i) { if (2 * i + 1 > cj) hb = e1[i][2] * hb + e1[i][3]; if (2 * i > cj) hb = e1[i][0] * hb + e1[i][1]; } }
            car[c] = hf; car[1024 + c] = hb;
        }
        __syncthreads();
        f32x4 cf[4], cb[4];
#pragma unroll
        for (int k = 0; k < 4; ++k) { cf[k] = *(const LAS f32x4*)(car + 4 * lane + 256 * k); cb[k] = *(const LAS f32x4*)(car + 1024 + 4 * lane + 256 * k); }
#pragma unroll 1
        for (int tk = 0; tk < 4; ++tk) {
            const int t = u * 32 + 4 * w + tk;
            const char* hsb = (const char*)hs; const char* pfb = (const char*)Pf; const char* pbb = (const char*)Pb;
            const char* yab = (const char*)yatt; const char* ymb = (const char*)ymem; const char* prb = (const char*)proj; char* yb = (char*)Y;
            const unsigned o_h = (unsigned)t * 4096u + 16u * lane, o_p = (unsigned)t * 2048u + 8u * lane, o_a = (unsigned)t * 4096u + 16u * lane, o_m = (unsigned)t * 2048u + 16u * lane;
            const unsigned o_pr = (unsigned)t * (unsigned)(INW * 2), o_y = (unsigned)t * 8192u;
            f32x4 h4[4]; u32x2 pf[4], pb[4]; u32x4 va[4], vm[2];
#pragma unroll
            for (int k = 0; k < 4; ++k) { h4[k] = *(const f32x4*)(hsb + o_h + 1024u * k); pf[k] = *(const u32x2*)(pfb + o_p + 512u * k); pb[k] = *(const u32x2*)(pbb + o_p + 512u * k); va[k] = *(const u32x4*)(yab + o_a + 1024u * k); }
#pragma unroll
            for (int k = 0; k < 2; ++k) vm[k] = *(const u32x4*)(ymb + o_m + 1024u * k);
            __builtin_amdgcn_sched_barrier(0);
            f32x4 v[4]; float ssl = 0.f, ssa = 0.f, ssm = 0.f;
#pragma unroll
            for (int k = 0; k < 4; ++k) {
                v[k][0] = h4[k][0] + bflo(pf[k].x) * cf[k][0] + bflo(pb[k].x) * cb[k][0]; v[k][1] = h4[k][1] + bfhi(pf[k].x) * cf[k][1] + bfhi(pb[k].x) * cb[k][1];
                v[k][2] = h4[k][2] + bflo(pf[k].y) * cf[k][2] + bflo(pb[k].y) * cb[k][2]; v[k][3] = h4[k][3] + bfhi(pf[k].y) * cf[k][3] + bfhi(pb[k].y) * cb[k][3];
                ssl += (v[k][0] * v[k][0] + v[k][1] * v[k][1]) + (v[k][2] * v[k][2] + v[k][3] * v[k][3]);
                { const float f0 = bflo(va[k].x), f1 = bfhi(va[k].x), f2 = bflo(va[k].y), f3 = bfhi(va[k].y), f4 = bflo(va[k].z), f5 = bfhi(va[k].z), f6 = bflo(va[k].w), f7 = bfhi(va[k].w);
                  ssa += ((f0 * f0 + f1 * f1) + (f2 * f2 + f3 * f3)) + ((f4 * f4 + f5 * f5) + (f6 * f6 + f7 * f7)); } }
#pragma unroll
            for (int k = 0; k < 2; ++k) { const float f0 = bflo(vm[k].x), f1 = bfhi(vm[k].x), f2 = bflo(vm[k].y), f3 = bfhi(vm[k].y), f4 = bflo(vm[k].z), f5 = bfhi(vm[k].z), f6 = bflo(vm[k].w), f7 = bfhi(vm[k].w);
                ssm += ((f0 * f0 + f1 * f1) + (f2 * f2 + f3 * f3)) + ((f4 * f4 + f5 * f5) + (f6 * f6 + f7 * f7)); }
#pragma unroll
            for (int o = 1; o < 64; o <<= 1) { ssl += __shfl_xor(ssl, o); ssa += __shfl_xor(ssa, o); ssm += __shfl_xor(ssm, o); }
            const float rsl = 1.f / sqrtf(ssl * (1.f / 1024.f) + EPSN), rsa = 1.f / sqrtf(ssa * (1.f / 2048.f) + EPSN), rsm = 1.f / sqrtf(ssm * (1.f / 1024.f) + EPSN);
            __builtin_amdgcn_sched_barrier(0);
#pragma unroll
            for (int k = 0; k < 4; ++k) { const int c = 4 * lane + 256 * k; const f32x4 g4 = *(const f32x4*)(a.in[15] + c); const u32x2 z = *(const u32x2*)(prb + o_pr + (unsigned)((C_ZL + c) * 2));
                u32x2 o; o.x = pk2(v[k][0] * rsl * g4[0] * silu_(bflo(z.x)), v[k][1] * rsl * g4[1] * silu_(bfhi(z.x))); o.y = pk2(v[k][2] * rsl * g4[2] * silu_(bflo(z.y)), v[k][3] * rsl * g4[3] * silu_(bfhi(z.y)));
                *(u32x2*)(yb + o_y + (unsigned)((2048 + c) * 2)) = o; }
            __builtin_amdgcn_sched_barrier(0);
#pragma unroll
            for (int k = 0; k < 4; ++k) { const int c = 8 * lane + 512 * k; const f32x4 g0 = *(const f32x4*)(a.in[14] + c), g1 = *(const f32x4*)(a.in[14] + c + 4); const u32x4 z = *(const u32x4*)(prb + o_pr + (unsigned)((C_ZA + c) * 2));
                u32x4 o; o.x = pk2(bflo(va[k].x) * rsa * g0[0] * silu_(bflo(z.x)), bfhi(va[k].x) * rsa * g0[1] * silu_(bfhi(z.x)));
                o.y = pk2(bflo(va[k].y) * rsa * g0[2] * silu_(bflo(z.y)), bfhi(va[k].y) * rsa * g0[3] * silu_(bfhi(z.y)));
                o.z = pk2(bflo(va[k].z) * rsa * g1[0] * silu_(bflo(z.z)), bfhi(va[k].z) * rsa * g1[1] * silu_(bfhi(z.z)));
                o.w = pk2(bflo(va[k].w) * rsa * g1[2] * silu_(bflo(z.w)), bfhi(va[k].w) * rsa * g1[3] * silu_(bfhi(z.w)));
                *(u32x4*)(yb + o_y + (unsigned)(c * 2)) = o; }
            __builtin_amdgcn_sched_barrier(0);
#pragma unroll
            for (int k = 0; k < 2; ++k) { const int c = 8 * lane + 512 * k; const f32x4 g0 = *(const f32x4*)(a.in[16] + c), g1 = *(const f32x4*)(a.in[16] + c + 4); const u32x4 z = *(const u32x4*)(prb + o_pr + (unsigned)((C_ZM + c) * 2));
                u32x4 o; o.x = pk2(bflo(vm[k].x) * rsm * g0[0] * silu_(bflo(z.x)), bfhi(vm[k].x) * rsm * g0[1] * silu_(bfhi(z.x)));
                o.y = pk2(bflo(vm[k].y) * rsm * g0[2] * silu_(bflo(z.y)), bfhi(vm[k].y) * rsm * g0[3] * silu_(bfhi(z.y)));
                o.z = pk2(bflo(vm[k].z) * rsm * g1[0] * silu_(bflo(z.z)), bfhi(vm[k].z) * rsm * g1[1] * silu_(bfhi(z.z)));
                o.w = pk2(bflo(vm[k].w) * rsm * g1[2] * silu_(bflo(z.w)), bfhi(vm[k].w) * rsm * g1[3] * silu_(bfhi(z.w)));
                *(u32x4*)(yb + o_y + (unsigned)((3072 + c) * 2)) = o; }
        }
    }
}

#define XB_TMO      128
#define XB_XCNT(j)  (256  + 64 * (j))
#define XB_XSUB(j)  (1280 + 64 * (j))
#define XB_XGEN(j)  (2304 + 64 * (j))
#define XB_TOP      3328
#define XB_TOPGEN   3392
#define XCD_BAR_WORDS 3456
#define XB_SPIN_CAP (1u << 18)

__device__ __forceinline__ unsigned xb_ld(unsigned* p)              { return __hip_atomic_load(p, __ATOMIC_RELAXED, __HIP_MEMORY_SCOPE_AGENT); }
__device__ __forceinline__ unsigned xb_add(unsigned* p, unsigned v) { return __hip_atomic_fetch_add(p, v, __ATOMIC_RELAXED, __HIP_MEMORY_SCOPE_AGENT); }
__device__ __forceinline__ unsigned xb_xcc_id() { return (unsigned)__builtin_amdgcn_s_getreg((3 << 11) | 20) & 0xFu; }
#define XB_SPIN(cond, bar) do { unsigned _sp = 0; while (cond) { __builtin_amdgcn_s_sleep(1); \
    if ((++_sp & 255u) == 0u) { if (xb_ld(&(bar)[XB_TMO])) break; if (_sp > XB_SPIN_CAP) { atomicAdd(&(bar)[XB_TMO], 1u); break; } } } } while (0)

struct XcdBarrier {
    unsigned* bar; unsigned x;
    volatile LAS unsigned* st;
};

__device__ __forceinline__ XcdBarrier xcd_barrier_post(unsigned* bar, volatile LAS unsigned* st) {
    XcdBarrier b; b.bar = bar; b.x = xb_xcc_id(); b.st = st;
    if (threadIdx.x == 0) (void)xb_add(&bar[XB_XCNT(b.x)], 1u);
    return b;
}
__device__ __forceinline__ void xcd_barrier_complete(unsigned* bar, unsigned x, unsigned& nloc, unsigned& nx) {
    const unsigned G = gridDim.x * gridDim.y * gridDim.z;
    unsigned sum, cnt, mine, sp = 0u;
    for (;;) {
        sum = 0u; cnt = 0u; mine = 0u;
#pragma unroll
        for (unsigned j = 0; j < 16; ++j) { const unsigned c = xb_ld(&bar[XB_XCNT(j)]); sum += c; cnt += (c > 0u) ? 1u : 0u; mine = (j == x) ? c : mine; }
        if (sum == G) break;
        __builtin_amdgcn_s_sleep(1);
        if ((++sp & 255u) == 0u) { if (xb_ld(&bar[XB_TMO])) break; if (sp > XB_SPIN_CAP) { atomicAdd(&bar[XB_TMO], 1u); break; } }
    }
    nloc = mine > 0u ? mine : 1u; nx = cnt > 0u ? cnt : 1u;
}

__device__ __forceinline__ void xcd_barrier(const XcdBarrier& b) {
    asm volatile("s_waitcnt vmcnt(0)" ::: "memory");
    __syncthreads();
    if (threadIdx.x == 0) {
        unsigned* bar = b.bar;
        __builtin_amdgcn_s_waitcnt(0);
        unsigned nloc = b.st[0], nx = b.st[1];
        if (nloc == 0u) { xcd_barrier_complete(bar, b.x, nloc, nx); b.st[0] = nloc; b.st[1] = nx; }
        const unsigned old = xb_add(&bar[XB_XSUB(b.x)], 1u);
        const unsigned gen = old / nloc;
        if (old + 1u == (gen + 1u) * nloc) {
            __builtin_amdgcn_fence(__ATOMIC_RELEASE, "agent");
            asm volatile("s_waitcnt vmcnt(0)" ::: "memory");
            const unsigned og = xb_add(&bar[XB_TOP], 1u);
            const unsigned tg = og / nx;
            if (og + 1u == (tg + 1u) * nx) xb_add(&bar[XB_TOPGEN], 1u);
            else XB_SPIN(xb_ld(&bar[XB_TOPGEN]) == tg, bar);
            __builtin_amdgcn_fence(__ATOMIC_ACQUIRE, "agent");
            xb_add(&bar[XB_XGEN(b.x)], 1u);
            asm volatile("s_waitcnt vmcnt(0)" ::: "memory");
        } else {
            XB_SPIN(xb_ld(&bar[XB_XGEN(b.x)]) == gen, bar);
            __builtin_amdgcn_fence(__ATOMIC_ACQUIRE, "agent");
            asm volatile("s_waitcnt vmcnt(0)" ::: "memory");
        }
    }
    __syncthreads();
}

struct Sched2 {
    int c;
    __device__ bool next(int i, pg8::Unit& u) const {
        if (i >= 2) return false;
        const int x = c & 7, j = c >> 3;
        u.pm = i * 16 + 4 * (x >> 1) + (j & 3); u.pn = 8 * (x & 1) + (j >> 2); return true;
    }
    __device__ __forceinline__ void a_ready(const pg8::Unit&) const {}
    __device__ __forceinline__ void done(const pg8::Unit&) const {}
};
struct Epi3 {
    static constexpr bool PERM = false, AFTER_DRAIN = false, HOLD_LAST = true;
    float* out; bf16_t* t0; float* sspart; const float* x; const float* gain; XcdBarrier xbar;
    __device__ __forceinline__ void operator()(const f32x4 (&acc)[2][2][4][2], const pg8::Unit& u, int wr, int wc, int fr, int fq) const {
#pragma unroll
        for (int ai = 0; ai < 2; ++ai)
#pragma unroll
            for (int m = 0; m < 4; ++m) { const int row = u.pm * 256 + ai * 128 + wr * 64 + m * 16 + fr; float ss = 0.f;
#pragma unroll
                for (int bj = 0; bj < 2; ++bj)
#pragma unroll
                    for (int n = 0; n < 2; ++n) { const f32x4 v = acc[ai][bj][m][n]; const int col = u.pn * 256 + bj * 128 + wc * 32 + n * 16 + 4 * fq;
                        u32x2 pk; pk.x = pk2(v[0], v[1]); pk.y = pk2(v[2], v[3]); *(u32x2*)(t0 + (size_t)row * 4096 + col) = pk;
                        ss += (v[0] * v[0] + v[1] * v[1]) + (v[2] * v[2] + v[3] * v[3]); }
                ss += __shfl_xor(ss, 16); ss += __shfl_xor(ss, 32);
                if (fq == 0) sspart[(size_t)row * 64 + u.pn * 4 + wc] = ss; }
    }
    __device__ __forceinline__ void fused(f32x4 (&acc)[2][2][4][2], const pg8::Unit& u, int wr, int wc, int fr, int fq, LAS unsigned char* lds, int wid, int lane) const {
#pragma unroll
        for (int ai = 0; ai < 2; ++ai)
#pragma unroll
            for (int m = 0; m < 4; ++m) { const int row = u.pm * 256 + ai * 128 + wr * 64 + m * 16 + fr; float ss = 0.f;
#pragma unroll
                for (int bj = 0; bj < 2; ++bj)
#pragma unroll
                    for (int n = 0; n < 2; ++n) { const f32x4 v = acc[ai][bj][m][n]; ss += (v[0] * v[0] + v[1] * v[1]) + (v[2] * v[2] + v[3] * v[3]); }
                ss += __shfl_xor(ss, 16); ss += __shfl_xor(ss, 32);
                if (fq == 0) sspart[(size_t)row * 64 + u.pn * 4 + wc] = ss; }
        xcd_barrier(xbar);
        LAS float* rsT = (LAS float*)lds;
        { const int tid = wid * 64 + lane, row = tid >> 1, hf = tid & 1;
          const f32x4* p = (const f32x4*)(sspart + (size_t)(u.pm * 256 + row) * 64 + hf * 32);
          float s = 0.f;
#pragma unroll
          for (int i = 0; i < 8; ++i) { const f32x4 v = p[i]; s += (v[0] + v[1]) + (v[2] + v[3]); }
          s += __shfl_xor(s, 1);
          if (hf == 0) rsT[row] = 1.f / sqrtf(s * (1.f / 4096.f) + EPSN); }
        __syncthreads();
#pragma unroll
        for (int ai = 0; ai < 2; ++ai)
#pragma unroll
            for (int m = 0; m < 4; ++m) { const int rl = ai * 128 + wr * 64 + m * 16 + fr, row = u.pm * 256 + rl; const float rs = rsT[rl];
#pragma unroll
                for (int bj = 0; bj < 2; ++bj)
#pragma unroll
                    for (int n = 0; n < 2; ++n) { const int col = u.pn * 256 + bj * 128 + wc * 32 + n * 16 + 4 * fq;
                        const f32x4 xv = *(const f32x4*)(x + (size_t)row * 4096 + col), gv = *(const f32x4*)(gain + col);
                        *(f32x4*)(out + (size_t)row * 4096 + col) = xv + acc[ai][bj][m][n] * rs * gv; }
                asm volatile("" ::: "memory"); }
    }
};
__device__ __forceinline__ void phase6(const Args& a) {
    int tid = threadIdx.x; asm volatile("" : "+v"(tid)); const int lane = tid & 63, w = tid >> 6;
    const float* sspart = (const float*)(a.ws + WS_SS); const bf16_t* t0 = (const bf16_t*)(a.ws + WS_T0);
    for (int row = blockIdx.x * 8 + w; row < 4096; row += gridDim.x * 8) {
        const float ss = wave_sum(sspart[(size_t)row * 64 + lane]);
        const float rs = 1.f / sqrtf(ss * (1.f / 4096.f) + EPSN);
        const u32x4* t4 = (const u32x4*)(t0 + (size_t)row * 4096) + lane; f32x4* o4 = (f32x4*)(a.out + (size_t)row * 4096) + 2 * lane;
        const f32x4* x4 = (const f32x4*)(a.in[0] + (size_t)row * 4096) + 2 * lane; const f32x4* g4 = (const f32x4*)a.in[18] + 2 * lane;
#pragma unroll
        for (int k = 0; k < 8; ++k) { const u32x4 tv = t4[64 * k];
            const f32x4 xa = x4[128 * k], xb = x4[128 * k + 1], ga = g4[128 * k], gb = g4[128 * k + 1];
            f32x4 oa, ob; oa[0] = xa[0] + bflo(tv.x) * rs * ga[0]; oa[1] = xa[1] + bfhi(tv.x) * rs * ga[1]; oa[2] = xa[2] + bflo(tv.y) * rs * ga[2]; oa[3] = xa[3] + bfhi(tv.y) * rs * ga[3];
            ob[0] = xb[0] + bflo(tv.z) * rs * gb[0]; ob[1] = xb[1] + bfhi(tv.z) * rs * gb[1]; ob[2] = xb[2] + bflo(tv.w) * rs * gb[2]; ob[3] = xb[3] + bfhi(tv.w) * rs * gb[3];
            o4[128 * k] = oa; o4[128 * k + 1] = ob; }
    }
}

__global__ void __launch_bounds__(512, 2) mega(Args a) {
    extern __shared__ __attribute__((aligned(16))) unsigned char lds_raw[];
    LAS unsigned char* lds = (LAS unsigned char*)lds_raw;
    cg::grid_group grid = cg::this_grid();
    unsigned char* ws = a.ws;
    volatile LAS unsigned* xst = (volatile LAS unsigned*)(lds + LDS_BYTES - 64);
    if (threadIdx.x < 16) xst[threadIdx.x] = 0u;
    __syncthreads();
    XcdBarrier xbar; xbar.bar = (unsigned*)(ws + WS_CTL); xbar.x = 0; xbar.st = nullptr;
    xbar = xcd_barrier_post((unsigned*)(ws + WS_CTL), xst);
    const int lo = a.ph_lo, hi = a.ph_hi;
#define IN(k) (lo <= (k) && (k) < hi)
#define SEAM(k) do { if (IN(k) && IN((k) + 1)) { if ((k) == 0) { __syncthreads(); grid.sync(); } else xcd_barrier(xbar); } } while (0)
    if (IN(0)) { if (PHMASK & 1) phase0(a, lds); if (REPMASK & 1) { __syncthreads(); phase0(a, lds); } }
    SEAM(0);
    if (IN(1)) { if (PHMASK & 2) {
        pg8::Gemm g{(const bf16_t*)(ws + WS_U), (const bf16_t*)(ws + WS_WT), SEQ + NMEM, INW + 2048, 4096};
        Sched1 S; S.init((int)gridDim.x, (int)blockIdx.x);
        Epi1 E{(bf16_t*)(ws + WS_PROJ), (bf16_t*)(ws + WS_VT), (bf16_t*)(ws + WS_MK), (bf16_t*)(ws + WS_MVT), (const float*)(ws + WS_ROPE)};
        pg8::gemm_phase<Epi1, Sched1, true, true>(lds, g, S, E);
        {
            const int G = (int)gridDim.x, nfull = 1160 % G, nidle = (nfull == 0) ? G : G - nfull;
            const int bi = (nfull == 0) ? (int)blockIdx.x : (int)blockIdx.x - nfull;
            if (bi >= 0) {
                int tid = threadIdx.x; asm volatile("" : "+v"(tid)); const int lane = tid & 63, w = tid >> 6;
                LAS float* scr = (LAS float*)(lds + w * 16384);
                for (int it = bi * 8 + w; it < 64 * (4096 / 32); it += nidle * 8) p0_transpose_item(a.in[17], 4096, 4096, (bf16_t*)(ws + WS_WOUT), 0, scr, it, lane);
            }
        }
        if (REPMASK & 2) { __syncthreads(); pg8::gemm_phase<Epi1, Sched1, true, true>(lds, g, S, E); }
    } }
    SEAM(1);
    if (IN(2)) { if (PHMASK & 4) phase2(a, lds, P2MASK); }
    SEAM(2);
    if (IN(3)) { if (PHMASK & 8) phase3(a, lds); if (REPMASK & 8) { __syncthreads(); phase3(a, lds); } }
    SEAM(3);
    if (IN(4)) { if (PHMASK & 16) phase4(a, lds); if (REPMASK & 16) { __syncthreads(); phase4(a, lds); } }
    SEAM(4);
    if (IN(5)) { if (PHMASK & 32) {
        pg8::Gemm g{(const bf16_t*)(ws + WS_Y), (const bf16_t*)(ws + WS_WOUT), SEQ, 4096, 4096};
        Sched2 S; S.c = (int)blockIdx.x;
        Epi3 E{a.out, (bf16_t*)(ws + WS_T0), (float*)(ws + WS_SS), a.in[0], a.in[18], xbar};
        pg8::gemm_phase<Epi3, Sched2, true, true>(lds, g, S, E);
    } }
    if (IN(6)) { if (PHMASK & 64) phase6(a); }
#if N_LAUNCHES != 1
    if (lo >= 7) phase2(a, lds, 1 << (lo - 7));
#endif
#undef IN
#undef SEAM
}

extern "C" void kernel_launch(void* const* d_in, const int* in_sizes, int n_in, void* d_out, int out_size, void* d_ws, size_t ws_size, hipStream_t stream) {
    static int grid = 0;
    if (grid == 0) {
        if (n_in != 19 || ws_size < WS_END) { fprintf(stderr, "kernel_launch: unexpected n_in %d or ws_size %zu (need %zu)\n", n_in, ws_size, (size_t)WS_END); grid = -1; return; }
        int dev = 0, cus = 0, per_cu = 0;
        hipGetDevice(&dev); hipDeviceGetAttribute(&cus, hipDeviceAttributeMultiprocessorCount, dev);
        if (hipFuncSetAttribute((const void*)mega, hipFuncAttributeMaxDynamicSharedMemorySize, LDS_BYTES) != hipSuccess) { fprintf(stderr, "kernel_launch: hipFuncSetAttribute failed\n"); grid = -1; return; }
        if (hipOccupancyMaxActiveBlocksPerMultiprocessor(&per_cu, (const void*)mega, 512, LDS_BYTES) != hipSuccess || per_cu < 1) { fprintf(stderr, "kernel_launch: occupancy query says %d\n", per_cu); per_cu = 1; }
        (void)hipGetLastError();
        if (cus < 256) { fprintf(stderr, "kernel_launch: needs 256 CUs (one workgroup per CU), device has %d\n", cus); grid = -1; return; }
        grid = 256;
    }
    if (grid < 0) return;
    Args a{};
    for (int i = 0; i < 19; ++i) a.in[i] = (const float*)d_in[i];
    a.out = (float*)d_out; a.ws = (unsigned char*)d_ws;
#if N_LAUNCHES == 1
    (void)hipMemsetAsync((char*)d_ws + WS_CTL, 0, 65536, stream);
    a.ph_lo = 0; a.ph_hi = NPH;
    void* args[] = {&a};
    hipError_t e = hipLaunchCooperativeKernel((const void*)mega, dim3(grid), dim3(512), args, LDS_BYTES, stream);
    if (e != hipSuccess) fprintf(stderr, "cooperative launch failed: %s (grid %d)\n", hipGetErrorString(e), grid);
#else
#ifndef PHSEQ
#define PHSEQ 0,1,2,3,4,5,6
#endif
    { const int seq[] = {PHSEQ};
      for (unsigned i = 0; i < sizeof(seq) / sizeof(int); ++i) { a.ph_lo = seq[i]; a.ph_hi = seq[i] + 1; (void)hipMemsetAsync((char*)d_ws + WS_CTL, 0, 65536, stream); hipLaunchKernelGGL(mega, dim3(grid), dim3(512), LDS_BYTES, stream, a); } }
#endif
}
```

```cpp
#include <hip/hip_runtime.h>
#include <hip/hip_cooperative_groups.h>
#include <cstdio>
#include <cstdint>
namespace cg = cooperative_groups;
#define N_LAUNCHES 1
namespace pg8 {
#define PG8_LAS __attribute__((address_space(3)))
typedef unsigned short bf16_t;
typedef short bf16x8 __attribute__((ext_vector_type(8)));
typedef float f32x4 __attribute__((ext_vector_type(4)));
typedef unsigned u32x4 __attribute__((ext_vector_type(4)));
constexpr int BM = 256, BK = 64, HALF = 128, HTB = HALF * BK * 2  , STAGE_BYTES = 8 * HTB, NXCD = 8, WGM = 8;

__host__ __device__ __forceinline__ int lds_byte(int r, int c) { const int st = (r >> 4) * 2 + (c >> 5), rr = r & 15, cc = c & 31, ob = rr * 64 + cc * 2; return st * 1024 + (ob ^ (((ob >> 9) & 1) << 5)); }
__host__ __device__ __forceinline__ void stage_rc(int b, int& R, int& C) { const int st = b / 1024, sb = b % 1024, swz = sb ^ (((sb >> 9) & 1) << 5); R = (st >> 1) * 16 + swz / 64; C = (st & 1) * 32 + (swz % 64) / 2; }
__host__ __device__ __forceinline__ int perm32(int rho) { const int n = rho >> 4, i = rho & 15; return 8 * (i >> 2) + 4 * n + (i & 3); }

struct Unit { int pm, pn; };
struct Gemm { const bf16_t* A; const bf16_t* Bt; int M, N, K; };

struct StaticOrder {
    int nM, nN, nwg, G, c;
    __host__ __device__ void init(int M, int N, int G_, int c_) { nM = M / BM; nN = N / BM; nwg = nM * nN; G = G_; c = c_; }
    __host__ __device__ bool next(int i, Unit& u) const {
        const long L = (long)i * G + c; if (L >= nwg) return false;
        int wgid = (int)L; { const int q = nwg / NXCD, r = nwg % NXCD, xcd = wgid % NXCD, off = wgid / NXCD; wgid = (xcd < r ? xcd * (q + 1) : r * (q + 1) + (xcd - r) * q) + off; }
        const int nig = WGM * nN, gid = wgid / nig, fm = gid * WGM, gsz = (nM - fm) < WGM ? (nM - fm) : WGM;
        u.pm = fm + ((wgid % nig) % gsz); u.pn = (wgid % nig) / gsz; return true;
    }
    __device__ __forceinline__ void a_ready(const Unit&) const {}
    __device__ __forceinline__ void done(const Unit&) const {}
};

__device__ __forceinline__ unsigned cvt_pk_bf16(float lo, float hi) { unsigned r; asm volatile("v_cvt_pk_bf16_f32 %0, %1, %2" : "=v"(r) : "v"(lo), "v"(hi)); return r; }
typedef float f32x2 __attribute__((ext_vector_type(2)));
__device__ __forceinline__ f32x2 gelu_pk(f32x2 v) {
    const f32x2 av = __builtin_elementwise_abs(v), d = av * 0.2316418882f + 1.0f;
    f32x2 t; t.x = __builtin_amdgcn_rcpf(d.x); t.y = __builtin_amdgcn_rcpf(d.y);
    f32x2 q = t * 0.5307027145f + (-0.7265760135f); q = q * t + 0.7107068705f; q = q * t + (-0.142248368f); q = q * t + 0.127414796f; q = q * t;
    const f32x2 s = (v * v) * (-0.72134752044f);
    f32x2 e; e.x = __builtin_amdgcn_exp2f(s.x); e.y = __builtin_amdgcn_exp2f(s.y);
    const f32x2 m = v * (q * e), r = v - m;
    f32x2 o; o.x = v.x < 0.f ? m.x : r.x; o.y = v.y < 0.f ? m.y : r.y; return o;
}

template <int ACT  > struct EpiBf16 {
    static constexpr bool PERM = true, AFTER_DRAIN = false, HOLD_LAST = false; static_assert(ACT == 0 || ACT == 1, "EpiBf16: ACT is 0 (none) or 1 (gelu_pk)");
    bf16_t* O; int ldc; const float* bias; int split_cols; size_t split_stride; float scale0;
    __device__ __forceinline__ void operator()(const f32x4 (&acc)[2][2][4][2], const Unit& u, int wr, int wc, int fr, int fq) const {
        const int row0 = u.pm * BM + wr * 64 + fr; int colt = u.pn * BM; bf16_t* base = O;
        float sc = 1.f; if (split_cols) { const int t = colt / split_cols; base += (size_t)t * split_stride; colt -= t * split_cols; if (t == 0) sc = scale0; }
        const int col0 = colt + wc * 32 + 8 * fq, bcol0 = u.pn * BM + wc * 32 + 8 * fq;
        f32x4 bv[2][2];
#pragma unroll
        for (int bj = 0; bj < 2; ++bj)
#pragma unroll
            for (int n = 0; n < 2; ++n) bv[bj][n] = bias ? *(const f32x4*)(bias + bcol0 + bj * HALF + 4 * n) : (f32x4){0.f, 0.f, 0.f, 0.f};
#pragma unroll
        for (int ai = 0; ai < 2; ++ai)
#pragma unroll
            for (int m = 0; m < 4; ++m) { bf16_t* rowp = base + (size_t)(row0 + ai * HALF + m * 16) * ldc + col0;
#pragma unroll
                for (int bj = 0; bj < 2; ++bj) { f32x4 v0 = acc[ai][bj][m][0] + bv[bj][0], v1 = acc[ai][bj][m][1] + bv[bj][1];
                    if (ACT == 1) { f32x2 a = gelu_pk((f32x2){v0[0], v0[1]}), b = gelu_pk((f32x2){v0[2], v0[3]}), c = gelu_pk((f32x2){v1[0], v1[1]}), d = gelu_pk((f32x2){v1[2], v1[3]});
                        v0 = (f32x4){a.x, a.y, b.x, b.y}; v1 = (f32x4){c.x, c.y, d.x, d.y}; }
                    v0 = v0 * sc; v1 = v1 * sc; u32x4 w; w.x = cvt_pk_bf16(v0[0], v0[1]); w.y = cvt_pk_bf16(v0[2], v0[3]); w.z = cvt_pk_bf16(v1[0], v1[1]); w.w = cvt_pk_bf16(v1[2], v1[3]);
                    *(u32x4*)(rowp + bj * HALF) = w; } }
    }
};
template <class Epi, class Sched, bool ALIGN_EPI = false, bool SP2 = false>
__device__ __forceinline__ void gemm_phase(PG8_LAS unsigned char* lds, const Gemm g, const Sched& S, const Epi& E) {
    int tid_ = threadIdx.x; asm volatile("" : "+v"(tid_)); const int tid = tid_, wid = __builtin_amdgcn_readfirstlane(tid >> 6), lane = tid & 63, wr = wid >> 2, wc = wid & 3, fr = lane & 15, fq = lane >> 4;
    const int K = g.K, nt = K / BK;
    unsigned voffA[2], voffB[2];
#pragma unroll
    for (int i = 0; i < 2; ++i) { int R, C; stage_rc(tid * 16 + i * 8192, R, C); const int Rb = Epi::PERM ? ((R & ~31) + perm32(R & 31)) : R;
        voffA[i] = (unsigned)(R * K + C) * 2u; voffB[i] = (unsigned)(Rb * K + C) * 2u; }
    const size_t kstep = (size_t)(BK * 2);
    const size_t hstep = (size_t)HALF * K * 2;
    const size_t tstep = 2 * hstep;
    const unsigned ldsw = (unsigned)wid * 1024u;
    const int aoff = lds_byte(wr * 64 + fr, fq * 8), boff = lds_byte(wc * 32 + fr, fq * 8);
#define PG8_SA(b, h) (((b) * 2 + (h)) * HTB)
#define PG8_SB(b, h) ((4 + (b) * 2 + (h)) * HTB)
#define PG8_STAGE(bufoff, gbase, voff) do { _Pragma("unroll") for (int _i = 0; _i < 2; ++_i) \
        __builtin_amdgcn_global_load_lds((const unsigned*)((const char*)(gbase) + (voff)[_i]), (PG8_LAS unsigned*)(lds + (bufoff) + ldsw + _i * 8192), 16, 0, 0); } while (0)
#define PG8_LDA(dst, b, h) do { _Pragma("unroll") for (int m = 0; m < 4; ++m) _Pragma("unroll") for (int k = 0; k < 2; ++k) dst[m][k] = *(const PG8_LAS bf16x8*)(lds + PG8_SA(b, h) + aoff + m * 2048 + k * 1024); } while (0)
#define PG8_LDB(dst, b, h) do { _Pragma("unroll") for (int n = 0; n < 2; ++n) _Pragma("unroll") for (int k = 0; k < 2; ++k) dst[n][k] = *(const PG8_LAS bf16x8*)(lds + PG8_SB(b, h) + boff + n * 2048 + k * 1024); } while (0)
#define PG8_MMA(ai, bj, At, Bt) do { __builtin_amdgcn_s_setprio(1); _Pragma("unroll") for (int m = 0; m < 4; ++m) _Pragma("unroll") for (int n = 0; n < 2; ++n) _Pragma("unroll") for (int k = 0; k < 2; ++k) \
        acc[ai][bj][m][n] = __builtin_amdgcn_mfma_f32_16x16x32_bf16(Bt[n][k], At[m][k], acc[ai][bj][m][n], 0, 0, 0); __builtin_amdgcn_s_setprio(0); } while (0)
#define PG8_WAIT_V(n) asm volatile("s_waitcnt vmcnt(" #n ")" ::: "memory")
#define PG8_WAIT_L(n) asm volatile("s_waitcnt lgkmcnt(" #n ")" ::: "memory")
#define PG8_BAR __builtin_amdgcn_s_barrier()
#define PG8_SCHED __builtin_amdgcn_sched_barrier(0)
    Unit cur, nxt; int ui = 0;
    if (!S.next(0, cur)) return;
    f32x4 acc[2][2][4][2];
#pragma unroll
    for (int a = 0; a < 2; ++a)
#pragma unroll
        for (int b = 0; b < 2; ++b)
#pragma unroll
            for (int m = 0; m < 4; ++m)
#pragma unroll
                for (int n = 0; n < 2; ++n) acc[a][b][m][n] = (f32x4){0.f, 0.f, 0.f, 0.f};
    bf16x8 At[4][2], B0[2][2], B1[2][2];
    const char* cA = (const char*)g.A + (size_t)cur.pm * tstep; const char* cB = (const char*)g.Bt + (size_t)cur.pn * tstep;
    S.a_ready(cur);
    if constexpr (SP2) {
        PG8_STAGE(PG8_SB(0, 0), cB, voffB); PG8_STAGE(PG8_SB(0, 1), cB + hstep, voffB); PG8_STAGE(PG8_SA(0, 0), cA, voffA); PG8_STAGE(PG8_SA(0, 1), cA + hstep, voffA);
        if (wr == 1) PG8_BAR;
        PG8_WAIT_V(2); PG8_BAR;
        PG8_STAGE(PG8_SB(1, 0), cB + kstep, voffB); PG8_STAGE(PG8_SA(1, 0), cA + kstep, voffA); PG8_STAGE(PG8_SB(1, 1), cB + hstep + kstep, voffB);
        PG8_WAIT_V(6); PG8_BAR;
    } else {
        PG8_STAGE(PG8_SB(0, 0), cB, voffB); PG8_STAGE(PG8_SA(0, 0), cA, voffA); PG8_STAGE(PG8_SB(0, 1), cB + hstep, voffB); PG8_STAGE(PG8_SA(0, 1), cA + hstep, voffA);
        if (wr == 1) PG8_BAR;
        PG8_WAIT_V(4); PG8_BAR;
        PG8_STAGE(PG8_SB(1, 0), cB + kstep, voffB); PG8_STAGE(PG8_SA(1, 0), cA + kstep, voffA); PG8_STAGE(PG8_SB(1, 1), cB + hstep + kstep, voffB);
        PG8_WAIT_V(6); PG8_BAR;
    }
    for (;;) {
        const bool has_next = S.next(ui + 1, nxt);
        const char* nA = has_next ? (const char*)g.A + (size_t)nxt.pm * tstep : cA; const char* nB = has_next ? (const char*)g.Bt + (size_t)nxt.pn * tstep : cB;
        for (int t = 0; t < nt; t += 2) {
            const bool last = (t == nt - 2);
            const char* a1 = cA + (size_t)(t + 1) * kstep;
            const char* a2 = last ? nA : cA + (size_t)(t + 2) * kstep; const char* b2 = last ? nB : cB + (size_t)(t + 2) * kstep;
            const char* a3 = a2 + kstep; const char* b3 = b2 + kstep;
            if (last && has_next) S.a_ready(nxt);
            if constexpr (SP2) {
            PG8_LDB(B0, 0, 0); PG8_LDB(B1, 0, 1); PG8_SCHED; PG8_LDA(At, 0, 0); PG8_STAGE(PG8_SA(1, 1), a1 + hstep, voffA);
            PG8_WAIT_V(8); PG8_WAIT_L(0); PG8_BAR; PG8_MMA(0, 0, At, B0); PG8_MMA(0, 1, At, B1); PG8_BAR; PG8_SCHED;
            PG8_LDA(At, 0, 1); PG8_STAGE(PG8_SB(0, 0), b2, voffB); PG8_STAGE(PG8_SB(0, 1), b2 + hstep, voffB); PG8_STAGE(PG8_SA(0, 0), a2, voffA);
            PG8_WAIT_V(8); PG8_WAIT_L(0); PG8_BAR; PG8_MMA(1, 0, At, B0); PG8_MMA(1, 1, At, B1); PG8_BAR; PG8_SCHED;
            PG8_LDB(B0, 1, 0); PG8_LDB(B1, 1, 1); PG8_SCHED; PG8_LDA(At, 1, 0); PG8_STAGE(PG8_SA(0, 1), a2 + hstep, voffA);
            PG8_WAIT_V(8); PG8_WAIT_L(0); PG8_BAR; PG8_MMA(0, 0, At, B0); PG8_MMA(0, 1, At, B1); PG8_BAR; PG8_SCHED;
            PG8_LDA(At, 1, 1); PG8_STAGE(PG8_SB(1, 0), b3, voffB); PG8_STAGE(PG8_SB(1, 1), b3 + hstep, voffB); PG8_STAGE(PG8_SA(1, 0), a3, voffA);
            PG8_WAIT_V(8); PG8_WAIT_L(0); PG8_BAR; PG8_MMA(1, 0, At, B0); PG8_MMA(1, 1, At, B1); PG8_BAR; PG8_SCHED;
            } else {
            PG8_LDB(B0, 0, 0); PG8_SCHED; PG8_LDA(At, 0, 0); PG8_STAGE(PG8_SA(1, 1), a1 + hstep, voffA);
            PG8_WAIT_L(8); PG8_BAR; PG8_WAIT_L(0); PG8_MMA(0, 0, At, B0); PG8_BAR; PG8_SCHED;
            PG8_LDB(B1, 0, 1); PG8_STAGE(PG8_SB(0, 0), b2, voffB);
            PG8_BAR; PG8_WAIT_L(0); PG8_MMA(0, 1, At, B1); PG8_BAR;
            PG8_LDA(At, 0, 1); PG8_STAGE(PG8_SA(0, 0), a2, voffA);
            PG8_BAR; PG8_WAIT_L(0); PG8_MMA(1, 0, At, B0); PG8_BAR; PG8_SCHED;
            PG8_STAGE(PG8_SB(0, 1), b2 + hstep, voffB);
            PG8_WAIT_V(6); PG8_BAR; PG8_MMA(1, 1, At, B1); PG8_BAR;
            PG8_LDB(B0, 1, 0); PG8_SCHED; PG8_LDA(At, 1, 0); PG8_STAGE(PG8_SA(0, 1), a2 + hstep, voffA);
            PG8_WAIT_L(8); PG8_BAR; PG8_WAIT_L(0); PG8_MMA(0, 0, At, B0); PG8_BAR; PG8_SCHED;
            PG8_LDB(B1, 1, 1); PG8_STAGE(PG8_SB(1, 0), b3, voffB);
            PG8_BAR; PG8_WAIT_L(0); PG8_MMA(0, 1, At, B1); PG8_BAR;
            PG8_LDA(At, 1, 1); PG8_STAGE(PG8_SA(1, 0), a3, voffA);
            PG8_BAR; PG8_WAIT_L(0); PG8_MMA(1, 0, At, B0); PG8_BAR; PG8_SCHED;
            PG8_STAGE(PG8_SB(1, 1), b3 + hstep, voffB);
            PG8_WAIT_V(6); PG8_BAR; PG8_MMA(1, 1, At, B1); PG8_BAR;
            }
        }
        if constexpr (ALIGN_EPI) { if (wr == 0) PG8_BAR; }
        if constexpr (!Epi::AFTER_DRAIN) { if (!Epi::HOLD_LAST || has_next) { E(acc, cur, wr, wc, fr, fq); S.done(cur); } }
        if (!has_next) break;
#pragma unroll
        for (int a = 0; a < 2; ++a)
#pragma unroll
            for (int b = 0; b < 2; ++b)
#pragma unroll
                for (int m = 0; m < 4; ++m)
#pragma unroll
                    for (int n = 0; n < 2; ++n) acc[a][b][m][n] = (f32x4){0.f, 0.f, 0.f, 0.f};
        cur = nxt; cA = nA; cB = nB; ++ui;
        if constexpr (ALIGN_EPI) { if (wr == 1) PG8_BAR; }
    }
    PG8_WAIT_V(0);
    if constexpr (!ALIGN_EPI) { if (wr == 0) PG8_BAR; }
    PG8_BAR;
    if constexpr (Epi::AFTER_DRAIN || Epi::HOLD_LAST) { E.fused(acc, cur, wr, wc, fr, fq, lds, wid, lane); S.done(cur); }
#undef PG8_SA
#undef PG8_SB
#undef PG8_STAGE
#undef PG8_LDA
#undef PG8_LDB
#undef PG8_MMA
#undef PG8_WAIT_V
#undef PG8_WAIT_L
#undef PG8_BAR
#undef PG8_SCHED
}
}

#ifndef PHMASK
#define PHMASK 127
#endif
#ifndef REPMASK
#define REPMASK 0
#endif
#ifndef P2MASK
#define P2MASK 7
#endif
#ifndef N_LAUNCHES
#define N_LAUNCHES 1
#endif
using pg8::bf16_t; using pg8::bf16x8; using pg8::f32x4; using pg8::u32x4;
#define LAS __attribute__((address_space(3)))
typedef unsigned u32x2 __attribute__((ext_vector_type(2)));
typedef float f32x2 __attribute__((ext_vector_type(2)));

constexpr int SEQ = 8192, DMODEL = 4096, INW = 9216, NMEM = 256;
constexpr int C_QA = 0, C_KA = 2048, C_VA = 2560, C_XL = 3072, C_QM = 4096, C_ZA = 5120, C_ZL = 7168, C_ZM = 8192;
constexpr float EPSN = 1e-6f;
constexpr float LOG2E = 1.4426950408889634f;
constexpr float SC_ATT = 0.08838834764831845f * LOG2E;
constexpr float SC_MEM = 0.0625f * LOG2E;
constexpr int NPH = 7;
constexpr int LDS_BYTES = 147456;

constexpr size_t MiB = 1u << 20;
constexpr size_t WS_CTL = 0, WS_LRUW = 1 * MiB, WS_ROPE = 2 * MiB, WS_MK = 3 * MiB, WS_MVT = 3 * MiB + 512 * 1024, WS_SS = 4 * MiB,
                 WS_AGG1 = 6 * MiB, WS_AGG2 = 10 * MiB, WS_VT = 12 * MiB, WS_WOUT = 20 * MiB, WS_WT = 52 * MiB, WS_U = 140 * MiB,
                 WS_PROJ = 206 * MiB, WS_HS = 350 * MiB, WS_PP = 382 * MiB, WS_YATT = 414 * MiB, WS_YMEM = 446 * MiB, WS_T0 = 462 * MiB, WS_END = 494 * MiB;
constexpr size_t WS_Y = WS_U;

struct Args { const float* in[19]; float* out; unsigned char* ws; int ph_lo, ph_hi; };

__device__ __forceinline__ unsigned pk2(float lo, float hi) { return pg8::cvt_pk_bf16(lo, hi); }
__device__ __forceinline__ float bflo(unsigned u) { return __builtin_bit_cast(float, u << 16); }
__device__ __forceinline__ float bfhi(unsigned u) { return __builtin_bit_cast(float, u & 0xffff0000u); }
__device__ __forceinline__ float wave_sum(float v) {
#pragma unroll
    for (int o = 1; o < 64; o <<= 1) v += __shfl_xor(v, o);
    return v;
}
__device__ __forceinline__ float fexp2(float x) { return __builtin_amdgcn_exp2f(x); }
__device__ __forceinline__ float sigmoidf_(float x) { return 1.f / (1.f + __expf(-x)); }
__device__ __forceinline__ float fsigmoid(float x) { return __builtin_amdgcn_rcpf(1.f + __builtin_amdgcn_exp2f(-x * 1.4426950408889634f)); }
__device__ __forceinline__ f32x4 mfma16(bf16x8 a, bf16x8 b, f32x4 c) { return __builtin_amdgcn_mfma_f32_16x16x32_bf16(a, b, c, 0, 0, 0); }

__device__ __forceinline__ void p0_transpose_item(const float* W, int K, int N, bf16_t* WT, int row_off, LAS float* scr, int item, int lane) {
    const int nblk = N / 32, kb = item / nblk, nb = item % nblk, k0 = 64 * kb, n0 = 32 * nb;
#pragma unroll 8
    for (int i = 0; i < 32; ++i) { const int kk = 2 * i + (lane >> 5); scr[kk * 33 + (lane & 31)] = W[(size_t)(k0 + kk) * N + n0 + (lane & 31)]; }
    asm volatile("s_waitcnt lgkmcnt(0)" ::: "memory");
    const int c = lane & 7;
#pragma unroll
    for (int j = 0; j < 4; ++j) { const int n = (lane >> 3) + 8 * j; const LAS float* s = scr + (8 * c) * 33 + n;
        u32x4 o; o.x = pk2(s[0 * 33], s[1 * 33]); o.y = pk2(s[2 * 33], s[3 * 33]); o.z = pk2(s[4 * 33], s[5 * 33]); o.w = pk2(s[6 * 33], s[7 * 33]);
        *(u32x4*)(WT + (size_t)(row_off + n0 + n) * K + k0 + 8 * c) = o; }
    asm volatile("s_waitcnt lgkmcnt(0)" ::: "memory");
}
__device__ __forceinline__ void rms_row_to_bf16(const float* xrow, const float* gain, bf16_t* orow, int lane) {
    const f32x4* xr = (const f32x4*)xrow + lane;
    f32x4 v[16]; float s = 0.f;
#pragma unroll
    for (int k = 0; k < 16; ++k) { v[k] = xr[64 * k]; s += (v[k].x * v[k].x + v[k].y * v[k].y) + (v[k].z * v[k].z + v[k].w * v[k].w); }
    const float rs = 1.f / sqrtf(wave_sum(s) * (1.f / 4096.f) + EPSN);
    const f32x4* gr = (const f32x4*)gain + lane; u32x2* o8 = (u32x2*)orow + lane;
#pragma unroll
    for (int k = 0; k < 16; ++k) { const f32x4 g4 = gr[64 * k]; u32x2 o; o.x = pk2(v[k].x * rs * g4.x, v[k].y * rs * g4.y); o.y = pk2(v[k].z * rs * g4.z, v[k].w * rs * g4.w); o8[64 * k] = o; }
}

__device__ __forceinline__ void phase0(const Args& a, LAS unsigned char* lds) {
    int tid = threadIdx.x; asm volatile("" : "+v"(tid)); const int lane = tid & 63, w = tid >> 6, G = gridDim.x;
    const int gw = blockIdx.x * 8 + w, NGW = G * 8;
    unsigned char* ws = a.ws;
    LAS float* scr = (LAS float*)(lds + w * 16384);
    bf16_t* WT = (bf16_t*)(ws + WS_WT); bf16_t* WOUT = (bf16_t*)(ws + WS_WOUT); bf16_t* LRUW = (bf16_t*)(ws + WS_LRUW);
    constexpr int I_IN = 64 * (INW / 32), I_MKV = 64 * (2048 / 32), I_OUT = 64 * (4096 / 32), I_LRU = 32 * 8;
    constexpr int NITEMS = I_IN + I_MKV + I_LRU;
    for (int it = gw; it < NITEMS; it += NGW) {
        int r = it;
        if (r < I_IN) { p0_transpose_item(a.in[3], 4096, INW, WT, 0, scr, r, lane); continue; } r -= I_IN;
        if (r < I_MKV) { p0_transpose_item(a.in[13], 4096, 2048, WT, INW, scr, r, lane); continue; } r -= I_MKV;
        { const int mat = r >> 3, sub = r & 7, gate = mat >> 4, dn = mat & 15;
          const float* src = (gate ? a.in[9] : a.in[7]) + (size_t)dn * 16384;
          p0_transpose_item(src, 128, 128, LRUW + (size_t)mat * 16384, 0, scr, sub, lane); }
    }
    bf16_t* U = (bf16_t*)(ws + WS_U);
    for (int m = gw; m < SEQ + NMEM; m += NGW) {
        if (m < SEQ) rms_row_to_bf16(a.in[0] + (size_t)m * 4096, a.in[2], U + (size_t)m * 4096, lane);
        else rms_row_to_bf16(a.in[1] + (size_t)(m - SEQ) * 4096, a.in[12], U + (size_t)m * 4096, lane);
    }
    f32x2* rope = (f32x2*)(ws + WS_ROPE);
    for (int e = blockIdx.x * 512 + tid; e < SEQ * 16; e += G * 512) {
        const int pos = e >> 4, i = e & 15;
        const float inv = powf(500000.0f, -(float)i * (1.0f / 16.0f));
        const float ang = (float)pos * inv;
        rope[e] = (f32x2){cosf(ang), sinf(ang)};
    }
}

struct Sched1 {
    pg8::StaticOrder so; int G, c;
    __device__ void init(int G_, int c_) { so.init(SEQ, INW, G_, c_); G = G_; c = c_; }
    __device__ bool next(int i, pg8::Unit& u) const {
        const long L = (long)i * G + c;
        if (L < 1152) return so.next(i, u);
        if (L < 1160) { u.pm = 32; u.pn = 36 + (int)(L - 1152); return true; }
        return false;
    }
    __device__ __forceinline__ void a_ready(const pg8::Unit&) const {}
    __device__ __forceinline__ void done(const pg8::Unit&) const {}
};
struct Epi1 {
    static constexpr bool PERM = true, AFTER_DRAIN = false, HOLD_LAST = false;
    bf16_t* proj; bf16_t* vt; bf16_t* mk; bf16_t* mvt; const float* rope;
    __device__ __forceinline__ void operator()(const f32x4 (&acc)[2][2][4][2], const pg8::Unit& u, int wr, int wc, int fr, int fq) const {
        const int rloc = wr * 64 + fr, cloc = wc * 32 + 8 * fq;
        if (u.pm == 32) {
            const int t = u.pn - 36;
            if (t < 4) {
#pragma unroll
                for (int ai = 0; ai < 2; ++ai)
#pragma unroll
                    for (int m = 0; m < 4; ++m) { const int row = rloc + ai * 128 + m * 16;
#pragma unroll
                        for (int bj = 0; bj < 2; ++bj) { const f32x4 v0 = acc[ai][bj][m][0], v1 = acc[ai][bj][m][1];
                            u32x4 wv; wv.x = pk2(v0[0], v0[1]); wv.y = pk2(v0[2], v0[3]); wv.z = pk2(v1[0], v1[1]); wv.w = pk2(v1[2], v1[3]);
                            *(u32x4*)(mk + (size_t)row * 1024 + t * 256 + bj * 128 + cloc) = wv; } asm volatile("" ::: "memory"); }
            } else {
#pragma unroll
                for (int ai = 0; ai < 2; ++ai)
#pragma unroll
                    for (int m = 0; m < 4; ++m) { const int row = rloc + ai * 128 + m * 16;
#pragma unroll
                        for (int bj = 0; bj < 2; ++bj)
#pragma unroll
                            for (int n = 0; n < 2; ++n)
#pragma unroll
                                for (int i = 0; i < 4; ++i) { const int col = (t - 4) * 256 + bj * 128 + cloc + 4 * n + i;
                                    mvt[(size_t)col * 256 + row] = (bf16_t)(pk2(acc[ai][bj][m][n][i], 0.f) & 0xffffu); } asm volatile("" ::: "memory"); }
            }
            return;
        }
        const int pn = u.pn, row0 = u.pm * 256 + rloc;
        if (pn == 10 || pn == 11) {
#pragma unroll
            for (int ai = 0; ai < 2; ++ai)
#pragma unroll
                for (int m = 0; m < 4; ++m) { const int row = row0 + ai * 128 + m * 16;
#pragma unroll
                    for (int bj = 0; bj < 2; ++bj)
#pragma unroll
                        for (int n = 0; n < 2; ++n)
#pragma unroll
                            for (int i = 0; i < 4; ++i) { const int col = (pn - 10) * 256 + bj * 128 + cloc + 4 * n + i;
                                vt[(size_t)col * SEQ + row] = (bf16_t)(pk2(acc[ai][bj][m][n][i], 0.f) & 0xffffu); } asm volatile("" ::: "memory"); }
            return;
        }
        float sc = 1.f; if (pn < 8) sc = SC_ATT; else if (pn >= 16 && pn < 20) sc = SC_MEM;
        const bool do_rope = (pn < 10) && (wc == 0);
        const float sgn = (fq < 2) ? -1.f : 1.f;
#pragma unroll
        for (int ai = 0; ai < 2; ++ai)
#pragma unroll
            for (int m = 0; m < 4; ++m) { const int row = row0 + ai * 128 + m * 16;
                f32x4 cs[2][2];
                if (do_rope) {
#pragma unroll
                    for (int n = 0; n < 2; ++n) { const float* rp = rope + ((size_t)row * 16 + 8 * (fq & 1) + 4 * n) * 2; cs[n][0] = *(const f32x4*)rp; cs[n][1] = *(const f32x4*)(rp + 4); }
                }
#pragma unroll
                for (int bj = 0; bj < 2; ++bj) { f32x4 v[2]; v[0] = acc[ai][bj][m][0]; v[1] = acc[ai][bj][m][1];
                    if (do_rope) {
#pragma unroll
                        for (int n = 0; n < 2; ++n) { f32x4 p; p[0] = __shfl_xor(v[n][0], 32); p[1] = __shfl_xor(v[n][1], 32); p[2] = __shfl_xor(v[n][2], 32); p[3] = __shfl_xor(v[n][3], 32);
                            f32x4 r; r[0] = v[n][0] * cs[n][0][0] + sgn * p[0] * cs[n][0][1]; r[1] = v[n][1] * cs[n][0][2] + sgn * p[1] * cs[n][0][3];
                            r[2] = v[n][2] * cs[n][1][0] + sgn * p[2] * cs[n][1][1]; r[3] = v[n][3] * cs[n][1][2] + sgn * p[3] * cs[n][1][3]; v[n] = r; }
                    }
                    u32x4 wv; wv.x = pk2(v[0][0] * sc, v[0][1] * sc); wv.y = pk2(v[0][2] * sc, v[0][3] * sc); wv.z = pk2(v[1][0] * sc, v[1][1] * sc); wv.w = pk2(v[1][2] * sc, v[1][3] * sc);
                    *(u32x4*)(proj + (size_t)row * INW + pn * 256 + bj * 128 + cloc) = wv; } asm volatile("" ::: "memory"); }
    }
};

template <int DH, bool PF, bool DB>
__device__ __forceinline__ void attn_unit(LAS unsigned char* lds, const bf16_t* Qp, int ldq, bf16_t* Op, int ldo, const bf16_t* Kg, int ldk, const bf16_t* Vtg, int ldv,
                                          int cb_lo, int cb_hi, int cb_self, float m_init, float l_init) {
    constexpr int PR = DH / 8, KROW = DH * 2, KT = 128 * KROW, VROW = 288, NKI = (128 * PR) / 512, NVI = (DH * 16) / 512, NS = DH / 32, NDT = DH / 16;
    int tid = threadIdx.x; asm volatile("" : "+v"(tid)); const int lane = tid & 63, w = tid >> 6, q = lane & 15, g = lane >> 4;
    const int krow = 8 * (q >> 2) + (q & 3);
    bf16x8 qf[NS];
    { const unsigned qoff = (unsigned)(((16 * w + q) * ldq + 8 * g) * 2);
#pragma unroll
      for (int s = 0; s < NS; ++s) qf[s] = *(const bf16x8*)((const char*)Qp + qoff + 64 * s); }
    f32x4 o[NDT];
#pragma unroll
    for (int dt = 0; dt < NDT; ++dt) o[dt] = (f32x4){0.f, 0.f, 0.f, 0.f};
    float m_run = m_init, l_run = l_init;
    u32x4 kreg[NKI], vreg[NVI];
#define ATT_LOAD(cb) do { const int k0_ = (cb) * 128; \
        const char* kb_ = (const char*)Kg + (size_t)k0_ * ldk * 2; const char* vb_ = (const char*)Vtg + (size_t)k0_ * 2; \
        _Pragma("unroll") for (int it = 0; it < NKI; ++it) { const int e = tid + 512 * it; const int key = e / PR, pc = e % PR; \
            kreg[it] = *(const u32x4*)(kb_ + (unsigned)((key * ldk + pc * 8) * 2)); } \
        _Pragma("unroll") for (int it = 0; it < NVI; ++it) { const int e = tid + 512 * it; const int d = e >> 4, pc = e & 15; \
            vreg[it] = *(const u32x4*)(vb_ + (unsigned)((d * ldv + pc * 8) * 2)); } } while (0)
#define ATT_STORE() do { \
        _Pragma("unroll") for (int it = 0; it < NKI; ++it) { const int e = tid + 512 * it; const int key = e / PR, pc = e % PR; \
            *(LAS u32x4*)(lds + key * KROW + ((pc ^ ((((key >> 3) & 3) << 2) | (key & 3))) * 16)) = kreg[it]; } \
        _Pragma("unroll") for (int it = 0; it < NVI; ++it) { const int e = tid + 512 * it; const int d = e >> 4, pc = e & 15; \
            *(LAS u32x4*)(lds + KT + d * VROW + pc * 16) = vreg[it]; } } while (0)
    if (PF) ATT_LOAD(cb_lo);
    for (int cb = cb_lo; cb < cb_hi; ++cb) {
        if (!PF) ATT_LOAD(cb);
        __syncthreads();
        ATT_STORE();
        __syncthreads();
        if (PF) { if (cb + 1 < cb_hi) ATT_LOAD(cb + 1); }
        f32x4 s[8];
#pragma unroll
        for (int kt = 0; kt < 8; ++kt) s[kt] = (f32x4){0.f, 0.f, 0.f, 0.f};
        {
            bf16x8 ka[DB ? 2 : 1][8];
            if (DB) {
#pragma unroll
                for (int kt = 0; kt < 8; ++kt) ka[0][kt] = *(const LAS bf16x8*)(lds + (32 * (kt >> 1) + 4 * (kt & 1) + krow) * KROW + (((0 + g) ^ q) * 16));
            }
#pragma unroll
            for (int ss = 0; ss < NS; ++ss) {
                if (DB) { if (ss + 1 < NS) {
#pragma unroll
                    for (int kt = 0; kt < 8; ++kt) ka[(ss + 1) & 1][kt] = *(const LAS bf16x8*)(lds + (32 * (kt >> 1) + 4 * (kt & 1) + krow) * KROW + (((4 * (ss + 1) + g) ^ q) * 16)); }
                } else {
#pragma unroll
                    for (int kt = 0; kt < 8; ++kt) ka[0][kt] = *(const LAS bf16x8*)(lds + (32 * (kt >> 1) + 4 * (kt & 1) + krow) * KROW + (((4 * ss + g) ^ q) * 16));
                }
                __builtin_amdgcn_sched_barrier(0);
#pragma unroll
                for (int kt = 0; kt < 8; ++kt) s[kt] = mfma16(ka[DB ? (ss & 1) : 0][kt], qf[ss], s[kt]);
                __builtin_amdgcn_sched_barrier(0);
            }
        }
        if (cb != cb_self && cb_self >= 0) {
            const float sg = (cb < cb_self) ? 1.f : -1.f;
            const float dq = (float)(16 * w + q - 8 * g);
#pragma unroll
            for (int kt = 0; kt < 8; ++kt)
#pragma unroll
                for (int j = 0; j < 4; ++j) { const float v = sg * ((float)(32 * (kt >> 1) + 4 * (kt & 1) + j) - dq); s[kt][j] += fminf(v, 0.f) * 1e30f; }
        }
        float mx = s[0][0];
#pragma unroll
        for (int kt = 0; kt < 8; ++kt)
#pragma unroll
            for (int j = 0; j < 4; ++j) mx = fmaxf(mx, s[kt][j]);
        mx = fmaxf(mx, __shfl_xor(mx, 16)); mx = fmaxf(mx, __shfl_xor(mx, 32));
        const float m_new = fmaxf(m_run, mx), alpha = fexp2(m_run - m_new); m_run = m_new;
        float rs = 0.f;
#pragma unroll
        for (int kt = 0; kt < 8; ++kt)
#pragma unroll
            for (int j = 0; j < 4; ++j) { const float p = fexp2(s[kt][j] - m_new); s[kt][j] = p; rs += p; }
        rs += __shfl_xor(rs, 16); rs += __shfl_xor(rs, 32);
        l_run = l_run * alpha + rs;
        bf16x8 pb[4];
#pragma unroll
        for (int u = 0; u < 4; ++u) { u32x4 t; t.x = pk2(s[2 * u][0], s[2 * u][1]); t.y = pk2(s[2 * u][2], s[2 * u][3]); t.z = pk2(s[2 * u + 1][0], s[2 * u + 1][1]); t.w = pk2(s[2 * u + 1][2], s[2 * u + 1][3]);
            pb[u] = __builtin_bit_cast(bf16x8, t); }
#pragma unroll
        for (int dt = 0; dt < NDT; ++dt) o[dt] = o[dt] * alpha;
        {
            constexpr int NG = (NDT / 8) * 4;
            u32x4 va[DB ? 2 : 1][8];
#define ATT_VLOAD(buf, gi) do { const int u_ = (gi) & 3, d0_ = 8 * ((gi) >> 2); \
            _Pragma("unroll") for (int i = 0; i < 8; ++i) { va[buf][i] = *(const LAS u32x4*)(lds + KT + (16 * (d0_ + i) + q) * VROW + (32 * u_ + 8 * g) * 2); } } while (0)
            if (DB) ATT_VLOAD(0, 0);
#pragma unroll
            for (int gi = 0; gi < NG; ++gi) {
                if (DB) { if (gi + 1 < NG) ATT_VLOAD((gi + 1) & 1, gi + 1); } else ATT_VLOAD(0, gi);
                __builtin_amdgcn_sched_barrier(0);
#pragma unroll
                for (int i = 0; i < 8; ++i) o[8 * (gi >> 2) + i] = mfma16(__builtin_bit_cast(bf16x8, va[DB ? (gi & 1) : 0][i]), pb[gi & 3], o[8 * (gi >> 2) + i]);
                __builtin_amdgcn_sched_barrier(0);
            }
#undef ATT_VLOAD
        }
    }
#undef ATT_LOAD
#undef ATT_STORE
    const float inv = 1.f / l_run;
    const unsigned ooff = (unsigned)(((16 * w + q) * ldo + 4 * g) * 2);
#pragma unroll
    for (int dt = 0; dt < NDT; ++dt) { u32x2 pkv; pkv.x = pk2(o[dt][0] * inv, o[dt][1] * inv); pkv.y = pk2(o[dt][2] * inv, o[dt][3] * inv); *(u32x2*)((char*)Op + ooff + 32 * dt) = pkv; }
}

__device__ __forceinline__ void windowed_stream(LAS unsigned char* lds0, const Args& a) {
    constexpr int DH = 128, PR = 16, KROW = 256, KT = 128 * KROW, VROW = 288, BUFB = KT + DH * VROW, NKI = 4, NVI = 4, NS = 4, NDT = 8;
    static_assert(2 * BUFB <= LDS_BYTES - 64, "two K/V tile buffers must fit under the barrier words");
    int tid = threadIdx.x; asm volatile("" : "+v"(tid)); const int lane = tid & 63, w = tid >> 6, q = lane & 15, g = lane >> 4;
    const int krow = 8 * (q >> 2) + (q & 3);
    unsigned char* ws = a.ws;
    const bf16_t* proj = (const bf16_t*)(ws + WS_PROJ); const bf16_t* vt = (const bf16_t*)(ws + WS_VT); bf16_t* yatt = (bf16_t*)(ws + WS_YATT);
    const int G = (int)gridDim.x;
    if ((int)blockIdx.x >= 1024) return;
    unsigned koff[NKI], voff[NVI], klds[NKI], vlds[NVI];
#pragma unroll
    for (int it = 0; it < NKI; ++it) { const int e = tid + 512 * it, key = e / PR, pc = e % PR; koff[it] = (unsigned)((key * INW + pc * 8) * 2); klds[it] = (unsigned)(key * KROW + ((pc ^ ((((key >> 3) & 3) << 2) | (key & 3))) * 16)); }
#pragma unroll
    for (int it = 0; it < NVI; ++it) { const int e = tid + 512 * it, d = e >> 4, pc = e & 15; voff[it] = (unsigned)((d * SEQ + pc * 8) * 2); vlds[it] = (unsigned)(KT + d * VROW + pc * 16); }
    u32x4 kreg[NKI], vreg[NVI];
#define WS_LOAD(v_, cb_) do { const int kvh_ = ((v_) & 15) >> 2; \
        const char* kb_ = (const char*)proj + ((size_t)((cb_) * 128) * INW + C_KA + kvh_ * 128) * 2; const char* vb_ = (const char*)vt + ((size_t)(kvh_ * 128) * SEQ + (cb_) * 128) * 2; \
        _Pragma("unroll") for (int it = 0; it < NKI; ++it) kreg[it] = *(const u32x4*)(kb_ + koff[it]); \
        _Pragma("unroll") for (int it = 0; it < NVI; ++it) vreg[it] = *(const u32x4*)(vb_ + voff[it]); } while (0)
#define WS_STORE(ldsb_) do { \
        _Pragma("unroll") for (int it = 0; it < NKI; ++it) *(LAS u32x4*)((ldsb_) + klds[it]) = kreg[it]; \
        _Pragma("unroll") for (int it = 0; it < NVI; ++it) *(LAS u32x4*)((ldsb_) + vlds[it]) = vreg[it]; } while (0)
#define WS_LO(v_) ((((v_) >> 4) > 0) ? ((v_) >> 4) - 1 : 0)
#define WS_HI(v_) ((((v_) >> 4) < 63) ? ((v_) >> 4) + 2 : 64)
    int Cv = (int)blockIdx.x, Ccb = WS_LO(Cv);
    int Lv = Cv, Lcb = Ccb; bool Lvalid = true;
#define WS_ADV_L() do { if (Lcb + 1 < WS_HI(Lv)) ++Lcb; else { Lv += G; if (Lv < 1024) Lcb = WS_LO(Lv); else Lvalid = false; } } while (0)
    __syncthreads();
    WS_LOAD(Lv, Lcb); WS_ADV_L();
    WS_STORE(lds0);
    bool have = false;
    if (Lvalid) { WS_LOAD(Lv, Lcb); WS_ADV_L(); have = true; }
    __syncthreads();
    int bsel = 0;
    bf16x8 qf[NS]; f32x4 o[NDT]; float m_run = 0.f, l_run = 1.f;
#pragma unroll 1
    for (;;) {
        const int qblk = Cv >> 4, hq = Cv & 15, lo = WS_LO(Cv), hi = WS_HI(Cv);
        LAS unsigned char* lds = lds0 + bsel * BUFB;
        if (Ccb == lo) {
            const unsigned qoff = (unsigned)(((16 * w + q) * INW + 8 * g) * 2);
            const char* qb = (const char*)proj + ((size_t)(qblk * 128) * INW + C_QA + hq * 128) * 2;
#pragma unroll
            for (int s = 0; s < NS; ++s) qf[s] = *(const bf16x8*)(qb + qoff + 64 * s);
#pragma unroll
            for (int dt = 0; dt < NDT; ++dt) o[dt] = (f32x4){0.f, 0.f, 0.f, 0.f};
            m_run = a.in[4][hq] * LOG2E; l_run = 1.f;
        }
        if (have) { WS_STORE(lds0 + (bsel ^ 1) * BUFB); have = false; }
        if (Lvalid) { WS_LOAD(Lv, Lcb); WS_ADV_L(); have = true; }
        f32x4 s[8];
#pragma unroll
        for (int kt = 0; kt < 8; ++kt) s[kt] = (f32x4){0.f, 0.f, 0.f, 0.f};
        {
            bf16x8 ka[2][8];
#pragma unroll
            for (int kt = 0; kt < 8; ++kt) ka[0][kt] = *(const LAS bf16x8*)(lds + (32 * (kt >> 1) + 4 * (kt & 1) + krow) * KROW + (((0 + g) ^ q) * 16));
#pragma unroll
            for (int ss = 0; ss < NS; ++ss) {
                if (ss + 1 < NS) {
#pragma unroll
                    for (int kt = 0; kt < 8; ++kt) ka[(ss + 1) & 1][kt] = *(const LAS bf16x8*)(lds + (32 * (kt >> 1) + 4 * (kt & 1) + krow) * KROW + (((4 * (ss + 1) + g) ^ q) * 16)); }
                __builtin_amdgcn_sched_barrier(0);
#pragma unroll
                for (int kt = 0; kt < 8; ++kt) s[kt] = mfma16(ka[ss & 1][kt], qf[ss], s[kt]);
                __builtin_amdgcn_sched_barrier(0);
            }
        }
        if (Ccb != qblk) {
            const float sg = (Ccb < qblk) ? 1.f : -1.f;
            const float dq = (float)(16 * w + q - 8 * g);
#pragma unroll
            for (int kt = 0; kt < 8; ++kt)
#pragma unroll
                for (int j = 0; j < 4; ++j) { const float v = sg * ((float)(32 * (kt >> 1) + 4 * (kt & 1) + j) - dq); s[kt][j] += fminf(v, 0.f) * 1e30f; }
        }
        float mx = s[0][0];
#pragma unroll
        for (int kt = 0; kt < 8; ++kt)
#pragma unroll
            for (int j = 0; j < 4; ++j) mx = fmaxf(mx, s[kt][j]);
        mx = fmaxf(mx, __shfl_xor(mx, 16)); mx = fmaxf(mx, __shfl_xor(mx, 32));
        const float m_new = fmaxf(m_run, mx), alpha = fexp2(m_run - m_new); m_run = m_new;
        float rs = 0.f;
#pragma unroll
        for (int kt = 0; kt < 8; ++kt)
#pragma unroll
            for (int j = 0; j < 4; ++j) { const float p = fexp2(s[kt][j] - m_new); s[kt][j] = p; rs += p; }
        rs += __shfl_xor(rs, 16); rs += __shfl_xor(rs, 32);
        l_run = l_run * alpha + rs;
        bf16x8 pb[4];
#pragma unroll
        for (int u = 0; u < 4; ++u) { u32x4 t; t.x = pk2(s[2 * u][0], s[2 * u][1]); t.y = pk2(s[2 * u][2], s[2 * u][3]); t.z = pk2(s[2 * u + 1][0], s[2 * u + 1][1]); t.w = pk2(s[2 * u + 1][2], s[2 * u + 1][3]);
            pb[u] = __builtin_bit_cast(bf16x8, t); }
#pragma unroll
        for (int dt = 0; dt < NDT; ++dt) o[dt] = o[dt] * alpha;
        {
            u32x4 va[2][8];
#define WS_VLOAD(buf, gi) do { _Pragma("unroll") for (int i = 0; i < 8; ++i) { va[buf][i] = *(const LAS u32x4*)(lds + KT + (16 * i + q) * VROW + (32 * (gi) + 8 * g) * 2); } } while (0)
            WS_VLOAD(0, 0);
#pragma unroll
            for (int gi = 0; gi < 4; ++gi) {
                if (gi + 1 < 4) WS_VLOAD((gi + 1) & 1, gi + 1);
                __builtin_amdgcn_sched_barrier(0);
#pragma unroll
                for (int i = 0; i < 8; ++i) o[i] = mfma16(__builtin_bit_cast(bf16x8, va[gi & 1][i]), pb[gi], o[i]);
                __builtin_amdgcn_sched_barrier(0);
            }
#undef WS_VLOAD
        }
        bool done = false;
        if (Ccb + 1 < hi) ++Ccb;
        else {
            const float inv = 1.f / l_run;
            char* ob = (char*)yatt + ((size_t)(qblk * 128) * 2048 + hq * 128) * 2;
            const unsigned ooff = (unsigned)(((16 * w + q) * 2048 + 4 * g) * 2);
#pragma unroll
            for (int dt = 0; dt < NDT; ++dt) { u32x2 pkv; pkv.x = pk2(o[dt][0] * inv, o[dt][1] * inv); pkv.y = pk2(o[dt][2] * inv, o[dt][3] * inv); *(u32x2*)(ob + ooff + 32 * dt) = pkv; }
            Cv += G; if (Cv < 1024) Ccb = WS_LO(Cv); else done = true;
        }
        __syncthreads();
        bsel ^= 1;
        if (done) break;
    }
#undef WS_LOAD
#undef WS_STORE
#undef WS_LO
#undef WS_HI
#undef WS_ADV_L
}

constexpr int LR_XCB = 0, LR_TA = 16384, LR_TB = LR_TA + 64 * 528, LR_TH = LR_TB + 64 * 528, LR_AGS = LR_TH + 64 * 528;
__device__ __forceinline__ void lru_phase(LAS unsigned char* lds, const Args& a, const int n, const int tt_first, const int tt_step) {
    int tid = threadIdx.x; asm volatile("" : "+v"(tid)); const int lane = tid & 63, w = tid >> 6, q = lane & 15, g = lane >> 4;
    unsigned char* ws = a.ws;
    const bf16_t* proj = (const bf16_t*)(ws + WS_PROJ);
    LAS unsigned char* xcb = lds + LR_XCB;
    LAS float* TA = (LAS float*)(lds + LR_TA); LAS float* TB = (LAS float*)(lds + LR_TB); LAS float* TH = (LAS float*)(lds + LR_TH);
    LAS f32x2* AGS = (LAS f32x2*)(lds + LR_AGS);
    const bf16_t* lruw = (const bf16_t*)(ws + WS_LRUW);
    f32x2* agg1 = (f32x2*)(ws + WS_AGG1);
    bf16_t* Pout = (bf16_t*)(ws + WS_PP);
    bf16x8 fa[2][4], fx[2][4];
    const int chl = 16 * w + 4 * g;
#pragma unroll
    for (int dir = 0; dir < 2; ++dir) {
        const bf16_t* wa = lruw + (size_t)((0 * 2 + dir) * 8 + n) * 16384 + (16 * w + q) * 128 + 8 * g;
        const bf16_t* wx = lruw + (size_t)((1 * 2 + dir) * 8 + n) * 16384 + (16 * w + q) * 128 + 8 * g;
#pragma unroll
        for (int s = 0; s < 4; ++s) { fa[dir][s] = *(const bf16x8*)(wa + 32 * s); fx[dir][s] = *(const bf16x8*)(wx + 32 * s); }
    }
    const int cg8 = tid & 15, t2 = tid >> 4, ch0 = n * 128 + cg8 * 8;
    LAS float* CW = (LAS float*)(lds + LR_AGS + 4096);
    __syncthreads();
    if (tid < 128) {
#pragma unroll
        for (int j = 0; j < 4; ++j) CW[j * 128 + tid] = a.in[5][j * 1024 + n * 128 + tid];
        CW[512 + tid] = a.in[6][n * 128 + tid];
    } else if (tid < 384) {
        const int d2 = (tid - 128) >> 7, c = tid & 127, cg = d2 * 1024 + n * 128 + c;
        const float xl = -a.in[11][cg];
        CW[640 + (d2 * 3 + 0) * 128 + c] = a.in[8][cg]; CW[640 + (d2 * 3 + 1) * 128 + c] = a.in[10][cg];
        CW[640 + (d2 * 3 + 2) * 128 + c] = fmaxf(xl, 0.f) + log1pf(expf(-fabsf(xl)));
    }
    u32x4 xr[5];
#define LRU_XLOAD(tt_) do { _Pragma("unroll") for (int r = 0; r < 5; ++r) { const int t = (tt_) * 64 + 2 * t2 - 2 + r; xr[r] = (u32x4){0u, 0u, 0u, 0u}; \
        if (t >= 0 && t < SEQ) xr[r] = *(const u32x4*)((const char*)proj + (unsigned)((t * INW + C_XL + ch0) * 2)); } } while (0)
    if (tt_first < 128) LRU_XLOAD(tt_first);
#pragma unroll 1
    for (int tt = tt_first; tt < 128; tt += tt_step) {
    const int t0 = tt * 64;
    __syncthreads();
    {
        float xin[5][8];
#pragma unroll
        for (int r = 0; r < 5; ++r) { const u32x4 v = xr[r];
            xin[r][0] = bflo(v.x); xin[r][1] = bfhi(v.x); xin[r][2] = bflo(v.y); xin[r][3] = bfhi(v.y); xin[r][4] = bflo(v.z); xin[r][5] = bfhi(v.z); xin[r][6] = bflo(v.w); xin[r][7] = bfhi(v.w); }
        float wv[4][8], bias[8];
#pragma unroll
        for (int j = 0; j < 4; ++j) { const f32x4 w0 = *(const LAS f32x4*)(CW + j * 128 + cg8 * 8), w1 = *(const LAS f32x4*)(CW + j * 128 + cg8 * 8 + 4);
            wv[j][0] = w0[0]; wv[j][1] = w0[1]; wv[j][2] = w0[2]; wv[j][3] = w0[3]; wv[j][4] = w1[0]; wv[j][5] = w1[1]; wv[j][6] = w1[2]; wv[j][7] = w1[3]; }
        { const f32x4 b0 = *(const LAS f32x4*)(CW + 512 + cg8 * 8), b1 = *(const LAS f32x4*)(CW + 512 + cg8 * 8 + 4);
          bias[0] = b0[0]; bias[1] = b0[1]; bias[2] = b0[2]; bias[3] = b0[3]; bias[4] = b1[0]; bias[5] = b1[1]; bias[6] = b1[2]; bias[7] = b1[3]; }
#pragma unroll
        for (int o = 0; o < 2; ++o) { float y[8];
#pragma unroll
            for (int e = 0; e < 8; ++e) { float v = bias[e];
#pragma unroll
                for (int j = 0; j < 4; ++j) v += wv[j][e] * xin[o + j][e];
                y[e] = v; }
            const int tok = 2 * t2 + o;
            u32x4 pk; pk.x = pk2(y[0], y[1]); pk.y = pk2(y[2], y[3]); pk.z = pk2(y[4], y[5]); pk.w = pk2(y[6], y[7]);
            *(LAS u32x4*)(xcb + tok * 256 + ((cg8 ^ (tok & 15)) * 16)) = pk; }
    }
    if (tt + tt_step < 128) LRU_XLOAD(tt + tt_step);
    __syncthreads();
#pragma unroll
    for (int dir = 0; dir < 2; ++dir) {
        {
            const f32x4 ba = *(const LAS f32x4*)(CW + 640 + (dir * 3 + 0) * 128 + chl), bx = *(const LAS f32x4*)(CW + 640 + (dir * 3 + 1) * 128 + chl), sp = *(const LAS f32x4*)(CW + 640 + (dir * 3 + 2) * 128 + chl);
#pragma unroll
            for (int tk = 0; tk < 4; ++tk) { const int tok = 16 * tk + q;
                f32x4 ar = (f32x4){0.f, 0.f, 0.f, 0.f}, ai = (f32x4){0.f, 0.f, 0.f, 0.f};
#pragma unroll
                for (int s = 0; s < 4; ++s) {
                    const bf16x8 xb = *(const LAS bf16x8*)(xcb + tok * 256 + (((4 * s + g) ^ q) * 16));
                    ar = mfma16(fa[dir][s], xb, ar); ai = mfma16(fx[dir][s], xb, ai); }
                const u32x2 xr2 = *(const LAS u32x2*)(xcb + tok * 256 + ((((chl >> 3)) ^ q) * 16) + (chl & 7) * 2);
                const float xc0 = bflo(xr2.x), xc1 = bfhi(xr2.x), xc2 = bflo(xr2.y), xc3 = bfhi(xr2.y);
                f32x4 av, bv;
#pragma unroll
                for (int j = 0; j < 4; ++j) { const float r = fsigmoid(ar[j] + ba[j]), ii = fsigmoid(ai[j] + bx[j]);
                    const float la = -8.0f * r * sp[j]; const float aa = fexp2(la * LOG2E); av[j] = aa;
                    const float x2 = 2.0f * la;
                    const float poly = x2 * (1.f + x2 * (0.5f + x2 * ((1.f / 6.f) + x2 * ((1.f / 24.f) + x2 * ((1.f / 120.f) + x2 * (1.f / 720.f))))));
                    const float om = (x2 > -0.25f) ? -poly : (1.f - aa * aa);
                    const float xcj = j == 0 ? xc0 : (j == 1 ? xc1 : (j == 2 ? xc2 : xc3));
                    bv[j] = __builtin_amdgcn_sqrtf(om) * ii * xcj; }
                *(LAS f32x4*)(TA + tok * 132 + chl) = av; *(LAS f32x4*)(TB + tok * 132 + chl) = bv; }
        }
        __syncthreads();
        const int ch = tid & 127, sub = tid >> 7;
        {
            float h = 0.f, P = 1.f;
#pragma unroll
            for (int i = 0; i < 16; ++i) { const int t = 16 * sub + (dir ? 15 - i : i);
                const float av = TA[t * 132 + ch], bv = TB[t * 132 + ch]; h = av * h + bv; P *= av; TB[t * 132 + ch] = h; TA[t * 132 + ch] = P; }
            AGS[sub * 128 + ch] = (f32x2){P, h};
        }
        __syncthreads();
        {
            float hc = 0.f, Pp = 1.f, At = 1.f, Ht = 0.f;
#pragma unroll
            for (int s = 0; s < 4; ++s) { const int s2 = dir ? 3 - s : s; const f32x2 e = AGS[s2 * 128 + ch];
                const bool before = dir ? (s2 > sub) : (s2 < sub);
                if (before) { hc = e.x * hc + e.y; Pp *= e.x; }
                Ht = e.x * Ht + e.y; At *= e.x; }
            bf16_t* pp = Pout + (size_t)dir * ((size_t)SEQ * 1024) + (size_t)(t0 + 16 * sub) * 1024 + n * 128 + ch;
#pragma unroll
            for (int i = 0; i < 16; ++i) { const int t = 16 * sub + i;
                const float Pl = TA[t * 132 + ch], hl = TB[t * 132 + ch];
                const float hfull = hl + Pl * hc;
                if (dir == 0) TH[t * 132 + ch] = hfull; else TH[t * 132 + ch] += hfull;
                pp[(size_t)i * 1024] = (bf16_t)(pk2(Pl * Pp, 0.f) & 0xffffu); }
            if (sub == 0) agg1[(size_t)(dir * 1024 + n * 128 + ch) * 128 + tt] = (f32x2){At, Ht};
        }
        __syncthreads();
    }
    {
        float* hs = (float*)(ws + WS_HS);
#pragma unroll
        for (int i = 0; i < 4; ++i) { const int e = tid + 512 * i, t = e >> 5, c4 = e & 31;
            *(f32x4*)(hs + (size_t)(t0 + t) * 1024 + n * 128 + 4 * c4) = *(const LAS f32x4*)(TH + t * 132 + 4 * c4); }
    }
    }
#undef LRU_XLOAD
}

__device__ __forceinline__ void phase2(const Args& a, LAS unsigned char* lds, int p2mask) {
    unsigned char* ws = a.ws;
    bf16_t* proj = (bf16_t*)(ws + WS_PROJ); const bf16_t* vt = (const bf16_t*)(ws + WS_VT);
    const bf16_t* mk = (const bf16_t*)(ws + WS_MK); const bf16_t* mvt = (const bf16_t*)(ws + WS_MVT);
    bf16_t* yatt = (bf16_t*)(ws + WS_YATT); bf16_t* ymem = (bf16_t*)(ws + WS_YMEM);
    if (p2mask & 1)
    for (int u = blockIdx.x; u < 256; u += gridDim.x) {
        const int qblk = u >> 2, hm = u & 3;
        attn_unit<256, false, false>(lds, proj + (size_t)(qblk * 128) * INW + C_QM + hm * 256, INW, ymem + (size_t)(qblk * 128) * 1024 + hm * 256, 1024, mk + hm * 256, 1024, mvt + (size_t)(hm * 256) * 256, 256, 0, 2, -100, -1e30f, 0.f);
    }
    if (p2mask & 2) windowed_stream(lds, a);
    if (p2mask & 4)
    { const int G = gridDim.x; const bool al = (G & 7) == 0; const int nrep = al ? 1 : 8;
#pragma unroll 1
      for (int rep = 0; rep < nrep; ++rep) lru_phase(lds, a, al ? (int)(blockIdx.x & 7) : rep, al ? (int)(blockIdx.x >> 3) : (int)blockIdx.x, al ? (G >> 3) : G); }
}

__device__ __forceinline__ void phase3(const Args& a, LAS unsigned char* lds) {
    unsigned char* ws = a.ws;
    const f32x2* agg1 = (const f32x2*)(ws + WS_AGG1); f32x2* agg2 = (f32x2*)(ws + WS_AGG2);
    for (int e = blockIdx.x * 512 + threadIdx.x; e < 2 * 1024 * 16; e += gridDim.x * 512) {
        const int sc = e & 15, dc = e >> 4, dir = dc >> 10;
        const f32x4* p = (const f32x4*)(agg1 + (size_t)dc * 128 + sc * 8);
        f32x4 v[4];
#pragma unroll
        for (int i = 0; i < 4; ++i) v[i] = p[i];
        float A = 1.f, H = 0.f;
        if (dir == 0) {
#pragma unroll
            for (int i = 0; i < 4; ++i) { H = v[i][0] * H + v[i][1]; A *= v[i][0]; H = v[i][2] * H + v[i][3]; A *= v[i][2]; }
        } else {
#pragma unroll
            for (int i = 3; i >= 0; --i) { H = v[i][2] * H + v[i][3]; A *= v[i][2]; H = v[i][0] * H + v[i][1]; A *= v[i][0]; }
        }
        agg2[(size_t)dc * 16 + sc] = (f32x2){A, H};
    }
}

__device__ __forceinline__ float silu_(float z) { return z * __builtin_amdgcn_rcpf(1.f + __builtin_amdgcn_exp2f(-z * 1.4426950408889634f)); }
__device__ __forceinline__ void phase4(const Args& a, LAS unsigned char* lds) {
    unsigned char* ws = a.ws;
    const f32x2* agg1 = (const f32x2*)(ws + WS_AGG1); const f32x2* agg2 = (const f32x2*)(ws + WS_AGG2);
    const bf16_t* proj = (const bf16_t*)(ws + WS_PROJ); bf16_t* Y = (bf16_t*)(ws + WS_Y);
    const bf16_t* yatt = (const bf16_t*)(ws + WS_YATT); const bf16_t* ymem = (const bf16_t*)(ws + WS_YMEM);
    const float* hs = (const float*)(ws + WS_HS); const bf16_t* Pf = (const bf16_t*)(ws + WS_PP); const bf16_t* Pb = Pf + (size_t)SEQ * 1024;
    LAS float* car = (LAS float*)lds;
    int tid = threadIdx.x; asm volatile("" : "+v"(tid)); const int lane = tid & 63, w = tid >> 6;
    for (int u = blockIdx.x; u < 256; u += gridDim.x) {
        const int tile = u >> 1, sc = tile >> 3, cj = tile & 7;
        __syncthreads();
#pragma unroll 1
        for (int half = 0; half < 2; ++half) {
            const int c = tid + 512 * half;
            float hf = 0.f, hb = 0.f;
            { const f32x4* p2 = (const f32x4*)(agg2 + (size_t)c * 16); const f32x4* p1 = (const f32x4*)(agg1 + (size_t)c * 128 + sc * 8);
              f32x4 e2[8], e1[4];
#pragma unroll
              for (int i = 0; i < 8; ++i) e2[i] = p2[i];
#pragma unroll
              for (int i = 0; i < 4; ++i) e1[i] = p1[i];
#pragma unroll
              for (int i = 0; i < 8; ++i) { if (2 * i < sc) hf = e2[i][0] * hf + e2[i][1]; if (2 * i + 1 < sc) hf = e2[i][2] * hf + e2[i][3]; }
#pragma unroll
              for (int i = 0; i < 4; ++i) { if (2 * i < cj) hf = e1[i][0] * hf + e1[i][1]; if (2 * i + 1 < cj) hf = e1[i][2] * hf + e1[i][3]; } }
            { const f32x4* p2 = (const f32x4*)(agg2 + (size_t)(1024 + c) * 16); const f32x4* p1 = (const f32x4*)(agg1 + (size_t)(1024 + c) * 128 + sc * 8);
              f32x4 e2[8], e1[4];
#pragma unroll
              for (int i = 0; i < 8; ++i) e2[i] = p2[i];
#pragma unroll
              for (int i = 0; i < 4; ++i) e1[i] = p1[i];
#pragma unroll
              for (int i = 7; i >= 0; --i) { if (2 * i + 1 > sc) hb = e2[i][2] * hb + e2[i][3]; if (2 * i > sc) hb = e2[i][0] * hb + e2[i][1]; }
#pragma unroll
              for (int i = 3; i >= 0; --i) { if (2 * i + 1 > cj) hb = e1[i][2] * hb + e1[i][3]; if (2 * i > cj) hb = e1[i][0] * hb + e1[i][1]; } }
            car[c] = hf; car[1024 + c] = hb;
        }
        __syncthreads();
        f32x4 cf[4], cb[4];
#pragma unroll
        for (int k = 0; k < 4; ++k) { cf[k] = *(const LAS f32x4*)(car + 4 * lane + 256 * k); cb[k] = *(const LAS f32x4*)(car + 1024 + 4 * lane + 256 * k); }
#pragma unroll 1
        for (int tk = 0; tk < 4; tk += 2) {
            const int tA = u * 32 + 4 * w + tk;
            const char* hsb = (const char*)hs; const char* pfb = (const char*)Pf; const char* pbb = (const char*)Pb;
            const char* yab = (const char*)yatt; const char* ymb = (const char*)ymem; const char* prb = (const char*)proj; char* yb = (char*)Y;
            f32x4 h4[2][4]; u32x2 pf[2][4], pb[2][4]; u32x4 va[2][4], vm[2][2];
#pragma unroll
            for (int e = 0; e < 2; ++e) { const unsigned t = (unsigned)(tA + e);
                const unsigned o_h = t * 4096u + 16u * lane, o_p = t * 2048u + 8u * lane, o_m = t * 2048u + 16u * lane;
#pragma unroll
                for (int k = 0; k < 4; ++k) { h4[e][k] = *(const f32x4*)(hsb + o_h + 1024u * k); pf[e][k] = *(const u32x2*)(pfb + o_p + 512u * k); pb[e][k] = *(const u32x2*)(pbb + o_p + 512u * k); va[e][k] = *(const u32x4*)(yab + o_h + 1024u * k); }
#pragma unroll
                for (int k = 0; k < 2; ++k) vm[e][k] = *(const u32x4*)(ymb + o_m + 1024u * k); }
            __builtin_amdgcn_sched_barrier(0);
            f32x4 v[2][4]; float ssl[2], ssa[2], ssm[2];
#pragma unroll
            for (int e = 0; e < 2; ++e) { ssl[e] = 0.f; ssa[e] = 0.f; ssm[e] = 0.f;
#pragma unroll
                for (int k = 0; k < 4; ++k) {
                    v[e][k][0] = h4[e][k][0] + bflo(pf[e][k].x) * cf[k][0] + bflo(pb[e][k].x) * cb[k][0]; v[e][k][1] = h4[e][k][1] + bfhi(pf[e][k].x) * cf[k][1] + bfhi(pb[e][k].x) * cb[k][1];
                    v[e][k][2] = h4[e][k][2] + bflo(pf[e][k].y) * cf[k][2] + bflo(pb[e][k].y) * cb[k][2]; v[e][k][3] = h4[e][k][3] + bfhi(pf[e][k].y) * cf[k][3] + bfhi(pb[e][k].y) * cb[k][3];
                    ssl[e] += (v[e][k][0] * v[e][k][0] + v[e][k][1] * v[e][k][1]) + (v[e][k][2] * v[e][k][2] + v[e][k][3] * v[e][k][3]);
                    { const float f0 = bflo(va[e][k].x), f1 = bfhi(va[e][k].x), f2 = bflo(va[e][k].y), f3 = bfhi(va[e][k].y), f4 = bflo(va[e][k].z), f5 = bfhi(va[e][k].z), f6 = bflo(va[e][k].w), f7 = bfhi(va[e][k].w);
                      ssa[e] += ((f0 * f0 + f1 * f1) + (f2 * f2 + f3 * f3)) + ((f4 * f4 + f5 * f5) + (f6 * f6 + f7 * f7)); } }
#pragma unroll
                for (int k = 0; k < 2; ++k) { const float f0 = bflo(vm[e][k].x), f1 = bfhi(vm[e][k].x), f2 = bflo(vm[e][k].y), f3 = bfhi(vm[e][k].y), f4 = bflo(vm[e][k].z), f5 = bfhi(vm[e][k].z), f6 = bflo(vm[e][k].w), f7 = bfhi(vm[e][k].w);
                    ssm[e] += ((f0 * f0 + f1 * f1) + (f2 * f2 + f3 * f3)) + ((f4 * f4 + f5 * f5) + (f6 * f6 + f7 * f7)); } }
#pragma unroll
            for (int o = 1; o < 64; o <<= 1) {
#pragma unroll
                for (int e = 0; e < 2; ++e) { ssl[e] += __shfl_xor(ssl[e], o); ssa[e] += __shfl_xor(ssa[e], o); ssm[e] += __shfl_xor(ssm[e], o); } }
#pragma unroll 1
            for (int e = 0; e < 2; ++e) {
                const unsigned t = (unsigned)(tA + e);
                const unsigned o_pr = t * (unsigned)(INW * 2), o_y = t * 8192u;
                const float rsl = 1.f / sqrtf((e ? ssl[1] : ssl[0]) * (1.f / 1024.f) + EPSN), rsa = 1.f / sqrtf((e ? ssa[1] : ssa[0]) * (1.f / 2048.f) + EPSN), rsm = 1.f / sqrtf((e ? ssm[1] : ssm[0]) * (1.f / 1024.f) + EPSN);
#pragma unroll
                for (int k = 0; k < 4; ++k) { const int c = 4 * lane + 256 * k; const f32x4 g4 = *(const f32x4*)(a.in[15] + c); const u32x2 z = *(const u32x2*)(prb + o_pr + (unsigned)((C_ZL + c) * 2));
                    const f32x4 vv = e ? v[1][k] : v[0][k];
                    u32x2 o; o.x = pk2(vv[0] * rsl * g4[0] * silu_(bflo(z.x)), vv[1] * rsl * g4[1] * silu_(bfhi(z.x))); o.y = pk2(vv[2] * rsl * g4[2] * silu_(bflo(z.y)), vv[3] * rsl * g4[3] * silu_(bfhi(z.y)));
                    *(u32x2*)(yb + o_y + (unsigned)((2048 + c) * 2)) = o; }
                __builtin_amdgcn_sched_barrier(0);
#pragma unroll
                for (int k = 0; k < 4; ++k) { const int c = 8 * lane + 512 * k; const f32x4 g0 = *(const f32x4*)(a.in[14] + c), g1 = *(const f32x4*)(a.in[14] + c + 4); const u32x4 z = *(const u32x4*)(prb + o_pr + (unsigned)((C_ZA + c) * 2));
                    const u32x4 av = e ? va[1][k] : va[0][k];
                    u32x4 o; o.x = pk2(bflo(av.x) * rsa * g0[0] * silu_(bflo(z.x)), bfhi(av.x) * rsa * g0[1] * silu_(bfhi(z.x)));
                    o.y = pk2(bflo(av.y) * rsa * g0[2] * silu_(bflo(z.y)), bfhi(av.y) * rsa * g0[3] * silu_(bfhi(z.y)));
                    o.z = pk2(bflo(av.z) * rsa * g1[0] * silu_(bflo(z.z)), bfhi(av.z) * rsa * g1[1] * silu_(bfhi(z.z)));
                    o.w = pk2(bflo(av.w) * rsa * g1[2] * silu_(bflo(z.w)), bfhi(av.w) * rsa * g1[3] * silu_(bfhi(z.w)));
                    *(u32x4*)(yb + o_y + (unsigned)(c * 2)) = o; }
                __builtin_amdgcn_sched_barrier(0);
#pragma unroll
                for (int k = 0; k < 2; ++k) { const int c = 8 * lane + 512 * k; const f32x4 g0 = *(const f32x4*)(a.in[16] + c), g1 = *(const f32x4*)(a.in[16] + c + 4); const u32x4 z = *(const u32x4*)(prb + o_pr + (unsigned)((C_ZM + c) * 2));
                    const u32x4 mv = e ? vm[1][k] : vm[0][k];
                    u32x4 o; o.x = pk2(bflo(mv.x) * rsm * g0[0] * silu_(bflo(z.x)), bfhi(mv.x) * rsm * g0[1] * silu_(bfhi(z.x)));
                    o.y = pk2(bflo(mv.y) * rsm * g0[2] * silu_(bflo(z.y)), bfhi(mv.y) * rsm * g0[3] * silu_(bfhi(z.y)));
                    o.z = pk2(bflo(mv.z) * rsm * g1[0] * silu_(bflo(z.z)), bfhi(mv.z) * rsm * g1[1] * silu_(bfhi(z.z)));
                    o.w = pk2(bflo(mv.w) * rsm * g1[2] * silu_(bflo(z.w)), bfhi(mv.w) * rsm * g1[3] * silu_(bfhi(z.w)));
                    *(u32x4*)(yb + o_y + (unsigned)((3072 + c) * 2)) = o; }
            }
        }
    }
}

#define XB_TMO      128
#define XB_XCNT(j)  (256  + 64 * (j))
#define XB_XSUB(j)  (1280 + 64 * (j))
#define XB_XGEN(j)  (2304 + 64 * (j))
#define XB_TOP      3328
#define XB_TOPGEN   3392
#define XCD_BAR_WORDS 3456
#define XB_SPIN_CAP (1u << 18)

__device__ __forceinline__ unsigned xb_ld(unsigned* p)              { return __hip_atomic_load(p, __ATOMIC_RELAXED, __HIP_MEMORY_SCOPE_AGENT); }
__device__ __forceinline__ unsigned xb_add(unsigned* p, unsigned v) { return __hip_atomic_fetch_add(p, v, __ATOMIC_RELAXED, __HIP_MEMORY_SCOPE_AGENT); }
__device__ __forceinline__ unsigned xb_xcc_id() { return (unsigned)__builtin_amdgcn_s_getreg((3 << 11) | 20) & 0xFu; }
#define XB_SPIN(cond, bar) do { unsigned _sp = 0; while (cond) { __builtin_amdgcn_s_sleep(1); \
    if ((++_sp & 255u) == 0u) { if (xb_ld(&(bar)[XB_TMO])) break; if (_sp > XB_SPIN_CAP) { atomicAdd(&(bar)[XB_TMO], 1u); break; } } } } while (0)

struct XcdBarrier {
    unsigned* bar; unsigned x;
    volatile LAS unsigned* st;
};

__device__ __forceinline__ XcdBarrier xcd_barrier_post(unsigned* bar, volatile LAS unsigned* st) {
    XcdBarrier b; b.bar = bar; b.x = xb_xcc_id(); b.st = st;
    if (threadIdx.x == 0) (void)xb_add(&bar[XB_XCNT(b.x)], 1u);
    return b;
}
__device__ __forceinline__ void xcd_barrier_complete(unsigned* bar, unsigned x, unsigned& nloc, unsigned& nx) {
    const unsigned G = gridDim.x * gridDim.y * gridDim.z;
    unsigned sum, cnt, mine, sp = 0u;
    for (;;) {
        sum = 0u; cnt = 0u; mine = 0u;
#pragma unroll
        for (unsigned j = 0; j < 16; ++j) { const unsigned c = xb_ld(&bar[XB_XCNT(j)]); sum += c; cnt += (c > 0u) ? 1u : 0u; mine = (j == x) ? c : mine; }
        if (sum == G) break;
        __builtin_amdgcn_s_sleep(1);
        if ((++sp & 255u) == 0u) { if (xb_ld(&bar[XB_TMO])) break; if (sp > XB_SPIN_CAP) { atomicAdd(&bar[XB_TMO], 1u); break; } }
    }
    nloc = mine > 0u ? mine : 1u; nx = cnt > 0u ? cnt : 1u;
}

__device__ __forceinline__ void xcd_barrier(const XcdBarrier& b) {
    asm volatile("s_waitcnt vmcnt(0)" ::: "memory");
    __syncthreads();
    if (threadIdx.x == 0) {
        unsigned* bar = b.bar;
        __builtin_amdgcn_s_waitcnt(0);
        unsigned nloc = b.st[0], nx = b.st[1];
        if (nloc == 0u) { xcd_barrier_complete(bar, b.x, nloc, nx); b.st[0] = nloc; b.st[1] = nx; }
        const unsigned old = xb_add(&bar[XB_XSUB(b.x)], 1u);
        const unsigned gen = old / nloc;
        if (old + 1u == (gen + 1u) * nloc) {
            __builtin_amdgcn_fence(__ATOMIC_RELEASE, "agent");
            asm volatile("s_waitcnt vmcnt(0)" ::: "memory");
            const unsigned og = xb_add(&bar[XB_TOP], 1u);
            const unsigned tg = og / nx;
            if (og + 1u == (tg + 1u) * nx) xb_add(&bar[XB_TOPGEN], 1u);
            else XB_SPIN(xb_ld(&bar[XB_TOPGEN]) == tg, bar);
            __builtin_amdgcn_fence(__ATOMIC_ACQUIRE, "agent");
            xb_add(&bar[XB_XGEN(b.x)], 1u);
            asm volatile("s_waitcnt vmcnt(0)" ::: "memory");
        } else {
            XB_SPIN(xb_ld(&bar[XB_XGEN(b.x)]) == gen, bar);
            __builtin_amdgcn_fence(__ATOMIC_ACQUIRE, "agent");
            asm volatile("s_waitcnt vmcnt(0)" ::: "memory");
        }
    }
    __syncthreads();
}

struct Sched2 {
    int c;
    __device__ bool next(int i, pg8::Unit& u) const {
        if (i >= 2) return false;
        const int x = c & 7, j = c >> 3;
        u.pm = i * 16 + 4 * (x >> 1) + (j & 3); u.pn = 8 * (x & 1) + (j >> 2); return true;
    }
    __device__ __forceinline__ void a_ready(const pg8::Unit&) const {}
    __device__ __forceinline__ void done(const pg8::Unit&) const {}
};
struct Epi3 {
    static constexpr bool PERM = true, AFTER_DRAIN = false, HOLD_LAST = true;
    float* out; bf16_t* t0; float* sspart; const float* x; const float* gain; XcdBarrier xbar;
    __device__ __forceinline__ void operator()(const f32x4 (&acc)[2][2][4][2], const pg8::Unit& u, int wr, int wc, int fr, int fq) const {
#pragma unroll
        for (int ai = 0; ai < 2; ++ai)
#pragma unroll
            for (int m = 0; m < 4; ++m) { const int row = u.pm * 256 + ai * 128 + wr * 64 + m * 16 + fr; float ss = 0.f;
#pragma unroll
                for (int bj = 0; bj < 2; ++bj) { const f32x4 v0 = acc[ai][bj][m][0], v1 = acc[ai][bj][m][1]; const int col = u.pn * 256 + bj * 128 + wc * 32 + 8 * fq;
                    u32x4 pk; pk.x = pk2(v0[0], v0[1]); pk.y = pk2(v0[2], v0[3]); pk.z = pk2(v1[0], v1[1]); pk.w = pk2(v1[2], v1[3]); *(u32x4*)(t0 + (size_t)row * 4096 + col) = pk;
                    ss += ((v0[0] * v0[0] + v0[1] * v0[1]) + (v0[2] * v0[2] + v0[3] * v0[3])) + ((v1[0] * v1[0] + v1[1] * v1[1]) + (v1[2] * v1[2] + v1[3] * v1[3])); }
                ss += __shfl_xor(ss, 16); ss += __shfl_xor(ss, 32);
                if (fq == 0) sspart[(size_t)row * 64 + u.pn * 4 + wc] = ss; }
    }
    __device__ __forceinline__ void fused(f32x4 (&acc)[2][2][4][2], const pg8::Unit& u, int wr, int wc, int fr, int fq, LAS unsigned char* lds, int wid, int lane) const {
#pragma unroll
        for (int ai = 0; ai < 2; ++ai)
#pragma unroll
            for (int m = 0; m < 4; ++m) { const int row = u.pm * 256 + ai * 128 + wr * 64 + m * 16 + fr; float ss = 0.f;
#pragma unroll
                for (int bj = 0; bj < 2; ++bj)
#pragma unroll
                    for (int n = 0; n < 2; ++n) { const f32x4 v = acc[ai][bj][m][n]; ss += (v[0] * v[0] + v[1] * v[1]) + (v[2] * v[2] + v[3] * v[3]); }
                ss += __shfl_xor(ss, 16); ss += __shfl_xor(ss, 32);
                if (fq == 0) sspart[(size_t)row * 64 + u.pn * 4 + wc] = ss; }
        xcd_barrier(xbar);
        constexpr int TP = 260;
        LAS float* T = (LAS float*)lds;
        LAS float* rsT = (LAS float*)(lds + 128 * TP * 4);
        { const int tid = wid * 64 + lane, row = tid >> 1, hf = tid & 1;
          const f32x4* p = (const f32x4*)(sspart + (size_t)(u.pm * 256 + row) * 64 + hf * 32);
          float s = 0.f;
#pragma unroll
          for (int i = 0; i < 8; ++i) { const f32x4 v = p[i]; s += (v[0] + v[1]) + (v[2] + v[3]); }
          s += __shfl_xor(s, 1);
          if (hf == 0) rsT[row] = 1.f / sqrtf(s * (1.f / 4096.f) + EPSN); }
        const f32x4 gv = *(const f32x4*)(gain + u.pn * 256 + 4 * lane);
#pragma unroll
        for (int ai = 0; ai < 2; ++ai) {
            __syncthreads();
#pragma unroll
            for (int m = 0; m < 4; ++m)
#pragma unroll
                for (int bj = 0; bj < 2; ++bj)
#pragma unroll
                    for (int n = 0; n < 2; ++n) *(LAS f32x4*)(T + (wr * 64 + m * 16 + fr) * TP + bj * 128 + wc * 32 + 8 * fq + 4 * n) = acc[ai][bj][m][n];
            __syncthreads();
#pragma unroll 4
            for (int r = 0; r < 16; ++r) { const int rl = wid * 16 + r; const size_t go = (size_t)(u.pm * 256 + ai * 128 + rl) * 4096 + u.pn * 256 + 4 * lane;
                const f32x4 tv = *(const LAS f32x4*)(T + rl * TP + 4 * lane); const float rs = rsT[ai * 128 + rl];
                const f32x4 xv = *(const f32x4*)(x + go);
                *(f32x4*)(out + go) = xv + tv * rs * gv; }
        }
    }
};
__device__ __forceinline__ void phase6(const Args& a) {
    int tid = threadIdx.x; asm volatile("" : "+v"(tid)); const int lane = tid & 63, w = tid >> 6;
    const float* sspart = (const float*)(a.ws + WS_SS); const bf16_t* t0 = (const bf16_t*)(a.ws + WS_T0);
    for (int row = blockIdx.x * 8 + w; row < 4096; row += gridDim.x * 8) {
        const float ss = wave_sum(sspart[(size_t)row * 64 + lane]);
        const float rs = 1.f / sqrtf(ss * (1.f / 4096.f) + EPSN);
        const u32x4* t4 = (const u32x4*)(t0 + (size_t)row * 4096) + lane; f32x4* o4 = (f32x4*)(a.out + (size_t)row * 4096) + 2 * lane;
        const f32x4* x4 = (const f32x4*)(a.in[0] + (size_t)row * 4096) + 2 * lane; const f32x4* g4 = (const f32x4*)a.in[18] + 2 * lane;
#pragma unroll
        for (int k = 0; k < 8; ++k) { const u32x4 tv = t4[64 * k];
            const f32x4 xa = x4[128 * k], xb = x4[128 * k + 1], ga = g4[128 * k], gb = g4[128 * k + 1];
            f32x4 oa, ob; oa[0] = xa[0] + bflo(tv.x) * rs * ga[0]; oa[1] = xa[1] + bfhi(tv.x) * rs * ga[1]; oa[2] = xa[2] + bflo(tv.y) * rs * ga[2]; oa[3] = xa[3] + bfhi(tv.y) * rs * ga[3];
            ob[0] = xb[0] + bflo(tv.z) * rs * gb[0]; ob[1] = xb[1] + bfhi(tv.z) * rs * gb[1]; ob[2] = xb[2] + bflo(tv.w) * rs * gb[2]; ob[3] = xb[3] + bfhi(tv.w) * rs * gb[3];
            o4[128 * k] = oa; o4[128 * k + 1] = ob; }
    }
}

__global__ void __launch_bounds__(512, 2) mega(Args a) {
    extern __shared__ __attribute__((aligned(16))) unsigned char lds_raw[];
    LAS unsigned char* lds = (LAS unsigned char*)lds_raw;
    cg::grid_group grid = cg::this_grid();
    unsigned char* ws = a.ws;
    volatile LAS unsigned* xst = (volatile LAS unsigned*)(lds + LDS_BYTES - 64);
    if (threadIdx.x < 16) xst[threadIdx.x] = 0u;
    __syncthreads();
    XcdBarrier xbar; xbar.bar = (unsigned*)(ws + WS_CTL); xbar.x = 0; xbar.st = nullptr;
    xbar = xcd_barrier_post((unsigned*)(ws + WS_CTL), xst);
    const int lo = a.ph_lo, hi = a.ph_hi;
#define IN(k) (lo <= (k) && (k) < hi)
#define SEAM(k) do { if (IN(k) && IN((k) + 1)) { if ((k) == 0) { __syncthreads(); grid.sync(); } else xcd_barrier(xbar); } } while (0)
    if (IN(0)) { if (PHMASK & 1) phase0(a, lds); if (REPMASK & 1) { __syncthreads(); phase0(a, lds); } }
    SEAM(0);
    if (IN(1)) { if (PHMASK & 2) {
        pg8::Gemm g{(const bf16_t*)(ws + WS_U), (const bf16_t*)(ws + WS_WT), SEQ + NMEM, INW + 2048, 4096};
        Sched1 S; S.init((int)gridDim.x, (int)blockIdx.x);
        Epi1 E{(bf16_t*)(ws + WS_PROJ), (bf16_t*)(ws + WS_VT), (bf16_t*)(ws + WS_MK), (bf16_t*)(ws + WS_MVT), (const float*)(ws + WS_ROPE)};
        pg8::gemm_phase<Epi1, Sched1, true, true>(lds, g, S, E);
        {
            const int G = (int)gridDim.x, nfull = 1160 % G, nidle = (nfull == 0) ? G : G - nfull;
            const int bi = (nfull == 0) ? (int)blockIdx.x : (int)blockIdx.x - nfull;
            if (bi >= 0) {
                int tid = threadIdx.x; asm volatile("" : "+v"(tid)); const int lane = tid & 63, w = tid >> 6;
                LAS float* scr = (LAS float*)(lds + w * 16384);
                for (int it = bi * 8 + w; it < 64 * (4096 / 32); it += nidle * 8) p0_transpose_item(a.in[17], 4096, 4096, (bf16_t*)(ws + WS_WOUT), 0, scr, it, lane);
            }
        }
        if (REPMASK & 2) { __syncthreads(); pg8::gemm_phase<Epi1, Sched1, true, true>(lds, g, S, E); }
    } }
    SEAM(1);
    if (IN(2)) { if (PHMASK & 4) phase2(a, lds, P2MASK); }
    SEAM(2);
    if (IN(3)) { if (PHMASK & 8) phase3(a, lds); if (REPMASK & 8) { __syncthreads(); phase3(a, lds); } }
    SEAM(3);
    if (IN(4)) { if (PHMASK & 16) phase4(a, lds); if (REPMASK & 16) { __syncthreads(); phase4(a, lds); } }
    SEAM(4);
    if (IN(5)) { if (PHMASK & 32) {
        pg8::Gemm g{(const bf16_t*)(ws + WS_Y), (const bf16_t*)(ws + WS_WOUT), SEQ, 4096, 4096};
        Sched2 S; S.c = (int)blockIdx.x;
        Epi3 E{a.out, (bf16_t*)(ws + WS_T0), (float*)(ws + WS_SS), a.in[0], a.in[18], xbar};
        pg8::gemm_phase<Epi3, Sched2, true, true>(lds, g, S, E);
    } }
    if (IN(6)) { if (PHMASK & 64) phase6(a); }
#if N_LAUNCHES != 1
    if (lo >= 7) phase2(a, lds, 1 << (lo - 7));
#endif
#undef IN
#undef SEAM
}

extern "C" void kernel_launch(void* const* d_in, const int* in_sizes, int n_in, void* d_out, int out_size, void* d_ws, size_t ws_size, hipStream_t stream) {
    static int grid = 0;
    if (grid == 0) {
        if (n_in != 19 || ws_size < WS_END) { fprintf(stderr, "kernel_launch: unexpected n_in %d or ws_size %zu (need %zu)\n", n_in, ws_size, (size_t)WS_END); grid = -1; return; }
        int dev = 0, cus = 0, per_cu = 0;
        hipGetDevice(&dev); hipDeviceGetAttribute(&cus, hipDeviceAttributeMultiprocessorCount, dev);
        if (hipFuncSetAttribute((const void*)mega, hipFuncAttributeMaxDynamicSharedMemorySize, LDS_BYTES) != hipSuccess) { fprintf(stderr, "kernel_launch: hipFuncSetAttribute failed\n"); grid = -1; return; }
        if (hipOccupancyMaxActiveBlocksPerMultiprocessor(&per_cu, (const void*)mega, 512, LDS_BYTES) != hipSuccess || per_cu < 1) { fprintf(stderr, "kernel_launch: occupancy query says %d\n", per_cu); per_cu = 1; }
        (void)hipGetLastError();
        if (cus < 256) { fprintf(stderr, "kernel_launch: needs 256 CUs (one workgroup per CU), device has %d\n", cus); grid = -1; return; }
        grid = 256;
    }
    if (grid < 0) return;
    Args a{};
    for (int i = 0; i < 19; ++i) a.in[i] = (const float*)d_in[i];
    a.out = (float*)d_out; a.ws = (unsigned char*)d_ws;
#if N_LAUNCHES == 1
    (void)hipMemsetAsync((char*)d_ws + WS_CTL, 0, 65536, stream);
    a.ph_lo = 0; a.ph_hi = NPH;
    void* args[] = {&a};
    hipError_t e = hipLaunchCooperativeKernel((const void*)mega, dim3(grid), dim3(512), args, LDS_BYTES, stream);
    if (e != hipSuccess) fprintf(stderr, "cooperative launch failed: %s (grid %d)\n", hipGetErrorString(e), grid);
#else
#ifndef PHSEQ
#define PHSEQ 0,1,2,3,4,5,6
#endif
    { const int seq[] = {PHSEQ};
      for (unsigned i = 0; i < sizeof(seq) / sizeof(int); ++i) { a.ph_lo = seq[i]; a.ph_hi = seq[i] + 1; (void)hipMemsetAsync((char*)d_ws + WS_CTL, 0, 65536, stream); hipLaunchKernelGGL(mega, dim3(grid), dim3(512), LDS_BYTES, stream, a); } }
#endif
}
```

```cpp
#include <hip/hip_runtime.h>
#include <hip/hip_cooperative_groups.h>
#include <cstdio>
#include <cstdint>
namespace cg = cooperative_groups;
#define N_LAUNCHES 1
namespace pg8 {
#define PG8_LAS __attribute__((address_space(3)))
typedef unsigned short bf16_t;
typedef short bf16x8 __attribute__((ext_vector_type(8)));
typedef float f32x4 __attribute__((ext_vector_type(4)));
typedef unsigned u32x4 __attribute__((ext_vector_type(4)));
constexpr int BM = 256, BK = 64, HALF = 128, HTB = HALF * BK * 2  , STAGE_BYTES = 8 * HTB, NXCD = 8, WGM = 8;

__host__ __device__ __forceinline__ int lds_byte(int r, int c) { const int st = (r >> 4) * 2 + (c >> 5), rr = r & 15, cc = c & 31, ob = rr * 64 + cc * 2; return st * 1024 + (ob ^ (((ob >> 9) & 1) << 5)); }
__host__ __device__ __forceinline__ void stage_rc(int b, int& R, int& C) { const int st = b / 1024, sb = b % 1024, swz = sb ^ (((sb >> 9) & 1) << 5); R = (st >> 1) * 16 + swz / 64; C = (st & 1) * 32 + (swz % 64) / 2; }
__host__ __device__ __forceinline__ int perm32(int rho) { const int n = rho >> 4, i = rho & 15; return 8 * (i >> 2) + 4 * n + (i & 3); }

struct Unit { int pm, pn; };
struct Gemm { const bf16_t* A; const bf16_t* Bt; int M, N, K; };

struct StaticOrder {
    int nM, nN, nwg, G, c;
    __host__ __device__ void init(int M, int N, int G_, int c_) { nM = M / BM; nN = N / BM; nwg = nM * nN; G = G_; c = c_; }
    __host__ __device__ bool next(int i, Unit& u) const {
        const long L = (long)i * G + c; if (L >= nwg) return false;
        int wgid = (int)L; { const int q = nwg / NXCD, r = nwg % NXCD, xcd = wgid % NXCD, off = wgid / NXCD; wgid = (xcd < r ? xcd * (q + 1) : r * (q + 1) + (xcd - r) * q) + off; }
        const int nig = WGM * nN, gid = wgid / nig, fm = gid * WGM, gsz = (nM - fm) < WGM ? (nM - fm) : WGM;
        u.pm = fm + ((wgid % nig) % gsz); u.pn = (wgid % nig) / gsz; return true;
    }
    __device__ __forceinline__ void a_ready(const Unit&) const {}
    __device__ __forceinline__ void done(const Unit&) const {}
};

__device__ __forceinline__ unsigned cvt_pk_bf16(float lo, float hi) { unsigned r; asm volatile("v_cvt_pk_bf16_f32 %0, %1, %2" : "=v"(r) : "v"(lo), "v"(hi)); return r; }
typedef float f32x2 __attribute__((ext_vector_type(2)));
__device__ __forceinline__ f32x2 gelu_pk(f32x2 v) {
    const f32x2 av = __builtin_elementwise_abs(v), d = av * 0.2316418882f + 1.0f;
    f32x2 t; t.x = __builtin_amdgcn_rcpf(d.x); t.y = __builtin_amdgcn_rcpf(d.y);
    f32x2 q = t * 0.5307027145f + (-0.7265760135f); q = q * t + 0.7107068705f; q = q * t + (-0.142248368f); q = q * t + 0.127414796f; q = q * t;
    const f32x2 s = (v * v) * (-0.72134752044f);
    f32x2 e; e.x = __builtin_amdgcn_exp2f(s.x); e.y = __builtin_amdgcn_exp2f(s.y);
    const f32x2 m = v * (q * e), r = v - m;
    f32x2 o; o.x = v.x < 0.f ? m.x : r.x; o.y = v.y < 0.f ? m.y : r.y; return o;
}

template <int ACT  > struct EpiBf16 {
    static constexpr bool PERM = true, AFTER_DRAIN = false, HOLD_LAST = false; static_assert(ACT == 0 || ACT == 1, "EpiBf16: ACT is 0 (none) or 1 (gelu_pk)");
    bf16_t* O; int ldc; const float* bias; int split_cols; size_t split_stride; float scale0;
    __device__ __forceinline__ void operator()(const f32x4 (&acc)[2][2][4][2], const Unit& u, int wr, int wc, int fr, int fq) const {
        const int row0 = u.pm * BM + wr * 64 + fr; int colt = u.pn * BM; bf16_t* base = O;
        float sc = 1.f; if (split_cols) { const int t = colt / split_cols; base += (size_t)t * split_stride; colt -= t * split_cols; if (t == 0) sc = scale0; }
        const int col0 = colt + wc * 32 + 8 * fq, bcol0 = u.pn * BM + wc * 32 + 8 * fq;
        f32x4 bv[2][2];
#pragma unroll
        for (int bj = 0; bj < 2; ++bj)
#pragma unroll
            for (int n = 0; n < 2; ++n) bv[bj][n] = bias ? *(const f32x4*)(bias + bcol0 + bj * HALF + 4 * n) : (f32x4){0.f, 0.f, 0.f, 0.f};
#pragma unroll
        for (int ai = 0; ai < 2; ++ai)
#pragma unroll
            for (int m = 0; m < 4; ++m) { bf16_t* rowp = base + (size_t)(row0 + ai * HALF + m * 16) * ldc + col0;
#pragma unroll
                for (int bj = 0; bj < 2; ++bj) { f32x4 v0 = acc[ai][bj][m][0] + bv[bj][0], v1 = acc[ai][bj][m][1] + bv[bj][1];
                    if (ACT == 1) { f32x2 a = gelu_pk((f32x2){v0[0], v0[1]}), b = gelu_pk((f32x2){v0[2], v0[3]}), c = gelu_pk((f32x2){v1[0], v1[1]}), d = gelu_pk((f32x2){v1[2], v1[3]});
                        v0 = (f32x4){a.x, a.y, b.x, b.y}; v1 = (f32x4){c.x, c.y, d.x, d.y}; }
                    v0 = v0 * sc; v1 = v1 * sc; u32x4 w; w.x = cvt_pk_bf16(v0[0], v0[1]); w.y = cvt_pk_bf16(v0[2], v0[3]); w.z = cvt_pk_bf16(v1[0], v1[1]); w.w = cvt_pk_bf16(v1[2], v1[3]);
                    *(u32x4*)(rowp + bj * HALF) = w; } }
    }
};
template <class Epi, class Sched, bool ALIGN_EPI = false, bool SP2 = false>
__device__ __forceinline__ void gemm_phase(PG8_LAS unsigned char* lds, const Gemm g, const Sched& S, const Epi& E) {
    int tid_ = threadIdx.x; asm volatile("" : "+v"(tid_)); const int tid = tid_, wid = __builtin_amdgcn_readfirstlane(tid >> 6), lane = tid & 63, wr = wid >> 2, wc = wid & 3, fr = lane & 15, fq = lane >> 4;
    const int K = g.K, nt = K / BK;
    unsigned voffA[2], voffB[2];
#pragma unroll
    for (int i = 0; i < 2; ++i) { int R, C; stage_rc(tid * 16 + i * 8192, R, C); const int Rb = Epi::PERM ? ((R & ~31) + perm32(R & 31)) : R;
        voffA[i] = (unsigned)(R * K + C) * 2u; voffB[i] = (unsigned)(Rb * K + C) * 2u; }
    const size_t kstep = (size_t)(BK * 2);
    const size_t hstep = (size_t)HALF * K * 2;
    const size_t tstep = 2 * hstep;
    const unsigned ldsw = (unsigned)wid * 1024u;
    const int aoff = lds_byte(wr * 64 + fr, fq * 8), boff = lds_byte(wc * 32 + fr, fq * 8);
#define PG8_SA(b, h) (((b) * 2 + (h)) * HTB)
#define PG8_SB(b, h) ((4 + (b) * 2 + (h)) * HTB)
#define PG8_STAGE(bufoff, gbase, voff) do { _Pragma("unroll") for (int _i = 0; _i < 2; ++_i) \
        __builtin_amdgcn_global_load_lds((const unsigned*)((const char*)(gbase) + (voff)[_i]), (PG8_LAS unsigned*)(lds + (bufoff) + ldsw + _i * 8192), 16, 0, 0); } while (0)
#define PG8_LDA(dst, b, h) do { _Pragma("unroll") for (int m = 0; m < 4; ++m) _Pragma("unroll") for (int k = 0; k < 2; ++k) dst[m][k] = *(const PG8_LAS bf16x8*)(lds + PG8_SA(b, h) + aoff + m * 2048 + k * 1024); } while (0)
#define PG8_LDB(dst, b, h) do { _Pragma("unroll") for (int n = 0; n < 2; ++n) _Pragma("unroll") for (int k = 0; k < 2; ++k) dst[n][k] = *(const PG8_LAS bf16x8*)(lds + PG8_SB(b, h) + boff + n * 2048 + k * 1024); } while (0)
#define PG8_MMA(ai, bj, At, Bt) do { __builtin_amdgcn_s_setprio(1); _Pragma("unroll") for (int m = 0; m < 4; ++m) _Pragma("unroll") for (int n = 0; n < 2; ++n) _Pragma("unroll") for (int k = 0; k < 2; ++k) \
        acc[ai][bj][m][n] = __builtin_amdgcn_mfma_f32_16x16x32_bf16(Bt[n][k], At[m][k], acc[ai][bj][m][n], 0, 0, 0); __builtin_amdgcn_s_setprio(0); } while (0)
#define PG8_WAIT_V(n) asm volatile("s_waitcnt vmcnt(" #n ")" ::: "memory")
#define PG8_WAIT_L(n) asm volatile("s_waitcnt lgkmcnt(" #n ")" ::: "memory")
#define PG8_BAR __builtin_amdgcn_s_barrier()
#define PG8_SCHED __builtin_amdgcn_sched_barrier(0)
    Unit cur, nxt; int ui = 0;
    if (!S.next(0, cur)) return;
    f32x4 acc[2][2][4][2];
#pragma unroll
    for (int a = 0; a < 2; ++a)
#pragma unroll
        for (int b = 0; b < 2; ++b)
#pragma unroll
            for (int m = 0; m < 4; ++m)
#pragma unroll
                for (int n = 0; n < 2; ++n) acc[a][b][m][n] = (f32x4){0.f, 0.f, 0.f, 0.f};
    bf16x8 At[4][2], B0[2][2], B1[2][2];
    const char* cA = (const char*)g.A + (size_t)cur.pm * tstep; const char* cB = (const char*)g.Bt + (size_t)cur.pn * tstep;
    S.a_ready(cur);
    if constexpr (SP2) {
        PG8_STAGE(PG8_SB(0, 0), cB, voffB); PG8_STAGE(PG8_SB(0, 1), cB + hstep, voffB); PG8_STAGE(PG8_SA(0, 0), cA, voffA); PG8_STAGE(PG8_SA(0, 1), cA + hstep, voffA);
        if (wr == 1) PG8_BAR;
        PG8_WAIT_V(2); PG8_BAR;
        PG8_STAGE(PG8_SB(1, 0), cB + kstep, voffB); PG8_STAGE(PG8_SA(1, 0), cA + kstep, voffA); PG8_STAGE(PG8_SB(1, 1), cB + hstep + kstep, voffB);
        PG8_WAIT_V(6); PG8_BAR;
    } else {
        PG8_STAGE(PG8_SB(0, 0), cB, voffB); PG8_STAGE(PG8_SA(0, 0), cA, voffA); PG8_STAGE(PG8_SB(0, 1), cB + hstep, voffB); PG8_STAGE(PG8_SA(0, 1), cA + hstep, voffA);
        if (wr == 1) PG8_BAR;
        PG8_WAIT_V(4); PG8_BAR;
        PG8_STAGE(PG8_SB(1, 0), cB + kstep, voffB); PG8_STAGE(PG8_SA(1, 0), cA + kstep, voffA); PG8_STAGE(PG8_SB(1, 1), cB + hstep + kstep, voffB);
        PG8_WAIT_V(6); PG8_BAR;
    }
    for (;;) {
        const bool has_next = S.next(ui + 1, nxt);
        const char* nA = has_next ? (const char*)g.A + (size_t)nxt.pm * tstep : cA; const char* nB = has_next ? (const char*)g.Bt + (size_t)nxt.pn * tstep : cB;
        for (int t = 0; t < nt; t += 2) {
            const bool last = (t == nt - 2);
            const char* a1 = cA + (size_t)(t + 1) * kstep;
            const char* a2 = last ? nA : cA + (size_t)(t + 2) * kstep; const char* b2 = last ? nB : cB + (size_t)(t + 2) * kstep;
            const char* a3 = a2 + kstep; const char* b3 = b2 + kstep;
            if (last && has_next) S.a_ready(nxt);
            if constexpr (SP2) {
            PG8_LDB(B0, 0, 0); PG8_LDB(B1, 0, 1); PG8_SCHED; PG8_LDA(At, 0, 0); PG8_STAGE(PG8_SA(1, 1), a1 + hstep, voffA);
            PG8_WAIT_V(8); PG8_WAIT_L(0); PG8_BAR; PG8_MMA(0, 0, At, B0); PG8_MMA(0, 1, At, B1); PG8_BAR; PG8_SCHED;
            PG8_LDA(At, 0, 1); PG8_STAGE(PG8_SB(0, 0), b2, voffB); PG8_STAGE(PG8_SB(0, 1), b2 + hstep, voffB); PG8_STAGE(PG8_SA(0, 0), a2, voffA);
            PG8_WAIT_V(8); PG8_WAIT_L(0); PG8_BAR; PG8_MMA(1, 0, At, B0); PG8_MMA(1, 1, At, B1); PG8_BAR; PG8_SCHED;
            PG8_LDB(B0, 1, 0); PG8_LDB(B1, 1, 1); PG8_SCHED; PG8_LDA(At, 1, 0); PG8_STAGE(PG8_SA(0, 1), a2 + hstep, voffA);
            PG8_WAIT_V(8); PG8_WAIT_L(0); PG8_BAR; PG8_MMA(0, 0, At, B0); PG8_MMA(0, 1, At, B1); PG8_BAR; PG8_SCHED;
            PG8_LDA(At, 1, 1); PG8_STAGE(PG8_SB(1, 0), b3, voffB); PG8_STAGE(PG8_SB(1, 1), b3 + hstep, voffB); PG8_STAGE(PG8_SA(1, 0), a3, voffA);
            PG8_WAIT_V(8); PG8_WAIT_L(0); PG8_BAR; PG8_MMA(1, 0, At, B0); PG8_MMA(1, 1, At, B1); PG8_BAR; PG8_SCHED;
            } else {
            PG8_LDB(B0, 0, 0); PG8_SCHED; PG8_LDA(At, 0, 0); PG8_STAGE(PG8_SA(1, 1), a1 + hstep, voffA);
            PG8_WAIT_L(8); PG8_BAR; PG8_WAIT_L(0); PG8_MMA(0, 0, At, B0); PG8_BAR; PG8_SCHED;
            PG8_LDB(B1, 0, 1); PG8_STAGE(PG8_SB(0, 0), b2, voffB);
            PG8_BAR; PG8_WAIT_L(0); PG8_MMA(0, 1, At, B1); PG8_BAR;
            PG8_LDA(At, 0, 1); PG8_STAGE(PG8_SA(0, 0), a2, voffA);
            PG8_BAR; PG8_WAIT_L(0); PG8_MMA(1, 0, At, B0); PG8_BAR; PG8_SCHED;
            PG8_STAGE(PG8_SB(0, 1), b2 + hstep, voffB);
            PG8_WAIT_V(6); PG8_BAR; PG8_MMA(1, 1, At, B1); PG8_BAR;
            PG8_LDB(B0, 1, 0); PG8_SCHED; PG8_LDA(At, 1, 0); PG8_STAGE(PG8_SA(0, 1), a2 + hstep, voffA);
            PG8_WAIT_L(8); PG8_BAR; PG8_WAIT_L(0); PG8_MMA(0, 0, At, B0); PG8_BAR; PG8_SCHED;
            PG8_LDB(B1, 1, 1); PG8_STAGE(PG8_SB(1, 0), b3, voffB);
            PG8_BAR; PG8_WAIT_L(0); PG8_MMA(0, 1, At, B1); PG8_BAR;
            PG8_LDA(At, 1, 1); PG8_STAGE(PG8_SA(1, 0), a3, voffA);
            PG8_BAR; PG8_WAIT_L(0); PG8_MMA(1, 0, At, B0); PG8_BAR; PG8_SCHED;
            PG8_STAGE(PG8_SB(1, 1), b3 + hstep, voffB);
            PG8_WAIT_V(6); PG8_BAR; PG8_MMA(1, 1, At, B1); PG8_BAR;
            }
        }
        if constexpr (ALIGN_EPI) { if (wr == 0) PG8_BAR; }
        if constexpr (!Epi::AFTER_DRAIN) { if (!Epi::HOLD_LAST || has_next) { E(acc, cur, wr, wc, fr, fq); S.done(cur); } }
        if (!has_next) break;
#pragma unroll
        for (int a = 0; a < 2; ++a)
#pragma unroll
            for (int b = 0; b < 2; ++b)
#pragma unroll
                for (int m = 0; m < 4; ++m)
#pragma unroll
                    for (int n = 0; n < 2; ++n) acc[a][b][m][n] = (f32x4){0.f, 0.f, 0.f, 0.f};
        cur = nxt; cA = nA; cB = nB; ++ui;
        if constexpr (ALIGN_EPI) { if (wr == 1) PG8_BAR; }
    }
    PG8_WAIT_V(0);
    if constexpr (!ALIGN_EPI) { if (wr == 0) PG8_BAR; }
    PG8_BAR;
    if constexpr (Epi::AFTER_DRAIN || Epi::HOLD_LAST) { E.fused(acc, cur, wr, wc, fr, fq, lds, wid, lane); S.done(cur); }
#undef PG8_SA
#undef PG8_SB
#undef PG8_STAGE
#undef PG8_LDA
#undef PG8_LDB
#undef PG8_MMA
#undef PG8_WAIT_V
#undef PG8_WAIT_L
#undef PG8_BAR
#undef PG8_SCHED
}
}

#ifndef PHMASK
#define PHMASK 127
#endif
#ifndef REPMASK
#define REPMASK 0
#endif
#ifndef P2MASK
#define P2MASK 7
#endif
#ifndef N_LAUNCHES
#define N_LAUNCHES 1
#endif
using pg8::bf16_t; using pg8::bf16x8; using pg8::f32x4; using pg8::u32x4;
#define LAS __attribute__((address_space(3)))
typedef unsigned u32x2 __attribute__((ext_vector_type(2)));
typedef float f32x2 __attribute__((ext_vector_type(2)));

constexpr int SEQ = 8192, DMODEL = 4096, INW = 9216, NMEM = 256;
constexpr int C_QA = 0, C_KA = 2048, C_VA = 2560, C_XL = 3072, C_QM = 4096, C_ZA = 5120, C_ZL = 7168, C_ZM = 8192;
constexpr float EPSN = 1e-6f;
constexpr float LOG2E = 1.4426950408889634f;
constexpr float SC_ATT = 0.08838834764831845f * LOG2E;
constexpr float SC_MEM = 0.0625f * LOG2E;
constexpr int NPH = 7;
constexpr int LDS_BYTES = 147456;

constexpr size_t MiB = 1u << 20;
constexpr size_t WS_CTL = 0, WS_LRUW = 1 * MiB, WS_ROPE = 2 * MiB, WS_MK = 3 * MiB, WS_MVT = 3 * MiB + 512 * 1024, WS_SS = 4 * MiB,
                 WS_AGG1 = 6 * MiB, WS_AGG2 = 10 * MiB, WS_VT = 12 * MiB, WS_WOUT = 20 * MiB, WS_WT = 52 * MiB, WS_U = 140 * MiB,
                 WS_PROJ = 206 * MiB, WS_HS = 350 * MiB, WS_PP = 382 * MiB, WS_YATT = 414 * MiB, WS_YMEM = 446 * MiB, WS_T0 = 462 * MiB, WS_END = 494 * MiB;
constexpr size_t WS_Y = WS_U;

struct Args { const float* in[19]; float* out; unsigned char* ws; int ph_lo, ph_hi; };

__device__ __forceinline__ unsigned pk2(float lo, float hi) { return pg8::cvt_pk_bf16(lo, hi); }
__device__ __forceinline__ float bflo(unsigned u) { return __builtin_bit_cast(float, u << 16); }
__device__ __forceinline__ float bfhi(unsigned u) { return __builtin_bit_cast(float, u & 0xffff0000u); }
__device__ __forceinline__ float wave_sum(float v) {
#pragma unroll
    for (int o = 1; o < 64; o <<= 1) v += __shfl_xor(v, o);
    return v;
}
__device__ __forceinline__ float fexp2(float x) { return __builtin_amdgcn_exp2f(x); }
__device__ __forceinline__ float sigmoidf_(float x) { return 1.f / (1.f + __expf(-x)); }
__device__ __forceinline__ float fsigmoid(float x) { return __builtin_amdgcn_rcpf(1.f + __builtin_amdgcn_exp2f(-x * 1.4426950408889634f)); }
__device__ __forceinline__ f32x4 mfma16(bf16x8 a, bf16x8 b, f32x4 c) { return __builtin_amdgcn_mfma_f32_16x16x32_bf16(a, b, c, 0, 0, 0); }

__device__ __forceinline__ void p0_item_load(const float* W, int N, int item, int lane, float (&r)[32]) {
    const int nblk = N / 32, kb = item / nblk, nb = item % nblk, k0 = 64 * kb, n0 = 32 * nb;
#pragma unroll
    for (int i = 0; i < 32; ++i) { const int kk = 2 * i + (lane >> 5); r[i] = W[(size_t)(k0 + kk) * N + n0 + (lane & 31)]; }
}
__device__ __forceinline__ void p0_item_lds_write(LAS float* scr, int lane, const float (&r)[32]) {
#pragma unroll
    for (int i = 0; i < 32; ++i) { const int kk = 2 * i + (lane >> 5); scr[kk * 33 + (lane & 31)] = r[i]; }
}
__device__ __forceinline__ void p0_item_store(int K, int N, bf16_t* WT, int row_off, LAS float* scr, int item, int lane) {
    const int nblk = N / 32, kb = item / nblk, nb = item % nblk, k0 = 64 * kb, n0 = 32 * nb;
    asm volatile("s_waitcnt lgkmcnt(0)" ::: "memory");
    const int c = lane & 7;
#pragma unroll
    for (int j = 0; j < 4; ++j) { const int n = (lane >> 3) + 8 * j; const LAS float* s = scr + (8 * c) * 33 + n;
        u32x4 o; o.x = pk2(s[0 * 33], s[1 * 33]); o.y = pk2(s[2 * 33], s[3 * 33]); o.z = pk2(s[4 * 33], s[5 * 33]); o.w = pk2(s[6 * 33], s[7 * 33]);
        *(u32x4*)(WT + (size_t)(row_off + n0 + n) * K + k0 + 8 * c) = o; }
    asm volatile("s_waitcnt lgkmcnt(0)" ::: "memory");
}
__device__ __forceinline__ void p0_transpose_item(const float* W, int K, int N, bf16_t* WT, int row_off, LAS float* scr, int item, int lane) {
    float r[32]; p0_item_load(W, N, item, lane, r); p0_item_lds_write(scr, lane, r); p0_item_store(K, N, WT, row_off, scr, item, lane);
}
__device__ __forceinline__ void p0_transpose_matrix(const float* W, int K, int N, bf16_t* WT, int row_off, LAS float* scr, int first, int step, int lane) {
    const int nitems = (K / 64) * (N / 32);
    if (first >= nitems) return;
    float r[32]; p0_item_load(W, N, first, lane, r);
#pragma unroll 1
    for (int it = first; it < nitems; it += step) {
        p0_item_lds_write(scr, lane, r);
        if (it + step < nitems) p0_item_load(W, N, it + step, lane, r);
        p0_item_store(K, N, WT, row_off, scr, it, lane);
    }
}
__device__ __forceinline__ void rms_row_to_bf16(const float* xrow, const f32x4 (&gv)[16], bf16_t* orow, int lane) {
    const f32x4* xr = (const f32x4*)xrow + lane;
    f32x4 v[16]; float s = 0.f;
#pragma unroll
    for (int k = 0; k < 16; ++k) { v[k] = xr[64 * k]; s += (v[k].x * v[k].x + v[k].y * v[k].y) + (v[k].z * v[k].z + v[k].w * v[k].w); }
    const float rs = 1.f / sqrtf(wave_sum(s) * (1.f / 4096.f) + EPSN);
    u32x2* o8 = (u32x2*)orow + lane;
#pragma unroll
    for (int k = 0; k < 16; ++k) { const f32x4 g4 = gv[k]; u32x2 o; o.x = pk2(v[k].x * rs * g4.x, v[k].y * rs * g4.y); o.y = pk2(v[k].z * rs * g4.z, v[k].w * rs * g4.w); o8[64 * k] = o; }
}

__device__ __forceinline__ void phase0(const Args& a, LAS unsigned char* lds) {
    int tid = threadIdx.x; asm volatile("" : "+v"(tid)); const int lane = tid & 63, w = tid >> 6, G = gridDim.x;
    const int gw = blockIdx.x * 8 + w, NGW = G * 8;
    unsigned char* ws = a.ws;
    LAS float* scr = (LAS float*)(lds + w * 16384);
    bf16_t* WT = (bf16_t*)(ws + WS_WT); bf16_t* WOUT = (bf16_t*)(ws + WS_WOUT); bf16_t* LRUW = (bf16_t*)(ws + WS_LRUW);
    constexpr int I_IN = 64 * (INW / 32), I_MKV = 64 * (2048 / 32), I_OUT = 64 * (4096 / 32), I_LRU = 32 * 8;
    p0_transpose_matrix(a.in[3], 4096, INW, WT, 0, scr, gw, NGW, lane);
    p0_transpose_matrix(a.in[13], 4096, 2048, WT, INW, scr, gw, NGW, lane);
    for (int r = gw; r < I_LRU; r += NGW) {
        const int mat = r >> 3, sub = r & 7, gate = mat >> 4, dn = mat & 15;
        const float* src = (gate ? a.in[9] : a.in[7]) + (size_t)dn * 16384;
        p0_transpose_item(src, 128, 128, LRUW + (size_t)mat * 16384, 0, scr, sub, lane);
    }
    bf16_t* U = (bf16_t*)(ws + WS_U);
    { f32x4 gv[16];
#pragma unroll
      for (int k = 0; k < 16; ++k) gv[k] = ((const f32x4*)a.in[2])[lane + 64 * k];
      for (int m = gw; m < SEQ; m += NGW) rms_row_to_bf16(a.in[0] + (size_t)m * 4096, gv, U + (size_t)m * 4096, lane);
#pragma unroll
      for (int k = 0; k < 16; ++k) gv[k] = ((const f32x4*)a.in[12])[lane + 64 * k];
      for (int m = gw; m < NMEM; m += NGW) rms_row_to_bf16(a.in[1] + (size_t)m * 4096, gv, U + (size_t)(SEQ + m) * 4096, lane); }
    f32x2* rope = (f32x2*)(ws + WS_ROPE);
    for (int e = blockIdx.x * 512 + tid; e < SEQ * 16; e += G * 512) {
        const int pos = e >> 4, i = e & 15;
        const float inv = powf(500000.0f, -(float)i * (1.0f / 16.0f));
        const float ang = (float)pos * inv;
        rope[e] = (f32x2){cosf(ang), sinf(ang)};
    }
}

struct Sched1 {
    pg8::StaticOrder so; int G, c, ioff, imax;
    __device__ void init(int G_, int c_) { so.init(SEQ, INW, G_, c_); G = G_; c = c_; ioff = 0; imax = 1 << 20; }
    __device__ bool next(int i0, pg8::Unit& u) const {
        if (i0 >= imax) return false;
        const int i = i0 + ioff;
        const long L = (long)i * G + c;
        if (L < 1152) return so.next(i, u);
        if (L < 1160) { u.pm = 32; u.pn = 36 + (int)(L - 1152); return true; }
        return false;
    }
    __device__ __forceinline__ void a_ready(const pg8::Unit&) const {}
    __device__ __forceinline__ void done(const pg8::Unit&) const {}
};
struct Epi1 {
    static constexpr bool PERM = true, AFTER_DRAIN = false, HOLD_LAST = false;
    bf16_t* proj; bf16_t* vt; bf16_t* mk; bf16_t* mvt; const float* rope;
    __device__ __forceinline__ void operator()(const f32x4 (&acc)[2][2][4][2], const pg8::Unit& u, int wr, int wc, int fr, int fq) const {
        const int rloc = wr * 64 + fr, cloc = wc * 32 + 8 * fq;
        if (u.pm == 32) {
            const int t = u.pn - 36;
            if (t < 4) {
#pragma unroll
                for (int ai = 0; ai < 2; ++ai)
#pragma unroll
                    for (int m = 0; m < 4; ++m) { const int row = rloc + ai * 128 + m * 16;
#pragma unroll
                        for (int bj = 0; bj < 2; ++bj) { const f32x4 v0 = acc[ai][bj][m][0], v1 = acc[ai][bj][m][1];
                            u32x4 wv; wv.x = pk2(v0[0], v0[1]); wv.y = pk2(v0[2], v0[3]); wv.z = pk2(v1[0], v1[1]); wv.w = pk2(v1[2], v1[3]);
                            *(u32x4*)(mk + (size_t)row * 1024 + t * 256 + bj * 128 + cloc) = wv; } asm volatile("" ::: "memory"); }
            } else {
#pragma unroll
                for (int ai = 0; ai < 2; ++ai)
#pragma unroll
                    for (int m = 0; m < 4; ++m) { const int row = rloc + ai * 128 + m * 16;
#pragma unroll
                        for (int bj = 0; bj < 2; ++bj)
#pragma unroll
                            for (int n = 0; n < 2; ++n)
#pragma unroll
                                for (int i = 0; i < 4; ++i) { const int col = (t - 4) * 256 + bj * 128 + cloc + 4 * n + i;
                                    mvt[(size_t)col * 256 + row] = (bf16_t)(pk2(acc[ai][bj][m][n][i], 0.f) & 0xffffu); } asm volatile("" ::: "memory"); }
            }
            return;
        }
        const int pn = u.pn, row0 = u.pm * 256 + rloc;
        if (pn == 10 || pn == 11) {
#pragma unroll
            for (int ai = 0; ai < 2; ++ai)
#pragma unroll
                for (int m = 0; m < 4; ++m) { const int row = row0 + ai * 128 + m * 16;
#pragma unroll
                    for (int bj = 0; bj < 2; ++bj)
#pragma unroll
                        for (int n = 0; n < 2; ++n)
#pragma unroll
                            for (int i = 0; i < 4; ++i) { const int col = (pn - 10) * 256 + bj * 128 + cloc + 4 * n + i;
                                vt[(size_t)col * SEQ + row] = (bf16_t)(pk2(acc[ai][bj][m][n][i], 0.f) & 0xffffu); } asm volatile("" ::: "memory"); }
            return;
        }
        float sc = 1.f; if (pn < 8) sc = SC_ATT; else if (pn >= 16 && pn < 20) sc = SC_MEM;
        const bool do_rope = (pn < 10) && (wc == 0);
        const float sgn = (fq < 2) ? -1.f : 1.f;
        f32x4 csA[2][2], cst[2][2];
        if (do_rope) {
#pragma unroll
            for (int n = 0; n < 2; ++n) { const int io = (8 * (fq & 1) + 4 * n) * 2;
                const float* ra = rope + (size_t)row0 * 32 + io; const float* rt = rope + 16 * 32 + io;
                csA[n][0] = *(const f32x4*)ra; csA[n][1] = *(const f32x4*)(ra + 4); cst[n][0] = *(const f32x4*)rt; cst[n][1] = *(const f32x4*)(rt + 4); }
        }
#pragma unroll
        for (int ai = 0; ai < 2; ++ai)
#pragma unroll
            for (int m = 0; m < 4; ++m) { const int row = row0 + ai * 128 + m * 16;
                f32x4 cs[2][2];
                if (do_rope) {
                    const int nrot = (ai == 0 && m == 3) ? 5 : 1;
#pragma unroll
                    for (int n = 0; n < 2; ++n)
#pragma unroll
                        for (int hh = 0; hh < 2; ++hh) { f32x4 cur = csA[n][hh]; cs[n][hh] = cur; const f32x4 t = cst[n][hh];
#pragma unroll
                            for (int rr = 0; rr < 5; ++rr) { if (rr < nrot) { f32x4 nx; nx[0] = cur[0] * t[0] - cur[1] * t[1]; nx[1] = cur[1] * t[0] + cur[0] * t[1]; nx[2] = cur[2] * t[2] - cur[3] * t[3]; nx[3] = cur[3] * t[2] + cur[2] * t[3]; cur = nx; } }
                            csA[n][hh] = cur; }
                }
#pragma unroll
                for (int bj = 0; bj < 2; ++bj) { f32x4 v[2]; v[0] = acc[ai][bj][m][0]; v[1] = acc[ai][bj][m][1];
                    if (do_rope) {
#pragma unroll
                        for (int n = 0; n < 2; ++n) { f32x4 p; p[0] = __shfl_xor(v[n][0], 32); p[1] = __shfl_xor(v[n][1], 32); p[2] = __shfl_xor(v[n][2], 32); p[3] = __shfl_xor(v[n][3], 32);
                            f32x4 r; r[0] = v[n][0] * cs[n][0][0] + sgn * p[0] * cs[n][0][1]; r[1] = v[n][1] * cs[n][0][2] + sgn * p[1] * cs[n][0][3];
                            r[2] = v[n][2] * cs[n][1][0] + sgn * p[2] * cs[n][1][1]; r[3] = v[n][3] * cs[n][1][2] + sgn * p[3] * cs[n][1][3]; v[n] = r; }
                    }
                    u32x4 wv; wv.x = pk2(v[0][0] * sc, v[0][1] * sc); wv.y = pk2(v[0][2] * sc, v[0][3] * sc); wv.z = pk2(v[1][0] * sc, v[1][1] * sc); wv.w = pk2(v[1][2] * sc, v[1][3] * sc);
                    __builtin_nontemporal_store(wv, (u32x4*)(proj + (size_t)row * INW + pn * 256 + bj * 128 + cloc)); } asm volatile("" ::: "memory"); }
    }
};

template <int DH, bool PF, bool DB>
__device__ __forceinline__ void attn_unit(LAS unsigned char* lds, const bf16_t* Qp, int ldq, bf16_t* Op, int ldo, const bf16_t* Kg, int ldk, const bf16_t* Vtg, int ldv,
                                          int cb_lo, int cb_hi, int cb_self, float m_init, float l_init) {
    constexpr int PR = DH / 8, KROW = DH * 2, KT = 128 * KROW, VROW = 288, NKI = (128 * PR) / 512, NVI = (DH * 16) / 512, NS = DH / 32, NDT = DH / 16;
    int tid = threadIdx.x; asm volatile("" : "+v"(tid)); const int lane = tid & 63, w = tid >> 6, q = lane & 15, g = lane >> 4;
    const int krow = 8 * (q >> 2) + (q & 3);
    bf16x8 qf[NS];
    { const unsigned qoff = (unsigned)(((16 * w + q) * ldq + 8 * g) * 2);
#pragma unroll
      for (int s = 0; s < NS; ++s) qf[s] = *(const bf16x8*)((const char*)Qp + qoff + 64 * s); }
    f32x4 o[NDT];
#pragma unroll
    for (int dt = 0; dt < NDT; ++dt) o[dt] = (f32x4){0.f, 0.f, 0.f, 0.f};
    float m_run = m_init, l_run = l_init;
    u32x4 kreg[NKI], vreg[NVI];
#define ATT_LOAD(cb) do { const int k0_ = (cb) * 128; \
        const char* kb_ = (const char*)Kg + (size_t)k0_ * ldk * 2; const char* vb_ = (const char*)Vtg + (size_t)k0_ * 2; \
        _Pragma("unroll") for (int it = 0; it < NKI; ++it) { const int e = tid + 512 * it; const int key = e / PR, pc = e % PR; \
            kreg[it] = *(const u32x4*)(kb_ + (unsigned)((key * ldk + pc * 8) * 2)); } \
        _Pragma("unroll") for (int it = 0; it < NVI; ++it) { const int e = tid + 512 * it; const int d = e >> 4, pc = e & 15; \
            vreg[it] = *(const u32x4*)(vb_ + (unsigned)((d * ldv + pc * 8) * 2)); } } while (0)
#define ATT_STORE() do { \
        _Pragma("unroll") for (int it = 0; it < NKI; ++it) { const int e = tid + 512 * it; const int key = e / PR, pc = e % PR; \
            *(LAS u32x4*)(lds + key * KROW + ((pc ^ ((((key >> 3) & 3) << 2) | (key & 3))) * 16)) = kreg[it]; } \
        _Pragma("unroll") for (int it = 0; it < NVI; ++it) { const int e = tid + 512 * it; const int d = e >> 4, pc = e & 15; \
            *(LAS u32x4*)(lds + KT + d * VROW + pc * 16) = vreg[it]; } } while (0)
    if (PF) ATT_LOAD(cb_lo);
    for (int cb = cb_lo; cb < cb_hi; ++cb) {
        if (!PF) ATT_LOAD(cb);
        __syncthreads();
        ATT_STORE();
        __syncthreads();
        if (PF) { if (cb + 1 < cb_hi) ATT_LOAD(cb + 1); }
        f32x4 s[8];
#pragma unroll
        for (int kt = 0; kt < 8; ++kt) s[kt] = (f32x4){0.f, 0.f, 0.f, 0.f};
        {
            bf16x8 ka[DB ? 2 : 1][8];
            if (DB) {
#pragma unroll
                for (int kt = 0; kt < 8; ++kt) ka[0][kt] = *(const LAS bf16x8*)(lds + (32 * (kt >> 1) + 4 * (kt & 1) + krow) * KROW + (((0 + g) ^ q) * 16));
            }
#pragma unroll
            for (int ss = 0; ss < NS; ++ss) {
                if (DB) { if (ss + 1 < NS) {
#pragma unroll
                    for (int kt = 0; kt < 8; ++kt) ka[(ss + 1) & 1][kt] = *(const LAS bf16x8*)(lds + (32 * (kt >> 1) + 4 * (kt & 1) + krow) * KROW + (((4 * (ss + 1) + g) ^ q) * 16)); }
                } else {
#pragma unroll
                    for (int kt = 0; kt < 8; ++kt) ka[0][kt] = *(const LAS bf16x8*)(lds + (32 * (kt >> 1) + 4 * (kt & 1) + krow) * KROW + (((4 * ss + g) ^ q) * 16));
                }
                __builtin_amdgcn_sched_barrier(0);
#pragma unroll
                for (int kt = 0; kt < 8; ++kt) s[kt] = mfma16(ka[DB ? (ss & 1) : 0][kt], qf[ss], s[kt]);
                __builtin_amdgcn_sched_barrier(0);
            }
        }
        if (cb != cb_self && cb_self >= 0) {
            const float sg = (cb < cb_self) ? 1.f : -1.f;
            const float dq = (float)(16 * w + q - 8 * g);
#pragma unroll
            for (int kt = 0; kt < 8; ++kt)
#pragma unroll
                for (int j = 0; j < 4; ++j) { const float v = sg * ((float)(32 * (kt >> 1) + 4 * (kt & 1) + j) - dq); s[kt][j] += fminf(v, 0.f) * 1e30f; }
        }
        float mx = s[0][0];
#pragma unroll
        for (int kt = 0; kt < 8; ++kt)
#pragma unroll
            for (int j = 0; j < 4; ++j) mx = fmaxf(mx, s[kt][j]);
        mx = fmaxf(mx, __shfl_xor(mx, 16)); mx = fmaxf(mx, __shfl_xor(mx, 32));
        const float m_new = fmaxf(m_run, mx), alpha = fexp2(m_run - m_new); m_run = m_new;
        float rs = 0.f;
#pragma unroll
        for (int kt = 0; kt < 8; ++kt)
#pragma unroll
            for (int j = 0; j < 4; ++j) { const float p = fexp2(s[kt][j] - m_new); s[kt][j] = p; rs += p; }
        rs += __shfl_xor(rs, 16); rs += __shfl_xor(rs, 32);
        l_run = l_run * alpha + rs;
        bf16x8 pb[4];
#pragma unroll
        for (int u = 0; u < 4; ++u) { u32x4 t; t.x = pk2(s[2 * u][0], s[2 * u][1]); t.y = pk2(s[2 * u][2], s[2 * u][3]); t.z = pk2(s[2 * u + 1][0], s[2 * u + 1][1]); t.w = pk2(s[2 * u + 1][2], s[2 * u + 1][3]);
            pb[u] = __builtin_bit_cast(bf16x8, t); }
#pragma unroll
        for (int dt = 0; dt < NDT; ++dt) o[dt] = o[dt] * alpha;
        {
            constexpr int NG = (NDT / 8) * 4;
            u32x4 va[DB ? 2 : 1][8];
#define ATT_VLOAD(buf, gi) do { const int u_ = (gi) & 3, d0_ = 8 * ((gi) >> 2); \
            _Pragma("unroll") for (int i = 0; i < 8; ++i) { va[buf][i] = *(const LAS u32x4*)(lds + KT + (16 * (d0_ + i) + q) * VROW + (32 * u_ + 8 * g) * 2); } } while (0)
            if (DB) ATT_VLOAD(0, 0);
#pragma unroll
            for (int gi = 0; gi < NG; ++gi) {
                if (DB) { if (gi + 1 < NG) ATT_VLOAD((gi + 1) & 1, gi + 1); } else ATT_VLOAD(0, gi);
                __builtin_amdgcn_sched_barrier(0);
#pragma unroll
                for (int i = 0; i < 8; ++i) o[8 * (gi >> 2) + i] = mfma16(__builtin_bit_cast(bf16x8, va[DB ? (gi & 1) : 0][i]), pb[gi & 3], o[8 * (gi >> 2) + i]);
                __builtin_amdgcn_sched_barrier(0);
            }
#undef ATT_VLOAD
        }
    }
#undef ATT_LOAD
#undef ATT_STORE
    const float inv = 1.f / l_run;
    const unsigned ooff = (unsigned)(((16 * w + q) * ldo + 4 * g) * 2);
#pragma unroll
    for (int dt = 0; dt < NDT; ++dt) { u32x2 pkv; pkv.x = pk2(o[dt][0] * inv, o[dt][1] * inv); pkv.y = pk2(o[dt][2] * inv, o[dt][3] * inv); *(u32x2*)((char*)Op + ooff + 32 * dt) = pkv; }
}

__device__ __forceinline__ void windowed_stream(LAS unsigned char* lds0, const Args& a) {
    constexpr int DH = 128, PR = 16, KROW = 256, KT = 128 * KROW, VROW = 288, BUFB = KT + DH * VROW, NKI = 4, NVI = 4, NS = 4, NDT = 8;
    static_assert(2 * BUFB <= LDS_BYTES - 64, "two K/V tile buffers must fit under the barrier words");
    int tid = threadIdx.x; asm volatile("" : "+v"(tid)); const int lane = tid & 63, w = tid >> 6, q = lane & 15, g = lane >> 4;
    const int krow = 8 * (q >> 2) + (q & 3);
    unsigned char* ws = a.ws;
    const bf16_t* proj = (const bf16_t*)(ws + WS_PROJ); const bf16_t* vt = (const bf16_t*)(ws + WS_VT); bf16_t* yatt = (bf16_t*)(ws + WS_YATT);
    const int G = (int)gridDim.x;
    if ((int)blockIdx.x >= 1024) return;
    unsigned koff[NKI], voff[NVI], klds[NKI], vlds[NVI];
#pragma unroll
    for (int it = 0; it < NKI; ++it) { const int e = tid + 512 * it, key = e / PR, pc = e % PR; koff[it] = (unsigned)((key * INW + pc * 8) * 2); klds[it] = (unsigned)(key * KROW + ((pc ^ ((((key >> 3) & 3) << 2) | (key & 3))) * 16)); }
#pragma unroll
    for (int it = 0; it < NVI; ++it) { const int e = tid + 512 * it, d = e >> 4, pc = e & 15; voff[it] = (unsigned)((d * SEQ + pc * 8) * 2); vlds[it] = (unsigned)(KT + d * VROW + pc * 16); }
    u32x4 kreg[NKI], vreg[NVI];
#define WS_LOAD(v_, cb_) do { const int kvh_ = ((v_) & 15) >> 2; \
        const char* kb_ = (const char*)proj + ((size_t)((cb_) * 128) * INW + C_KA + kvh_ * 128) * 2; const char* vb_ = (const char*)vt + ((size_t)(kvh_ * 128) * SEQ + (cb_) * 128) * 2; \
        _Pragma("unroll") for (int it = 0; it < NKI; ++it) kreg[it] = *(const u32x4*)(kb_ + koff[it]); \
        _Pragma("unroll") for (int it = 0; it < NVI; ++it) vreg[it] = *(const u32x4*)(vb_ + voff[it]); } while (0)
#define WS_STORE(ldsb_) do { \
        _Pragma("unroll") for (int it = 0; it < NKI; ++it) *(LAS u32x4*)((ldsb_) + klds[it]) = kreg[it]; \
        _Pragma("unroll") for (int it = 0; it < NVI; ++it) *(LAS u32x4*)((ldsb_) + vlds[it]) = vreg[it]; } while (0)
#define WS_LO(v_) ((((v_) >> 4) > 0) ? ((v_) >> 4) - 1 : 0)
#define WS_HI(v_) ((((v_) >> 4) < 63) ? ((v_) >> 4) + 2 : 64)
    int Cv = (int)blockIdx.x, Ccb = WS_LO(Cv);
    int Lv = Cv, Lcb = Ccb; bool Lvalid = true;
#define WS_ADV_L() do { if (Lcb + 1 < WS_HI(Lv)) ++Lcb; else { Lv += G; if (Lv < 1024) Lcb = WS_LO(Lv); else Lvalid = false; } } while (0)
    __syncthreads();
    WS_LOAD(Lv, Lcb); WS_ADV_L();
    WS_STORE(lds0);
    bool have = false;
    if (Lvalid) { WS_LOAD(Lv, Lcb); WS_ADV_L(); have = true; }
    __syncthreads();
    int bsel = 0;
    bf16x8 qf[NS]; f32x4 o[NDT]; float m_run = 0.f, l_run = 1.f;
#pragma unroll 1
    for (;;) {
        const int qblk = Cv >> 4, hq = Cv & 15, lo = WS_LO(Cv), hi = WS_HI(Cv);
        LAS unsigned char* lds = lds0 + bsel * BUFB;
        if (Ccb == lo) {
            const unsigned qoff = (unsigned)(((16 * w + q) * INW + 8 * g) * 2);
            const char* qb = (const char*)proj + ((size_t)(qblk * 128) * INW + C_QA + hq * 128) * 2;
#pragma unroll
            for (int s = 0; s < NS; ++s) qf[s] = *(const bf16x8*)(qb + qoff + 64 * s);
#pragma unroll
            for (int dt = 0; dt < NDT; ++dt) o[dt] = (f32x4){0.f, 0.f, 0.f, 0.f};
            m_run = a.in[4][hq] * LOG2E; l_run = 1.f;
        }
        if (have) { WS_STORE(lds0 + (bsel ^ 1) * BUFB); have = false; }
        if (Lvalid) { WS_LOAD(Lv, Lcb); WS_ADV_L(); have = true; }
        f32x4 s[8];
#pragma unroll
        for (int kt = 0; kt < 8; ++kt) s[kt] = (f32x4){0.f, 0.f, 0.f, 0.f};
        {
            bf16x8 ka[2][8];
#pragma unroll
            for (int kt = 0; kt < 8; ++kt) ka[0][kt] = *(const LAS bf16x8*)(lds + (32 * (kt >> 1) + 4 * (kt & 1) + krow) * KROW + (((0 + g) ^ q) * 16));
#pragma unroll
            for (int ss = 0; ss < NS; ++ss) {
                if (ss + 1 < NS) {
#pragma unroll
                    for (int kt = 0; kt < 8; ++kt) ka[(ss + 1) & 1][kt] = *(const LAS bf16x8*)(lds + (32 * (kt >> 1) + 4 * (kt & 1) + krow) * KROW + (((4 * (ss + 1) + g) ^ q) * 16)); }
                __builtin_amdgcn_sched_barrier(0);
#pragma unroll
                for (int kt = 0; kt < 8; ++kt) s[kt] = mfma16(ka[ss & 1][kt], qf[ss], s[kt]);
                __builtin_amdgcn_sched_barrier(0);
            }
        }
        if (Ccb != qblk) {
            const float sg = (Ccb < qblk) ? 1.f : -1.f;
            const float dq = (float)(16 * w + q - 8 * g);
#pragma unroll
            for (int kt = 0; kt < 8; ++kt)
#pragma unroll
                for (int j = 0; j < 4; ++j) { const float v = sg * ((float)(32 * (kt >> 1) + 4 * (kt & 1) + j) - dq); s[kt][j] += fminf(v, 0.f) * 1e30f; }
        }
        float mx = s[0][0];
#pragma unroll
        for (int kt = 0; kt < 8; ++kt)
#pragma unroll
            for (int j = 0; j < 4; ++j) mx = fmaxf(mx, s[kt][j]);
        mx = fmaxf(mx, __shfl_xor(mx, 16)); mx = fmaxf(mx, __shfl_xor(mx, 32));
        const float m_new = fmaxf(m_run, mx), alpha = fexp2(m_run - m_new); m_run = m_new;
        float rs = 0.f;
#pragma unroll
        for (int kt = 0; kt < 8; ++kt)
#pragma unroll
            for (int j = 0; j < 4; ++j) { const float p = fexp2(s[kt][j] - m_new); s[kt][j] = p; rs += p; }
        rs += __shfl_xor(rs, 16); rs += __shfl_xor(rs, 32);
        l_run = l_run * alpha + rs;
        bf16x8 pb[4];
#pragma unroll
        for (int u = 0; u < 4; ++u) { u32x4 t; t.x = pk2(s[2 * u][0], s[2 * u][1]); t.y = pk2(s[2 * u][2], s[2 * u][3]); t.z = pk2(s[2 * u + 1][0], s[2 * u + 1][1]); t.w = pk2(s[2 * u + 1][2], s[2 * u + 1][3]);
            pb[u] = __builtin_bit_cast(bf16x8, t); }
#pragma unroll
        for (int dt = 0; dt < NDT; ++dt) o[dt] = o[dt] * alpha;
        {
            u32x4 va[2][8];
#define WS_VLOAD(buf, gi) do { _Pragma("unroll") for (int i = 0; i < 8; ++i) { va[buf][i] = *(const LAS u32x4*)(lds + KT + (16 * i + q) * VROW + (32 * (gi) + 8 * g) * 2); } } while (0)
            WS_VLOAD(0, 0);
#pragma unroll
            for (int gi = 0; gi < 4; ++gi) {
                if (gi + 1 < 4) WS_VLOAD((gi + 1) & 1, gi + 1);
                __builtin_amdgcn_sched_barrier(0);
#pragma unroll
                for (int i = 0; i < 8; ++i) o[i] = mfma16(__builtin_bit_cast(bf16x8, va[gi & 1][i]), pb[gi], o[i]);
                __builtin_amdgcn_sched_barrier(0);
            }
#undef WS_VLOAD
        }
        bool done = false;
        if (Ccb + 1 < hi) ++Ccb;
        else {
            const float inv = 1.f / l_run;
            char* ob = (char*)yatt + ((size_t)(qblk * 128) * 2048 + hq * 128) * 2;
            const unsigned ooff = (unsigned)(((16 * w + q) * 2048 + 4 * g) * 2);
#pragma unroll
            for (int dt = 0; dt < NDT; ++dt) { u32x2 pkv; pkv.x = pk2(o[dt][0] * inv, o[dt][1] * inv); pkv.y = pk2(o[dt][2] * inv, o[dt][3] * inv); *(u32x2*)(ob + ooff + 32 * dt) = pkv; }
            Cv += G; if (Cv < 1024) Ccb = WS_LO(Cv); else done = true;
        }
        __syncthreads();
        bsel ^= 1;
        if (done) break;
    }
#undef WS_LOAD
#undef WS_STORE
#undef WS_LO
#undef WS_HI
#undef WS_ADV_L
}

constexpr int LR_XCB = 0, LR_TA = 16384, LR_TB = LR_TA + 64 * 528, LR_TH = LR_TB + 64 * 528, LR_AGS = LR_TH + 64 * 528;
template <int VAR>
__device__ __forceinline__ void lru_phase(LAS unsigned char* lds, const Args& a, const int n, const int tt_first, const int tt_step) {
    int tid = threadIdx.x; asm volatile("" : "+v"(tid)); const int lane = tid & 63, w0 = tid >> 6, q0 = lane & 15, g0 = lane >> 4;
    unsigned char* ws = a.ws;
    const bf16_t* proj = (const bf16_t*)(ws + WS_PROJ);
    LAS unsigned char* xcb = lds + LR_XCB;
    LAS float* TA = (LAS float*)(lds + LR_TA); LAS float* TB = (LAS float*)(lds + LR_TB); LAS float* TH = (LAS float*)(lds + LR_TH);
    LAS f32x2* AGS = (LAS f32x2*)(lds + LR_AGS);
    const bf16_t* lruw = (const bf16_t*)(ws + WS_LRUW);
    f32x2* agg1 = (f32x2*)(ws + (VAR ? WS_T0 : WS_AGG1));
    bf16_t* Pout = (bf16_t*)(ws + (VAR ? WS_U + 32 * MiB : WS_PP));
    bf16x8 fa[2][4], fx[2][4];
#pragma unroll
    for (int dir = 0; dir < 2; ++dir) {
        const bf16_t* wa = lruw + (size_t)((0 * 2 + dir) * 8 + n) * 16384 + (16 * w0 + q0) * 128 + 8 * g0;
        const bf16_t* wx = lruw + (size_t)((1 * 2 + dir) * 8 + n) * 16384 + (16 * w0 + q0) * 128 + 8 * g0;
#pragma unroll
        for (int s = 0; s < 4; ++s) { fa[dir][s] = *(const bf16x8*)(wa + 32 * s); fx[dir][s] = *(const bf16x8*)(wx + 32 * s); }
    }
    const int cg8 = tid & 15, t2 = tid >> 4, ch0 = n * 128 + cg8 * 8;
    LAS float* CW = (LAS float*)(lds + LR_AGS + 4096);
    __syncthreads();
    if (tid < 128) {
#pragma unroll
        for (int j = 0; j < 4; ++j) CW[j * 128 + tid] = a.in[5][j * 1024 + n * 128 + tid];
        CW[512 + tid] = a.in[6][n * 128 + tid];
    } else if (tid < 384) {
        const int d2 = (tid - 128) >> 7, c = tid & 127, cg = d2 * 1024 + n * 128 + c;
        const float xl = -a.in[11][cg];
        CW[640 + (d2 * 3 + 0) * 128 + c] = a.in[8][cg]; CW[640 + (d2 * 3 + 1) * 128 + c] = a.in[10][cg];
        CW[640 + (d2 * 3 + 2) * 128 + c] = fmaxf(xl, 0.f) + log1pf(expf(-fabsf(xl)));
    }
    u32x4 xr[5];
#define LRU_XLOAD(tt_) do { _Pragma("unroll") for (int r = 0; r < 5; ++r) { const int t = (tt_) * 64 + 2 * t2 - 2 + r; xr[r] = (u32x4){0u, 0u, 0u, 0u}; \
        if (t >= 0 && t < SEQ) xr[r] = *(const u32x4*)((const char*)proj + (unsigned)((t * INW + C_XL + ch0) * 2)); } } while (0)
    if (tt_first < 128) LRU_XLOAD(tt_first);
#pragma unroll 1
    for (int tt = tt_first; tt < 128; tt += tt_step) {
    const int t0 = tt * 64;
    __syncthreads();
    {
        float xin[5][8];
#pragma unroll
        for (int r = 0; r < 5; ++r) { const u32x4 v = xr[r];
            xin[r][0] = bflo(v.x); xin[r][1] = bfhi(v.x); xin[r][2] = bflo(v.y); xin[r][3] = bfhi(v.y); xin[r][4] = bflo(v.z); xin[r][5] = bfhi(v.z); xin[r][6] = bflo(v.w); xin[r][7] = bfhi(v.w); }
        float wv[4][8], bias[8];
#pragma unroll
        for (int j = 0; j < 4; ++j) { const f32x4 w0 = *(const LAS f32x4*)(CW + j * 128 + cg8 * 8), w1 = *(const LAS f32x4*)(CW + j * 128 + cg8 * 8 + 4);
            wv[j][0] = w0[0]; wv[j][1] = w0[1]; wv[j][2] = w0[2]; wv[j][3] = w0[3]; wv[j][4] = w1[0]; wv[j][5] = w1[1]; wv[j][6] = w1[2]; wv[j][7] = w1[3]; }
        { const f32x4 b0 = *(const LAS f32x4*)(CW + 512 + cg8 * 8), b1 = *(const LAS f32x4*)(CW + 512 + cg8 * 8 + 4);
          bias[0] = b0[0]; bias[1] = b0[1]; bias[2] = b0[2]; bias[3] = b0[3]; bias[4] = b1[0]; bias[5] = b1[1]; bias[6] = b1[2]; bias[7] = b1[3]; }
#pragma unroll
        for (int o = 0; o < 2; ++o) { float y[8];
#pragma unroll
            for (int e = 0; e < 8; ++e) { float v = bias[e];
#pragma unroll
                for (int j = 0; j < 4; ++j) v += wv[j][e] * xin[o + j][e];
                y[e] = v; }
            const int tok = 2 * t2 + o;
            u32x4 pk; pk.x = pk2(y[0], y[1]); pk.y = pk2(y[2], y[3]); pk.z = pk2(y[4], y[5]); pk.w = pk2(y[6], y[7]);
            *(LAS u32x4*)(xcb + tok * 256 + ((cg8 ^ (tok & 15)) * 16)) = pk; }
    }
    if (tt + tt_step < 128) LRU_XLOAD(tt + tt_step);
    __syncthreads();
    float hreg[16];
    int tl = tid; asm volatile("" : "+v"(tl));
    const int q = tl & 15, g = (tl >> 4) & 3, w = tl >> 6, chl = 16 * w + 4 * g;
    const int ch = 16 * w + q, sub = g;
#pragma unroll
    for (int dir = 0; dir < 2; ++dir) {
        LAS float* TAd = dir ? TH : TA;
        if (VAR != 3) {
            const f32x4 ba = *(const LAS f32x4*)(CW + 640 + (dir * 3 + 0) * 128 + chl), bx = *(const LAS f32x4*)(CW + 640 + (dir * 3 + 1) * 128 + chl), sp = *(const LAS f32x4*)(CW + 640 + (dir * 3 + 2) * 128 + chl);
#pragma unroll
            for (int tk = 0; tk < 4; ++tk) { const int tok = 16 * tk + q;
                f32x4 ar = (f32x4){0.f, 0.f, 0.f, 0.f}, ai = (f32x4){0.f, 0.f, 0.f, 0.f};
#pragma unroll
                for (int s = 0; s < 4; ++s) {
                    const bf16x8 xb = *(const LAS bf16x8*)(xcb + tok * 256 + (((4 * s + g) ^ q) * 16));
                    ar = mfma16(fa[dir][s], xb, ar); ai = mfma16(fx[dir][s], xb, ai); }
                const u32x2 xr2 = *(const LAS u32x2*)(xcb + tok * 256 + ((((chl >> 3)) ^ q) * 16) + (chl & 7) * 2);
                const float xc0 = bflo(xr2.x), xc1 = bfhi(xr2.x), xc2 = bflo(xr2.y), xc3 = bfhi(xr2.y);
                f32x4 av, bv;
#pragma unroll
                for (int j = 0; j < 4; ++j) { if (VAR == 1) { av[j] = ar[j] + ba[j] + sp[j]; bv[j] = ai[j] + bx[j] + (j == 0 ? xc0 : (j == 1 ? xc1 : (j == 2 ? xc2 : xc3))); continue; }
                    const float r = fsigmoid(ar[j] + ba[j]), ii = fsigmoid(ai[j] + bx[j]);
                    const float la = -8.0f * r * sp[j]; const float aa = fexp2(la * LOG2E); av[j] = aa;
                    const float x2 = 2.0f * la;
                    const float poly = x2 * (1.f + x2 * (0.5f + x2 * ((1.f / 6.f) + x2 * ((1.f / 24.f) + x2 * (1.f / 120.f)))));
                    const float om = (x2 > -0.25f) ? -poly : (1.f - aa * aa);
                    const float xcj = j == 0 ? xc0 : (j == 1 ? xc1 : (j == 2 ? xc2 : xc3));
                    bv[j] = __builtin_amdgcn_sqrtf(om) * ii * xcj; }
                *(LAS f32x4*)(TAd + tok * 132 + chl) = av; *(LAS f32x4*)(TB + tok * 132 + chl) = bv; }
        }
        asm volatile("s_waitcnt lgkmcnt(0)" ::: "memory");
        if (VAR != 2 && VAR != 3) {
            float h = 0.f, P = 1.f;
#pragma unroll
            for (int i = 0; i < 16; ++i) { const int t = 16 * sub + (dir ? 15 - i : i);
                const float av = TAd[t * 132 + ch], bv = TB[t * 132 + ch]; h = av * h + bv; P *= av; TB[t * 132 + ch] = h; TAd[t * 132 + ch] = P; }
            AGS[sub * 128 + ch] = (f32x2){P, h};
        }
        asm volatile("s_waitcnt lgkmcnt(0)" ::: "memory");
        if (VAR == 2 || VAR == 3) {
#pragma unroll
            for (int i = 0; i < 16; ++i) hreg[i] = 0.f;
        } else {
            float hc = 0.f, Pp = 1.f, At = 1.f, Ht = 0.f;
#pragma unroll
            for (int s = 0; s < 4; ++s) { const int s2 = dir ? 3 - s : s; const f32x2 e = AGS[s2 * 128 + ch];
                const bool before = dir ? (s2 > sub) : (s2 < sub);
                if (before) { hc = e.x * hc + e.y; Pp *= e.x; }
                Ht = e.x * Ht + e.y; At *= e.x; }
#pragma unroll
            for (int i = 0; i < 16; ++i) { const int t = 16 * sub + i;
                const float Pl = TAd[t * 132 + ch], hl = TB[t * 132 + ch];
                const float hfull = hl + Pl * hc;
                if (dir == 0) hreg[i] = hfull; else hreg[i] += hfull;
                TAd[t * 132 + ch] = Pl * Pp; }
            if (sub == 0) agg1[(size_t)(dir * 1024 + n * 128 + ch) * 128 + tt] = (f32x2){At, Ht};
        }
        asm volatile("s_waitcnt lgkmcnt(0)" ::: "memory");
    }
#pragma unroll
    for (int i = 0; i < 16; ++i) TB[(16 * sub + i) * 132 + ch] = hreg[i];
    __syncthreads();
    {
        float* hs = (float*)(ws + (VAR ? WS_U : WS_HS));
#pragma unroll
        for (int i = 0; i < 4; ++i) { const int e = tid + 512 * i, t = e >> 5, c4 = e & 31;
            *(f32x4*)(hs + (size_t)(t0 + t) * 1024 + n * 128 + 4 * c4) = *(const LAS f32x4*)(TB + t * 132 + 4 * c4);
            const f32x4 p0 = *(const LAS f32x4*)(TA + t * 132 + 4 * c4), p1 = *(const LAS f32x4*)(TH + t * 132 + 4 * c4);
            u32x2 o0, o1; o0.x = pk2(p0[0], p0[1]); o0.y = pk2(p0[2], p0[3]); o1.x = pk2(p1[0], p1[1]); o1.y = pk2(p1[2], p1[3]);
            *(u32x2*)(Pout + (size_t)(t0 + t) * 1024 + n * 128 + 4 * c4) = o0;
            *(u32x2*)(Pout + (size_t)SEQ * 1024 + (size_t)(t0 + t) * 1024 + n * 128 + 4 * c4) = o1; }
    }
    }
#undef LRU_XLOAD
}

__device__ __forceinline__ void phase2(const Args& a, LAS unsigned char* lds, int p2mask) {
    unsigned char* ws = a.ws;
    bf16_t* proj = (bf16_t*)(ws + WS_PROJ); const bf16_t* vt = (const bf16_t*)(ws + WS_VT);
    const bf16_t* mk = (const bf16_t*)(ws + WS_MK); const bf16_t* mvt = (const bf16_t*)(ws + WS_MVT);
    bf16_t* yatt = (bf16_t*)(ws + WS_YATT); bf16_t* ymem = (bf16_t*)(ws + WS_YMEM);
    if (p2mask & 1)
    for (int u = blockIdx.x; u < 256; u += gridDim.x) {
        const int qblk = u >> 2, hm = u & 3;
        attn_unit<256, false, false>(lds, proj + (size_t)(qblk * 128) * INW + C_QM + hm * 256, INW, ymem + (size_t)(qblk * 128) * 1024 + hm * 256, 1024, mk + hm * 256, 1024, mvt + (size_t)(hm * 256) * 256, 256, 0, 2, -100, -1e30f, 0.f);
    }
    if (p2mask & 2) windowed_stream(lds, a);
    if (p2mask & 4)
    { const int G = gridDim.x; const bool al = (G & 7) == 0; const int nrep = al ? 1 : 8;
#pragma unroll 1
      for (int rep = 0; rep < nrep; ++rep) lru_phase<0>(lds, a, al ? (int)(blockIdx.x & 7) : rep, al ? (int)(blockIdx.x >> 3) : (int)blockIdx.x, al ? (G >> 3) : G); }
}

__device__ __forceinline__ void phase3(const Args& a, LAS unsigned char* lds) {
    unsigned char* ws = a.ws;
    const f32x2* agg1 = (const f32x2*)(ws + WS_AGG1); f32x2* agg2 = (f32x2*)(ws + WS_AGG2);
    for (int e = blockIdx.x * 512 + threadIdx.x; e < 2 * 1024 * 16; e += gridDim.x * 512) {
        const int sc = e & 15, dc = e >> 4, dir = dc >> 10;
        const f32x4* p = (const f32x4*)(agg1 + (size_t)dc * 128 + sc * 8);
        f32x4 v[4];
#pragma unroll
        for (int i = 0; i < 4; ++i) v[i] = p[i];
        float A = 1.f, H = 0.f;
        if (dir == 0) {
#pragma unroll
            for (int i = 0; i < 4; ++i) { H = v[i][0] * H + v[i][1]; A *= v[i][0]; H = v[i][2] * H + v[i][3]; A *= v[i][2]; }
        } else {
#pragma unroll
            for (int i = 3; i >= 0; --i) { H = v[i][2] * H + v[i][3]; A *= v[i][2]; H = v[i][0] * H + v[i][1]; A *= v[i][0]; }
        }
        agg2[(size_t)dc * 16 + sc] = (f32x2){A, H};
    }
}

__device__ __forceinline__ float silu_(float z) { return z * __builtin_amdgcn_rcpf(1.f + __builtin_amdgcn_exp2f(-z * 1.4426950408889634f)); }
__device__ __forceinline__ void phase4(const Args& a, LAS unsigned char* lds) {
    unsigned char* ws = a.ws;
    const f32x2* agg1 = (const f32x2*)(ws + WS_AGG1); const f32x2* agg2 = (const f32x2*)(ws + WS_AGG2);
    const bf16_t* proj = (const bf16_t*)(ws + WS_PROJ); bf16_t* Y = (bf16_t*)(ws + WS_Y);
    const bf16_t* yatt = (const bf16_t*)(ws + WS_YATT); const bf16_t* ymem = (const bf16_t*)(ws + WS_YMEM);
    const float* hs = (const float*)(ws + WS_HS); const bf16_t* Pf = (const bf16_t*)(ws + WS_PP); const bf16_t* Pb = Pf + (size_t)SEQ * 1024;
    LAS float* car = (LAS float*)lds;
    LAS float* gl = (LAS float*)(lds + 8192);
    int tid = threadIdx.x; asm volatile("" : "+v"(tid)); const int lane = tid & 63, w = tid >> 6;
    __syncthreads();
    for (int i = tid; i < 1024; i += 512) { *(LAS f32x4*)(gl + 4 * i) = (i < 512) ? ((const f32x4*)a.in[14])[i] : (i < 768 ? ((const f32x4*)a.in[15])[i - 512] : ((const f32x4*)a.in[16])[i - 768]); }
    for (int u = blockIdx.x; u < 256; u += gridDim.x) {
        const int tile = u >> 1, sc = tile >> 3, cj = tile & 7;
        __syncthreads();
#pragma unroll 1
        for (int half = 0; half < 2; ++half) {
            const int c = tid + 512 * half;
            float hf = 0.f, hb = 0.f;
            { const f32x4* p2 = (const f32x4*)(agg2 + (size_t)c * 16); const f32x4* p1 = (const f32x4*)(agg1 + (size_t)c * 128 + sc * 8);
              f32x4 e2[8], e1[4];
#pragma unroll
              for (int i = 0; i < 8; ++i) e2[i] = p2[i];
#pragma unroll
              for (int i = 0; i < 4; ++i) e1[i] = p1[i];
#pragma unroll
              for (int i = 0; i < 8; ++i) { if (2 * i < sc) hf = e2[i][0] * hf + e2[i][1]; if (2 * i + 1 < sc) hf = e2[i][2] * hf + e2[i][3]; }
#pragma unroll
              for (int i = 0; i < 4; ++i) { if (2 * i < cj) hf = e1[i][0] * hf + e1[i][1]; if (2 * i + 1 < cj) hf = e1[i][2] * hf + e1[i][3]; } }
            { const f32x4* p2 = (const f32x4*)(agg2 + (size_t)(1024 + c) * 16); const f32x4* p1 = (const f32x4*)(agg1 + (size_t)(1024 + c) * 128 + sc * 8);
              f32x4 e2[8], e1[4];
#pragma unroll
              for (int i = 0; i < 8; ++i) e2[i] = p2[i];
#pragma unroll
              for (int i = 0; i < 4; ++i) e1[i] = p1[i];
#pragma unroll
              for (int i = 7; i >= 0; --i) { if (2 * i + 1 > sc) hb = e2[i][2] * hb + e2[i][3]; if (2 * i > sc) hb = e2[i][0] * hb + e2[i][1]; }
#pragma unroll
              for (int i = 3; i >= 0; --i) { if (2 * i + 1 > cj) hb = e1[i][2] * hb + e1[i][3]; if (2 * i > cj) hb = e1[i][0] * hb + e1[i][1]; } }
            car[c] = hf; car[1024 + c] = hb;
        }
        __syncthreads();
        f32x4 cf[4], cb[4];
#pragma unroll
        for (int k = 0; k < 4; ++k) { cf[k] = *(const LAS f32x4*)(car + 4 * lane + 256 * k); cb[k] = *(const LAS f32x4*)(car + 1024 + 4 * lane + 256 * k); }
#pragma unroll 1
        for (int tk = 0; tk < 4; ++tk) {
            const unsigned t = (unsigned)(u * 32 + 4 * w + tk);
            const char* hsb = (const char*)hs; const char* pfb = (const char*)Pf; const char* pbb = (const char*)Pb;
            const char* yab = (const char*)yatt; const char* ymb = (const char*)ymem; const char* prb = (const char*)proj; char* yb = (char*)Y;
            const unsigned o_h = t * 4096u + 16u * lane, o_p = t * 2048u + 8u * lane, o_m = t * 2048u + 16u * lane;
            const unsigned o_pr = t * (unsigned)(INW * 2), o_y = t * 8192u;
            f32x4 h4[4]; u32x2 pf[4], pb[4], zl[4]; u32x4 va[4], vm[2], za[4], zm[2];
#pragma unroll
            for (int k = 0; k < 4; ++k) { h4[k] = *(const f32x4*)(hsb + o_h + 1024u * k); pf[k] = *(const u32x2*)(pfb + o_p + 512u * k); pb[k] = *(const u32x2*)(pbb + o_p + 512u * k); va[k] = *(const u32x4*)(yab + o_h + 1024u * k); }
#pragma unroll
            for (int k = 0; k < 2; ++k) vm[k] = *(const u32x4*)(ymb + o_m + 1024u * k);
#pragma unroll
            for (int k = 0; k < 4; ++k) { zl[k] = *(const u32x2*)(prb + o_pr + (unsigned)((C_ZL + 4 * lane + 256 * k) * 2)); za[k] = *(const u32x4*)(prb + o_pr + (unsigned)((C_ZA + 8 * lane + 512 * k) * 2)); }
#pragma unroll
            for (int k = 0; k < 2; ++k) zm[k] = *(const u32x4*)(prb + o_pr + (unsigned)((C_ZM + 8 * lane + 512 * k) * 2));
            __builtin_amdgcn_sched_barrier(0);
            f32x4 v[4]; float ssl = 0.f, ssa = 0.f, ssm = 0.f;
#pragma unroll
            for (int k = 0; k < 4; ++k) {
                v[k][0] = h4[k][0] + bflo(pf[k].x) * cf[k][0] + bflo(pb[k].x) * cb[k][0]; v[k][1] = h4[k][1] + bfhi(pf[k].x) * cf[k][1] + bfhi(pb[k].x) * cb[k][1];
                v[k][2] = h4[k][2] + bflo(pf[k].y) * cf[k][2] + bflo(pb[k].y) * cb[k][2]; v[k][3] = h4[k][3] + bfhi(pf[k].y) * cf[k][3] + bfhi(pb[k].y) * cb[k][3];
                ssl += (v[k][0] * v[k][0] + v[k][1] * v[k][1]) + (v[k][2] * v[k][2] + v[k][3] * v[k][3]);
                { const float f0 = bflo(va[k].x), f1 = bfhi(va[k].x), f2 = bflo(va[k].y), f3 = bfhi(va[k].y), f4 = bflo(va[k].z), f5 = bfhi(va[k].z), f6 = bflo(va[k].w), f7 = bfhi(va[k].w);
                  ssa += ((f0 * f0 + f1 * f1) + (f2 * f2 + f3 * f3)) + ((f4 * f4 + f5 * f5) + (f6 * f6 + f7 * f7)); } }
#pragma unroll
            for (int k = 0; k < 2; ++k) { const float f0 = bflo(vm[k].x), f1 = bfhi(vm[k].x), f2 = bflo(vm[k].y), f3 = bfhi(vm[k].y), f4 = bflo(vm[k].z), f5 = bfhi(vm[k].z), f6 = bflo(vm[k].w), f7 = bfhi(vm[k].w);
                ssm += ((f0 * f0 + f1 * f1) + (f2 * f2 + f3 * f3)) + ((f4 * f4 + f5 * f5) + (f6 * f6 + f7 * f7)); }
#pragma unroll
            for (int o = 1; o < 64; o <<= 1) { ssl += __shfl_xor(ssl, o); ssa += __shfl_xor(ssa, o); ssm += __shfl_xor(ssm, o); }
            const float rsl = 1.f / sqrtf(ssl * (1.f / 1024.f) + EPSN), rsa = 1.f / sqrtf(ssa * (1.f / 2048.f) + EPSN), rsm = 1.f / sqrtf(ssm * (1.f / 1024.f) + EPSN);
            __builtin_amdgcn_sched_barrier(0);
#pragma unroll
            for (int k = 0; k < 4; ++k) { const int c = 4 * lane + 256 * k; const f32x4 g4 = *(const LAS f32x4*)(gl + 2048 + c); const u32x2 z = zl[k];
                u32x2 o; o.x = pk2(v[k][0] * rsl * g4[0] * silu_(bflo(z.x)), v[k][1] * rsl * g4[1] * silu_(bfhi(z.x))); o.y = pk2(v[k][2] * rsl * g4[2] * silu_(bflo(z.y)), v[k][3] * rsl * g4[3] * silu_(bfhi(z.y)));
                *(u32x2*)(yb + o_y + (unsigned)((2048 + c) * 2)) = o; }
            __builtin_amdgcn_sched_barrier(0);
#pragma unroll
            for (int k = 0; k < 4; ++k) { const int c = 8 * lane + 512 * k; const f32x4 g0 = *(const LAS f32x4*)(gl + c), g1 = *(const LAS f32x4*)(gl + c + 4); const u32x4 z = za[k];
                u32x4 o; o.x = pk2(bflo(va[k].x) * rsa * g0[0] * silu_(bflo(z.x)), bfhi(va[k].x) * rsa * g0[1] * silu_(bfhi(z.x)));
                o.y = pk2(bflo(va[k].y) * rsa * g0[2] * silu_(bflo(z.y)), bfhi(va[k].y) * rsa * g0[3] * silu_(bfhi(z.y)));
                o.z = pk2(bflo(va[k].z) * rsa * g1[0] * silu_(bflo(z.z)), bfhi(va[k].z) * rsa * g1[1] * silu_(bfhi(z.z)));
                o.w = pk2(bflo(va[k].w) * rsa * g1[2] * silu_(bflo(z.w)), bfhi(va[k].w) * rsa * g1[3] * silu_(bfhi(z.w)));
                *(u32x4*)(yb + o_y + (unsigned)(c * 2)) = o; }
            __builtin_amdgcn_sched_barrier(0);
#pragma unroll
            for (int k = 0; k < 2; ++k) { const int c = 8 * lane + 512 * k; const f32x4 g0 = *(const LAS f32x4*)(gl + 3072 + c), g1 = *(const LAS f32x4*)(gl + 3072 + c + 4); const u32x4 z = zm[k];
                u32x4 o; o.x = pk2(bflo(vm[k].x) * rsm * g0[0] * silu_(bflo(z.x)), bfhi(vm[k].x) * rsm * g0[1] * silu_(bfhi(z.x)));
                o.y = pk2(bflo(vm[k].y) * rsm * g0[2] * silu_(bflo(z.y)), bfhi(vm[k].y) * rsm * g0[3] * silu_(bfhi(z.y)));
                o.z = pk2(bflo(vm[k].z) * rsm * g1[0] * silu_(bflo(z.z)), bfhi(vm[k].z) * rsm * g1[1] * silu_(bfhi(z.z)));
                o.w = pk2(bflo(vm[k].w) * rsm * g1[2] * silu_(bflo(z.w)), bfhi(vm[k].w) * rsm * g1[3] * silu_(bfhi(z.w)));
                *(u32x4*)(yb + o_y + (unsigned)((3072 + c) * 2)) = o; }
        }
    }
}

#define XB_TMO      128
#define XB_XCNT(j)  (256  + 64 * (j))
#define XB_XSUB(j)  (1280 + 64 * (j))
#define XB_XGEN(j)  (2304 + 64 * (j))
#define XB_TOP      3328
#define XB_TOPGEN   3392
#define XCD_BAR_WORDS 3456
#define XB_SPIN_CAP (1u << 18)

__device__ __forceinline__ unsigned xb_ld(unsigned* p)              { return __hip_atomic_load(p, __ATOMIC_RELAXED, __HIP_MEMORY_SCOPE_AGENT); }
__device__ __forceinline__ unsigned xb_add(unsigned* p, unsigned v) { return __hip_atomic_fetch_add(p, v, __ATOMIC_RELAXED, __HIP_MEMORY_SCOPE_AGENT); }
__device__ __forceinline__ unsigned xb_xcc_id() { return (unsigned)__builtin_amdgcn_s_getreg((3 << 11) | 20) & 0xFu; }
#define XB_SPIN(cond, bar) do { unsigned _sp = 0; while (cond) { __builtin_amdgcn_s_sleep(1); \
    if ((++_sp & 255u) == 0u) { if (xb_ld(&(bar)[XB_TMO])) break; if (_sp > XB_SPIN_CAP) { atomicAdd(&(bar)[XB_TMO], 1u); break; } } } } while (0)

struct XcdBarrier {
    unsigned* bar; unsigned x;
    volatile LAS unsigned* st;
};

__device__ __forceinline__ XcdBarrier xcd_barrier_post(unsigned* bar, volatile LAS unsigned* st) {
    XcdBarrier b; b.bar = bar; b.x = xb_xcc_id(); b.st = st;
    if (threadIdx.x == 0) (void)xb_add(&bar[XB_XCNT(b.x)], 1u);
    return b;
}
__device__ __forceinline__ void xcd_barrier_complete(unsigned* bar, unsigned x, unsigned& nloc, unsigned& nx) {
    const unsigned G = gridDim.x * gridDim.y * gridDim.z;
    unsigned sum, cnt, mine, sp = 0u;
    for (;;) {
        sum = 0u; cnt = 0u; mine = 0u;
#pragma unroll
        for (unsigned j = 0; j < 16; ++j) { const unsigned c = xb_ld(&bar[XB_XCNT(j)]); sum += c; cnt += (c > 0u) ? 1u : 0u; mine = (j == x) ? c : mine; }
        if (sum == G) break;
        __builtin_amdgcn_s_sleep(1);
        if ((++sp & 255u) == 0u) { if (xb_ld(&bar[XB_TMO])) break; if (sp > XB_SPIN_CAP) { atomicAdd(&bar[XB_TMO], 1u); break; } }
    }
    nloc = mine > 0u ? mine : 1u; nx = cnt > 0u ? cnt : 1u;
}

__device__ __forceinline__ void xcd_barrier(const XcdBarrier& b) {
    asm volatile("s_waitcnt vmcnt(0)" ::: "memory");
    __syncthreads();
    if (threadIdx.x == 0) {
        unsigned* bar = b.bar;
        __builtin_amdgcn_s_waitcnt(0);
        unsigned nloc = b.st[0], nx = b.st[1];
        if (nloc == 0u) { xcd_barrier_complete(bar, b.x, nloc, nx); b.st[0] = nloc; b.st[1] = nx; }
        const unsigned old = xb_add(&bar[XB_XSUB(b.x)], 1u);
        const unsigned gen = old / nloc;
        if (old + 1u == (gen + 1u) * nloc) {
            __builtin_amdgcn_fence(__ATOMIC_RELEASE, "agent");
            asm volatile("s_waitcnt vmcnt(0)" ::: "memory");
            const unsigned og = xb_add(&bar[XB_TOP], 1u);
            const unsigned tg = og / nx;
            if (og + 1u == (tg + 1u) * nx) xb_add(&bar[XB_TOPGEN], 1u);
            else XB_SPIN(xb_ld(&bar[XB_TOPGEN]) == tg, bar);
            __builtin_amdgcn_fence(__ATOMIC_ACQUIRE, "agent");
            xb_add(&bar[XB_XGEN(b.x)], 1u);
            asm volatile("s_waitcnt vmcnt(0)" ::: "memory");
        } else {
            XB_SPIN(xb_ld(&bar[XB_XGEN(b.x)]) == gen, bar);
            __builtin_amdgcn_fence(__ATOMIC_ACQUIRE, "agent");
            asm volatile("s_waitcnt vmcnt(0)" ::: "memory");
        }
    }
    __syncthreads();
}

struct Sched2 {
    int c;
    __device__ bool next(int i, pg8::Unit& u) const {
        if (i >= 2) return false;
        const int x = c & 7, j = c >> 3;
        u.pm = i * 16 + 4 * (x >> 1) + (j & 3); u.pn = 8 * (x & 1) + (j >> 2); return true;
    }
    __device__ __forceinline__ void a_ready(const pg8::Unit&) const {}
    __device__ __forceinline__ void done(const pg8::Unit&) const {}
};
struct Epi3 {
    static constexpr bool PERM = true, AFTER_DRAIN = false, HOLD_LAST = true;
    float* out; bf16_t* t0; float* sspart; const float* x; const float* gain; XcdBarrier xbar;
    __device__ __forceinline__ void operator()(const f32x4 (&acc)[2][2][4][2], const pg8::Unit& u, int wr, int wc, int fr, int fq) const {
#pragma unroll
        for (int ai = 0; ai < 2; ++ai)
#pragma unroll
            for (int m = 0; m < 4; ++m) { const int row = u.pm * 256 + ai * 128 + wr * 64 + m * 16 + fr; float ss = 0.f;
#pragma unroll
                for (int bj = 0; bj < 2; ++bj) { const f32x4 v0 = acc[ai][bj][m][0], v1 = acc[ai][bj][m][1]; const int col = u.pn * 256 + bj * 128 + wc * 32 + 8 * fq;
                    u32x4 pk; pk.x = pk2(v0[0], v0[1]); pk.y = pk2(v0[2], v0[3]); pk.z = pk2(v1[0], v1[1]); pk.w = pk2(v1[2], v1[3]); *(u32x4*)(t0 + (size_t)row * 4096 + col) = pk;
                    ss += ((v0[0] * v0[0] + v0[1] * v0[1]) + (v0[2] * v0[2] + v0[3] * v0[3])) + ((v1[0] * v1[0] + v1[1] * v1[1]) + (v1[2] * v1[2] + v1[3] * v1[3])); }
                ss += __shfl_xor(ss, 16); ss += __shfl_xor(ss, 32);
                if (fq == 0) sspart[(size_t)row * 64 + u.pn * 4 + wc] = ss; }
    }
    __device__ __forceinline__ void fused(f32x4 (&acc)[2][2][4][2], const pg8::Unit& u, int wr, int wc, int fr, int fq, LAS unsigned char* lds, int wid, int lane) const {
#pragma unroll
        for (int ai = 0; ai < 2; ++ai)
#pragma unroll
            for (int m = 0; m < 4; ++m) { const int row = u.pm * 256 + ai * 128 + wr * 64 + m * 16 + fr; float ss = 0.f;
#pragma unroll
                for (int bj = 0; bj < 2; ++bj)
#pragma unroll
                    for (int n = 0; n < 2; ++n) { const f32x4 v = acc[ai][bj][m][n]; ss += (v[0] * v[0] + v[1] * v[1]) + (v[2] * v[2] + v[3] * v[3]); }
                ss += __shfl_xor(ss, 16); ss += __shfl_xor(ss, 32);
                if (fq == 0) sspart[(size_t)row * 64 + u.pn * 4 + wc] = ss; }
        xcd_barrier(xbar);
        constexpr int TP = 260;
        LAS float* T = (LAS float*)lds;
        LAS float* rsT = (LAS float*)(lds + 128 * TP * 4);
        { const int tid = wid * 64 + lane, row = tid >> 1, hf = tid & 1;
          const f32x4* p = (const f32x4*)(sspart + (size_t)(u.pm * 256 + row) * 64 + hf * 32);
          float s = 0.f;
#pragma unroll
          for (int i = 0; i < 8; ++i) { const f32x4 v = p[i]; s += (v[0] + v[1]) + (v[2] + v[3]); }
          s += __shfl_xor(s, 1);
          if (hf == 0) rsT[row] = 1.f / sqrtf(s * (1.f / 4096.f) + EPSN); }
        const f32x4 gv = *(const f32x4*)(gain + u.pn * 256 + 4 * lane);
#pragma unroll
        for (int ai = 0; ai < 2; ++ai) {
            __syncthreads();
#pragma unroll
            for (int m = 0; m < 4; ++m)
#pragma unroll
                for (int bj = 0; bj < 2; ++bj)
#pragma unroll
                    for (int n = 0; n < 2; ++n) *(LAS f32x4*)(T + (wr * 64 + m * 16 + fr) * TP + bj * 128 + wc * 32 + 8 * fq + 4 * n) = acc[ai][bj][m][n];
            __syncthreads();
#pragma unroll 4
            for (int r = 0; r < 16; ++r) { const int rl = wid * 16 + r; const size_t go = (size_t)(u.pm * 256 + ai * 128 + rl) * 4096 + u.pn * 256 + 4 * lane;
                const f32x4 tv = *(const LAS f32x4*)(T + rl * TP + 4 * lane); const float rs = rsT[ai * 128 + rl];
                const f32x4 xv = *(const f32x4*)(x + go);
                *(f32x4*)(out + go) = xv + tv * rs * gv; }
        }
    }
};
__device__ __forceinline__ void phase6(const Args& a) {
    int tid = threadIdx.x; asm volatile("" : "+v"(tid)); const int lane = tid & 63, w = tid >> 6;
    const float* sspart = (const float*)(a.ws + WS_SS); const bf16_t* t0 = (const bf16_t*)(a.ws + WS_T0);
    f32x4 gv[16];
#pragma unroll
    for (int k = 0; k < 16; ++k) gv[k] = ((const f32x4*)a.in[18])[2 * lane + 128 * (k >> 1) + (k & 1)];
    for (int row = blockIdx.x * 8 + w; row < 4096; row += gridDim.x * 8) {
        const u32x4* t4 = (const u32x4*)(t0 + (size_t)row * 4096) + lane; f32x4* o4 = (f32x4*)(a.out + (size_t)row * 4096) + 2 * lane;
        const f32x4* x4 = (const f32x4*)(a.in[0] + (size_t)row * 4096) + 2 * lane;
        u32x4 tv[8]; f32x4 xa[8], xb[8];
        const float sp = sspart[(size_t)row * 64 + lane];
#pragma unroll
        for (int k = 0; k < 8; ++k) { tv[k] = t4[64 * k]; xa[k] = x4[128 * k]; xb[k] = x4[128 * k + 1]; }
        const float rs = 1.f / sqrtf(wave_sum(sp) * (1.f / 4096.f) + EPSN);
#pragma unroll
        for (int k = 0; k < 8; ++k) { const f32x4 ga = gv[2 * k], gb = gv[2 * k + 1];
            f32x4 oa, ob; oa[0] = xa[k][0] + bflo(tv[k].x) * rs * ga[0]; oa[1] = xa[k][1] + bfhi(tv[k].x) * rs * ga[1]; oa[2] = xa[k][2] + bflo(tv[k].y) * rs * ga[2]; oa[3] = xa[k][3] + bfhi(tv[k].y) * rs * ga[3];
            ob[0] = xb[k][0] + bflo(tv[k].z) * rs * gb[0]; ob[1] = xb[k][1] + bfhi(tv[k].z) * rs * gb[1]; ob[2] = xb[k][2] + bflo(tv[k].w) * rs * gb[2]; ob[3] = xb[k][3] + bfhi(tv[k].w) * rs * gb[3];
            o4[128 * k] = oa; o4[128 * k + 1] = ob; }
    }
}

__global__ void __launch_bounds__(512, 2) mega(Args a) {
    extern __shared__ __attribute__((aligned(16))) unsigned char lds_raw[];
    LAS unsigned char* lds = (LAS unsigned char*)lds_raw;
    cg::grid_group grid = cg::this_grid();
    unsigned char* ws = a.ws;
    volatile LAS unsigned* xst = (volatile LAS unsigned*)(lds + LDS_BYTES - 64);
    if (threadIdx.x < 16) xst[threadIdx.x] = 0u;
    __syncthreads();
    XcdBarrier xbar; xbar.bar = (unsigned*)(ws + WS_CTL); xbar.x = 0; xbar.st = nullptr;
    xbar = xcd_barrier_post((unsigned*)(ws + WS_CTL), xst);
    const int lo = a.ph_lo, hi = a.ph_hi;
#define IN(k) (lo <= (k) && (k) < hi)
#define SEAM(k) do { if (IN(k) && IN((k) + 1)) { if ((k) == 1) { __syncthreads(); grid.sync(); } else xcd_barrier(xbar); } } while (0)
    if (IN(0)) { if (PHMASK & 1) phase0(a, lds); if (REPMASK & 1) { __syncthreads(); phase0(a, lds); } }
    SEAM(0);
    if (IN(1)) { if (PHMASK & 2) {
        pg8::Gemm g{(const bf16_t*)(ws + WS_U), (const bf16_t*)(ws + WS_WT), SEQ + NMEM, INW + 2048, 4096};
        Sched1 S; S.init((int)gridDim.x, (int)blockIdx.x);
        Epi1 E{(bf16_t*)(ws + WS_PROJ), (bf16_t*)(ws + WS_VT), (bf16_t*)(ws + WS_MK), (bf16_t*)(ws + WS_MVT), (const float*)(ws + WS_ROPE)};
        pg8::gemm_phase<Epi1, Sched1, true, true>(lds, g, S, E);
        {
            const int G = (int)gridDim.x, nfull = 1160 % G, nidle = (nfull == 0) ? G : G - nfull;
            const int bi = (nfull == 0) ? (int)blockIdx.x : (int)blockIdx.x - nfull;
            if (bi >= 0) {
                int tid = threadIdx.x; asm volatile("" : "+v"(tid)); const int lane = tid & 63, w = tid >> 6;
                LAS float* scr = (LAS float*)(lds + w * 16384);
                p0_transpose_matrix(a.in[17], 4096, 4096, (bf16_t*)(ws + WS_WOUT), 0, scr, bi * 8 + w, nidle * 8, lane);
            }
        }
        if (REPMASK & 2) { __syncthreads(); pg8::gemm_phase<Epi1, Sched1, true, true>(lds, g, S, E); }
    } }
    SEAM(1);
    if (IN(2)) { if (PHMASK & 4) phase2(a, lds, P2MASK); }
    SEAM(2);
    if (IN(3)) { if (PHMASK & 8) phase3(a, lds); if (REPMASK & 8) { __syncthreads(); phase3(a, lds); } }
    SEAM(3);
    if (IN(4)) { if (PHMASK & 16) phase4(a, lds); if (REPMASK & 16) { __syncthreads(); phase4(a, lds); } }
    SEAM(4);
    if (IN(5)) { if (PHMASK & 32) {
        pg8::Gemm g{(const bf16_t*)(ws + WS_Y), (const bf16_t*)(ws + WS_WOUT), SEQ, 4096, 4096};
        Sched2 S; S.c = (int)blockIdx.x;
        Epi3 E{a.out, (bf16_t*)(ws + WS_T0), (float*)(ws + WS_SS), a.in[0], a.in[18], xbar};
        pg8::gemm_phase<Epi3, Sched2, true, true>(lds, g, S, E);
    } }
    if (IN(6)) { if (PHMASK & 64) phase6(a); }
#if N_LAUNCHES != 1
    if (lo >= 7 && lo < 10) phase2(a, lds, 1 << (lo - 7));
    if (lo == 11 || lo == 12) {
        pg8::Gemm g{(const bf16_t*)(ws + WS_U), (const bf16_t*)(ws + WS_WT), SEQ + NMEM, INW + 2048, 4096};
        Sched1 S; S.init((int)gridDim.x, (int)blockIdx.x); if (lo == 11) S.imax = 4; else S.ioff = 4;
        Epi1 E{(bf16_t*)(ws + WS_PROJ), (bf16_t*)(ws + WS_VT), (bf16_t*)(ws + WS_MK), (bf16_t*)(ws + WS_MVT), (const float*)(ws + WS_ROPE)};
        pg8::gemm_phase<Epi1, Sched1, true, true>(lds, g, S, E);
    }
    if (lo == 13) {
        pg8::Gemm g{(const bf16_t*)(ws + WS_U), (const bf16_t*)(ws + WS_WT), SEQ + NMEM, INW + 2048, 4096};
        Sched1 S; S.init((int)gridDim.x, (int)blockIdx.x); S.imax = 4;
        pg8::EpiBf16<0> E{(bf16_t*)(ws + WS_HS), INW, nullptr, 0, 0, 1.f};
        pg8::gemm_phase<pg8::EpiBf16<0>, Sched1, true, true>(lds, g, S, E);
    }
#ifdef LRUVAR
    if (lo == 10) lru_phase<LRUVAR>(lds, a, (int)(blockIdx.x & 7), (int)(blockIdx.x >> 3), (int)(gridDim.x >> 3));
#endif
#endif
#undef IN
#undef SEAM
}

extern "C" void kernel_launch(void* const* d_in, const int* in_sizes, int n_in, void* d_out, int out_size, void* d_ws, size_t ws_size, hipStream_t stream) {
    static int grid = 0;
    if (grid == 0) {
        if (n_in != 19 || ws_size < WS_END) { fprintf(stderr, "kernel_launch: unexpected n_in %d or ws_size %zu (need %zu)\n", n_in, ws_size, (size_t)WS_END); grid = -1; return; }
        int dev = 0, cus = 0, per_cu = 0;
        hipGetDevice(&dev); hipDeviceGetAttribute(&cus, hipDeviceAttributeMultiprocessorCount, dev);
        if (hipFuncSetAttribute((const void*)mega, hipFuncAttributeMaxDynamicSharedMemorySize, LDS_BYTES) != hipSuccess) { fprintf(stderr, "kernel_launch: hipFuncSetAttribute failed\n"); grid = -1; return; }
        if (hipOccupancyMaxActiveBlocksPerMultiprocessor(&per_cu, (const void*)mega, 512, LDS_BYTES) != hipSuccess || per_cu < 1) { fprintf(stderr, "kernel_launch: occupancy query says %d\n", per_cu); per_cu = 1; }
        (void)hipGetLastError();
        if (cus < 256) { fprintf(stderr, "kernel_launch: needs 256 CUs (one workgroup per CU), device has %d\n", cus); grid = -1; return; }
        grid = 256;
    }
    if (grid < 0) return;
    Args a{};
    for (int i = 0; i < 19; ++i) a.in[i] = (const float*)d_in[i];
    a.out = (float*)d_out; a.ws = (unsigned char*)d_ws;
#if N_LAUNCHES == 1
    (void)hipMemsetAsync((char*)d_ws + WS_CTL, 0, 65536, stream);
    a.ph_lo = 0; a.ph_hi = NPH;
    void* args[] = {&a};
    hipError_t e = hipLaunchCooperativeKernel((const void*)mega, dim3(grid), dim3(512), args, LDS_BYTES, stream);
    if (e != hipSuccess) fprintf(stderr, "cooperative launch failed: %s (grid %d)\n", hipGetErrorString(e), grid);
#else
#ifndef PHSEQ
#define PHSEQ 0,1,2,3,4,5,6
#endif
    { const int seq[] = {PHSEQ};
      for (unsigned i = 0; i < sizeof(seq) / sizeof(int); ++i) { a.ph_lo = seq[i]; a.ph_hi = seq[i] + 1; (void)hipMemsetAsync((char*)d_ws + WS_CTL, 0, 65536, stream); hipLaunchKernelGGL(mega, dim3(grid), dim3(512), LDS_BYTES, stream, a); } }
#endif
}
```

```cpp
#include <hip/hip_runtime.h>
#include <hip/hip_cooperative_groups.h>
#include <cstdio>
#include <cstdint>
namespace cg = cooperative_groups;
#define N_LAUNCHES 1
namespace pg8 {
#define PG8_LAS __attribute__((address_space(3)))
typedef unsigned short bf16_t;
typedef short bf16x8 __attribute__((ext_vector_type(8)));
typedef float f32x4 __attribute__((ext_vector_type(4)));
typedef unsigned u32x4 __attribute__((ext_vector_type(4)));
constexpr int BM = 256, BK = 64, HALF = 128, HTB = HALF * BK * 2  , STAGE_BYTES = 8 * HTB, NXCD = 8, WGM = 8;

__host__ __device__ __forceinline__ int lds_byte(int r, int c) { const int st = (r >> 4) * 2 + (c >> 5), rr = r & 15, cc = c & 31, ob = rr * 64 + cc * 2; return st * 1024 + (ob ^ (((ob >> 9) & 1) << 5)); }
__host__ __device__ __forceinline__ void stage_rc(int b, int& R, int& C) { const int st = b / 1024, sb = b % 1024, swz = sb ^ (((sb >> 9) & 1) << 5); R = (st >> 1) * 16 + swz / 64; C = (st & 1) * 32 + (swz % 64) / 2; }
__host__ __device__ __forceinline__ int perm32(int rho) { const int n = rho >> 4, i = rho & 15; return 8 * (i >> 2) + 4 * n + (i & 3); }

struct Unit { int pm, pn; };
struct Gemm { const bf16_t* A; const bf16_t* Bt; int M, N, K; };

struct StaticOrder {
    int nM, nN, nwg, G, c;
    __host__ __device__ void init(int M, int N, int G_, int c_) { nM = M / BM; nN = N / BM; nwg = nM * nN; G = G_; c = c_; }
    __host__ __device__ bool next(int i, Unit& u) const {
        const long L = (long)i * G + c; if (L >= nwg) return false;
        int wgid = (int)L; { const int q = nwg / NXCD, r = nwg % NXCD, xcd = wgid % NXCD, off = wgid / NXCD; wgid = (xcd < r ? xcd * (q + 1) : r * (q + 1) + (xcd - r) * q) + off; }
        const int nig = WGM * nN, gid = wgid / nig, fm = gid * WGM, gsz = (nM - fm) < WGM ? (nM - fm) : WGM;
        u.pm = fm + ((wgid % nig) % gsz); u.pn = (wgid % nig) / gsz; return true;
    }
    __device__ __forceinline__ void a_ready(const Unit&) const {}
    __device__ __forceinline__ void done(const Unit&) const {}
};

__device__ __forceinline__ unsigned cvt_pk_bf16(float lo, float hi) { unsigned r; asm volatile("v_cvt_pk_bf16_f32 %0, %1, %2" : "=v"(r) : "v"(lo), "v"(hi)); return r; }
typedef float f32x2 __attribute__((ext_vector_type(2)));
__device__ __forceinline__ f32x2 gelu_pk(f32x2 v) {
    const f32x2 av = __builtin_elementwise_abs(v), d = av * 0.2316418882f + 1.0f;
    f32x2 t; t.x = __builtin_amdgcn_rcpf(d.x); t.y = __builtin_amdgcn_rcpf(d.y);
    f32x2 q = t * 0.5307027145f + (-0.7265760135f); q = q * t + 0.7107068705f; q = q * t + (-0.142248368f); q = q * t + 0.127414796f; q = q * t;
    const f32x2 s = (v * v) * (-0.72134752044f);
    f32x2 e; e.x = __builtin_amdgcn_exp2f(s.x); e.y = __builtin_amdgcn_exp2f(s.y);
    const f32x2 m = v * (q * e), r = v - m;
    f32x2 o; o.x = v.x < 0.f ? m.x : r.x; o.y = v.y < 0.f ? m.y : r.y; return o;
}

template <int ACT  > struct EpiBf16 {
    static constexpr bool PERM = true, AFTER_DRAIN = false, HOLD_LAST = false; static_assert(ACT == 0 || ACT == 1, "EpiBf16: ACT is 0 (none) or 1 (gelu_pk)");
    bf16_t* O; int ldc; const float* bias; int split_cols; size_t split_stride; float scale0;
    __device__ __forceinline__ void operator()(const f32x4 (&acc)[2][2][4][2], const Unit& u, int wr, int wc, int fr, int fq) const {
        const int row0 = u.pm * BM + wr * 64 + fr; int colt = u.pn * BM; bf16_t* base = O;
        float sc = 1.f; if (split_cols) { const int t = colt / split_cols; base += (size_t)t * split_stride; colt -= t * split_cols; if (t == 0) sc = scale0; }
        const int col0 = colt + wc * 32 + 8 * fq, bcol0 = u.pn * BM + wc * 32 + 8 * fq;
        f32x4 bv[2][2];
#pragma unroll
        for (int bj = 0; bj < 2; ++bj)
#pragma unroll
            for (int n = 0; n < 2; ++n) bv[bj][n] = bias ? *(const f32x4*)(bias + bcol0 + bj * HALF + 4 * n) : (f32x4){0.f, 0.f, 0.f, 0.f};
#pragma unroll
        for (int ai = 0; ai < 2; ++ai)
#pragma unroll
            for (int m = 0; m < 4; ++m) { bf16_t* rowp = base + (size_t)(row0 + ai * HALF + m * 16) * ldc + col0;
#pragma unroll
                for (int bj = 0; bj < 2; ++bj) { f32x4 v0 = acc[ai][bj][m][0] + bv[bj][0], v1 = acc[ai][bj][m][1] + bv[bj][1];
                    if (ACT == 1) { f32x2 a = gelu_pk((f32x2){v0[0], v0[1]}), b = gelu_pk((f32x2){v0[2], v0[3]}), c = gelu_pk((f32x2){v1[0], v1[1]}), d = gelu_pk((f32x2){v1[2], v1[3]});
                        v0 = (f32x4){a.x, a.y, b.x, b.y}; v1 = (f32x4){c.x, c.y, d.x, d.y}; }
                    v0 = v0 * sc; v1 = v1 * sc; u32x4 w; w.x = cvt_pk_bf16(v0[0], v0[1]); w.y = cvt_pk_bf16(v0[2], v0[3]); w.z = cvt_pk_bf16(v1[0], v1[1]); w.w = cvt_pk_bf16(v1[2], v1[3]);
                    *(u32x4*)(rowp + bj * HALF) = w; } }
    }
};
template <class Epi, class Sched, bool ALIGN_EPI = false, bool SP2 = false>
__device__ __forceinline__ void gemm_phase(PG8_LAS unsigned char* lds, const Gemm g, const Sched& S, const Epi& E) {
    int tid_ = threadIdx.x; asm volatile("" : "+v"(tid_)); const int tid = tid_, wid = __builtin_amdgcn_readfirstlane(tid >> 6), lane = tid & 63, wr = wid >> 2, wc = wid & 3, fr = lane & 15, fq = lane >> 4;
    const int K = g.K, nt = K / BK;
    unsigned voffA[2], voffB[2];
#pragma unroll
    for (int i = 0; i < 2; ++i) { int R, C; stage_rc(tid * 16 + i * 8192, R, C); const int Rb = Epi::PERM ? ((R & ~31) + perm32(R & 31)) : R;
        voffA[i] = (unsigned)(R * K + C) * 2u; voffB[i] = (unsigned)(Rb * K + C) * 2u; }
    const size_t kstep = (size_t)(BK * 2);
    const size_t hstep = (size_t)HALF * K * 2;
    const size_t tstep = 2 * hstep;
    const unsigned ldsw = (unsigned)wid * 1024u;
    const int aoff = lds_byte(wr * 64 + fr, fq * 8), boff = lds_byte(wc * 32 + fr, fq * 8);
#define PG8_SA(b, h) (((b) * 2 + (h)) * HTB)
#define PG8_SB(b, h) ((4 + (b) * 2 + (h)) * HTB)
#define PG8_STAGE(bufoff, gbase, voff) do { _Pragma("unroll") for (int _i = 0; _i < 2; ++_i) \
        __builtin_amdgcn_global_load_lds((const unsigned*)((const char*)(gbase) + (voff)[_i]), (PG8_LAS unsigned*)(lds + (bufoff) + ldsw + _i * 8192), 16, 0, 0); } while (0)
#define PG8_LDA(dst, b, h) do { _Pragma("unroll") for (int m = 0; m < 4; ++m) _Pragma("unroll") for (int k = 0; k < 2; ++k) dst[m][k] = *(const PG8_LAS bf16x8*)(lds + PG8_SA(b, h) + aoff + m * 2048 + k * 1024); } while (0)
#define PG8_LDB(dst, b, h) do { _Pragma("unroll") for (int n = 0; n < 2; ++n) _Pragma("unroll") for (int k = 0; k < 2; ++k) dst[n][k] = *(const PG8_LAS bf16x8*)(lds + PG8_SB(b, h) + boff + n * 2048 + k * 1024); } while (0)
#define PG8_MMA(ai, bj, At, Bt) do { __builtin_amdgcn_s_setprio(1); _Pragma("unroll") for (int m = 0; m < 4; ++m) _Pragma("unroll") for (int n = 0; n < 2; ++n) _Pragma("unroll") for (int k = 0; k < 2; ++k) \
        acc[ai][bj][m][n] = __builtin_amdgcn_mfma_f32_16x16x32_bf16(Bt[n][k], At[m][k], acc[ai][bj][m][n], 0, 0, 0); __builtin_amdgcn_s_setprio(0); } while (0)
#define PG8_WAIT_V(n) asm volatile("s_waitcnt vmcnt(" #n ")" ::: "memory")
#define PG8_WAIT_L(n) asm volatile("s_waitcnt lgkmcnt(" #n ")" ::: "memory")
#define PG8_BAR __builtin_amdgcn_s_barrier()
#define PG8_SCHED __builtin_amdgcn_sched_barrier(0)
    Unit cur, nxt; int ui = 0;
    if (!S.next(0, cur)) return;
    f32x4 acc[2][2][4][2];
#pragma unroll
    for (int a = 0; a < 2; ++a)
#pragma unroll
        for (int b = 0; b < 2; ++b)
#pragma unroll
            for (int m = 0; m < 4; ++m)
#pragma unroll
                for (int n = 0; n < 2; ++n) acc[a][b][m][n] = (f32x4){0.f, 0.f, 0.f, 0.f};
    bf16x8 At[4][2], B0[2][2], B1[2][2];
    const char* cA = (const char*)g.A + (size_t)cur.pm * tstep; const char* cB = (const char*)g.Bt + (size_t)cur.pn * tstep;
    S.a_ready(cur);
    if constexpr (SP2) {
        PG8_STAGE(PG8_SB(0, 0), cB, voffB); PG8_STAGE(PG8_SB(0, 1), cB + hstep, voffB); PG8_STAGE(PG8_SA(0, 0), cA, voffA); PG8_STAGE(PG8_SA(0, 1), cA + hstep, voffA);
        if (wr == 1) PG8_BAR;
        PG8_WAIT_V(2); PG8_BAR;
        PG8_STAGE(PG8_SB(1, 0), cB + kstep, voffB); PG8_STAGE(PG8_SA(1, 0), cA + kstep, voffA); PG8_STAGE(PG8_SB(1, 1), cB + hstep + kstep, voffB);
        PG8_WAIT_V(6); PG8_BAR;
    } else {
        PG8_STAGE(PG8_SB(0, 0), cB, voffB); PG8_STAGE(PG8_SA(0, 0), cA, voffA); PG8_STAGE(PG8_SB(0, 1), cB + hstep, voffB); PG8_STAGE(PG8_SA(0, 1), cA + hstep, voffA);
        if (wr == 1) PG8_BAR;
        PG8_WAIT_V(4); PG8_BAR;
        PG8_STAGE(PG8_SB(1, 0), cB + kstep, voffB); PG8_STAGE(PG8_SA(1, 0), cA + kstep, voffA); PG8_STAGE(PG8_SB(1, 1), cB + hstep + kstep, voffB);
        PG8_WAIT_V(6); PG8_BAR;
    }
    for (;;) {
        const bool has_next = S.next(ui + 1, nxt);
        const char* nA = has_next ? (const char*)g.A + (size_t)nxt.pm * tstep : cA; const char* nB = has_next ? (const char*)g.Bt + (size_t)nxt.pn * tstep : cB;
        for (int t = 0; t < nt; t += 2) {
            const bool last = (t == nt - 2);
            const char* a1 = cA + (size_t)(t + 1) * kstep;
            const char* a2 = last ? nA : cA + (size_t)(t + 2) * kstep; const char* b2 = last ? nB : cB + (size_t)(t + 2) * kstep;
            const char* a3 = a2 + kstep; const char* b3 = b2 + kstep;
            if (last && has_next) S.a_ready(nxt);
            if constexpr (SP2) {
            PG8_LDB(B0, 0, 0); PG8_LDB(B1, 0, 1); PG8_SCHED; PG8_LDA(At, 0, 0); PG8_STAGE(PG8_SA(1, 1), a1 + hstep, voffA);
            PG8_WAIT_V(8); PG8_WAIT_L(0); PG8_BAR; PG8_MMA(0, 0, At, B0); PG8_MMA(0, 1, At, B1); PG8_BAR; PG8_SCHED;
            PG8_LDA(At, 0, 1); PG8_STAGE(PG8_SB(0, 0), b2, voffB); PG8_STAGE(PG8_SB(0, 1), b2 + hstep, voffB); PG8_STAGE(PG8_SA(0, 0), a2, voffA);
            PG8_WAIT_V(8); PG8_WAIT_L(0); PG8_BAR; PG8_MMA(1, 0, At, B0); PG8_MMA(1, 1, At, B1); PG8_BAR; PG8_SCHED;
            PG8_LDB(B0, 1, 0); PG8_LDB(B1, 1, 1); PG8_SCHED; PG8_LDA(At, 1, 0); PG8_STAGE(PG8_SA(0, 1), a2 + hstep, voffA);
            PG8_WAIT_V(8); PG8_WAIT_L(0); PG8_BAR; PG8_MMA(0, 0, At, B0); PG8_MMA(0, 1, At, B1); PG8_BAR; PG8_SCHED;
            PG8_LDA(At, 1, 1); PG8_STAGE(PG8_SB(1, 0), b3, voffB); PG8_STAGE(PG8_SB(1, 1), b3 + hstep, voffB); PG8_STAGE(PG8_SA(1, 0), a3, voffA);
            PG8_WAIT_V(8); PG8_WAIT_L(0); PG8_BAR; PG8_MMA(1, 0, At, B0); PG8_MMA(1, 1, At, B1); PG8_BAR; PG8_SCHED;
            } else {
            PG8_LDB(B0, 0, 0); PG8_SCHED; PG8_LDA(At, 0, 0); PG8_STAGE(PG8_SA(1, 1), a1 + hstep, voffA);
            PG8_WAIT_L(8); PG8_BAR; PG8_WAIT_L(0); PG8_MMA(0, 0, At, B0); PG8_BAR; PG8_SCHED;
            PG8_LDB(B1, 0, 1); PG8_STAGE(PG8_SB(0, 0), b2, voffB);
            PG8_BAR; PG8_WAIT_L(0); PG8_MMA(0, 1, At, B1); PG8_BAR;
            PG8_LDA(At, 0, 1); PG8_STAGE(PG8_SA(0, 0), a2, voffA);
            PG8_BAR; PG8_WAIT_L(0); PG8_MMA(1, 0, At, B0); PG8_BAR; PG8_SCHED;
            PG8_STAGE(PG8_SB(0, 1), b2 + hstep, voffB);
            PG8_WAIT_V(6); PG8_BAR; PG8_MMA(1, 1, At, B1); PG8_BAR;
            PG8_LDB(B0, 1, 0); PG8_SCHED; PG8_LDA(At, 1, 0); PG8_STAGE(PG8_SA(0, 1), a2 + hstep, voffA);
            PG8_WAIT_L(8); PG8_BAR; PG8_WAIT_L(0); PG8_MMA(0, 0, At, B0); PG8_BAR; PG8_SCHED;
            PG8_LDB(B1, 1, 1); PG8_STAGE(PG8_SB(1, 0), b3, voffB);
            PG8_BAR; PG8_WAIT_L(0); PG8_MMA(0, 1, At, B1); PG8_BAR;
            PG8_LDA(At, 1, 1); PG8_STAGE(PG8_SA(1, 0), a3, voffA);
            PG8_BAR; PG8_WAIT_L(0); PG8_MMA(1, 0, At, B0); PG8_BAR; PG8_SCHED;
            PG8_STAGE(PG8_SB(1, 1), b3 + hstep, voffB);
            PG8_WAIT_V(6); PG8_BAR; PG8_MMA(1, 1, At, B1); PG8_BAR;
            }
        }
        if constexpr (ALIGN_EPI) { if (wr == 0) PG8_BAR; }
        if constexpr (!Epi::AFTER_DRAIN) { if (!Epi::HOLD_LAST || has_next) { E(acc, cur, wr, wc, fr, fq); S.done(cur); } }
        if (!has_next) break;
#pragma unroll
        for (int a = 0; a < 2; ++a)
#pragma unroll
            for (int b = 0; b < 2; ++b)
#pragma unroll
                for (int m = 0; m < 4; ++m)
#pragma unroll
                    for (int n = 0; n < 2; ++n) acc[a][b][m][n] = (f32x4){0.f, 0.f, 0.f, 0.f};
        cur = nxt; cA = nA; cB = nB; ++ui;
        if constexpr (ALIGN_EPI) { if (wr == 1) PG8_BAR; }
    }
    PG8_WAIT_V(0);
    if constexpr (!ALIGN_EPI) { if (wr == 0) PG8_BAR; }
    PG8_BAR;
    if constexpr (Epi::AFTER_DRAIN || Epi::HOLD_LAST) { E.fused(acc, cur, wr, wc, fr, fq, lds, wid, lane); S.done(cur); }
#undef PG8_SA
#undef PG8_SB
#undef PG8_STAGE
#undef PG8_LDA
#undef PG8_LDB
#undef PG8_MMA
#undef PG8_WAIT_V
#undef PG8_WAIT_L
#undef PG8_BAR
#undef PG8_SCHED
}
}

#ifndef PHMASK
#define PHMASK 127
#endif
#ifndef REPMASK
#define REPMASK 0
#endif
#ifndef P2MASK
#define P2MASK 7
#endif
#ifndef N_LAUNCHES
#define N_LAUNCHES 1
#endif
using pg8::bf16_t; using pg8::bf16x8; using pg8::f32x4; using pg8::u32x4;
#define LAS __attribute__((address_space(3)))
typedef unsigned u32x2 __attribute__((ext_vector_type(2)));
typedef float f32x2 __attribute__((ext_vector_type(2)));

constexpr int SEQ = 8192, DMODEL = 4096, INW = 9216, NMEM = 256;
constexpr int C_QA = 0, C_KA = 2048, C_VA = 2560, C_XL = 3072, C_QM = 4096, C_ZA = 5120, C_ZL = 7168, C_ZM = 8192;
constexpr float EPSN = 1e-6f;
constexpr float LOG2E = 1.4426950408889634f;
constexpr float SC_ATT = 0.08838834764831845f * LOG2E;
constexpr float SC_MEM = 0.0625f * LOG2E;
constexpr int NPH = 7;
constexpr int LDS_BYTES = 147456;

constexpr size_t MiB = 1u << 20;
constexpr size_t WS_CTL = 0, WS_LRUW = 1 * MiB, WS_ROPE = 2 * MiB, WS_MK = 3 * MiB, WS_MVT = 3 * MiB + 512 * 1024, WS_SS = 4 * MiB,
                 WS_AGG1 = 6 * MiB, WS_AGG2 = 10 * MiB, WS_VT = 12 * MiB, WS_WOUT = 20 * MiB, WS_WT = 52 * MiB, WS_U = 140 * MiB,
                 WS_PROJ = 206 * MiB, WS_HS = 350 * MiB, WS_PP = 382 * MiB, WS_YATT = 414 * MiB, WS_YMEM = 446 * MiB, WS_T0 = 462 * MiB, WS_END = 494 * MiB;
constexpr size_t WS_Y = WS_U;

struct Args { const float* in[19]; float* out; unsigned char* ws; int ph_lo, ph_hi; };

__device__ __forceinline__ unsigned pk2(float lo, float hi) { return pg8::cvt_pk_bf16(lo, hi); }
__device__ __forceinline__ float bflo(unsigned u) { return __builtin_bit_cast(float, u << 16); }
__device__ __forceinline__ float bfhi(unsigned u) { return __builtin_bit_cast(float, u & 0xffff0000u); }
__device__ __forceinline__ float wave_sum(float v) {
#pragma unroll
    for (int o = 1; o < 64; o <<= 1) v += __shfl_xor(v, o);
    return v;
}
__device__ __forceinline__ float fexp2(float x) { return __builtin_amdgcn_exp2f(x); }
__device__ __forceinline__ float sigmoidf_(float x) { return 1.f / (1.f + __expf(-x)); }
__device__ __forceinline__ float fsigmoid(float x) { return __builtin_amdgcn_rcpf(1.f + __builtin_amdgcn_exp2f(-x * 1.4426950408889634f)); }
__device__ __forceinline__ f32x4 mfma16(bf16x8 a, bf16x8 b, f32x4 c) { return __builtin_amdgcn_mfma_f32_16x16x32_bf16(a, b, c, 0, 0, 0); }

__device__ __forceinline__ void p0_item_load(const float* W, int N, int item, int lane, float (&r)[32]) {
    const int nblk = N / 32, kb = item / nblk, nb = item % nblk, k0 = 64 * kb, n0 = 32 * nb;
#pragma unroll
    for (int i = 0; i < 32; ++i) { const int kk = 2 * i + (lane >> 5); r[i] = __builtin_nontemporal_load(W + (size_t)(k0 + kk) * N + n0 + (lane & 31)); }
}
__device__ __forceinline__ void p0_item_lds_write(LAS float* scr, int lane, const float (&r)[32]) {
#pragma unroll
    for (int i = 0; i < 32; ++i) { const int kk = 2 * i + (lane >> 5); scr[kk * 33 + (lane & 31)] = r[i]; }
}
__device__ __forceinline__ void p0_item_store(int K, int N, bf16_t* WT, int row_off, LAS float* scr, int item, int lane) {
    const int nblk = N / 32, kb = item / nblk, nb = item % nblk, k0 = 64 * kb, n0 = 32 * nb;
    asm volatile("s_waitcnt lgkmcnt(0)" ::: "memory");
    const int c = lane & 7;
#pragma unroll
    for (int j = 0; j < 4; ++j) { const int n = (lane >> 3) + 8 * j; const LAS float* s = scr + (8 * c) * 33 + n;
        u32x4 o; o.x = pk2(s[0 * 33], s[1 * 33]); o.y = pk2(s[2 * 33], s[3 * 33]); o.z = pk2(s[4 * 33], s[5 * 33]); o.w = pk2(s[6 * 33], s[7 * 33]);
        *(u32x4*)(WT + (size_t)(row_off + n0 + n) * K + k0 + 8 * c) = o; }
    asm volatile("s_waitcnt lgkmcnt(0)" ::: "memory");
}
__device__ __forceinline__ void p0_transpose_item(const float* W, int K, int N, bf16_t* WT, int row_off, LAS float* scr, int item, int lane) {
    float r[32]; p0_item_load(W, N, item, lane, r); p0_item_lds_write(scr, lane, r); p0_item_store(K, N, WT, row_off, scr, item, lane);
}
__device__ __forceinline__ void p0_transpose_matrix(const float* W, int K, int N, bf16_t* WT, int row_off, LAS float* scr, int first, int step, int lane) {
    const int nitems = (K / 64) * (N / 32);
    if (first >= nitems) return;
    float r[32]; p0_item_load(W, N, first, lane, r);
#pragma unroll 1
    for (int it = first; it < nitems; it += step) {
        p0_item_lds_write(scr, lane, r);
        if (it + step < nitems) p0_item_load(W, N, it + step, lane, r);
        p0_item_store(K, N, WT, row_off, scr, it, lane);
    }
}
__device__ __forceinline__ void rms_row_to_bf16(const float* xrow, const f32x4 (&gv)[16], bf16_t* orow, int lane) {
    const f32x4* xr = (const f32x4*)xrow + lane;
    f32x4 v[16]; float s = 0.f;
#pragma unroll
    for (int k = 0; k < 16; ++k) { v[k] = __builtin_nontemporal_load(xr + 64 * k); s += (v[k].x * v[k].x + v[k].y * v[k].y) + (v[k].z * v[k].z + v[k].w * v[k].w); }
    const float rs = 1.f / sqrtf(wave_sum(s) * (1.f / 4096.f) + EPSN);
    u32x2* o8 = (u32x2*)orow + lane;
#pragma unroll
    for (int k = 0; k < 16; ++k) { const f32x4 g4 = gv[k]; u32x2 o; o.x = pk2(v[k].x * rs * g4.x, v[k].y * rs * g4.y); o.y = pk2(v[k].z * rs * g4.z, v[k].w * rs * g4.w); o8[64 * k] = o; }
}

__device__ __forceinline__ void phase0(const Args& a, LAS unsigned char* lds) {
    int tid = threadIdx.x; asm volatile("" : "+v"(tid)); const int lane = tid & 63, w = tid >> 6, G = gridDim.x;
    const int gw = blockIdx.x * 8 + w, NGW = G * 8;
    unsigned char* ws = a.ws;
    LAS float* scr = (LAS float*)(lds + w * 16384);
    bf16_t* WT = (bf16_t*)(ws + WS_WT); bf16_t* WOUT = (bf16_t*)(ws + WS_WOUT); bf16_t* LRUW = (bf16_t*)(ws + WS_LRUW);
    constexpr int I_IN = 64 * (INW / 32), I_MKV = 64 * (2048 / 32), I_OUT = 64 * (4096 / 32), I_LRU = 32 * 8;
    p0_transpose_matrix(a.in[3], 4096, INW, WT, 0, scr, gw, NGW, lane);
    p0_transpose_matrix(a.in[13], 4096, 2048, WT, INW, scr, gw, NGW, lane);
    for (int r = gw; r < I_LRU; r += NGW) {
        const int mat = r >> 3, sub = r & 7, gate = mat >> 4, dn = mat & 15;
        const float* src = (gate ? a.in[9] : a.in[7]) + (size_t)dn * 16384;
        p0_transpose_item(src, 128, 128, LRUW + (size_t)mat * 16384, 0, scr, sub, lane);
    }
    bf16_t* U = (bf16_t*)(ws + WS_U);
    { f32x4 gv[16];
#pragma unroll
      for (int k = 0; k < 16; ++k) gv[k] = ((const f32x4*)a.in[2])[lane + 64 * k];
      for (int m = gw; m < SEQ; m += NGW) rms_row_to_bf16(a.in[0] + (size_t)m * 4096, gv, U + (size_t)m * 4096, lane);
#pragma unroll
      for (int k = 0; k < 16; ++k) gv[k] = ((const f32x4*)a.in[12])[lane + 64 * k];
      for (int m = gw; m < NMEM; m += NGW) rms_row_to_bf16(a.in[1] + (size_t)m * 4096, gv, U + (size_t)(SEQ + m) * 4096, lane); }
    f32x2* rope = (f32x2*)(ws + WS_ROPE);
    for (int e = blockIdx.x * 512 + tid; e < SEQ * 16; e += G * 512) {
        const int pos = e >> 4, i = e & 15;
        const float inv = powf(500000.0f, -(float)i * (1.0f / 16.0f));
        const float ang = (float)pos * inv;
        rope[e] = (f32x2){cosf(ang), sinf(ang)};
    }
}

struct Sched1 {
    pg8::StaticOrder so; int G, c, ioff, imax;
    __device__ void init(int G_, int c_) { so.init(SEQ, INW, G_, c_); G = G_; c = c_; ioff = 0; imax = 1 << 20; }
    __device__ bool next(int i0, pg8::Unit& u) const {
        if (i0 >= imax) return false;
        const int i = i0 + ioff;
        const long L = (long)i * G + c;
        if (L < 1152) return so.next(i, u);
        if (L < 1160) { u.pm = 32; u.pn = 36 + (int)(L - 1152); return true; }
        return false;
    }
    __device__ __forceinline__ void a_ready(const pg8::Unit&) const {}
    __device__ __forceinline__ void done(const pg8::Unit&) const {}
};
struct Epi1 {
    static constexpr bool PERM = true, AFTER_DRAIN = false, HOLD_LAST = false;
    bf16_t* proj; bf16_t* vt; bf16_t* mk; bf16_t* mvt; const float* rope;
    __device__ __forceinline__ void operator()(const f32x4 (&acc)[2][2][4][2], const pg8::Unit& u, int wr, int wc, int fr, int fq) const {
        const int rloc = wr * 64 + fr, cloc = wc * 32 + 8 * fq;
        if (u.pm == 32) {
            const int t = u.pn - 36;
            if (t < 4) {
#pragma unroll
                for (int ai = 0; ai < 2; ++ai)
#pragma unroll
                    for (int m = 0; m < 4; ++m) { const int row = rloc + ai * 128 + m * 16;
#pragma unroll
                        for (int bj = 0; bj < 2; ++bj) { const f32x4 v0 = acc[ai][bj][m][0], v1 = acc[ai][bj][m][1];
                            u32x4 wv; wv.x = pk2(v0[0], v0[1]); wv.y = pk2(v0[2], v0[3]); wv.z = pk2(v1[0], v1[1]); wv.w = pk2(v1[2], v1[3]);
                            *(u32x4*)(mk + (size_t)row * 1024 + t * 256 + bj * 128 + cloc) = wv; } asm volatile("" ::: "memory"); }
            } else {
#pragma unroll
                for (int ai = 0; ai < 2; ++ai)
#pragma unroll
                    for (int m = 0; m < 4; ++m) { const int row = rloc + ai * 128 + m * 16;
#pragma unroll
                        for (int bj = 0; bj < 2; ++bj)
#pragma unroll
                            for (int n = 0; n < 2; ++n)
#pragma unroll
                                for (int i = 0; i < 4; ++i) { const int col = (t - 4) * 256 + bj * 128 + cloc + 4 * n + i;
                                    mvt[(size_t)col * 256 + row] = (bf16_t)(pk2(acc[ai][bj][m][n][i], 0.f) & 0xffffu); } asm volatile("" ::: "memory"); }
            }
            return;
        }
        const int pn = u.pn, row0 = u.pm * 256 + rloc;
        if (pn == 10 || pn == 11) {
#pragma unroll
            for (int ai = 0; ai < 2; ++ai)
#pragma unroll
                for (int m = 0; m < 4; ++m) { const int row = row0 + ai * 128 + m * 16;
#pragma unroll
                    for (int bj = 0; bj < 2; ++bj)
#pragma unroll
                        for (int n = 0; n < 2; ++n)
#pragma unroll
                            for (int i = 0; i < 4; ++i) { const int col = (pn - 10) * 256 + bj * 128 + cloc + 4 * n + i;
                                vt[(size_t)col * SEQ + row] = (bf16_t)(pk2(acc[ai][bj][m][n][i], 0.f) & 0xffffu); } asm volatile("" ::: "memory"); }
            return;
        }
        float sc = 1.f; if (pn < 8) sc = SC_ATT; else if (pn >= 16 && pn < 20) sc = SC_MEM;
        const bool do_rope = (pn < 10) && (wc == 0);
        const float sgn = (fq < 2) ? -1.f : 1.f;
        f32x4 csA[2][2], cst[2][2];
        if (do_rope) {
#pragma unroll
            for (int n = 0; n < 2; ++n) { const int io = (8 * (fq & 1) + 4 * n) * 2;
                const float* ra = rope + (size_t)row0 * 32 + io; const float* rt = rope + 16 * 32 + io;
                csA[n][0] = *(const f32x4*)ra; csA[n][1] = *(const f32x4*)(ra + 4); cst[n][0] = *(const f32x4*)rt; cst[n][1] = *(const f32x4*)(rt + 4); }
        }
#pragma unroll
        for (int ai = 0; ai < 2; ++ai)
#pragma unroll
            for (int m = 0; m < 4; ++m) { const int row = row0 + ai * 128 + m * 16;
                f32x4 cs[2][2];
                if (do_rope) {
                    const int nrot = (ai == 0 && m == 3) ? 5 : 1;
#pragma unroll
                    for (int n = 0; n < 2; ++n)
#pragma unroll
                        for (int hh = 0; hh < 2; ++hh) { f32x4 cur = csA[n][hh]; cs[n][hh] = cur; const f32x4 t = cst[n][hh];
#pragma unroll
                            for (int rr = 0; rr < 5; ++rr) { if (rr < nrot) { f32x4 nx; nx[0] = cur[0] * t[0] - cur[1] * t[1]; nx[1] = cur[1] * t[0] + cur[0] * t[1]; nx[2] = cur[2] * t[2] - cur[3] * t[3]; nx[3] = cur[3] * t[2] + cur[2] * t[3]; cur = nx; } }
                            csA[n][hh] = cur; }
                }
#pragma unroll
                for (int bj = 0; bj < 2; ++bj) { f32x4 v[2]; v[0] = acc[ai][bj][m][0]; v[1] = acc[ai][bj][m][1];
                    if (do_rope) {
#pragma unroll
                        for (int n = 0; n < 2; ++n) { f32x4 p; p[0] = __shfl_xor(v[n][0], 32); p[1] = __shfl_xor(v[n][1], 32); p[2] = __shfl_xor(v[n][2], 32); p[3] = __shfl_xor(v[n][3], 32);
                            f32x4 r; r[0] = v[n][0] * cs[n][0][0] + sgn * p[0] * cs[n][0][1]; r[1] = v[n][1] * cs[n][0][2] + sgn * p[1] * cs[n][0][3];
                            r[2] = v[n][2] * cs[n][1][0] + sgn * p[2] * cs[n][1][1]; r[3] = v[n][3] * cs[n][1][2] + sgn * p[3] * cs[n][1][3]; v[n] = r; }
                    }
                    u32x4 wv; wv.x = pk2(v[0][0] * sc, v[0][1] * sc); wv.y = pk2(v[0][2] * sc, v[0][3] * sc); wv.z = pk2(v[1][0] * sc, v[1][1] * sc); wv.w = pk2(v[1][2] * sc, v[1][3] * sc);
                    __builtin_nontemporal_store(wv, (u32x4*)(proj + (size_t)row * INW + pn * 256 + bj * 128 + cloc)); } asm volatile("" ::: "memory"); }
    }
};

template <int DH, bool PF, bool DB>
__device__ __forceinline__ void attn_unit(LAS unsigned char* lds, const bf16_t* Qp, int ldq, bf16_t* Op, int ldo, const bf16_t* Kg, int ldk, const bf16_t* Vtg, int ldv,
                                          int cb_lo, int cb_hi, int cb_self, float m_init, float l_init) {
    constexpr int PR = DH / 8, KROW = DH * 2, KT = 128 * KROW, VROW = 288, NKI = (128 * PR) / 512, NVI = (DH * 16) / 512, NS = DH / 32, NDT = DH / 16;
    int tid = threadIdx.x; asm volatile("" : "+v"(tid)); const int lane = tid & 63, w = tid >> 6, q = lane & 15, g = lane >> 4;
    const int krow = 8 * (q >> 2) + (q & 3);
    bf16x8 qf[NS];
    { const unsigned qoff = (unsigned)(((16 * w + q) * ldq + 8 * g) * 2);
#pragma unroll
      for (int s = 0; s < NS; ++s) qf[s] = __builtin_nontemporal_load((const bf16x8*)((const char*)Qp + qoff + 64 * s)); }
    f32x4 o[NDT];
#pragma unroll
    for (int dt = 0; dt < NDT; ++dt) o[dt] = (f32x4){0.f, 0.f, 0.f, 0.f};
    float m_run = m_init, l_run = l_init;
    u32x4 kreg[NKI], vreg[NVI];
#define ATT_LOAD(cb) do { const int k0_ = (cb) * 128; \
        const char* kb_ = (const char*)Kg + (size_t)k0_ * ldk * 2; const char* vb_ = (const char*)Vtg + (size_t)k0_ * 2; \
        _Pragma("unroll") for (int it = 0; it < NKI; ++it) { const int e = tid + 512 * it; const int key = e / PR, pc = e % PR; \
            kreg[it] = *(const u32x4*)(kb_ + (unsigned)((key * ldk + pc * 8) * 2)); } \
        _Pragma("unroll") for (int it = 0; it < NVI; ++it) { const int e = tid + 512 * it; const int d = e >> 4, pc = e & 15; \
            vreg[it] = *(const u32x4*)(vb_ + (unsigned)((d * ldv + pc * 8) * 2)); } } while (0)
#define ATT_STORE() do { \
        _Pragma("unroll") for (int it = 0; it < NKI; ++it) { const int e = tid + 512 * it; const int key = e / PR, pc = e % PR; \
            *(LAS u32x4*)(lds + key * KROW + ((pc ^ ((((key >> 3) & 3) << 2) | (key & 3))) * 16)) = kreg[it]; } \
        _Pragma("unroll") for (int it = 0; it < NVI; ++it) { const int e = tid + 512 * it; const int d = e >> 4, pc = e & 15; \
            *(LAS u32x4*)(lds + KT + d * VROW + pc * 16) = vreg[it]; } } while (0)
    if (PF) ATT_LOAD(cb_lo);
    for (int cb = cb_lo; cb < cb_hi; ++cb) {
        if (!PF) ATT_LOAD(cb);
        __syncthreads();
        ATT_STORE();
        __syncthreads();
        if (PF) { if (cb + 1 < cb_hi) ATT_LOAD(cb + 1); }
        f32x4 s[8];
#pragma unroll
        for (int kt = 0; kt < 8; ++kt) s[kt] = (f32x4){0.f, 0.f, 0.f, 0.f};
        {
            bf16x8 ka[DB ? 2 : 1][8];
            if (DB) {
#pragma unroll
                for (int kt = 0; kt < 8; ++kt) ka[0][kt] = *(const LAS bf16x8*)(lds + (32 * (kt >> 1) + 4 * (kt & 1) + krow) * KROW + (((0 + g) ^ q) * 16));
            }
#pragma unroll
            for (int ss = 0; ss < NS; ++ss) {
                if (DB) { if (ss + 1 < NS) {
#pragma unroll
                    for (int kt = 0; kt < 8; ++kt) ka[(ss + 1) & 1][kt] = *(const LAS bf16x8*)(lds + (32 * (kt >> 1) + 4 * (kt & 1) + krow) * KROW + (((4 * (ss + 1) + g) ^ q) * 16)); }
                } else {
#pragma unroll
                    for (int kt = 0; kt < 8; ++kt) ka[0][kt] = *(const LAS bf16x8*)(lds + (32 * (kt >> 1) + 4 * (kt & 1) + krow) * KROW + (((4 * ss + g) ^ q) * 16));
                }
                __builtin_amdgcn_sched_barrier(0);
#pragma unroll
                for (int kt = 0; kt < 8; ++kt) s[kt] = mfma16(ka[DB ? (ss & 1) : 0][kt], qf[ss], s[kt]);
                __builtin_amdgcn_sched_barrier(0);
            }
        }
        if (cb != cb_self && cb_self >= 0) {
            const float sg = (cb < cb_self) ? 1.f : -1.f;
            const float dq = (float)(16 * w + q - 8 * g);
#pragma unroll
            for (int kt = 0; kt < 8; ++kt)
#pragma unroll
                for (int j = 0; j < 4; ++j) { const float v = sg * ((float)(32 * (kt >> 1) + 4 * (kt & 1) + j) - dq); s[kt][j] += fminf(v, 0.f) * 1e30f; }
        }
        float mx = s[0][0];
#pragma unroll
        for (int kt = 0; kt < 8; ++kt)
#pragma unroll
            for (int j = 0; j < 4; ++j) mx = fmaxf(mx, s[kt][j]);
        mx = fmaxf(mx, __shfl_xor(mx, 16)); mx = fmaxf(mx, __shfl_xor(mx, 32));
        const float m_new = fmaxf(m_run, mx), alpha = fexp2(m_run - m_new); m_run = m_new;
        float rs = 0.f;
#pragma unroll
        for (int kt = 0; kt < 8; ++kt)
#pragma unroll
            for (int j = 0; j < 4; ++j) { const float p = fexp2(s[kt][j] - m_new); s[kt][j] = p; rs += p; }
        rs += __shfl_xor(rs, 16); rs += __shfl_xor(rs, 32);
        l_run = l_run * alpha + rs;
        bf16x8 pb[4];
#pragma unroll
        for (int u = 0; u < 4; ++u) { u32x4 t; t.x = pk2(s[2 * u][0], s[2 * u][1]); t.y = pk2(s[2 * u][2], s[2 * u][3]); t.z = pk2(s[2 * u + 1][0], s[2 * u + 1][1]); t.w = pk2(s[2 * u + 1][2], s[2 * u + 1][3]);
            pb[u] = __builtin_bit_cast(bf16x8, t); }
#pragma unroll
        for (int dt = 0; dt < NDT; ++dt) o[dt] = o[dt] * alpha;
        {
            constexpr int NG = (NDT / 8) * 4;
            u32x4 va[DB ? 2 : 1][8];
#define ATT_VLOAD(buf, gi) do { const int u_ = (gi) & 3, d0_ = 8 * ((gi) >> 2); \
            _Pragma("unroll") for (int i = 0; i < 8; ++i) { va[buf][i] = *(const LAS u32x4*)(lds + KT + (16 * (d0_ + i) + q) * VROW + (32 * u_ + 8 * g) * 2); } } while (0)
            if (DB) ATT_VLOAD(0, 0);
#pragma unroll
            for (int gi = 0; gi < NG; ++gi) {
                if (DB) { if (gi + 1 < NG) ATT_VLOAD((gi + 1) & 1, gi + 1); } else ATT_VLOAD(0, gi);
                __builtin_amdgcn_sched_barrier(0);
#pragma unroll
                for (int i = 0; i < 8; ++i) o[8 * (gi >> 2) + i] = mfma16(__builtin_bit_cast(bf16x8, va[DB ? (gi & 1) : 0][i]), pb[gi & 3], o[8 * (gi >> 2) + i]);
                __builtin_amdgcn_sched_barrier(0);
            }
#undef ATT_VLOAD
        }
    }
#undef ATT_LOAD
#undef ATT_STORE
    const float inv = 1.f / l_run;
    const unsigned ooff = (unsigned)(((16 * w + q) * ldo + 4 * g) * 2);
#pragma unroll
    for (int dt = 0; dt < NDT; ++dt) { u32x2 pkv; pkv.x = pk2(o[dt][0] * inv, o[dt][1] * inv); pkv.y = pk2(o[dt][2] * inv, o[dt][3] * inv); *(u32x2*)((char*)Op + ooff + 32 * dt) = pkv; }
}

__device__ __forceinline__ void windowed_stream(LAS unsigned char* lds0, const Args& a) {
    constexpr int DH = 128, PR = 16, KROW = 256, KT = 128 * KROW, VROW = 288, BUFB = KT + DH * VROW, NKI = 4, NVI = 4, NS = 4, NDT = 8;
    static_assert(2 * BUFB <= LDS_BYTES - 64, "two K/V tile buffers must fit under the barrier words");
    int tid = threadIdx.x; asm volatile("" : "+v"(tid)); const int lane = tid & 63, w = tid >> 6, q = lane & 15, g = lane >> 4;
    const int krow = 8 * (q >> 2) + (q & 3);
    unsigned char* ws = a.ws;
    const bf16_t* proj = (const bf16_t*)(ws + WS_PROJ); const bf16_t* vt = (const bf16_t*)(ws + WS_VT); bf16_t* yatt = (bf16_t*)(ws + WS_YATT);
    const int G = (int)gridDim.x;
    if ((int)blockIdx.x >= 1024) return;
    unsigned koff[NKI], voff[NVI], klds[NKI], vlds[NVI];
#pragma unroll
    for (int it = 0; it < NKI; ++it) { const int e = tid + 512 * it, key = e / PR, pc = e % PR; koff[it] = (unsigned)((key * INW + pc * 8) * 2); klds[it] = (unsigned)(key * KROW + ((pc ^ ((((key >> 3) & 3) << 2) | (key & 3))) * 16)); }
#pragma unroll
    for (int it = 0; it < NVI; ++it) { const int e = tid + 512 * it, d = e >> 4, pc = e & 15; voff[it] = (unsigned)((d * SEQ + pc * 8) * 2); vlds[it] = (unsigned)(KT + d * VROW + pc * 16); }
    u32x4 kreg[NKI], vreg[NVI];
#define WS_LOAD(v_, cb_) do { const int kvh_ = ((v_) & 15) >> 2; \
        const char* kb_ = (const char*)proj + ((size_t)((cb_) * 128) * INW + C_KA + kvh_ * 128) * 2; const char* vb_ = (const char*)vt + ((size_t)(kvh_ * 128) * SEQ + (cb_) * 128) * 2; \
        _Pragma("unroll") for (int it = 0; it < NKI; ++it) kreg[it] = *(const u32x4*)(kb_ + koff[it]); \
        _Pragma("unroll") for (int it = 0; it < NVI; ++it) vreg[it] = *(const u32x4*)(vb_ + voff[it]); } while (0)
#define WS_STORE(ldsb_) do { \
        _Pragma("unroll") for (int it = 0; it < NKI; ++it) *(LAS u32x4*)((ldsb_) + klds[it]) = kreg[it]; \
        _Pragma("unroll") for (int it = 0; it < NVI; ++it) *(LAS u32x4*)((ldsb_) + vlds[it]) = vreg[it]; } while (0)
#define WS_LO(v_) ((((v_) >> 4) > 0) ? ((v_) >> 4) - 1 : 0)
#define WS_HI(v_) ((((v_) >> 4) < 63) ? ((v_) >> 4) + 2 : 64)
    int Cv = (int)blockIdx.x, Ccb = WS_LO(Cv);
    int Lv = Cv, Lcb = Ccb; bool Lvalid = true;
#define WS_ADV_L() do { if (Lcb + 1 < WS_HI(Lv)) ++Lcb; else { Lv += G; if (Lv < 1024) Lcb = WS_LO(Lv); else Lvalid = false; } } while (0)
    __syncthreads();
    WS_LOAD(Lv, Lcb); WS_ADV_L();
    WS_STORE(lds0);
    bool have = false;
    if (Lvalid) { WS_LOAD(Lv, Lcb); WS_ADV_L(); have = true; }
    __syncthreads();
    int bsel = 0;
    bf16x8 qf[NS]; f32x4 o[NDT]; float m_run = 0.f, l_run = 1.f;
#pragma unroll 1
    for (;;) {
        const int qblk = Cv >> 4, hq = Cv & 15, lo = WS_LO(Cv), hi = WS_HI(Cv);
        LAS unsigned char* lds = lds0 + bsel * BUFB;
        if (Ccb == lo) {
            const unsigned qoff = (unsigned)(((16 * w + q) * INW + 8 * g) * 2);
            const char* qb = (const char*)proj + ((size_t)(qblk * 128) * INW + C_QA + hq * 128) * 2;
#pragma unroll
            for (int s = 0; s < NS; ++s) qf[s] = __builtin_nontemporal_load((const bf16x8*)(qb + qoff + 64 * s));
#pragma unroll
            for (int dt = 0; dt < NDT; ++dt) o[dt] = (f32x4){0.f, 0.f, 0.f, 0.f};
            m_run = a.in[4][hq] * LOG2E; l_run = 1.f;
        }
        if (have) { WS_STORE(lds0 + (bsel ^ 1) * BUFB); have = false; }
        if (Lvalid) { WS_LOAD(Lv, Lcb); WS_ADV_L(); have = true; }
        f32x4 s[8];
#pragma unroll
        for (int kt = 0; kt < 8; ++kt) s[kt] = (f32x4){0.f, 0.f, 0.f, 0.f};
        {
            bf16x8 ka[2][8];
#pragma unroll
            for (int kt = 0; kt < 8; ++kt) ka[0][kt] = *(const LAS bf16x8*)(lds + (32 * (kt >> 1) + 4 * (kt & 1) + krow) * KROW + (((0 + g) ^ q) * 16));
#pragma unroll
            for (int ss = 0; ss < NS; ++ss) {
                if (ss + 1 < NS) {
#pragma unroll
                    for (int kt = 0; kt < 8; ++kt) ka[(ss + 1) & 1][kt] = *(const LAS bf16x8*)(lds + (32 * (kt >> 1) + 4 * (kt & 1) + krow) * KROW + (((4 * (ss + 1) + g) ^ q) * 16)); }
                __builtin_amdgcn_sched_barrier(0);
#pragma unroll
                for (int kt = 0; kt < 8; ++kt) s[kt] = mfma16(ka[ss & 1][kt], qf[ss], s[kt]);
                __builtin_amdgcn_sched_barrier(0);
            }
        }
        if (Ccb != qblk) {
            const float sg = (Ccb < qblk) ? 1.f : -1.f;
            const float dq = (float)(16 * w + q - 8 * g);
#pragma unroll
            for (int kt = 0; kt < 8; ++kt)
#pragma unroll
                for (int j = 0; j < 4; ++j) { const float v = sg * ((float)(32 * (kt >> 1) + 4 * (kt & 1) + j) - dq); s[kt][j] += fminf(v, 0.f) * 1e30f; }
        }
        float mx = s[0][0];
#pragma unroll
        for (int kt = 0; kt < 8; ++kt)
#pragma unroll
            for (int j = 0; j < 4; ++j) mx = fmaxf(mx, s[kt][j]);
        mx = fmaxf(mx, __shfl_xor(mx, 16)); mx = fmaxf(mx, __shfl_xor(mx, 32));
        const float m_new = fmaxf(m_run, mx), alpha = fexp2(m_run - m_new); m_run = m_new;
        float rs = 0.f;
#pragma unroll
        for (int kt = 0; kt < 8; ++kt)
#pragma unroll
            for (int j = 0; j < 4; ++j) { const float p = fexp2(s[kt][j] - m_new); s[kt][j] = p; rs += p; }
        rs += __shfl_xor(rs, 16); rs += __shfl_xor(rs, 32);
        l_run = l_run * alpha + rs;
        bf16x8 pb[4];
#pragma unroll
        for (int u = 0; u < 4; ++u) { u32x4 t; t.x = pk2(s[2 * u][0], s[2 * u][1]); t.y = pk2(s[2 * u][2], s[2 * u][3]); t.z = pk2(s[2 * u + 1][0], s[2 * u + 1][1]); t.w = pk2(s[2 * u + 1][2], s[2 * u + 1][3]);
            pb[u] = __builtin_bit_cast(bf16x8, t); }
#pragma unroll
        for (int dt = 0; dt < NDT; ++dt) o[dt] = o[dt] * alpha;
        {
            u32x4 va[2][8];
#define WS_VLOAD(buf, gi) do { _Pragma("unroll") for (int i = 0; i < 8; ++i) { va[buf][i] = *(const LAS u32x4*)(lds + KT + (16 * i + q) * VROW + (32 * (gi) + 8 * g) * 2); } } while (0)
            WS_VLOAD(0, 0);
#pragma unroll
            for (int gi = 0; gi < 4; ++gi) {
                if (gi + 1 < 4) WS_VLOAD((gi + 1) & 1, gi + 1);
                __builtin_amdgcn_sched_barrier(0);
#pragma unroll
                for (int i = 0; i < 8; ++i) o[i] = mfma16(__builtin_bit_cast(bf16x8, va[gi & 1][i]), pb[gi], o[i]);
                __builtin_amdgcn_sched_barrier(0);
            }
#undef WS_VLOAD
        }
        bool done = false;
        if (Ccb + 1 < hi) ++Ccb;
        else {
            const float inv = 1.f / l_run;
            char* ob = (char*)yatt + ((size_t)(qblk * 128) * 2048 + hq * 128) * 2;
            const unsigned ooff = (unsigned)(((16 * w + q) * 2048 + 4 * g) * 2);
#pragma unroll
            for (int dt = 0; dt < NDT; ++dt) { u32x2 pkv; pkv.x = pk2(o[dt][0] * inv, o[dt][1] * inv); pkv.y = pk2(o[dt][2] * inv, o[dt][3] * inv); *(u32x2*)(ob + ooff + 32 * dt) = pkv; }
            Cv += G; if (Cv < 1024) Ccb = WS_LO(Cv); else done = true;
        }
        __syncthreads();
        bsel ^= 1;
        if (done) break;
    }
#undef WS_LOAD
#undef WS_STORE
#undef WS_LO
#undef WS_HI
#undef WS_ADV_L
}

constexpr int LR_XCB = 0, LR_TA = 16384, LR_TB = LR_TA + 64 * 528, LR_TH = LR_TB + 64 * 528, LR_AGS = LR_TH + 64 * 528;
template <int VAR>
__device__ __forceinline__ void lru_phase(LAS unsigned char* lds, const Args& a, const int n, const int tt_first, const int tt_step) {
    int tid = threadIdx.x; asm volatile("" : "+v"(tid)); const int lane = tid & 63, w0 = tid >> 6, q0 = lane & 15, g0 = lane >> 4;
    unsigned char* ws = a.ws;
    const bf16_t* proj = (const bf16_t*)(ws + WS_PROJ);
    LAS unsigned char* xcb = lds + LR_XCB;
    LAS float* TA = (LAS float*)(lds + LR_TA); LAS float* TB = (LAS float*)(lds + LR_TB); LAS float* TH = (LAS float*)(lds + LR_TH);
    LAS f32x2* AGS = (LAS f32x2*)(lds + LR_AGS);
    const bf16_t* lruw = (const bf16_t*)(ws + WS_LRUW);
    f32x2* agg1 = (f32x2*)(ws + (VAR ? WS_T0 : WS_AGG1));
    bf16_t* Pout = (bf16_t*)(ws + (VAR ? WS_U + 32 * MiB : WS_PP));
    bf16x8 fa[2][4], fx[2][4];
#pragma unroll
    for (int dir = 0; dir < 2; ++dir) {
        const bf16_t* wa = lruw + (size_t)((0 * 2 + dir) * 8 + n) * 16384 + (16 * w0 + q0) * 128 + 8 * g0;
        const bf16_t* wx = lruw + (size_t)((1 * 2 + dir) * 8 + n) * 16384 + (16 * w0 + q0) * 128 + 8 * g0;
#pragma unroll
        for (int s = 0; s < 4; ++s) { fa[dir][s] = *(const bf16x8*)(wa + 32 * s); fx[dir][s] = *(const bf16x8*)(wx + 32 * s); }
    }
    const int cg8 = tid & 15, t2 = tid >> 4, ch0 = n * 128 + cg8 * 8;
    LAS float* CW = (LAS float*)(lds + LR_AGS + 4096);
    __syncthreads();
    if (tid < 128) {
#pragma unroll
        for (int j = 0; j < 4; ++j) CW[j * 128 + tid] = a.in[5][j * 1024 + n * 128 + tid];
        CW[512 + tid] = a.in[6][n * 128 + tid];
    } else if (tid < 384) {
        const int d2 = (tid - 128) >> 7, c = tid & 127, cg = d2 * 1024 + n * 128 + c;
        const float xl = -a.in[11][cg];
        CW[640 + (d2 * 3 + 0) * 128 + c] = a.in[8][cg]; CW[640 + (d2 * 3 + 1) * 128 + c] = a.in[10][cg];
        CW[640 + (d2 * 3 + 2) * 128 + c] = fmaxf(xl, 0.f) + log1pf(expf(-fabsf(xl)));
    }
    u32x4 xr[5];
#define LRU_XLOAD(tt_) do { _Pragma("unroll") for (int r = 0; r < 5; ++r) { const int t = (tt_) * 64 + 2 * t2 - 2 + r; xr[r] = (u32x4){0u, 0u, 0u, 0u}; \
        if (t >= 0 && t < SEQ) xr[r] = __builtin_nontemporal_load((const u32x4*)((const char*)proj + (unsigned)((t * INW + C_XL + ch0) * 2))); } } while (0)
    if (tt_first < 128) LRU_XLOAD(tt_first);
#pragma unroll 1
    for (int tt = tt_first; tt < 128; tt += tt_step) {
    const int t0 = tt * 64;
    __syncthreads();
    {
        float xin[5][8];
#pragma unroll
        for (int r = 0; r < 5; ++r) { const u32x4 v = xr[r];
            xin[r][0] = bflo(v.x); xin[r][1] = bfhi(v.x); xin[r][2] = bflo(v.y); xin[r][3] = bfhi(v.y); xin[r][4] = bflo(v.z); xin[r][5] = bfhi(v.z); xin[r][6] = bflo(v.w); xin[r][7] = bfhi(v.w); }
        float wv[4][8], bias[8];
#pragma unroll
        for (int j = 0; j < 4; ++j) { const f32x4 w0 = *(const LAS f32x4*)(CW + j * 128 + cg8 * 8), w1 = *(const LAS f32x4*)(CW + j * 128 + cg8 * 8 + 4);
            wv[j][0] = w0[0]; wv[j][1] = w0[1]; wv[j][2] = w0[2]; wv[j][3] = w0[3]; wv[j][4] = w1[0]; wv[j][5] = w1[1]; wv[j][6] = w1[2]; wv[j][7] = w1[3]; }
        { const f32x4 b0 = *(const LAS f32x4*)(CW + 512 + cg8 * 8), b1 = *(const LAS f32x4*)(CW + 512 + cg8 * 8 + 4);
          bias[0] = b0[0]; bias[1] = b0[1]; bias[2] = b0[2]; bias[3] = b0[3]; bias[4] = b1[0]; bias[5] = b1[1]; bias[6] = b1[2]; bias[7] = b1[3]; }
#pragma unroll
        for (int o = 0; o < 2; ++o) { float y[8];
#pragma unroll
            for (int e = 0; e < 8; ++e) { float v = bias[e];
#pragma unroll
                for (int j = 0; j < 4; ++j) v += wv[j][e] * xin[o + j][e];
                y[e] = v; }
            const int tok = 2 * t2 + o;
            u32x4 pk; pk.x = pk2(y[0], y[1]); pk.y = pk2(y[2], y[3]); pk.z = pk2(y[4], y[5]); pk.w = pk2(y[6], y[7]);
            *(LAS u32x4*)(xcb + tok * 256 + ((cg8 ^ (tok & 15)) * 16)) = pk; }
    }
    if (tt + tt_step < 128) LRU_XLOAD(tt + tt_step);
    __syncthreads();
    float hreg[16];
    int tl = tid; asm volatile("" : "+v"(tl));
    const int q = tl & 15, g = (tl >> 4) & 3, w = tl >> 6, chl = 16 * w + 4 * g;
    const int ch = 16 * w + q, sub = g;
#pragma unroll
    for (int dir = 0; dir < 2; ++dir) {
        LAS float* TAd = dir ? TH : TA;
        if (VAR != 3) {
            const f32x4 ba = *(const LAS f32x4*)(CW + 640 + (dir * 3 + 0) * 128 + chl), bx = *(const LAS f32x4*)(CW + 640 + (dir * 3 + 1) * 128 + chl), sp = *(const LAS f32x4*)(CW + 640 + (dir * 3 + 2) * 128 + chl);
#pragma unroll
            for (int tk = 0; tk < 4; ++tk) { const int tok = 16 * tk + q;
                f32x4 ar = (f32x4){0.f, 0.f, 0.f, 0.f}, ai = (f32x4){0.f, 0.f, 0.f, 0.f};
#pragma unroll
                for (int s = 0; s < 4; ++s) {
                    const bf16x8 xb = *(const LAS bf16x8*)(xcb + tok * 256 + (((4 * s + g) ^ q) * 16));
                    ar = mfma16(fa[dir][s], xb, ar); ai = mfma16(fx[dir][s], xb, ai); }
                const u32x2 xr2 = *(const LAS u32x2*)(xcb + tok * 256 + ((((chl >> 3)) ^ q) * 16) + (chl & 7) * 2);
                const float xc0 = bflo(xr2.x), xc1 = bfhi(xr2.x), xc2 = bflo(xr2.y), xc3 = bfhi(xr2.y);
                f32x4 av, bv;
#pragma unroll
                for (int j = 0; j < 4; ++j) { if (VAR == 1) { av[j] = ar[j] + ba[j] + sp[j]; bv[j] = ai[j] + bx[j] + (j == 0 ? xc0 : (j == 1 ? xc1 : (j == 2 ? xc2 : xc3))); continue; }
                    const float r = fsigmoid(ar[j] + ba[j]), ii = fsigmoid(ai[j] + bx[j]);
                    const float la = -8.0f * r * sp[j]; const float aa = fexp2(la * LOG2E); av[j] = aa;
                    const float x2 = 2.0f * la;
                    const float poly = x2 * (1.f + x2 * (0.5f + x2 * ((1.f / 6.f) + x2 * ((1.f / 24.f) + x2 * (1.f / 120.f)))));
                    const float om = (x2 > -0.25f) ? -poly : (1.f - aa * aa);
                    const float xcj = j == 0 ? xc0 : (j == 1 ? xc1 : (j == 2 ? xc2 : xc3));
                    bv[j] = __builtin_amdgcn_sqrtf(om) * ii * xcj; }
                *(LAS f32x4*)(TAd + tok * 132 + chl) = av; *(LAS f32x4*)(TB + tok * 132 + chl) = bv; }
        }
        asm volatile("s_waitcnt lgkmcnt(0)" ::: "memory");
        if (VAR != 2 && VAR != 3) {
            float h = 0.f, P = 1.f;
#pragma unroll
            for (int i = 0; i < 16; ++i) { const int t = 16 * sub + (dir ? 15 - i : i);
                const float av = TAd[t * 132 + ch], bv = TB[t * 132 + ch]; h = av * h + bv; P *= av; TB[t * 132 + ch] = h; TAd[t * 132 + ch] = P; }
            AGS[sub * 128 + ch] = (f32x2){P, h};
        }
        asm volatile("s_waitcnt lgkmcnt(0)" ::: "memory");
        if (VAR == 2 || VAR == 3) {
#pragma unroll
            for (int i = 0; i < 16; ++i) hreg[i] = 0.f;
        } else {
            float hc = 0.f, Pp = 1.f, At = 1.f, Ht = 0.f;
#pragma unroll
            for (int s = 0; s < 4; ++s) { const int s2 = dir ? 3 - s : s; const f32x2 e = AGS[s2 * 128 + ch];
                const bool before = dir ? (s2 > sub) : (s2 < sub);
                if (before) { hc = e.x * hc + e.y; Pp *= e.x; }
                Ht = e.x * Ht + e.y; At *= e.x; }
#pragma unroll
            for (int i = 0; i < 16; ++i) { const int t = 16 * sub + i;
                const float Pl = TAd[t * 132 + ch], hl = TB[t * 132 + ch];
                const float hfull = hl + Pl * hc;
                if (dir == 0) hreg[i] = hfull; else hreg[i] += hfull;
                TAd[t * 132 + ch] = Pl * Pp; }
            if (sub == 0) agg1[(size_t)(dir * 1024 + n * 128 + ch) * 128 + tt] = (f32x2){At, Ht};
        }
        asm volatile("s_waitcnt lgkmcnt(0)" ::: "memory");
    }
#pragma unroll
    for (int i = 0; i < 16; ++i) TB[(16 * sub + i) * 132 + ch] = hreg[i];
    __syncthreads();
    {
        float* hs = (float*)(ws + (VAR ? WS_U : WS_HS));
#pragma unroll
        for (int i = 0; i < 4; ++i) { const int e = tid + 512 * i, t = e >> 5, c4 = e & 31;
            *(f32x4*)(hs + (size_t)(t0 + t) * 1024 + n * 128 + 4 * c4) = *(const LAS f32x4*)(TB + t * 132 + 4 * c4);
            const f32x4 p0 = *(const LAS f32x4*)(TA + t * 132 + 4 * c4), p1 = *(const LAS f32x4*)(TH + t * 132 + 4 * c4);
            u32x2 o0, o1; o0.x = pk2(p0[0], p0[1]); o0.y = pk2(p0[2], p0[3]); o1.x = pk2(p1[0], p1[1]); o1.y = pk2(p1[2], p1[3]);
            *(u32x2*)(Pout + (size_t)(t0 + t) * 1024 + n * 128 + 4 * c4) = o0;
            *(u32x2*)(Pout + (size_t)SEQ * 1024 + (size_t)(t0 + t) * 1024 + n * 128 + 4 * c4) = o1; }
    }
    }
#undef LRU_XLOAD
}

__device__ __forceinline__ void phase2(const Args& a, LAS unsigned char* lds, int p2mask) {
    unsigned char* ws = a.ws;
    bf16_t* proj = (bf16_t*)(ws + WS_PROJ); const bf16_t* vt = (const bf16_t*)(ws + WS_VT);
    const bf16_t* mk = (const bf16_t*)(ws + WS_MK); const bf16_t* mvt = (const bf16_t*)(ws + WS_MVT);
    bf16_t* yatt = (bf16_t*)(ws + WS_YATT); bf16_t* ymem = (bf16_t*)(ws + WS_YMEM);
    if (p2mask & 1)
    for (int u = blockIdx.x; u < 256; u += gridDim.x) {
        const int qblk = u >> 2, hm = u & 3;
        attn_unit<256, false, false>(lds, proj + (size_t)(qblk * 128) * INW + C_QM + hm * 256, INW, ymem + (size_t)(qblk * 128) * 1024 + hm * 256, 1024, mk + hm * 256, 1024, mvt + (size_t)(hm * 256) * 256, 256, 0, 2, -100, -1e30f, 0.f);
    }
    if (p2mask & 2) windowed_stream(lds, a);
    if (p2mask & 4)
    { const int G = gridDim.x; const bool al = (G & 7) == 0; const int nrep = al ? 1 : 8;
#pragma unroll 1
      for (int rep = 0; rep < nrep; ++rep) lru_phase<0>(lds, a, al ? (int)(blockIdx.x & 7) : rep, al ? (int)(blockIdx.x >> 3) : (int)blockIdx.x, al ? (G >> 3) : G); }
}

__device__ __forceinline__ void phase3(const Args& a, LAS unsigned char* lds) {
    unsigned char* ws = a.ws;
    const f32x2* agg1 = (const f32x2*)(ws + WS_AGG1); f32x2* agg2 = (f32x2*)(ws + WS_AGG2);
    for (int e = blockIdx.x * 512 + threadIdx.x; e < 2 * 1024 * 16; e += gridDim.x * 512) {
        const int sc = e & 15, dc = e >> 4, dir = dc >> 10;
        const f32x4* p = (const f32x4*)(agg1 + (size_t)dc * 128 + sc * 8);
        f32x4 v[4];
#pragma unroll
        for (int i = 0; i < 4; ++i) v[i] = p[i];
        float A = 1.f, H = 0.f;
        if (dir == 0) {
#pragma unroll
            for (int i = 0; i < 4; ++i) { H = v[i][0] * H + v[i][1]; A *= v[i][0]; H = v[i][2] * H + v[i][3]; A *= v[i][2]; }
        } else {
#pragma unroll
            for (int i = 3; i >= 0; --i) { H = v[i][2] * H + v[i][3]; A *= v[i][2]; H = v[i][0] * H + v[i][1]; A *= v[i][0]; }
        }
        agg2[(size_t)dc * 16 + sc] = (f32x2){A, H};
    }
}

__device__ __forceinline__ float silu_(float z) { return z * __builtin_amdgcn_rcpf(1.f + __builtin_amdgcn_exp2f(-z * 1.4426950408889634f)); }
__device__ __forceinline__ void phase4(const Args& a, LAS unsigned char* lds) {
    unsigned char* ws = a.ws;
    const f32x2* agg1 = (const f32x2*)(ws + WS_AGG1); const f32x2* agg2 = (const f32x2*)(ws + WS_AGG2);
    const bf16_t* proj = (const bf16_t*)(ws + WS_PROJ); bf16_t* Y = (bf16_t*)(ws + WS_Y);
    const bf16_t* yatt = (const bf16_t*)(ws + WS_YATT); const bf16_t* ymem = (const bf16_t*)(ws + WS_YMEM);
    const float* hs = (const float*)(ws + WS_HS); const bf16_t* Pf = (const bf16_t*)(ws + WS_PP); const bf16_t* Pb = Pf + (size_t)SEQ * 1024;
    LAS float* car = (LAS float*)lds;
    LAS float* gl = (LAS float*)(lds + 8192);
    int tid = threadIdx.x; asm volatile("" : "+v"(tid)); const int lane = tid & 63, w = tid >> 6;
    __syncthreads();
    for (int i = tid; i < 1024; i += 512) { *(LAS f32x4*)(gl + 4 * i) = (i < 512) ? ((const f32x4*)a.in[14])[i] : (i < 768 ? ((const f32x4*)a.in[15])[i - 512] : ((const f32x4*)a.in[16])[i - 768]); }
    for (int u = blockIdx.x; u < 256; u += gridDim.x) {
        const int tile = u >> 1, sc = tile >> 3, cj = tile & 7;
        __syncthreads();
#pragma unroll 1
        for (int half = 0; half < 2; ++half) {
            const int c = tid + 512 * half;
            float hf = 0.f, hb = 0.f;
            { const f32x4* p2 = (const f32x4*)(agg2 + (size_t)c * 16); const f32x4* p1 = (const f32x4*)(agg1 + (size_t)c * 128 + sc * 8);
              f32x4 e2[8], e1[4];
#pragma unroll
              for (int i = 0; i < 8; ++i) e2[i] = p2[i];
#pragma unroll
              for (int i = 0; i < 4; ++i) e1[i] = p1[i];
#pragma unroll
              for (int i = 0; i < 8; ++i) { if (2 * i < sc) hf = e2[i][0] * hf + e2[i][1]; if (2 * i + 1 < sc) hf = e2[i][2] * hf + e2[i][3]; }
#pragma unroll
              for (int i = 0; i < 4; ++i) { if (2 * i < cj) hf = e1[i][0] * hf + e1[i][1]; if (2 * i + 1 < cj) hf = e1[i][2] * hf + e1[i][3]; } }
            { const f32x4* p2 = (const f32x4*)(agg2 + (size_t)(1024 + c) * 16); const f32x4* p1 = (const f32x4*)(agg1 + (size_t)(1024 + c) * 128 + sc * 8);
              f32x4 e2[8], e1[4];
#pragma unroll
              for (int i = 0; i < 8; ++i) e2[i] = p2[i];
#pragma unroll
              for (int i = 0; i < 4; ++i) e1[i] = p1[i];
#pragma unroll
              for (int i = 7; i >= 0; --i) { if (2 * i + 1 > sc) hb = e2[i][2] * hb + e2[i][3]; if (2 * i > sc) hb = e2[i][0] * hb + e2[i][1]; }
#pragma unroll
              for (int i = 3; i >= 0; --i) { if (2 * i + 1 > cj) hb = e1[i][2] * hb + e1[i][3]; if (2 * i > cj) hb = e1[i][0] * hb + e1[i][1]; } }
            car[c] = hf; car[1024 + c] = hb;
        }
        __syncthreads();
        f32x4 cf[4], cb[4];
#pragma unroll
        for (int k = 0; k < 4; ++k) { cf[k] = *(const LAS f32x4*)(car + 4 * lane + 256 * k); cb[k] = *(const LAS f32x4*)(car + 1024 + 4 * lane + 256 * k); }
#pragma unroll 1
        for (int tk = 0; tk < 4; ++tk) {
            const unsigned t = (unsigned)(u * 32 + 4 * w + tk);
            const char* hsb = (const char*)hs; const char* pfb = (const char*)Pf; const char* pbb = (const char*)Pb;
            const char* yab = (const char*)yatt; const char* ymb = (const char*)ymem; const char* prb = (const char*)proj; char* yb = (char*)Y;
            const unsigned o_h = t * 4096u + 16u * lane, o_p = t * 2048u + 8u * lane, o_m = t * 2048u + 16u * lane;
            const unsigned o_pr = t * (unsigned)(INW * 2), o_y = t * 8192u;
            f32x4 h4[4]; u32x2 pf[4], pb[4], zl[4]; u32x4 va[4], vm[2], za[4], zm[2];
#pragma unroll
            for (int k = 0; k < 4; ++k) { h4[k] = __builtin_nontemporal_load((const f32x4*)(hsb + o_h + 1024u * k)); pf[k] = __builtin_nontemporal_load((const u32x2*)(pfb + o_p + 512u * k)); pb[k] = __builtin_nontemporal_load((const u32x2*)(pbb + o_p + 512u * k)); va[k] = __builtin_nontemporal_load((const u32x4*)(yab + o_h + 1024u * k)); }
#pragma unroll
            for (int k = 0; k < 2; ++k) vm[k] = __builtin_nontemporal_load((const u32x4*)(ymb + o_m + 1024u * k));
#pragma unroll
            for (int k = 0; k < 4; ++k) { zl[k] = __builtin_nontemporal_load((const u32x2*)(prb + o_pr + (unsigned)((C_ZL + 4 * lane + 256 * k) * 2))); za[k] = __builtin_nontemporal_load((const u32x4*)(prb + o_pr + (unsigned)((C_ZA + 8 * lane + 512 * k) * 2))); }
#pragma unroll
            for (int k = 0; k < 2; ++k) zm[k] = __builtin_nontemporal_load((const u32x4*)(prb + o_pr + (unsigned)((C_ZM + 8 * lane + 512 * k) * 2)));
            __builtin_amdgcn_sched_barrier(0);
            f32x4 v[4]; float ssl = 0.f, ssa = 0.f, ssm = 0.f;
#pragma unroll
            for (int k = 0; k < 4; ++k) {
                v[k][0] = h4[k][0] + bflo(pf[k].x) * cf[k][0] + bflo(pb[k].x) * cb[k][0]; v[k][1] = h4[k][1] + bfhi(pf[k].x) * cf[k][1] + bfhi(pb[k].x) * cb[k][1];
                v[k][2] = h4[k][2] + bflo(pf[k].y) * cf[k][2] + bflo(pb[k].y) * cb[k][2]; v[k][3] = h4[k][3] + bfhi(pf[k].y) * cf[k][3] + bfhi(pb[k].y) * cb[k][3];
                ssl += (v[k][0] * v[k][0] + v[k][1] * v[k][1]) + (v[k][2] * v[k][2] + v[k][3] * v[k][3]);
                { const float f0 = bflo(va[k].x), f1 = bfhi(va[k].x), f2 = bflo(va[k].y), f3 = bfhi(va[k].y), f4 = bflo(va[k].z), f5 = bfhi(va[k].z), f6 = bflo(va[k].w), f7 = bfhi(va[k].w);
                  ssa += ((f0 * f0 + f1 * f1) + (f2 * f2 + f3 * f3)) + ((f4 * f4 + f5 * f5) + (f6 * f6 + f7 * f7)); } }
#pragma unroll
            for (int k = 0; k < 2; ++k) { const float f0 = bflo(vm[k].x), f1 = bfhi(vm[k].x), f2 = bflo(vm[k].y), f3 = bfhi(vm[k].y), f4 = bflo(vm[k].z), f5 = bfhi(vm[k].z), f6 = bflo(vm[k].w), f7 = bfhi(vm[k].w);
                ssm += ((f0 * f0 + f1 * f1) + (f2 * f2 + f3 * f3)) + ((f4 * f4 + f5 * f5) + (f6 * f6 + f7 * f7)); }
#pragma unroll
            for (int o = 1; o < 64; o <<= 1) { ssl += __shfl_xor(ssl, o); ssa += __shfl_xor(ssa, o); ssm += __shfl_xor(ssm, o); }
            const float rsl = 1.f / sqrtf(ssl * (1.f / 1024.f) + EPSN), rsa = 1.f / sqrtf(ssa * (1.f / 2048.f) + EPSN), rsm = 1.f / sqrtf(ssm * (1.f / 1024.f) + EPSN);
            __builtin_amdgcn_sched_barrier(0);
#pragma unroll
            for (int k = 0; k < 4; ++k) { const int c = 4 * lane + 256 * k; const f32x4 g4 = *(const LAS f32x4*)(gl + 2048 + c); const u32x2 z = zl[k];
                u32x2 o; o.x = pk2(v[k][0] * rsl * g4[0] * silu_(bflo(z.x)), v[k][1] * rsl * g4[1] * silu_(bfhi(z.x))); o.y = pk2(v[k][2] * rsl * g4[2] * silu_(bflo(z.y)), v[k][3] * rsl * g4[3] * silu_(bfhi(z.y)));
                *(u32x2*)(yb + o_y + (unsigned)((2048 + c) * 2)) = o; }
            __builtin_amdgcn_sched_barrier(0);
#pragma unroll
            for (int k = 0; k < 4; ++k) { const int c = 8 * lane + 512 * k; const f32x4 g0 = *(const LAS f32x4*)(gl + c), g1 = *(const LAS f32x4*)(gl + c + 4); const u32x4 z = za[k];
                u32x4 o; o.x = pk2(bflo(va[k].x) * rsa * g0[0] * silu_(bflo(z.x)), bfhi(va[k].x) * rsa * g0[1] * silu_(bfhi(z.x)));
                o.y = pk2(bflo(va[k].y) * rsa * g0[2] * silu_(bflo(z.y)), bfhi(va[k].y) * rsa * g0[3] * silu_(bfhi(z.y)));
                o.z = pk2(bflo(va[k].z) * rsa * g1[0] * silu_(bflo(z.z)), bfhi(va[k].z) * rsa * g1[1] * silu_(bfhi(z.z)));
                o.w = pk2(bflo(va[k].w) * rsa * g1[2] * silu_(bflo(z.w)), bfhi(va[k].w) * rsa * g1[3] * silu_(bfhi(z.w)));
                *(u32x4*)(yb + o_y + (unsigned)(c * 2)) = o; }
            __builtin_amdgcn_sched_barrier(0);
#pragma unroll
            for (int k = 0; k < 2; ++k) { const int c = 8 * lane + 512 * k; const f32x4 g0 = *(const LAS f32x4*)(gl + 3072 + c), g1 = *(const LAS f32x4*)(gl + 3072 + c + 4); const u32x4 z = zm[k];
                u32x4 o; o.x = pk2(bflo(vm[k].x) * rsm * g0[0] * silu_(bflo(z.x)), bfhi(vm[k].x) * rsm * g0[1] * silu_(bfhi(z.x)));
                o.y = pk2(bflo(vm[k].y) * rsm * g0[2] * silu_(bflo(z.y)), bfhi(vm[k].y) * rsm * g0[3] * silu_(bfhi(z.y)));
                o.z = pk2(bflo(vm[k].z) * rsm * g1[0] * silu_(bflo(z.z)), bfhi(vm[k].z) * rsm * g1[1] * silu_(bfhi(z.z)));
                o.w = pk2(bflo(vm[k].w) * rsm * g1[2] * silu_(bflo(z.w)), bfhi(vm[k].w) * rsm * g1[3] * silu_(bfhi(z.w)));
                *(u32x4*)(yb + o_y + (unsigned)((3072 + c) * 2)) = o; }
        }
    }
}

#define XB_TMO      128
#define XB_XCNT(j)  (256  + 64 * (j))
#define XB_XSUB(j)  (1280 + 64 * (j))
#define XB_XGEN(j)  (2304 + 64 * (j))
#define XB_TOP      3328
#define XB_TOPGEN   3392
#define XCD_BAR_WORDS 3456
#define XB_SPIN_CAP (1u << 18)

__device__ __forceinline__ unsigned xb_ld(unsigned* p)              { return __hip_atomic_load(p, __ATOMIC_RELAXED, __HIP_MEMORY_SCOPE_AGENT); }
__device__ __forceinline__ unsigned xb_add(unsigned* p, unsigned v) { return __hip_atomic_fetch_add(p, v, __ATOMIC_RELAXED, __HIP_MEMORY_SCOPE_AGENT); }
__device__ __forceinline__ unsigned xb_xcc_id() { return (unsigned)__builtin_amdgcn_s_getreg((3 << 11) | 20) & 0xFu; }
#define XB_SPIN(cond, bar) do { unsigned _sp = 0; while (cond) { __builtin_amdgcn_s_sleep(1); \
    if ((++_sp & 255u) == 0u) { if (xb_ld(&(bar)[XB_TMO])) break; if (_sp > XB_SPIN_CAP) { atomicAdd(&(bar)[XB_TMO], 1u); break; } } } } while (0)

struct XcdBarrier {
    unsigned* bar; unsigned x;
    volatile LAS unsigned* st;
};

__device__ __forceinline__ XcdBarrier xcd_barrier_post(unsigned* bar, volatile LAS unsigned* st) {
    XcdBarrier b; b.bar = bar; b.x = xb_xcc_id(); b.st = st;
    if (threadIdx.x == 0) (void)xb_add(&bar[XB_XCNT(b.x)], 1u);
    return b;
}
__device__ __forceinline__ void xcd_barrier_complete(unsigned* bar, unsigned x, unsigned& nloc, unsigned& nx) {
    const unsigned G = gridDim.x * gridDim.y * gridDim.z;
    unsigned sum, cnt, mine, sp = 0u;
    for (;;) {
        sum = 0u; cnt = 0u; mine = 0u;
#pragma unroll
        for (unsigned j = 0; j < 16; ++j) { const unsigned c = xb_ld(&bar[XB_XCNT(j)]); sum += c; cnt += (c > 0u) ? 1u : 0u; mine = (j == x) ? c : mine; }
        if (sum == G) break;
        __builtin_amdgcn_s_sleep(1);
        if ((++sp & 255u) == 0u) { if (xb_ld(&bar[XB_TMO])) break; if (sp > XB_SPIN_CAP) { atomicAdd(&bar[XB_TMO], 1u); break; } }
    }
    nloc = mine > 0u ? mine : 1u; nx = cnt > 0u ? cnt : 1u;
}

__device__ __forceinline__ void xcd_barrier(const XcdBarrier& b) {
    asm volatile("s_waitcnt vmcnt(0)" ::: "memory");
    __syncthreads();
    if (threadIdx.x == 0) {
        unsigned* bar = b.bar;
        __builtin_amdgcn_s_waitcnt(0);
        unsigned nloc = b.st[0], nx = b.st[1];
        if (nloc == 0u) { xcd_barrier_complete(bar, b.x, nloc, nx); b.st[0] = nloc; b.st[1] = nx; }
        const unsigned old = xb_add(&bar[XB_XSUB(b.x)], 1u);
        const unsigned gen = old / nloc;
        if (old + 1u == (gen + 1u) * nloc) {
            __builtin_amdgcn_fence(__ATOMIC_RELEASE, "agent");
            asm volatile("s_waitcnt vmcnt(0)" ::: "memory");
            const unsigned og = xb_add(&bar[XB_TOP], 1u);
            const unsigned tg = og / nx;
            if (og + 1u == (tg + 1u) * nx) xb_add(&bar[XB_TOPGEN], 1u);
            else XB_SPIN(xb_ld(&bar[XB_TOPGEN]) == tg, bar);
            __builtin_amdgcn_fence(__ATOMIC_ACQUIRE, "agent");
            xb_add(&bar[XB_XGEN(b.x)], 1u);
            asm volatile("s_waitcnt vmcnt(0)" ::: "memory");
        } else {
            XB_SPIN(xb_ld(&bar[XB_XGEN(b.x)]) == gen, bar);
            __builtin_amdgcn_fence(__ATOMIC_ACQUIRE, "agent");
            asm volatile("s_waitcnt vmcnt(0)" ::: "memory");
        }
    }
    __syncthreads();
}

struct Sched2 {
    int c;
    __device__ bool next(int i, pg8::Unit& u) const {
        if (i >= 2) return false;
        const int x = c & 7, j = c >> 3;
        u.pm = i * 16 + 4 * (x >> 1) + (j & 3); u.pn = 8 * (x & 1) + (j >> 2); return true;
    }
    __device__ __forceinline__ void a_ready(const pg8::Unit&) const {}
    __device__ __forceinline__ void done(const pg8::Unit&) const {}
};
struct Epi3 {
    static constexpr bool PERM = true, AFTER_DRAIN = false, HOLD_LAST = true;
    float* out; bf16_t* t0; float* sspart; const float* x; const float* gain; XcdBarrier xbar;
    __device__ __forceinline__ void operator()(const f32x4 (&acc)[2][2][4][2], const pg8::Unit& u, int wr, int wc, int fr, int fq) const {
#pragma unroll
        for (int ai = 0; ai < 2; ++ai)
#pragma unroll
            for (int m = 0; m < 4; ++m) { const int row = u.pm * 256 + ai * 128 + wr * 64 + m * 16 + fr; float ss = 0.f;
#pragma unroll
                for (int bj = 0; bj < 2; ++bj) { const f32x4 v0 = acc[ai][bj][m][0], v1 = acc[ai][bj][m][1]; const int col = u.pn * 256 + bj * 128 + wc * 32 + 8 * fq;
                    u32x4 pk; pk.x = pk2(v0[0], v0[1]); pk.y = pk2(v0[2], v0[3]); pk.z = pk2(v1[0], v1[1]); pk.w = pk2(v1[2], v1[3]); *(u32x4*)(t0 + (size_t)row * 4096 + col) = pk;
                    ss += ((v0[0] * v0[0] + v0[1] * v0[1]) + (v0[2] * v0[2] + v0[3] * v0[3])) + ((v1[0] * v1[0] + v1[1] * v1[1]) + (v1[2] * v1[2] + v1[3] * v1[3])); }
                ss += __shfl_xor(ss, 16); ss += __shfl_xor(ss, 32);
                if (fq == 0) sspart[(size_t)row * 64 + u.pn * 4 + wc] = ss; }
    }
    __device__ __forceinline__ void fused(f32x4 (&acc)[2][2][4][2], const pg8::Unit& u, int wr, int wc, int fr, int fq, LAS unsigned char* lds, int wid, int lane) const {
#pragma unroll
        for (int ai = 0; ai < 2; ++ai)
#pragma unroll
            for (int m = 0; m < 4; ++m) { const int row = u.pm * 256 + ai * 128 + wr * 64 + m * 16 + fr; float ss = 0.f;
#pragma unroll
                for (int bj = 0; bj < 2; ++bj)
#pragma unroll
                    for (int n = 0; n < 2; ++n) { const f32x4 v = acc[ai][bj][m][n]; ss += (v[0] * v[0] + v[1] * v[1]) + (v[2] * v[2] + v[3] * v[3]); }
                ss += __shfl_xor(ss, 16); ss += __shfl_xor(ss, 32);
                if (fq == 0) sspart[(size_t)row * 64 + u.pn * 4 + wc] = ss; }
        xcd_barrier(xbar);
        constexpr int TP = 260;
        LAS float* T = (LAS float*)lds;
        LAS float* rsT = (LAS float*)(lds + 128 * TP * 4);
        { const int tid = wid * 64 + lane, row = tid >> 1, hf = tid & 1;
          const f32x4* p = (const f32x4*)(sspart + (size_t)(u.pm * 256 + row) * 64 + hf * 32);
          float s = 0.f;
#pragma unroll
          for (int i = 0; i < 8; ++i) { const f32x4 v = p[i]; s += (v[0] + v[1]) + (v[2] + v[3]); }
          s += __shfl_xor(s, 1);
          if (hf == 0) rsT[row] = 1.f / sqrtf(s * (1.f / 4096.f) + EPSN); }
        const f32x4 gv = *(const f32x4*)(gain + u.pn * 256 + 4 * lane);
#pragma unroll
        for (int ai = 0; ai < 2; ++ai) {
            __syncthreads();
#pragma unroll
            for (int m = 0; m < 4; ++m)
#pragma unroll
                for (int bj = 0; bj < 2; ++bj)
#pragma unroll
                    for (int n = 0; n < 2; ++n) *(LAS f32x4*)(T + (wr * 64 + m * 16 + fr) * TP + bj * 128 + wc * 32 + 8 * fq + 4 * n) = acc[ai][bj][m][n];
            __syncthreads();
#pragma unroll 4
            for (int r = 0; r < 16; ++r) { const int rl = wid * 16 + r; const size_t go = (size_t)(u.pm * 256 + ai * 128 + rl) * 4096 + u.pn * 256 + 4 * lane;
                const f32x4 tv = *(const LAS f32x4*)(T + rl * TP + 4 * lane); const float rs = rsT[ai * 128 + rl];
                const f32x4 xv = __builtin_nontemporal_load((const f32x4*)(x + go));
                __builtin_nontemporal_store(xv + tv * rs * gv, (f32x4*)(out + go)); }
        }
    }
};
__device__ __forceinline__ void phase6(const Args& a) {
    int tid = threadIdx.x; asm volatile("" : "+v"(tid)); const int lane = tid & 63, w = tid >> 6;
    const float* sspart = (const float*)(a.ws + WS_SS); const bf16_t* t0 = (const bf16_t*)(a.ws + WS_T0);
    f32x4 gv[16];
#pragma unroll
    for (int k = 0; k < 16; ++k) gv[k] = ((const f32x4*)a.in[18])[2 * lane + 128 * (k >> 1) + (k & 1)];
    for (int row = blockIdx.x * 8 + w; row < 4096; row += gridDim.x * 8) {
        const u32x4* t4 = (const u32x4*)(t0 + (size_t)row * 4096) + lane; f32x4* o4 = (f32x4*)(a.out + (size_t)row * 4096) + 2 * lane;
        const f32x4* x4 = (const f32x4*)(a.in[0] + (size_t)row * 4096) + 2 * lane;
        u32x4 tv[8]; f32x4 xa[8], xb[8];
        const float sp = sspart[(size_t)row * 64 + lane];
#pragma unroll
        for (int k = 0; k < 8; ++k) { tv[k] = __builtin_nontemporal_load(t4 + 64 * k); xa[k] = __builtin_nontemporal_load(x4 + 128 * k); xb[k] = __builtin_nontemporal_load(x4 + 128 * k + 1); }
        const float rs = 1.f / sqrtf(wave_sum(sp) * (1.f / 4096.f) + EPSN);
#pragma unroll
        for (int k = 0; k < 8; ++k) { const f32x4 ga = gv[2 * k], gb = gv[2 * k + 1];
            f32x4 oa, ob; oa[0] = xa[k][0] + bflo(tv[k].x) * rs * ga[0]; oa[1] = xa[k][1] + bfhi(tv[k].x) * rs * ga[1]; oa[2] = xa[k][2] + bflo(tv[k].y) * rs * ga[2]; oa[3] = xa[k][3] + bfhi(tv[k].y) * rs * ga[3];
            ob[0] = xb[k][0] + bflo(tv[k].z) * rs * gb[0]; ob[1] = xb[k][1] + bfhi(tv[k].z) * rs * gb[1]; ob[2] = xb[k][2] + bflo(tv[k].w) * rs * gb[2]; ob[3] = xb[k][3] + bfhi(tv[k].w) * rs * gb[3];
            __builtin_nontemporal_store(oa, o4 + 128 * k); __builtin_nontemporal_store(ob, o4 + 128 * k + 1); }
    }
}

__global__ void __launch_bounds__(512, 2) mega(Args a) {
    extern __shared__ __attribute__((aligned(16))) unsigned char lds_raw[];
    LAS unsigned char* lds = (LAS unsigned char*)lds_raw;
    cg::grid_group grid = cg::this_grid();
    unsigned char* ws = a.ws;
    volatile LAS unsigned* xst = (volatile LAS unsigned*)(lds + LDS_BYTES - 64);
    if (threadIdx.x < 16) xst[threadIdx.x] = 0u;
    __syncthreads();
    XcdBarrier xbar; xbar.bar = (unsigned*)(ws + WS_CTL); xbar.x = 0; xbar.st = nullptr;
    xbar = xcd_barrier_post((unsigned*)(ws + WS_CTL), xst);
    const int lo = a.ph_lo, hi = a.ph_hi;
#define IN(k) (lo <= (k) && (k) < hi)
#define SEAM(k) do { if (IN(k) && IN((k) + 1)) { if ((k) == 1) { __syncthreads(); grid.sync(); } else xcd_barrier(xbar); } } while (0)
    if (IN(0)) { if (PHMASK & 1) phase0(a, lds); if (REPMASK & 1) { __syncthreads(); phase0(a, lds); } }
    SEAM(0);
    if (IN(1)) { if (PHMASK & 2) {
        pg8::Gemm g{(const bf16_t*)(ws + WS_U), (const bf16_t*)(ws + WS_WT), SEQ + NMEM, INW + 2048, 4096};
        Sched1 S; S.init((int)gridDim.x, (int)blockIdx.x);
        Epi1 E{(bf16_t*)(ws + WS_PROJ), (bf16_t*)(ws + WS_VT), (bf16_t*)(ws + WS_MK), (bf16_t*)(ws + WS_MVT), (const float*)(ws + WS_ROPE)};
        pg8::gemm_phase<Epi1, Sched1, true, true>(lds, g, S, E);
        {
            const int G = (int)gridDim.x, nfull = 1160 % G, nidle = (nfull == 0) ? G : G - nfull;
            const int bi = (nfull == 0) ? (int)blockIdx.x : (int)blockIdx.x - nfull;
            if (bi >= 0) {
                int tid = threadIdx.x; asm volatile("" : "+v"(tid)); const int lane = tid & 63, w = tid >> 6;
                LAS float* scr = (LAS float*)(lds + w * 16384);
                p0_transpose_matrix(a.in[17], 4096, 4096, (bf16_t*)(ws + WS_WOUT), 0, scr, bi * 8 + w, nidle * 8, lane);
            }
        }
        if (REPMASK & 2) { __syncthreads(); pg8::gemm_phase<Epi1, Sched1, true, true>(lds, g, S, E); }
    } }
    SEAM(1);
    if (IN(2)) { if (PHMASK & 4) phase2(a, lds, P2MASK); }
    SEAM(2);
    if (IN(3)) { if (PHMASK & 8) phase3(a, lds); if (REPMASK & 8) { __syncthreads(); phase3(a, lds); } }
    SEAM(3);
    if (IN(4)) { if (PHMASK & 16) phase4(a, lds); if (REPMASK & 16) { __syncthreads(); phase4(a, lds); } }
    SEAM(4);
    if (IN(5)) { if (PHMASK & 32) {
        pg8::Gemm g{(const bf16_t*)(ws + WS_Y), (const bf16_t*)(ws + WS_WOUT), SEQ, 4096, 4096};
        Sched2 S; S.c = (int)blockIdx.x;
        Epi3 E{a.out, (bf16_t*)(ws + WS_T0), (float*)(ws + WS_SS), a.in[0], a.in[18], xbar};
        pg8::gemm_phase<Epi3, Sched2, true, true>(lds, g, S, E);
    } }
    if (IN(6)) { if (PHMASK & 64) phase6(a); }
#if N_LAUNCHES != 1
    if (lo >= 7 && lo < 10) phase2(a, lds, 1 << (lo - 7));
    if (lo == 11 || lo == 12) {
        pg8::Gemm g{(const bf16_t*)(ws + WS_U), (const bf16_t*)(ws + WS_WT), SEQ + NMEM, INW + 2048, 4096};
        Sched1 S; S.init((int)gridDim.x, (int)blockIdx.x); if (lo == 11) S.imax = 4; else S.ioff = 4;
        Epi1 E{(bf16_t*)(ws + WS_PROJ), (bf16_t*)(ws + WS_VT), (bf16_t*)(ws + WS_MK), (bf16_t*)(ws + WS_MVT), (const float*)(ws + WS_ROPE)};
        pg8::gemm_phase<Epi1, Sched1, true, true>(lds, g, S, E);
    }
    if (lo == 13) {
        pg8::Gemm g{(const bf16_t*)(ws + WS_U), (const bf16_t*)(ws + WS_WT), SEQ + NMEM, INW + 2048, 4096};
        Sched1 S; S.init((int)gridDim.x, (int)blockIdx.x); S.imax = 4;
        pg8::EpiBf16<0> E{(bf16_t*)(ws + WS_HS), INW, nullptr, 0, 0, 1.f};
        pg8::gemm_phase<pg8::EpiBf16<0>, Sched1, true, true>(lds, g, S, E);
    }
#ifdef LRUVAR
    if (lo == 10) lru_phase<LRUVAR>(lds, a, (int)(blockIdx.x & 7), (int)(blockIdx.x >> 3), (int)(gridDim.x >> 3));
#endif
#endif
#undef IN
#undef SEAM
}

extern "C" void kernel_launch(void* const* d_in, const int* in_sizes, int n_in, void* d_out, int out_size, void* d_ws, size_t ws_size, hipStream_t stream) {
    static int grid = 0;
    if (grid == 0) {
        if (n_in != 19 || ws_size < WS_END) { fprintf(stderr, "kernel_launch: unexpected n_in %d or ws_size %zu (need %zu)\n", n_in, ws_size, (size_t)WS_END); grid = -1; return; }
        int dev = 0, cus = 0, per_cu = 0;
        hipGetDevice(&dev); hipDeviceGetAttribute(&cus, hipDeviceAttributeMultiprocessorCount, dev);
        if (hipFuncSetAttribute((const void*)mega, hipFuncAttributeMaxDynamicSharedMemorySize, LDS_BYTES) != hipSuccess) { fprintf(stderr, "kernel_launch: hipFuncSetAttribute failed\n"); grid = -1; return; }
        if (hipOccupancyMaxActiveBlocksPerMultiprocessor(&per_cu, (const void*)mega, 512, LDS_BYTES) != hipSuccess || per_cu < 1) { fprintf(stderr, "kernel_launch: occupancy query says %d\n", per_cu); per_cu = 1; }
        (void)hipGetLastError();
        if (cus < 256) { fprintf(stderr, "kernel_launch: needs 256 CUs (one workgroup per CU), device has %d\n", cus); grid = -1; return; }
        grid = 256;
    }
    if (grid < 0) return;
    Args a{};
    for (int i = 0; i < 19; ++i) a.in[i] = (const float*)d_in[i];
    a.out = (float*)d_out; a.ws = (unsigned char*)d_ws;
#if N_LAUNCHES == 1
    (void)hipMemsetAsync((char*)d_ws + WS_CTL, 0, 65536, stream);
    a.ph_lo = 0; a.ph_hi = NPH;
    void* args[] = {&a};
    hipError_t e = hipLaunchCooperativeKernel((const void*)mega, dim3(grid), dim3(512), args, LDS_BYTES, stream);
    if (e != hipSuccess) fprintf(stderr, "cooperative launch failed: %s (grid %d)\n", hipGetErrorString(e), grid);
#else
#ifndef PHSEQ
#define PHSEQ 0,1,2,3,4,5,6
#endif
    { const int seq[] = {PHSEQ};
      for (unsigned i = 0; i < sizeof(seq) / sizeof(int); ++i) { a.ph_lo = seq[i]; a.ph_hi = seq[i] + 1; (void)hipMemsetAsync((char*)d_ws + WS_CTL, 0, 65536, stream); hipLaunchKernelGGL(mega, dim3(grid), dim3(512), LDS_BYTES, stream, a); } }
#endif
}
```

```cpp
#include <hip/hip_runtime.h>
#include <hip/hip_cooperative_groups.h>
#include <cstdio>
#include <cstdint>
namespace cg = cooperative_groups;
#define N_LAUNCHES 1
namespace pg8 {
#define PG8_LAS __attribute__((address_space(3)))
typedef unsigned short bf16_t;
typedef short bf16x8 __attribute__((ext_vector_type(8)));
typedef float f32x4 __attribute__((ext_vector_type(4)));
typedef unsigned u32x4 __attribute__((ext_vector_type(4)));
constexpr int BM = 256, BK = 64, HALF = 128, HTB = HALF * BK * 2  , STAGE_BYTES = 8 * HTB, NXCD = 8, WGM = 8;

__host__ __device__ __forceinline__ int lds_byte(int r, int c) { const int st = (r >> 4) * 2 + (c >> 5), rr = r & 15, cc = c & 31, ob = rr * 64 + cc * 2; return st * 1024 + (ob ^ (((ob >> 9) & 1) << 5)); }
__host__ __device__ __forceinline__ void stage_rc(int b, int& R, int& C) { const int st = b / 1024, sb = b % 1024, swz = sb ^ (((sb >> 9) & 1) << 5); R = (st >> 1) * 16 + swz / 64; C = (st & 1) * 32 + (swz % 64) / 2; }
__host__ __device__ __forceinline__ int perm32(int rho) { const int n = rho >> 4, i = rho & 15; return 8 * (i >> 2) + 4 * n + (i & 3); }

struct Unit { int pm, pn; };
struct Gemm { const bf16_t* A; const bf16_t* Bt; int M, N, K; };

struct StaticOrder {
    int nM, nN, nwg, G, c;
    __host__ __device__ void init(int M, int N, int G_, int c_) { nM = M / BM; nN = N / BM; nwg = nM * nN; G = G_; c = c_; }
    __host__ __device__ bool next(int i, Unit& u) const {
        const long L = (long)i * G + c; if (L >= nwg) return false;
        int wgid = (int)L; { const int q = nwg / NXCD, r = nwg % NXCD, xcd = wgid % NXCD, off = wgid / NXCD; wgid = (xcd < r ? xcd * (q + 1) : r * (q + 1) + (xcd - r) * q) + off; }
        const int nig = WGM * nN, gid = wgid / nig, fm = gid * WGM, gsz = (nM - fm) < WGM ? (nM - fm) : WGM;
        u.pm = fm + ((wgid % nig) % gsz); u.pn = (wgid % nig) / gsz; return true;
    }
    __device__ __forceinline__ void a_ready(const Unit&) const {}
    __device__ __forceinline__ void done(const Unit&) const {}
};

__device__ __forceinline__ unsigned cvt_pk_bf16(float lo, float hi) { unsigned r; asm volatile("v_cvt_pk_bf16_f32 %0, %1, %2" : "=v"(r) : "v"(lo), "v"(hi)); return r; }
typedef float f32x2 __attribute__((ext_vector_type(2)));
__device__ __forceinline__ f32x2 gelu_pk(f32x2 v) {
    const f32x2 av = __builtin_elementwise_abs(v), d = av * 0.2316418882f + 1.0f;
    f32x2 t; t.x = __builtin_amdgcn_rcpf(d.x); t.y = __builtin_amdgcn_rcpf(d.y);
    f32x2 q = t * 0.5307027145f + (-0.7265760135f); q = q * t + 0.7107068705f; q = q * t + (-0.142248368f); q = q * t + 0.127414796f; q = q * t;
    const f32x2 s = (v * v) * (-0.72134752044f);
    f32x2 e; e.x = __builtin_amdgcn_exp2f(s.x); e.y = __builtin_amdgcn_exp2f(s.y);
    const f32x2 m = v * (q * e), r = v - m;
    f32x2 o; o.x = v.x < 0.f ? m.x : r.x; o.y = v.y < 0.f ? m.y : r.y; return o;
}

template <int ACT  > struct EpiBf16 {
    static constexpr bool PERM = true, AFTER_DRAIN = false, HOLD_LAST = false; static_assert(ACT == 0 || ACT == 1, "EpiBf16: ACT is 0 (none) or 1 (gelu_pk)");
    bf16_t* O; int ldc; const float* bias; int split_cols; size_t split_stride; float scale0;
    __device__ __forceinline__ void operator()(const f32x4 (&acc)[2][2][4][2], const Unit& u, int wr, int wc, int fr, int fq) const {
        const int row0 = u.pm * BM + wr * 64 + fr; int colt = u.pn * BM; bf16_t* base = O;
        float sc = 1.f; if (split_cols) { const int t = colt / split_cols; base += (size_t)t * split_stride; colt -= t * split_cols; if (t == 0) sc = scale0; }
        const int col0 = colt + wc * 32 + 8 * fq, bcol0 = u.pn * BM + wc * 32 + 8 * fq;
        f32x4 bv[2][2];
#pragma unroll
        for (int bj = 0; bj < 2; ++bj)
#pragma unroll
            for (int n = 0; n < 2; ++n) bv[bj][n] = bias ? *(const f32x4*)(bias + bcol0 + bj * HALF + 4 * n) : (f32x4){0.f, 0.f, 0.f, 0.f};
#pragma unroll
        for (int ai = 0; ai < 2; ++ai)
#pragma unroll
            for (int m = 0; m < 4; ++m) { bf16_t* rowp = base + (size_t)(row0 + ai * HALF + m * 16) * ldc + col0;
#pragma unroll
                for (int bj = 0; bj < 2; ++bj) { f32x4 v0 = acc[ai][bj][m][0] + bv[bj][0], v1 = acc[ai][bj][m][1] + bv[bj][1];
                    if (ACT == 1) { f32x2 a = gelu_pk((f32x2){v0[0], v0[1]}), b = gelu_pk((f32x2){v0[2], v0[3]}), c = gelu_pk((f32x2){v1[0], v1[1]}), d = gelu_pk((f32x2){v1[2], v1[3]});
                        v0 = (f32x4){a.x, a.y, b.x, b.y}; v1 = (f32x4){c.x, c.y, d.x, d.y}; }
                    v0 = v0 * sc; v1 = v1 * sc; u32x4 w; w.x = cvt_pk_bf16(v0[0], v0[1]); w.y = cvt_pk_bf16(v0[2], v0[3]); w.z = cvt_pk_bf16(v1[0], v1[1]); w.w = cvt_pk_bf16(v1[2], v1[3]);
                    *(u32x4*)(rowp + bj * HALF) = w; } }
    }
};
template <class Epi, class Sched, bool ALIGN_EPI = false, bool SP2 = false>
__device__ __forceinline__ void gemm_phase(PG8_LAS unsigned char* lds, const Gemm g, const Sched& S, const Epi& E) {
    int tid_ = threadIdx.x; asm volatile("" : "+v"(tid_)); const int tid = tid_, wid = __builtin_amdgcn_readfirstlane(tid >> 6), lane = tid & 63, wr = wid >> 2, wc = wid & 3, fr = lane & 15, fq = lane >> 4;
    const int K = g.K, nt = K / BK;
    unsigned voffA[2], voffB[2];
#pragma unroll
    for (int i = 0; i < 2; ++i) { int R, C; stage_rc(tid * 16 + i * 8192, R, C); const int Rb = Epi::PERM ? ((R & ~31) + perm32(R & 31)) : R;
        voffA[i] = (unsigned)(R * K + C) * 2u; voffB[i] = (unsigned)(Rb * K + C) * 2u; }
    const size_t kstep = (size_t)(BK * 2);
    const size_t hstep = (size_t)HALF * K * 2;
    const size_t tstep = 2 * hstep;
    const unsigned ldsw = (unsigned)wid * 1024u;
    const int aoff = lds_byte(wr * 64 + fr, fq * 8), boff = lds_byte(wc * 32 + fr, fq * 8);
#define PG8_SA(b, h) (((b) * 2 + (h)) * HTB)
#define PG8_SB(b, h) ((4 + (b) * 2 + (h)) * HTB)
#define PG8_STAGE(bufoff, gbase, voff) do { _Pragma("unroll") for (int _i = 0; _i < 2; ++_i) \
        __builtin_amdgcn_global_load_lds((const unsigned*)((const char*)(gbase) + (voff)[_i]), (PG8_LAS unsigned*)(lds + (bufoff) + ldsw + _i * 8192), 16, 0, 0); } while (0)
#define PG8_LDA(dst, b, h) do { _Pragma("unroll") for (int m = 0; m < 4; ++m) _Pragma("unroll") for (int k = 0; k < 2; ++k) dst[m][k] = *(const PG8_LAS bf16x8*)(lds + PG8_SA(b, h) + aoff + m * 2048 + k * 1024); } while (0)
#define PG8_LDB(dst, b, h) do { _Pragma("unroll") for (int n = 0; n < 2; ++n) _Pragma("unroll") for (int k = 0; k < 2; ++k) dst[n][k] = *(const PG8_LAS bf16x8*)(lds + PG8_SB(b, h) + boff + n * 2048 + k * 1024); } while (0)
#define PG8_MMA(ai, bj, At, Bt) do { __builtin_amdgcn_s_setprio(1); _Pragma("unroll") for (int m = 0; m < 4; ++m) _Pragma("unroll") for (int n = 0; n < 2; ++n) _Pragma("unroll") for (int k = 0; k < 2; ++k) \
        acc[ai][bj][m][n] = __builtin_amdgcn_mfma_f32_16x16x32_bf16(Bt[n][k], At[m][k], acc[ai][bj][m][n], 0, 0, 0); __builtin_amdgcn_s_setprio(0); } while (0)
#define PG8_WAIT_V(n) asm volatile("s_waitcnt vmcnt(" #n ")" ::: "memory")
#define PG8_WAIT_L(n) asm volatile("s_waitcnt lgkmcnt(" #n ")" ::: "memory")
#define PG8_BAR __builtin_amdgcn_s_barrier()
#define PG8_SCHED __builtin_amdgcn_sched_barrier(0)
    Unit cur, nxt; int ui = 0;
    if (!S.next(0, cur)) return;
    f32x4 acc[2][2][4][2];
#pragma unroll
    for (int a = 0; a < 2; ++a)
#pragma unroll
        for (int b = 0; b < 2; ++b)
#pragma unroll
            for (int m = 0; m < 4; ++m)
#pragma unroll
                for (int n = 0; n < 2; ++n) acc[a][b][m][n] = (f32x4){0.f, 0.f, 0.f, 0.f};
    bf16x8 At[4][2], B0[2][2], B1[2][2];
    const char* cA = (const char*)g.A + (size_t)cur.pm * tstep; const char* cB = (const char*)g.Bt + (size_t)cur.pn * tstep;
    S.a_ready(cur);
    if constexpr (SP2) {
        PG8_STAGE(PG8_SB(0, 0), cB, voffB); PG8_STAGE(PG8_SB(0, 1), cB + hstep, voffB); PG8_STAGE(PG8_SA(0, 0), cA, voffA); PG8_STAGE(PG8_SA(0, 1), cA + hstep, voffA);
        if (wr == 1) PG8_BAR;
        PG8_WAIT_V(2); PG8_BAR;
        PG8_STAGE(PG8_SB(1, 0), cB + kstep, voffB); PG8_STAGE(PG8_SA(1, 0), cA + kstep, voffA); PG8_STAGE(PG8_SB(1, 1), cB + hstep + kstep, voffB);
        PG8_WAIT_V(6); PG8_BAR;
    } else {
        PG8_STAGE(PG8_SB(0, 0), cB, voffB); PG8_STAGE(PG8_SA(0, 0), cA, voffA); PG8_STAGE(PG8_SB(0, 1), cB + hstep, voffB); PG8_STAGE(PG8_SA(0, 1), cA + hstep, voffA);
        if (wr == 1) PG8_BAR;
        PG8_WAIT_V(4); PG8_BAR;
        PG8_STAGE(PG8_SB(1, 0), cB + kstep, voffB); PG8_STAGE(PG8_SA(1, 0), cA + kstep, voffA); PG8_STAGE(PG8_SB(1, 1), cB + hstep + kstep, voffB);
        PG8_WAIT_V(6); PG8_BAR;
    }
    for (;;) {
        const bool has_next = S.next(ui + 1, nxt);
        const char* nA = has_next ? (const char*)g.A + (size_t)nxt.pm * tstep : cA; const char* nB = has_next ? (const char*)g.Bt + (size_t)nxt.pn * tstep : cB;
        for (int t = 0; t < nt; t += 2) {
            const bool last = (t == nt - 2);
            const char* a1 = cA + (size_t)(t + 1) * kstep;
            const char* a2 = last ? nA : cA + (size_t)(t + 2) * kstep; const char* b2 = last ? nB : cB + (size_t)(t + 2) * kstep;
            const char* a3 = a2 + kstep; const char* b3 = b2 + kstep;
            if (last && has_next) S.a_ready(nxt);
            if constexpr (SP2) {
            PG8_LDB(B0, 0, 0); PG8_LDB(B1, 0, 1); PG8_SCHED; PG8_LDA(At, 0, 0); PG8_STAGE(PG8_SA(1, 1), a1 + hstep, voffA);
            PG8_WAIT_V(8); PG8_WAIT_L(0); PG8_BAR; PG8_MMA(0, 0, At, B0); PG8_MMA(0, 1, At, B1); PG8_BAR; PG8_SCHED;
            PG8_LDA(At, 0, 1); PG8_STAGE(PG8_SB(0, 0), b2, voffB); PG8_STAGE(PG8_SB(0, 1), b2 + hstep, voffB); PG8_STAGE(PG8_SA(0, 0), a2, voffA);
            PG8_WAIT_V(8); PG8_WAIT_L(0); PG8_BAR; PG8_MMA(1, 0, At, B0); PG8_MMA(1, 1, At, B1); PG8_BAR; PG8_SCHED;
            PG8_LDB(B0, 1, 0); PG8_LDB(B1, 1, 1); PG8_SCHED; PG8_LDA(At, 1, 0); PG8_STAGE(PG8_SA(0, 1), a2 + hstep, voffA);
            PG8_WAIT_V(8); PG8_WAIT_L(0); PG8_BAR; PG8_MMA(0, 0, At, B0); PG8_MMA(0, 1, At, B1); PG8_BAR; PG8_SCHED;
            PG8_LDA(At, 1, 1); PG8_STAGE(PG8_SB(1, 0), b3, voffB); PG8_STAGE(PG8_SB(1, 1), b3 + hstep, voffB); PG8_STAGE(PG8_SA(1, 0), a3, voffA);
            PG8_WAIT_V(8); PG8_WAIT_L(0); PG8_BAR; PG8_MMA(1, 0, At, B0); PG8_MMA(1, 1, At, B1); PG8_BAR; PG8_SCHED;
            } else {
            PG8_LDB(B0, 0, 0); PG8_SCHED; PG8_LDA(At, 0, 0); PG8_STAGE(PG8_SA(1, 1), a1 + hstep, voffA);
            PG8_WAIT_L(8); PG8_BAR; PG8_WAIT_L(0); PG8_MMA(0, 0, At, B0); PG8_BAR; PG8_SCHED;
            PG8_LDB(B1, 0, 1); PG8_STAGE(PG8_SB(0, 0), b2, voffB);
            PG8_BAR; PG8_WAIT_L(0); PG8_MMA(0, 1, At, B1); PG8_BAR;
            PG8_LDA(At, 0, 1); PG8_STAGE(PG8_SA(0, 0), a2, voffA);
            PG8_BAR; PG8_WAIT_L(0); PG8_MMA(1, 0, At, B0); PG8_BAR; PG8_SCHED;
            PG8_STAGE(PG8_SB(0, 1), b2 + hstep, voffB);
            PG8_WAIT_V(6); PG8_BAR; PG8_MMA(1, 1, At, B1); PG8_BAR;
            PG8_LDB(B0, 1, 0); PG8_SCHED; PG8_LDA(At, 1, 0); PG8_STAGE(PG8_SA(0, 1), a2 + hstep, voffA);
            PG8_WAIT_L(8); PG8_BAR; PG8_WAIT_L(0); PG8_MMA(0, 0, At, B0); PG8_BAR; PG8_SCHED;
            PG8_LDB(B1, 1, 1); PG8_STAGE(PG8_SB(1, 0), b3, voffB);
            PG8_BAR; PG8_WAIT_L(0); PG8_MMA(0, 1, At, B1); PG8_BAR;
            PG8_LDA(At, 1, 1); PG8_STAGE(PG8_SA(1, 0), a3, voffA);
            PG8_BAR; PG8_WAIT_L(0); PG8_MMA(1, 0, At, B0); PG8_BAR; PG8_SCHED;
            PG8_STAGE(PG8_SB(1, 1), b3 + hstep, voffB);
            PG8_WAIT_V(6); PG8_BAR; PG8_MMA(1, 1, At, B1); PG8_BAR;
            }
        }
        if constexpr (ALIGN_EPI) { if (wr == 0) PG8_BAR; }
        if constexpr (!Epi::AFTER_DRAIN) { if (!Epi::HOLD_LAST || has_next) { E(acc, cur, wr, wc, fr, fq); S.done(cur); } }
        if (!has_next) break;
#pragma unroll
        for (int a = 0; a < 2; ++a)
#pragma unroll
            for (int b = 0; b < 2; ++b)
#pragma unroll
                for (int m = 0; m < 4; ++m)
#pragma unroll
                    for (int n = 0; n < 2; ++n) acc[a][b][m][n] = (f32x4){0.f, 0.f, 0.f, 0.f};
        cur = nxt; cA = nA; cB = nB; ++ui;
        if constexpr (ALIGN_EPI) { if (wr == 1) PG8_BAR; }
    }
    PG8_WAIT_V(0);
    if constexpr (!ALIGN_EPI) { if (wr == 0) PG8_BAR; }
    PG8_BAR;
    if constexpr (Epi::AFTER_DRAIN || Epi::HOLD_LAST) { E.fused(acc, cur, wr, wc, fr, fq, lds, wid, lane); S.done(cur); }
#undef PG8_SA
#undef PG8_SB
#undef PG8_STAGE
#undef PG8_LDA
#undef PG8_LDB
#undef PG8_MMA
#undef PG8_WAIT_V
#undef PG8_WAIT_L
#undef PG8_BAR
#undef PG8_SCHED
}
}

#ifndef PHMASK
#define PHMASK 127
#endif
#ifndef REPMASK
#define REPMASK 0
#endif
#ifndef P2MASK
#define P2MASK 7
#endif
#ifndef N_LAUNCHES
#define N_LAUNCHES 1
#endif
using pg8::bf16_t; using pg8::bf16x8; using pg8::f32x4; using pg8::u32x4;
#define LAS __attribute__((address_space(3)))
typedef unsigned u32x2 __attribute__((ext_vector_type(2)));
typedef float f32x2 __attribute__((ext_vector_type(2)));

constexpr int SEQ = 8192, DMODEL = 4096, INW = 9216, NMEM = 256;
constexpr int C_QA = 0, C_KA = 2048, C_VA = 2560, C_XL = 3072, C_QM = 4096, C_ZA = 5120, C_ZL = 7168, C_ZM = 8192;
constexpr float EPSN = 1e-6f;
constexpr float LOG2E = 1.4426950408889634f;
constexpr float SC_ATT = 0.08838834764831845f * LOG2E;
constexpr float SC_MEM = 0.0625f * LOG2E;
constexpr int NPH = 7;
constexpr int LDS_BYTES = 147456;

constexpr size_t MiB = 1u << 20;
constexpr size_t WS_CTL = 0, WS_LRUW = 1 * MiB, WS_ROPE = 2 * MiB, WS_MK = 3 * MiB, WS_MVT = 3 * MiB + 512 * 1024, WS_SS = 4 * MiB,
                 WS_AGG1 = 6 * MiB, WS_AGG2 = 10 * MiB, WS_VT = 12 * MiB, WS_WOUT = 20 * MiB, WS_WT = 52 * MiB, WS_U = 140 * MiB,
                 WS_PROJ = 206 * MiB, WS_HS = 350 * MiB, WS_PP = 382 * MiB, WS_YATT = 414 * MiB, WS_YMEM = 446 * MiB, WS_T0 = 462 * MiB, WS_END = 494 * MiB;
constexpr size_t WS_Y = WS_U;

struct Args { const float* in[19]; float* out; unsigned char* ws; int ph_lo, ph_hi; };

__device__ __forceinline__ unsigned pk2(float lo, float hi) { return pg8::cvt_pk_bf16(lo, hi); }
__device__ __forceinline__ float bflo(unsigned u) { return __builtin_bit_cast(float, u << 16); }
__device__ __forceinline__ float bfhi(unsigned u) { return __builtin_bit_cast(float, u & 0xffff0000u); }
__device__ __forceinline__ float wave_sum(float v) {
#pragma unroll
    for (int o = 1; o < 64; o <<= 1) v += __shfl_xor(v, o);
    return v;
}
__device__ __forceinline__ float fexp2(float x) { return __builtin_amdgcn_exp2f(x); }
__device__ __forceinline__ float sigmoidf_(float x) { return 1.f / (1.f + __expf(-x)); }
__device__ __forceinline__ float fsigmoid(float x) { return __builtin_amdgcn_rcpf(1.f + __builtin_amdgcn_exp2f(-x * 1.4426950408889634f)); }
__device__ __forceinline__ f32x4 mfma16(bf16x8 a, bf16x8 b, f32x4 c) { return __builtin_amdgcn_mfma_f32_16x16x32_bf16(a, b, c, 0, 0, 0); }

__device__ __forceinline__ void p0_item_load(const float* W, int N, int item, int lane, float (&r)[32]) {
    const int nblk = N / 32, kb = item / nblk, nb = item % nblk, k0 = 64 * kb, n0 = 32 * nb;
#pragma unroll
    for (int i = 0; i < 32; ++i) { const int kk = 2 * i + (lane >> 5); r[i] = __builtin_nontemporal_load(W + (size_t)(k0 + kk) * N + n0 + (lane & 31)); }
}
__device__ __forceinline__ void p0_item_lds_write(LAS float* scr, int lane, const float (&r)[32]) {
#pragma unroll
    for (int i = 0; i < 32; ++i) { const int kk = 2 * i + (lane >> 5); scr[kk * 33 + (lane & 31)] = r[i]; }
}
__device__ __forceinline__ void p0_item_store(int K, int N, bf16_t* WT, int row_off, LAS float* scr, int item, int lane) {
    const int nblk = N / 32, kb = item / nblk, nb = item % nblk, k0 = 64 * kb, n0 = 32 * nb;
    asm volatile("s_waitcnt lgkmcnt(0)" ::: "memory");
    const int c = lane & 7;
#pragma unroll
    for (int j = 0; j < 4; ++j) { const int n = (lane >> 3) + 8 * j; const LAS float* s = scr + (8 * c) * 33 + n;
        u32x4 o; o.x = pk2(s[0 * 33], s[1 * 33]); o.y = pk2(s[2 * 33], s[3 * 33]); o.z = pk2(s[4 * 33], s[5 * 33]); o.w = pk2(s[6 * 33], s[7 * 33]);
        *(u32x4*)(WT + (size_t)(row_off + n0 + n) * K + k0 + 8 * c) = o; }
    asm volatile("s_waitcnt lgkmcnt(0)" ::: "memory");
}
__device__ __forceinline__ void p0_transpose_item(const float* W, int K, int N, bf16_t* WT, int row_off, LAS float* scr, int item, int lane) {
    float r[32]; p0_item_load(W, N, item, lane, r); p0_item_lds_write(scr, lane, r); p0_item_store(K, N, WT, row_off, scr, item, lane);
}
__device__ __forceinline__ void p0_transpose_matrix(const float* W, int K, int N, bf16_t* WT, int row_off, LAS float* scr, int first, int step, int lane) {
    const int nitems = (K / 64) * (N / 32);
    if (first >= nitems) return;
    float r[32]; p0_item_load(W, N, first, lane, r);
#pragma unroll 1
    for (int it = first; it < nitems; it += step) {
        p0_item_lds_write(scr, lane, r);
        if (it + step < nitems) p0_item_load(W, N, it + step, lane, r);
        p0_item_store(K, N, WT, row_off, scr, it, lane);
    }
}
__device__ __forceinline__ void rms_row_to_bf16(const float* xrow, const f32x4 (&gv)[16], bf16_t* orow, int lane) {
    const f32x4* xr = (const f32x4*)xrow + lane;
    f32x4 v[16]; float s = 0.f;
#pragma unroll
    for (int k = 0; k < 16; ++k) { v[k] = __builtin_nontemporal_load(xr + 64 * k); s += (v[k].x * v[k].x + v[k].y * v[k].y) + (v[k].z * v[k].z + v[k].w * v[k].w); }
    const float rs = 1.f / sqrtf(wave_sum(s) * (1.f / 4096.f) + EPSN);
    u32x2* o8 = (u32x2*)orow + lane;
#pragma unroll
    for (int k = 0; k < 16; ++k) { const f32x4 g4 = gv[k]; u32x2 o; o.x = pk2(v[k].x * rs * g4.x, v[k].y * rs * g4.y); o.y = pk2(v[k].z * rs * g4.z, v[k].w * rs * g4.w); o8[64 * k] = o; }
}

__device__ __forceinline__ void phase0(const Args& a, LAS unsigned char* lds) {
    int tid = threadIdx.x; asm volatile("" : "+v"(tid)); const int lane = tid & 63, w = tid >> 6, G = gridDim.x;
    const int gw = blockIdx.x * 8 + w, NGW = G * 8;
    unsigned char* ws = a.ws;
    LAS float* scr = (LAS float*)(lds + w * 16384);
    bf16_t* WT = (bf16_t*)(ws + WS_WT); bf16_t* WOUT = (bf16_t*)(ws + WS_WOUT); bf16_t* LRUW = (bf16_t*)(ws + WS_LRUW);
    constexpr int I_IN = 64 * (INW / 32), I_MKV = 64 * (2048 / 32), I_OUT = 64 * (4096 / 32), I_LRU = 32 * 8;
    p0_transpose_matrix(a.in[3], 4096, INW, WT, 0, scr, gw, NGW, lane);
    p0_transpose_matrix(a.in[13], 4096, 2048, WT, INW, scr, gw, NGW, lane);
    for (int r = gw; r < I_LRU; r += NGW) {
        const int mat = r >> 3, sub = r & 7, gate = mat >> 4, dn = mat & 15;
        const float* src = (gate ? a.in[9] : a.in[7]) + (size_t)dn * 16384;
        p0_transpose_item(src, 128, 128, LRUW + (size_t)mat * 16384, 0, scr, sub, lane);
    }
    bf16_t* U = (bf16_t*)(ws + WS_U);
    { f32x4 gv[16];
#pragma unroll
      for (int k = 0; k < 16; ++k) gv[k] = ((const f32x4*)a.in[2])[lane + 64 * k];
      for (int m = gw; m < SEQ; m += NGW) rms_row_to_bf16(a.in[0] + (size_t)m * 4096, gv, U + (size_t)m * 4096, lane);
#pragma unroll
      for (int k = 0; k < 16; ++k) gv[k] = ((const f32x4*)a.in[12])[lane + 64 * k];
      for (int m = gw; m < NMEM; m += NGW) rms_row_to_bf16(a.in[1] + (size_t)m * 4096, gv, U + (size_t)(SEQ + m) * 4096, lane); }
    f32x2* rope = (f32x2*)(ws + WS_ROPE);
    for (int e = blockIdx.x * 512 + tid; e < SEQ * 16; e += G * 512) {
        const int pos = e >> 4, i = e & 15;
        const float inv = powf(500000.0f, -(float)i * (1.0f / 16.0f));
        const float ang = (float)pos * inv;
        rope[e] = (f32x2){cosf(ang), sinf(ang)};
    }
}

struct Sched1 {
    pg8::StaticOrder so; int G, c, ioff, imax;
    __device__ void init(int G_, int c_) { so.init(SEQ, INW, G_, c_); G = G_; c = c_; ioff = 0; imax = 1 << 20; }
    __device__ bool next(int i0, pg8::Unit& u) const {
        if (i0 >= imax) return false;
        const int i = i0 + ioff;
        const long L = (long)i * G + c;
        if (L < 1152) return so.next(i, u);
        if (L < 1160) { u.pm = 32; u.pn = 36 + (int)(L - 1152); return true; }
        return false;
    }
    __device__ __forceinline__ void a_ready(const pg8::Unit&) const {}
    __device__ __forceinline__ void done(const pg8::Unit&) const {}
};
struct Epi1 {
    static constexpr bool PERM = true, AFTER_DRAIN = false, HOLD_LAST = false;
    bf16_t* proj; bf16_t* vt; bf16_t* mk; bf16_t* mvt; const float* rope;
    __device__ __forceinline__ void operator()(const f32x4 (&acc)[2][2][4][2], const pg8::Unit& u, int wr, int wc, int fr, int fq) const {
        const int rloc = wr * 64 + fr, cloc = wc * 32 + 8 * fq;
        if (u.pm == 32) {
            const int t = u.pn - 36;
            if (t < 4) {
#pragma unroll
                for (int ai = 0; ai < 2; ++ai)
#pragma unroll
                    for (int m = 0; m < 4; ++m) { const int row = rloc + ai * 128 + m * 16;
#pragma unroll
                        for (int bj = 0; bj < 2; ++bj) { const f32x4 v0 = acc[ai][bj][m][0], v1 = acc[ai][bj][m][1];
                            u32x4 wv; wv.x = pk2(v0[0], v0[1]); wv.y = pk2(v0[2], v0[3]); wv.z = pk2(v1[0], v1[1]); wv.w = pk2(v1[2], v1[3]);
                            *(u32x4*)(mk + (size_t)row * 1024 + t * 256 + bj * 128 + cloc) = wv; } asm volatile("" ::: "memory"); }
            } else {
#pragma unroll
                for (int ai = 0; ai < 2; ++ai)
#pragma unroll
                    for (int m = 0; m < 4; ++m) { const int row = rloc + ai * 128 + m * 16;
#pragma unroll
                        for (int bj = 0; bj < 2; ++bj)
#pragma unroll
                            for (int n = 0; n < 2; ++n)
#pragma unroll
                                for (int i = 0; i < 4; ++i) { const int col = (t - 4) * 256 + bj * 128 + cloc + 4 * n + i;
                                    mvt[(size_t)col * 256 + row] = (bf16_t)(pk2(acc[ai][bj][m][n][i], 0.f) & 0xffffu); } asm volatile("" ::: "memory"); }
            }
            return;
        }
        const int pn = u.pn, row0 = u.pm * 256 + rloc;
        if (pn == 10 || pn == 11) {
#pragma unroll
            for (int ai = 0; ai < 2; ++ai)
#pragma unroll
                for (int m = 0; m < 4; ++m) { const int row = row0 + ai * 128 + m * 16;
#pragma unroll
                    for (int bj = 0; bj < 2; ++bj)
#pragma unroll
                        for (int n = 0; n < 2; ++n)
#pragma unroll
                            for (int i = 0; i < 4; ++i) { const int col = (pn - 10) * 256 + bj * 128 + cloc + 4 * n + i;
                                vt[(size_t)col * SEQ + row] = (bf16_t)(pk2(acc[ai][bj][m][n][i], 0.f) & 0xffffu); } asm volatile("" ::: "memory"); }
            return;
        }
        float sc = 1.f; if (pn < 8) sc = SC_ATT; else if (pn >= 16 && pn < 20) sc = SC_MEM;
        const bool do_rope = (pn < 10) && (wc == 0);
        const float sgn = (fq < 2) ? -1.f : 1.f;
        f32x4 csA[2][2], cst[2][2];
        if (do_rope) {
#pragma unroll
            for (int n = 0; n < 2; ++n) { const int io = (8 * (fq & 1) + 4 * n) * 2;
                const float* ra = rope + (size_t)row0 * 32 + io; const float* rt = rope + 16 * 32 + io;
                csA[n][0] = *(const f32x4*)ra; csA[n][1] = *(const f32x4*)(ra + 4); cst[n][0] = *(const f32x4*)rt; cst[n][1] = *(const f32x4*)(rt + 4); }
        }
#pragma unroll
        for (int ai = 0; ai < 2; ++ai)
#pragma unroll
            for (int m = 0; m < 4; ++m) { const int row = row0 + ai * 128 + m * 16;
                f32x4 cs[2][2];
                if (do_rope) {
                    const int nrot = (ai == 0 && m == 3) ? 5 : 1;
#pragma unroll
                    for (int n = 0; n < 2; ++n)
#pragma unroll
                        for (int hh = 0; hh < 2; ++hh) { f32x4 cur = csA[n][hh]; cs[n][hh] = cur; const f32x4 t = cst[n][hh];
#pragma unroll
                            for (int rr = 0; rr < 5; ++rr) { if (rr < nrot) { f32x4 nx; nx[0] = cur[0] * t[0] - cur[1] * t[1]; nx[1] = cur[1] * t[0] + cur[0] * t[1]; nx[2] = cur[2] * t[2] - cur[3] * t[3]; nx[3] = cur[3] * t[2] + cur[2] * t[3]; cur = nx; } }
                            csA[n][hh] = cur; }
                }
#pragma unroll
                for (int bj = 0; bj < 2; ++bj) { f32x4 v[2]; v[0] = acc[ai][bj][m][0]; v[1] = acc[ai][bj][m][1];
                    if (do_rope) {
#pragma unroll
                        for (int n = 0; n < 2; ++n) { f32x4 p; p[0] = __shfl_xor(v[n][0], 32); p[1] = __shfl_xor(v[n][1], 32); p[2] = __shfl_xor(v[n][2], 32); p[3] = __shfl_xor(v[n][3], 32);
                            f32x4 r; r[0] = v[n][0] * cs[n][0][0] + sgn * p[0] * cs[n][0][1]; r[1] = v[n][1] * cs[n][0][2] + sgn * p[1] * cs[n][0][3];
                            r[2] = v[n][2] * cs[n][1][0] + sgn * p[2] * cs[n][1][1]; r[3] = v[n][3] * cs[n][1][2] + sgn * p[3] * cs[n][1][3]; v[n] = r; }
                    }
                    u32x4 wv; wv.x = pk2(v[0][0] * sc, v[0][1] * sc); wv.y = pk2(v[0][2] * sc, v[0][3] * sc); wv.z = pk2(v[1][0] * sc, v[1][1] * sc); wv.w = pk2(v[1][2] * sc, v[1][3] * sc);
                    __builtin_nontemporal_store(wv, (u32x4*)(proj + (size_t)row * INW + pn * 256 + bj * 128 + cloc)); } asm volatile("" ::: "memory"); }
    }
};

template <int DH, bool PF, bool DB>
__device__ __forceinline__ void attn_unit(LAS unsigned char* lds, const bf16_t* Qp, int ldq, bf16_t* Op, int ldo, const bf16_t* Kg, int ldk, const bf16_t* Vtg, int ldv,
                                          int cb_lo, int cb_hi, int cb_self, float m_init, float l_init) {
    constexpr int PR = DH / 8, KROW = DH * 2, KT = 128 * KROW, VROW = 288, NKI = (128 * PR) / 512, NVI = (DH * 16) / 512, NS = DH / 32, NDT = DH / 16;
    int tid = threadIdx.x; asm volatile("" : "+v"(tid)); const int lane = tid & 63, w = tid >> 6, q = lane & 15, g = lane >> 4;
    const int krow = 8 * (q >> 2) + (q & 3);
    bf16x8 qf[NS];
    { const unsigned qoff = (unsigned)(((16 * w + q) * ldq + 8 * g) * 2);
#pragma unroll
      for (int s = 0; s < NS; ++s) qf[s] = __builtin_nontemporal_load((const bf16x8*)((const char*)Qp + qoff + 64 * s)); }
    f32x4 o[NDT];
#pragma unroll
    for (int dt = 0; dt < NDT; ++dt) o[dt] = (f32x4){0.f, 0.f, 0.f, 0.f};
    float m_run = m_init, l_run = l_init;
    u32x4 kreg[NKI], vreg[NVI];
#define ATT_LOAD(cb) do { const int k0_ = (cb) * 128; \
        const char* kb_ = (const char*)Kg + (size_t)k0_ * ldk * 2; const char* vb_ = (const char*)Vtg + (size_t)k0_ * 2; \
        _Pragma("unroll") for (int it = 0; it < NKI; ++it) { const int e = tid + 512 * it; const int key = e / PR, pc = e % PR; \
            kreg[it] = *(const u32x4*)(kb_ + (unsigned)((key * ldk + pc * 8) * 2)); } \
        _Pragma("unroll") for (int it = 0; it < NVI; ++it) { const int e = tid + 512 * it; const int d = e >> 4, pc = e & 15; \
            vreg[it] = *(const u32x4*)(vb_ + (unsigned)((d * ldv + pc * 8) * 2)); } } while (0)
#define ATT_STORE() do { \
        _Pragma("unroll") for (int it = 0; it < NKI; ++it) { const int e = tid + 512 * it; const int key = e / PR, pc = e % PR; \
            *(LAS u32x4*)(lds + key * KROW + ((pc ^ ((((key >> 3) & 3) << 2) | (key & 3))) * 16)) = kreg[it]; } \
        _Pragma("unroll") for (int it = 0; it < NVI; ++it) { const int e = tid + 512 * it; const int d = e >> 4, pc = e & 15; \
            *(LAS u32x4*)(lds + KT + d * VROW + pc * 16) = vreg[it]; } } while (0)
    if (PF) ATT_LOAD(cb_lo);
    for (int cb = cb_lo; cb < cb_hi; ++cb) {
        if (!PF) ATT_LOAD(cb);
        __syncthreads();
        ATT_STORE();
        __syncthreads();
        if (PF) { if (cb + 1 < cb_hi) ATT_LOAD(cb + 1); }
        f32x4 s[8];
#pragma unroll
        for (int kt = 0; kt < 8; ++kt) s[kt] = (f32x4){0.f, 0.f, 0.f, 0.f};
        {
            bf16x8 ka[DB ? 2 : 1][8];
            if (DB) {
#pragma unroll
                for (int kt = 0; kt < 8; ++kt) ka[0][kt] = *(const LAS bf16x8*)(lds + (32 * (kt >> 1) + 4 * (kt & 1) + krow) * KROW + (((0 + g) ^ q) * 16));
            }
#pragma unroll
            for (int ss = 0; ss < NS; ++ss) {
                if (DB) { if (ss + 1 < NS) {
#pragma unroll
                    for (int kt = 0; kt < 8; ++kt) ka[(ss + 1) & 1][kt] = *(const LAS bf16x8*)(lds + (32 * (kt >> 1) + 4 * (kt & 1) + krow) * KROW + (((4 * (ss + 1) + g) ^ q) * 16)); }
                } else {
#pragma unroll
                    for (int kt = 0; kt < 8; ++kt) ka[0][kt] = *(const LAS bf16x8*)(lds + (32 * (kt >> 1) + 4 * (kt & 1) + krow) * KROW + (((4 * ss + g) ^ q) * 16));
                }
                __builtin_amdgcn_sched_barrier(0);
#pragma unroll
                for (int kt = 0; kt < 8; ++kt) s[kt] = mfma16(ka[DB ? (ss & 1) : 0][kt], qf[ss], s[kt]);
                __builtin_amdgcn_sched_barrier(0);
            }
        }
        if (cb != cb_self && cb_self >= 0) {
            const float sg = (cb < cb_self) ? 1.f : -1.f;
            const float dq = (float)(16 * w + q - 8 * g);
#pragma unroll
            for (int kt = 0; kt < 8; ++kt)
#pragma unroll
                for (int j = 0; j < 4; ++j) { const float v = sg * ((float)(32 * (kt >> 1) + 4 * (kt & 1) + j) - dq); s[kt][j] += fminf(v, 0.f) * 1e30f; }
        }
        float mx = s[0][0];
#pragma unroll
        for (int kt = 0; kt < 8; ++kt)
#pragma unroll
            for (int j = 0; j < 4; ++j) mx = fmaxf(mx, s[kt][j]);
        mx = fmaxf(mx, __shfl_xor(mx, 16)); mx = fmaxf(mx, __shfl_xor(mx, 32));
        const float m_new = fmaxf(m_run, mx), alpha = fexp2(m_run - m_new); m_run = m_new;
        float rs = 0.f;
#pragma unroll
        for (int kt = 0; kt < 8; ++kt)
#pragma unroll
            for (int j = 0; j < 4; ++j) { const float p = fexp2(s[kt][j] - m_new); s[kt][j] = p; rs += p; }
        rs += __shfl_xor(rs, 16); rs += __shfl_xor(rs, 32);
        l_run = l_run * alpha + rs;
        bf16x8 pb[4];
#pragma unroll
        for (int u = 0; u < 4; ++u) { u32x4 t; t.x = pk2(s[2 * u][0], s[2 * u][1]); t.y = pk2(s[2 * u][2], s[2 * u][3]); t.z = pk2(s[2 * u + 1][0], s[2 * u + 1][1]); t.w = pk2(s[2 * u + 1][2], s[2 * u + 1][3]);
            pb[u] = __builtin_bit_cast(bf16x8, t); }
#pragma unroll
        for (int dt = 0; dt < NDT; ++dt) o[dt] = o[dt] * alpha;
        {
            constexpr int NG = (NDT / 8) * 4;
            u32x4 va[DB ? 2 : 1][8];
#define ATT_VLOAD(buf, gi) do { const int u_ = (gi) & 3, d0_ = 8 * ((gi) >> 2); \
            _Pragma("unroll") for (int i = 0; i < 8; ++i) { va[buf][i] = *(const LAS u32x4*)(lds + KT + (16 * (d0_ + i) + q) * VROW + (32 * u_ + 8 * g) * 2); } } while (0)
            if (DB) ATT_VLOAD(0, 0);
#pragma unroll
            for (int gi = 0; gi < NG; ++gi) {
                if (DB) { if (gi + 1 < NG) ATT_VLOAD((gi + 1) & 1, gi + 1); } else ATT_VLOAD(0, gi);
                __builtin_amdgcn_sched_barrier(0);
#pragma unroll
                for (int i = 0; i < 8; ++i) o[8 * (gi >> 2) + i] = mfma16(__builtin_bit_cast(bf16x8, va[DB ? (gi & 1) : 0][i]), pb[gi & 3], o[8 * (gi >> 2) + i]);
                __builtin_amdgcn_sched_barrier(0);
            }
#undef ATT_VLOAD
        }
    }
#undef ATT_LOAD
#undef ATT_STORE
    const float inv = 1.f / l_run;
    const unsigned ooff = (unsigned)(((16 * w + q) * ldo + 4 * g) * 2);
#pragma unroll
    for (int dt = 0; dt < NDT; ++dt) { u32x2 pkv; pkv.x = pk2(o[dt][0] * inv, o[dt][1] * inv); pkv.y = pk2(o[dt][2] * inv, o[dt][3] * inv); *(u32x2*)((char*)Op + ooff + 32 * dt) = pkv; }
}

__device__ __forceinline__ void windowed_stream(LAS unsigned char* lds0, const Args& a) {
    constexpr int DH = 128, PR = 16, KROW = 256, KT = 128 * KROW, VROW = 288, BUFB = KT + DH * VROW, NKI = 4, NVI = 4, NS = 4, NDT = 8;
    static_assert(2 * BUFB <= LDS_BYTES - 64, "two K/V tile buffers must fit under the barrier words");
    int tid = threadIdx.x; asm volatile("" : "+v"(tid)); const int lane = tid & 63, w = tid >> 6, q = lane & 15, g = lane >> 4;
    const int krow = 8 * (q >> 2) + (q & 3);
    unsigned char* ws = a.ws;
    const bf16_t* proj = (const bf16_t*)(ws + WS_PROJ); const bf16_t* vt = (const bf16_t*)(ws + WS_VT); bf16_t* yatt = (bf16_t*)(ws + WS_YATT);
    const int G = (int)gridDim.x;
    if ((int)blockIdx.x >= 1024) return;
    unsigned koff[NKI], voff[NVI], klds[NKI], vlds[NVI];
#pragma unroll
    for (int it = 0; it < NKI; ++it) { const int e = tid + 512 * it, key = e / PR, pc = e % PR; koff[it] = (unsigned)((key * INW + pc * 8) * 2); klds[it] = (unsigned)(key * KROW + ((pc ^ ((((key >> 3) & 3) << 2) | (key & 3))) * 16)); }
#pragma unroll
    for (int it = 0; it < NVI; ++it) { const int e = tid + 512 * it, d = e >> 4, pc = e & 15; voff[it] = (unsigned)((d * SEQ + pc * 8) * 2); vlds[it] = (unsigned)(KT + d * VROW + pc * 16); }
    u32x4 kreg[NKI], vreg[NVI];
#define WS_LOAD(v_, cb_) do { const int kvh_ = ((v_) & 15) >> 2; \
        const char* kb_ = (const char*)proj + ((size_t)((cb_) * 128) * INW + C_KA + kvh_ * 128) * 2; const char* vb_ = (const char*)vt + ((size_t)(kvh_ * 128) * SEQ + (cb_) * 128) * 2; \
        _Pragma("unroll") for (int it = 0; it < NKI; ++it) kreg[it] = *(const u32x4*)(kb_ + koff[it]); \
        _Pragma("unroll") for (int it = 0; it < NVI; ++it) vreg[it] = *(const u32x4*)(vb_ + voff[it]); } while (0)
#define WS_STORE(ldsb_) do { \
        _Pragma("unroll") for (int it = 0; it < NKI; ++it) *(LAS u32x4*)((ldsb_) + klds[it]) = kreg[it]; \
        _Pragma("unroll") for (int it = 0; it < NVI; ++it) *(LAS u32x4*)((ldsb_) + vlds[it]) = vreg[it]; } while (0)
#define WS_LO(v_) ((((v_) >> 4) > 0) ? ((v_) >> 4) - 1 : 0)
#define WS_HI(v_) ((((v_) >> 4) < 63) ? ((v_) >> 4) + 2 : 64)
    int Cv = (int)blockIdx.x, Ccb = WS_LO(Cv);
    int Lv = Cv, Lcb = Ccb; bool Lvalid = true;
#define WS_ADV_L() do { if (Lcb + 1 < WS_HI(Lv)) ++Lcb; else { Lv += G; if (Lv < 1024) Lcb = WS_LO(Lv); else Lvalid = false; } } while (0)
    __syncthreads();
    WS_LOAD(Lv, Lcb); WS_ADV_L();
    WS_STORE(lds0);
    bool have = false;
    if (Lvalid) { WS_LOAD(Lv, Lcb); WS_ADV_L(); have = true; }
    __syncthreads();
    int bsel = 0;
    bf16x8 qf[NS]; f32x4 o[NDT]; float m_run = 0.f, l_run = 1.f;
#pragma unroll 1
    for (;;) {
        const int qblk = Cv >> 4, hq = Cv & 15, lo = WS_LO(Cv), hi = WS_HI(Cv);
        LAS unsigned char* lds = lds0 + bsel * BUFB;
        if (Ccb == lo) {
            const unsigned qoff = (unsigned)(((16 * w + q) * INW + 8 * g) * 2);
            const char* qb = (const char*)proj + ((size_t)(qblk * 128) * INW + C_QA + hq * 128) * 2;
#pragma unroll
            for (int s = 0; s < NS; ++s) qf[s] = __builtin_nontemporal_load((const bf16x8*)(qb + qoff + 64 * s));
#pragma unroll
            for (int dt = 0; dt < NDT; ++dt) o[dt] = (f32x4){0.f, 0.f, 0.f, 0.f};
            m_run = a.in[4][hq] * LOG2E; l_run = 1.f;
        }
        if (have) { WS_STORE(lds0 + (bsel ^ 1) * BUFB); have = false; }
        if (Lvalid) { WS_LOAD(Lv, Lcb); WS_ADV_L(); have = true; }
        f32x4 s[8];
#pragma unroll
        for (int kt = 0; kt < 8; ++kt) s[kt] = (f32x4){0.f, 0.f, 0.f, 0.f};
        {
            bf16x8 ka[2][8];
#pragma unroll
            for (int kt = 0; kt < 8; ++kt) ka[0][kt] = *(const LAS bf16x8*)(lds + (32 * (kt >> 1) + 4 * (kt & 1) + krow) * KROW + (((0 + g) ^ q) * 16));
#pragma unroll
            for (int ss = 0; ss < NS; ++ss) {
                if (ss + 1 < NS) {
#pragma unroll
                    for (int kt = 0; kt < 8; ++kt) ka[(ss + 1) & 1][kt] = *(const LAS bf16x8*)(lds + (32 * (kt >> 1) + 4 * (kt & 1) + krow) * KROW + (((4 * (ss + 1) + g) ^ q) * 16)); }
                __builtin_amdgcn_sched_barrier(0);
#pragma unroll
                for (int kt = 0; kt < 8; ++kt) s[kt] = mfma16(ka[ss & 1][kt], qf[ss], s[kt]);
                __builtin_amdgcn_sched_barrier(0);
            }
        }
        if (Ccb != qblk) {
            const bool prev = Ccb < qblk; const int ud = __builtin_amdgcn_readfirstlane(w) >> 1;
            const float sg = prev ? 1.f : -1.f;
            const float dq = (float)(16 * w + q - 8 * g);
#pragma unroll
            for (int u = 0; u < 4; ++u) {
                if (prev ? (u < ud) : (u > ud)) {
#pragma unroll
                    for (int j = 0; j < 4; ++j) { s[2 * u][j] = -1e30f; s[2 * u + 1][j] = -1e30f; }
                } else if (u == ud) {
#pragma unroll
                    for (int h2 = 0; h2 < 2; ++h2)
#pragma unroll
                        for (int j = 0; j < 4; ++j) { const float v = sg * ((float)(32 * u + 4 * h2 + j) - dq); s[2 * u + h2][j] += fminf(v, 0.f) * 1e30f; }
                }
            }
        }
        float mx = s[0][0];
#pragma unroll
        for (int kt = 0; kt < 8; ++kt)
#pragma unroll
            for (int j = 0; j < 4; ++j) mx = fmaxf(mx, s[kt][j]);
        mx = fmaxf(mx, __shfl_xor(mx, 16)); mx = fmaxf(mx, __shfl_xor(mx, 32));
        const float m_new = fmaxf(m_run, mx), alpha = fexp2(m_run - m_new); m_run = m_new;
        float rs = 0.f;
#pragma unroll
        for (int kt = 0; kt < 8; ++kt)
#pragma unroll
            for (int j = 0; j < 4; ++j) { const float p = fexp2(s[kt][j] - m_new); s[kt][j] = p; rs += p; }
        rs += __shfl_xor(rs, 16); rs += __shfl_xor(rs, 32);
        l_run = l_run * alpha + rs;
        bf16x8 pb[4];
#pragma unroll
        for (int u = 0; u < 4; ++u) { u32x4 t; t.x = pk2(s[2 * u][0], s[2 * u][1]); t.y = pk2(s[2 * u][2], s[2 * u][3]); t.z = pk2(s[2 * u + 1][0], s[2 * u + 1][1]); t.w = pk2(s[2 * u + 1][2], s[2 * u + 1][3]);
            pb[u] = __builtin_bit_cast(bf16x8, t); }
#pragma unroll
        for (int dt = 0; dt < NDT; ++dt) o[dt] = o[dt] * alpha;
        {
            u32x4 va[2][8];
#define WS_VLOAD(buf, gi) do { _Pragma("unroll") for (int i = 0; i < 8; ++i) { va[buf][i] = *(const LAS u32x4*)(lds + KT + (16 * i + q) * VROW + (32 * (gi) + 8 * g) * 2); } } while (0)
            WS_VLOAD(0, 0);
#pragma unroll
            for (int gi = 0; gi < 4; ++gi) {
                if (gi + 1 < 4) WS_VLOAD((gi + 1) & 1, gi + 1);
                __builtin_amdgcn_sched_barrier(0);
#pragma unroll
                for (int i = 0; i < 8; ++i) o[i] = mfma16(__builtin_bit_cast(bf16x8, va[gi & 1][i]), pb[gi], o[i]);
                __builtin_amdgcn_sched_barrier(0);
            }
#undef WS_VLOAD
        }
        bool done = false;
        if (Ccb + 1 < hi) ++Ccb;
        else {
            const float inv = 1.f / l_run;
            char* ob = (char*)yatt + ((size_t)(qblk * 128) * 2048 + hq * 128) * 2;
            const unsigned ooff = (unsigned)(((16 * w + q) * 2048 + 4 * g) * 2);
#pragma unroll
            for (int dt = 0; dt < NDT; ++dt) { u32x2 pkv; pkv.x = pk2(o[dt][0] * inv, o[dt][1] * inv); pkv.y = pk2(o[dt][2] * inv, o[dt][3] * inv); *(u32x2*)(ob + ooff + 32 * dt) = pkv; }
            Cv += G; if (Cv < 1024) Ccb = WS_LO(Cv); else done = true;
        }
        __syncthreads();
        bsel ^= 1;
        if (done) break;
    }
#undef WS_LOAD
#undef WS_STORE
#undef WS_LO
#undef WS_HI
#undef WS_ADV_L
}

constexpr int LR_XCB = 0, LR_TA = 16384, LR_TB = LR_TA + 64 * 528, LR_TH = LR_TB + 64 * 528, LR_AGS = LR_TH + 64 * 528;
template <int VAR>
__device__ __forceinline__ void lru_phase(LAS unsigned char* lds, const Args& a, const int n, const int tt_first, const int tt_step) {
    int tid = threadIdx.x; asm volatile("" : "+v"(tid)); const int lane = tid & 63, w0 = tid >> 6, q0 = lane & 15, g0 = lane >> 4;
    unsigned char* ws = a.ws;
    const bf16_t* proj = (const bf16_t*)(ws + WS_PROJ);
    LAS unsigned char* xcb = lds + LR_XCB;
    LAS float* TA = (LAS float*)(lds + LR_TA); LAS float* TB = (LAS float*)(lds + LR_TB); LAS float* TH = (LAS float*)(lds + LR_TH);
    LAS f32x2* AGS = (LAS f32x2*)(lds + LR_AGS);
    const bf16_t* lruw = (const bf16_t*)(ws + WS_LRUW);
    f32x2* agg1 = (f32x2*)(ws + (VAR ? WS_T0 : WS_AGG1));
    bf16_t* Pout = (bf16_t*)(ws + (VAR ? WS_U + 32 * MiB : WS_PP));
    bf16x8 fa[2][4], fx[2][4];
#pragma unroll
    for (int dir = 0; dir < 2; ++dir) {
        const bf16_t* wa = lruw + (size_t)((0 * 2 + dir) * 8 + n) * 16384 + (16 * w0 + q0) * 128 + 8 * g0;
        const bf16_t* wx = lruw + (size_t)((1 * 2 + dir) * 8 + n) * 16384 + (16 * w0 + q0) * 128 + 8 * g0;
#pragma unroll
        for (int s = 0; s < 4; ++s) { fa[dir][s] = *(const bf16x8*)(wa + 32 * s); fx[dir][s] = *(const bf16x8*)(wx + 32 * s); }
    }
    const int cg8 = tid & 15, t2 = tid >> 4, ch0 = n * 128 + cg8 * 8;
    LAS float* CW = (LAS float*)(lds + LR_AGS + 4096);
    __syncthreads();
    if (tid < 128) {
#pragma unroll
        for (int j = 0; j < 4; ++j) CW[j * 128 + tid] = a.in[5][j * 1024 + n * 128 + tid];
        CW[512 + tid] = a.in[6][n * 128 + tid];
    } else if (tid < 384) {
        const int d2 = (tid - 128) >> 7, c = tid & 127, cg = d2 * 1024 + n * 128 + c;
        const float xl = -a.in[11][cg];
        CW[640 + (d2 * 3 + 0) * 128 + c] = a.in[8][cg]; CW[640 + (d2 * 3 + 1) * 128 + c] = a.in[10][cg];
        CW[640 + (d2 * 3 + 2) * 128 + c] = fmaxf(xl, 0.f) + log1pf(expf(-fabsf(xl)));
    }
    u32x4 xr[5];
#define LRU_XLOAD(tt_) do { _Pragma("unroll") for (int r = 0; r < 5; ++r) { const int t = (tt_) * 64 + 2 * t2 - 2 + r; xr[r] = (u32x4){0u, 0u, 0u, 0u}; \
        if (t >= 0 && t < SEQ) xr[r] = __builtin_nontemporal_load((const u32x4*)((const char*)proj + (unsigned)((t * INW + C_XL + ch0) * 2))); } } while (0)
    if (tt_first < 128) LRU_XLOAD(tt_first);
#pragma unroll 1
    for (int tt = tt_first; tt < 128; tt += tt_step) {
    const int t0 = tt * 64;
    __syncthreads();
    {
        float xin[5][8];
#pragma unroll
        for (int r = 0; r < 5; ++r) { const u32x4 v = xr[r];
            xin[r][0] = bflo(v.x); xin[r][1] = bfhi(v.x); xin[r][2] = bflo(v.y); xin[r][3] = bfhi(v.y); xin[r][4] = bflo(v.z); xin[r][5] = bfhi(v.z); xin[r][6] = bflo(v.w); xin[r][7] = bfhi(v.w); }
        float wv[4][8], bias[8];
#pragma unroll
        for (int j = 0; j < 4; ++j) { const f32x4 w0 = *(const LAS f32x4*)(CW + j * 128 + cg8 * 8), w1 = *(const LAS f32x4*)(CW + j * 128 + cg8 * 8 + 4);
            wv[j][0] = w0[0]; wv[j][1] = w0[1]; wv[j][2] = w0[2]; wv[j][3] = w0[3]; wv[j][4] = w1[0]; wv[j][5] = w1[1]; wv[j][6] = w1[2]; wv[j][7] = w1[3]; }
        { const f32x4 b0 = *(const LAS f32x4*)(CW + 512 + cg8 * 8), b1 = *(const LAS f32x4*)(CW + 512 + cg8 * 8 + 4);
          bias[0] = b0[0]; bias[1] = b0[1]; bias[2] = b0[2]; bias[3] = b0[3]; bias[4] = b1[0]; bias[5] = b1[1]; bias[6] = b1[2]; bias[7] = b1[3]; }
#pragma unroll
        for (int o = 0; o < 2; ++o) { float y[8];
#pragma unroll
            for (int e = 0; e < 8; ++e) { float v = bias[e];
#pragma unroll
                for (int j = 0; j < 4; ++j) v += wv[j][e] * xin[o + j][e];
                y[e] = v; }
            const int tok = 2 * t2 + o;
            u32x4 pk; pk.x = pk2(y[0], y[1]); pk.y = pk2(y[2], y[3]); pk.z = pk2(y[4], y[5]); pk.w = pk2(y[6], y[7]);
            *(LAS u32x4*)(xcb + tok * 256 + ((cg8 ^ (tok & 15)) * 16)) = pk; }
    }
    if (tt + tt_step < 128) LRU_XLOAD(tt + tt_step);
    __syncthreads();
    float hreg[16];
    int tl = tid; asm volatile("" : "+v"(tl));
    const int q = tl & 15, g = (tl >> 4) & 3, w = tl >> 6, chl = 16 * w + 4 * g;
    const int ch = 16 * w + q, sub = g;
#pragma unroll
    for (int dir = 0; dir < 2; ++dir) {
        LAS float* TAd = dir ? TH : TA;
        if (VAR != 3) {
            const f32x4 ba = *(const LAS f32x4*)(CW + 640 + (dir * 3 + 0) * 128 + chl), bx = *(const LAS f32x4*)(CW + 640 + (dir * 3 + 1) * 128 + chl), sp = *(const LAS f32x4*)(CW + 640 + (dir * 3 + 2) * 128 + chl);
#pragma unroll
            for (int tk = 0; tk < 4; ++tk) { const int tok = 16 * tk + q;
                f32x4 ar = (f32x4){0.f, 0.f, 0.f, 0.f}, ai = (f32x4){0.f, 0.f, 0.f, 0.f};
#pragma unroll
                for (int s = 0; s < 4; ++s) {
                    const bf16x8 xb = *(const LAS bf16x8*)(xcb + tok * 256 + (((4 * s + g) ^ q) * 16));
                    ar = mfma16(fa[dir][s], xb, ar); ai = mfma16(fx[dir][s], xb, ai); }
                const u32x2 xr2 = *(const LAS u32x2*)(xcb + tok * 256 + ((((chl >> 3)) ^ q) * 16) + (chl & 7) * 2);
                const float xc0 = bflo(xr2.x), xc1 = bfhi(xr2.x), xc2 = bflo(xr2.y), xc3 = bfhi(xr2.y);
                f32x4 av, bv;
#pragma unroll
                for (int j = 0; j < 4; ++j) { if (VAR == 1) { av[j] = ar[j] + ba[j] + sp[j]; bv[j] = ai[j] + bx[j] + (j == 0 ? xc0 : (j == 1 ? xc1 : (j == 2 ? xc2 : xc3))); continue; }
                    const float r = fsigmoid(ar[j] + ba[j]), ii = fsigmoid(ai[j] + bx[j]);
                    const float la = -8.0f * r * sp[j]; const float aa = fexp2(la * LOG2E); av[j] = aa;
                    const float x2 = 2.0f * la;
                    const float poly = x2 * (1.f + x2 * (0.5f + x2 * ((1.f / 6.f) + x2 * ((1.f / 24.f) + x2 * (1.f / 120.f)))));
                    const float om = (x2 > -0.25f) ? -poly : (1.f - aa * aa);
                    const float xcj = j == 0 ? xc0 : (j == 1 ? xc1 : (j == 2 ? xc2 : xc3));
                    bv[j] = __builtin_amdgcn_sqrtf(om) * ii * xcj; }
                *(LAS f32x4*)(TAd + tok * 132 + chl) = av; *(LAS f32x4*)(TB + tok * 132 + chl) = bv; }
        }
        asm volatile("s_waitcnt lgkmcnt(0)" ::: "memory");
        if (VAR != 2 && VAR != 3) {
            float h = 0.f, P = 1.f;
#pragma unroll
            for (int i = 0; i < 16; ++i) { const int t = 16 * sub + (dir ? 15 - i : i);
                const float av = TAd[t * 132 + ch], bv = TB[t * 132 + ch]; h = av * h + bv; P *= av; TB[t * 132 + ch] = h; TAd[t * 132 + ch] = P; }
            AGS[sub * 128 + ch] = (f32x2){P, h};
        }
        asm volatile("s_waitcnt lgkmcnt(0)" ::: "memory");
        if (VAR == 2 || VAR == 3) {
#pragma unroll
            for (int i = 0; i < 16; ++i) hreg[i] = 0.f;
        } else {
            float hc = 0.f, Pp = 1.f, At = 1.f, Ht = 0.f;
#pragma unroll
            for (int s = 0; s < 4; ++s) { const int s2 = dir ? 3 - s : s; const f32x2 e = AGS[s2 * 128 + ch];
                const bool before = dir ? (s2 > sub) : (s2 < sub);
                if (before) { hc = e.x * hc + e.y; Pp *= e.x; }
                Ht = e.x * Ht + e.y; At *= e.x; }
#pragma unroll
            for (int i = 0; i < 16; ++i) { const int t = 16 * sub + i;
                const float Pl = TAd[t * 132 + ch], hl = TB[t * 132 + ch];
                const float hfull = hl + Pl * hc;
                if (dir == 0) hreg[i] = hfull; else hreg[i] += hfull;
                TAd[t * 132 + ch] = Pl * Pp; }
            if (sub == 0) agg1[(size_t)(dir * 1024 + n * 128 + ch) * 128 + tt] = (f32x2){At, Ht};
        }
        asm volatile("s_waitcnt lgkmcnt(0)" ::: "memory");
    }
#pragma unroll
    for (int i = 0; i < 16; ++i) TB[(16 * sub + i) * 132 + ch] = hreg[i];
    __syncthreads();
    {
        float* hs = (float*)(ws + (VAR ? WS_U : WS_HS));
#pragma unroll
        for (int i = 0; i < 4; ++i) { const int e = tid + 512 * i, t = e >> 5, c4 = e & 31;
            *(f32x4*)(hs + (size_t)(t0 + t) * 1024 + n * 128 + 4 * c4) = *(const LAS f32x4*)(TB + t * 132 + 4 * c4);
            const f32x4 p0 = *(const LAS f32x4*)(TA + t * 132 + 4 * c4), p1 = *(const LAS f32x4*)(TH + t * 132 + 4 * c4);
            u32x2 o0, o1; o0.x = pk2(p0[0], p0[1]); o0.y = pk2(p0[2], p0[3]); o1.x = pk2(p1[0], p1[1]); o1.y = pk2(p1[2], p1[3]);
            *(u32x2*)(Pout + (size_t)(t0 + t) * 1024 + n * 128 + 4 * c4) = o0;
            *(u32x2*)(Pout + (size_t)SEQ * 1024 + (size_t)(t0 + t) * 1024 + n * 128 + 4 * c4) = o1; }
    }
    }
#undef LRU_XLOAD
}

__device__ __forceinline__ void phase2(const Args& a, LAS unsigned char* lds, int p2mask) {
    unsigned char* ws = a.ws;
    bf16_t* proj = (bf16_t*)(ws + WS_PROJ); const bf16_t* vt = (const bf16_t*)(ws + WS_VT);
    const bf16_t* mk = (const bf16_t*)(ws + WS_MK); const bf16_t* mvt = (const bf16_t*)(ws + WS_MVT);
    bf16_t* yatt = (bf16_t*)(ws + WS_YATT); bf16_t* ymem = (bf16_t*)(ws + WS_YMEM);
    if (p2mask & 1)
    for (int u = blockIdx.x; u < 256; u += gridDim.x) {
        const int qblk = u >> 2, hm = u & 3;
        attn_unit<256, false, false>(lds, proj + (size_t)(qblk * 128) * INW + C_QM + hm * 256, INW, ymem + (size_t)(qblk * 128) * 1024 + hm * 256, 1024, mk + hm * 256, 1024, mvt + (size_t)(hm * 256) * 256, 256, 0, 2, -100, -1e30f, 0.f);
    }
    if (p2mask & 2) windowed_stream(lds, a);
    if (p2mask & 4)
    { const int G = gridDim.x; const bool al = (G & 7) == 0; const int nrep = al ? 1 : 8;
#pragma unroll 1
      for (int rep = 0; rep < nrep; ++rep) lru_phase<0>(lds, a, al ? (int)(blockIdx.x & 7) : rep, al ? (int)(blockIdx.x >> 3) : (int)blockIdx.x, al ? (G >> 3) : G); }
}

__device__ __forceinline__ void phase3(const Args& a, LAS unsigned char* lds) {
    unsigned char* ws = a.ws;
    const f32x2* agg1 = (const f32x2*)(ws + WS_AGG1); f32x2* agg2 = (f32x2*)(ws + WS_AGG2);
    for (int e = blockIdx.x * 512 + threadIdx.x; e < 2 * 1024 * 16; e += gridDim.x * 512) {
        const int sc = e & 15, dc = e >> 4, dir = dc >> 10;
        const f32x4* p = (const f32x4*)(agg1 + (size_t)dc * 128 + sc * 8);
        f32x4 v[4];
#pragma unroll
        for (int i = 0; i < 4; ++i) v[i] = p[i];
        float A = 1.f, H = 0.f;
        if (dir == 0) {
#pragma unroll
            for (int i = 0; i < 4; ++i) { H = v[i][0] * H + v[i][1]; A *= v[i][0]; H = v[i][2] * H + v[i][3]; A *= v[i][2]; }
        } else {
#pragma unroll
            for (int i = 3; i >= 0; --i) { H = v[i][2] * H + v[i][3]; A *= v[i][2]; H = v[i][0] * H + v[i][1]; A *= v[i][0]; }
        }
        agg2[(size_t)dc * 16 + sc] = (f32x2){A, H};
    }
}

__device__ __forceinline__ float silu_(float z) { return z * __builtin_amdgcn_rcpf(1.f + __builtin_amdgcn_exp2f(-z * 1.4426950408889634f)); }
__device__ __forceinline__ void phase4(const Args& a, LAS unsigned char* lds) {
    unsigned char* ws = a.ws;
    const f32x2* agg1 = (const f32x2*)(ws + WS_AGG1); const f32x2* agg2 = (const f32x2*)(ws + WS_AGG2);
    const bf16_t* proj = (const bf16_t*)(ws + WS_PROJ); bf16_t* Y = (bf16_t*)(ws + WS_Y);
    const bf16_t* yatt = (const bf16_t*)(ws + WS_YATT); const bf16_t* ymem = (const bf16_t*)(ws + WS_YMEM);
    const float* hs = (const float*)(ws + WS_HS); const bf16_t* Pf = (const bf16_t*)(ws + WS_PP); const bf16_t* Pb = Pf + (size_t)SEQ * 1024;
    LAS float* car = (LAS float*)lds;
    LAS float* gl = (LAS float*)(lds + 8192);
    int tid = threadIdx.x; asm volatile("" : "+v"(tid)); const int lane = tid & 63, w = tid >> 6;
    __syncthreads();
    for (int i = tid; i < 1024; i += 512) { *(LAS f32x4*)(gl + 4 * i) = (i < 512) ? ((const f32x4*)a.in[14])[i] : (i < 768 ? ((const f32x4*)a.in[15])[i - 512] : ((const f32x4*)a.in[16])[i - 768]); }
    for (int u = blockIdx.x; u < 256; u += gridDim.x) {
        const int tile = u >> 1, sc = tile >> 3, cj = tile & 7;
        __syncthreads();
#pragma unroll 1
        for (int half = 0; half < 2; ++half) {
            const int c = tid + 512 * half;
            float hf = 0.f, hb = 0.f;
            { const f32x4* p2 = (const f32x4*)(agg2 + (size_t)c * 16); const f32x4* p1 = (const f32x4*)(agg1 + (size_t)c * 128 + sc * 8);
              f32x4 e2[8], e1[4];
#pragma unroll
              for (int i = 0; i < 8; ++i) e2[i] = p2[i];
#pragma unroll
              for (int i = 0; i < 4; ++i) e1[i] = p1[i];
#pragma unroll
              for (int i = 0; i < 8; ++i) { if (2 * i < sc) hf = e2[i][0] * hf + e2[i][1]; if (2 * i + 1 < sc) hf = e2[i][2] * hf + e2[i][3]; }
#pragma unroll
              for (int i = 0; i < 4; ++i) { if (2 * i < cj) hf = e1[i][0] * hf + e1[i][1]; if (2 * i + 1 < cj) hf = e1[i][2] * hf + e1[i][3]; } }
            { const f32x4* p2 = (const f32x4*)(agg2 + (size_t)(1024 + c) * 16); const f32x4* p1 = (const f32x4*)(agg1 + (size_t)(1024 + c) * 128 + sc * 8);
              f32x4 e2[8], e1[4];
#pragma unroll
              for (int i = 0; i < 8; ++i) e2[i] = p2[i];
#pragma unroll
              for (int i = 0; i < 4; ++i) e1[i] = p1[i];
#pragma unroll
              for (int i = 7; i >= 0; --i) { if (2 * i + 1 > sc) hb = e2[i][2] * hb + e2[i][3]; if (2 * i > sc) hb = e2[i][0] * hb + e2[i][1]; }
#pragma unroll
              for (int i = 3; i >= 0; --i) { if (2 * i + 1 > cj) hb = e1[i][2] * hb + e1[i][3]; if (2 * i > cj) hb = e1[i][0] * hb + e1[i][1]; } }
            car[c] = hf; car[1024 + c] = hb;
        }
        __syncthreads();
        f32x4 cf[4], cb[4];
#pragma unroll
        for (int k = 0; k < 4; ++k) { cf[k] = *(const LAS f32x4*)(car + 4 * lane + 256 * k); cb[k] = *(const LAS f32x4*)(car + 1024 + 4 * lane + 256 * k); }
#pragma unroll 1
        for (int tk = 0; tk < 4; ++tk) {
            const unsigned t = (unsigned)(u * 32 + 4 * w + tk);
            const char* hsb = (const char*)hs; const char* pfb = (const char*)Pf; const char* pbb = (const char*)Pb;
            const char* yab = (const char*)yatt; const char* ymb = (const char*)ymem; const char* prb = (const char*)proj; char* yb = (char*)Y;
            const unsigned o_h = t * 4096u + 16u * lane, o_p = t * 2048u + 8u * lane, o_m = t * 2048u + 16u * lane;
            const unsigned o_pr = t * (unsigned)(INW * 2), o_y = t * 8192u;
            f32x4 h4[4]; u32x2 pf[4], pb[4], zl[4]; u32x4 va[4], vm[2], za[4], zm[2];
#pragma unroll
            for (int k = 0; k < 4; ++k) { h4[k] = __builtin_nontemporal_load((const f32x4*)(hsb + o_h + 1024u * k)); pf[k] = __builtin_nontemporal_load((const u32x2*)(pfb + o_p + 512u * k)); pb[k] = __builtin_nontemporal_load((const u32x2*)(pbb + o_p + 512u * k)); va[k] = __builtin_nontemporal_load((const u32x4*)(yab + o_h + 1024u * k)); }
#pragma unroll
            for (int k = 0; k < 2; ++k) vm[k] = __builtin_nontemporal_load((const u32x4*)(ymb + o_m + 1024u * k));
#pragma unroll
            for (int k = 0; k < 4; ++k) { zl[k] = __builtin_nontemporal_load((const u32x2*)(prb + o_pr + (unsigned)((C_ZL + 4 * lane + 256 * k) * 2))); za[k] = __builtin_nontemporal_load((const u32x4*)(prb + o_pr + (unsigned)((C_ZA + 8 * lane + 512 * k) * 2))); }
#pragma unroll
            for (int k = 0; k < 2; ++k) zm[k] = __builtin_nontemporal_load((const u32x4*)(prb + o_pr + (unsigned)((C_ZM + 8 * lane + 512 * k) * 2)));
            __builtin_amdgcn_sched_barrier(0);
            f32x4 v[4]; float ssl = 0.f, ssa = 0.f, ssm = 0.f;
#pragma unroll
            for (int k = 0; k < 4; ++k) {
                v[k][0] = h4[k][0] + bflo(pf[k].x) * cf[k][0] + bflo(pb[k].x) * cb[k][0]; v[k][1] = h4[k][1] + bfhi(pf[k].x) * cf[k][1] + bfhi(pb[k].x) * cb[k][1];
                v[k][2] = h4[k][2] + bflo(pf[k].y) * cf[k][2] + bflo(pb[k].y) * cb[k][2]; v[k][3] = h4[k][3] + bfhi(pf[k].y) * cf[k][3] + bfhi(pb[k].y) * cb[k][3];
                ssl += (v[k][0] * v[k][0] + v[k][1] * v[k][1]) + (v[k][2] * v[k][2] + v[k][3] * v[k][3]);
                { const float f0 = bflo(va[k].x), f1 = bfhi(va[k].x), f2 = bflo(va[k].y), f3 = bfhi(va[k].y), f4 = bflo(va[k].z), f5 = bfhi(va[k].z), f6 = bflo(va[k].w), f7 = bfhi(va[k].w);
                  ssa += ((f0 * f0 + f1 * f1) + (f2 * f2 + f3 * f3)) + ((f4 * f4 + f5 * f5) + (f6 * f6 + f7 * f7)); } }
#pragma unroll
            for (int k = 0; k < 2; ++k) { const float f0 = bflo(vm[k].x), f1 = bfhi(vm[k].x), f2 = bflo(vm[k].y), f3 = bfhi(vm[k].y), f4 = bflo(vm[k].z), f5 = bfhi(vm[k].z), f6 = bflo(vm[k].w), f7 = bfhi(vm[k].w);
                ssm += ((f0 * f0 + f1 * f1) + (f2 * f2 + f3 * f3)) + ((f4 * f4 + f5 * f5) + (f6 * f6 + f7 * f7)); }
#pragma unroll
            for (int o = 1; o < 64; o <<= 1) { ssl += __shfl_xor(ssl, o); ssa += __shfl_xor(ssa, o); ssm += __shfl_xor(ssm, o); }
            const float rsl = 1.f / sqrtf(ssl * (1.f / 1024.f) + EPSN), rsa = 1.f / sqrtf(ssa * (1.f / 2048.f) + EPSN), rsm = 1.f / sqrtf(ssm * (1.f / 1024.f) + EPSN);
            __builtin_amdgcn_sched_barrier(0);
#pragma unroll
            for (int k = 0; k < 4; ++k) { const int c = 4 * lane + 256 * k; const f32x4 g4 = *(const LAS f32x4*)(gl + 2048 + c); const u32x2 z = zl[k];
                u32x2 o; o.x = pk2(v[k][0] * rsl * g4[0] * silu_(bflo(z.x)), v[k][1] * rsl * g4[1] * silu_(bfhi(z.x))); o.y = pk2(v[k][2] * rsl * g4[2] * silu_(bflo(z.y)), v[k][3] * rsl * g4[3] * silu_(bfhi(z.y)));
                *(u32x2*)(yb + o_y + (unsigned)((2048 + c) * 2)) = o; }
            __builtin_amdgcn_sched_barrier(0);
#pragma unroll
            for (int k = 0; k < 4; ++k) { const int c = 8 * lane + 512 * k; const f32x4 g0 = *(const LAS f32x4*)(gl + c), g1 = *(const LAS f32x4*)(gl + c + 4); const u32x4 z = za[k];
                u32x4 o; o.x = pk2(bflo(va[k].x) * rsa * g0[0] * silu_(bflo(z.x)), bfhi(va[k].x) * rsa * g0[1] * silu_(bfhi(z.x)));
                o.y = pk2(bflo(va[k].y) * rsa * g0[2] * silu_(bflo(z.y)), bfhi(va[k].y) * rsa * g0[3] * silu_(bfhi(z.y)));
                o.z = pk2(bflo(va[k].z) * rsa * g1[0] * silu_(bflo(z.z)), bfhi(va[k].z) * rsa * g1[1] * silu_(bfhi(z.z)));
                o.w = pk2(bflo(va[k].w) * rsa * g1[2] * silu_(bflo(z.w)), bfhi(va[k].w) * rsa * g1[3] * silu_(bfhi(z.w)));
                *(u32x4*)(yb + o_y + (unsigned)(c * 2)) = o; }
            __builtin_amdgcn_sched_barrier(0);
#pragma unroll
            for (int k = 0; k < 2; ++k) { const int c = 8 * lane + 512 * k; const f32x4 g0 = *(const LAS f32x4*)(gl + 3072 + c), g1 = *(const LAS f32x4*)(gl + 3072 + c + 4); const u32x4 z = zm[k];
                u32x4 o; o.x = pk2(bflo(vm[k].x) * rsm * g0[0] * silu_(bflo(z.x)), bfhi(vm[k].x) * rsm * g0[1] * silu_(bfhi(z.x)));
                o.y = pk2(bflo(vm[k].y) * rsm * g0[2] * silu_(bflo(z.y)), bfhi(vm[k].y) * rsm * g0[3] * silu_(bfhi(z.y)));
                o.z = pk2(bflo(vm[k].z) * rsm * g1[0] * silu_(bflo(z.z)), bfhi(vm[k].z) * rsm * g1[1] * silu_(bfhi(z.z)));
                o.w = pk2(bflo(vm[k].w) * rsm * g1[2] * silu_(bflo(z.w)), bfhi(vm[k].w) * rsm * g1[3] * silu_(bfhi(z.w)));
                *(u32x4*)(yb + o_y + (unsigned)((3072 + c) * 2)) = o; }
        }
    }
}

#define XB_TMO      128
#define XB_XCNT(j)  (256  + 64 * (j))
#define XB_XSUB(j)  (1280 + 64 * (j))
#define XB_XGEN(j)  (2304 + 64 * (j))
#define XB_TOP      3328
#define XB_TOPGEN   3392
#define XCD_BAR_WORDS 3456
#define XB_SPIN_CAP (1u << 18)

__device__ __forceinline__ unsigned xb_ld(unsigned* p)              { return __hip_atomic_load(p, __ATOMIC_RELAXED, __HIP_MEMORY_SCOPE_AGENT); }
__device__ __forceinline__ unsigned xb_add(unsigned* p, unsigned v) { return __hip_atomic_fetch_add(p, v, __ATOMIC_RELAXED, __HIP_MEMORY_SCOPE_AGENT); }
__device__ __forceinline__ unsigned xb_xcc_id() { return (unsigned)__builtin_amdgcn_s_getreg((3 << 11) | 20) & 0xFu; }
#define XB_SPIN(cond, bar) do { unsigned _sp = 0; while (cond) { __builtin_amdgcn_s_sleep(1); \
    if ((++_sp & 255u) == 0u) { if (xb_ld(&(bar)[XB_TMO])) break; if (_sp > XB_SPIN_CAP) { atomicAdd(&(bar)[XB_TMO], 1u); break; } } } } while (0)

struct XcdBarrier {
    unsigned* bar; unsigned x;
    volatile LAS unsigned* st;
};

__device__ __forceinline__ XcdBarrier xcd_barrier_post(unsigned* bar, volatile LAS unsigned* st) {
    XcdBarrier b; b.bar = bar; b.x = xb_xcc_id(); b.st = st;
    if (threadIdx.x == 0) (void)xb_add(&bar[XB_XCNT(b.x)], 1u);
    return b;
}
__device__ __forceinline__ void xcd_barrier_complete(unsigned* bar, unsigned x, unsigned& nloc, unsigned& nx) {
    const unsigned G = gridDim.x * gridDim.y * gridDim.z;
    unsigned sum, cnt, mine, sp = 0u;
    for (;;) {
        sum = 0u; cnt = 0u; mine = 0u;
#pragma unroll
        for (unsigned j = 0; j < 16; ++j) { const unsigned c = xb_ld(&bar[XB_XCNT(j)]); sum += c; cnt += (c > 0u) ? 1u : 0u; mine = (j == x) ? c : mine; }
        if (sum == G) break;
        __builtin_amdgcn_s_sleep(1);
        if ((++sp & 255u) == 0u) { if (xb_ld(&bar[XB_TMO])) break; if (sp > XB_SPIN_CAP) { atomicAdd(&bar[XB_TMO], 1u); break; } }
    }
    nloc = mine > 0u ? mine : 1u; nx = cnt > 0u ? cnt : 1u;
}

__device__ __forceinline__ void xcd_barrier(const XcdBarrier& b) {
    asm volatile("s_waitcnt vmcnt(0)" ::: "memory");
    __syncthreads();
    if (threadIdx.x == 0) {
        unsigned* bar = b.bar;
        __builtin_amdgcn_s_waitcnt(0);
        unsigned nloc = b.st[0], nx = b.st[1];
        if (nloc == 0u) { xcd_barrier_complete(bar, b.x, nloc, nx); b.st[0] = nloc; b.st[1] = nx; }
        const unsigned old = xb_add(&bar[XB_XSUB(b.x)], 1u);
        const unsigned gen = old / nloc;
        if (old + 1u == (gen + 1u) * nloc) {
            __builtin_amdgcn_fence(__ATOMIC_RELEASE, "agent");
            asm volatile("s_waitcnt vmcnt(0)" ::: "memory");
            const unsigned og = xb_add(&bar[XB_TOP], 1u);
            const unsigned tg = og / nx;
            if (og + 1u == (tg + 1u) * nx) xb_add(&bar[XB_TOPGEN], 1u);
            else XB_SPIN(xb_ld(&bar[XB_TOPGEN]) == tg, bar);
            __builtin_amdgcn_fence(__ATOMIC_ACQUIRE, "agent");
            xb_add(&bar[XB_XGEN(b.x)], 1u);
            asm volatile("s_waitcnt vmcnt(0)" ::: "memory");
        } else {
            XB_SPIN(xb_ld(&bar[XB_XGEN(b.x)]) == gen, bar);
            __builtin_amdgcn_fence(__ATOMIC_ACQUIRE, "agent");
            asm volatile("s_waitcnt vmcnt(0)" ::: "memory");
        }
    }
    __syncthreads();
}

struct Sched2 {
    int c;
    __device__ bool next(int i, pg8::Unit& u) const {
        if (i >= 2) return false;
        const int x = c & 7, j = c >> 3;
        u.pm = i * 16 + 4 * (x >> 1) + (j & 3); u.pn = 8 * (x & 1) + (j >> 2); return true;
    }
    __device__ __forceinline__ void a_ready(const pg8::Unit&) const {}
    __device__ __forceinline__ void done(const pg8::Unit&) const {}
};
struct Epi3 {
    static constexpr bool PERM = true, AFTER_DRAIN = false, HOLD_LAST = true;
    float* out; bf16_t* t0; float* sspart; const float* x; const float* gain; XcdBarrier xbar;
    __device__ __forceinline__ void operator()(const f32x4 (&acc)[2][2][4][2], const pg8::Unit& u, int wr, int wc, int fr, int fq) const {
#pragma unroll
        for (int ai = 0; ai < 2; ++ai)
#pragma unroll
            for (int m = 0; m < 4; ++m) { const int row = u.pm * 256 + ai * 128 + wr * 64 + m * 16 + fr; float ss = 0.f;
#pragma unroll
                for (int bj = 0; bj < 2; ++bj) { const f32x4 v0 = acc[ai][bj][m][0], v1 = acc[ai][bj][m][1]; const int col = u.pn * 256 + bj * 128 + wc * 32 + 8 * fq;
                    u32x4 pk; pk.x = pk2(v0[0], v0[1]); pk.y = pk2(v0[2], v0[3]); pk.z = pk2(v1[0], v1[1]); pk.w = pk2(v1[2], v1[3]); *(u32x4*)(t0 + (size_t)row * 4096 + col) = pk;
                    ss += ((v0[0] * v0[0] + v0[1] * v0[1]) + (v0[2] * v0[2] + v0[3] * v0[3])) + ((v1[0] * v1[0] + v1[1] * v1[1]) + (v1[2] * v1[2] + v1[3] * v1[3])); }
                ss += __shfl_xor(ss, 16); ss += __shfl_xor(ss, 32);
                if (fq == 0) sspart[(size_t)row * 64 + u.pn * 4 + wc] = ss; }
    }
    __device__ __forceinline__ void fused(f32x4 (&acc)[2][2][4][2], const pg8::Unit& u, int wr, int wc, int fr, int fq, LAS unsigned char* lds, int wid, int lane) const {
#pragma unroll
        for (int ai = 0; ai < 2; ++ai)
#pragma unroll
            for (int m = 0; m < 4; ++m) { const int row = u.pm * 256 + ai * 128 + wr * 64 + m * 16 + fr; float ss = 0.f;
#pragma unroll
                for (int bj = 0; bj < 2; ++bj)
#pragma unroll
                    for (int n = 0; n < 2; ++n) { const f32x4 v = acc[ai][bj][m][n]; ss += (v[0] * v[0] + v[1] * v[1]) + (v[2] * v[2] + v[3] * v[3]); }
                ss += __shfl_xor(ss, 16); ss += __shfl_xor(ss, 32);
                if (fq == 0) sspart[(size_t)row * 64 + u.pn * 4 + wc] = ss; }
        f32x4 xv0[16], xv1[16];
        const size_t gob = (size_t)(u.pm * 256 + wid * 16) * 4096 + u.pn * 256 + 4 * lane;
#pragma unroll
        for (int r = 0; r < 16; ++r) xv0[r] = __builtin_nontemporal_load((const f32x4*)(x + gob + (size_t)r * 4096));
        xcd_barrier(xbar);
        constexpr int TP = 260;
        LAS float* T = (LAS float*)lds;
        LAS float* rsT = (LAS float*)(lds + 128 * TP * 4);
        { const int tid = wid * 64 + lane, row = tid >> 1, hf = tid & 1;
          const f32x4* p = (const f32x4*)(sspart + (size_t)(u.pm * 256 + row) * 64 + hf * 32);
          float s = 0.f;
#pragma unroll
          for (int i = 0; i < 8; ++i) { const f32x4 v = p[i]; s += (v[0] + v[1]) + (v[2] + v[3]); }
          s += __shfl_xor(s, 1);
          if (hf == 0) rsT[row] = 1.f / sqrtf(s * (1.f / 4096.f) + EPSN); }
        const f32x4 gv = *(const f32x4*)(gain + u.pn * 256 + 4 * lane);
#pragma unroll
        for (int ai = 0; ai < 2; ++ai) {
            __syncthreads();
#pragma unroll
            for (int m = 0; m < 4; ++m)
#pragma unroll
                for (int bj = 0; bj < 2; ++bj)
#pragma unroll
                    for (int n = 0; n < 2; ++n) *(LAS f32x4*)(T + (wr * 64 + m * 16 + fr) * TP + bj * 128 + wc * 32 + 8 * fq + 4 * n) = acc[ai][bj][m][n];
            if (ai == 0) {
#pragma unroll
                for (int r = 0; r < 16; ++r) xv1[r] = __builtin_nontemporal_load((const f32x4*)(x + gob + (size_t)(128 + r) * 4096));
            }
            __syncthreads();
#pragma unroll
            for (int r = 0; r < 16; ++r) { const int rl = wid * 16 + r;
                const f32x4 tv = *(const LAS f32x4*)(T + rl * TP + 4 * lane); const float rs = rsT[ai * 128 + rl];
                __builtin_nontemporal_store((ai ? xv1[r] : xv0[r]) + tv * rs * gv, (f32x4*)(out + gob + (size_t)(ai * 128 + r) * 4096)); }
        }
    }
};
__device__ __forceinline__ void phase6(const Args& a) {
    int tid = threadIdx.x; asm volatile("" : "+v"(tid)); const int lane = tid & 63, w = tid >> 6;
    const float* sspart = (const float*)(a.ws + WS_SS); const bf16_t* t0 = (const bf16_t*)(a.ws + WS_T0);
    f32x4 gv[16];
#pragma unroll
    for (int k = 0; k < 16; ++k) gv[k] = ((const f32x4*)a.in[18])[2 * lane + 128 * (k >> 1) + (k & 1)];
    for (int row = blockIdx.x * 8 + w; row < 4096; row += gridDim.x * 8) {
        const u32x4* t4 = (const u32x4*)(t0 + (size_t)row * 4096) + lane; f32x4* o4 = (f32x4*)(a.out + (size_t)row * 4096) + 2 * lane;
        const f32x4* x4 = (const f32x4*)(a.in[0] + (size_t)row * 4096) + 2 * lane;
        u32x4 tv[8]; f32x4 xa[8], xb[8];
        const float sp = sspart[(size_t)row * 64 + lane];
#pragma unroll
        for (int k = 0; k < 8; ++k) { tv[k] = __builtin_nontemporal_load(t4 + 64 * k); xa[k] = __builtin_nontemporal_load(x4 + 128 * k); xb[k] = __builtin_nontemporal_load(x4 + 128 * k + 1); }
        const float rs = 1.f / sqrtf(wave_sum(sp) * (1.f / 4096.f) + EPSN);
#pragma unroll
        for (int k = 0; k < 8; ++k) { const f32x4 ga = gv[2 * k], gb = gv[2 * k + 1];
            f32x4 oa, ob; oa[0] = xa[k][0] + bflo(tv[k].x) * rs * ga[0]; oa[1] = xa[k][1] + bfhi(tv[k].x) * rs * ga[1]; oa[2] = xa[k][2] + bflo(tv[k].y) * rs * ga[2]; oa[3] = xa[k][3] + bfhi(tv[k].y) * rs * ga[3];
            ob[0] = xb[k][0] + bflo(tv[k].z) * rs * gb[0]; ob[1] = xb[k][1] + bfhi(tv[k].z) * rs * gb[1]; ob[2] = xb[k][2] + bflo(tv[k].w) * rs * gb[2]; ob[3] = xb[k][3] + bfhi(tv[k].w) * rs * gb[3];
            __builtin_nontemporal_store(oa, o4 + 128 * k); __builtin_nontemporal_store(ob, o4 + 128 * k + 1); }
    }
}

__global__ void __launch_bounds__(512, 2) mega(Args a) {
    extern __shared__ __attribute__((aligned(16))) unsigned char lds_raw[];
    LAS unsigned char* lds = (LAS unsigned char*)lds_raw;
    cg::grid_group grid = cg::this_grid();
    unsigned char* ws = a.ws;
    volatile LAS unsigned* xst = (volatile LAS unsigned*)(lds + LDS_BYTES - 64);
    if (threadIdx.x < 16) xst[threadIdx.x] = 0u;
    __syncthreads();
    XcdBarrier xbar; xbar.bar = (unsigned*)(ws + WS_CTL); xbar.x = 0; xbar.st = nullptr;
    xbar = xcd_barrier_post((unsigned*)(ws + WS_CTL), xst);
    const int lo = a.ph_lo, hi = a.ph_hi;
#define IN(k) (lo <= (k) && (k) < hi)
#define SEAM(k) do { if (IN(k) && IN((k) + 1)) { if ((k) == 1) { __syncthreads(); grid.sync(); } else xcd_barrier(xbar); } } while (0)
    if (IN(0)) { if (PHMASK & 1) phase0(a, lds); if (REPMASK & 1) { __syncthreads(); phase0(a, lds); } }
    SEAM(0);
    if (IN(1)) { if (PHMASK & 2) {
        pg8::Gemm g{(const bf16_t*)(ws + WS_U), (const bf16_t*)(ws + WS_WT), SEQ + NMEM, INW + 2048, 4096};
        Sched1 S; S.init((int)gridDim.x, (int)blockIdx.x);
        Epi1 E{(bf16_t*)(ws + WS_PROJ), (bf16_t*)(ws + WS_VT), (bf16_t*)(ws + WS_MK), (bf16_t*)(ws + WS_MVT), (const float*)(ws + WS_ROPE)};
        pg8::gemm_phase<Epi1, Sched1, true, true>(lds, g, S, E);
        {
            const int G = (int)gridDim.x, nfull = 1160 % G, nidle = (nfull == 0) ? G : G - nfull;
            const int bi = (nfull == 0) ? (int)blockIdx.x : (int)blockIdx.x - nfull;
            if (bi >= 0) {
                int tid = threadIdx.x; asm volatile("" : "+v"(tid)); const int lane = tid & 63, w = tid >> 6;
                LAS float* scr = (LAS float*)(lds + w * 16384);
                p0_transpose_matrix(a.in[17], 4096, 4096, (bf16_t*)(ws + WS_WOUT), 0, scr, bi * 8 + w, nidle * 8, lane);
            }
        }
        if (REPMASK & 2) { __syncthreads(); pg8::gemm_phase<Epi1, Sched1, true, true>(lds, g, S, E); }
    } }
    SEAM(1);
    if (IN(2)) { if (PHMASK & 4) phase2(a, lds, P2MASK); }
    SEAM(2);
    if (IN(3)) { if (PHMASK & 8) phase3(a, lds); if (REPMASK & 8) { __syncthreads(); phase3(a, lds); } }
    SEAM(3);
    if (IN(4)) { if (PHMASK & 16) phase4(a, lds); if (REPMASK & 16) { __syncthreads(); phase4(a, lds); } }
    SEAM(4);
    if (IN(5)) { if (PHMASK & 32) {
        pg8::Gemm g{(const bf16_t*)(ws + WS_Y), (const bf16_t*)(ws + WS_WOUT), SEQ, 4096, 4096};
        Sched2 S; S.c = (int)blockIdx.x;
        Epi3 E{a.out, (bf16_t*)(ws + WS_T0), (float*)(ws + WS_SS), a.in[0], a.in[18], xbar};
        pg8::gemm_phase<Epi3, Sched2, true, true>(lds, g, S, E);
    } }
    if (IN(6)) { if (PHMASK & 64) phase6(a); }
#if N_LAUNCHES != 1
    if (lo >= 7 && lo < 10) phase2(a, lds, 1 << (lo - 7));
    if (lo == 11 || lo == 12) {
        pg8::Gemm g{(const bf16_t*)(ws + WS_U), (const bf16_t*)(ws + WS_WT), SEQ + NMEM, INW + 2048, 4096};
        Sched1 S; S.init((int)gridDim.x, (int)blockIdx.x); if (lo == 11) S.imax = 4; else S.ioff = 4;
        Epi1 E{(bf16_t*)(ws + WS_PROJ), (bf16_t*)(ws + WS_VT), (bf16_t*)(ws + WS_MK), (bf16_t*)(ws + WS_MVT), (const float*)(ws + WS_ROPE)};
        pg8::gemm_phase<Epi1, Sched1, true, true>(lds, g, S, E);
    }
    if (lo == 13) {
        pg8::Gemm g{(const bf16_t*)(ws + WS_U), (const bf16_t*)(ws + WS_WT), SEQ + NMEM, INW + 2048, 4096};
        Sched1 S; S.init((int)gridDim.x, (int)blockIdx.x); S.imax = 4;
        pg8::EpiBf16<0> E{(bf16_t*)(ws + WS_HS), INW, nullptr, 0, 0, 1.f};
        pg8::gemm_phase<pg8::EpiBf16<0>, Sched1, true, true>(lds, g, S, E);
    }
#ifdef LRUVAR
    if (lo == 10) lru_phase<LRUVAR>(lds, a, (int)(blockIdx.x & 7), (int)(blockIdx.x >> 3), (int)(gridDim.x >> 3));
#endif
#endif
#undef IN
#undef SEAM
}

extern "C" void kernel_launch(void* const* d_in, const int* in_sizes, int n_in, void* d_out, int out_size, void* d_ws, size_t ws_size, hipStream_t stream) {
    static int grid = 0;
    if (grid == 0) {
        if (n_in != 19 || ws_size < WS_END) { fprintf(stderr, "kernel_launch: unexpected n_in %d or ws_size %zu (need %zu)\n", n_in, ws_size, (size_t)WS_END); grid = -1; return; }
        int dev = 0, cus = 0, per_cu = 0;
        hipGetDevice(&dev); hipDeviceGetAttribute(&cus, hipDeviceAttributeMultiprocessorCount, dev);
        if (hipFuncSetAttribute((const void*)mega, hipFuncAttributeMaxDynamicSharedMemorySize, LDS_BYTES) != hipSuccess) { fprintf(stderr, "kernel_launch: hipFuncSetAttribute failed\n"); grid = -1; return; }
        if (hipOccupancyMaxActiveBlocksPerMultiprocessor(&per_cu, (const void*)mega, 512, LDS_BYTES) != hipSuccess || per_cu < 1) { fprintf(stderr, "kernel_launch: occupancy query says %d\n", per_cu); per_cu = 1; }
        (void)hipGetLastError();
        if (cus < 256) { fprintf(stderr, "kernel_launch: needs 256 CUs (one workgroup per CU), device has %d\n", cus); grid = -1; return; }
        grid = 256;
    }
    if (grid < 0) return;
    Args a{};
    for (int i = 0; i < 19; ++i) a.in[i] = (const float*)d_in[i];
    a.out = (float*)d_out; a.ws = (unsigned char*)d_ws;
#if N_LAUNCHES == 1
    (void)hipMemsetAsync((char*)d_ws + WS_CTL, 0, 65536, stream);
    a.ph_lo = 0; a.ph_hi = NPH;
    void* args[] = {&a};
    hipError_t e = hipLaunchCooperativeKernel((const void*)mega, dim3(grid), dim3(512), args, LDS_BYTES, stream);
    if (e != hipSuccess) fprintf(stderr, "cooperative launch failed: %s (grid %d)\n", hipGetErrorString(e), grid);
#else
#ifndef PHSEQ
#define PHSEQ 0,1,2,3,4,5,6
#endif
    { const int seq[] = {PHSEQ};
      for (unsigned i = 0; i < sizeof(seq) / sizeof(int); ++i) { a.ph_lo = seq[i]; a.ph_hi = seq[i] + 1; (void)hipMemsetAsync((char*)d_ws + WS_CTL, 0, 65536, stream); hipLaunchKernelGGL(mega, dim3(grid), dim3(512), LDS_BYTES, stream, a); } }
#endif
}
```

```cpp
#include <hip/hip_runtime.h>
#include <hip/hip_cooperative_groups.h>
#include <cstdio>
#include <cstdint>
namespace cg = cooperative_groups;
#define N_LAUNCHES 1
namespace pg8 {
#define PG8_LAS __attribute__((address_space(3)))
typedef unsigned short bf16_t;
typedef short bf16x8 __attribute__((ext_vector_type(8)));
typedef float f32x4 __attribute__((ext_vector_type(4)));
typedef unsigned u32x4 __attribute__((ext_vector_type(4)));
constexpr int BM = 256, BK = 64, HALF = 128, HTB = HALF * BK * 2  , STAGE_BYTES = 8 * HTB, NXCD = 8, WGM = 8;

__host__ __device__ __forceinline__ int lds_byte(int r, int c) { const int st = (r >> 4) * 2 + (c >> 5), rr = r & 15, cc = c & 31, ob = rr * 64 + cc * 2; return st * 1024 + (ob ^ (((ob >> 9) & 1) << 5)); }
__host__ __device__ __forceinline__ void stage_rc(int b, int& R, int& C) { const int st = b / 1024, sb = b % 1024, swz = sb ^ (((sb >> 9) & 1) << 5); R = (st >> 1) * 16 + swz / 64; C = (st & 1) * 32 + (swz % 64) / 2; }
__host__ __device__ __forceinline__ int perm32(int rho) { const int n = rho >> 4, i = rho & 15; return 8 * (i >> 2) + 4 * n + (i & 3); }

struct Unit { int pm, pn; };
struct Gemm { const bf16_t* A; const bf16_t* Bt; int M, N, K; };

struct StaticOrder {
    int nM, nN, nwg, G, c;
    __host__ __device__ void init(int M, int N, int G_, int c_) { nM = M / BM; nN = N / BM; nwg = nM * nN; G = G_; c = c_; }
    __host__ __device__ bool next(int i, Unit& u) const {
        const long L = (long)i * G + c; if (L >= nwg) return false;
        int wgid = (int)L; { const int q = nwg / NXCD, r = nwg % NXCD, xcd = wgid % NXCD, off = wgid / NXCD; wgid = (xcd < r ? xcd * (q + 1) : r * (q + 1) + (xcd - r) * q) + off; }
        const int nig = WGM * nN, gid = wgid / nig, fm = gid * WGM, gsz = (nM - fm) < WGM ? (nM - fm) : WGM;
        u.pm = fm + ((wgid % nig) % gsz); u.pn = (wgid % nig) / gsz; return true;
    }
    __device__ __forceinline__ void a_ready(const Unit&) const {}
    __device__ __forceinline__ void done(const Unit&) const {}
};

__device__ __forceinline__ unsigned cvt_pk_bf16(float lo, float hi) { unsigned r; asm volatile("v_cvt_pk_bf16_f32 %0, %1, %2" : "=v"(r) : "v"(lo), "v"(hi)); return r; }
typedef float f32x2 __attribute__((ext_vector_type(2)));
__device__ __forceinline__ f32x2 gelu_pk(f32x2 v) {
    const f32x2 av = __builtin_elementwise_abs(v), d = av * 0.2316418882f + 1.0f;
    f32x2 t; t.x = __builtin_amdgcn_rcpf(d.x); t.y = __builtin_amdgcn_rcpf(d.y);
    f32x2 q = t * 0.5307027145f + (-0.7265760135f); q = q * t + 0.7107068705f; q = q * t + (-0.142248368f); q = q * t + 0.127414796f; q = q * t;
    const f32x2 s = (v * v) * (-0.72134752044f);
    f32x2 e; e.x = __builtin_amdgcn_exp2f(s.x); e.y = __builtin_amdgcn_exp2f(s.y);
    const f32x2 m = v * (q * e), r = v - m;
    f32x2 o; o.x = v.x < 0.f ? m.x : r.x; o.y = v.y < 0.f ? m.y : r.y; return o;
}

template <int ACT  > struct EpiBf16 {
    static constexpr bool PERM = true, AFTER_DRAIN = false, HOLD_LAST = false; static_assert(ACT == 0 || ACT == 1, "EpiBf16: ACT is 0 (none) or 1 (gelu_pk)");
    bf16_t* O; int ldc; const float* bias; int split_cols; size_t split_stride; float scale0;
    __device__ __forceinline__ void operator()(const f32x4 (&acc)[2][2][4][2], const Unit& u, int wr, int wc, int fr, int fq) const {
        const int row0 = u.pm * BM + wr * 64 + fr; int colt = u.pn * BM; bf16_t* base = O;
        float sc = 1.f; if (split_cols) { const int t = colt / split_cols; base += (size_t)t * split_stride; colt -= t * split_cols; if (t == 0) sc = scale0; }
        const int col0 = colt + wc * 32 + 8 * fq, bcol0 = u.pn * BM + wc * 32 + 8 * fq;
        f32x4 bv[2][2];
#pragma unroll
        for (int bj = 0; bj < 2; ++bj)
#pragma unroll
            for (int n = 0; n < 2; ++n) bv[bj][n] = bias ? *(const f32x4*)(bias + bcol0 + bj * HALF + 4 * n) : (f32x4){0.f, 0.f, 0.f, 0.f};
#pragma unroll
        for (int ai = 0; ai < 2; ++ai)
#pragma unroll
            for (int m = 0; m < 4; ++m) { bf16_t* rowp = base + (size_t)(row0 + ai * HALF + m * 16) * ldc + col0;
#pragma unroll
                for (int bj = 0; bj < 2; ++bj) { f32x4 v0 = acc[ai][bj][m][0] + bv[bj][0], v1 = acc[ai][bj][m][1] + bv[bj][1];
                    if (ACT == 1) { f32x2 a = gelu_pk((f32x2){v0[0], v0[1]}), b = gelu_pk((f32x2){v0[2], v0[3]}), c = gelu_pk((f32x2){v1[0], v1[1]}), d = gelu_pk((f32x2){v1[2], v1[3]});
                        v0 = (f32x4){a.x, a.y, b.x, b.y}; v1 = (f32x4){c.x, c.y, d.x, d.y}; }
                    v0 = v0 * sc; v1 = v1 * sc; u32x4 w; w.x = cvt_pk_bf16(v0[0], v0[1]); w.y = cvt_pk_bf16(v0[2], v0[3]); w.z = cvt_pk_bf16(v1[0], v1[1]); w.w = cvt_pk_bf16(v1[2], v1[3]);
                    *(u32x4*)(rowp + bj * HALF) = w; } }
    }
};
template <class Epi, class Sched, bool ALIGN_EPI = false, bool SP2 = false>
__device__ __forceinline__ void gemm_phase(PG8_LAS unsigned char* lds, const Gemm g, const Sched& S, const Epi& E) {
    int tid_ = threadIdx.x; asm volatile("" : "+v"(tid_)); const int tid = tid_, wid = __builtin_amdgcn_readfirstlane(tid >> 6), lane = tid & 63, wr = wid >> 2, wc = wid & 3, fr = lane & 15, fq = lane >> 4;
    const int K = g.K, nt = K / BK;
    unsigned voffA[2], voffB[2];
#pragma unroll
    for (int i = 0; i < 2; ++i) { int R, C; stage_rc(tid * 16 + i * 8192, R, C); const int Rb = Epi::PERM ? ((R & ~31) + perm32(R & 31)) : R;
        voffA[i] = (unsigned)(R * K + C) * 2u; voffB[i] = (unsigned)(Rb * K + C) * 2u; }
    const size_t kstep = (size_t)(BK * 2);
    const size_t hstep = (size_t)HALF * K * 2;
    const size_t tstep = 2 * hstep;
    const unsigned ldsw = (unsigned)wid * 1024u;
    const int aoff = lds_byte(wr * 64 + fr, fq * 8), boff = lds_byte(wc * 32 + fr, fq * 8);
#define PG8_SA(b, h) (((b) * 2 + (h)) * HTB)
#define PG8_SB(b, h) ((4 + (b) * 2 + (h)) * HTB)
#define PG8_STAGE(bufoff, gbase, voff) do { _Pragma("unroll") for (int _i = 0; _i < 2; ++_i) \
        __builtin_amdgcn_global_load_lds((const unsigned*)((const char*)(gbase) + (voff)[_i]), (PG8_LAS unsigned*)(lds + (bufoff) + ldsw + _i * 8192), 16, 0, 0); } while (0)
#define PG8_LDA(dst, b, h) do { _Pragma("unroll") for (int m = 0; m < 4; ++m) _Pragma("unroll") for (int k = 0; k < 2; ++k) dst[m][k] = *(const PG8_LAS bf16x8*)(lds + PG8_SA(b, h) + aoff + m * 2048 + k * 1024); } while (0)
#define PG8_LDB(dst, b, h) do { _Pragma("unroll") for (int n = 0; n < 2; ++n) _Pragma("unroll") for (int k = 0; k < 2; ++k) dst[n][k] = *(const PG8_LAS bf16x8*)(lds + PG8_SB(b, h) + boff + n * 2048 + k * 1024); } while (0)
#define PG8_MMA(ai, bj, At, Bt) do { __builtin_amdgcn_s_setprio(1); _Pragma("unroll") for (int m = 0; m < 4; ++m) _Pragma("unroll") for (int n = 0; n < 2; ++n) _Pragma("unroll") for (int k = 0; k < 2; ++k) \
        acc[ai][bj][m][n] = __builtin_amdgcn_mfma_f32_16x16x32_bf16(Bt[n][k], At[m][k], acc[ai][bj][m][n], 0, 0, 0); __builtin_amdgcn_s_setprio(0); } while (0)
#define PG8_WAIT_V(n) asm volatile("s_waitcnt vmcnt(" #n ")" ::: "memory")
#define PG8_WAIT_L(n) asm volatile("s_waitcnt lgkmcnt(" #n ")" ::: "memory")
#define PG8_BAR __builtin_amdgcn_s_barrier()
#define PG8_SCHED __builtin_amdgcn_sched_barrier(0)
    Unit cur, nxt; int ui = 0;
    if (!S.next(0, cur)) return;
    f32x4 acc[2][2][4][2];
#pragma unroll
    for (int a = 0; a < 2; ++a)
#pragma unroll
        for (int b = 0; b < 2; ++b)
#pragma unroll
            for (int m = 0; m < 4; ++m)
#pragma unroll
                for (int n = 0; n < 2; ++n) acc[a][b][m][n] = (f32x4){0.f, 0.f, 0.f, 0.f};
    bf16x8 At[4][2], B0[2][2], B1[2][2];
    const char* cA = (const char*)g.A + (size_t)cur.pm * tstep; const char* cB = (const char*)g.Bt + (size_t)cur.pn * tstep;
    S.a_ready(cur);
    if constexpr (SP2) {
        PG8_STAGE(PG8_SB(0, 0), cB, voffB); PG8_STAGE(PG8_SB(0, 1), cB + hstep, voffB); PG8_STAGE(PG8_SA(0, 0), cA, voffA); PG8_STAGE(PG8_SA(0, 1), cA + hstep, voffA);
        if (wr == 1) PG8_BAR;
        PG8_WAIT_V(2); PG8_BAR;
        PG8_STAGE(PG8_SB(1, 0), cB + kstep, voffB); PG8_STAGE(PG8_SA(1, 0), cA + kstep, voffA); PG8_STAGE(PG8_SB(1, 1), cB + hstep + kstep, voffB);
        PG8_WAIT_V(6); PG8_BAR;
    } else {
        PG8_STAGE(PG8_SB(0, 0), cB, voffB); PG8_STAGE(PG8_SA(0, 0), cA, voffA); PG8_STAGE(PG8_SB(0, 1), cB + hstep, voffB); PG8_STAGE(PG8_SA(0, 1), cA + hstep, voffA);
        if (wr == 1) PG8_BAR;
        PG8_WAIT_V(4); PG8_BAR;
        PG8_STAGE(PG8_SB(1, 0), cB + kstep, voffB); PG8_STAGE(PG8_SA(1, 0), cA + kstep, voffA); PG8_STAGE(PG8_SB(1, 1), cB + hstep + kstep, voffB);
        PG8_WAIT_V(6); PG8_BAR;
    }
    for (;;) {
        const bool has_next = S.next(ui + 1, nxt);
        const char* nA = has_next ? (const char*)g.A + (size_t)nxt.pm * tstep : cA; const char* nB = has_next ? (const char*)g.Bt + (size_t)nxt.pn * tstep : cB;
        for (int t = 0; t < nt; t += 2) {
            const bool last = (t == nt - 2);
            const char* a1 = cA + (size_t)(t + 1) * kstep;
            const char* a2 = last ? nA : cA + (size_t)(t + 2) * kstep; const char* b2 = last ? nB : cB + (size_t)(t + 2) * kstep;
            const char* a3 = a2 + kstep; const char* b3 = b2 + kstep;
            if (last && has_next) S.a_ready(nxt);
            if constexpr (SP2) {
            PG8_LDB(B0, 0, 0); PG8_LDB(B1, 0, 1); PG8_SCHED; PG8_LDA(At, 0, 0); PG8_STAGE(PG8_SA(1, 1), a1 + hstep, voffA);
            PG8_WAIT_V(8); PG8_WAIT_L(0); PG8_BAR; PG8_MMA(0, 0, At, B0); PG8_MMA(0, 1, At, B1); PG8_BAR; PG8_SCHED;
            PG8_LDA(At, 0, 1); PG8_STAGE(PG8_SB(0, 0), b2, voffB); PG8_STAGE(PG8_SB(0, 1), b2 + hstep, voffB); PG8_STAGE(PG8_SA(0, 0), a2, voffA);
            PG8_WAIT_V(8); PG8_WAIT_L(0); PG8_BAR; PG8_MMA(1, 0, At, B0); PG8_MMA(1, 1, At, B1); PG8_BAR; PG8_SCHED;
            PG8_LDB(B0, 1, 0); PG8_LDB(B1, 1, 1); PG8_SCHED; PG8_LDA(At, 1, 0); PG8_STAGE(PG8_SA(0, 1), a2 + hstep, voffA);
            PG8_WAIT_V(8); PG8_WAIT_L(0); PG8_BAR; PG8_MMA(0, 0, At, B0); PG8_MMA(0, 1, At, B1); PG8_BAR; PG8_SCHED;
            PG8_LDA(At, 1, 1); PG8_STAGE(PG8_SB(1, 0), b3, voffB); PG8_STAGE(PG8_SB(1, 1), b3 + hstep, voffB); PG8_STAGE(PG8_SA(1, 0), a3, voffA);
            PG8_WAIT_V(8); PG8_WAIT_L(0); PG8_BAR; PG8_MMA(1, 0, At, B0); PG8_MMA(1, 1, At, B1); PG8_BAR; PG8_SCHED;
            } else {
            PG8_LDB(B0, 0, 0); PG8_SCHED; PG8_LDA(At, 0, 0); PG8_STAGE(PG8_SA(1, 1), a1 + hstep, voffA);
            PG8_WAIT_L(8); PG8_BAR; PG8_WAIT_L(0); PG8_MMA(0, 0, At, B0); PG8_BAR; PG8_SCHED;
            PG8_LDB(B1, 0, 1); PG8_STAGE(PG8_SB(0, 0), b2, voffB);
            PG8_BAR; PG8_WAIT_L(0); PG8_MMA(0, 1, At, B1); PG8_BAR;
            PG8_LDA(At, 0, 1); PG8_STAGE(PG8_SA(0, 0), a2, voffA);
            PG8_BAR; PG8_WAIT_L(0); PG8_MMA(1, 0, At, B0); PG8_BAR; PG8_SCHED;
            PG8_STAGE(PG8_SB(0, 1), b2 + hstep, voffB);
            PG8_WAIT_V(6); PG8_BAR; PG8_MMA(1, 1, At, B1); PG8_BAR;
            PG8_LDB(B0, 1, 0); PG8_SCHED; PG8_LDA(At, 1, 0); PG8_STAGE(PG8_SA(0, 1), a2 + hstep, voffA);
            PG8_WAIT_L(8); PG8_BAR; PG8_WAIT_L(0); PG8_MMA(0, 0, At, B0); PG8_BAR; PG8_SCHED;
            PG8_LDB(B1, 1, 1); PG8_STAGE(PG8_SB(1, 0), b3, voffB);
            PG8_BAR; PG8_WAIT_L(0); PG8_MMA(0, 1, At, B1); PG8_BAR;
            PG8_LDA(At, 1, 1); PG8_STAGE(PG8_SA(1, 0), a3, voffA);
            PG8_BAR; PG8_WAIT_L(0); PG8_MMA(1, 0, At, B0); PG8_BAR; PG8_SCHED;
            PG8_STAGE(PG8_SB(1, 1), b3 + hstep, voffB);
            PG8_WAIT_V(6); PG8_BAR; PG8_MMA(1, 1, At, B1); PG8_BAR;
            }
        }
        if constexpr (ALIGN_EPI) { if (wr == 0) PG8_BAR; }
        if constexpr (!Epi::AFTER_DRAIN) { if (!Epi::HOLD_LAST || has_next) { E(acc, cur, wr, wc, fr, fq); S.done(cur); } }
        if (!has_next) break;
#pragma unroll
        for (int a = 0; a < 2; ++a)
#pragma unroll
            for (int b = 0; b < 2; ++b)
#pragma unroll
                for (int m = 0; m < 4; ++m)
#pragma unroll
                    for (int n = 0; n < 2; ++n) acc[a][b][m][n] = (f32x4){0.f, 0.f, 0.f, 0.f};
        cur = nxt; cA = nA; cB = nB; ++ui;
        if constexpr (ALIGN_EPI) { if (wr == 1) PG8_BAR; }
    }
    PG8_WAIT_V(0);
    if constexpr (!ALIGN_EPI) { if (wr == 0) PG8_BAR; }
    PG8_BAR;
    if constexpr (Epi::AFTER_DRAIN || Epi::HOLD_LAST) { E.fused(acc, cur, wr, wc, fr, fq, lds, wid, lane); S.done(cur); }
#undef PG8_SA
#undef PG8_SB
#undef PG8_STAGE
#undef PG8_LDA
#undef PG8_LDB
#undef PG8_MMA
#undef PG8_WAIT_V
#undef PG8_WAIT_L
#undef PG8_BAR
#undef PG8_SCHED
}
}

#ifndef PHMASK
#define PHMASK 127
#endif
#ifndef REPMASK
#define REPMASK 0
#endif
#ifndef P2MASK
#define P2MASK 7
#endif
#ifndef N_LAUNCHES
#define N_LAUNCHES 1
#endif
using pg8::bf16_t; using pg8::bf16x8; using pg8::f32x4; using pg8::u32x4;
#define LAS __attribute__((address_space(3)))
typedef unsigned u32x2 __attribute__((ext_vector_type(2)));
typedef float f32x2 __attribute__((ext_vector_type(2)));

constexpr int SEQ = 8192, DMODEL = 4096, INW = 9216, NMEM = 256;
constexpr int C_QA = 0, C_KA = 2048, C_VA = 2560, C_XL = 3072, C_QM = 4096, C_ZA = 5120, C_ZL = 7168, C_ZM = 8192;
constexpr float EPSN = 1e-6f;
constexpr float LOG2E = 1.4426950408889634f;
constexpr float SC_ATT = 0.08838834764831845f * LOG2E;
constexpr float SC_MEM = 0.0625f * LOG2E;
constexpr int NPH = 7;
constexpr int LDS_BYTES = 147456;

constexpr size_t MiB = 1u << 20;
constexpr size_t WS_CTL = 0, WS_LRUW = 1 * MiB, WS_ROPE = 2 * MiB, WS_MK = 3 * MiB, WS_MVT = 3 * MiB + 512 * 1024, WS_SS = 4 * MiB,
                 WS_AGG1 = 6 * MiB, WS_AGG2 = 10 * MiB, WS_VT = 12 * MiB, WS_WOUT = 20 * MiB, WS_WT = 52 * MiB, WS_U = 140 * MiB,
                 WS_PROJ = 206 * MiB, WS_HS = 350 * MiB, WS_PP = 382 * MiB, WS_YATT = 414 * MiB, WS_YMEM = 446 * MiB, WS_T0 = 462 * MiB, WS_END = 494 * MiB;
constexpr size_t WS_Y = WS_U;

struct Args { const float* in[19]; float* out; unsigned char* ws; int ph_lo, ph_hi; };

__device__ __forceinline__ unsigned pk2(float lo, float hi) { return pg8::cvt_pk_bf16(lo, hi); }
__device__ __forceinline__ float bflo(unsigned u) { return __builtin_bit_cast(float, u << 16); }
__device__ __forceinline__ float bfhi(unsigned u) { return __builtin_bit_cast(float, u & 0xffff0000u); }
__device__ __forceinline__ float wave_sum(float v) {
#pragma unroll
    for (int o = 1; o < 64; o <<= 1) v += __shfl_xor(v, o);
    return v;
}
__device__ __forceinline__ float fexp2(float x) { return __builtin_amdgcn_exp2f(x); }
__device__ __forceinline__ float sigmoidf_(float x) { return 1.f / (1.f + __expf(-x)); }
__device__ __forceinline__ float fsigmoid(float x) { return __builtin_amdgcn_rcpf(1.f + __builtin_amdgcn_exp2f(-x * 1.4426950408889634f)); }
__device__ __forceinline__ f32x4 mfma16(bf16x8 a, bf16x8 b, f32x4 c) { return __builtin_amdgcn_mfma_f32_16x16x32_bf16(a, b, c, 0, 0, 0); }

__device__ __forceinline__ void p0_item_load(const float* W, int N, int item, int lane, float (&r)[32]) {
    const int nblk = N / 32, kb = item / nblk, nb = item % nblk, k0 = 64 * kb, n0 = 32 * nb;
#pragma unroll
    for (int i = 0; i < 32; ++i) { const int kk = 2 * i + (lane >> 5); r[i] = __builtin_nontemporal_load(W + (size_t)(k0 + kk) * N + n0 + (lane & 31)); }
}
__device__ __forceinline__ void p0_item_lds_write(LAS float* scr, int lane, const float (&r)[32]) {
#pragma unroll
    for (int i = 0; i < 32; ++i) { const int kk = 2 * i + (lane >> 5); scr[kk * 33 + (lane & 31)] = r[i]; }
}
__device__ __forceinline__ void p0_item_store(int K, int N, bf16_t* WT, int row_off, LAS float* scr, int item, int lane) {
    const int nblk = N / 32, kb = item / nblk, nb = item % nblk, k0 = 64 * kb, n0 = 32 * nb;
    asm volatile("s_waitcnt lgkmcnt(0)" ::: "memory");
    const int c = lane & 7;
#pragma unroll
    for (int j = 0; j < 4; ++j) { const int n = (lane >> 3) + 8 * j; const LAS float* s = scr + (8 * c) * 33 + n;
        u32x4 o; o.x = pk2(s[0 * 33], s[1 * 33]); o.y = pk2(s[2 * 33], s[3 * 33]); o.z = pk2(s[4 * 33], s[5 * 33]); o.w = pk2(s[6 * 33], s[7 * 33]);
        *(u32x4*)(WT + (size_t)(row_off + n0 + n) * K + k0 + 8 * c) = o; }
    asm volatile("s_waitcnt lgkmcnt(0)" ::: "memory");
}
__device__ __forceinline__ void p0_transpose_item(const float* W, int K, int N, bf16_t* WT, int row_off, LAS float* scr, int item, int lane) {
    float r[32]; p0_item_load(W, N, item, lane, r); p0_item_lds_write(scr, lane, r); p0_item_store(K, N, WT, row_off, scr, item, lane);
}
__device__ __forceinline__ void p0_transpose_matrix(const float* W, int K, int N, bf16_t* WT, int row_off, LAS float* scr, int first, int step, int lane) {
    const int nitems = (K / 64) * (N / 32);
    if (first >= nitems) return;
    float r[32]; p0_item_load(W, N, first, lane, r);
#pragma unroll 1
    for (int it = first; it < nitems; it += step) {
        p0_item_lds_write(scr, lane, r);
        if (it + step < nitems) p0_item_load(W, N, it + step, lane, r);
        p0_item_store(K, N, WT, row_off, scr, it, lane);
    }
}
__device__ __forceinline__ void rms_row_to_bf16(const float* xrow, const f32x4 (&gv)[16], bf16_t* orow, int lane) {
    const f32x4* xr = (const f32x4*)xrow + lane;
    f32x4 v[16]; float s = 0.f;
#pragma unroll
    for (int k = 0; k < 16; ++k) { v[k] = __builtin_nontemporal_load(xr + 64 * k); s += (v[k].x * v[k].x + v[k].y * v[k].y) + (v[k].z * v[k].z + v[k].w * v[k].w); }
    const float rs = 1.f / sqrtf(wave_sum(s) * (1.f / 4096.f) + EPSN);
    u32x2* o8 = (u32x2*)orow + lane;
#pragma unroll
    for (int k = 0; k < 16; ++k) { const f32x4 g4 = gv[k]; u32x2 o; o.x = pk2(v[k].x * rs * g4.x, v[k].y * rs * g4.y); o.y = pk2(v[k].z * rs * g4.z, v[k].w * rs * g4.w); o8[64 * k] = o; }
}

__device__ __forceinline__ void phase0(const Args& a, LAS unsigned char* lds) {
    int tid = threadIdx.x; asm volatile("" : "+v"(tid)); const int lane = tid & 63, w = tid >> 6, G = gridDim.x;
    const int gw = blockIdx.x * 8 + w, NGW = G * 8;
    unsigned char* ws = a.ws;
    LAS float* scr = (LAS float*)(lds + w * 16384);
    bf16_t* WT = (bf16_t*)(ws + WS_WT); bf16_t* WOUT = (bf16_t*)(ws + WS_WOUT); bf16_t* LRUW = (bf16_t*)(ws + WS_LRUW);
    constexpr int I_IN = 64 * (INW / 32), I_MKV = 64 * (2048 / 32), I_OUT = 64 * (4096 / 32), I_LRU = 32 * 8;
    p0_transpose_matrix(a.in[3], 4096, INW, WT, 0, scr, gw, NGW, lane);
    p0_transpose_matrix(a.in[13], 4096, 2048, WT, INW, scr, gw, NGW, lane);
    for (int r = gw; r < I_LRU; r += NGW) {
        const int mat = r >> 3, sub = r & 7, gate = mat >> 4, dn = mat & 15;
        const float* src = (gate ? a.in[9] : a.in[7]) + (size_t)dn * 16384;
        p0_transpose_item(src, 128, 128, LRUW + (size_t)mat * 16384, 0, scr, sub, lane);
    }
    bf16_t* U = (bf16_t*)(ws + WS_U);
    { f32x4 gv[16];
#pragma unroll
      for (int k = 0; k < 16; ++k) gv[k] = ((const f32x4*)a.in[2])[lane + 64 * k];
      for (int m = gw; m < SEQ; m += NGW) rms_row_to_bf16(a.in[0] + (size_t)m * 4096, gv, U + (size_t)m * 4096, lane);
#pragma unroll
      for (int k = 0; k < 16; ++k) gv[k] = ((const f32x4*)a.in[12])[lane + 64 * k];
      for (int m = gw; m < NMEM; m += NGW) rms_row_to_bf16(a.in[1] + (size_t)m * 4096, gv, U + (size_t)(SEQ + m) * 4096, lane); }
    f32x2* rope = (f32x2*)(ws + WS_ROPE);
    for (int e = blockIdx.x * 512 + tid; e < SEQ * 16; e += G * 512) {
        const int pos = e >> 4, i = e & 15;
        const float inv = powf(500000.0f, -(float)i * (1.0f / 16.0f));
        const float ang = (float)pos * inv;
        rope[e] = (f32x2){cosf(ang), sinf(ang)};
    }
}

struct Sched1 {
    pg8::StaticOrder so; int G, c, ioff, imax;
    __device__ void init(int G_, int c_) { so.init(SEQ, INW, G_, c_); G = G_; c = c_; ioff = 0; imax = 1 << 20; }
    __device__ bool next(int i0, pg8::Unit& u) const {
        if (i0 >= imax) return false;
        const int i = i0 + ioff;
        const long L = (long)i * G + c;
        if (L < 1152) return so.next(i, u);
        if (L < 1160) { u.pm = 32; u.pn = 36 + (int)(L - 1152); return true; }
        return false;
    }
    __device__ __forceinline__ void a_ready(const pg8::Unit&) const {}
    __device__ __forceinline__ void done(const pg8::Unit&) const {}
};
struct Epi1 {
    static constexpr bool PERM = true, AFTER_DRAIN = false, HOLD_LAST = false;
    bf16_t* proj; bf16_t* vt; bf16_t* mk; bf16_t* mvt; const float* rope;
    __device__ __forceinline__ void operator()(const f32x4 (&acc)[2][2][4][2], const pg8::Unit& u, int wr, int wc, int fr, int fq) const {
        const int rloc = wr * 64 + fr, cloc = wc * 32 + 8 * fq;
        if (u.pm == 32) {
            const int t = u.pn - 36;
            if (t < 4) {
#pragma unroll
                for (int ai = 0; ai < 2; ++ai)
#pragma unroll
                    for (int m = 0; m < 4; ++m) { const int row = rloc + ai * 128 + m * 16;
#pragma unroll
                        for (int bj = 0; bj < 2; ++bj) { const f32x4 v0 = acc[ai][bj][m][0], v1 = acc[ai][bj][m][1];
                            u32x4 wv; wv.x = pk2(v0[0], v0[1]); wv.y = pk2(v0[2], v0[3]); wv.z = pk2(v1[0], v1[1]); wv.w = pk2(v1[2], v1[3]);
                            *(u32x4*)(mk + (size_t)row * 1024 + t * 256 + bj * 128 + cloc) = wv; } asm volatile("" ::: "memory"); }
            } else {
#pragma unroll
                for (int ai = 0; ai < 2; ++ai)
#pragma unroll
                    for (int m = 0; m < 4; ++m) { const int row = rloc + ai * 128 + m * 16;
#pragma unroll
                        for (int bj = 0; bj < 2; ++bj)
#pragma unroll
                            for (int n = 0; n < 2; ++n)
#pragma unroll
                                for (int i = 0; i < 4; ++i) { const int col = (t - 4) * 256 + bj * 128 + cloc + 4 * n + i;
                                    mvt[(size_t)col * 256 + row] = (bf16_t)(pk2(acc[ai][bj][m][n][i], 0.f) & 0xffffu); } asm volatile("" ::: "memory"); }
            }
            return;
        }
        const int pn = u.pn, row0 = u.pm * 256 + rloc;
        if (pn == 10 || pn == 11) {
#pragma unroll
            for (int ai = 0; ai < 2; ++ai)
#pragma unroll
                for (int m = 0; m < 4; ++m) { const int row = row0 + ai * 128 + m * 16;
#pragma unroll
                    for (int bj = 0; bj < 2; ++bj)
#pragma unroll
                        for (int n = 0; n < 2; ++n)
#pragma unroll
                            for (int i = 0; i < 4; ++i) { const int col = (pn - 10) * 256 + bj * 128 + cloc + 4 * n + i;
                                vt[(size_t)col * SEQ + row] = (bf16_t)(pk2(acc[ai][bj][m][n][i], 0.f) & 0xffffu); } asm volatile("" ::: "memory"); }
            return;
        }
        float sc = 1.f; if (pn < 8) sc = SC_ATT; else if (pn >= 16 && pn < 20) sc = SC_MEM;
        const bool do_rope = (pn < 10) && (wc == 0);
        const float sgn = (fq < 2) ? -1.f : 1.f;
        f32x4 csA[2][2], cst[2][2];
        if (do_rope) {
#pragma unroll
            for (int n = 0; n < 2; ++n) { const int io = (8 * (fq & 1) + 4 * n) * 2;
                const float* ra = rope + (size_t)row0 * 32 + io; const float* rt = rope + 16 * 32 + io;
                csA[n][0] = *(const f32x4*)ra; csA[n][1] = *(const f32x4*)(ra + 4); cst[n][0] = *(const f32x4*)rt; cst[n][1] = *(const f32x4*)(rt + 4); }
        }
#pragma unroll
        for (int ai = 0; ai < 2; ++ai)
#pragma unroll
            for (int m = 0; m < 4; ++m) { const int row = row0 + ai * 128 + m * 16;
                f32x4 cs[2][2];
                if (do_rope) {
                    const int nrot = (ai == 0 && m == 3) ? 5 : 1;
#pragma unroll
                    for (int n = 0; n < 2; ++n)
#pragma unroll
                        for (int hh = 0; hh < 2; ++hh) { f32x4 cur = csA[n][hh]; cs[n][hh] = cur; const f32x4 t = cst[n][hh];
#pragma unroll
                            for (int rr = 0; rr < 5; ++rr) { if (rr < nrot) { f32x4 nx; nx[0] = cur[0] * t[0] - cur[1] * t[1]; nx[1] = cur[1] * t[0] + cur[0] * t[1]; nx[2] = cur[2] * t[2] - cur[3] * t[3]; nx[3] = cur[3] * t[2] + cur[2] * t[3]; cur = nx; } }
                            csA[n][hh] = cur; }
                }
#pragma unroll
                for (int bj = 0; bj < 2; ++bj) { f32x4 v[2]; v[0] = acc[ai][bj][m][0]; v[1] = acc[ai][bj][m][1];
                    if (do_rope) {
#pragma unroll
                        for (int n = 0; n < 2; ++n) { f32x4 p; p[0] = __shfl_xor(v[n][0], 32); p[1] = __shfl_xor(v[n][1], 32); p[2] = __shfl_xor(v[n][2], 32); p[3] = __shfl_xor(v[n][3], 32);
                            f32x4 r; r[0] = v[n][0] * cs[n][0][0] + sgn * p[0] * cs[n][0][1]; r[1] = v[n][1] * cs[n][0][2] + sgn * p[1] * cs[n][0][3];
                            r[2] = v[n][2] * cs[n][1][0] + sgn * p[2] * cs[n][1][1]; r[3] = v[n][3] * cs[n][1][2] + sgn * p[3] * cs[n][1][3]; v[n] = r; }
                    }
                    u32x4 wv; wv.x = pk2(v[0][0] * sc, v[0][1] * sc); wv.y = pk2(v[0][2] * sc, v[0][3] * sc); wv.z = pk2(v[1][0] * sc, v[1][1] * sc); wv.w = pk2(v[1][2] * sc, v[1][3] * sc);
                    __builtin_nontemporal_store(wv, (u32x4*)(proj + (size_t)row * INW + pn * 256 + bj * 128 + cloc)); } asm volatile("" ::: "memory"); }
    }
};

template <int DH, bool PF, bool DB>
__device__ __forceinline__ void attn_unit(LAS unsigned char* lds, const bf16_t* Qp, int ldq, bf16_t* Op, int ldo, const bf16_t* Kg, int ldk, const bf16_t* Vtg, int ldv,
                                          int cb_lo, int cb_hi, int cb_self, float m_init, float l_init) {
    constexpr int PR = DH / 8, KROW = DH * 2, KT = 128 * KROW, VROW = 288, NKI = (128 * PR) / 512, NVI = (DH * 16) / 512, NS = DH / 32, NDT = DH / 16;
    int tid = threadIdx.x; asm volatile("" : "+v"(tid)); const int lane = tid & 63, w = tid >> 6, q = lane & 15, g = lane >> 4;
    const int krow = 8 * (q >> 2) + (q & 3);
    bf16x8 qf[NS];
    { const unsigned qoff = (unsigned)(((16 * w + q) * ldq + 8 * g) * 2);
#pragma unroll
      for (int s = 0; s < NS; ++s) qf[s] = __builtin_nontemporal_load((const bf16x8*)((const char*)Qp + qoff + 64 * s)); }
    f32x4 o[NDT];
#pragma unroll
    for (int dt = 0; dt < NDT; ++dt) o[dt] = (f32x4){0.f, 0.f, 0.f, 0.f};
    float m_run = m_init, l_run = l_init;
    u32x4 kreg[NKI], vreg[NVI];
#define ATT_LOAD(cb) do { const int k0_ = (cb) * 128; \
        const char* kb_ = (const char*)Kg + (size_t)k0_ * ldk * 2; const char* vb_ = (const char*)Vtg + (size_t)k0_ * 2; \
        _Pragma("unroll") for (int it = 0; it < NKI; ++it) { const int e = tid + 512 * it; const int key = e / PR, pc = e % PR; \
            kreg[it] = *(const u32x4*)(kb_ + (unsigned)((key * ldk + pc * 8) * 2)); } \
        _Pragma("unroll") for (int it = 0; it < NVI; ++it) { const int e = tid + 512 * it; const int d = e >> 4, pc = e & 15; \
            vreg[it] = *(const u32x4*)(vb_ + (unsigned)((d * ldv + pc * 8) * 2)); } } while (0)
#define ATT_STORE() do { \
        _Pragma("unroll") for (int it = 0; it < NKI; ++it) { const int e = tid + 512 * it; const int key = e / PR, pc = e % PR; \
            *(LAS u32x4*)(lds + key * KROW + ((pc ^ ((((key >> 3) & 3) << 2) | (key & 3))) * 16)) = kreg[it]; } \
        _Pragma("unroll") for (int it = 0; it < NVI; ++it) { const int e = tid + 512 * it; const int d = e >> 4, pc = e & 15; \
            *(LAS u32x4*)(lds + KT + d * VROW + pc * 16) = vreg[it]; } } while (0)
    if (PF) ATT_LOAD(cb_lo);
    for (int cb = cb_lo; cb < cb_hi; ++cb) {
        if (!PF) ATT_LOAD(cb);
        __syncthreads();
        ATT_STORE();
        __syncthreads();
        if (PF) { if (cb + 1 < cb_hi) ATT_LOAD(cb + 1); }
        f32x4 s[8];
#pragma unroll
        for (int kt = 0; kt < 8; ++kt) s[kt] = (f32x4){0.f, 0.f, 0.f, 0.f};
        {
            bf16x8 ka[DB ? 2 : 1][8];
            if (DB) {
#pragma unroll
                for (int kt = 0; kt < 8; ++kt) ka[0][kt] = *(const LAS bf16x8*)(lds + (32 * (kt >> 1) + 4 * (kt & 1) + krow) * KROW + (((0 + g) ^ q) * 16));
            }
#pragma unroll
            for (int ss = 0; ss < NS; ++ss) {
                if (DB) { if (ss + 1 < NS) {
#pragma unroll
                    for (int kt = 0; kt < 8; ++kt) ka[(ss + 1) & 1][kt] = *(const LAS bf16x8*)(lds + (32 * (kt >> 1) + 4 * (kt & 1) + krow) * KROW + (((4 * (ss + 1) + g) ^ q) * 16)); }
                } else {
#pragma unroll
                    for (int kt = 0; kt < 8; ++kt) ka[0][kt] = *(const LAS bf16x8*)(lds + (32 * (kt >> 1) + 4 * (kt & 1) + krow) * KROW + (((4 * ss + g) ^ q) * 16));
                }
                __builtin_amdgcn_sched_barrier(0);
#pragma unroll
                for (int kt = 0; kt < 8; ++kt) s[kt] = mfma16(ka[DB ? (ss & 1) : 0][kt], qf[ss], s[kt]);
                __builtin_amdgcn_sched_barrier(0);
            }
        }
        if (cb != cb_self && cb_self >= 0) {
            const float sg = (cb < cb_self) ? 1.f : -1.f;
            const float dq = (float)(16 * w + q - 8 * g);
#pragma unroll
            for (int kt = 0; kt < 8; ++kt)
#pragma unroll
                for (int j = 0; j < 4; ++j) { const float v = sg * ((float)(32 * (kt >> 1) + 4 * (kt & 1) + j) - dq); s[kt][j] += fminf(v, 0.f) * 1e30f; }
        }
        float mx = s[0][0];
#pragma unroll
        for (int kt = 0; kt < 8; ++kt)
#pragma unroll
            for (int j = 0; j < 4; ++j) mx = fmaxf(mx, s[kt][j]);
        mx = fmaxf(mx, __shfl_xor(mx, 16)); mx = fmaxf(mx, __shfl_xor(mx, 32));
        const float m_new = fmaxf(m_run, mx), alpha = fexp2(m_run - m_new); m_run = m_new;
        float rs = 0.f;
#pragma unroll
        for (int kt = 0; kt < 8; ++kt)
#pragma unroll
            for (int j = 0; j < 4; ++j) { const float p = fexp2(s[kt][j] - m_new); s[kt][j] = p; rs += p; }
        rs += __shfl_xor(rs, 16); rs += __shfl_xor(rs, 32);
        l_run = l_run * alpha + rs;
        bf16x8 pb[4];
#pragma unroll
        for (int u = 0; u < 4; ++u) { u32x4 t; t.x = pk2(s[2 * u][0], s[2 * u][1]); t.y = pk2(s[2 * u][2], s[2 * u][3]); t.z = pk2(s[2 * u + 1][0], s[2 * u + 1][1]); t.w = pk2(s[2 * u + 1][2], s[2 * u + 1][3]);
            pb[u] = __builtin_bit_cast(bf16x8, t); }
#pragma unroll
        for (int dt = 0; dt < NDT; ++dt) o[dt] = o[dt] * alpha;
        {
            constexpr int NG = (NDT / 8) * 4;
            u32x4 va[DB ? 2 : 1][8];
#define ATT_VLOAD(buf, gi) do { const int u_ = (gi) & 3, d0_ = 8 * ((gi) >> 2); \
            _Pragma("unroll") for (int i = 0; i < 8; ++i) { va[buf][i] = *(const LAS u32x4*)(lds + KT + (16 * (d0_ + i) + q) * VROW + (32 * u_ + 8 * g) * 2); } } while (0)
            if (DB) ATT_VLOAD(0, 0);
#pragma unroll
            for (int gi = 0; gi < NG; ++gi) {
                if (DB) { if (gi + 1 < NG) ATT_VLOAD((gi + 1) & 1, gi + 1); } else ATT_VLOAD(0, gi);
                __builtin_amdgcn_sched_barrier(0);
#pragma unroll
                for (int i = 0; i < 8; ++i) o[8 * (gi >> 2) + i] = mfma16(__builtin_bit_cast(bf16x8, va[DB ? (gi & 1) : 0][i]), pb[gi & 3], o[8 * (gi >> 2) + i]);
                __builtin_amdgcn_sched_barrier(0);
            }
#undef ATT_VLOAD
        }
    }
#undef ATT_LOAD
#undef ATT_STORE
    const float inv = 1.f / l_run;
    const unsigned ooff = (unsigned)(((16 * w + q) * ldo + 4 * g) * 2);
#pragma unroll
    for (int dt = 0; dt < NDT; ++dt) { u32x2 pkv; pkv.x = pk2(o[dt][0] * inv, o[dt][1] * inv); pkv.y = pk2(o[dt][2] * inv, o[dt][3] * inv); *(u32x2*)((char*)Op + ooff + 32 * dt) = pkv; }
}

__device__ __forceinline__ void windowed_stream(LAS unsigned char* lds0, const Args& a) {
    constexpr int DH = 128, PR = 16, KROW = 256, KT = 128 * KROW, VROW = 288, BUFB = KT + DH * VROW, NKI = 4, NVI = 4, NS = 4, NDT = 8;
    static_assert(2 * BUFB <= LDS_BYTES - 64, "two K/V tile buffers must fit under the barrier words");
    int tid = threadIdx.x; asm volatile("" : "+v"(tid)); const int lane = tid & 63, w = tid >> 6, q = lane & 15, g = lane >> 4;
    const int krow = 8 * (q >> 2) + (q & 3);
    unsigned char* ws = a.ws;
    const bf16_t* proj = (const bf16_t*)(ws + WS_PROJ); const bf16_t* vt = (const bf16_t*)(ws + WS_VT); bf16_t* yatt = (bf16_t*)(ws + WS_YATT);
    const int G = (int)gridDim.x;
    if ((int)blockIdx.x >= 1024) return;
    unsigned koff[NKI], voff[NVI], klds[NKI], vlds[NVI];
#pragma unroll
    for (int it = 0; it < NKI; ++it) { const int e = tid + 512 * it, key = e / PR, pc = e % PR; koff[it] = (unsigned)((key * INW + pc * 8) * 2); klds[it] = (unsigned)(key * KROW + ((pc ^ ((((key >> 3) & 3) << 2) | (key & 3))) * 16)); }
#pragma unroll
    for (int it = 0; it < NVI; ++it) { const int e = tid + 512 * it, d = e >> 4, pc = e & 15; voff[it] = (unsigned)((d * SEQ + pc * 8) * 2); vlds[it] = (unsigned)(KT + d * VROW + pc * 16); }
    u32x4 kreg[NKI], vreg[NVI];
#define WS_LOAD(v_, cb_) do { const int kvh_ = ((v_) & 15) >> 2; \
        const char* kb_ = (const char*)proj + ((size_t)((cb_) * 128) * INW + C_KA + kvh_ * 128) * 2; const char* vb_ = (const char*)vt + ((size_t)(kvh_ * 128) * SEQ + (cb_) * 128) * 2; \
        _Pragma("unroll") for (int it = 0; it < NKI; ++it) kreg[it] = *(const u32x4*)(kb_ + koff[it]); \
        _Pragma("unroll") for (int it = 0; it < NVI; ++it) vreg[it] = *(const u32x4*)(vb_ + voff[it]); } while (0)
#define WS_STORE(ldsb_) do { \
        _Pragma("unroll") for (int it = 0; it < NKI; ++it) *(LAS u32x4*)((ldsb_) + klds[it]) = kreg[it]; \
        _Pragma("unroll") for (int it = 0; it < NVI; ++it) *(LAS u32x4*)((ldsb_) + vlds[it]) = vreg[it]; } while (0)
#define WS_LO(v_) ((((v_) >> 4) > 0) ? ((v_) >> 4) - 1 : 0)
#define WS_HI(v_) ((((v_) >> 4) < 63) ? ((v_) >> 4) + 2 : 64)
    int Cv = (int)blockIdx.x, Ccb = WS_LO(Cv);
    int Lv = Cv, Lcb = Ccb; bool Lvalid = true;
#define WS_ADV_L() do { if (Lcb + 1 < WS_HI(Lv)) ++Lcb; else { Lv += G; if (Lv < 1024) Lcb = WS_LO(Lv); else Lvalid = false; } } while (0)
    __syncthreads();
    WS_LOAD(Lv, Lcb); WS_ADV_L();
    WS_STORE(lds0);
    bool have = false;
    if (Lvalid) { WS_LOAD(Lv, Lcb); WS_ADV_L(); have = true; }
    __syncthreads();
    int bsel = 0;
    bf16x8 qf[NS]; f32x4 o[NDT]; float m_run = 0.f, l_run = 1.f;
#pragma unroll 1
    for (;;) {
        const int qblk = Cv >> 4, hq = Cv & 15, lo = WS_LO(Cv), hi = WS_HI(Cv);
        LAS unsigned char* lds = lds0 + bsel * BUFB;
        if (Ccb == lo) {
            const unsigned qoff = (unsigned)(((16 * w + q) * INW + 8 * g) * 2);
            const char* qb = (const char*)proj + ((size_t)(qblk * 128) * INW + C_QA + hq * 128) * 2;
#pragma unroll
            for (int s = 0; s < NS; ++s) qf[s] = __builtin_nontemporal_load((const bf16x8*)(qb + qoff + 64 * s));
#pragma unroll
            for (int dt = 0; dt < NDT; ++dt) o[dt] = (f32x4){0.f, 0.f, 0.f, 0.f};
            m_run = a.in[4][hq] * LOG2E; l_run = 1.f;
        }
        if (have) { WS_STORE(lds0 + (bsel ^ 1) * BUFB); have = false; }
        if (Lvalid) { WS_LOAD(Lv, Lcb); WS_ADV_L(); have = true; }
        f32x4 s[8];
#pragma unroll
        for (int kt = 0; kt < 8; ++kt) s[kt] = (f32x4){0.f, 0.f, 0.f, 0.f};
        {
            bf16x8 ka[2][8];
#pragma unroll
            for (int kt = 0; kt < 8; ++kt) ka[0][kt] = *(const LAS bf16x8*)(lds + (32 * (kt >> 1) + 4 * (kt & 1) + krow) * KROW + (((0 + g) ^ q) * 16));
#pragma unroll
            for (int ss = 0; ss < NS; ++ss) {
                if (ss + 1 < NS) {
#pragma unroll
                    for (int kt = 0; kt < 8; ++kt) ka[(ss + 1) & 1][kt] = *(const LAS bf16x8*)(lds + (32 * (kt >> 1) + 4 * (kt & 1) + krow) * KROW + (((4 * (ss + 1) + g) ^ q) * 16)); }
                __builtin_amdgcn_sched_barrier(0);
#pragma unroll
                for (int kt = 0; kt < 8; ++kt) s[kt] = mfma16(ka[ss & 1][kt], qf[ss], s[kt]);
                __builtin_amdgcn_sched_barrier(0);
            }
        }
        if (Ccb != qblk) {
            const bool prev = Ccb < qblk; const int ud = __builtin_amdgcn_readfirstlane(w) >> 1;
            const float sg = prev ? 1.f : -1.f;
            const float dq = (float)(16 * w + q - 8 * g);
#pragma unroll
            for (int u = 0; u < 4; ++u) {
                if (prev ? (u < ud) : (u > ud)) {
#pragma unroll
                    for (int j = 0; j < 4; ++j) { s[2 * u][j] = -1e30f; s[2 * u + 1][j] = -1e30f; }
                } else if (u == ud) {
#pragma unroll
                    for (int h2 = 0; h2 < 2; ++h2)
#pragma unroll
                        for (int j = 0; j < 4; ++j) { const float v = sg * ((float)(32 * u + 4 * h2 + j) - dq); s[2 * u + h2][j] += fminf(v, 0.f) * 1e30f; }
                }
            }
        }
        float mx = s[0][0];
#pragma unroll
        for (int kt = 0; kt < 8; ++kt)
#pragma unroll
            for (int j = 0; j < 4; ++j) mx = fmaxf(mx, s[kt][j]);
        mx = fmaxf(mx, __shfl_xor(mx, 16)); mx = fmaxf(mx, __shfl_xor(mx, 32));
        const float m_new = fmaxf(m_run, mx), alpha = fexp2(m_run - m_new); m_run = m_new;
        float rs = 0.f;
#pragma unroll
        for (int kt = 0; kt < 8; ++kt)
#pragma unroll
            for (int j = 0; j < 4; ++j) { const float p = fexp2(s[kt][j] - m_new); s[kt][j] = p; rs += p; }
        rs += __shfl_xor(rs, 16); rs += __shfl_xor(rs, 32);
        l_run = l_run * alpha + rs;
        bf16x8 pb[4];
#pragma unroll
        for (int u = 0; u < 4; ++u) { u32x4 t; t.x = pk2(s[2 * u][0], s[2 * u][1]); t.y = pk2(s[2 * u][2], s[2 * u][3]); t.z = pk2(s[2 * u + 1][0], s[2 * u + 1][1]); t.w = pk2(s[2 * u + 1][2], s[2 * u + 1][3]);
            pb[u] = __builtin_bit_cast(bf16x8, t); }
#pragma unroll
        for (int dt = 0; dt < NDT; ++dt) o[dt] = o[dt] * alpha;
        {
            u32x4 va[2][8];
#define WS_VLOAD(buf, gi) do { _Pragma("unroll") for (int i = 0; i < 8; ++i) { va[buf][i] = *(const LAS u32x4*)(lds + KT + (16 * i + q) * VROW + (32 * (gi) + 8 * g) * 2); } } while (0)
            WS_VLOAD(0, 0);
#pragma unroll
            for (int gi = 0; gi < 4; ++gi) {
                if (gi + 1 < 4) WS_VLOAD((gi + 1) & 1, gi + 1);
                __builtin_amdgcn_sched_barrier(0);
#pragma unroll
                for (int i = 0; i < 8; ++i) o[i] = mfma16(__builtin_bit_cast(bf16x8, va[gi & 1][i]), pb[gi], o[i]);
                __builtin_amdgcn_sched_barrier(0);
            }
#undef WS_VLOAD
        }
        bool done = false;
        if (Ccb + 1 < hi) ++Ccb;
        else {
            const float inv = 1.f / l_run;
            char* ob = (char*)yatt + ((size_t)(qblk * 128) * 2048 + hq * 128) * 2;
            const unsigned ooff = (unsigned)(((16 * w + q) * 2048 + 4 * g) * 2);
#pragma unroll
            for (int dt = 0; dt < NDT; ++dt) { u32x2 pkv; pkv.x = pk2(o[dt][0] * inv, o[dt][1] * inv); pkv.y = pk2(o[dt][2] * inv, o[dt][3] * inv); *(u32x2*)(ob + ooff + 32 * dt) = pkv; }
            Cv += G; if (Cv < 1024) Ccb = WS_LO(Cv); else done = true;
        }
        __syncthreads();
        bsel ^= 1;
        if (done) break;
    }
#undef WS_LOAD
#undef WS_STORE
#undef WS_LO
#undef WS_HI
#undef WS_ADV_L
}

constexpr int LR_XCB = 0, LR_TA = 16384, LR_TB = LR_TA + 64 * 528, LR_TH = LR_TB + 64 * 528, LR_AGS = LR_TH + 64 * 528;
template <int VAR>
__device__ __forceinline__ void lru_phase(LAS unsigned char* lds, const Args& a, const int n, const int tt_first, const int tt_step) {
    int tid = threadIdx.x; asm volatile("" : "+v"(tid)); const int lane = tid & 63, w0 = tid >> 6, q0 = lane & 15, g0 = lane >> 4;
    unsigned char* ws = a.ws;
    const bf16_t* proj = (const bf16_t*)(ws + WS_PROJ);
    LAS unsigned char* xcb = lds + LR_XCB;
    LAS float* TA = (LAS float*)(lds + LR_TA); LAS float* TB = (LAS float*)(lds + LR_TB); LAS float* TH = (LAS float*)(lds + LR_TH);
    LAS f32x2* AGS = (LAS f32x2*)(lds + LR_AGS);
    const bf16_t* lruw = (const bf16_t*)(ws + WS_LRUW);
    f32x2* agg1 = (f32x2*)(ws + (VAR ? WS_T0 : WS_AGG1));
    bf16_t* Pout = (bf16_t*)(ws + (VAR ? WS_U + 32 * MiB : WS_PP));
    bf16x8 fa[2][4], fx[2][4];
#pragma unroll
    for (int dir = 0; dir < 2; ++dir) {
        const bf16_t* wa = lruw + (size_t)((0 * 2 + dir) * 8 + n) * 16384 + (16 * w0 + q0) * 128 + 8 * g0;
        const bf16_t* wx = lruw + (size_t)((1 * 2 + dir) * 8 + n) * 16384 + (16 * w0 + q0) * 128 + 8 * g0;
#pragma unroll
        for (int s = 0; s < 4; ++s) { fa[dir][s] = *(const bf16x8*)(wa + 32 * s); fx[dir][s] = *(const bf16x8*)(wx + 32 * s); }
    }
    const int cg8 = tid & 15, t2 = tid >> 4, ch0 = n * 128 + cg8 * 8;
    LAS float* CW = (LAS float*)(lds + LR_AGS + 4096);
    __syncthreads();
    if (tid < 128) {
#pragma unroll
        for (int j = 0; j < 4; ++j) CW[j * 128 + tid] = a.in[5][j * 1024 + n * 128 + tid];
        CW[512 + tid] = a.in[6][n * 128 + tid];
    } else if (tid < 384) {
        const int d2 = (tid - 128) >> 7, c = tid & 127, cg = d2 * 1024 + n * 128 + c;
        const float xl = -a.in[11][cg];
        CW[640 + (d2 * 3 + 0) * 128 + c] = a.in[8][cg]; CW[640 + (d2 * 3 + 1) * 128 + c] = a.in[10][cg];
        CW[640 + (d2 * 3 + 2) * 128 + c] = fmaxf(xl, 0.f) + log1pf(expf(-fabsf(xl)));
    }
    u32x4 xr[5];
#define LRU_XLOAD(tt_) do { _Pragma("unroll") for (int r = 0; r < 5; ++r) { const int t = (tt_) * 64 + 2 * t2 - 2 + r; xr[r] = (u32x4){0u, 0u, 0u, 0u}; \
        if (t >= 0 && t < SEQ) xr[r] = __builtin_nontemporal_load((const u32x4*)((const char*)proj + (unsigned)((t * INW + C_XL + ch0) * 2))); } } while (0)
    float A2f = 1.f, H2f = 0.f, A2b = 1.f, H2b = 0.f;
    LRU_XLOAD(tt_first);
#pragma unroll 1
    for (int tt = tt_first; tt < tt_first + 4; ++tt) {
    const int t0 = tt * 64;
    __syncthreads();
    {
        float xin[5][8];
#pragma unroll
        for (int r = 0; r < 5; ++r) { const u32x4 v = xr[r];
            xin[r][0] = bflo(v.x); xin[r][1] = bfhi(v.x); xin[r][2] = bflo(v.y); xin[r][3] = bfhi(v.y); xin[r][4] = bflo(v.z); xin[r][5] = bfhi(v.z); xin[r][6] = bflo(v.w); xin[r][7] = bfhi(v.w); }
        float wv[4][8], bias[8];
#pragma unroll
        for (int j = 0; j < 4; ++j) { const f32x4 w0 = *(const LAS f32x4*)(CW + j * 128 + cg8 * 8), w1 = *(const LAS f32x4*)(CW + j * 128 + cg8 * 8 + 4);
            wv[j][0] = w0[0]; wv[j][1] = w0[1]; wv[j][2] = w0[2]; wv[j][3] = w0[3]; wv[j][4] = w1[0]; wv[j][5] = w1[1]; wv[j][6] = w1[2]; wv[j][7] = w1[3]; }
        { const f32x4 b0 = *(const LAS f32x4*)(CW + 512 + cg8 * 8), b1 = *(const LAS f32x4*)(CW + 512 + cg8 * 8 + 4);
          bias[0] = b0[0]; bias[1] = b0[1]; bias[2] = b0[2]; bias[3] = b0[3]; bias[4] = b1[0]; bias[5] = b1[1]; bias[6] = b1[2]; bias[7] = b1[3]; }
#pragma unroll
        for (int o = 0; o < 2; ++o) { float y[8];
#pragma unroll
            for (int e = 0; e < 8; ++e) { float v = bias[e];
#pragma unroll
                for (int j = 0; j < 4; ++j) v += wv[j][e] * xin[o + j][e];
                y[e] = v; }
            const int tok = 2 * t2 + o;
            u32x4 pk; pk.x = pk2(y[0], y[1]); pk.y = pk2(y[2], y[3]); pk.z = pk2(y[4], y[5]); pk.w = pk2(y[6], y[7]);
            *(LAS u32x4*)(xcb + tok * 256 + ((cg8 ^ (tok & 15)) * 16)) = pk; }
    }
    if (tt + 1 < tt_first + 4) LRU_XLOAD(tt + 1);
    __syncthreads();
    float hreg[16];
    int tl = tid; asm volatile("" : "+v"(tl));
    const int q = tl & 15, g = (tl >> 4) & 3, w = tl >> 6, chl = 16 * w + 4 * g;
    const int ch = 16 * w + q, sub = g;
#pragma unroll
    for (int dir = 0; dir < 2; ++dir) {
        LAS float* TAd = dir ? TH : TA;
        if (VAR != 3) {
            const f32x4 ba = *(const LAS f32x4*)(CW + 640 + (dir * 3 + 0) * 128 + chl), bx = *(const LAS f32x4*)(CW + 640 + (dir * 3 + 1) * 128 + chl), sp = *(const LAS f32x4*)(CW + 640 + (dir * 3 + 2) * 128 + chl);
#pragma unroll
            for (int tk = 0; tk < 4; ++tk) { const int tok = 16 * tk + q;
                f32x4 ar = (f32x4){0.f, 0.f, 0.f, 0.f}, ai = (f32x4){0.f, 0.f, 0.f, 0.f};
#pragma unroll
                for (int s = 0; s < 4; ++s) {
                    const bf16x8 xb = *(const LAS bf16x8*)(xcb + tok * 256 + (((4 * s + g) ^ q) * 16));
                    ar = mfma16(fa[dir][s], xb, ar); ai = mfma16(fx[dir][s], xb, ai); }
                const u32x2 xr2 = *(const LAS u32x2*)(xcb + tok * 256 + ((((chl >> 3)) ^ q) * 16) + (chl & 7) * 2);
                const float xc0 = bflo(xr2.x), xc1 = bfhi(xr2.x), xc2 = bflo(xr2.y), xc3 = bfhi(xr2.y);
                f32x4 av, bv;
#pragma unroll
                for (int j = 0; j < 4; ++j) { if (VAR == 1) { av[j] = ar[j] + ba[j] + sp[j]; bv[j] = ai[j] + bx[j] + (j == 0 ? xc0 : (j == 1 ? xc1 : (j == 2 ? xc2 : xc3))); continue; }
                    const float r = fsigmoid(ar[j] + ba[j]), ii = fsigmoid(ai[j] + bx[j]);
                    const float la = -8.0f * r * sp[j]; const float aa = fexp2(la * LOG2E); av[j] = aa;
                    const float x2 = 2.0f * la;
                    const float poly = x2 * (1.f + x2 * (0.5f + x2 * ((1.f / 6.f) + x2 * ((1.f / 24.f) + x2 * (1.f / 120.f)))));
                    const float om = (x2 > -0.25f) ? -poly : (1.f - aa * aa);
                    const float xcj = j == 0 ? xc0 : (j == 1 ? xc1 : (j == 2 ? xc2 : xc3));
                    bv[j] = __builtin_amdgcn_sqrtf(om) * ii * xcj; }
                *(LAS f32x4*)(TAd + tok * 132 + chl) = av; *(LAS f32x4*)(TB + tok * 132 + chl) = bv; }
        }
        asm volatile("s_waitcnt lgkmcnt(0)" ::: "memory");
        if (VAR != 2 && VAR != 3) {
            float h = 0.f, P = 1.f;
#pragma unroll
            for (int i = 0; i < 16; ++i) { const int t = 16 * sub + (dir ? 15 - i : i);
                const float av = TAd[t * 132 + ch], bv = TB[t * 132 + ch]; h = av * h + bv; P *= av; TB[t * 132 + ch] = h; TAd[t * 132 + ch] = P; }
            AGS[sub * 128 + ch] = (f32x2){P, h};
        }
        asm volatile("s_waitcnt lgkmcnt(0)" ::: "memory");
        if (VAR == 2 || VAR == 3) {
#pragma unroll
            for (int i = 0; i < 16; ++i) hreg[i] = 0.f;
        } else {
            float hc = 0.f, Pp = 1.f, At = 1.f, Ht = 0.f;
#pragma unroll
            for (int s = 0; s < 4; ++s) { const int s2 = dir ? 3 - s : s; const f32x2 e = AGS[s2 * 128 + ch];
                const bool before = dir ? (s2 > sub) : (s2 < sub);
                if (before) { hc = e.x * hc + e.y; Pp *= e.x; }
                Ht = e.x * Ht + e.y; At *= e.x; }
#pragma unroll
            for (int i = 0; i < 16; ++i) { const int t = 16 * sub + i;
                const float Pl = TAd[t * 132 + ch], hl = TB[t * 132 + ch];
                const float hfull = hl + Pl * hc;
                if (dir == 0) hreg[i] = hfull; else hreg[i] += hfull;
                TAd[t * 132 + ch] = Pl * Pp; }
            if (sub == 0) agg1[(size_t)(dir * 1024 + n * 128 + ch) * 128 + tt] = (f32x2){At, Ht};
            if (dir == 0) { H2f = At * H2f + Ht; A2f *= At; }
            else { H2b = A2b * Ht + H2b; A2b *= At; }
        }
        asm volatile("s_waitcnt lgkmcnt(0)" ::: "memory");
    }
#pragma unroll
    for (int i = 0; i < 16; ++i) TB[(16 * sub + i) * 132 + ch] = hreg[i];
    __syncthreads();
    {
        float* hs = (float*)(ws + (VAR ? WS_U : WS_HS));
#pragma unroll
        for (int i = 0; i < 4; ++i) { const int e = tid + 512 * i, t = e >> 5, c4 = e & 31;
            *(f32x4*)(hs + (size_t)(t0 + t) * 1024 + n * 128 + 4 * c4) = *(const LAS f32x4*)(TB + t * 132 + 4 * c4);
            const f32x4 p0 = *(const LAS f32x4*)(TA + t * 132 + 4 * c4), p1 = *(const LAS f32x4*)(TH + t * 132 + 4 * c4);
            u32x2 o0, o1; o0.x = pk2(p0[0], p0[1]); o0.y = pk2(p0[2], p0[3]); o1.x = pk2(p1[0], p1[1]); o1.y = pk2(p1[2], p1[3]);
            *(u32x2*)(Pout + (size_t)(t0 + t) * 1024 + n * 128 + 4 * c4) = o0;
            *(u32x2*)(Pout + (size_t)SEQ * 1024 + (size_t)(t0 + t) * 1024 + n * 128 + 4 * c4) = o1; }
    }
    }
    if (g0 == 0) { f32x2* agg2 = (f32x2*)(ws + (VAR ? WS_T0 + 8 * MiB : WS_AGG2)); const int chg2 = n * 128 + 16 * w0 + q0, sc2 = tt_first >> 2;
        agg2[(size_t)chg2 * 32 + sc2] = (f32x2){A2f, H2f}; agg2[(size_t)(1024 + chg2) * 32 + sc2] = (f32x2){A2b, H2b}; }
#undef LRU_XLOAD
}

__device__ __forceinline__ void phase2(const Args& a, LAS unsigned char* lds, int p2mask) {
    unsigned char* ws = a.ws;
    bf16_t* proj = (bf16_t*)(ws + WS_PROJ); const bf16_t* vt = (const bf16_t*)(ws + WS_VT);
    const bf16_t* mk = (const bf16_t*)(ws + WS_MK); const bf16_t* mvt = (const bf16_t*)(ws + WS_MVT);
    bf16_t* yatt = (bf16_t*)(ws + WS_YATT); bf16_t* ymem = (bf16_t*)(ws + WS_YMEM);
    if (p2mask & 1)
    for (int u = blockIdx.x; u < 256; u += gridDim.x) {
        const int qblk = u >> 2, hm = u & 3;
        attn_unit<256, false, false>(lds, proj + (size_t)(qblk * 128) * INW + C_QM + hm * 256, INW, ymem + (size_t)(qblk * 128) * 1024 + hm * 256, 1024, mk + hm * 256, 1024, mvt + (size_t)(hm * 256) * 256, 256, 0, 2, -100, -1e30f, 0.f);
    }
    if (p2mask & 2) windowed_stream(lds, a);
    if (p2mask & 4)
    lru_phase<0>(lds, a, (int)(blockIdx.x & 7), 4 * (int)(blockIdx.x >> 3), 1);
}

__device__ __forceinline__ void phase3(const Args& a, LAS unsigned char* lds) {
    unsigned char* ws = a.ws;
    const f32x2* agg1 = (const f32x2*)(ws + WS_AGG1); f32x2* agg2 = (f32x2*)(ws + WS_AGG2);
    for (int e = blockIdx.x * 512 + threadIdx.x; e < 2 * 1024 * 16; e += gridDim.x * 512) {
        const int sc = e & 15, dc = e >> 4, dir = dc >> 10;
        const f32x4* p = (const f32x4*)(agg1 + (size_t)dc * 128 + sc * 8);
        f32x4 v[4];
#pragma unroll
        for (int i = 0; i < 4; ++i) v[i] = p[i];
        float A = 1.f, H = 0.f;
        if (dir == 0) {
#pragma unroll
            for (int i = 0; i < 4; ++i) { H = v[i][0] * H + v[i][1]; A *= v[i][0]; H = v[i][2] * H + v[i][3]; A *= v[i][2]; }
        } else {
#pragma unroll
            for (int i = 3; i >= 0; --i) { H = v[i][2] * H + v[i][3]; A *= v[i][2]; H = v[i][0] * H + v[i][1]; A *= v[i][0]; }
        }
        agg2[(size_t)dc * 16 + sc] = (f32x2){A, H};
    }
}

__device__ __forceinline__ float silu_(float z) { return z * __builtin_amdgcn_rcpf(1.f + __builtin_amdgcn_exp2f(-z * 1.4426950408889634f)); }
__device__ __forceinline__ void phase4(const Args& a, LAS unsigned char* lds) {
    unsigned char* ws = a.ws;
    const f32x2* agg1 = (const f32x2*)(ws + WS_AGG1); const f32x2* agg2 = (const f32x2*)(ws + WS_AGG2);
    const bf16_t* proj = (const bf16_t*)(ws + WS_PROJ); bf16_t* Y = (bf16_t*)(ws + WS_Y);
    const bf16_t* yatt = (const bf16_t*)(ws + WS_YATT); const bf16_t* ymem = (const bf16_t*)(ws + WS_YMEM);
    const float* hs = (const float*)(ws + WS_HS); const bf16_t* Pf = (const bf16_t*)(ws + WS_PP); const bf16_t* Pb = Pf + (size_t)SEQ * 1024;
    LAS float* car = (LAS float*)lds;
    LAS float* gl = (LAS float*)(lds + 8192);
    int tid = threadIdx.x; asm volatile("" : "+v"(tid)); const int lane = tid & 63, w = tid >> 6;
    __syncthreads();
    for (int i = tid; i < 1024; i += 512) { *(LAS f32x4*)(gl + 4 * i) = (i < 512) ? ((const f32x4*)a.in[14])[i] : (i < 768 ? ((const f32x4*)a.in[15])[i - 512] : ((const f32x4*)a.in[16])[i - 768]); }
    for (int u = blockIdx.x; u < 256; u += gridDim.x) {
        const int tile = u >> 1, sc = tile >> 2, cj = tile & 3;
        __syncthreads();
#pragma unroll 1
        for (int half = 0; half < 2; ++half) {
            const int c = tid + 512 * half;
            float hf = 0.f, hb = 0.f;
            float scf = (float)sc, cjf = (float)cj; asm volatile("" : "+v"(scf), "+v"(cjf));
            { const f32x4* p2 = (const f32x4*)(agg2 + (size_t)c * 32); const f32x4* p1 = (const f32x4*)(agg1 + (size_t)c * 128 + sc * 4);
              f32x4 e2[16], e1[2];
#pragma unroll
              for (int i = 0; i < 16; ++i) e2[i] = p2[i];
#pragma unroll
              for (int i = 0; i < 2; ++i) e1[i] = p1[i];
#pragma unroll
              for (int i = 0; i < 16; ++i) { const float w0 = fminf(fmaxf(scf - (float)(2 * i), 0.f), 1.f), w1 = fminf(fmaxf(scf - (float)(2 * i + 1), 0.f), 1.f);
                  hf = (w0 * e2[i][0] + (1.f - w0)) * hf + w0 * e2[i][1]; hf = (w1 * e2[i][2] + (1.f - w1)) * hf + w1 * e2[i][3]; }
#pragma unroll
              for (int i = 0; i < 2; ++i) { const float w0 = fminf(fmaxf(cjf - (float)(2 * i), 0.f), 1.f), w1 = fminf(fmaxf(cjf - (float)(2 * i + 1), 0.f), 1.f);
                  hf = (w0 * e1[i][0] + (1.f - w0)) * hf + w0 * e1[i][1]; hf = (w1 * e1[i][2] + (1.f - w1)) * hf + w1 * e1[i][3]; } }
            { const f32x4* p2 = (const f32x4*)(agg2 + (size_t)(1024 + c) * 32); const f32x4* p1 = (const f32x4*)(agg1 + (size_t)(1024 + c) * 128 + sc * 4);
              f32x4 e2[16], e1[2];
#pragma unroll
              for (int i = 0; i < 16; ++i) e2[i] = p2[i];
#pragma unroll
              for (int i = 0; i < 2; ++i) e1[i] = p1[i];
#pragma unroll
              for (int i = 15; i >= 0; --i) { const float w1 = fminf(fmaxf((float)(2 * i + 1) - scf, 0.f), 1.f), w0 = fminf(fmaxf((float)(2 * i) - scf, 0.f), 1.f);
                  hb = (w1 * e2[i][2] + (1.f - w1)) * hb + w1 * e2[i][3]; hb = (w0 * e2[i][0] + (1.f - w0)) * hb + w0 * e2[i][1]; }
#pragma unroll
              for (int i = 1; i >= 0; --i) { const float w1 = fminf(fmaxf((float)(2 * i + 1) - cjf, 0.f), 1.f), w0 = fminf(fmaxf((float)(2 * i) - cjf, 0.f), 1.f);
                  hb = (w1 * e1[i][2] + (1.f - w1)) * hb + w1 * e1[i][3]; hb = (w0 * e1[i][0] + (1.f - w0)) * hb + w0 * e1[i][1]; } }
            car[c] = hf; car[1024 + c] = hb;
        }
        __syncthreads();
        f32x4 cf[4], cb[4];
#pragma unroll
        for (int k = 0; k < 4; ++k) { cf[k] = *(const LAS f32x4*)(car + 4 * lane + 256 * k); cb[k] = *(const LAS f32x4*)(car + 1024 + 4 * lane + 256 * k); }
#pragma unroll 1
        for (int tk = 0; tk < 4; ++tk) {
            const unsigned t = (unsigned)(u * 32 + 4 * w + tk);
            const char* hsb = (const char*)hs; const char* pfb = (const char*)Pf; const char* pbb = (const char*)Pb;
            const char* yab = (const char*)yatt; const char* ymb = (const char*)ymem; const char* prb = (const char*)proj; char* yb = (char*)Y;
            const unsigned o_h = t * 4096u + 16u * lane, o_p = t * 2048u + 8u * lane, o_m = t * 2048u + 16u * lane;
            const unsigned o_pr = t * (unsigned)(INW * 2), o_y = t * 8192u;
            f32x4 h4[4]; u32x2 pf[4], pb[4], zl[4]; u32x4 va[4], vm[2], za[4], zm[2];
#pragma unroll
            for (int k = 0; k < 4; ++k) { h4[k] = __builtin_nontemporal_load((const f32x4*)(hsb + o_h + 1024u * k)); pf[k] = __builtin_nontemporal_load((const u32x2*)(pfb + o_p + 512u * k)); pb[k] = __builtin_nontemporal_load((const u32x2*)(pbb + o_p + 512u * k)); va[k] = __builtin_nontemporal_load((const u32x4*)(yab + o_h + 1024u * k)); }
#pragma unroll
            for (int k = 0; k < 2; ++k) vm[k] = __builtin_nontemporal_load((const u32x4*)(ymb + o_m + 1024u * k));
#pragma unroll
            for (int k = 0; k < 4; ++k) { zl[k] = __builtin_nontemporal_load((const u32x2*)(prb + o_pr + (unsigned)((C_ZL + 4 * lane + 256 * k) * 2))); za[k] = __builtin_nontemporal_load((const u32x4*)(prb + o_pr + (unsigned)((C_ZA + 8 * lane + 512 * k) * 2))); }
#pragma unroll
            for (int k = 0; k < 2; ++k) zm[k] = __builtin_nontemporal_load((const u32x4*)(prb + o_pr + (unsigned)((C_ZM + 8 * lane + 512 * k) * 2)));
            __builtin_amdgcn_sched_barrier(0);
            f32x4 v[4]; float ssl = 0.f, ssa = 0.f, ssm = 0.f;
#pragma unroll
            for (int k = 0; k < 4; ++k) {
                v[k][0] = h4[k][0] + bflo(pf[k].x) * cf[k][0] + bflo(pb[k].x) * cb[k][0]; v[k][1] = h4[k][1] + bfhi(pf[k].x) * cf[k][1] + bfhi(pb[k].x) * cb[k][1];
                v[k][2] = h4[k][2] + bflo(pf[k].y) * cf[k][2] + bflo(pb[k].y) * cb[k][2]; v[k][3] = h4[k][3] + bfhi(pf[k].y) * cf[k][3] + bfhi(pb[k].y) * cb[k][3];
                ssl += (v[k][0] * v[k][0] + v[k][1] * v[k][1]) + (v[k][2] * v[k][2] + v[k][3] * v[k][3]);
                { const float f0 = bflo(va[k].x), f1 = bfhi(va[k].x), f2 = bflo(va[k].y), f3 = bfhi(va[k].y), f4 = bflo(va[k].z), f5 = bfhi(va[k].z), f6 = bflo(va[k].w), f7 = bfhi(va[k].w);
                  ssa += ((f0 * f0 + f1 * f1) + (f2 * f2 + f3 * f3)) + ((f4 * f4 + f5 * f5) + (f6 * f6 + f7 * f7)); } }
#pragma unroll
            for (int k = 0; k < 2; ++k) { const float f0 = bflo(vm[k].x), f1 = bfhi(vm[k].x), f2 = bflo(vm[k].y), f3 = bfhi(vm[k].y), f4 = bflo(vm[k].z), f5 = bfhi(vm[k].z), f6 = bflo(vm[k].w), f7 = bfhi(vm[k].w);
                ssm += ((f0 * f0 + f1 * f1) + (f2 * f2 + f3 * f3)) + ((f4 * f4 + f5 * f5) + (f6 * f6 + f7 * f7)); }
#pragma unroll
            for (int o = 1; o < 64; o <<= 1) { ssl += __shfl_xor(ssl, o); ssa += __shfl_xor(ssa, o); ssm += __shfl_xor(ssm, o); }
            const float rsl = 1.f / sqrtf(ssl * (1.f / 1024.f) + EPSN), rsa = 1.f / sqrtf(ssa * (1.f / 2048.f) + EPSN), rsm = 1.f / sqrtf(ssm * (1.f / 1024.f) + EPSN);
            __builtin_amdgcn_sched_barrier(0);
#pragma unroll
            for (int k = 0; k < 4; ++k) { const int c = 4 * lane + 256 * k; const f32x4 g4 = *(const LAS f32x4*)(gl + 2048 + c); const u32x2 z = zl[k];
                u32x2 o; o.x = pk2(v[k][0] * rsl * g4[0] * silu_(bflo(z.x)), v[k][1] * rsl * g4[1] * silu_(bfhi(z.x))); o.y = pk2(v[k][2] * rsl * g4[2] * silu_(bflo(z.y)), v[k][3] * rsl * g4[3] * silu_(bfhi(z.y)));
                *(u32x2*)(yb + o_y + (unsigned)((2048 + c) * 2)) = o; }
            __builtin_amdgcn_sched_barrier(0);
#pragma unroll
            for (int k = 0; k < 4; ++k) { const int c = 8 * lane + 512 * k; const f32x4 g0 = *(const LAS f32x4*)(gl + c), g1 = *(const LAS f32x4*)(gl + c + 4); const u32x4 z = za[k];
                u32x4 o; o.x = pk2(bflo(va[k].x) * rsa * g0[0] * silu_(bflo(z.x)), bfhi(va[k].x) * rsa * g0[1] * silu_(bfhi(z.x)));
                o.y = pk2(bflo(va[k].y) * rsa * g0[2] * silu_(bflo(z.y)), bfhi(va[k].y) * rsa * g0[3] * silu_(bfhi(z.y)));
                o.z = pk2(bflo(va[k].z) * rsa * g1[0] * silu_(bflo(z.z)), bfhi(va[k].z) * rsa * g1[1] * silu_(bfhi(z.z)));
                o.w = pk2(bflo(va[k].w) * rsa * g1[2] * silu_(bflo(z.w)), bfhi(va[k].w) * rsa * g1[3] * silu_(bfhi(z.w)));
                *(u32x4*)(yb + o_y + (unsigned)(c * 2)) = o; }
            __builtin_amdgcn_sched_barrier(0);
#pragma unroll
            for (int k = 0; k < 2; ++k) { const int c = 8 * lane + 512 * k; const f32x4 g0 = *(const LAS f32x4*)(gl + 3072 + c), g1 = *(const LAS f32x4*)(gl + 3072 + c + 4); const u32x4 z = zm[k];
                u32x4 o; o.x = pk2(bflo(vm[k].x) * rsm * g0[0] * silu_(bflo(z.x)), bfhi(vm[k].x) * rsm * g0[1] * silu_(bfhi(z.x)));
                o.y = pk2(bflo(vm[k].y) * rsm * g0[2] * silu_(bflo(z.y)), bfhi(vm[k].y) * rsm * g0[3] * silu_(bfhi(z.y)));
                o.z = pk2(bflo(vm[k].z) * rsm * g1[0] * silu_(bflo(z.z)), bfhi(vm[k].z) * rsm * g1[1] * silu_(bfhi(z.z)));
                o.w = pk2(bflo(vm[k].w) * rsm * g1[2] * silu_(bflo(z.w)), bfhi(vm[k].w) * rsm * g1[3] * silu_(bfhi(z.w)));
                *(u32x4*)(yb + o_y + (unsigned)((3072 + c) * 2)) = o; }
        }
    }
}

#define XB_TMO      128
#define XB_XCNT(j)  (256  + 64 * (j))
#define XB_XSUB(j)  (1280 + 64 * (j))
#define XB_XGEN(j)  (2304 + 64 * (j))
#define XB_TOP      3328
#define XB_TOPGEN   3392
#define XCD_BAR_WORDS 3456
#define XB_SPIN_CAP (1u << 18)

__device__ __forceinline__ unsigned xb_ld(unsigned* p)              { return __hip_atomic_load(p, __ATOMIC_RELAXED, __HIP_MEMORY_SCOPE_AGENT); }
__device__ __forceinline__ unsigned xb_add(unsigned* p, unsigned v) { return __hip_atomic_fetch_add(p, v, __ATOMIC_RELAXED, __HIP_MEMORY_SCOPE_AGENT); }
__device__ __forceinline__ unsigned xb_xcc_id() { return (unsigned)__builtin_amdgcn_s_getreg((3 << 11) | 20) & 0xFu; }
#define XB_SPIN(cond, bar) do { unsigned _sp = 0; while (cond) { __builtin_amdgcn_s_sleep(1); \
    if ((++_sp & 255u) == 0u) { if (xb_ld(&(bar)[XB_TMO])) break; if (_sp > XB_SPIN_CAP) { atomicAdd(&(bar)[XB_TMO], 1u); break; } } } } while (0)

struct XcdBarrier {
    unsigned* bar; unsigned x;
    volatile LAS unsigned* st;
};

__device__ __forceinline__ XcdBarrier xcd_barrier_post(unsigned* bar, volatile LAS unsigned* st) {
    XcdBarrier b; b.bar = bar; b.x = xb_xcc_id(); b.st = st;
    if (threadIdx.x == 0) (void)xb_add(&bar[XB_XCNT(b.x)], 1u);
    return b;
}
__device__ __forceinline__ void xcd_barrier_complete(unsigned* bar, unsigned x, unsigned& nloc, unsigned& nx) {
    const unsigned G = gridDim.x * gridDim.y * gridDim.z;
    unsigned sum, cnt, mine, sp = 0u;
    for (;;) {
        sum = 0u; cnt = 0u; mine = 0u;
#pragma unroll
        for (unsigned j = 0; j < 16; ++j) { const unsigned c = xb_ld(&bar[XB_XCNT(j)]); sum += c; cnt += (c > 0u) ? 1u : 0u; mine = (j == x) ? c : mine; }
        if (sum == G) break;
        __builtin_amdgcn_s_sleep(1);
        if ((++sp & 255u) == 0u) { if (xb_ld(&bar[XB_TMO])) break; if (sp > XB_SPIN_CAP) { atomicAdd(&bar[XB_TMO], 1u); break; } }
    }
    nloc = mine > 0u ? mine : 1u; nx = cnt > 0u ? cnt : 1u;
}

__device__ __forceinline__ void xcd_barrier(const XcdBarrier& b) {
    asm volatile("s_waitcnt vmcnt(0)" ::: "memory");
    __syncthreads();
    if (threadIdx.x == 0) {
        unsigned* bar = b.bar;
        __builtin_amdgcn_s_waitcnt(0);
        unsigned nloc = b.st[0], nx = b.st[1];
        if (nloc == 0u) { xcd_barrier_complete(bar, b.x, nloc, nx); b.st[0] = nloc; b.st[1] = nx; }
        const unsigned old = xb_add(&bar[XB_XSUB(b.x)], 1u);
        const unsigned gen = old / nloc;
        if (old + 1u == (gen + 1u) * nloc) {
            __builtin_amdgcn_fence(__ATOMIC_RELEASE, "agent");
            asm volatile("s_waitcnt vmcnt(0)" ::: "memory");
            const unsigned og = xb_add(&bar[XB_TOP], 1u);
            const unsigned tg = og / nx;
            if (og + 1u == (tg + 1u) * nx) xb_add(&bar[XB_TOPGEN], 1u);
            else XB_SPIN(xb_ld(&bar[XB_TOPGEN]) == tg, bar);
            __builtin_amdgcn_fence(__ATOMIC_ACQUIRE, "agent");
            xb_add(&bar[XB_XGEN(b.x)], 1u);
            asm volatile("s_waitcnt vmcnt(0)" ::: "memory");
        } else {
            XB_SPIN(xb_ld(&bar[XB_XGEN(b.x)]) == gen, bar);
            __builtin_amdgcn_fence(__ATOMIC_ACQUIRE, "agent");
            asm volatile("s_waitcnt vmcnt(0)" ::: "memory");
        }
    }
    __syncthreads();
}

struct Sched2 {
    int c;
    __device__ bool next(int i, pg8::Unit& u) const {
        if (i >= 2) return false;
        const int x = c & 7, j = c >> 3;
        u.pm = i * 16 + 4 * (x >> 1) + (j & 3); u.pn = 8 * (x & 1) + (j >> 2); return true;
    }
    __device__ __forceinline__ void a_ready(const pg8::Unit&) const {}
    __device__ __forceinline__ void done(const pg8::Unit&) const {}
};
struct Epi3 {
    static constexpr bool PERM = true, AFTER_DRAIN = false, HOLD_LAST = true;
    float* out; bf16_t* t0; float* sspart; const float* x; const float* gain; XcdBarrier xbar;
    __device__ __forceinline__ void operator()(const f32x4 (&acc)[2][2][4][2], const pg8::Unit& u, int wr, int wc, int fr, int fq) const {
#pragma unroll
        for (int ai = 0; ai < 2; ++ai)
#pragma unroll
            for (int m = 0; m < 4; ++m) { const int row = u.pm * 256 + ai * 128 + wr * 64 + m * 16 + fr; float ss = 0.f;
#pragma unroll
                for (int bj = 0; bj < 2; ++bj) { const f32x4 v0 = acc[ai][bj][m][0], v1 = acc[ai][bj][m][1]; const int col = u.pn * 256 + bj * 128 + wc * 32 + 8 * fq;
                    u32x4 pk; pk.x = pk2(v0[0], v0[1]); pk.y = pk2(v0[2], v0[3]); pk.z = pk2(v1[0], v1[1]); pk.w = pk2(v1[2], v1[3]); *(u32x4*)(t0 + (size_t)row * 4096 + col) = pk;
                    ss += ((v0[0] * v0[0] + v0[1] * v0[1]) + (v0[2] * v0[2] + v0[3] * v0[3])) + ((v1[0] * v1[0] + v1[1] * v1[1]) + (v1[2] * v1[2] + v1[3] * v1[3])); }
                ss += __shfl_xor(ss, 16); ss += __shfl_xor(ss, 32);
                if (fq == 0) sspart[(size_t)row * 64 + u.pn * 4 + wc] = ss; }
    }
    __device__ __forceinline__ void fused(f32x4 (&acc)[2][2][4][2], const pg8::Unit& u, int wr, int wc, int fr, int fq, LAS unsigned char* lds, int wid, int lane) const {
#pragma unroll
        for (int ai = 0; ai < 2; ++ai)
#pragma unroll
            for (int m = 0; m < 4; ++m) { const int row = u.pm * 256 + ai * 128 + wr * 64 + m * 16 + fr; float ss = 0.f;
#pragma unroll
                for (int bj = 0; bj < 2; ++bj)
#pragma unroll
                    for (int n = 0; n < 2; ++n) { const f32x4 v = acc[ai][bj][m][n]; ss += (v[0] * v[0] + v[1] * v[1]) + (v[2] * v[2] + v[3] * v[3]); }
                ss += __shfl_xor(ss, 16); ss += __shfl_xor(ss, 32);
                if (fq == 0) sspart[(size_t)row * 64 + u.pn * 4 + wc] = ss; }
        f32x4 xv0[16], xv1[16];
        const size_t gob = (size_t)(u.pm * 256 + wid * 16) * 4096 + u.pn * 256 + 4 * lane;
#pragma unroll
        for (int r = 0; r < 16; ++r) xv0[r] = __builtin_nontemporal_load((const f32x4*)(x + gob + (size_t)r * 4096));
        xcd_barrier(xbar);
        constexpr int TP = 260;
        LAS float* T = (LAS float*)lds;
        LAS float* rsT = (LAS float*)(lds + 128 * TP * 4);
        { const int tid = wid * 64 + lane, row = tid >> 1, hf = tid & 1;
          const f32x4* p = (const f32x4*)(sspart + (size_t)(u.pm * 256 + row) * 64 + hf * 32);
          float s = 0.f;
#pragma unroll
          for (int i = 0; i < 8; ++i) { const f32x4 v = p[i]; s += (v[0] + v[1]) + (v[2] + v[3]); }
          s += __shfl_xor(s, 1);
          if (hf == 0) rsT[row] = 1.f / sqrtf(s * (1.f / 4096.f) + EPSN); }
        const f32x4 gv = *(const f32x4*)(gain + u.pn * 256 + 4 * lane);
#pragma unroll
        for (int ai = 0; ai < 2; ++ai) {
            __syncthreads();
#pragma unroll
            for (int m = 0; m < 4; ++m)
#pragma unroll
                for (int bj = 0; bj < 2; ++bj)
#pragma unroll
                    for (int n = 0; n < 2; ++n) *(LAS f32x4*)(T + (wr * 64 + m * 16 + fr) * TP + bj * 128 + wc * 32 + 8 * fq + 4 * n) = acc[ai][bj][m][n];
            if (ai == 0) {
#pragma unroll
                for (int r = 0; r < 16; ++r) xv1[r] = __builtin_nontemporal_load((const f32x4*)(x + gob + (size_t)(128 + r) * 4096));
            }
            __syncthreads();
#pragma unroll
            for (int r = 0; r < 16; ++r) { const int rl = wid * 16 + r;
                const f32x4 tv = *(const LAS f32x4*)(T + rl * TP + 4 * lane); const float rs = rsT[ai * 128 + rl];
                __builtin_nontemporal_store((ai ? xv1[r] : xv0[r]) + tv * rs * gv, (f32x4*)(out + gob + (size_t)(ai * 128 + r) * 4096)); }
        }
    }
};
__device__ __forceinline__ void phase6(const Args& a) {
    int tid = threadIdx.x; asm volatile("" : "+v"(tid)); const int lane = tid & 63, w = tid >> 6;
    const float* sspart = (const float*)(a.ws + WS_SS); const bf16_t* t0 = (const bf16_t*)(a.ws + WS_T0);
    f32x4 gv[16];
#pragma unroll
    for (int k = 0; k < 16; ++k) gv[k] = ((const f32x4*)a.in[18])[2 * lane + 128 * (k >> 1) + (k & 1)];
    for (int row = blockIdx.x * 8 + w; row < 4096; row += gridDim.x * 8) {
        const u32x4* t4 = (const u32x4*)(t0 + (size_t)row * 4096) + lane; f32x4* o4 = (f32x4*)(a.out + (size_t)row * 4096) + 2 * lane;
        const f32x4* x4 = (const f32x4*)(a.in[0] + (size_t)row * 4096) + 2 * lane;
        u32x4 tv[8]; f32x4 xa[8], xb[8];
        const float sp = sspart[(size_t)row * 64 + lane];
#pragma unroll
        for (int k = 0; k < 8; ++k) { tv[k] = __builtin_nontemporal_load(t4 + 64 * k); xa[k] = __builtin_nontemporal_load(x4 + 128 * k); xb[k] = __builtin_nontemporal_load(x4 + 128 * k + 1); }
        const float rs = 1.f / sqrtf(wave_sum(sp) * (1.f / 4096.f) + EPSN);
#pragma unroll
        for (int k = 0; k < 8; ++k) { const f32x4 ga = gv[2 * k], gb = gv[2 * k + 1];
            f32x4 oa, ob; oa[0] = xa[k][0] + bflo(tv[k].x) * rs * ga[0]; oa[1] = xa[k][1] + bfhi(tv[k].x) * rs * ga[1]; oa[2] = xa[k][2] + bflo(tv[k].y) * rs * ga[2]; oa[3] = xa[k][3] + bfhi(tv[k].y) * rs * ga[3];
            ob[0] = xb[k][0] + bflo(tv[k].z) * rs * gb[0]; ob[1] = xb[k][1] + bfhi(tv[k].z) * rs * gb[1]; ob[2] = xb[k][2] + bflo(tv[k].w) * rs * gb[2]; ob[3] = xb[k][3] + bfhi(tv[k].w) * rs * gb[3];
            __builtin_nontemporal_store(oa, o4 + 128 * k); __builtin_nontemporal_store(ob, o4 + 128 * k + 1); }
    }
}

__global__ void __launch_bounds__(512, 2) mega(Args a) {
    extern __shared__ __attribute__((aligned(16))) unsigned char lds_raw[];
    LAS unsigned char* lds = (LAS unsigned char*)lds_raw;
    cg::grid_group grid = cg::this_grid();
    unsigned char* ws = a.ws;
    volatile LAS unsigned* xst = (volatile LAS unsigned*)(lds + LDS_BYTES - 64);
    if (threadIdx.x < 16) xst[threadIdx.x] = 0u;
    __syncthreads();
    XcdBarrier xbar; xbar.bar = (unsigned*)(ws + WS_CTL); xbar.x = 0; xbar.st = nullptr;
    xbar = xcd_barrier_post((unsigned*)(ws + WS_CTL), xst);
    const int lo = a.ph_lo, hi = a.ph_hi;
#define IN(k) (lo <= (k) && (k) < hi)
#define SEAM(k) do { if (IN(k) && IN((k) + 1)) { if ((k) == 1) { __syncthreads(); grid.sync(); } else xcd_barrier(xbar); } } while (0)
    if (IN(0)) { if (PHMASK & 1) phase0(a, lds); if (REPMASK & 1) { __syncthreads(); phase0(a, lds); } }
    SEAM(0);
    if (IN(1)) { if (PHMASK & 2) {
        pg8::Gemm g{(const bf16_t*)(ws + WS_U), (const bf16_t*)(ws + WS_WT), SEQ + NMEM, INW + 2048, 4096};
        Sched1 S; S.init((int)gridDim.x, (int)blockIdx.x);
        Epi1 E{(bf16_t*)(ws + WS_PROJ), (bf16_t*)(ws + WS_VT), (bf16_t*)(ws + WS_MK), (bf16_t*)(ws + WS_MVT), (const float*)(ws + WS_ROPE)};
        pg8::gemm_phase<Epi1, Sched1, true, true>(lds, g, S, E);
        {
            const int G = (int)gridDim.x, nfull = 1160 % G, nidle = (nfull == 0) ? G : G - nfull;
            const int bi = (nfull == 0) ? (int)blockIdx.x : (int)blockIdx.x - nfull;
            if (bi >= 0) {
                int tid = threadIdx.x; asm volatile("" : "+v"(tid)); const int lane = tid & 63, w = tid >> 6;
                LAS float* scr = (LAS float*)(lds + w * 16384);
                p0_transpose_matrix(a.in[17], 4096, 4096, (bf16_t*)(ws + WS_WOUT), 0, scr, bi * 8 + w, nidle * 8, lane);
            }
        }
        if (REPMASK & 2) { __syncthreads(); pg8::gemm_phase<Epi1, Sched1, true, true>(lds, g, S, E); }
    } }
    SEAM(1);
    if (IN(2)) { if (PHMASK & 4) phase2(a, lds, P2MASK); }
    SEAM(2);
    if (IN(4)) { if (PHMASK & 16) phase4(a, lds); if (REPMASK & 16) { __syncthreads(); phase4(a, lds); } }
    SEAM(4);
    if (IN(5)) { if (PHMASK & 32) {
        pg8::Gemm g{(const bf16_t*)(ws + WS_Y), (const bf16_t*)(ws + WS_WOUT), SEQ, 4096, 4096};
        Sched2 S; S.c = (int)blockIdx.x;
        Epi3 E{a.out, (bf16_t*)(ws + WS_T0), (float*)(ws + WS_SS), a.in[0], a.in[18], xbar};
        pg8::gemm_phase<Epi3, Sched2, true, true>(lds, g, S, E);
    } }
    if (IN(6)) { if (PHMASK & 64) phase6(a); }
#if N_LAUNCHES != 1
    if (lo >= 7 && lo < 10) phase2(a, lds, 1 << (lo - 7));
    if (lo == 11 || lo == 12) {
        pg8::Gemm g{(const bf16_t*)(ws + WS_U), (const bf16_t*)(ws + WS_WT), SEQ + NMEM, INW + 2048, 4096};
        Sched1 S; S.init((int)gridDim.x, (int)blockIdx.x); if (lo == 11) S.imax = 4; else S.ioff = 4;
        Epi1 E{(bf16_t*)(ws + WS_PROJ), (bf16_t*)(ws + WS_VT), (bf16_t*)(ws + WS_MK), (bf16_t*)(ws + WS_MVT), (const float*)(ws + WS_ROPE)};
        pg8::gemm_phase<Epi1, Sched1, true, true>(lds, g, S, E);
    }
    if (lo == 13) {
        pg8::Gemm g{(const bf16_t*)(ws + WS_U), (const bf16_t*)(ws + WS_WT), SEQ + NMEM, INW + 2048, 4096};
        Sched1 S; S.init((int)gridDim.x, (int)blockIdx.x); S.imax = 4;
        pg8::EpiBf16<0> E{(bf16_t*)(ws + WS_HS), INW, nullptr, 0, 0, 1.f};
        pg8::gemm_phase<pg8::EpiBf16<0>, Sched1, true, true>(lds, g, S, E);
    }
#ifdef LRUVAR
    if (lo == 10) lru_phase<LRUVAR>(lds, a, (int)(blockIdx.x & 7), (int)(blockIdx.x >> 3), (int)(gridDim.x >> 3));
#endif
#endif
#undef IN
#undef SEAM
}

extern "C" void kernel_launch(void* const* d_in, const int* in_sizes, int n_in, void* d_out, int out_size, void* d_ws, size_t ws_size, hipStream_t stream) {
    static int grid = 0;
    if (grid == 0) {
        if (n_in != 19 || ws_size < WS_END) { fprintf(stderr, "kernel_launch: unexpected n_in %d or ws_size %zu (need %zu)\n", n_in, ws_size, (size_t)WS_END); grid = -1; return; }
        int dev = 0, cus = 0, per_cu = 0;
        hipGetDevice(&dev); hipDeviceGetAttribute(&cus, hipDeviceAttributeMultiprocessorCount, dev);
        if (hipFuncSetAttribute((const void*)mega, hipFuncAttributeMaxDynamicSharedMemorySize, LDS_BYTES) != hipSuccess) { fprintf(stderr, "kernel_launch: hipFuncSetAttribute failed\n"); grid = -1; return; }
        if (hipOccupancyMaxActiveBlocksPerMultiprocessor(&per_cu, (const void*)mega, 512, LDS_BYTES) != hipSuccess || per_cu < 1) { fprintf(stderr, "kernel_launch: occupancy query says %d\n", per_cu); per_cu = 1; }
        (void)hipGetLastError();
        if (cus < 256) { fprintf(stderr, "kernel_launch: needs 256 CUs (one workgroup per CU), device has %d\n", cus); grid = -1; return; }
        grid = 256;
    }
    if (grid < 0) return;
    Args a{};
    for (int i = 0; i < 19; ++i) a.in[i] = (const float*)d_in[i];
    a.out = (float*)d_out; a.ws = (unsigned char*)d_ws;
#if N_LAUNCHES == 1
    (void)hipMemsetAsync((char*)d_ws + WS_CTL, 0, 65536, stream);
    a.ph_lo = 0; a.ph_hi = NPH;
    void* args[] = {&a};
    hipError_t e = hipLaunchCooperativeKernel((const void*)mega, dim3(grid), dim3(512), args, LDS_BYTES, stream);
    if (e != hipSuccess) fprintf(stderr, "cooperative launch failed: %s (grid %d)\n", hipGetErrorString(e), grid);
#else
#ifndef PHSEQ
#define PHSEQ 0,1,2,3,4,5,6
#endif
    { const int seq[] = {PHSEQ};
      for (unsigned i = 0; i < sizeof(seq) / sizeof(int); ++i) { a.ph_lo = seq[i]; a.ph_hi = seq[i] + 1; (void)hipMemsetAsync((char*)d_ws + WS_CTL, 0, 65536, stream); hipLaunchKernelGGL(mega, dim3(grid), dim3(512), LDS_BYTES, stream, a); } }
#endif
}
```

```cpp
#include <hip/hip_runtime.h>
#include <hip/hip_cooperative_groups.h>
#include <cstdio>
#include <cstdint>
namespace cg = cooperative_groups;
#define N_LAUNCHES 1
namespace pg8 {
#define PG8_LAS __attribute__((address_space(3)))
typedef unsigned short bf16_t;
typedef short bf16x8 __attribute__((ext_vector_type(8)));
typedef float f32x4 __attribute__((ext_vector_type(4)));
typedef unsigned u32x4 __attribute__((ext_vector_type(4)));
constexpr int BM = 256, BK = 64, HALF = 128, HTB = HALF * BK * 2  , STAGE_BYTES = 8 * HTB, NXCD = 8, WGM = 8;

__host__ __device__ __forceinline__ int lds_byte(int r, int c) { const int st = (r >> 4) * 2 + (c >> 5), rr = r & 15, cc = c & 31, ob = rr * 64 + cc * 2; return st * 1024 + (ob ^ (((ob >> 9) & 1) << 5)); }
__host__ __device__ __forceinline__ void stage_rc(int b, int& R, int& C) { const int st = b / 1024, sb = b % 1024, swz = sb ^ (((sb >> 9) & 1) << 5); R = (st >> 1) * 16 + swz / 64; C = (st & 1) * 32 + (swz % 64) / 2; }
__host__ __device__ __forceinline__ int perm32(int rho) { const int n = rho >> 4, i = rho & 15; return 8 * (i >> 2) + 4 * n + (i & 3); }

struct Unit { int pm, pn; };
struct Gemm { const bf16_t* A; const bf16_t* Bt; int M, N, K; };

struct StaticOrder {
    int nM, nN, nwg, G, c;
    __host__ __device__ void init(int M, int N, int G_, int c_) { nM = M / BM; nN = N / BM; nwg = nM * nN; G = G_; c = c_; }
    __host__ __device__ bool next(int i, Unit& u) const {
        const long L = (long)i * G + c; if (L >= nwg) return false;
        int wgid = (int)L; { const int q = nwg / NXCD, r = nwg % NXCD, xcd = wgid % NXCD, off = wgid / NXCD; wgid = (xcd < r ? xcd * (q + 1) : r * (q + 1) + (xcd - r) * q) + off; }
        const int nig = WGM * nN, gid = wgid / nig, fm = gid * WGM, gsz = (nM - fm) < WGM ? (nM - fm) : WGM;
        u.pm = fm + ((wgid % nig) % gsz); u.pn = (wgid % nig) / gsz; return true;
    }
    __device__ __forceinline__ void a_ready(const Unit&) const {}
    __device__ __forceinline__ void done(const Unit&) const {}
};

__device__ __forceinline__ unsigned cvt_pk_bf16(float lo, float hi) { unsigned r; asm volatile("v_cvt_pk_bf16_f32 %0, %1, %2" : "=v"(r) : "v"(lo), "v"(hi)); return r; }
typedef float f32x2 __attribute__((ext_vector_type(2)));
__device__ __forceinline__ f32x2 gelu_pk(f32x2 v) {
    const f32x2 av = __builtin_elementwise_abs(v), d = av * 0.2316418882f + 1.0f;
    f32x2 t; t.x = __builtin_amdgcn_rcpf(d.x); t.y = __builtin_amdgcn_rcpf(d.y);
    f32x2 q = t * 0.5307027145f + (-0.7265760135f); q = q * t + 0.7107068705f; q = q * t + (-0.142248368f); q = q * t + 0.127414796f; q = q * t;
    const f32x2 s = (v * v) * (-0.72134752044f);
    f32x2 e; e.x = __builtin_amdgcn_exp2f(s.x); e.y = __builtin_amdgcn_exp2f(s.y);
    const f32x2 m = v * (q * e), r = v - m;
    f32x2 o; o.x = v.x < 0.f ? m.x : r.x; o.y = v.y < 0.f ? m.y : r.y; return o;
}

template <int ACT  > struct EpiBf16 {
    static constexpr bool PERM = true, AFTER_DRAIN = false, HOLD_LAST = false; static_assert(ACT == 0 || ACT == 1, "EpiBf16: ACT is 0 (none) or 1 (gelu_pk)");
    bf16_t* O; int ldc; const float* bias; int split_cols; size_t split_stride; float scale0;
    __device__ __forceinline__ void operator()(const f32x4 (&acc)[2][2][4][2], const Unit& u, int wr, int wc, int fr, int fq) const {
        const int row0 = u.pm * BM + wr * 64 + fr; int colt = u.pn * BM; bf16_t* base = O;
        float sc = 1.f; if (split_cols) { const int t = colt / split_cols; base += (size_t)t * split_stride; colt -= t * split_cols; if (t == 0) sc = scale0; }
        const int col0 = colt + wc * 32 + 8 * fq, bcol0 = u.pn * BM + wc * 32 + 8 * fq;
        f32x4 bv[2][2];
#pragma unroll
        for (int bj = 0; bj < 2; ++bj)
#pragma unroll
            for (int n = 0; n < 2; ++n) bv[bj][n] = bias ? *(const f32x4*)(bias + bcol0 + bj * HALF + 4 * n) : (f32x4){0.f, 0.f, 0.f, 0.f};
#pragma unroll
        for (int ai = 0; ai < 2; ++ai)
#pragma unroll
            for (int m = 0; m < 4; ++m) { bf16_t* rowp = base + (size_t)(row0 + ai * HALF + m * 16) * ldc + col0;
#pragma unroll
                for (int bj = 0; bj < 2; ++bj) { f32x4 v0 = acc[ai][bj][m][0] + bv[bj][0], v1 = acc[ai][bj][m][1] + bv[bj][1];
                    if (ACT == 1) { f32x2 a = gelu_pk((f32x2){v0[0], v0[1]}), b = gelu_pk((f32x2){v0[2], v0[3]}), c = gelu_pk((f32x2){v1[0], v1[1]}), d = gelu_pk((f32x2){v1[2], v1[3]});
                        v0 = (f32x4){a.x, a.y, b.x, b.y}; v1 = (f32x4){c.x, c.y, d.x, d.y}; }
                    v0 = v0 * sc; v1 = v1 * sc; u32x4 w; w.x = cvt_pk_bf16(v0[0], v0[1]); w.y = cvt_pk_bf16(v0[2], v0[3]); w.z = cvt_pk_bf16(v1[0], v1[1]); w.w = cvt_pk_bf16(v1[2], v1[3]);
                    *(u32x4*)(rowp + bj * HALF) = w; } }
    }
};
template <class Epi, class Sched, bool ALIGN_EPI = false, bool SP2 = false>
__device__ __forceinline__ void gemm_phase(PG8_LAS unsigned char* lds, const Gemm g, const Sched& S, const Epi& E) {
    int tid_ = threadIdx.x; asm volatile("" : "+v"(tid_)); const int tid = tid_, wid = __builtin_amdgcn_readfirstlane(tid >> 6), lane = tid & 63, wr = wid >> 2, wc = wid & 3, fr = lane & 15, fq = lane >> 4;
    const int K = g.K, nt = K / BK;
    unsigned voffA[2], voffB[2];
#pragma unroll
    for (int i = 0; i < 2; ++i) { int R, C; stage_rc(tid * 16 + i * 8192, R, C); const int Rb = Epi::PERM ? ((R & ~31) + perm32(R & 31)) : R;
        voffA[i] = (unsigned)(R * K + C) * 2u; voffB[i] = (unsigned)(Rb * K + C) * 2u; }
    const size_t kstep = (size_t)(BK * 2);
    const size_t hstep = (size_t)HALF * K * 2;
    const size_t tstep = 2 * hstep;
    const unsigned ldsw = (unsigned)wid * 1024u;
    const int aoff = lds_byte(wr * 64 + fr, fq * 8), boff = lds_byte(wc * 32 + fr, fq * 8);
#define PG8_SA(b, h) (((b) * 2 + (h)) * HTB)
#define PG8_SB(b, h) ((4 + (b) * 2 + (h)) * HTB)
#define PG8_STAGE(bufoff, gbase, voff) do { _Pragma("unroll") for (int _i = 0; _i < 2; ++_i) \
        __builtin_amdgcn_global_load_lds((const unsigned*)((const char*)(gbase) + (voff)[_i]), (PG8_LAS unsigned*)(lds + (bufoff) + ldsw + _i * 8192), 16, 0, 0); } while (0)
#define PG8_LDA(dst, b, h) do { _Pragma("unroll") for (int m = 0; m < 4; ++m) _Pragma("unroll") for (int k = 0; k < 2; ++k) dst[m][k] = *(const PG8_LAS bf16x8*)(lds + PG8_SA(b, h) + aoff + m * 2048 + k * 1024); } while (0)
#define PG8_LDB(dst, b, h) do { _Pragma("unroll") for (int n = 0; n < 2; ++n) _Pragma("unroll") for (int k = 0; k < 2; ++k) dst[n][k] = *(const PG8_LAS bf16x8*)(lds + PG8_SB(b, h) + boff + n * 2048 + k * 1024); } while (0)
#define PG8_MMA(ai, bj, At, Bt) do { __builtin_amdgcn_s_setprio(1); _Pragma("unroll") for (int m = 0; m < 4; ++m) _Pragma("unroll") for (int n = 0; n < 2; ++n) _Pragma("unroll") for (int k = 0; k < 2; ++k) \
        acc[ai][bj][m][n] = __builtin_amdgcn_mfma_f32_16x16x32_bf16(Bt[n][k], At[m][k], acc[ai][bj][m][n], 0, 0, 0); __builtin_amdgcn_s_setprio(0); } while (0)
#define PG8_WAIT_V(n) asm volatile("s_waitcnt vmcnt(" #n ")" ::: "memory")
#define PG8_WAIT_L(n) asm volatile("s_waitcnt lgkmcnt(" #n ")" ::: "memory")
#define PG8_BAR __builtin_amdgcn_s_barrier()
#define PG8_SCHED __builtin_amdgcn_sched_barrier(0)
    Unit cur, nxt; int ui = 0;
    if (!S.next(0, cur)) return;
    f32x4 acc[2][2][4][2];
#pragma unroll
    for (int a = 0; a < 2; ++a)
#pragma unroll
        for (int b = 0; b < 2; ++b)
#pragma unroll
            for (int m = 0; m < 4; ++m)
#pragma unroll
                for (int n = 0; n < 2; ++n) acc[a][b][m][n] = (f32x4){0.f, 0.f, 0.f, 0.f};
    bf16x8 At[4][2], B0[2][2], B1[2][2];
    const char* cA = (const char*)g.A + (size_t)cur.pm * tstep; const char* cB = (const char*)g.Bt + (size_t)cur.pn * tstep;
    S.a_ready(cur);
    if constexpr (SP2) {
        PG8_STAGE(PG8_SB(0, 0), cB, voffB); PG8_STAGE(PG8_SB(0, 1), cB + hstep, voffB); PG8_STAGE(PG8_SA(0, 0), cA, voffA); PG8_STAGE(PG8_SA(0, 1), cA + hstep, voffA);
        if (wr == 1) PG8_BAR;
        PG8_WAIT_V(2); PG8_BAR;
        PG8_STAGE(PG8_SB(1, 0), cB + kstep, voffB); PG8_STAGE(PG8_SA(1, 0), cA + kstep, voffA); PG8_STAGE(PG8_SB(1, 1), cB + hstep + kstep, voffB);
        PG8_WAIT_V(6); PG8_BAR;
    } else {
        PG8_STAGE(PG8_SB(0, 0), cB, voffB); PG8_STAGE(PG8_SA(0, 0), cA, voffA); PG8_STAGE(PG8_SB(0, 1), cB + hstep, voffB); PG8_STAGE(PG8_SA(0, 1), cA + hstep, voffA);
        if (wr == 1) PG8_BAR;
        PG8_WAIT_V(4); PG8_BAR;
        PG8_STAGE(PG8_SB(1, 0), cB + kstep, voffB); PG8_STAGE(PG8_SA(1, 0), cA + kstep, voffA); PG8_STAGE(PG8_SB(1, 1), cB + hstep + kstep, voffB);
        PG8_WAIT_V(6); PG8_BAR;
    }
    for (;;) {
        const bool has_next = S.next(ui + 1, nxt);
        const char* nA = has_next ? (const char*)g.A + (size_t)nxt.pm * tstep : cA; const char* nB = has_next ? (const char*)g.Bt + (size_t)nxt.pn * tstep : cB;
        for (int t = 0; t < nt; t += 2) {
            const bool last = (t == nt - 2);
            const char* a1 = cA + (size_t)(t + 1) * kstep;
            const char* a2 = last ? nA : cA + (size_t)(t + 2) * kstep; const char* b2 = last ? nB : cB + (size_t)(t + 2) * kstep;
            const char* a3 = a2 + kstep; const char* b3 = b2 + kstep;
            if (last && has_next) S.a_ready(nxt);
            if constexpr (SP2) {
            PG8_LDB(B0, 0, 0); PG8_LDB(B1, 0, 1); PG8_SCHED; PG8_LDA(At, 0, 0); PG8_STAGE(PG8_SA(1, 1), a1 + hstep, voffA);
            PG8_WAIT_V(8); PG8_WAIT_L(0); PG8_BAR; PG8_MMA(0, 0, At, B0); PG8_MMA(0, 1, At, B1); PG8_BAR; PG8_SCHED;
            PG8_LDA(At, 0, 1); PG8_STAGE(PG8_SB(0, 0), b2, voffB); PG8_STAGE(PG8_SB(0, 1), b2 + hstep, voffB); PG8_STAGE(PG8_SA(0, 0), a2, voffA);
            PG8_WAIT_V(8); PG8_WAIT_L(0); PG8_BAR; PG8_MMA(1, 0, At, B0); PG8_MMA(1, 1, At, B1); PG8_BAR; PG8_SCHED;
            PG8_LDB(B0, 1, 0); PG8_LDB(B1, 1, 1); PG8_SCHED; PG8_LDA(At, 1, 0); PG8_STAGE(PG8_SA(0, 1), a2 + hstep, voffA);
            PG8_WAIT_V(8); PG8_WAIT_L(0); PG8_BAR; PG8_MMA(0, 0, At, B0); PG8_MMA(0, 1, At, B1); PG8_BAR; PG8_SCHED;
            PG8_LDA(At, 1, 1); PG8_STAGE(PG8_SB(1, 0), b3, voffB); PG8_STAGE(PG8_SB(1, 1), b3 + hstep, voffB); PG8_STAGE(PG8_SA(1, 0), a3, voffA);
            PG8_WAIT_V(8); PG8_WAIT_L(0); PG8_BAR; PG8_MMA(1, 0, At, B0); PG8_MMA(1, 1, At, B1); PG8_BAR; PG8_SCHED;
            } else {
            PG8_LDB(B0, 0, 0); PG8_SCHED; PG8_LDA(At, 0, 0); PG8_STAGE(PG8_SA(1, 1), a1 + hstep, voffA);
            PG8_WAIT_L(8); PG8_BAR; PG8_WAIT_L(0); PG8_MMA(0, 0, At, B0); PG8_BAR; PG8_SCHED;
            PG8_LDB(B1, 0, 1); PG8_STAGE(PG8_SB(0, 0), b2, voffB);
            PG8_BAR; PG8_WAIT_L(0); PG8_MMA(0, 1, At, B1); PG8_BAR;
            PG8_LDA(At, 0, 1); PG8_STAGE(PG8_SA(0, 0), a2, voffA);
            PG8_BAR; PG8_WAIT_L(0); PG8_MMA(1, 0, At, B0); PG8_BAR; PG8_SCHED;
            PG8_STAGE(PG8_SB(0, 1), b2 + hstep, voffB);
            PG8_WAIT_V(6); PG8_BAR; PG8_MMA(1, 1, At, B1); PG8_BAR;
            PG8_LDB(B0, 1, 0); PG8_SCHED; PG8_LDA(At, 1, 0); PG8_STAGE(PG8_SA(0, 1), a2 + hstep, voffA);
            PG8_WAIT_L(8); PG8_BAR; PG8_WAIT_L(0); PG8_MMA(0, 0, At, B0); PG8_BAR; PG8_SCHED;
            PG8_LDB(B1, 1, 1); PG8_STAGE(PG8_SB(1, 0), b3, voffB);
            PG8_BAR; PG8_WAIT_L(0); PG8_MMA(0, 1, At, B1); PG8_BAR;
            PG8_LDA(At, 1, 1); PG8_STAGE(PG8_SA(1, 0), a3, voffA);
            PG8_BAR; PG8_WAIT_L(0); PG8_MMA(1, 0, At, B0); PG8_BAR; PG8_SCHED;
            PG8_STAGE(PG8_SB(1, 1), b3 + hstep, voffB);
            PG8_WAIT_V(6); PG8_BAR; PG8_MMA(1, 1, At, B1); PG8_BAR;
            }
        }
        if constexpr (ALIGN_EPI) { if (wr == 0) PG8_BAR; }
        if constexpr (!Epi::AFTER_DRAIN) { if (!Epi::HOLD_LAST || has_next) { E(acc, cur, wr, wc, fr, fq); S.done(cur); } }
        if (!has_next) break;
#pragma unroll
        for (int a = 0; a < 2; ++a)
#pragma unroll
            for (int b = 0; b < 2; ++b)
#pragma unroll
                for (int m = 0; m < 4; ++m)
#pragma unroll
                    for (int n = 0; n < 2; ++n) acc[a][b][m][n] = (f32x4){0.f, 0.f, 0.f, 0.f};
        cur = nxt; cA = nA; cB = nB; ++ui;
        if constexpr (ALIGN_EPI) { if (wr == 1) PG8_BAR; }
    }
    PG8_WAIT_V(0);
    if constexpr (!ALIGN_EPI) { if (wr == 0) PG8_BAR; }
    PG8_BAR;
    if constexpr (Epi::AFTER_DRAIN || Epi::HOLD_LAST) { E.fused(acc, cur, wr, wc, fr, fq, lds, wid, lane); S.done(cur); }
#undef PG8_SA
#undef PG8_SB
#undef PG8_STAGE
#undef PG8_LDA
#undef PG8_LDB
#undef PG8_MMA
#undef PG8_WAIT_V
#undef PG8_WAIT_L
#undef PG8_BAR
#undef PG8_SCHED
}
}

#ifndef PHMASK
#define PHMASK 127
#endif
#ifndef REPMASK
#define REPMASK 0
#endif
#ifndef P2MASK
#define P2MASK 7
#endif
#ifndef N_LAUNCHES
#define N_LAUNCHES 1
#endif
using pg8::bf16_t; using pg8::bf16x8; using pg8::f32x4; using pg8::u32x4;
#define LAS __attribute__((address_space(3)))
typedef unsigned u32x2 __attribute__((ext_vector_type(2)));
typedef float f32x2 __attribute__((ext_vector_type(2)));

constexpr int SEQ = 8192, DMODEL = 4096, INW = 9216, NMEM = 256;
constexpr int C_QA = 0, C_KA = 2048, C_VA = 2560, C_XL = 3072, C_QM = 4096, C_ZA = 5120, C_ZL = 7168, C_ZM = 8192;
constexpr float EPSN = 1e-6f;
constexpr float LOG2E = 1.4426950408889634f;
constexpr float SC_ATT = 0.08838834764831845f * LOG2E;
constexpr float SC_MEM = 0.0625f * LOG2E;
constexpr int NPH = 7;
constexpr int LDS_BYTES = 147456;

constexpr size_t MiB = 1u << 20;
constexpr size_t WS_CTL = 0, WS_LRUW = 1 * MiB, WS_ROPE = 2 * MiB, WS_MK = 3 * MiB, WS_MVT = 3 * MiB + 512 * 1024, WS_SS = 4 * MiB,
                 WS_AGG1 = 6 * MiB, WS_AGG2 = 10 * MiB, WS_VT = 12 * MiB, WS_WOUT = 20 * MiB, WS_WT = 52 * MiB, WS_U = 140 * MiB,
                 WS_PROJ = 206 * MiB, WS_HS = 350 * MiB, WS_PP = 382 * MiB, WS_YATT = 414 * MiB, WS_YMEM = 446 * MiB, WS_T0 = 462 * MiB, WS_END = 494 * MiB;
constexpr size_t WS_Y = WS_U;

struct Args { const float* in[19]; float* out; unsigned char* ws; int ph_lo, ph_hi; };

__device__ __forceinline__ unsigned pk2(float lo, float hi) { return pg8::cvt_pk_bf16(lo, hi); }
__device__ __forceinline__ float bflo(unsigned u) { return __builtin_bit_cast(float, u << 16); }
__device__ __forceinline__ float bfhi(unsigned u) { return __builtin_bit_cast(float, u & 0xffff0000u); }
__device__ __forceinline__ float wave_sum(float v) {
#pragma unroll
    for (int o = 1; o < 64; o <<= 1) v += __shfl_xor(v, o);
    return v;
}
__device__ __forceinline__ float fexp2(float x) { return __builtin_amdgcn_exp2f(x); }
__device__ __forceinline__ float sigmoidf_(float x) { return 1.f / (1.f + __expf(-x)); }
__device__ __forceinline__ float fsigmoid(float x) { return __builtin_amdgcn_rcpf(1.f + __builtin_amdgcn_exp2f(-x * 1.4426950408889634f)); }
__device__ __forceinline__ f32x4 mfma16(bf16x8 a, bf16x8 b, f32x4 c) { return __builtin_amdgcn_mfma_f32_16x16x32_bf16(a, b, c, 0, 0, 0); }

__device__ __forceinline__ void p0_item_load(const float* W, int N, int item, int lane, float (&r)[32]) {
    const int nblk = N / 32, kb = item / nblk, nb = item % nblk, k0 = 64 * kb, n0 = 32 * nb;
#pragma unroll
    for (int i = 0; i < 32; ++i) { const int kk = 2 * i + (lane >> 5); r[i] = __builtin_nontemporal_load(W + (size_t)(k0 + kk) * N + n0 + (lane & 31)); }
}
__device__ __forceinline__ void p0_item_lds_write(LAS float* scr, int lane, const float (&r)[32]) {
#pragma unroll
    for (int i = 0; i < 32; ++i) { const int kk = 2 * i + (lane >> 5); scr[kk * 33 + (lane & 31)] = r[i]; }
}
__device__ __forceinline__ void p0_item_store(int K, int N, bf16_t* WT, int row_off, LAS float* scr, int item, int lane) {
    const int nblk = N / 32, kb = item / nblk, nb = item % nblk, k0 = 64 * kb, n0 = 32 * nb;
    asm volatile("s_waitcnt lgkmcnt(0)" ::: "memory");
    const int c = lane & 7;
#pragma unroll
    for (int j = 0; j < 4; ++j) { const int n = (lane >> 3) + 8 * j; const LAS float* s = scr + (8 * c) * 33 + n;
        u32x4 o; o.x = pk2(s[0 * 33], s[1 * 33]); o.y = pk2(s[2 * 33], s[3 * 33]); o.z = pk2(s[4 * 33], s[5 * 33]); o.w = pk2(s[6 * 33], s[7 * 33]);
        *(u32x4*)(WT + (size_t)(row_off + n0 + n) * K + k0 + 8 * c) = o; }
    asm volatile("s_waitcnt lgkmcnt(0)" ::: "memory");
}
__device__ __forceinline__ void p0_transpose_item(const float* W, int K, int N, bf16_t* WT, int row_off, LAS float* scr, int item, int lane) {
    float r[32]; p0_item_load(W, N, item, lane, r); p0_item_lds_write(scr, lane, r); p0_item_store(K, N, WT, row_off, scr, item, lane);
}
__device__ __forceinline__ void p0_transpose_matrix(const float* W, int K, int N, bf16_t* WT, int row_off, LAS float* scr, int first, int step, int lane) {
    const int nitems = (K / 64) * (N / 32);
    if (first >= nitems) return;
    float r[32]; p0_item_load(W, N, first, lane, r);
#pragma unroll 1
    for (int it = first; it < nitems; it += step) {
        p0_item_lds_write(scr, lane, r);
        if (it + step < nitems) p0_item_load(W, N, it + step, lane, r);
        p0_item_store(K, N, WT, row_off, scr, it, lane);
    }
}
__device__ __forceinline__ void rms_row_to_bf16(const float* xrow, const f32x4 (&gv)[16], bf16_t* orow, int lane) {
    const f32x4* xr = (const f32x4*)xrow + lane;
    f32x4 v[16]; float s = 0.f;
#pragma unroll
    for (int k = 0; k < 16; ++k) { v[k] = __builtin_nontemporal_load(xr + 64 * k); s += (v[k].x * v[k].x + v[k].y * v[k].y) + (v[k].z * v[k].z + v[k].w * v[k].w); }
    const float rs = 1.f / sqrtf(wave_sum(s) * (1.f / 4096.f) + EPSN);
    u32x2* o8 = (u32x2*)orow + lane;
#pragma unroll
    for (int k = 0; k < 16; ++k) { const f32x4 g4 = gv[k]; u32x2 o; o.x = pk2(v[k].x * rs * g4.x, v[k].y * rs * g4.y); o.y = pk2(v[k].z * rs * g4.z, v[k].w * rs * g4.w); o8[64 * k] = o; }
}

__device__ __forceinline__ void phase0(const Args& a, LAS unsigned char* lds) {
    int tid = threadIdx.x; asm volatile("" : "+v"(tid)); const int lane = tid & 63, w = tid >> 6, G = gridDim.x;
    const int gw = blockIdx.x * 8 + w, NGW = G * 8;
    unsigned char* ws = a.ws;
    LAS float* scr = (LAS float*)(lds + w * 16384);
    bf16_t* WT = (bf16_t*)(ws + WS_WT); bf16_t* WOUT = (bf16_t*)(ws + WS_WOUT); bf16_t* LRUW = (bf16_t*)(ws + WS_LRUW);
    constexpr int I_IN = 64 * (INW / 32), I_MKV = 64 * (2048 / 32), I_OUT = 64 * (4096 / 32), I_LRU = 32 * 8;
    p0_transpose_matrix(a.in[3], 4096, INW, WT, 0, scr, gw, NGW, lane);
    p0_transpose_matrix(a.in[13], 4096, 2048, WT, INW, scr, gw, NGW, lane);
    for (int r = gw; r < I_LRU; r += NGW) {
        const int mat = r >> 3, sub = r & 7, gate = mat >> 4, dn = mat & 15;
        const float* src = (gate ? a.in[9] : a.in[7]) + (size_t)dn * 16384;
        p0_transpose_item(src, 128, 128, LRUW + (size_t)mat * 16384, 0, scr, sub, lane);
    }
    bf16_t* U = (bf16_t*)(ws + WS_U);
    { f32x4 gv[16];
#pragma unroll
      for (int k = 0; k < 16; ++k) gv[k] = ((const f32x4*)a.in[2])[lane + 64 * k];
      for (int m = gw; m < SEQ; m += NGW) rms_row_to_bf16(a.in[0] + (size_t)m * 4096, gv, U + (size_t)m * 4096, lane);
#pragma unroll
      for (int k = 0; k < 16; ++k) gv[k] = ((const f32x4*)a.in[12])[lane + 64 * k];
      for (int m = gw; m < NMEM; m += NGW) rms_row_to_bf16(a.in[1] + (size_t)m * 4096, gv, U + (size_t)(SEQ + m) * 4096, lane); }
    f32x2* rope = (f32x2*)(ws + WS_ROPE);
    for (int e = blockIdx.x * 512 + tid; e < SEQ * 16; e += G * 512) {
        const int pos = e >> 4, i = e & 15;
        const float inv = powf(500000.0f, -(float)i * (1.0f / 16.0f));
        const float ang = (float)pos * inv;
        rope[e] = (f32x2){cosf(ang), sinf(ang)};
    }
}

struct Sched1 {
    pg8::StaticOrder so; int G, c, ioff, imax;
    __device__ void init(int G_, int c_) { so.init(SEQ, INW, G_, c_); G = G_; c = c_; ioff = 0; imax = 1 << 20; }
    __device__ bool next(int i0, pg8::Unit& u) const {
        if (i0 >= imax) return false;
        const int i = i0 + ioff;
        const long L = (long)i * G + c;
        if (L < 1152) return so.next(i, u);
        if (L < 1160) { u.pm = 32; u.pn = 36 + (int)(L - 1152); return true; }
        return false;
    }
    __device__ __forceinline__ void a_ready(const pg8::Unit&) const {}
    __device__ __forceinline__ void done(const pg8::Unit&) const {}
};
struct Epi1 {
    static constexpr bool PERM = true, AFTER_DRAIN = false, HOLD_LAST = false;
    bf16_t* proj; bf16_t* vt; bf16_t* mk; bf16_t* mvt; const float* rope;
    __device__ __forceinline__ void operator()(const f32x4 (&acc)[2][2][4][2], const pg8::Unit& u, int wr, int wc, int fr, int fq) const {
        const int rloc = wr * 64 + fr, cloc = wc * 32 + 8 * fq;
        if (u.pm == 32) {
            const int t = u.pn - 36;
            if (t < 4) {
#pragma unroll
                for (int ai = 0; ai < 2; ++ai)
#pragma unroll
                    for (int m = 0; m < 4; ++m) { const int row = rloc + ai * 128 + m * 16;
#pragma unroll
                        for (int bj = 0; bj < 2; ++bj) { const f32x4 v0 = acc[ai][bj][m][0], v1 = acc[ai][bj][m][1];
                            u32x4 wv; wv.x = pk2(v0[0], v0[1]); wv.y = pk2(v0[2], v0[3]); wv.z = pk2(v1[0], v1[1]); wv.w = pk2(v1[2], v1[3]);
                            *(u32x4*)(mk + (size_t)row * 1024 + t * 256 + bj * 128 + cloc) = wv; } asm volatile("" ::: "memory"); }
            } else {
#pragma unroll
                for (int ai = 0; ai < 2; ++ai)
#pragma unroll
                    for (int m = 0; m < 4; ++m) { const int row = rloc + ai * 128 + m * 16;
#pragma unroll
                        for (int bj = 0; bj < 2; ++bj)
#pragma unroll
                            for (int n = 0; n < 2; ++n)
#pragma unroll
                                for (int i = 0; i < 4; ++i) { const int col = (t - 4) * 256 + bj * 128 + cloc + 4 * n + i;
                                    mvt[(size_t)col * 256 + row] = (bf16_t)(pk2(acc[ai][bj][m][n][i], 0.f) & 0xffffu); } asm volatile("" ::: "memory"); }
            }
            return;
        }
        const int pn = u.pn, row0 = u.pm * 256 + rloc;
        if (pn == 10 || pn == 11) {
#pragma unroll
            for (int ai = 0; ai < 2; ++ai)
#pragma unroll
                for (int m = 0; m < 4; ++m) { const int row = row0 + ai * 128 + m * 16;
#pragma unroll
                    for (int bj = 0; bj < 2; ++bj)
#pragma unroll
                        for (int n = 0; n < 2; ++n)
#pragma unroll
                            for (int i = 0; i < 4; ++i) { const int col = (pn - 10) * 256 + bj * 128 + cloc + 4 * n + i;
                                vt[(size_t)col * SEQ + row] = (bf16_t)(pk2(acc[ai][bj][m][n][i], 0.f) & 0xffffu); } asm volatile("" ::: "memory"); }
            return;
        }
        float sc = 1.f; if (pn < 8) sc = SC_ATT; else if (pn >= 16 && pn < 20) sc = SC_MEM;
        const bool do_rope = (pn < 10) && (wc == 0);
        const float sgn = (fq < 2) ? -1.f : 1.f;
        f32x4 csA[2][2], cst[2][2];
        if (do_rope) {
#pragma unroll
            for (int n = 0; n < 2; ++n) { const int io = (8 * (fq & 1) + 4 * n) * 2;
                const float* ra = rope + (size_t)row0 * 32 + io; const float* rt = rope + 16 * 32 + io;
                csA[n][0] = *(const f32x4*)ra; csA[n][1] = *(const f32x4*)(ra + 4); cst[n][0] = *(const f32x4*)rt; cst[n][1] = *(const f32x4*)(rt + 4); }
        }
#pragma unroll
        for (int ai = 0; ai < 2; ++ai)
#pragma unroll
            for (int m = 0; m < 4; ++m) { const int row = row0 + ai * 128 + m * 16;
                f32x4 cs[2][2];
                if (do_rope) {
                    const int nrot = (ai == 0 && m == 3) ? 5 : 1;
#pragma unroll
                    for (int n = 0; n < 2; ++n)
#pragma unroll
                        for (int hh = 0; hh < 2; ++hh) { f32x4 cur = csA[n][hh]; cs[n][hh] = cur; const f32x4 t = cst[n][hh];
#pragma unroll
                            for (int rr = 0; rr < 5; ++rr) { if (rr < nrot) { f32x4 nx; nx[0] = cur[0] * t[0] - cur[1] * t[1]; nx[1] = cur[1] * t[0] + cur[0] * t[1]; nx[2] = cur[2] * t[2] - cur[3] * t[3]; nx[3] = cur[3] * t[2] + cur[2] * t[3]; cur = nx; } }
                            csA[n][hh] = cur; }
                }
#pragma unroll
                for (int bj = 0; bj < 2; ++bj) { f32x4 v[2]; v[0] = acc[ai][bj][m][0]; v[1] = acc[ai][bj][m][1];
                    if (do_rope) {
#pragma unroll
                        for (int n = 0; n < 2; ++n) { f32x4 p; p[0] = __shfl_xor(v[n][0], 32); p[1] = __shfl_xor(v[n][1], 32); p[2] = __shfl_xor(v[n][2], 32); p[3] = __shfl_xor(v[n][3], 32);
                            f32x4 r; r[0] = v[n][0] * cs[n][0][0] + sgn * p[0] * cs[n][0][1]; r[1] = v[n][1] * cs[n][0][2] + sgn * p[1] * cs[n][0][3];
                            r[2] = v[n][2] * cs[n][1][0] + sgn * p[2] * cs[n][1][1]; r[3] = v[n][3] * cs[n][1][2] + sgn * p[3] * cs[n][1][3]; v[n] = r; }
                    }
                    u32x4 wv; wv.x = pk2(v[0][0] * sc, v[0][1] * sc); wv.y = pk2(v[0][2] * sc, v[0][3] * sc); wv.z = pk2(v[1][0] * sc, v[1][1] * sc); wv.w = pk2(v[1][2] * sc, v[1][3] * sc);
                    __builtin_nontemporal_store(wv, (u32x4*)(proj + (size_t)row * INW + pn * 256 + bj * 128 + cloc)); } asm volatile("" ::: "memory"); }
    }
};

template <int DH, bool PF, bool DB>
__device__ __forceinline__ void attn_unit(LAS unsigned char* lds, const bf16_t* Qp, int ldq, bf16_t* Op, int ldo, const bf16_t* Kg, int ldk, const bf16_t* Vtg, int ldv,
                                          int cb_lo, int cb_hi, int cb_self, float m_init, float l_init) {
    constexpr int PR = DH / 8, KROW = DH * 2, KT = 128 * KROW, VROW = 288, NKI = (128 * PR) / 512, NVI = (DH * 16) / 512, NS = DH / 32, NDT = DH / 16;
    int tid = threadIdx.x; asm volatile("" : "+v"(tid)); const int lane = tid & 63, w = tid >> 6, q = lane & 15, g = lane >> 4;
    const int krow = 8 * (q >> 2) + (q & 3);
    bf16x8 qf[NS];
    { const unsigned qoff = (unsigned)(((16 * w + q) * ldq + 8 * g) * 2);
#pragma unroll
      for (int s = 0; s < NS; ++s) qf[s] = __builtin_nontemporal_load((const bf16x8*)((const char*)Qp + qoff + 64 * s)); }
    f32x4 o[NDT];
#pragma unroll
    for (int dt = 0; dt < NDT; ++dt) o[dt] = (f32x4){0.f, 0.f, 0.f, 0.f};
    float m_run = m_init, l_run = l_init;
    u32x4 kreg[NKI], vreg[NVI];
#define ATT_LOAD(cb) do { const int k0_ = (cb) * 128; \
        const char* kb_ = (const char*)Kg + (size_t)k0_ * ldk * 2; const char* vb_ = (const char*)Vtg + (size_t)k0_ * 2; \
        _Pragma("unroll") for (int it = 0; it < NKI; ++it) { const int e = tid + 512 * it; const int key = e / PR, pc = e % PR; \
            kreg[it] = *(const u32x4*)(kb_ + (unsigned)((key * ldk + pc * 8) * 2)); } \
        _Pragma("unroll") for (int it = 0; it < NVI; ++it) { const int e = tid + 512 * it; const int d = e >> 4, pc = e & 15; \
            vreg[it] = *(const u32x4*)(vb_ + (unsigned)((d * ldv + pc * 8) * 2)); } } while (0)
#define ATT_STORE() do { \
        _Pragma("unroll") for (int it = 0; it < NKI; ++it) { const int e = tid + 512 * it; const int key = e / PR, pc = e % PR; \
            *(LAS u32x4*)(lds + key * KROW + ((pc ^ ((((key >> 3) & 3) << 2) | (key & 3))) * 16)) = kreg[it]; } \
        _Pragma("unroll") for (int it = 0; it < NVI; ++it) { const int e = tid + 512 * it; const int d = e >> 4, pc = e & 15; \
            *(LAS u32x4*)(lds + KT + d * VROW + pc * 16) = vreg[it]; } } while (0)
    if (PF) ATT_LOAD(cb_lo);
    for (int cb = cb_lo; cb < cb_hi; ++cb) {
        if (!PF) ATT_LOAD(cb);
        __syncthreads();
        ATT_STORE();
        __syncthreads();
        if (PF) { if (cb + 1 < cb_hi) ATT_LOAD(cb + 1); }
        f32x4 s[8];
#pragma unroll
        for (int kt = 0; kt < 8; ++kt) s[kt] = (f32x4){0.f, 0.f, 0.f, 0.f};
        {
            bf16x8 ka[DB ? 2 : 1][8];
            if (DB) {
#pragma unroll
                for (int kt = 0; kt < 8; ++kt) ka[0][kt] = *(const LAS bf16x8*)(lds + (32 * (kt >> 1) + 4 * (kt & 1) + krow) * KROW + (((0 + g) ^ q) * 16));
            }
#pragma unroll
            for (int ss = 0; ss < NS; ++ss) {
                if (DB) { if (ss + 1 < NS) {
#pragma unroll
                    for (int kt = 0; kt < 8; ++kt) ka[(ss + 1) & 1][kt] = *(const LAS bf16x8*)(lds + (32 * (kt >> 1) + 4 * (kt & 1) + krow) * KROW + (((4 * (ss + 1) + g) ^ q) * 16)); }
                } else {
#pragma unroll
                    for (int kt = 0; kt < 8; ++kt) ka[0][kt] = *(const LAS bf16x8*)(lds + (32 * (kt >> 1) + 4 * (kt & 1) + krow) * KROW + (((4 * ss + g) ^ q) * 16));
                }
                __builtin_amdgcn_sched_barrier(0);
#pragma unroll
                for (int kt = 0; kt < 8; ++kt) s[kt] = mfma16(ka[DB ? (ss & 1) : 0][kt], qf[ss], s[kt]);
                __builtin_amdgcn_sched_barrier(0);
            }
        }
        if (cb != cb_self && cb_self >= 0) {
            const float sg = (cb < cb_self) ? 1.f : -1.f;
            const float dq = (float)(16 * w + q - 8 * g);
#pragma unroll
            for (int kt = 0; kt < 8; ++kt)
#pragma unroll
                for (int j = 0; j < 4; ++j) { const float v = sg * ((float)(32 * (kt >> 1) + 4 * (kt & 1) + j) - dq); s[kt][j] += fminf(v, 0.f) * 1e30f; }
        }
        float mx = s[0][0];
#pragma unroll
        for (int kt = 0; kt < 8; ++kt)
#pragma unroll
            for (int j = 0; j < 4; ++j) mx = fmaxf(mx, s[kt][j]);
        mx = fmaxf(mx, __shfl_xor(mx, 16)); mx = fmaxf(mx, __shfl_xor(mx, 32));
        const float m_new = fmaxf(m_run, mx), alpha = fexp2(m_run - m_new); m_run = m_new;
        float rs = 0.f;
#pragma unroll
        for (int kt = 0; kt < 8; ++kt)
#pragma unroll
            for (int j = 0; j < 4; ++j) { const float p = fexp2(s[kt][j] - m_new); s[kt][j] = p; rs += p; }
        rs += __shfl_xor(rs, 16); rs += __shfl_xor(rs, 32);
        l_run = l_run * alpha + rs;
        bf16x8 pb[4];
#pragma unroll
        for (int u = 0; u < 4; ++u) { u32x4 t; t.x = pk2(s[2 * u][0], s[2 * u][1]); t.y = pk2(s[2 * u][2], s[2 * u][3]); t.z = pk2(s[2 * u + 1][0], s[2 * u + 1][1]); t.w = pk2(s[2 * u + 1][2], s[2 * u + 1][3]);
            pb[u] = __builtin_bit_cast(bf16x8, t); }
#pragma unroll
        for (int dt = 0; dt < NDT; ++dt) o[dt] = o[dt] * alpha;
        {
            constexpr int NG = (NDT / 8) * 4;
            u32x4 va[DB ? 2 : 1][8];
#define ATT_VLOAD(buf, gi) do { const int u_ = (gi) & 3, d0_ = 8 * ((gi) >> 2); \
            _Pragma("unroll") for (int i = 0; i < 8; ++i) { va[buf][i] = *(const LAS u32x4*)(lds + KT + (16 * (d0_ + i) + q) * VROW + (32 * u_ + 8 * g) * 2); } } while (0)
            if (DB) ATT_VLOAD(0, 0);
#pragma unroll
            for (int gi = 0; gi < NG; ++gi) {
                if (DB) { if (gi + 1 < NG) ATT_VLOAD((gi + 1) & 1, gi + 1); } else ATT_VLOAD(0, gi);
                __builtin_amdgcn_sched_barrier(0);
#pragma unroll
                for (int i = 0; i < 8; ++i) o[8 * (gi >> 2) + i] = mfma16(__builtin_bit_cast(bf16x8, va[DB ? (gi & 1) : 0][i]), pb[gi & 3], o[8 * (gi >> 2) + i]);
                __builtin_amdgcn_sched_barrier(0);
            }
#undef ATT_VLOAD
        }
    }
#undef ATT_LOAD
#undef ATT_STORE
    const float inv = 1.f / l_run;
    const unsigned ooff = (unsigned)(((16 * w + q) * ldo + 4 * g) * 2);
#pragma unroll
    for (int dt = 0; dt < NDT; ++dt) { u32x2 pkv; pkv.x = pk2(o[dt][0] * inv, o[dt][1] * inv); pkv.y = pk2(o[dt][2] * inv, o[dt][3] * inv); *(u32x2*)((char*)Op + ooff + 32 * dt) = pkv; }
}

__device__ __forceinline__ void windowed_stream(LAS unsigned char* lds0, const Args& a) {
    constexpr int DH = 128, PR = 16, KROW = 256, KT = 128 * KROW, VROW = 288, BUFB = KT + DH * VROW, NKI = 4, NVI = 4, NS = 4, NDT = 8;
    static_assert(2 * BUFB <= LDS_BYTES - 64, "two K/V tile buffers must fit under the barrier words");
    int tid = threadIdx.x; asm volatile("" : "+v"(tid)); const int lane = tid & 63, w = tid >> 6, q = lane & 15, g = lane >> 4;
    const int krow = 8 * (q >> 2) + (q & 3);
    unsigned char* ws = a.ws;
    const bf16_t* proj = (const bf16_t*)(ws + WS_PROJ); const bf16_t* vt = (const bf16_t*)(ws + WS_VT); bf16_t* yatt = (bf16_t*)(ws + WS_YATT);
    const int G = (int)gridDim.x;
    if ((int)blockIdx.x >= 1024) return;
    unsigned koff[NKI], voff[NVI], klds[NKI], vlds[NVI];
#pragma unroll
    for (int it = 0; it < NKI; ++it) { const int e = tid + 512 * it, key = e / PR, pc = e % PR; koff[it] = (unsigned)((key * INW + pc * 8) * 2); klds[it] = (unsigned)(key * KROW + ((pc ^ ((((key >> 3) & 3) << 2) | (key & 3))) * 16)); }
#pragma unroll
    for (int it = 0; it < NVI; ++it) { const int e = tid + 512 * it, d = e >> 4, pc = e & 15; voff[it] = (unsigned)((d * SEQ + pc * 8) * 2); vlds[it] = (unsigned)(KT + d * VROW + pc * 16); }
    u32x4 kreg[NKI], vreg[NVI];
#define WS_LOAD(v_, cb_) do { const int kvh_ = ((v_) & 15) >> 2; \
        const char* kb_ = (const char*)proj + ((size_t)((cb_) * 128) * INW + C_KA + kvh_ * 128) * 2; const char* vb_ = (const char*)vt + ((size_t)(kvh_ * 128) * SEQ + (cb_) * 128) * 2; \
        _Pragma("unroll") for (int it = 0; it < NKI; ++it) kreg[it] = *(const u32x4*)(kb_ + koff[it]); \
        _Pragma("unroll") for (int it = 0; it < NVI; ++it) vreg[it] = *(const u32x4*)(vb_ + voff[it]); } while (0)
#define WS_STORE(ldsb_) do { \
        _Pragma("unroll") for (int it = 0; it < NKI; ++it) *(LAS u32x4*)((ldsb_) + klds[it]) = kreg[it]; \
        _Pragma("unroll") for (int it = 0; it < NVI; ++it) *(LAS u32x4*)((ldsb_) + vlds[it]) = vreg[it]; } while (0)
#define WS_LO(v_) ((((v_) >> 4) > 0) ? ((v_) >> 4) - 1 : 0)
#define WS_HI(v_) ((((v_) >> 4) < 63) ? ((v_) >> 4) + 2 : 64)
    int Cv = (int)blockIdx.x, Ccb = WS_LO(Cv);
    int Lv = Cv, Lcb = Ccb; bool Lvalid = true;
#define WS_ADV_L() do { if (Lcb + 1 < WS_HI(Lv)) ++Lcb; else { Lv += G; if (Lv < 1024) Lcb = WS_LO(Lv); else Lvalid = false; } } while (0)
    __syncthreads();
    WS_LOAD(Lv, Lcb); WS_ADV_L();
    WS_STORE(lds0);
    bool have = false;
    if (Lvalid) { WS_LOAD(Lv, Lcb); WS_ADV_L(); have = true; }
    __syncthreads();
    int bsel = 0;
    bf16x8 qf[NS]; f32x4 o[NDT]; float m_run = 0.f, l_run = 1.f;
#pragma unroll 1
    for (;;) {
        const int qblk = Cv >> 4, hq = Cv & 15, lo = WS_LO(Cv), hi = WS_HI(Cv);
        LAS unsigned char* lds = lds0 + bsel * BUFB;
        if (Ccb == lo) {
            const unsigned qoff = (unsigned)(((16 * w + q) * INW + 8 * g) * 2);
            const char* qb = (const char*)proj + ((size_t)(qblk * 128) * INW + C_QA + hq * 128) * 2;
#pragma unroll
            for (int s = 0; s < NS; ++s) qf[s] = __builtin_nontemporal_load((const bf16x8*)(qb + qoff + 64 * s));
#pragma unroll
            for (int dt = 0; dt < NDT; ++dt) o[dt] = (f32x4){0.f, 0.f, 0.f, 0.f};
            m_run = a.in[4][hq] * LOG2E; l_run = 1.f;
        }
        if (have) { WS_STORE(lds0 + (bsel ^ 1) * BUFB); have = false; }
        if (Lvalid) { WS_LOAD(Lv, Lcb); WS_ADV_L(); have = true; }
        f32x4 s[8];
#pragma unroll
        for (int kt = 0; kt < 8; ++kt) s[kt] = (f32x4){0.f, 0.f, 0.f, 0.f};
        {
            bf16x8 ka[2][8];
#pragma unroll
            for (int kt = 0; kt < 8; ++kt) ka[0][kt] = *(const LAS bf16x8*)(lds + (32 * (kt >> 1) + 4 * (kt & 1) + krow) * KROW + (((0 + g) ^ q) * 16));
#pragma unroll
            for (int ss = 0; ss < NS; ++ss) {
                if (ss + 1 < NS) {
#pragma unroll
                    for (int kt = 0; kt < 8; ++kt) ka[(ss + 1) & 1][kt] = *(const LAS bf16x8*)(lds + (32 * (kt >> 1) + 4 * (kt & 1) + krow) * KROW + (((4 * (ss + 1) + g) ^ q) * 16)); }
                __builtin_amdgcn_sched_barrier(0);
#pragma unroll
                for (int kt = 0; kt < 8; ++kt) s[kt] = mfma16(ka[ss & 1][kt], qf[ss], s[kt]);
                __builtin_amdgcn_sched_barrier(0);
            }
        }
        if (Ccb != qblk) {
            const bool prev = Ccb < qblk; const int ud = __builtin_amdgcn_readfirstlane(w) >> 1;
            const float sg = prev ? 1.f : -1.f;
            const float dq = (float)(16 * w + q - 8 * g);
#pragma unroll
            for (int u = 0; u < 4; ++u) {
                if (prev ? (u < ud) : (u > ud)) {
#pragma unroll
                    for (int j = 0; j < 4; ++j) { s[2 * u][j] = -1e30f; s[2 * u + 1][j] = -1e30f; }
                } else if (u == ud) {
#pragma unroll
                    for (int h2 = 0; h2 < 2; ++h2)
#pragma unroll
                        for (int j = 0; j < 4; ++j) { const float v = sg * ((float)(32 * u + 4 * h2 + j) - dq); s[2 * u + h2][j] += fminf(v, 0.f) * 1e30f; }
                }
            }
        }
        float mx = s[0][0];
#pragma unroll
        for (int kt = 0; kt < 8; ++kt)
#pragma unroll
            for (int j = 0; j < 4; ++j) mx = fmaxf(mx, s[kt][j]);
        mx = fmaxf(mx, __shfl_xor(mx, 16)); mx = fmaxf(mx, __shfl_xor(mx, 32));
        const float m_new = fmaxf(m_run, mx), alpha = fexp2(m_run - m_new); m_run = m_new;
        float rs = 0.f;
#pragma unroll
        for (int kt = 0; kt < 8; ++kt)
#pragma unroll
            for (int j = 0; j < 4; ++j) { const float p = fexp2(s[kt][j] - m_new); s[kt][j] = p; rs += p; }
        rs += __shfl_xor(rs, 16); rs += __shfl_xor(rs, 32);
        l_run = l_run * alpha + rs;
        bf16x8 pb[4];
#pragma unroll
        for (int u = 0; u < 4; ++u) { u32x4 t; t.x = pk2(s[2 * u][0], s[2 * u][1]); t.y = pk2(s[2 * u][2], s[2 * u][3]); t.z = pk2(s[2 * u + 1][0], s[2 * u + 1][1]); t.w = pk2(s[2 * u + 1][2], s[2 * u + 1][3]);
            pb[u] = __builtin_bit_cast(bf16x8, t); }
#pragma unroll
        for (int dt = 0; dt < NDT; ++dt) o[dt] = o[dt] * alpha;
        {
            u32x4 va[2][8];
#define WS_VLOAD(buf, gi) do { _Pragma("unroll") for (int i = 0; i < 8; ++i) { va[buf][i] = *(const LAS u32x4*)(lds + KT + (16 * i + q) * VROW + (32 * (gi) + 8 * g) * 2); } } while (0)
            WS_VLOAD(0, 0);
#pragma unroll
            for (int gi = 0; gi < 4; ++gi) {
                if (gi + 1 < 4) WS_VLOAD((gi + 1) & 1, gi + 1);
                __builtin_amdgcn_sched_barrier(0);
#pragma unroll
                for (int i = 0; i < 8; ++i) o[i] = mfma16(__builtin_bit_cast(bf16x8, va[gi & 1][i]), pb[gi], o[i]);
                __builtin_amdgcn_sched_barrier(0);
            }
#undef WS_VLOAD
        }
        bool done = false;
        if (Ccb + 1 < hi) ++Ccb;
        else {
            const float inv = 1.f / l_run;
            char* ob = (char*)yatt + ((size_t)(qblk * 128) * 2048 + hq * 128) * 2;
            const unsigned ooff = (unsigned)(((16 * w + q) * 2048 + 4 * g) * 2);
#pragma unroll
            for (int dt = 0; dt < NDT; ++dt) { u32x2 pkv; pkv.x = pk2(o[dt][0] * inv, o[dt][1] * inv); pkv.y = pk2(o[dt][2] * inv, o[dt][3] * inv); *(u32x2*)(ob + ooff + 32 * dt) = pkv; }
            Cv += G; if (Cv < 1024) Ccb = WS_LO(Cv); else done = true;
        }
        __syncthreads();
        bsel ^= 1;
        if (done) break;
    }
#undef WS_LOAD
#undef WS_STORE
#undef WS_LO
#undef WS_HI
#undef WS_ADV_L
}

constexpr int LR_XCB = 0, LR_TA = 16384, LR_TB = LR_TA + 64 * 528, LR_TH = LR_TB + 64 * 528, LR_AGS = LR_TH + 64 * 528;
template <int VAR>
__device__ __forceinline__ void lru_phase(LAS unsigned char* lds, const Args& a, const int n, const int tt_first, const int tt_step) {
    int tid = threadIdx.x; asm volatile("" : "+v"(tid)); const int lane = tid & 63, w0 = tid >> 6, q0 = lane & 15, g0 = lane >> 4;
    unsigned char* ws = a.ws;
    const bf16_t* proj = (const bf16_t*)(ws + WS_PROJ);
    LAS unsigned char* xcb = lds + LR_XCB;
    LAS float* TA = (LAS float*)(lds + LR_TA); LAS float* TB = (LAS float*)(lds + LR_TB); LAS float* TH = (LAS float*)(lds + LR_TH);
    LAS f32x2* AGS = (LAS f32x2*)(lds + LR_AGS);
    const bf16_t* lruw = (const bf16_t*)(ws + WS_LRUW);
    f32x2* agg1 = (f32x2*)(ws + (VAR ? WS_T0 : WS_AGG1));
    bf16_t* Pout = (bf16_t*)(ws + (VAR ? WS_U + 32 * MiB : WS_PP));
    bf16x8 fa[2][4], fx[2][4];
#pragma unroll
    for (int dir = 0; dir < 2; ++dir) {
        const bf16_t* wa = lruw + (size_t)((0 * 2 + dir) * 8 + n) * 16384 + (16 * w0 + q0) * 128 + 8 * g0;
        const bf16_t* wx = lruw + (size_t)((1 * 2 + dir) * 8 + n) * 16384 + (16 * w0 + q0) * 128 + 8 * g0;
#pragma unroll
        for (int s = 0; s < 4; ++s) { fa[dir][s] = *(const bf16x8*)(wa + 32 * s); fx[dir][s] = *(const bf16x8*)(wx + 32 * s); }
    }
    const int cg8 = tid & 15, t2 = tid >> 4, ch0 = n * 128 + cg8 * 8;
    LAS float* CW = (LAS float*)(lds + LR_AGS + 4096);
    __syncthreads();
    if (tid < 128) {
#pragma unroll
        for (int j = 0; j < 4; ++j) CW[j * 128 + tid] = a.in[5][j * 1024 + n * 128 + tid];
        CW[512 + tid] = a.in[6][n * 128 + tid];
    } else if (tid < 384) {
        const int d2 = (tid - 128) >> 7, c = tid & 127, cg = d2 * 1024 + n * 128 + c;
        const float xl = -a.in[11][cg];
        CW[640 + (d2 * 3 + 0) * 128 + c] = a.in[8][cg]; CW[640 + (d2 * 3 + 1) * 128 + c] = a.in[10][cg];
        CW[640 + (d2 * 3 + 2) * 128 + c] = fmaxf(xl, 0.f) + log1pf(expf(-fabsf(xl)));
    }
    u32x4 xr[5];
#define LRU_XLOAD(tt_) do { _Pragma("unroll") for (int r = 0; r < 5; ++r) { const int t = (tt_) * 64 + 2 * t2 - 2 + r; xr[r] = (u32x4){0u, 0u, 0u, 0u}; \
        if (t >= 0 && t < SEQ) xr[r] = __builtin_nontemporal_load((const u32x4*)((const char*)proj + (unsigned)((t * INW + C_XL + ch0) * 2))); } } while (0)
    float A2f = 1.f, H2f = 0.f, A2b = 1.f, H2b = 0.f;
    LRU_XLOAD(tt_first);
#pragma unroll 1
    for (int tt = tt_first; tt < tt_first + 4; ++tt) {
    const int t0 = tt * 64;
    __syncthreads();
    {
        float xin[5][8];
#pragma unroll
        for (int r = 0; r < 5; ++r) { const u32x4 v = xr[r];
            xin[r][0] = bflo(v.x); xin[r][1] = bfhi(v.x); xin[r][2] = bflo(v.y); xin[r][3] = bfhi(v.y); xin[r][4] = bflo(v.z); xin[r][5] = bfhi(v.z); xin[r][6] = bflo(v.w); xin[r][7] = bfhi(v.w); }
        float wv[4][8], bias[8];
#pragma unroll
        for (int j = 0; j < 4; ++j) { const f32x4 w0 = *(const LAS f32x4*)(CW + j * 128 + cg8 * 8), w1 = *(const LAS f32x4*)(CW + j * 128 + cg8 * 8 + 4);
            wv[j][0] = w0[0]; wv[j][1] = w0[1]; wv[j][2] = w0[2]; wv[j][3] = w0[3]; wv[j][4] = w1[0]; wv[j][5] = w1[1]; wv[j][6] = w1[2]; wv[j][7] = w1[3]; }
        { const f32x4 b0 = *(const LAS f32x4*)(CW + 512 + cg8 * 8), b1 = *(const LAS f32x4*)(CW + 512 + cg8 * 8 + 4);
          bias[0] = b0[0]; bias[1] = b0[1]; bias[2] = b0[2]; bias[3] = b0[3]; bias[4] = b1[0]; bias[5] = b1[1]; bias[6] = b1[2]; bias[7] = b1[3]; }
#pragma unroll
        for (int o = 0; o < 2; ++o) { float y[8];
#pragma unroll
            for (int e = 0; e < 8; ++e) { float v = bias[e];
#pragma unroll
                for (int j = 0; j < 4; ++j) v += wv[j][e] * xin[o + j][e];
                y[e] = v; }
            const int tok = 2 * t2 + o;
            u32x4 pk; pk.x = pk2(y[0], y[1]); pk.y = pk2(y[2], y[3]); pk.z = pk2(y[4], y[5]); pk.w = pk2(y[6], y[7]);
            *(LAS u32x4*)(xcb + tok * 256 + ((cg8 ^ (tok & 15)) * 16)) = pk; }
    }
    if (tt + 1 < tt_first + 4) LRU_XLOAD(tt + 1);
    __syncthreads();
    float hreg[16];
    int tl = tid; asm volatile("" : "+v"(tl));
    const int q = tl & 15, g = (tl >> 4) & 3, w = tl >> 6, chl = 16 * w + 4 * g;
    const int ch = 16 * w + q, sub = g;
#pragma unroll
    for (int dir = 0; dir < 2; ++dir) {
        LAS float* TAd = dir ? TH : TA;
        if (VAR != 3) {
            const f32x4 ba = *(const LAS f32x4*)(CW + 640 + (dir * 3 + 0) * 128 + chl), bx = *(const LAS f32x4*)(CW + 640 + (dir * 3 + 1) * 128 + chl), sp = *(const LAS f32x4*)(CW + 640 + (dir * 3 + 2) * 128 + chl);
#pragma unroll
            for (int tk = 0; tk < 4; ++tk) { const int tok = 16 * tk + q;
                f32x4 ar = (f32x4){0.f, 0.f, 0.f, 0.f}, ai = (f32x4){0.f, 0.f, 0.f, 0.f};
#pragma unroll
                for (int s = 0; s < 4; ++s) {
                    const bf16x8 xb = *(const LAS bf16x8*)(xcb + tok * 256 + (((4 * s + g) ^ q) * 16));
                    ar = mfma16(fa[dir][s], xb, ar); ai = mfma16(fx[dir][s], xb, ai); }
                const u32x2 xr2 = *(const LAS u32x2*)(xcb + tok * 256 + ((((chl >> 3)) ^ q) * 16) + (chl & 7) * 2);
                const float xc0 = bflo(xr2.x), xc1 = bfhi(xr2.x), xc2 = bflo(xr2.y), xc3 = bfhi(xr2.y);
                f32x4 av, bv;
#pragma unroll
                for (int j = 0; j < 4; ++j) { if (VAR == 1) { av[j] = ar[j] + ba[j] + sp[j]; bv[j] = ai[j] + bx[j] + (j == 0 ? xc0 : (j == 1 ? xc1 : (j == 2 ? xc2 : xc3))); continue; }
                    const float r = fsigmoid(ar[j] + ba[j]), ii = fsigmoid(ai[j] + bx[j]);
                    const float la = -8.0f * r * sp[j]; const float aa = fexp2(la * LOG2E); av[j] = aa;
                    const float x2 = 2.0f * la;
                    const float poly = x2 * (1.f + x2 * (0.5f + x2 * ((1.f / 6.f) + x2 * ((1.f / 24.f) + x2 * (1.f / 120.f)))));
                    const float om = (x2 > -0.25f) ? -poly : (1.f - aa * aa);
                    const float xcj = j == 0 ? xc0 : (j == 1 ? xc1 : (j == 2 ? xc2 : xc3));
                    bv[j] = __builtin_amdgcn_sqrtf(om) * ii * xcj; }
                *(LAS f32x4*)(TAd + tok * 132 + chl) = av; *(LAS f32x4*)(TB + tok * 132 + chl) = bv; }
        }
        asm volatile("s_waitcnt lgkmcnt(0)" ::: "memory");
        if (VAR != 2 && VAR != 3) {
            float h = 0.f, P = 1.f;
#pragma unroll
            for (int i = 0; i < 16; ++i) { const int t = 16 * sub + (dir ? 15 - i : i);
                const float av = TAd[t * 132 + ch], bv = TB[t * 132 + ch]; h = av * h + bv; P *= av; TB[t * 132 + ch] = h; TAd[t * 132 + ch] = P; }
            AGS[sub * 128 + ch] = (f32x2){P, h};
        }
        asm volatile("s_waitcnt lgkmcnt(0)" ::: "memory");
        if (VAR == 2 || VAR == 3) {
#pragma unroll
            for (int i = 0; i < 16; ++i) hreg[i] = 0.f;
        } else {
            float hc = 0.f, Pp = 1.f, At = 1.f, Ht = 0.f;
#pragma unroll
            for (int s = 0; s < 4; ++s) { const int s2 = dir ? 3 - s : s; const f32x2 e = AGS[s2 * 128 + ch];
                const bool before = dir ? (s2 > sub) : (s2 < sub);
                if (before) { hc = e.x * hc + e.y; Pp *= e.x; }
                Ht = e.x * Ht + e.y; At *= e.x; }
#pragma unroll
            for (int i = 0; i < 16; ++i) { const int t = 16 * sub + i;
                const float Pl = TAd[t * 132 + ch], hl = TB[t * 132 + ch];
                const float hfull = hl + Pl * hc;
                if (dir == 0) hreg[i] = hfull; else hreg[i] += hfull;
                TAd[t * 132 + ch] = Pl * Pp; }
            if (sub == 0) agg1[(size_t)(dir * 1024 + n * 128 + ch) * 128 + tt] = (f32x2){At, Ht};
            if (dir == 0) { H2f = At * H2f + Ht; A2f *= At; }
            else { H2b = A2b * Ht + H2b; A2b *= At; }
        }
        asm volatile("s_waitcnt lgkmcnt(0)" ::: "memory");
    }
#pragma unroll
    for (int i = 0; i < 16; ++i) TB[(16 * sub + i) * 132 + ch] = hreg[i];
    __syncthreads();
    {
        float* hs = (float*)(ws + (VAR ? WS_U : WS_HS));
#pragma unroll
        for (int i = 0; i < 4; ++i) { const int e = tid + 512 * i, t = e >> 5, c4 = e & 31;
            *(f32x4*)(hs + (size_t)(t0 + t) * 1024 + n * 128 + 4 * c4) = *(const LAS f32x4*)(TB + t * 132 + 4 * c4);
            const f32x4 p0 = *(const LAS f32x4*)(TA + t * 132 + 4 * c4), p1 = *(const LAS f32x4*)(TH + t * 132 + 4 * c4);
            u32x2 o0, o1; o0.x = pk2(p0[0], p0[1]); o0.y = pk2(p0[2], p0[3]); o1.x = pk2(p1[0], p1[1]); o1.y = pk2(p1[2], p1[3]);
            *(u32x2*)(Pout + (size_t)(t0 + t) * 1024 + n * 128 + 4 * c4) = o0;
            *(u32x2*)(Pout + (size_t)SEQ * 1024 + (size_t)(t0 + t) * 1024 + n * 128 + 4 * c4) = o1; }
    }
    }
    if (g0 == 0) { f32x2* agg2 = (f32x2*)(ws + (VAR ? WS_T0 + 8 * MiB : WS_AGG2)); const int chg2 = n * 128 + 16 * w0 + q0, sc2 = tt_first >> 2;
        agg2[(size_t)chg2 * 32 + sc2] = (f32x2){A2f, H2f}; agg2[(size_t)(1024 + chg2) * 32 + sc2] = (f32x2){A2b, H2b}; }
#undef LRU_XLOAD
}

__device__ __forceinline__ void phase2(const Args& a, LAS unsigned char* lds, int p2mask) {
    unsigned char* ws = a.ws;
    bf16_t* proj = (bf16_t*)(ws + WS_PROJ); const bf16_t* vt = (const bf16_t*)(ws + WS_VT);
    const bf16_t* mk = (const bf16_t*)(ws + WS_MK); const bf16_t* mvt = (const bf16_t*)(ws + WS_MVT);
    bf16_t* yatt = (bf16_t*)(ws + WS_YATT); bf16_t* ymem = (bf16_t*)(ws + WS_YMEM);
    if (p2mask & 1)
    for (int u = blockIdx.x; u < 256; u += gridDim.x) {
        const int qblk = u >> 2, hm = u & 3;
        attn_unit<256, false, false>(lds, proj + (size_t)(qblk * 128) * INW + C_QM + hm * 256, INW, ymem + (size_t)(qblk * 128) * 1024 + hm * 256, 1024, mk + hm * 256, 1024, mvt + (size_t)(hm * 256) * 256, 256, 0, 2, -100, -1e30f, 0.f);
    }
    if (p2mask & 2) windowed_stream(lds, a);
    if (p2mask & 4)
    lru_phase<0>(lds, a, (int)(blockIdx.x & 7), 4 * (int)(blockIdx.x >> 3), 1);
}

__device__ __forceinline__ void phase3(const Args& a, LAS unsigned char* lds) {
    unsigned char* ws = a.ws;
    const f32x2* agg1 = (const f32x2*)(ws + WS_AGG1); f32x2* agg2 = (f32x2*)(ws + WS_AGG2);
    for (int e = blockIdx.x * 512 + threadIdx.x; e < 2 * 1024 * 16; e += gridDim.x * 512) {
        const int sc = e & 15, dc = e >> 4, dir = dc >> 10;
        const f32x4* p = (const f32x4*)(agg1 + (size_t)dc * 128 + sc * 8);
        f32x4 v[4];
#pragma unroll
        for (int i = 0; i < 4; ++i) v[i] = p[i];
        float A = 1.f, H = 0.f;
        if (dir == 0) {
#pragma unroll
            for (int i = 0; i < 4; ++i) { H = v[i][0] * H + v[i][1]; A *= v[i][0]; H = v[i][2] * H + v[i][3]; A *= v[i][2]; }
        } else {
#pragma unroll
            for (int i = 3; i >= 0; --i) { H = v[i][2] * H + v[i][3]; A *= v[i][2]; H = v[i][0] * H + v[i][1]; A *= v[i][0]; }
        }
        agg2[(size_t)dc * 16 + sc] = (f32x2){A, H};
    }
}

__device__ __forceinline__ float silu_(float z) { return z * __builtin_amdgcn_rcpf(1.f + __builtin_amdgcn_exp2f(-z * 1.4426950408889634f)); }
__device__ __forceinline__ void phase4(const Args& a, LAS unsigned char* lds) {
    unsigned char* ws = a.ws;
    const f32x2* agg1 = (const f32x2*)(ws + WS_AGG1); const f32x2* agg2 = (const f32x2*)(ws + WS_AGG2);
    const bf16_t* proj = (const bf16_t*)(ws + WS_PROJ); bf16_t* Y = (bf16_t*)(ws + WS_Y);
    const bf16_t* yatt = (const bf16_t*)(ws + WS_YATT); const bf16_t* ymem = (const bf16_t*)(ws + WS_YMEM);
    const float* hs = (const float*)(ws + WS_HS); const bf16_t* Pf = (const bf16_t*)(ws + WS_PP); const bf16_t* Pb = Pf + (size_t)SEQ * 1024;
    LAS float* car = (LAS float*)lds;
    LAS float* gl = (LAS float*)(lds + 8192);
    int tid = threadIdx.x; asm volatile("" : "+v"(tid)); const int lane = tid & 63, w = tid >> 6;
    __syncthreads();
    for (int i = tid; i < 1024; i += 512) { *(LAS f32x4*)(gl + 4 * i) = (i < 512) ? ((const f32x4*)a.in[14])[i] : (i < 768 ? ((const f32x4*)a.in[15])[i - 512] : ((const f32x4*)a.in[16])[i - 768]); }
    for (int u = blockIdx.x; u < 256; u += gridDim.x) {
        const int tile = u >> 1, sc = tile >> 2, cj = tile & 3;
        __syncthreads();
#pragma unroll 1
        for (int half = 0; half < 2; ++half) {
            const int c = tid + 512 * half;
            float hf = 0.f, hb = 0.f;
            float scf = (float)sc, cjf = (float)cj; asm volatile("" : "+v"(scf), "+v"(cjf));
            { const f32x4* p2 = (const f32x4*)(agg2 + (size_t)c * 32); const f32x4* p1 = (const f32x4*)(agg1 + (size_t)c * 128 + sc * 4);
              f32x4 e2[16], e1[2];
#pragma unroll
              for (int i = 0; i < 16; ++i) e2[i] = p2[i];
#pragma unroll
              for (int i = 0; i < 2; ++i) e1[i] = p1[i];
#pragma unroll
              for (int i = 0; i < 16; ++i) { const float w0 = fminf(fmaxf(scf - (float)(2 * i), 0.f), 1.f), w1 = fminf(fmaxf(scf - (float)(2 * i + 1), 0.f), 1.f);
                  hf = (w0 * e2[i][0] + (1.f - w0)) * hf + w0 * e2[i][1]; hf = (w1 * e2[i][2] + (1.f - w1)) * hf + w1 * e2[i][3]; }
#pragma unroll
              for (int i = 0; i < 2; ++i) { const float w0 = fminf(fmaxf(cjf - (float)(2 * i), 0.f), 1.f), w1 = fminf(fmaxf(cjf - (float)(2 * i + 1), 0.f), 1.f);
                  hf = (w0 * e1[i][0] + (1.f - w0)) * hf + w0 * e1[i][1]; hf = (w1 * e1[i][2] + (1.f - w1)) * hf + w1 * e1[i][3]; } }
            { const f32x4* p2 = (const f32x4*)(agg2 + (size_t)(1024 + c) * 32); const f32x4* p1 = (const f32x4*)(agg1 + (size_t)(1024 + c) * 128 + sc * 4);
              f32x4 e2[16], e1[2];
#pragma unroll
              for (int i = 0; i < 16; ++i) e2[i] = p2[i];
#pragma unroll
              for (int i = 0; i < 2; ++i) e1[i] = p1[i];
#pragma unroll
              for (int i = 15; i >= 0; --i) { const float w1 = fminf(fmaxf((float)(2 * i + 1) - scf, 0.f), 1.f), w0 = fminf(fmaxf((float)(2 * i) - scf, 0.f), 1.f);
                  hb = (w1 * e2[i][2] + (1.f - w1)) * hb + w1 * e2[i][3]; hb = (w0 * e2[i][0] + (1.f - w0)) * hb + w0 * e2[i][1]; }
#pragma unroll
              for (int i = 1; i >= 0; --i) { const float w1 = fminf(fmaxf((float)(2 * i + 1) - cjf, 0.f), 1.f), w0 = fminf(fmaxf((float)(2 * i) - cjf, 0.f), 1.f);
                  hb = (w1 * e1[i][2] + (1.f - w1)) * hb + w1 * e1[i][3]; hb = (w0 * e1[i][0] + (1.f - w0)) * hb + w0 * e1[i][1]; } }
            car[c] = hf; car[1024 + c] = hb;
        }
        __syncthreads();
        f32x4 cf[4], cb[4];
#pragma unroll
        for (int k = 0; k < 4; ++k) { cf[k] = *(const LAS f32x4*)(car + 4 * lane + 256 * k); cb[k] = *(const LAS f32x4*)(car + 1024 + 4 * lane + 256 * k); }
#pragma unroll 1
        for (int tk = 0; tk < 4; ++tk) {
            const unsigned t = (unsigned)(u * 32 + 4 * w + tk);
            const char* hsb = (const char*)hs; const char* pfb = (const char*)Pf; const char* pbb = (const char*)Pb;
            const char* yab = (const char*)yatt; const char* ymb = (const char*)ymem; const char* prb = (const char*)proj; char* yb = (char*)Y;
            const unsigned o_h = t * 4096u + 16u * lane, o_p = t * 2048u + 8u * lane, o_m = t * 2048u + 16u * lane;
            const unsigned o_pr = t * (unsigned)(INW * 2), o_y = t * 8192u;
            f32x4 h4[4]; u32x2 pf[4], pb[4], zl[4]; u32x4 va[4], vm[2], za[4], zm[2];
#pragma unroll
            for (int k = 0; k < 4; ++k) { h4[k] = __builtin_nontemporal_load((const f32x4*)(hsb + o_h + 1024u * k)); pf[k] = __builtin_nontemporal_load((const u32x2*)(pfb + o_p + 512u * k)); pb[k] = __builtin_nontemporal_load((const u32x2*)(pbb + o_p + 512u * k)); va[k] = __builtin_nontemporal_load((const u32x4*)(yab + o_h + 1024u * k)); }
#pragma unroll
            for (int k = 0; k < 2; ++k) vm[k] = __builtin_nontemporal_load((const u32x4*)(ymb + o_m + 1024u * k));
#pragma unroll
            for (int k = 0; k < 4; ++k) { zl[k] = __builtin_nontemporal_load((const u32x2*)(prb + o_pr + (unsigned)((C_ZL + 4 * lane + 256 * k) * 2))); za[k] = __builtin_nontemporal_load((const u32x4*)(prb + o_pr + (unsigned)((C_ZA + 8 * lane + 512 * k) * 2))); }
#pragma unroll
            for (int k = 0; k < 2; ++k) zm[k] = __builtin_nontemporal_load((const u32x4*)(prb + o_pr + (unsigned)((C_ZM + 8 * lane + 512 * k) * 2)));
            __builtin_amdgcn_sched_barrier(0);
            f32x4 v[4]; float ssl = 0.f, ssa = 0.f, ssm = 0.f;
#pragma unroll
            for (int k = 0; k < 4; ++k) {
                v[k][0] = h4[k][0] + bflo(pf[k].x) * cf[k][0] + bflo(pb[k].x) * cb[k][0]; v[k][1] = h4[k][1] + bfhi(pf[k].x) * cf[k][1] + bfhi(pb[k].x) * cb[k][1];
                v[k][2] = h4[k][2] + bflo(pf[k].y) * cf[k][2] + bflo(pb[k].y) * cb[k][2]; v[k][3] = h4[k][3] + bfhi(pf[k].y) * cf[k][3] + bfhi(pb[k].y) * cb[k][3];
                ssl += (v[k][0] * v[k][0] + v[k][1] * v[k][1]) + (v[k][2] * v[k][2] + v[k][3] * v[k][3]);
                { const float f0 = bflo(va[k].x), f1 = bfhi(va[k].x), f2 = bflo(va[k].y), f3 = bfhi(va[k].y), f4 = bflo(va[k].z), f5 = bfhi(va[k].z), f6 = bflo(va[k].w), f7 = bfhi(va[k].w);
                  ssa += ((f0 * f0 + f1 * f1) + (f2 * f2 + f3 * f3)) + ((f4 * f4 + f5 * f5) + (f6 * f6 + f7 * f7)); } }
#pragma unroll
            for (int k = 0; k < 2; ++k) { const float f0 = bflo(vm[k].x), f1 = bfhi(vm[k].x), f2 = bflo(vm[k].y), f3 = bfhi(vm[k].y), f4 = bflo(vm[k].z), f5 = bfhi(vm[k].z), f6 = bflo(vm[k].w), f7 = bfhi(vm[k].w);
                ssm += ((f0 * f0 + f1 * f1) + (f2 * f2 + f3 * f3)) + ((f4 * f4 + f5 * f5) + (f6 * f6 + f7 * f7)); }
#pragma unroll
            for (int o = 1; o < 64; o <<= 1) { ssl += __shfl_xor(ssl, o); ssa += __shfl_xor(ssa, o); ssm += __shfl_xor(ssm, o); }
            const float rsl = 1.f / sqrtf(ssl * (1.f / 1024.f) + EPSN), rsa = 1.f / sqrtf(ssa * (1.f / 2048.f) + EPSN), rsm = 1.f / sqrtf(ssm * (1.f / 1024.f) + EPSN);
            __builtin_amdgcn_sched_barrier(0);
#pragma unroll
            for (int k = 0; k < 4; ++k) { const int c = 4 * lane + 256 * k; const f32x4 g4 = *(const LAS f32x4*)(gl + 2048 + c); const u32x2 z = zl[k];
                u32x2 o; o.x = pk2(v[k][0] * rsl * g4[0] * silu_(bflo(z.x)), v[k][1] * rsl * g4[1] * silu_(bfhi(z.x))); o.y = pk2(v[k][2] * rsl * g4[2] * silu_(bflo(z.y)), v[k][3] * rsl * g4[3] * silu_(bfhi(z.y)));
                *(u32x2*)(yb + o_y + (unsigned)((2048 + c) * 2)) = o; }
            __builtin_amdgcn_sched_barrier(0);
#pragma unroll
            for (int k = 0; k < 4; ++k) { const int c = 8 * lane + 512 * k; const f32x4 g0 = *(const LAS f32x4*)(gl + c), g1 = *(const LAS f32x4*)(gl + c + 4); const u32x4 z = za[k];
                u32x4 o; o.x = pk2(bflo(va[k].x) * rsa * g0[0] * silu_(bflo(z.x)), bfhi(va[k].x) * rsa * g0[1] * silu_(bfhi(z.x)));
                o.y = pk2(bflo(va[k].y) * rsa * g0[2] * silu_(bflo(z.y)), bfhi(va[k].y) * rsa * g0[3] * silu_(bfhi(z.y)));
                o.z = pk2(bflo(va[k].z) * rsa * g1[0] * silu_(bflo(z.z)), bfhi(va[k].z) * rsa * g1[1] * silu_(bfhi(z.z)));
                o.w = pk2(bflo(va[k].w) * rsa * g1[2] * silu_(bflo(z.w)), bfhi(va[k].w) * rsa * g1[3] * silu_(bfhi(z.w)));
                *(u32x4*)(yb + o_y + (unsigned)(c * 2)) = o; }
            __builtin_amdgcn_sched_barrier(0);
#pragma unroll
            for (int k = 0; k < 2; ++k) { const int c = 8 * lane + 512 * k; const f32x4 g0 = *(const LAS f32x4*)(gl + 3072 + c), g1 = *(const LAS f32x4*)(gl + 3072 + c + 4); const u32x4 z = zm[k];
                u32x4 o; o.x = pk2(bflo(vm[k].x) * rsm * g0[0] * silu_(bflo(z.x)), bfhi(vm[k].x) * rsm * g0[1] * silu_(bfhi(z.x)));
                o.y = pk2(bflo(vm[k].y) * rsm * g0[2] * silu_(bflo(z.y)), bfhi(vm[k].y) * rsm * g0[3] * silu_(bfhi(z.y)));
                o.z = pk2(bflo(vm[k].z) * rsm * g1[0] * silu_(bflo(z.z)), bfhi(vm[k].z) * rsm * g1[1] * silu_(bfhi(z.z)));
                o.w = pk2(bflo(vm[k].w) * rsm * g1[2] * silu_(bflo(z.w)), bfhi(vm[k].w) * rsm * g1[3] * silu_(bfhi(z.w)));
                *(u32x4*)(yb + o_y + (unsigned)((3072 + c) * 2)) = o; }
        }
    }
}

#define XB_TMO      128
#define XB_XCNT(j)  (256  + 64 * (j))
#define XB_XSUB(j)  (1280 + 64 * (j))
#define XB_XGEN(j)  (2304 + 64 * (j))
#define XB_TOP      3328
#define XB_TOPGEN   3392
#define XCD_BAR_WORDS 3456
#define XB_SPIN_CAP (1u << 18)

__device__ __forceinline__ unsigned xb_ld(unsigned* p)              { return __hip_atomic_load(p, __ATOMIC_RELAXED, __HIP_MEMORY_SCOPE_AGENT); }
__device__ __forceinline__ unsigned xb_add(unsigned* p, unsigned v) { return __hip_atomic_fetch_add(p, v, __ATOMIC_RELAXED, __HIP_MEMORY_SCOPE_AGENT); }
__device__ __forceinline__ unsigned xb_xcc_id() { return (unsigned)__builtin_amdgcn_s_getreg((3 << 11) | 20) & 0xFu; }
#define XB_SPIN(cond, bar) do { unsigned _sp = 0; while (cond) { __builtin_amdgcn_s_sleep(1); \
    if ((++_sp & 255u) == 0u) { if (xb_ld(&(bar)[XB_TMO])) break; if (_sp > XB_SPIN_CAP) { atomicAdd(&(bar)[XB_TMO], 1u); break; } } } } while (0)

struct XcdBarrier {
    unsigned* bar; unsigned x;
    volatile LAS unsigned* st;
};

__device__ __forceinline__ XcdBarrier xcd_barrier_post(unsigned* bar, volatile LAS unsigned* st) {
    XcdBarrier b; b.bar = bar; b.x = xb_xcc_id(); b.st = st;
    if (threadIdx.x == 0) (void)xb_add(&bar[XB_XCNT(b.x)], 1u);
    return b;
}
__device__ __forceinline__ void xcd_barrier_complete(unsigned* bar, unsigned x, unsigned& nloc, unsigned& nx) {
    const unsigned G = gridDim.x * gridDim.y * gridDim.z;
    unsigned sum, cnt, mine, sp = 0u;
    for (;;) {
        sum = 0u; cnt = 0u; mine = 0u;
#pragma unroll
        for (unsigned j = 0; j < 16; ++j) { const unsigned c = xb_ld(&bar[XB_XCNT(j)]); sum += c; cnt += (c > 0u) ? 1u : 0u; mine = (j == x) ? c : mine; }
        if (sum == G) break;
        __builtin_amdgcn_s_sleep(1);
        if ((++sp & 255u) == 0u) { if (xb_ld(&bar[XB_TMO])) break; if (sp > XB_SPIN_CAP) { atomicAdd(&bar[XB_TMO], 1u); break; } }
    }
    nloc = mine > 0u ? mine : 1u; nx = cnt > 0u ? cnt : 1u;
}

__device__ __forceinline__ void xcd_barrier(const XcdBarrier& b) {
    asm volatile("s_waitcnt vmcnt(0)" ::: "memory");
    __syncthreads();
    if (threadIdx.x == 0) {
        unsigned* bar = b.bar;
        __builtin_amdgcn_s_waitcnt(0);
        unsigned nloc = b.st[0], nx = b.st[1];
        if (nloc == 0u) { xcd_barrier_complete(bar, b.x, nloc, nx); b.st[0] = nloc; b.st[1] = nx; }
        const unsigned old = xb_add(&bar[XB_XSUB(b.x)], 1u);
        const unsigned gen = old / nloc;
        if (old + 1u == (gen + 1u) * nloc) {
            __builtin_amdgcn_fence(__ATOMIC_RELEASE, "agent");
            asm volatile("s_waitcnt vmcnt(0)" ::: "memory");
            const unsigned og = xb_add(&bar[XB_TOP], 1u);
            const unsigned tg = og / nx;
            if (og + 1u == (tg + 1u) * nx) xb_add(&bar[XB_TOPGEN], 1u);
            else XB_SPIN(xb_ld(&bar[XB_TOPGEN]) == tg, bar);
            __builtin_amdgcn_fence(__ATOMIC_ACQUIRE, "agent");
            xb_add(&bar[XB_XGEN(b.x)], 1u);
            asm volatile("s_waitcnt vmcnt(0)" ::: "memory");
        } else {
            XB_SPIN(xb_ld(&bar[XB_XGEN(b.x)]) == gen, bar);
            __builtin_amdgcn_fence(__ATOMIC_ACQUIRE, "agent");
            asm volatile("s_waitcnt vmcnt(0)" ::: "memory");
        }
    }
    __syncthreads();
}

struct Sched2 {
    int c;
    __device__ bool next(int i, pg8::Unit& u) const {
        if (i >= 2) return false;
        const int x = c & 7, j = c >> 3;
        u.pm = i * 16 + 4 * (x >> 1) + (j & 3); u.pn = 8 * (x & 1) + (j >> 2); return true;
    }
    __device__ __forceinline__ void a_ready(const pg8::Unit&) const {}
    __device__ __forceinline__ void done(const pg8::Unit&) const {}
};
struct Epi3 {
    static constexpr bool PERM = true, AFTER_DRAIN = false, HOLD_LAST = true;
    float* out; bf16_t* t0; float* sspart; const float* x; const float* gain; XcdBarrier xbar;
    __device__ __forceinline__ void operator()(const f32x4 (&acc)[2][2][4][2], const pg8::Unit& u, int wr, int wc, int fr, int fq) const {
#pragma unroll
        for (int ai = 0; ai < 2; ++ai)
#pragma unroll
            for (int m = 0; m < 4; ++m) { const int row = u.pm * 256 + ai * 128 + wr * 64 + m * 16 + fr; float ss = 0.f;
#pragma unroll
                for (int bj = 0; bj < 2; ++bj) { const f32x4 v0 = acc[ai][bj][m][0], v1 = acc[ai][bj][m][1]; const int col = u.pn * 256 + bj * 128 + wc * 32 + 8 * fq;
                    u32x4 pk; pk.x = pk2(v0[0], v0[1]); pk.y = pk2(v0[2], v0[3]); pk.z = pk2(v1[0], v1[1]); pk.w = pk2(v1[2], v1[3]); *(u32x4*)(t0 + (size_t)row * 4096 + col) = pk;
                    ss += ((v0[0] * v0[0] + v0[1] * v0[1]) + (v0[2] * v0[2] + v0[3] * v0[3])) + ((v1[0] * v1[0] + v1[1] * v1[1]) + (v1[2] * v1[2] + v1[3] * v1[3])); }
                ss += __shfl_xor(ss, 16); ss += __shfl_xor(ss, 32);
                if (fq == 0) sspart[(size_t)row * 64 + u.pn * 4 + wc] = ss; }
    }
    __device__ __forceinline__ void fused(f32x4 (&acc)[2][2][4][2], const pg8::Unit& u, int wr, int wc, int fr, int fq, LAS unsigned char* lds, int wid, int lane) const {
#pragma unroll
        for (int ai = 0; ai < 2; ++ai)
#pragma unroll
            for (int m = 0; m < 4; ++m) { const int row = u.pm * 256 + ai * 128 + wr * 64 + m * 16 + fr; float ss = 0.f;
#pragma unroll
                for (int bj = 0; bj < 2; ++bj)
#pragma unroll
                    for (int n = 0; n < 2; ++n) { const f32x4 v = acc[ai][bj][m][n]; ss += (v[0] * v[0] + v[1] * v[1]) + (v[2] * v[2] + v[3] * v[3]); }
                ss += __shfl_xor(ss, 16); ss += __shfl_xor(ss, 32);
                if (fq == 0) sspart[(size_t)row * 64 + u.pn * 4 + wc] = ss; }
        f32x4 xv0[16], xv1[16];
        const size_t gob = (size_t)(u.pm * 256 + wid * 16) * 4096 + u.pn * 256 + 4 * lane;
#pragma unroll
        for (int r = 0; r < 16; ++r) xv0[r] = __builtin_nontemporal_load((const f32x4*)(x + gob + (size_t)r * 4096));
        xcd_barrier(xbar);
        constexpr int TP = 260;
        LAS float* T = (LAS float*)lds;
        LAS float* rsT = (LAS float*)(lds + 128 * TP * 4);
        { const int tid = wid * 64 + lane, row = tid >> 1, hf = tid & 1;
          const f32x4* p = (const f32x4*)(sspart + (size_t)(u.pm * 256 + row) * 64 + hf * 32);
          float s = 0.f;
#pragma unroll
          for (int i = 0; i < 8; ++i) { const f32x4 v = p[i]; s += (v[0] + v[1]) + (v[2] + v[3]); }
          s += __shfl_xor(s, 1);
          if (hf == 0) rsT[row] = 1.f / sqrtf(s * (1.f / 4096.f) + EPSN); }
        const f32x4 gv = *(const f32x4*)(gain + u.pn * 256 + 4 * lane);
#pragma unroll
        for (int ai = 0; ai < 2; ++ai) {
            __syncthreads();
#pragma unroll
            for (int m = 0; m < 4; ++m)
#pragma unroll
                for (int bj = 0; bj < 2; ++bj)
#pragma unroll
                    for (int n = 0; n < 2; ++n) *(LAS f32x4*)(T + (wr * 64 + m * 16 + fr) * TP + bj * 128 + wc * 32 + 8 * fq + 4 * n) = acc[ai][bj][m][n];
            if (ai == 0) {
#pragma unroll
                for (int r = 0; r < 16; ++r) xv1[r] = __builtin_nontemporal_load((const f32x4*)(x + gob + (size_t)(128 + r) * 4096));
            }
            __syncthreads();
#pragma unroll
            for (int r = 0; r < 16; ++r) { const int rl = wid * 16 + r;
                const f32x4 tv = *(const LAS f32x4*)(T + rl * TP + 4 * lane); const float rs = rsT[ai * 128 + rl];
                __builtin_nontemporal_store((ai ? xv1[r] : xv0[r]) + tv * rs * gv, (f32x4*)(out + gob + (size_t)(ai * 128 + r) * 4096)); }
        }
        const int pm0 = u.pm - 16;
        __syncthreads();
        { const int tid = wid * 64 + lane, row = tid >> 1, hf = tid & 1;
          const f32x4* p = (const f32x4*)(sspart + (size_t)(pm0 * 256 + row) * 64 + hf * 32);
          float s = 0.f;
#pragma unroll
          for (int i = 0; i < 8; ++i) { const f32x4 v = p[i]; s += (v[0] + v[1]) + (v[2] + v[3]); }
          s += __shfl_xor(s, 1);
          if (hf == 0) rsT[row] = 1.f / sqrtf(s * (1.f / 4096.f) + EPSN); }
        __syncthreads();
#pragma unroll 1
        for (int hb = 0; hb < 2; ++hb) {
            const int r0 = wid * 32 + hb * 16;
            const size_t go = (size_t)(pm0 * 256 + r0) * 4096 + u.pn * 256 + 4 * lane;
            f32x4 xr[16]; u32x2 tr[16];
#pragma unroll
            for (int r = 0; r < 16; ++r) { xr[r] = __builtin_nontemporal_load((const f32x4*)(x + go + (size_t)r * 4096)); tr[r] = __builtin_nontemporal_load((const u32x2*)(t0 + go + (size_t)r * 4096)); }
#pragma unroll
            for (int r = 0; r < 16; ++r) { const float rs = rsT[r0 + r];
                f32x4 o; o[0] = xr[r][0] + bflo(tr[r].x) * rs * gv[0]; o[1] = xr[r][1] + bfhi(tr[r].x) * rs * gv[1]; o[2] = xr[r][2] + bflo(tr[r].y) * rs * gv[2]; o[3] = xr[r][3] + bfhi(tr[r].y) * rs * gv[3];
                __builtin_nontemporal_store(o, (f32x4*)(out + go + (size_t)r * 4096)); }
        }
    }
};
__device__ __forceinline__ void phase6(const Args& a) {
    int tid = threadIdx.x; asm volatile("" : "+v"(tid)); const int lane = tid & 63, w = tid >> 6;
    const float* sspart = (const float*)(a.ws + WS_SS); const bf16_t* t0 = (const bf16_t*)(a.ws + WS_T0);
    f32x4 gv[16];
#pragma unroll
    for (int k = 0; k < 16; ++k) gv[k] = ((const f32x4*)a.in[18])[2 * lane + 128 * (k >> 1) + (k & 1)];
    for (int row = blockIdx.x * 8 + w; row < 4096; row += gridDim.x * 8) {
        const u32x4* t4 = (const u32x4*)(t0 + (size_t)row * 4096) + lane; f32x4* o4 = (f32x4*)(a.out + (size_t)row * 4096) + 2 * lane;
        const f32x4* x4 = (const f32x4*)(a.in[0] + (size_t)row * 4096) + 2 * lane;
        u32x4 tv[8]; f32x4 xa[8], xb[8];
        const float sp = sspart[(size_t)row * 64 + lane];
#pragma unroll
        for (int k = 0; k < 8; ++k) { tv[k] = __builtin_nontemporal_load(t4 + 64 * k); xa[k] = __builtin_nontemporal_load(x4 + 128 * k); xb[k] = __builtin_nontemporal_load(x4 + 128 * k + 1); }
        const float rs = 1.f / sqrtf(wave_sum(sp) * (1.f / 4096.f) + EPSN);
#pragma unroll
        for (int k = 0; k < 8; ++k) { const f32x4 ga = gv[2 * k], gb = gv[2 * k + 1];
            f32x4 oa, ob; oa[0] = xa[k][0] + bflo(tv[k].x) * rs * ga[0]; oa[1] = xa[k][1] + bfhi(tv[k].x) * rs * ga[1]; oa[2] = xa[k][2] + bflo(tv[k].y) * rs * ga[2]; oa[3] = xa[k][3] + bfhi(tv[k].y) * rs * ga[3];
            ob[0] = xb[k][0] + bflo(tv[k].z) * rs * gb[0]; ob[1] = xb[k][1] + bfhi(tv[k].z) * rs * gb[1]; ob[2] = xb[k][2] + bflo(tv[k].w) * rs * gb[2]; ob[3] = xb[k][3] + bfhi(tv[k].w) * rs * gb[3];
            __builtin_nontemporal_store(oa, o4 + 128 * k); __builtin_nontemporal_store(ob, o4 + 128 * k + 1); }
    }
}

__global__ void __launch_bounds__(512, 2) mega(Args a) {
    extern __shared__ __attribute__((aligned(16))) unsigned char lds_raw[];
    LAS unsigned char* lds = (LAS unsigned char*)lds_raw;
    cg::grid_group grid = cg::this_grid();
    unsigned char* ws = a.ws;
    volatile LAS unsigned* xst = (volatile LAS unsigned*)(lds + LDS_BYTES - 64);
    if (threadIdx.x < 16) xst[threadIdx.x] = 0u;
    __syncthreads();
    XcdBarrier xbar; xbar.bar = (unsigned*)(ws + WS_CTL); xbar.x = 0; xbar.st = nullptr;
    xbar = xcd_barrier_post((unsigned*)(ws + WS_CTL), xst);
    const int lo = a.ph_lo, hi = a.ph_hi;
#define IN(k) (lo <= (k) && (k) < hi)
#define SEAM(k) do { if (IN(k) && IN((k) + 1)) { if ((k) == 1) { __syncthreads(); grid.sync(); } else xcd_barrier(xbar); } } while (0)
    if (IN(0)) { if (PHMASK & 1) phase0(a, lds); if (REPMASK & 1) { __syncthreads(); phase0(a, lds); } }
    SEAM(0);
    if (IN(1)) { if (PHMASK & 2) {
        pg8::Gemm g{(const bf16_t*)(ws + WS_U), (const bf16_t*)(ws + WS_WT), SEQ + NMEM, INW + 2048, 4096};
        Sched1 S; S.init((int)gridDim.x, (int)blockIdx.x);
        Epi1 E{(bf16_t*)(ws + WS_PROJ), (bf16_t*)(ws + WS_VT), (bf16_t*)(ws + WS_MK), (bf16_t*)(ws + WS_MVT), (const float*)(ws + WS_ROPE)};
        pg8::gemm_phase<Epi1, Sched1, true, true>(lds, g, S, E);
        {
            const int G = (int)gridDim.x, nfull = 1160 % G, nidle = (nfull == 0) ? G : G - nfull;
            const int bi = (nfull == 0) ? (int)blockIdx.x : (int)blockIdx.x - nfull;
            if (bi >= 0) {
                int tid = threadIdx.x; asm volatile("" : "+v"(tid)); const int lane = tid & 63, w = tid >> 6;
                LAS float* scr = (LAS float*)(lds + w * 16384);
                p0_transpose_matrix(a.in[17], 4096, 4096, (bf16_t*)(ws + WS_WOUT), 0, scr, bi * 8 + w, nidle * 8, lane);
            }
        }
        if (REPMASK & 2) { __syncthreads(); pg8::gemm_phase<Epi1, Sched1, true, true>(lds, g, S, E); }
    } }
    SEAM(1);
    if (IN(2)) { if (PHMASK & 4) phase2(a, lds, P2MASK); }
    SEAM(2);
    if (IN(4)) { if (PHMASK & 16) phase4(a, lds); if (REPMASK & 16) { __syncthreads(); phase4(a, lds); } }
    SEAM(4);
    if (IN(5)) { if (PHMASK & 32) {
        pg8::Gemm g{(const bf16_t*)(ws + WS_Y), (const bf16_t*)(ws + WS_WOUT), SEQ, 4096, 4096};
        Sched2 S; S.c = (int)blockIdx.x;
        Epi3 E{a.out, (bf16_t*)(ws + WS_T0), (float*)(ws + WS_SS), a.in[0], a.in[18], xbar};
        pg8::gemm_phase<Epi3, Sched2, true, true>(lds, g, S, E);
    } }
#if N_LAUNCHES != 1
    if (lo >= 7 && lo < 10) phase2(a, lds, 1 << (lo - 7));
    if (lo == 11 || lo == 12) {
        pg8::Gemm g{(const bf16_t*)(ws + WS_U), (const bf16_t*)(ws + WS_WT), SEQ + NMEM, INW + 2048, 4096};
        Sched1 S; S.init((int)gridDim.x, (int)blockIdx.x); if (lo == 11) S.imax = 4; else S.ioff = 4;
        Epi1 E{(bf16_t*)(ws + WS_PROJ), (bf16_t*)(ws + WS_VT), (bf16_t*)(ws + WS_MK), (bf16_t*)(ws + WS_MVT), (const float*)(ws + WS_ROPE)};
        pg8::gemm_phase<Epi1, Sched1, true, true>(lds, g, S, E);
    }
    if (lo == 13) {
        pg8::Gemm g{(const bf16_t*)(ws + WS_U), (const bf16_t*)(ws + WS_WT), SEQ + NMEM, INW + 2048, 4096};
        Sched1 S; S.init((int)gridDim.x, (int)blockIdx.x); S.imax = 4;
        pg8::EpiBf16<0> E{(bf16_t*)(ws + WS_HS), INW, nullptr, 0, 0, 1.f};
        pg8::gemm_phase<pg8::EpiBf16<0>, Sched1, true, true>(lds, g, S, E);
    }
#ifdef LRUVAR
    if (lo == 10) lru_phase<LRUVAR>(lds, a, (int)(blockIdx.x & 7), (int)(blockIdx.x >> 3), (int)(gridDim.x >> 3));
#endif
#endif
#undef IN
#undef SEAM
}

extern "C" void kernel_launch(void* const* d_in, const int* in_sizes, int n_in, void* d_out, int out_size, void* d_ws, size_t ws_size, hipStream_t stream) {
    static int grid = 0;
    if (grid == 0) {
        if (n_in != 19 || ws_size < WS_END) { fprintf(stderr, "kernel_launch: unexpected n_in %d or ws_size %zu (need %zu)\n", n_in, ws_size, (size_t)WS_END); grid = -1; return; }
        int dev = 0, cus = 0, per_cu = 0;
        hipGetDevice(&dev); hipDeviceGetAttribute(&cus, hipDeviceAttributeMultiprocessorCount, dev);
        if (hipFuncSetAttribute((const void*)mega, hipFuncAttributeMaxDynamicSharedMemorySize, LDS_BYTES) != hipSuccess) { fprintf(stderr, "kernel_launch: hipFuncSetAttribute failed\n"); grid = -1; return; }
        if (hipOccupancyMaxActiveBlocksPerMultiprocessor(&per_cu, (const void*)mega, 512, LDS_BYTES) != hipSuccess || per_cu < 1) { fprintf(stderr, "kernel_launch: occupancy query says %d\n", per_cu); per_cu = 1; }
        (void)hipGetLastError();
        if (cus < 256) { fprintf(stderr, "kernel_launch: needs 256 CUs (one workgroup per CU), device has %d\n", cus); grid = -1; return; }
        grid = 256;
    }
    if (grid < 0) return;
    Args a{};
    for (int i = 0; i < 19; ++i) a.in[i] = (const float*)d_in[i];
    a.out = (float*)d_out; a.ws = (unsigned char*)d_ws;
#if N_LAUNCHES == 1
    (void)hipMemsetAsync((char*)d_ws + WS_CTL, 0, 65536, stream);
    a.ph_lo = 0; a.ph_hi = NPH;
    void* args[] = {&a};
    hipError_t e = hipLaunchCooperativeKernel((const void*)mega, dim3(grid), dim3(512), args, LDS_BYTES, stream);
    if (e != hipSuccess) fprintf(stderr, "cooperative launch failed: %s (grid %d)\n", hipGetErrorString(e), grid);
#else
#ifndef PHSEQ
#define PHSEQ 0,1,2,3,4,5,6
#endif
    { const int seq[] = {PHSEQ};
      for (unsigned i = 0; i < sizeof(seq) / sizeof(int); ++i) { a.ph_lo = seq[i]; a.ph_hi = seq[i] + 1; (void)hipMemsetAsync((char*)d_ws + WS_CTL, 0, 65536, stream); hipLaunchKernelGGL(mega, dim3(grid), dim3(512), LDS_BYTES, stream, a); } }
#endif
}
```

```cpp
#include <hip/hip_runtime.h>
#include <hip/hip_cooperative_groups.h>
#include <cstdio>
#include <cstdint>
namespace cg = cooperative_groups;
#define N_LAUNCHES 1
namespace pg8 {
#define PG8_LAS __attribute__((address_space(3)))
typedef unsigned short bf16_t;
typedef short bf16x8 __attribute__((ext_vector_type(8)));
typedef float f32x4 __attribute__((ext_vector_type(4)));
typedef unsigned u32x4 __attribute__((ext_vector_type(4)));
constexpr int BM = 256, BK = 64, HALF = 128, HTB = HALF * BK * 2  , STAGE_BYTES = 8 * HTB, NXCD = 8, WGM = 8;

__host__ __device__ __forceinline__ int lds_byte(int r, int c) { const int st = (r >> 4) * 2 + (c >> 5), rr = r & 15, cc = c & 31, ob = rr * 64 + cc * 2; return st * 1024 + (ob ^ (((ob >> 9) & 1) << 5)); }
__host__ __device__ __forceinline__ void stage_rc(int b, int& R, int& C) { const int st = b / 1024, sb = b % 1024, swz = sb ^ (((sb >> 9) & 1) << 5); R = (st >> 1) * 16 + swz / 64; C = (st & 1) * 32 + (swz % 64) / 2; }
__host__ __device__ __forceinline__ int perm32(int rho) { const int n = rho >> 4, i = rho & 15; return 8 * (i >> 2) + 4 * n + (i & 3); }

struct Unit { int pm, pn; };
struct Gemm { const bf16_t* A; const bf16_t* Bt; int M, N, K; };

struct StaticOrder {
    int nM, nN, nwg, G, c;
    __host__ __device__ void init(int M, int N, int G_, int c_) { nM = M / BM; nN = N / BM; nwg = nM * nN; G = G_; c = c_; }
    __host__ __device__ bool next(int i, Unit& u) const {
        const long L = (long)i * G + c; if (L >= nwg) return false;
        int wgid = (int)L; { const int q = nwg / NXCD, r = nwg % NXCD, xcd = wgid % NXCD, off = wgid / NXCD; wgid = (xcd < r ? xcd * (q + 1) : r * (q + 1) + (xcd - r) * q) + off; }
        const int nig = WGM * nN, gid = wgid / nig, fm = gid * WGM, gsz = (nM - fm) < WGM ? (nM - fm) : WGM;
        u.pm = fm + ((wgid % nig) % gsz); u.pn = (wgid % nig) / gsz; return true;
    }
    __device__ __forceinline__ void a_ready(const Unit&) const {}
    __device__ __forceinline__ void done(const Unit&) const {}
};

__device__ __forceinline__ unsigned cvt_pk_bf16(float lo, float hi) { unsigned r; asm volatile("v_cvt_pk_bf16_f32 %0, %1, %2" : "=v"(r) : "v"(lo), "v"(hi)); return r; }
typedef float f32x2 __attribute__((ext_vector_type(2)));
__device__ __forceinline__ f32x2 gelu_pk(f32x2 v) {
    const f32x2 av = __builtin_elementwise_abs(v), d = av * 0.2316418882f + 1.0f;
    f32x2 t; t.x = __builtin_amdgcn_rcpf(d.x); t.y = __builtin_amdgcn_rcpf(d.y);
    f32x2 q = t * 0.5307027145f + (-0.7265760135f); q = q * t + 0.7107068705f; q = q * t + (-0.142248368f); q = q * t + 0.127414796f; q = q * t;
    const f32x2 s = (v * v) * (-0.72134752044f);
    f32x2 e; e.x = __builtin_amdgcn_exp2f(s.x); e.y = __builtin_amdgcn_exp2f(s.y);
    const f32x2 m = v * (q * e), r = v - m;
    f32x2 o; o.x = v.x < 0.f ? m.x : r.x; o.y = v.y < 0.f ? m.y : r.y; return o;
}

template <int ACT  > struct EpiBf16 {
    static constexpr bool PERM = true, AFTER_DRAIN = false, HOLD_LAST = false; static_assert(ACT == 0 || ACT == 1, "EpiBf16: ACT is 0 (none) or 1 (gelu_pk)");
    bf16_t* O; int ldc; const float* bias; int split_cols; size_t split_stride; float scale0;
    __device__ __forceinline__ void operator()(const f32x4 (&acc)[2][2][4][2], const Unit& u, int wr, int wc, int fr, int fq) const {
        const int row0 = u.pm * BM + wr * 64 + fr; int colt = u.pn * BM; bf16_t* base = O;
        float sc = 1.f; if (split_cols) { const int t = colt / split_cols; base += (size_t)t * split_stride; colt -= t * split_cols; if (t == 0) sc = scale0; }
        const int col0 = colt + wc * 32 + 8 * fq, bcol0 = u.pn * BM + wc * 32 + 8 * fq;
        f32x4 bv[2][2];
#pragma unroll
        for (int bj = 0; bj < 2; ++bj)
#pragma unroll
            for (int n = 0; n < 2; ++n) bv[bj][n] = bias ? *(const f32x4*)(bias + bcol0 + bj * HALF + 4 * n) : (f32x4){0.f, 0.f, 0.f, 0.f};
#pragma unroll
        for (int ai = 0; ai < 2; ++ai)
#pragma unroll
            for (int m = 0; m < 4; ++m) { bf16_t* rowp = base + (size_t)(row0 + ai * HALF + m * 16) * ldc + col0;
#pragma unroll
                for (int bj = 0; bj < 2; ++bj) { f32x4 v0 = acc[ai][bj][m][0] + bv[bj][0], v1 = acc[ai][bj][m][1] + bv[bj][1];
                    if (ACT == 1) { f32x2 a = gelu_pk((f32x2){v0[0], v0[1]}), b = gelu_pk((f32x2){v0[2], v0[3]}), c = gelu_pk((f32x2){v1[0], v1[1]}), d = gelu_pk((f32x2){v1[2], v1[3]});
                        v0 = (f32x4){a.x, a.y, b.x, b.y}; v1 = (f32x4){c.x, c.y, d.x, d.y}; }
                    v0 = v0 * sc; v1 = v1 * sc; u32x4 w; w.x = cvt_pk_bf16(v0[0], v0[1]); w.y = cvt_pk_bf16(v0[2], v0[3]); w.z = cvt_pk_bf16(v1[0], v1[1]); w.w = cvt_pk_bf16(v1[2], v1[3]);
                    *(u32x4*)(rowp + bj * HALF) = w; } }
    }
};
template <class Epi, class Sched, bool ALIGN_EPI = false, bool SP2 = false>
__device__ __forceinline__ void gemm_phase(PG8_LAS unsigned char* lds, const Gemm g, const Sched& S, const Epi& E) {
    int tid_ = threadIdx.x; asm volatile("" : "+v"(tid_)); const int tid = tid_, wid = __builtin_amdgcn_readfirstlane(tid >> 6), lane = tid & 63, wr = wid >> 2, wc = wid & 3, fr = lane & 15, fq = lane >> 4;
    const int K = g.K, nt = K / BK;
    unsigned voffA[2], voffB[2];
#pragma unroll
    for (int i = 0; i < 2; ++i) { int R, C; stage_rc(tid * 16 + i * 8192, R, C); const int Rb = Epi::PERM ? ((R & ~31) + perm32(R & 31)) : R;
        voffA[i] = (unsigned)(R * K + C) * 2u; voffB[i] = (unsigned)(Rb * K + C) * 2u; }
    const size_t kstep = (size_t)(BK * 2);
    const size_t hstep = (size_t)HALF * K * 2;
    const size_t tstep = 2 * hstep;
    const unsigned ldsw = (unsigned)wid * 1024u;
    const int aoff = lds_byte(wr * 64 + fr, fq * 8), boff = lds_byte(wc * 32 + fr, fq * 8);
#define PG8_SA(b, h) (((b) * 2 + (h)) * HTB)
#define PG8_SB(b, h) ((4 + (b) * 2 + (h)) * HTB)
#define PG8_STAGE(bufoff, gbase, voff) do { _Pragma("unroll") for (int _i = 0; _i < 2; ++_i) \
        __builtin_amdgcn_global_load_lds((const unsigned*)((const char*)(gbase) + (voff)[_i]), (PG8_LAS unsigned*)(lds + (bufoff) + ldsw + _i * 8192), 16, 0, 0); } while (0)
#define PG8_LDA(dst, b, h) do { _Pragma("unroll") for (int m = 0; m < 4; ++m) _Pragma("unroll") for (int k = 0; k < 2; ++k) dst[m][k] = *(const PG8_LAS bf16x8*)(lds + PG8_SA(b, h) + aoff + m * 2048 + k * 1024); } while (0)
#define PG8_LDB(dst, b, h) do { _Pragma("unroll") for (int n = 0; n < 2; ++n) _Pragma("unroll") for (int k = 0; k < 2; ++k) dst[n][k] = *(const PG8_LAS bf16x8*)(lds + PG8_SB(b, h) + boff + n * 2048 + k * 1024); } while (0)
#define PG8_MMA(ai, bj, At, Bt) do { __builtin_amdgcn_s_setprio(1); _Pragma("unroll") for (int m = 0; m < 4; ++m) _Pragma("unroll") for (int n = 0; n < 2; ++n) _Pragma("unroll") for (int k = 0; k < 2; ++k) \
        acc[ai][bj][m][n] = __builtin_amdgcn_mfma_f32_16x16x32_bf16(Bt[n][k], At[m][k], acc[ai][bj][m][n], 0, 0, 0); __builtin_amdgcn_s_setprio(0); } while (0)
#define PG8_WAIT_V(n) asm volatile("s_waitcnt vmcnt(" #n ")" ::: "memory")
#define PG8_WAIT_L(n) asm volatile("s_waitcnt lgkmcnt(" #n ")" ::: "memory")
#define PG8_BAR __builtin_amdgcn_s_barrier()
#define PG8_SCHED __builtin_amdgcn_sched_barrier(0)
    Unit cur, nxt; int ui = 0;
    if (!S.next(0, cur)) return;
    f32x4 acc[2][2][4][2];
#pragma unroll
    for (int a = 0; a < 2; ++a)
#pragma unroll
        for (int b = 0; b < 2; ++b)
#pragma unroll
            for (int m = 0; m < 4; ++m)
#pragma unroll
                for (int n = 0; n < 2; ++n) acc[a][b][m][n] = (f32x4){0.f, 0.f, 0.f, 0.f};
    bf16x8 At[4][2], B0[2][2], B1[2][2];
    const char* cA = (const char*)g.A + (size_t)cur.pm * tstep; const char* cB = (const char*)g.Bt + (size_t)cur.pn * tstep;
    S.a_ready(cur);
    if constexpr (SP2) {
        PG8_STAGE(PG8_SB(0, 0), cB, voffB); PG8_STAGE(PG8_SB(0, 1), cB + hstep, voffB); PG8_STAGE(PG8_SA(0, 0), cA, voffA); PG8_STAGE(PG8_SA(0, 1), cA + hstep, voffA);
        if (wr == 1) PG8_BAR;
        PG8_WAIT_V(2); PG8_BAR;
        PG8_STAGE(PG8_SB(1, 0), cB + kstep, voffB); PG8_STAGE(PG8_SA(1, 0), cA + kstep, voffA); PG8_STAGE(PG8_SB(1, 1), cB + hstep + kstep, voffB);
        PG8_WAIT_V(6); PG8_BAR;
    } else {
        PG8_STAGE(PG8_SB(0, 0), cB, voffB); PG8_STAGE(PG8_SA(0, 0), cA, voffA); PG8_STAGE(PG8_SB(0, 1), cB + hstep, voffB); PG8_STAGE(PG8_SA(0, 1), cA + hstep, voffA);
        if (wr == 1) PG8_BAR;
        PG8_WAIT_V(4); PG8_BAR;
        PG8_STAGE(PG8_SB(1, 0), cB + kstep, voffB); PG8_STAGE(PG8_SA(1, 0), cA + kstep, voffA); PG8_STAGE(PG8_SB(1, 1), cB + hstep + kstep, voffB);
        PG8_WAIT_V(6); PG8_BAR;
    }
    for (;;) {
        const bool has_next = S.next(ui + 1, nxt);
        const char* nA = has_next ? (const char*)g.A + (size_t)nxt.pm * tstep : cA; const char* nB = has_next ? (const char*)g.Bt + (size_t)nxt.pn * tstep : cB;
        for (int t = 0; t < nt; t += 2) {
            const bool last = (t == nt - 2);
            const char* a1 = cA + (size_t)(t + 1) * kstep;
            const char* a2 = last ? nA : cA + (size_t)(t + 2) * kstep; const char* b2 = last ? nB : cB + (size_t)(t + 2) * kstep;
            const char* a3 = a2 + kstep; const char* b3 = b2 + kstep;
            if (last && has_next) S.a_ready(nxt);
            if constexpr (SP2) {
            PG8_LDB(B0, 0, 0); PG8_LDB(B1, 0, 1); PG8_SCHED; PG8_LDA(At, 0, 0); PG8_STAGE(PG8_SA(1, 1), a1 + hstep, voffA);
            PG8_WAIT_V(8); PG8_WAIT_L(0); PG8_BAR; PG8_MMA(0, 0, At, B0); PG8_MMA(0, 1, At, B1); PG8_BAR; PG8_SCHED;
            PG8_LDA(At, 0, 1); PG8_STAGE(PG8_SB(0, 0), b2, voffB); PG8_STAGE(PG8_SB(0, 1), b2 + hstep, voffB); PG8_STAGE(PG8_SA(0, 0), a2, voffA);
            PG8_WAIT_V(8); PG8_WAIT_L(0); PG8_BAR; PG8_MMA(1, 0, At, B0); PG8_MMA(1, 1, At, B1); PG8_BAR; PG8_SCHED;
            PG8_LDB(B0, 1, 0); PG8_LDB(B1, 1, 1); PG8_SCHED; PG8_LDA(At, 1, 0); PG8_STAGE(PG8_SA(0, 1), a2 + hstep, voffA);
            PG8_WAIT_V(8); PG8_WAIT_L(0); PG8_BAR; PG8_MMA(0, 0, At, B0); PG8_MMA(0, 1, At, B1); PG8_BAR; PG8_SCHED;
            PG8_LDA(At, 1, 1); PG8_STAGE(PG8_SB(1, 0), b3, voffB); PG8_STAGE(PG8_SB(1, 1), b3 + hstep, voffB); PG8_STAGE(PG8_SA(1, 0), a3, voffA);
            PG8_WAIT_V(8); PG8_WAIT_L(0); PG8_BAR; PG8_MMA(1, 0, At, B0); PG8_MMA(1, 1, At, B1); PG8_BAR; PG8_SCHED;
            } else {
            PG8_LDB(B0, 0, 0); PG8_SCHED; PG8_LDA(At, 0, 0); PG8_STAGE(PG8_SA(1, 1), a1 + hstep, voffA);
            PG8_WAIT_L(8); PG8_BAR; PG8_WAIT_L(0); PG8_MMA(0, 0, At, B0); PG8_BAR; PG8_SCHED;
            PG8_LDB(B1, 0, 1); PG8_STAGE(PG8_SB(0, 0), b2, voffB);
            PG8_BAR; PG8_WAIT_L(0); PG8_MMA(0, 1, At, B1); PG8_BAR;
            PG8_LDA(At, 0, 1); PG8_STAGE(PG8_SA(0, 0), a2, voffA);
            PG8_BAR; PG8_WAIT_L(0); PG8_MMA(1, 0, At, B0); PG8_BAR; PG8_SCHED;
            PG8_STAGE(PG8_SB(0, 1), b2 + hstep, voffB);
            PG8_WAIT_V(6); PG8_BAR; PG8_MMA(1, 1, At, B1); PG8_BAR;
            PG8_LDB(B0, 1, 0); PG8_SCHED; PG8_LDA(At, 1, 0); PG8_STAGE(PG8_SA(0, 1), a2 + hstep, voffA);
            PG8_WAIT_L(8); PG8_BAR; PG8_WAIT_L(0); PG8_MMA(0, 0, At, B0); PG8_BAR; PG8_SCHED;
            PG8_LDB(B1, 1, 1); PG8_STAGE(PG8_SB(1, 0), b3, voffB);
            PG8_BAR; PG8_WAIT_L(0); PG8_MMA(0, 1, At, B1); PG8_BAR;
            PG8_LDA(At, 1, 1); PG8_STAGE(PG8_SA(1, 0), a3, voffA);
            PG8_BAR; PG8_WAIT_L(0); PG8_MMA(1, 0, At, B0); PG8_BAR; PG8_SCHED;
            PG8_STAGE(PG8_SB(1, 1), b3 + hstep, voffB);
            PG8_WAIT_V(6); PG8_BAR; PG8_MMA(1, 1, At, B1); PG8_BAR;
            }
        }
        if constexpr (ALIGN_EPI) { if (wr == 0) PG8_BAR; }
        if constexpr (!Epi::AFTER_DRAIN) { if (!Epi::HOLD_LAST || has_next) { E(acc, cur, wr, wc, fr, fq); S.done(cur); } }
        if (!has_next) break;
#pragma unroll
        for (int a = 0; a < 2; ++a)
#pragma unroll
            for (int b = 0; b < 2; ++b)
#pragma unroll
                for (int m = 0; m < 4; ++m)
#pragma unroll
                    for (int n = 0; n < 2; ++n) acc[a][b][m][n] = (f32x4){0.f, 0.f, 0.f, 0.f};
        cur = nxt; cA = nA; cB = nB; ++ui;
        if constexpr (ALIGN_EPI) { if (wr == 1) PG8_BAR; }
    }
    PG8_WAIT_V(0);
    if constexpr (!ALIGN_EPI) { if (wr == 0) PG8_BAR; }
    PG8_BAR;
    if constexpr (Epi::AFTER_DRAIN || Epi::HOLD_LAST) { E.fused(acc, cur, wr, wc, fr, fq, lds, wid, lane); S.done(cur); }
#undef PG8_SA
#undef PG8_SB
#undef PG8_STAGE
#undef PG8_LDA
#undef PG8_LDB
#undef PG8_MMA
#undef PG8_WAIT_V
#undef PG8_WAIT_L
#undef PG8_BAR
#undef PG8_SCHED
}
}

#ifndef PHMASK
#define PHMASK 127
#endif
#ifndef REPMASK
#define REPMASK 0
#endif
#ifndef P2MASK
#define P2MASK 7
#endif
#ifndef N_LAUNCHES
#define N_LAUNCHES 1
#endif
using pg8::bf16_t; using pg8::bf16x8; using pg8::f32x4; using pg8::u32x4;
#define LAS __attribute__((address_space(3)))
typedef unsigned u32x2 __attribute__((ext_vector_type(2)));
typedef float f32x2 __attribute__((ext_vector_type(2)));

constexpr int SEQ = 8192, DMODEL = 4096, INW = 9216, NMEM = 256;
constexpr int C_QA = 0, C_KA = 2048, C_VA = 2560, C_XL = 3072, C_QM = 4096, C_ZA = 5120, C_ZL = 7168, C_ZM = 8192;
constexpr float EPSN = 1e-6f;
constexpr float LOG2E = 1.4426950408889634f;
constexpr float SC_ATT = 0.08838834764831845f * LOG2E;
constexpr float SC_MEM = 0.0625f * LOG2E;
constexpr int NPH = 7;
constexpr int LDS_BYTES = 147456;

constexpr size_t MiB = 1u << 20;
constexpr size_t WS_CTL = 0, WS_LRUW = 1 * MiB, WS_ROPE = 2 * MiB, WS_MK = 3 * MiB, WS_MVT = 3 * MiB + 512 * 1024, WS_SS = 4 * MiB,
                 WS_AGG1 = 6 * MiB, WS_AGG2 = 10 * MiB, WS_VT = 12 * MiB, WS_WOUT = 20 * MiB, WS_WT = 52 * MiB, WS_U = 140 * MiB,
                 WS_PROJ = 206 * MiB, WS_HS = 350 * MiB, WS_PP = 382 * MiB, WS_YATT = 414 * MiB, WS_YMEM = 446 * MiB, WS_T0 = 462 * MiB, WS_END = 494 * MiB;
constexpr size_t WS_Y = WS_U;

struct Args { const float* in[19]; float* out; unsigned char* ws; int ph_lo, ph_hi; };

__device__ __forceinline__ unsigned pk2(float lo, float hi) { return pg8::cvt_pk_bf16(lo, hi); }
__device__ __forceinline__ float bflo(unsigned u) { return __builtin_bit_cast(float, u << 16); }
__device__ __forceinline__ float bfhi(unsigned u) { return __builtin_bit_cast(float, u & 0xffff0000u); }
template <int CTRL> __device__ __forceinline__ float dpp_mov(float v) { return __uint_as_float(__builtin_amdgcn_update_dpp(0u, __float_as_uint(v), CTRL, 0xF, 0xF, true)); }
__device__ __forceinline__ float xor16_add(float v) { auto r = __builtin_amdgcn_permlane16_swap(__float_as_uint(v), __float_as_uint(v), false, false); return __uint_as_float(r[0]) + __uint_as_float(r[1]); }
__device__ __forceinline__ float xor32_add(float v) { auto r = __builtin_amdgcn_permlane32_swap(__float_as_uint(v), __float_as_uint(v), false, false); return __uint_as_float(r[0]) + __uint_as_float(r[1]); }
__device__ __forceinline__ float xor16_max(float v) { auto r = __builtin_amdgcn_permlane16_swap(__float_as_uint(v), __float_as_uint(v), false, false); return fmaxf(__uint_as_float(r[0]), __uint_as_float(r[1])); }
__device__ __forceinline__ float xor32_max(float v) { auto r = __builtin_amdgcn_permlane32_swap(__float_as_uint(v), __float_as_uint(v), false, false); return fmaxf(__uint_as_float(r[0]), __uint_as_float(r[1])); }
__device__ __forceinline__ float xor32_get(float v, bool upper) { auto r = __builtin_amdgcn_permlane32_swap(__float_as_uint(v), __float_as_uint(v), false, false); return __uint_as_float(upper ? r[0] : r[1]); }
__device__ __forceinline__ float wave_sum(float v) {
    v += dpp_mov<0xB1>(v);
    v += dpp_mov<0x4E>(v);
    v += dpp_mov<0x141>(v);
    v += dpp_mov<0x140>(v);
    v = xor16_add(v); v = xor32_add(v);
    return v;
}
__device__ __forceinline__ float fexp2(float x) { return __builtin_amdgcn_exp2f(x); }
__device__ __forceinline__ float sigmoidf_(float x) { return 1.f / (1.f + __expf(-x)); }
__device__ __forceinline__ float fsigmoid(float x) { return __builtin_amdgcn_rcpf(1.f + __builtin_amdgcn_exp2f(-x * 1.4426950408889634f)); }
__device__ __forceinline__ f32x4 mfma16(bf16x8 a, bf16x8 b, f32x4 c) { return __builtin_amdgcn_mfma_f32_16x16x32_bf16(a, b, c, 0, 0, 0); }

__device__ __forceinline__ void p0_item_load(const float* W, int N, int item, int lane, float (&r)[32]) {
    const int nblk = N / 32, kb = item / nblk, nb = item % nblk, k0 = 64 * kb, n0 = 32 * nb;
#pragma unroll
    for (int i = 0; i < 32; ++i) { const int kk = 2 * i + (lane >> 5); r[i] = __builtin_nontemporal_load(W + (size_t)(k0 + kk) * N + n0 + (lane & 31)); }
}
__device__ __forceinline__ void p0_item_lds_write(LAS float* scr, int lane, const float (&r)[32]) {
#pragma unroll
    for (int i = 0; i < 32; ++i) { const int kk = 2 * i + (lane >> 5); scr[kk * 33 + (lane & 31)] = r[i]; }
}
__device__ __forceinline__ void p0_item_store(int K, int N, bf16_t* WT, int row_off, LAS float* scr, int item, int lane) {
    const int nblk = N / 32, kb = item / nblk, nb = item % nblk, k0 = 64 * kb, n0 = 32 * nb;
    asm volatile("s_waitcnt lgkmcnt(0)" ::: "memory");
    const int c = lane & 7;
#pragma unroll
    for (int j = 0; j < 4; ++j) { const int n = (lane >> 3) + 8 * j; const LAS float* s = scr + (8 * c) * 33 + n;
        u32x4 o; o.x = pk2(s[0 * 33], s[1 * 33]); o.y = pk2(s[2 * 33], s[3 * 33]); o.z = pk2(s[4 * 33], s[5 * 33]); o.w = pk2(s[6 * 33], s[7 * 33]);
        *(u32x4*)(WT + (size_t)(row_off + n0 + n) * K + k0 + 8 * c) = o; }
    asm volatile("s_waitcnt lgkmcnt(0)" ::: "memory");
}
__device__ __forceinline__ void p0_transpose_item(const float* W, int K, int N, bf16_t* WT, int row_off, LAS float* scr, int item, int lane) {
    float r[32]; p0_item_load(W, N, item, lane, r); p0_item_lds_write(scr, lane, r); p0_item_store(K, N, WT, row_off, scr, item, lane);
}
__device__ __forceinline__ void p0_transpose_matrix(const float* W, int K, int N, bf16_t* WT, int row_off, LAS float* scr, int first, int step, int lane) {
    const int nitems = (K / 64) * (N / 32);
    if (first >= nitems) return;
    float r[32]; p0_item_load(W, N, first, lane, r);
#pragma unroll 1
    for (int it = first; it < nitems; it += step) {
        p0_item_lds_write(scr, lane, r);
        if (it + step < nitems) p0_item_load(W, N, it + step, lane, r);
        p0_item_store(K, N, WT, row_off, scr, it, lane);
    }
}
__device__ __forceinline__ void rms_row_to_bf16(const float* xrow, const f32x4 (&gv)[16], bf16_t* orow, int lane) {
    const f32x4* xr = (const f32x4*)xrow + lane;
    f32x4 v[16]; float s = 0.f;
#pragma unroll
    for (int k = 0; k < 16; ++k) { v[k] = __builtin_nontemporal_load(xr + 64 * k); s += (v[k].x * v[k].x + v[k].y * v[k].y) + (v[k].z * v[k].z + v[k].w * v[k].w); }
    const float rs = 1.f / sqrtf(wave_sum(s) * (1.f / 4096.f) + EPSN);
    u32x2* o8 = (u32x2*)orow + lane;
#pragma unroll
    for (int k = 0; k < 16; ++k) { const f32x4 g4 = gv[k]; u32x2 o; o.x = pk2(v[k].x * rs * g4.x, v[k].y * rs * g4.y); o.y = pk2(v[k].z * rs * g4.z, v[k].w * rs * g4.w); o8[64 * k] = o; }
}

__device__ __forceinline__ void phase0(const Args& a, LAS unsigned char* lds) {
    int tid = threadIdx.x; asm volatile("" : "+v"(tid)); const int lane = tid & 63, w = tid >> 6, G = gridDim.x;
    const int gw = blockIdx.x * 8 + w, NGW = G * 8;
    unsigned char* ws = a.ws;
    LAS float* scr = (LAS float*)(lds + w * 16384);
    bf16_t* WT = (bf16_t*)(ws + WS_WT); bf16_t* WOUT = (bf16_t*)(ws + WS_WOUT); bf16_t* LRUW = (bf16_t*)(ws + WS_LRUW);
    constexpr int I_IN = 64 * (INW / 32), I_MKV = 64 * (2048 / 32), I_OUT = 64 * (4096 / 32), I_LRU = 32 * 8;
    p0_transpose_matrix(a.in[3], 4096, INW, WT, 0, scr, gw, NGW, lane);
    p0_transpose_matrix(a.in[13], 4096, 2048, WT, INW, scr, gw, NGW, lane);
    for (int r = gw; r < I_LRU; r += NGW) {
        const int mat = r >> 3, sub = r & 7, gate = mat >> 4, dn = mat & 15;
        const float* src = (gate ? a.in[9] : a.in[7]) + (size_t)dn * 16384;
        p0_transpose_item(src, 128, 128, LRUW + (size_t)mat * 16384, 0, scr, sub, lane);
    }
    bf16_t* U = (bf16_t*)(ws + WS_U);
    { f32x4 gv[16];
#pragma unroll
      for (int k = 0; k < 16; ++k) gv[k] = ((const f32x4*)a.in[2])[lane + 64 * k];
      for (int m = gw; m < SEQ; m += NGW) rms_row_to_bf16(a.in[0] + (size_t)m * 4096, gv, U + (size_t)m * 4096, lane);
#pragma unroll
      for (int k = 0; k < 16; ++k) gv[k] = ((const f32x4*)a.in[12])[lane + 64 * k];
      for (int m = gw; m < NMEM; m += NGW) rms_row_to_bf16(a.in[1] + (size_t)m * 4096, gv, U + (size_t)(SEQ + m) * 4096, lane); }
    f32x2* rope = (f32x2*)(ws + WS_ROPE);
    for (int e = blockIdx.x * 512 + tid; e < SEQ * 16; e += G * 512) {
        const int pos = e >> 4, i = e & 15;
        const float inv = powf(500000.0f, -(float)i * (1.0f / 16.0f));
        const float ang = (float)pos * inv;
        rope[e] = (f32x2){cosf(ang), sinf(ang)};
    }
}

struct Sched1 {
    pg8::StaticOrder so; int G, c, ioff, imax;
    __device__ void init(int G_, int c_) { so.init(SEQ, INW, G_, c_); G = G_; c = c_; ioff = 0; imax = 1 << 20; }
    __device__ bool next(int i0, pg8::Unit& u) const {
        if (i0 >= imax) return false;
        const int i = i0 + ioff;
        const long L = (long)i * G + c;
        if (L < 1152) return so.next(i, u);
        if (L < 1160) { u.pm = 32; u.pn = 36 + (int)(L - 1152); return true; }
        return false;
    }
    __device__ __forceinline__ void a_ready(const pg8::Unit&) const {}
    __device__ __forceinline__ void done(const pg8::Unit&) const {}
};
struct Epi1 {
    static constexpr bool PERM = true, AFTER_DRAIN = false, HOLD_LAST = false;
    bf16_t* proj; bf16_t* vt; bf16_t* mk; bf16_t* mvt; const float* rope;
    __device__ __forceinline__ void operator()(const f32x4 (&acc)[2][2][4][2], const pg8::Unit& u, int wr, int wc, int fr, int fq) const {
        const int rloc = wr * 64 + fr, cloc = wc * 32 + 8 * fq;
        if (u.pm == 32) {
            const int t = u.pn - 36;
            if (t < 4) {
#pragma unroll
                for (int ai = 0; ai < 2; ++ai)
#pragma unroll
                    for (int m = 0; m < 4; ++m) { const int row = rloc + ai * 128 + m * 16;
#pragma unroll
                        for (int bj = 0; bj < 2; ++bj) { const f32x4 v0 = acc[ai][bj][m][0], v1 = acc[ai][bj][m][1];
                            u32x4 wv; wv.x = pk2(v0[0], v0[1]); wv.y = pk2(v0[2], v0[3]); wv.z = pk2(v1[0], v1[1]); wv.w = pk2(v1[2], v1[3]);
                            *(u32x4*)(mk + (size_t)row * 1024 + t * 256 + bj * 128 + cloc) = wv; } asm volatile("" ::: "memory"); }
            } else {
#pragma unroll
                for (int ai = 0; ai < 2; ++ai)
#pragma unroll
                    for (int m = 0; m < 4; ++m) { const int row = rloc + ai * 128 + m * 16;
#pragma unroll
                        for (int bj = 0; bj < 2; ++bj)
#pragma unroll
                            for (int n = 0; n < 2; ++n)
#pragma unroll
                                for (int i = 0; i < 4; ++i) { const int col = (t - 4) * 256 + bj * 128 + cloc + 4 * n + i;
                                    mvt[(size_t)col * 256 + row] = (bf16_t)(pk2(acc[ai][bj][m][n][i], 0.f) & 0xffffu); } asm volatile("" ::: "memory"); }
            }
            return;
        }
        const int pn = u.pn, row0 = u.pm * 256 + rloc;
        if (pn == 10 || pn == 11) {
#pragma unroll
            for (int ai = 0; ai < 2; ++ai)
#pragma unroll
                for (int m = 0; m < 4; ++m) { const int row = row0 + ai * 128 + m * 16;
#pragma unroll
                    for (int bj = 0; bj < 2; ++bj)
#pragma unroll
                        for (int n = 0; n < 2; ++n)
#pragma unroll
                            for (int i = 0; i < 4; ++i) { const int col = (pn - 10) * 256 + bj * 128 + cloc + 4 * n + i;
                                vt[(size_t)col * SEQ + row] = (bf16_t)(pk2(acc[ai][bj][m][n][i], 0.f) & 0xffffu); } asm volatile("" ::: "memory"); }
            return;
        }
        float sc = 1.f; if (pn < 8) sc = SC_ATT; else if (pn >= 16 && pn < 20) sc = SC_MEM;
        const bool do_rope = (pn < 10) && (wc == 0);
        const float sgn = (fq < 2) ? -1.f : 1.f;
        f32x4 csA[2][2], cst[2][2];
        if (do_rope) {
#pragma unroll
            for (int n = 0; n < 2; ++n) { const int io = (8 * (fq & 1) + 4 * n) * 2;
                const float* ra = rope + (size_t)row0 * 32 + io; const float* rt = rope + 16 * 32 + io;
                csA[n][0] = *(const f32x4*)ra; csA[n][1] = *(const f32x4*)(ra + 4); cst[n][0] = *(const f32x4*)rt; cst[n][1] = *(const f32x4*)(rt + 4); }
        }
#pragma unroll
        for (int ai = 0; ai < 2; ++ai)
#pragma unroll
            for (int m = 0; m < 4; ++m) { const int row = row0 + ai * 128 + m * 16;
                f32x4 cs[2][2];
                if (do_rope) {
                    const int nrot = (ai == 0 && m == 3) ? 5 : 1;
#pragma unroll
                    for (int n = 0; n < 2; ++n)
#pragma unroll
                        for (int hh = 0; hh < 2; ++hh) { f32x4 cur = csA[n][hh]; cs[n][hh] = cur; const f32x4 t = cst[n][hh];
#pragma unroll
                            for (int rr = 0; rr < 5; ++rr) { if (rr < nrot) { f32x4 nx; nx[0] = cur[0] * t[0] - cur[1] * t[1]; nx[1] = cur[1] * t[0] + cur[0] * t[1]; nx[2] = cur[2] * t[2] - cur[3] * t[3]; nx[3] = cur[3] * t[2] + cur[2] * t[3]; cur = nx; } }
                            csA[n][hh] = cur; }
                }
#pragma unroll
                for (int bj = 0; bj < 2; ++bj) { f32x4 v[2]; v[0] = acc[ai][bj][m][0]; v[1] = acc[ai][bj][m][1];
                    if (do_rope) {
#pragma unroll
                        for (int n = 0; n < 2; ++n) { f32x4 p; p[0] = xor32_get(v[n][0], fq >= 2); p[1] = xor32_get(v[n][1], fq >= 2); p[2] = xor32_get(v[n][2], fq >= 2); p[3] = xor32_get(v[n][3], fq >= 2);
                            f32x4 r; r[0] = v[n][0] * cs[n][0][0] + sgn * p[0] * cs[n][0][1]; r[1] = v[n][1] * cs[n][0][2] + sgn * p[1] * cs[n][0][3];
                            r[2] = v[n][2] * cs[n][1][0] + sgn * p[2] * cs[n][1][1]; r[3] = v[n][3] * cs[n][1][2] + sgn * p[3] * cs[n][1][3]; v[n] = r; }
                    }
                    u32x4 wv; wv.x = pk2(v[0][0] * sc, v[0][1] * sc); wv.y = pk2(v[0][2] * sc, v[0][3] * sc); wv.z = pk2(v[1][0] * sc, v[1][1] * sc); wv.w = pk2(v[1][2] * sc, v[1][3] * sc);
                    __builtin_nontemporal_store(wv, (u32x4*)(proj + (size_t)row * INW + pn * 256 + bj * 128 + cloc)); } asm volatile("" ::: "memory"); }
    }
};

template <int DH, bool PF, bool DB>
__device__ __forceinline__ void attn_unit(LAS unsigned char* lds, const bf16_t* Qp, int ldq, bf16_t* Op, int ldo, const bf16_t* Kg, int ldk, const bf16_t* Vtg, int ldv,
                                          int cb_lo, int cb_hi, int cb_self, float m_init, float l_init) {
    constexpr int PR = DH / 8, KROW = DH * 2, KT = 128 * KROW, VROW = 288, NKI = (128 * PR) / 512, NVI = (DH * 16) / 512, NS = DH / 32, NDT = DH / 16;
    int tid = threadIdx.x; asm volatile("" : "+v"(tid)); const int lane = tid & 63, w = tid >> 6, q = lane & 15, g = lane >> 4;
    const int krow = 8 * (q >> 2) + (q & 3);
    bf16x8 qf[NS];
    { const unsigned qoff = (unsigned)(((16 * w + q) * ldq + 8 * g) * 2);
#pragma unroll
      for (int s = 0; s < NS; ++s) qf[s] = __builtin_nontemporal_load((const bf16x8*)((const char*)Qp + qoff + 64 * s)); }
    f32x4 o[NDT];
#pragma unroll
    for (int dt = 0; dt < NDT; ++dt) o[dt] = (f32x4){0.f, 0.f, 0.f, 0.f};
    float m_run = m_init, l_run = l_init;
    u32x4 kreg[NKI], vreg[NVI];
#define ATT_LOAD(cb) do { const int k0_ = (cb) * 128; \
        const char* kb_ = (const char*)Kg + (size_t)k0_ * ldk * 2; const char* vb_ = (const char*)Vtg + (size_t)k0_ * 2; \
        _Pragma("unroll") for (int it = 0; it < NKI; ++it) { const int e = tid + 512 * it; const int key = e / PR, pc = e % PR; \
            kreg[it] = *(const u32x4*)(kb_ + (unsigned)((key * ldk + pc * 8) * 2)); } \
        _Pragma("unroll") for (int it = 0; it < NVI; ++it) { const int e = tid + 512 * it; const int d = e >> 4, pc = e & 15; \
            vreg[it] = *(const u32x4*)(vb_ + (unsigned)((d * ldv + pc * 8) * 2)); } } while (0)
#define ATT_STORE() do { \
        _Pragma("unroll") for (int it = 0; it < NKI; ++it) { const int e = tid + 512 * it; const int key = e / PR, pc = e % PR; \
            *(LAS u32x4*)(lds + key * KROW + ((pc ^ ((((key >> 3) & 3) << 2) | (key & 3))) * 16)) = kreg[it]; } \
        _Pragma("unroll") for (int it = 0; it < NVI; ++it) { const int e = tid + 512 * it; const int d = e >> 4, pc = e & 15; \
            *(LAS u32x4*)(lds + KT + d * VROW + pc * 16) = vreg[it]; } } while (0)
    if (PF) ATT_LOAD(cb_lo);
    for (int cb = cb_lo; cb < cb_hi; ++cb) {
        if (!PF) ATT_LOAD(cb);
        __syncthreads();
        ATT_STORE();
        __syncthreads();
        if (PF) { if (cb + 1 < cb_hi) ATT_LOAD(cb + 1); }
        f32x4 s[8];
#pragma unroll
        for (int kt = 0; kt < 8; ++kt) s[kt] = (f32x4){0.f, 0.f, 0.f, 0.f};
        {
            bf16x8 ka[DB ? 2 : 1][8];
            if (DB) {
#pragma unroll
                for (int kt = 0; kt < 8; ++kt) ka[0][kt] = *(const LAS bf16x8*)(lds + (32 * (kt >> 1) + 4 * (kt & 1) + krow) * KROW + (((0 + g) ^ q) * 16));
            }
#pragma unroll
            for (int ss = 0; ss < NS; ++ss) {
                if (DB) { if (ss + 1 < NS) {
#pragma unroll
                    for (int kt = 0; kt < 8; ++kt) ka[(ss + 1) & 1][kt] = *(const LAS bf16x8*)(lds + (32 * (kt >> 1) + 4 * (kt & 1) + krow) * KROW + (((4 * (ss + 1) + g) ^ q) * 16)); }
                } else {
#pragma unroll
                    for (int kt = 0; kt < 8; ++kt) ka[0][kt] = *(const LAS bf16x8*)(lds + (32 * (kt >> 1) + 4 * (kt & 1) + krow) * KROW + (((4 * ss + g) ^ q) * 16));
                }
                __builtin_amdgcn_sched_barrier(0);
#pragma unroll
                for (int kt = 0; kt < 8; ++kt) s[kt] = mfma16(ka[DB ? (ss & 1) : 0][kt], qf[ss], s[kt]);
                __builtin_amdgcn_sched_barrier(0);
            }
        }
        if (cb != cb_self && cb_self >= 0) {
            const float sg = (cb < cb_self) ? 1.f : -1.f;
            const float dq = (float)(16 * w + q - 8 * g);
#pragma unroll
            for (int kt = 0; kt < 8; ++kt)
#pragma unroll
                for (int j = 0; j < 4; ++j) { const float v = sg * ((float)(32 * (kt >> 1) + 4 * (kt & 1) + j) - dq); s[kt][j] += fminf(v, 0.f) * 1e30f; }
        }
        float mx = s[0][0];
#pragma unroll
        for (int kt = 0; kt < 8; ++kt)
#pragma unroll
            for (int j = 0; j < 4; ++j) mx = fmaxf(mx, s[kt][j]);
        mx = xor16_max(mx); mx = xor32_max(mx);
        const float m_new = fmaxf(m_run, mx), alpha = fexp2(m_run - m_new); m_run = m_new;
        float rs = 0.f;
#pragma unroll
        for (int kt = 0; kt < 8; ++kt)
#pragma unroll
            for (int j = 0; j < 4; ++j) { const float p = fexp2(s[kt][j] - m_new); s[kt][j] = p; rs += p; }
        rs = xor16_add(rs); rs = xor32_add(rs);
        l_run = l_run * alpha + rs;
        bf16x8 pb[4];
#pragma unroll
        for (int u = 0; u < 4; ++u) { u32x4 t; t.x = pk2(s[2 * u][0], s[2 * u][1]); t.y = pk2(s[2 * u][2], s[2 * u][3]); t.z = pk2(s[2 * u + 1][0], s[2 * u + 1][1]); t.w = pk2(s[2 * u + 1][2], s[2 * u + 1][3]);
            pb[u] = __builtin_bit_cast(bf16x8, t); }
#pragma unroll
        for (int dt = 0; dt < NDT; ++dt) o[dt] = o[dt] * alpha;
        {
            constexpr int NG = (NDT / 8) * 4;
            u32x4 va[DB ? 2 : 1][8];
#define ATT_VLOAD(buf, gi) do { const int u_ = (gi) & 3, d0_ = 8 * ((gi) >> 2); \
            _Pragma("unroll") for (int i = 0; i < 8; ++i) { va[buf][i] = *(const LAS u32x4*)(lds + KT + (16 * (d0_ + i) + q) * VROW + (32 * u_ + 8 * g) * 2); } } while (0)
            if (DB) ATT_VLOAD(0, 0);
#pragma unroll
            for (int gi = 0; gi < NG; ++gi) {
                if (DB) { if (gi + 1 < NG) ATT_VLOAD((gi + 1) & 1, gi + 1); } else ATT_VLOAD(0, gi);
                __builtin_amdgcn_sched_barrier(0);
#pragma unroll
                for (int i = 0; i < 8; ++i) o[8 * (gi >> 2) + i] = mfma16(__builtin_bit_cast(bf16x8, va[DB ? (gi & 1) : 0][i]), pb[gi & 3], o[8 * (gi >> 2) + i]);
                __builtin_amdgcn_sched_barrier(0);
            }
#undef ATT_VLOAD
        }
    }
#undef ATT_LOAD
#undef ATT_STORE
    const float inv = 1.f / l_run;
    const unsigned ooff = (unsigned)(((16 * w + q) * ldo + 4 * g) * 2);
#pragma unroll
    for (int dt = 0; dt < NDT; ++dt) { u32x2 pkv; pkv.x = pk2(o[dt][0] * inv, o[dt][1] * inv); pkv.y = pk2(o[dt][2] * inv, o[dt][3] * inv); *(u32x2*)((char*)Op + ooff + 32 * dt) = pkv; }
}

__device__ __forceinline__ void windowed_stream(LAS unsigned char* lds0, const Args& a) {
    constexpr int DH = 128, PR = 16, KROW = 256, KT = 128 * KROW, VROW = 288, BUFB = KT + DH * VROW, NKI = 4, NVI = 4, NS = 4, NDT = 8;
    static_assert(2 * BUFB <= LDS_BYTES - 64, "two K/V tile buffers must fit under the barrier words");
    int tid = threadIdx.x; asm volatile("" : "+v"(tid)); const int lane = tid & 63, w = tid >> 6, q = lane & 15, g = lane >> 4;
    const int krow = 8 * (q >> 2) + (q & 3);
    unsigned char* ws = a.ws;
    const bf16_t* proj = (const bf16_t*)(ws + WS_PROJ); const bf16_t* vt = (const bf16_t*)(ws + WS_VT); bf16_t* yatt = (bf16_t*)(ws + WS_YATT);
    const int G = (int)gridDim.x;
    if ((int)blockIdx.x >= 1024) return;
    unsigned koff[NKI], voff[NVI], klds[NKI], vlds[NVI];
#pragma unroll
    for (int it = 0; it < NKI; ++it) { const int e = tid + 512 * it, key = e / PR, pc = e % PR; koff[it] = (unsigned)((key * INW + pc * 8) * 2); klds[it] = (unsigned)(key * KROW + ((pc ^ ((((key >> 3) & 3) << 2) | (key & 3))) * 16)); }
#pragma unroll
    for (int it = 0; it < NVI; ++it) { const int e = tid + 512 * it, d = e >> 4, pc = e & 15; voff[it] = (unsigned)((d * SEQ + pc * 8) * 2); vlds[it] = (unsigned)(KT + d * VROW + pc * 16); }
    u32x4 kreg[NKI], vreg[NVI];
#define WS_LOAD(v_, cb_) do { const int kvh_ = ((v_) & 15) >> 2; \
        const char* kb_ = (const char*)proj + ((size_t)((cb_) * 128) * INW + C_KA + kvh_ * 128) * 2; const char* vb_ = (const char*)vt + ((size_t)(kvh_ * 128) * SEQ + (cb_) * 128) * 2; \
        _Pragma("unroll") for (int it = 0; it < NKI; ++it) kreg[it] = *(const u32x4*)(kb_ + koff[it]); \
        _Pragma("unroll") for (int it = 0; it < NVI; ++it) vreg[it] = *(const u32x4*)(vb_ + voff[it]); } while (0)
#define WS_STORE(ldsb_) do { \
        _Pragma("unroll") for (int it = 0; it < NKI; ++it) *(LAS u32x4*)((ldsb_) + klds[it]) = kreg[it]; \
        _Pragma("unroll") for (int it = 0; it < NVI; ++it) *(LAS u32x4*)((ldsb_) + vlds[it]) = vreg[it]; } while (0)
#define WS_LO(v_) ((((v_) >> 4) > 0) ? ((v_) >> 4) - 1 : 0)
#define WS_HI(v_) ((((v_) >> 4) < 63) ? ((v_) >> 4) + 2 : 64)
    int Cv = (int)blockIdx.x, Ccb = WS_LO(Cv);
    int Lv = Cv, Lcb = Ccb; bool Lvalid = true;
#define WS_ADV_L() do { if (Lcb + 1 < WS_HI(Lv)) ++Lcb; else { Lv += G; if (Lv < 1024) Lcb = WS_LO(Lv); else Lvalid = false; } } while (0)
    __syncthreads();
    WS_LOAD(Lv, Lcb); WS_ADV_L();
    WS_STORE(lds0);
    bool have = false;
    if (Lvalid) { WS_LOAD(Lv, Lcb); WS_ADV_L(); have = true; }
    __syncthreads();
    int bsel = 0;
    bf16x8 qf[NS]; f32x4 o[NDT]; float m_run = 0.f, l_run = 1.f;
#pragma unroll 1
    for (;;) {
        const int qblk = Cv >> 4, hq = Cv & 15, lo = WS_LO(Cv), hi = WS_HI(Cv);
        LAS unsigned char* lds = lds0 + bsel * BUFB;
        if (Ccb == lo) {
            const unsigned qoff = (unsigned)(((16 * w + q) * INW + 8 * g) * 2);
            const char* qb = (const char*)proj + ((size_t)(qblk * 128) * INW + C_QA + hq * 128) * 2;
#pragma unroll
            for (int s = 0; s < NS; ++s) qf[s] = __builtin_nontemporal_load((const bf16x8*)(qb + qoff + 64 * s));
#pragma unroll
            for (int dt = 0; dt < NDT; ++dt) o[dt] = (f32x4){0.f, 0.f, 0.f, 0.f};
            m_run = a.in[4][hq] * LOG2E; l_run = 1.f;
        }
        if (have) { WS_STORE(lds0 + (bsel ^ 1) * BUFB); have = false; }
        if (Lvalid) { WS_LOAD(Lv, Lcb); WS_ADV_L(); have = true; }
        f32x4 s[8];
#pragma unroll
        for (int kt = 0; kt < 8; ++kt) s[kt] = (f32x4){0.f, 0.f, 0.f, 0.f};
        {
            bf16x8 ka[2][8];
#pragma unroll
            for (int kt = 0; kt < 8; ++kt) ka[0][kt] = *(const LAS bf16x8*)(lds + (32 * (kt >> 1) + 4 * (kt & 1) + krow) * KROW + (((0 + g) ^ q) * 16));
#pragma unroll
            for (int ss = 0; ss < NS; ++ss) {
                if (ss + 1 < NS) {
#pragma unroll
                    for (int kt = 0; kt < 8; ++kt) ka[(ss + 1) & 1][kt] = *(const LAS bf16x8*)(lds + (32 * (kt >> 1) + 4 * (kt & 1) + krow) * KROW + (((4 * (ss + 1) + g) ^ q) * 16)); }
                __builtin_amdgcn_sched_barrier(0);
#pragma unroll
                for (int kt = 0; kt < 8; ++kt) s[kt] = mfma16(ka[ss & 1][kt], qf[ss], s[kt]);
                __builtin_amdgcn_sched_barrier(0);
            }
        }
        if (Ccb != qblk) {
            const bool prev = Ccb < qblk; const int ud = __builtin_amdgcn_readfirstlane(w) >> 1;
            const float sg = prev ? 1.f : -1.f;
            const float dq = (float)(16 * w + q - 8 * g);
#pragma unroll
            for (int u = 0; u < 4; ++u) {
                if (prev ? (u < ud) : (u > ud)) {
#pragma unroll
                    for (int j = 0; j < 4; ++j) { s[2 * u][j] = -1e30f; s[2 * u + 1][j] = -1e30f; }
                } else if (u == ud) {
#pragma unroll
                    for (int h2 = 0; h2 < 2; ++h2)
#pragma unroll
                        for (int j = 0; j < 4; ++j) { const float v = sg * ((float)(32 * u + 4 * h2 + j) - dq); s[2 * u + h2][j] += fminf(v, 0.f) * 1e30f; }
                }
            }
        }
        float mx = s[0][0];
#pragma unroll
        for (int kt = 0; kt < 8; ++kt)
#pragma unroll
            for (int j = 0; j < 4; ++j) mx = fmaxf(mx, s[kt][j]);
        mx = xor16_max(mx); mx = xor32_max(mx);
        const float m_new = fmaxf(m_run, mx), alpha = fexp2(m_run - m_new); m_run = m_new;
        float rs = 0.f;
#pragma unroll
        for (int kt = 0; kt < 8; ++kt)
#pragma unroll
            for (int j = 0; j < 4; ++j) { const float p = fexp2(s[kt][j] - m_new); s[kt][j] = p; rs += p; }
        rs = xor16_add(rs); rs = xor32_add(rs);
        l_run = l_run * alpha + rs;
        bf16x8 pb[4];
#pragma unroll
        for (int u = 0; u < 4; ++u) { u32x4 t; t.x = pk2(s[2 * u][0], s[2 * u][1]); t.y = pk2(s[2 * u][2], s[2 * u][3]); t.z = pk2(s[2 * u + 1][0], s[2 * u + 1][1]); t.w = pk2(s[2 * u + 1][2], s[2 * u + 1][3]);
            pb[u] = __builtin_bit_cast(bf16x8, t); }
#pragma unroll
        for (int dt = 0; dt < NDT; ++dt) o[dt] = o[dt] * alpha;
        {
            u32x4 va[2][8];
#define WS_VLOAD(buf, gi) do { _Pragma("unroll") for (int i = 0; i < 8; ++i) { va[buf][i] = *(const LAS u32x4*)(lds + KT + (16 * i + q) * VROW + (32 * (gi) + 8 * g) * 2); } } while (0)
            WS_VLOAD(0, 0);
#pragma unroll
            for (int gi = 0; gi < 4; ++gi) {
                if (gi + 1 < 4) WS_VLOAD((gi + 1) & 1, gi + 1);
                __builtin_amdgcn_sched_barrier(0);
#pragma unroll
                for (int i = 0; i < 8; ++i) o[i] = mfma16(__builtin_bit_cast(bf16x8, va[gi & 1][i]), pb[gi], o[i]);
                __builtin_amdgcn_sched_barrier(0);
            }
#undef WS_VLOAD
        }
        bool done = false;
        if (Ccb + 1 < hi) ++Ccb;
        else {
            const float inv = 1.f / l_run;
            char* ob = (char*)yatt + ((size_t)(qblk * 128) * 2048 + hq * 128) * 2;
            const unsigned ooff = (unsigned)(((16 * w + q) * 2048 + 4 * g) * 2);
#pragma unroll
            for (int dt = 0; dt < NDT; ++dt) { u32x2 pkv; pkv.x = pk2(o[dt][0] * inv, o[dt][1] * inv); pkv.y = pk2(o[dt][2] * inv, o[dt][3] * inv); *(u32x2*)(ob + ooff + 32 * dt) = pkv; }
            Cv += G; if (Cv < 1024) Ccb = WS_LO(Cv); else done = true;
        }
        __syncthreads();
        bsel ^= 1;
        if (done) break;
    }
#undef WS_LOAD
#undef WS_STORE
#undef WS_LO
#undef WS_HI
#undef WS_ADV_L
}

constexpr int LR_XCB = 0, LR_TA = 16384, LR_TB = LR_TA + 64 * 528, LR_TH = LR_TB + 64 * 528, LR_AGS = LR_TH + 64 * 528;
template <int VAR>
__device__ __forceinline__ void lru_phase(LAS unsigned char* lds, const Args& a, const int n, const int tt_first, const int tt_step) {
    int tid = threadIdx.x; asm volatile("" : "+v"(tid)); const int lane = tid & 63, w0 = tid >> 6, q0 = lane & 15, g0 = lane >> 4;
    unsigned char* ws = a.ws;
    const bf16_t* proj = (const bf16_t*)(ws + WS_PROJ);
    LAS unsigned char* xcb = lds + LR_XCB;
    LAS float* TA = (LAS float*)(lds + LR_TA); LAS float* TB = (LAS float*)(lds + LR_TB); LAS float* TH = (LAS float*)(lds + LR_TH);
    LAS f32x2* AGS = (LAS f32x2*)(lds + LR_AGS);
    const bf16_t* lruw = (const bf16_t*)(ws + WS_LRUW);
    f32x2* agg1 = (f32x2*)(ws + (VAR ? WS_T0 : WS_AGG1));
    bf16_t* Pout = (bf16_t*)(ws + (VAR ? WS_U + 32 * MiB : WS_PP));
    bf16x8 fa[2][4], fx[2][4];
#pragma unroll
    for (int dir = 0; dir < 2; ++dir) {
        const bf16_t* wa = lruw + (size_t)((0 * 2 + dir) * 8 + n) * 16384 + (16 * w0 + q0) * 128 + 8 * g0;
        const bf16_t* wx = lruw + (size_t)((1 * 2 + dir) * 8 + n) * 16384 + (16 * w0 + q0) * 128 + 8 * g0;
#pragma unroll
        for (int s = 0; s < 4; ++s) { fa[dir][s] = *(const bf16x8*)(wa + 32 * s); fx[dir][s] = *(const bf16x8*)(wx + 32 * s); }
    }
    const int cg8 = tid & 15, t2 = tid >> 4, ch0 = n * 128 + cg8 * 8;
    LAS float* CW = (LAS float*)(lds + LR_AGS + 4096);
    __syncthreads();
    if (tid < 128) {
#pragma unroll
        for (int j = 0; j < 4; ++j) CW[j * 128 + tid] = a.in[5][j * 1024 + n * 128 + tid];
        CW[512 + tid] = a.in[6][n * 128 + tid];
    } else if (tid < 384) {
        const int d2 = (tid - 128) >> 7, c = tid & 127, cg = d2 * 1024 + n * 128 + c;
        const float xl = -a.in[11][cg];
        CW[640 + (d2 * 3 + 0) * 128 + c] = a.in[8][cg]; CW[640 + (d2 * 3 + 1) * 128 + c] = a.in[10][cg];
        CW[640 + (d2 * 3 + 2) * 128 + c] = fmaxf(xl, 0.f) + log1pf(expf(-fabsf(xl)));
    }
    u32x4 xr[5];
#define LRU_XLOAD(tt_) do { _Pragma("unroll") for (int r = 0; r < 5; ++r) { const int t = (tt_) * 64 + 2 * t2 - 2 + r; xr[r] = (u32x4){0u, 0u, 0u, 0u}; \
        if (t >= 0 && t < SEQ) xr[r] = __builtin_nontemporal_load((const u32x4*)((const char*)proj + (unsigned)((t * INW + C_XL + ch0) * 2))); } } while (0)
    float A2f = 1.f, H2f = 0.f, A2b = 1.f, H2b = 0.f;
    LRU_XLOAD(tt_first);
#pragma unroll 1
    for (int tt = tt_first; tt < tt_first + 4; ++tt) {
    const int t0 = tt * 64;
    __syncthreads();
    {
        float xin[5][8];
#pragma unroll
        for (int r = 0; r < 5; ++r) { const u32x4 v = xr[r];
            xin[r][0] = bflo(v.x); xin[r][1] = bfhi(v.x); xin[r][2] = bflo(v.y); xin[r][3] = bfhi(v.y); xin[r][4] = bflo(v.z); xin[r][5] = bfhi(v.z); xin[r][6] = bflo(v.w); xin[r][7] = bfhi(v.w); }
        float wv[4][8], bias[8];
#pragma unroll
        for (int j = 0; j < 4; ++j) { const f32x4 w0 = *(const LAS f32x4*)(CW + j * 128 + cg8 * 8), w1 = *(const LAS f32x4*)(CW + j * 128 + cg8 * 8 + 4);
            wv[j][0] = w0[0]; wv[j][1] = w0[1]; wv[j][2] = w0[2]; wv[j][3] = w0[3]; wv[j][4] = w1[0]; wv[j][5] = w1[1]; wv[j][6] = w1[2]; wv[j][7] = w1[3]; }
        { const f32x4 b0 = *(const LAS f32x4*)(CW + 512 + cg8 * 8), b1 = *(const LAS f32x4*)(CW + 512 + cg8 * 8 + 4);
          bias[0] = b0[0]; bias[1] = b0[1]; bias[2] = b0[2]; bias[3] = b0[3]; bias[4] = b1[0]; bias[5] = b1[1]; bias[6] = b1[2]; bias[7] = b1[3]; }
#pragma unroll
        for (int o = 0; o < 2; ++o) { float y[8];
#pragma unroll
            for (int e = 0; e < 8; ++e) { float v = bias[e];
#pragma unroll
                for (int j = 0; j < 4; ++j) v += wv[j][e] * xin[o + j][e];
                y[e] = v; }
            const int tok = 2 * t2 + o;
            u32x4 pk; pk.x = pk2(y[0], y[1]); pk.y = pk2(y[2], y[3]); pk.z = pk2(y[4], y[5]); pk.w = pk2(y[6], y[7]);
            *(LAS u32x4*)(xcb + tok * 256 + ((cg8 ^ (tok & 15)) * 16)) = pk; }
    }
    if (tt + 1 < tt_first + 4) LRU_XLOAD(tt + 1);
    __syncthreads();
    float hreg[16];
    int tl = tid; asm volatile("" : "+v"(tl));
    const int q = tl & 15, g = (tl >> 4) & 3, w = tl >> 6, chl = 16 * w + 4 * g;
    const int ch = 16 * w + q, sub = g;
#pragma unroll
    for (int dir = 0; dir < 2; ++dir) {
        LAS float* TAd = dir ? TH : TA;
        if (VAR != 3) {
            const f32x4 ba = *(const LAS f32x4*)(CW + 640 + (dir * 3 + 0) * 128 + chl), bx = *(const LAS f32x4*)(CW + 640 + (dir * 3 + 1) * 128 + chl), sp = *(const LAS f32x4*)(CW + 640 + (dir * 3 + 2) * 128 + chl);
#pragma unroll
            for (int tk = 0; tk < 4; ++tk) { const int tok = 16 * tk + q;
                f32x4 ar = (f32x4){0.f, 0.f, 0.f, 0.f}, ai = (f32x4){0.f, 0.f, 0.f, 0.f};
#pragma unroll
                for (int s = 0; s < 4; ++s) {
                    const bf16x8 xb = *(const LAS bf16x8*)(xcb + tok * 256 + (((4 * s + g) ^ q) * 16));
                    ar = mfma16(fa[dir][s], xb, ar); ai = mfma16(fx[dir][s], xb, ai); }
                const u32x2 xr2 = *(const LAS u32x2*)(xcb + tok * 256 + ((((chl >> 3)) ^ q) * 16) + (chl & 7) * 2);
                const float xc0 = bflo(xr2.x), xc1 = bfhi(xr2.x), xc2 = bflo(xr2.y), xc3 = bfhi(xr2.y);
                f32x4 av, bv;
#pragma unroll
                for (int j = 0; j < 4; ++j) { if (VAR == 1) { av[j] = ar[j] + ba[j] + sp[j]; bv[j] = ai[j] + bx[j] + (j == 0 ? xc0 : (j == 1 ? xc1 : (j == 2 ? xc2 : xc3))); continue; }
                    const float r = fsigmoid(ar[j] + ba[j]), ii = fsigmoid(ai[j] + bx[j]);
                    const float la = -8.0f * r * sp[j]; const float aa = fexp2(la * LOG2E); av[j] = aa;
                    const float x2 = 2.0f * la;
                    const float poly = x2 * (1.f + x2 * (0.5f + x2 * ((1.f / 6.f) + x2 * ((1.f / 24.f) + x2 * (1.f / 120.f)))));
                    const float om = (x2 > -0.25f) ? -poly : (1.f - aa * aa);
                    const float xcj = j == 0 ? xc0 : (j == 1 ? xc1 : (j == 2 ? xc2 : xc3));
                    bv[j] = __builtin_amdgcn_sqrtf(om) * ii * xcj; }
                *(LAS f32x4*)(TAd + tok * 132 + chl) = av; *(LAS f32x4*)(TB + tok * 132 + chl) = bv; }
        }
        asm volatile("s_waitcnt lgkmcnt(0)" ::: "memory");
        if (VAR != 2 && VAR != 3) {
            float h = 0.f, P = 1.f;
#pragma unroll
            for (int i = 0; i < 16; ++i) { const int t = 16 * sub + (dir ? 15 - i : i);
                const float av = TAd[t * 132 + ch], bv = TB[t * 132 + ch]; h = av * h + bv; P *= av; TB[t * 132 + ch] = h; TAd[t * 132 + ch] = P; }
            AGS[sub * 128 + ch] = (f32x2){P, h};
        }
        asm volatile("s_waitcnt lgkmcnt(0)" ::: "memory");
        if (VAR == 2 || VAR == 3) {
#pragma unroll
            for (int i = 0; i < 16; ++i) hreg[i] = 0.f;
        } else {
            float hc = 0.f, Pp = 1.f, At = 1.f, Ht = 0.f;
#pragma unroll
            for (int s = 0; s < 4; ++s) { const int s2 = dir ? 3 - s : s; const f32x2 e = AGS[s2 * 128 + ch];
                const bool before = dir ? (s2 > sub) : (s2 < sub);
                if (before) { hc = e.x * hc + e.y; Pp *= e.x; }
                Ht = e.x * Ht + e.y; At *= e.x; }
#pragma unroll
            for (int i = 0; i < 16; ++i) { const int t = 16 * sub + i;
                const float Pl = TAd[t * 132 + ch], hl = TB[t * 132 + ch];
                const float hfull = hl + Pl * hc;
                if (dir == 0) hreg[i] = hfull; else hreg[i] += hfull;
                TAd[t * 132 + ch] = Pl * Pp; }
            if (sub == 0) agg1[(size_t)(dir * 1024 + n * 128 + ch) * 128 + tt] = (f32x2){At, Ht};
            if (dir == 0) { H2f = At * H2f + Ht; A2f *= At; }
            else { H2b = A2b * Ht + H2b; A2b *= At; }
        }
        asm volatile("s_waitcnt lgkmcnt(0)" ::: "memory");
    }
#pragma unroll
    for (int i = 0; i < 16; ++i) TB[(16 * sub + i) * 132 + ch] = hreg[i];
    __syncthreads();
    {
        float* hs = (float*)(ws + (VAR ? WS_U : WS_HS));
#pragma unroll
        for (int i = 0; i < 4; ++i) { const int e = tid + 512 * i, t = e >> 5, c4 = e & 31;
            *(f32x4*)(hs + (size_t)(t0 + t) * 1024 + n * 128 + 4 * c4) = *(const LAS f32x4*)(TB + t * 132 + 4 * c4);
            const f32x4 p0 = *(const LAS f32x4*)(TA + t * 132 + 4 * c4), p1 = *(const LAS f32x4*)(TH + t * 132 + 4 * c4);
            u32x2 o0, o1; o0.x = pk2(p0[0], p0[1]); o0.y = pk2(p0[2], p0[3]); o1.x = pk2(p1[0], p1[1]); o1.y = pk2(p1[2], p1[3]);
            *(u32x2*)(Pout + (size_t)(t0 + t) * 1024 + n * 128 + 4 * c4) = o0;
            *(u32x2*)(Pout + (size_t)SEQ * 1024 + (size_t)(t0 + t) * 1024 + n * 128 + 4 * c4) = o1; }
    }
    }
    if (g0 == 0) { f32x2* agg2 = (f32x2*)(ws + (VAR ? WS_T0 + 8 * MiB : WS_AGG2)); const int chg2 = n * 128 + 16 * w0 + q0, sc2 = tt_first >> 2;
        agg2[(size_t)chg2 * 32 + sc2] = (f32x2){A2f, H2f}; agg2[(size_t)(1024 + chg2) * 32 + sc2] = (f32x2){A2b, H2b}; }
#undef LRU_XLOAD
}

__device__ __forceinline__ void phase2(const Args& a, LAS unsigned char* lds, int p2mask) {
    unsigned char* ws = a.ws;
    bf16_t* proj = (bf16_t*)(ws + WS_PROJ); const bf16_t* vt = (const bf16_t*)(ws + WS_VT);
    const bf16_t* mk = (const bf16_t*)(ws + WS_MK); const bf16_t* mvt = (const bf16_t*)(ws + WS_MVT);
    bf16_t* yatt = (bf16_t*)(ws + WS_YATT); bf16_t* ymem = (bf16_t*)(ws + WS_YMEM);
    if (p2mask & 1)
    for (int u = blockIdx.x; u < 256; u += gridDim.x) {
        const int qblk = u >> 2, hm = u & 3;
        attn_unit<256, false, false>(lds, proj + (size_t)(qblk * 128) * INW + C_QM + hm * 256, INW, ymem + (size_t)(qblk * 128) * 1024 + hm * 256, 1024, mk + hm * 256, 1024, mvt + (size_t)(hm * 256) * 256, 256, 0, 2, -100, -1e30f, 0.f);
    }
    if (p2mask & 2) windowed_stream(lds, a);
    if (p2mask & 4)
    lru_phase<0>(lds, a, (int)(blockIdx.x & 7), 4 * (int)(blockIdx.x >> 3), 1);
}

__device__ __forceinline__ void phase3(const Args& a, LAS unsigned char* lds) {
    unsigned char* ws = a.ws;
    const f32x2* agg1 = (const f32x2*)(ws + WS_AGG1); f32x2* agg2 = (f32x2*)(ws + WS_AGG2);
    for (int e = blockIdx.x * 512 + threadIdx.x; e < 2 * 1024 * 16; e += gridDim.x * 512) {
        const int sc = e & 15, dc = e >> 4, dir = dc >> 10;
        const f32x4* p = (const f32x4*)(agg1 + (size_t)dc * 128 + sc * 8);
        f32x4 v[4];
#pragma unroll
        for (int i = 0; i < 4; ++i) v[i] = p[i];
        float A = 1.f, H = 0.f;
        if (dir == 0) {
#pragma unroll
            for (int i = 0; i < 4; ++i) { H = v[i][0] * H + v[i][1]; A *= v[i][0]; H = v[i][2] * H + v[i][3]; A *= v[i][2]; }
        } else {
#pragma unroll
            for (int i = 3; i >= 0; --i) { H = v[i][2] * H + v[i][3]; A *= v[i][2]; H = v[i][0] * H + v[i][1]; A *= v[i][0]; }
        }
        agg2[(size_t)dc * 16 + sc] = (f32x2){A, H};
    }
}

__device__ __forceinline__ float silu_(float z) { return z * __builtin_amdgcn_rcpf(1.f + __builtin_amdgcn_exp2f(-z * 1.4426950408889634f)); }
__device__ __forceinline__ void phase4(const Args& a, LAS unsigned char* lds) {
    unsigned char* ws = a.ws;
    const f32x2* agg1 = (const f32x2*)(ws + WS_AGG1); const f32x2* agg2 = (const f32x2*)(ws + WS_AGG2);
    const bf16_t* proj = (const bf16_t*)(ws + WS_PROJ); bf16_t* Y = (bf16_t*)(ws + WS_Y);
    const bf16_t* yatt = (const bf16_t*)(ws + WS_YATT); const bf16_t* ymem = (const bf16_t*)(ws + WS_YMEM);
    const float* hs = (const float*)(ws + WS_HS); const bf16_t* Pf = (const bf16_t*)(ws + WS_PP); const bf16_t* Pb = Pf + (size_t)SEQ * 1024;
    LAS float* car = (LAS float*)lds;
    LAS float* gl = (LAS float*)(lds + 8192);
    int tid = threadIdx.x; asm volatile("" : "+v"(tid)); const int lane = tid & 63, w = tid >> 6;
    __syncthreads();
    for (int i = tid; i < 1024; i += 512) { *(LAS f32x4*)(gl + 4 * i) = (i < 512) ? ((const f32x4*)a.in[14])[i] : (i < 768 ? ((const f32x4*)a.in[15])[i - 512] : ((const f32x4*)a.in[16])[i - 768]); }
    for (int u = blockIdx.x; u < 256; u += gridDim.x) {
        const int tile = u >> 1, sc = tile >> 2, cj = tile & 3;
        __syncthreads();
#pragma unroll 1
        for (int half = 0; half < 2; ++half) {
            const int c = tid + 512 * half;
            float hf = 0.f, hb = 0.f;
            float scf = (float)sc, cjf = (float)cj; asm volatile("" : "+v"(scf), "+v"(cjf));
            { const f32x4* p2 = (const f32x4*)(agg2 + (size_t)c * 32); const f32x4* p1 = (const f32x4*)(agg1 + (size_t)c * 128 + sc * 4);
              f32x4 e2[16], e1[2];
#pragma unroll
              for (int i = 0; i < 16; ++i) e2[i] = p2[i];
#pragma unroll
              for (int i = 0; i < 2; ++i) e1[i] = p1[i];
#pragma unroll
              for (int i = 0; i < 16; ++i) { const float w0 = fminf(fmaxf(scf - (float)(2 * i), 0.f), 1.f), w1 = fminf(fmaxf(scf - (float)(2 * i + 1), 0.f), 1.f);
                  hf = (w0 * e2[i][0] + (1.f - w0)) * hf + w0 * e2[i][1]; hf = (w1 * e2[i][2] + (1.f - w1)) * hf + w1 * e2[i][3]; }
#pragma unroll
              for (int i = 0; i < 2; ++i) { const float w0 = fminf(fmaxf(cjf - (float)(2 * i), 0.f), 1.f), w1 = fminf(fmaxf(cjf - (float)(2 * i + 1), 0.f), 1.f);
                  hf = (w0 * e1[i][0] + (1.f - w0)) * hf + w0 * e1[i][1]; hf = (w1 * e1[i][2] + (1.f - w1)) * hf + w1 * e1[i][3]; } }
            { const f32x4* p2 = (const f32x4*)(agg2 + (size_t)(1024 + c) * 32); const f32x4* p1 = (const f32x4*)(agg1 + (size_t)(1024 + c) * 128 + sc * 4);
              f32x4 e2[16], e1[2];
#pragma unroll
              for (int i = 0; i < 16; ++i) e2[i] = p2[i];
#pragma unroll
              for (int i = 0; i < 2; ++i) e1[i] = p1[i];
#pragma unroll
              for (int i = 15; i >= 0; --i) { const float w1 = fminf(fmaxf((float)(2 * i + 1) - scf, 0.f), 1.f), w0 = fminf(fmaxf((float)(2 * i) - scf, 0.f), 1.f);
                  hb = (w1 * e2[i][2] + (1.f - w1)) * hb + w1 * e2[i][3]; hb = (w0 * e2[i][0] + (1.f - w0)) * hb + w0 * e2[i][1]; }
#pragma unroll
              for (int i = 1; i >= 0; --i) { const float w1 = fminf(fmaxf((float)(2 * i + 1) - cjf, 0.f), 1.f), w0 = fminf(fmaxf((float)(2 * i) - cjf, 0.f), 1.f);
                  hb = (w1 * e1[i][2] + (1.f - w1)) * hb + w1 * e1[i][3]; hb = (w0 * e1[i][0] + (1.f - w0)) * hb + w0 * e1[i][1]; } }
            car[c] = hf; car[1024 + c] = hb;
        }
        __syncthreads();
        f32x4 cf[4], cb[4];
#pragma unroll
        for (int k = 0; k < 4; ++k) { cf[k] = *(const LAS f32x4*)(car + 4 * lane + 256 * k); cb[k] = *(const LAS f32x4*)(car + 1024 + 4 * lane + 256 * k); }
#pragma unroll 1
        for (int tk = 0; tk < 4; ++tk) {
            const unsigned t = (unsigned)(u * 32 + 4 * w + tk);
            const char* hsb = (const char*)hs; const char* pfb = (const char*)Pf; const char* pbb = (const char*)Pb;
            const char* yab = (const char*)yatt; const char* ymb = (const char*)ymem; const char* prb = (const char*)proj; char* yb = (char*)Y;
            const unsigned o_h = t * 4096u + 16u * lane, o_p = t * 2048u + 8u * lane, o_m = t * 2048u + 16u * lane;
            const unsigned o_pr = t * (unsigned)(INW * 2), o_y = t * 8192u;
            f32x4 h4[4]; u32x2 pf[4], pb[4], zl[4]; u32x4 va[4], vm[2], za[4], zm[2];
#pragma unroll
            for (int k = 0; k < 4; ++k) { h4[k] = __builtin_nontemporal_load((const f32x4*)(hsb + o_h + 1024u * k)); pf[k] = __builtin_nontemporal_load((const u32x2*)(pfb + o_p + 512u * k)); pb[k] = __builtin_nontemporal_load((const u32x2*)(pbb + o_p + 512u * k)); va[k] = __builtin_nontemporal_load((const u32x4*)(yab + o_h + 1024u * k)); }
#pragma unroll
            for (int k = 0; k < 2; ++k) vm[k] = __builtin_nontemporal_load((const u32x4*)(ymb + o_m + 1024u * k));
#pragma unroll
            for (int k = 0; k < 4; ++k) { zl[k] = __builtin_nontemporal_load((const u32x2*)(prb + o_pr + (unsigned)((C_ZL + 4 * lane + 256 * k) * 2))); za[k] = __builtin_nontemporal_load((const u32x4*)(prb + o_pr + (unsigned)((C_ZA + 8 * lane + 512 * k) * 2))); }
#pragma unroll
            for (int k = 0; k < 2; ++k) zm[k] = __builtin_nontemporal_load((const u32x4*)(prb + o_pr + (unsigned)((C_ZM + 8 * lane + 512 * k) * 2)));
            __builtin_amdgcn_sched_barrier(0);
            f32x4 v[4]; float ssl = 0.f, ssa = 0.f, ssm = 0.f;
#pragma unroll
            for (int k = 0; k < 4; ++k) {
                v[k][0] = h4[k][0] + bflo(pf[k].x) * cf[k][0] + bflo(pb[k].x) * cb[k][0]; v[k][1] = h4[k][1] + bfhi(pf[k].x) * cf[k][1] + bfhi(pb[k].x) * cb[k][1];
                v[k][2] = h4[k][2] + bflo(pf[k].y) * cf[k][2] + bflo(pb[k].y) * cb[k][2]; v[k][3] = h4[k][3] + bfhi(pf[k].y) * cf[k][3] + bfhi(pb[k].y) * cb[k][3];
                ssl += (v[k][0] * v[k][0] + v[k][1] * v[k][1]) + (v[k][2] * v[k][2] + v[k][3] * v[k][3]);
                { const float f0 = bflo(va[k].x), f1 = bfhi(va[k].x), f2 = bflo(va[k].y), f3 = bfhi(va[k].y), f4 = bflo(va[k].z), f5 = bfhi(va[k].z), f6 = bflo(va[k].w), f7 = bfhi(va[k].w);
                  ssa += ((f0 * f0 + f1 * f1) + (f2 * f2 + f3 * f3)) + ((f4 * f4 + f5 * f5) + (f6 * f6 + f7 * f7)); } }
#pragma unroll
            for (int k = 0; k < 2; ++k) { const float f0 = bflo(vm[k].x), f1 = bfhi(vm[k].x), f2 = bflo(vm[k].y), f3 = bfhi(vm[k].y), f4 = bflo(vm[k].z), f5 = bfhi(vm[k].z), f6 = bflo(vm[k].w), f7 = bfhi(vm[k].w);
                ssm += ((f0 * f0 + f1 * f1) + (f2 * f2 + f3 * f3)) + ((f4 * f4 + f5 * f5) + (f6 * f6 + f7 * f7)); }
            ssl = wave_sum(ssl); ssa = wave_sum(ssa); ssm = wave_sum(ssm);
            const float rsl = 1.f / sqrtf(ssl * (1.f / 1024.f) + EPSN), rsa = 1.f / sqrtf(ssa * (1.f / 2048.f) + EPSN), rsm = 1.f / sqrtf(ssm * (1.f / 1024.f) + EPSN);
            __builtin_amdgcn_sched_barrier(0);
#pragma unroll
            for (int k = 0; k < 4; ++k) { const int c = 4 * lane + 256 * k; const f32x4 g4 = *(const LAS f32x4*)(gl + 2048 + c); const u32x2 z = zl[k];
                u32x2 o; o.x = pk2(v[k][0] * rsl * g4[0] * silu_(bflo(z.x)), v[k][1] * rsl * g4[1] * silu_(bfhi(z.x))); o.y = pk2(v[k][2] * rsl * g4[2] * silu_(bflo(z.y)), v[k][3] * rsl * g4[3] * silu_(bfhi(z.y)));
                *(u32x2*)(yb + o_y + (unsigned)((2048 + c) * 2)) = o; }
            __builtin_amdgcn_sched_barrier(0);
#pragma unroll
            for (int k = 0; k < 4; ++k) { const int c = 8 * lane + 512 * k; const f32x4 g0 = *(const LAS f32x4*)(gl + c), g1 = *(const LAS f32x4*)(gl + c + 4); const u32x4 z = za[k];
                u32x4 o; o.x = pk2(bflo(va[k].x) * rsa * g0[0] * silu_(bflo(z.x)), bfhi(va[k].x) * rsa * g0[1] * silu_(bfhi(z.x)));
                o.y = pk2(bflo(va[k].y) * rsa * g0[2] * silu_(bflo(z.y)), bfhi(va[k].y) * rsa * g0[3] * silu_(bfhi(z.y)));
                o.z = pk2(bflo(va[k].z) * rsa * g1[0] * silu_(bflo(z.z)), bfhi(va[k].z) * rsa * g1[1] * silu_(bfhi(z.z)));
                o.w = pk2(bflo(va[k].w) * rsa * g1[2] * silu_(bflo(z.w)), bfhi(va[k].w) * rsa * g1[3] * silu_(bfhi(z.w)));
                *(u32x4*)(yb + o_y + (unsigned)(c * 2)) = o; }
            __builtin_amdgcn_sched_barrier(0);
#pragma unroll
            for (int k = 0; k < 2; ++k) { const int c = 8 * lane + 512 * k; const f32x4 g0 = *(const LAS f32x4*)(gl + 3072 + c), g1 = *(const LAS f32x4*)(gl + 3072 + c + 4); const u32x4 z = zm[k];
                u32x4 o; o.x = pk2(bflo(vm[k].x) * rsm * g0[0] * silu_(bflo(z.x)), bfhi(vm[k].x) * rsm * g0[1] * silu_(bfhi(z.x)));
                o.y = pk2(bflo(vm[k].y) * rsm * g0[2] * silu_(bflo(z.y)), bfhi(vm[k].y) * rsm * g0[3] * silu_(bfhi(z.y)));
                o.z = pk2(bflo(vm[k].z) * rsm * g1[0] * silu_(bflo(z.z)), bfhi(vm[k].z) * rsm * g1[1] * silu_(bfhi(z.z)));
                o.w = pk2(bflo(vm[k].w) * rsm * g1[2] * silu_(bflo(z.w)), bfhi(vm[k].w) * rsm * g1[3] * silu_(bfhi(z.w)));
                *(u32x4*)(yb + o_y + (unsigned)((3072 + c) * 2)) = o; }
        }
    }
}

#define XB_TMO      128
#define XB_XCNT(j)  (256  + 64 * (j))
#define XB_XSUB(j)  (1280 + 64 * (j))
#define XB_XGEN(j)  (2304 + 64 * (j))
#define XB_TOP      3328
#define XB_TOPGEN   3392
#define XCD_BAR_WORDS 3456
#define XB_SPIN_CAP (1u << 18)

__device__ __forceinline__ unsigned xb_ld(unsigned* p)              { return __hip_atomic_load(p, __ATOMIC_RELAXED, __HIP_MEMORY_SCOPE_AGENT); }
__device__ __forceinline__ unsigned xb_add(unsigned* p, unsigned v) { return __hip_atomic_fetch_add(p, v, __ATOMIC_RELAXED, __HIP_MEMORY_SCOPE_AGENT); }
__device__ __forceinline__ unsigned xb_xcc_id() { return (unsigned)__builtin_amdgcn_s_getreg((3 << 11) | 20) & 0xFu; }
#define XB_SPIN(cond, bar) do { unsigned _sp = 0; while (cond) { __builtin_amdgcn_s_sleep(1); \
    if ((++_sp & 255u) == 0u) { if (xb_ld(&(bar)[XB_TMO])) break; if (_sp > XB_SPIN_CAP) { atomicAdd(&(bar)[XB_TMO], 1u); break; } } } } while (0)

struct XcdBarrier {
    unsigned* bar; unsigned x;
    volatile LAS unsigned* st;
};

__device__ __forceinline__ XcdBarrier xcd_barrier_post(unsigned* bar, volatile LAS unsigned* st) {
    XcdBarrier b; b.bar = bar; b.x = xb_xcc_id(); b.st = st;
    if (threadIdx.x == 0) (void)xb_add(&bar[XB_XCNT(b.x)], 1u);
    return b;
}
__device__ __forceinline__ void xcd_barrier_complete(unsigned* bar, unsigned x, unsigned& nloc, unsigned& nx) {
    const unsigned G = gridDim.x * gridDim.y * gridDim.z;
    unsigned sum, cnt, mine, sp = 0u;
    for (;;) {
        sum = 0u; cnt = 0u; mine = 0u;
#pragma unroll
        for (unsigned j = 0; j < 16; ++j) { const unsigned c = xb_ld(&bar[XB_XCNT(j)]); sum += c; cnt += (c > 0u) ? 1u : 0u; mine = (j == x) ? c : mine; }
        if (sum == G) break;
        __builtin_amdgcn_s_sleep(1);
        if ((++sp & 255u) == 0u) { if (xb_ld(&bar[XB_TMO])) break; if (sp > XB_SPIN_CAP) { atomicAdd(&bar[XB_TMO], 1u); break; } }
    }
    nloc = mine > 0u ? mine : 1u; nx = cnt > 0u ? cnt : 1u;
}

__device__ __forceinline__ void xcd_barrier(const XcdBarrier& b) {
    asm volatile("s_waitcnt vmcnt(0)" ::: "memory");
    __syncthreads();
    if (threadIdx.x == 0) {
        unsigned* bar = b.bar;
        __builtin_amdgcn_s_waitcnt(0);
        unsigned nloc = b.st[0], nx = b.st[1];
        if (nloc == 0u) { xcd_barrier_complete(bar, b.x, nloc, nx); b.st[0] = nloc; b.st[1] = nx; }
        const unsigned old = xb_add(&bar[XB_XSUB(b.x)], 1u);
        const unsigned gen = old / nloc;
        if (old + 1u == (gen + 1u) * nloc) {
            __builtin_amdgcn_fence(__ATOMIC_RELEASE, "agent");
            asm volatile("s_waitcnt vmcnt(0)" ::: "memory");
            const unsigned og = xb_add(&bar[XB_TOP], 1u);
            const unsigned tg = og / nx;
            if (og + 1u == (tg + 1u) * nx) xb_add(&bar[XB_TOPGEN], 1u);
            else XB_SPIN(xb_ld(&bar[XB_TOPGEN]) == tg, bar);
            __builtin_amdgcn_fence(__ATOMIC_ACQUIRE, "agent");
            xb_add(&bar[XB_XGEN(b.x)], 1u);
            asm volatile("s_waitcnt vmcnt(0)" ::: "memory");
        } else {
            XB_SPIN(xb_ld(&bar[XB_XGEN(b.x)]) == gen, bar);
            __builtin_amdgcn_fence(__ATOMIC_ACQUIRE, "agent");
            asm volatile("s_waitcnt vmcnt(0)" ::: "memory");
        }
    }
    __syncthreads();
}

struct Sched2 {
    int c;
    __device__ bool next(int i, pg8::Unit& u) const {
        if (i >= 2) return false;
        const int x = c & 7, j = c >> 3;
        u.pm = i * 16 + 4 * (x >> 1) + (j & 3); u.pn = 8 * (x & 1) + (j >> 2); return true;
    }
    __device__ __forceinline__ void a_ready(const pg8::Unit&) const {}
    __device__ __forceinline__ void done(const pg8::Unit&) const {}
};
struct Epi3 {
    static constexpr bool PERM = true, AFTER_DRAIN = false, HOLD_LAST = true;
    float* out; bf16_t* t0; float* sspart; const float* x; const float* gain; XcdBarrier xbar;
    __device__ __forceinline__ void operator()(const f32x4 (&acc)[2][2][4][2], const pg8::Unit& u, int wr, int wc, int fr, int fq) const {
#pragma unroll
        for (int ai = 0; ai < 2; ++ai)
#pragma unroll
            for (int m = 0; m < 4; ++m) { const int row = u.pm * 256 + ai * 128 + wr * 64 + m * 16 + fr; float ss = 0.f;
#pragma unroll
                for (int bj = 0; bj < 2; ++bj) { const f32x4 v0 = acc[ai][bj][m][0], v1 = acc[ai][bj][m][1]; const int col = u.pn * 256 + bj * 128 + wc * 32 + 8 * fq;
                    u32x4 pk; pk.x = pk2(v0[0], v0[1]); pk.y = pk2(v0[2], v0[3]); pk.z = pk2(v1[0], v1[1]); pk.w = pk2(v1[2], v1[3]); *(u32x4*)(t0 + (size_t)row * 4096 + col) = pk;
                    ss += ((v0[0] * v0[0] + v0[1] * v0[1]) + (v0[2] * v0[2] + v0[3] * v0[3])) + ((v1[0] * v1[0] + v1[1] * v1[1]) + (v1[2] * v1[2] + v1[3] * v1[3])); }
                ss = xor16_add(ss); ss = xor32_add(ss);
                if (fq == 0) sspart[(size_t)row * 64 + u.pn * 4 + wc] = ss; }
    }
    __device__ __forceinline__ void fused(f32x4 (&acc)[2][2][4][2], const pg8::Unit& u, int wr, int wc, int fr, int fq, LAS unsigned char* lds, int wid, int lane) const {
#pragma unroll
        for (int ai = 0; ai < 2; ++ai)
#pragma unroll
            for (int m = 0; m < 4; ++m) { const int row = u.pm * 256 + ai * 128 + wr * 64 + m * 16 + fr; float ss = 0.f;
#pragma unroll
                for (int bj = 0; bj < 2; ++bj)
#pragma unroll
                    for (int n = 0; n < 2; ++n) { const f32x4 v = acc[ai][bj][m][n]; ss += (v[0] * v[0] + v[1] * v[1]) + (v[2] * v[2] + v[3] * v[3]); }
                ss = xor16_add(ss); ss = xor32_add(ss);
                if (fq == 0) sspart[(size_t)row * 64 + u.pn * 4 + wc] = ss; }
        f32x4 xv0[16], xv1[16];
        const size_t gob = (size_t)(u.pm * 256 + wid * 16) * 4096 + u.pn * 256 + 4 * lane;
#pragma unroll
        for (int r = 0; r < 16; ++r) xv0[r] = __builtin_nontemporal_load((const f32x4*)(x + gob + (size_t)r * 4096));
        xcd_barrier(xbar);
        constexpr int TP = 260;
        LAS float* T = (LAS float*)lds;
        LAS float* rsT = (LAS float*)(lds + 128 * TP * 4);
        { const int tid = wid * 64 + lane, row = tid >> 1, hf = tid & 1;
          const f32x4* p = (const f32x4*)(sspart + (size_t)(u.pm * 256 + row) * 64 + hf * 32);
          float s = 0.f;
#pragma unroll
          for (int i = 0; i < 8; ++i) { const f32x4 v = p[i]; s += (v[0] + v[1]) + (v[2] + v[3]); }
          s += dpp_mov<0xB1>(s);
          if (hf == 0) rsT[row] = 1.f / sqrtf(s * (1.f / 4096.f) + EPSN); }
        const f32x4 gv = *(const f32x4*)(gain + u.pn * 256 + 4 * lane);
#pragma unroll
        for (int ai = 0; ai < 2; ++ai) {
            __syncthreads();
#pragma unroll
            for (int m = 0; m < 4; ++m)
#pragma unroll
                for (int bj = 0; bj < 2; ++bj)
#pragma unroll
                    for (int n = 0; n < 2; ++n) *(LAS f32x4*)(T + (wr * 64 + m * 16 + fr) * TP + bj * 128 + wc * 32 + 8 * fq + 4 * n) = acc[ai][bj][m][n];
            if (ai == 0) {
#pragma unroll
                for (int r = 0; r < 16; ++r) xv1[r] = __builtin_nontemporal_load((const f32x4*)(x + gob + (size_t)(128 + r) * 4096));
            }
            __syncthreads();
#pragma unroll
            for (int r = 0; r < 16; ++r) { const int rl = wid * 16 + r;
                const f32x4 tv = *(const LAS f32x4*)(T + rl * TP + 4 * lane); const float rs = rsT[ai * 128 + rl];
                __builtin_nontemporal_store((ai ? xv1[r] : xv0[r]) + tv * rs * gv, (f32x4*)(out + gob + (size_t)(ai * 128 + r) * 4096)); }
        }
        const int pm0 = u.pm - 16;
        __syncthreads();
        { const int tid = wid * 64 + lane, row = tid >> 1, hf = tid & 1;
          const f32x4* p = (const f32x4*)(sspart + (size_t)(pm0 * 256 + row) * 64 + hf * 32);
          float s = 0.f;
#pragma unroll
          for (int i = 0; i < 8; ++i) { const f32x4 v = p[i]; s += (v[0] + v[1]) + (v[2] + v[3]); }
          s += dpp_mov<0xB1>(s);
          if (hf == 0) rsT[row] = 1.f / sqrtf(s * (1.f / 4096.f) + EPSN); }
        __syncthreads();
#pragma unroll 1
        for (int hb = 0; hb < 2; ++hb) {
            const int r0 = wid * 32 + hb * 16;
            const size_t go = (size_t)(pm0 * 256 + r0) * 4096 + u.pn * 256 + 4 * lane;
            f32x4 xr[16]; u32x2 tr[16];
#pragma unroll
            for (int r = 0; r < 16; ++r) { xr[r] = __builtin_nontemporal_load((const f32x4*)(x + go + (size_t)r * 4096)); tr[r] = __builtin_nontemporal_load((const u32x2*)(t0 + go + (size_t)r * 4096)); }
#pragma unroll
            for (int r = 0; r < 16; ++r) { const float rs = rsT[r0 + r];
                f32x4 o; o[0] = xr[r][0] + bflo(tr[r].x) * rs * gv[0]; o[1] = xr[r][1] + bfhi(tr[r].x) * rs * gv[1]; o[2] = xr[r][2] + bflo(tr[r].y) * rs * gv[2]; o[3] = xr[r][3] + bfhi(tr[r].y) * rs * gv[3];
                __builtin_nontemporal_store(o, (f32x4*)(out + go + (size_t)r * 4096)); }
        }
    }
};
__device__ __forceinline__ void phase6(const Args& a) {
    int tid = threadIdx.x; asm volatile("" : "+v"(tid)); const int lane = tid & 63, w = tid >> 6;
    const float* sspart = (const float*)(a.ws + WS_SS); const bf16_t* t0 = (const bf16_t*)(a.ws + WS_T0);
    f32x4 gv[16];
#pragma unroll
    for (int k = 0; k < 16; ++k) gv[k] = ((const f32x4*)a.in[18])[2 * lane + 128 * (k >> 1) + (k & 1)];
    for (int row = blockIdx.x * 8 + w; row < 4096; row += gridDim.x * 8) {
        const u32x4* t4 = (const u32x4*)(t0 + (size_t)row * 4096) + lane; f32x4* o4 = (f32x4*)(a.out + (size_t)row * 4096) + 2 * lane;
        const f32x4* x4 = (const f32x4*)(a.in[0] + (size_t)row * 4096) + 2 * lane;
        u32x4 tv[8]; f32x4 xa[8], xb[8];
        const float sp = sspart[(size_t)row * 64 + lane];
#pragma unroll
        for (int k = 0; k < 8; ++k) { tv[k] = __builtin_nontemporal_load(t4 + 64 * k); xa[k] = __builtin_nontemporal_load(x4 + 128 * k); xb[k] = __builtin_nontemporal_load(x4 + 128 * k + 1); }
        const float rs = 1.f / sqrtf(wave_sum(sp) * (1.f / 4096.f) + EPSN);
#pragma unroll
        for (int k = 0; k < 8; ++k) { const f32x4 ga = gv[2 * k], gb = gv[2 * k + 1];
            f32x4 oa, ob; oa[0] = xa[k][0] + bflo(tv[k].x) * rs * ga[0]; oa[1] = xa[k][1] + bfhi(tv[k].x) * rs * ga[1]; oa[2] = xa[k][2] + bflo(tv[k].y) * rs * ga[2]; oa[3] = xa[k][3] + bfhi(tv[k].y) * rs * ga[3];
            ob[0] = xb[k][0] + bflo(tv[k].z) * rs * gb[0]; ob[1] = xb[k][1] + bfhi(tv[k].z) * rs * gb[1]; ob[2] = xb[k][2] + bflo(tv[k].w) * rs * gb[2]; ob[3] = xb[k][3] + bfhi(tv[k].w) * rs * gb[3];
            __builtin_nontemporal_store(oa, o4 + 128 * k); __builtin_nontemporal_store(ob, o4 + 128 * k + 1); }
    }
}

__global__ void __launch_bounds__(512, 2) mega(Args a) {
    extern __shared__ __attribute__((aligned(16))) unsigned char lds_raw[];
    LAS unsigned char* lds = (LAS unsigned char*)lds_raw;
    cg::grid_group grid = cg::this_grid();
    unsigned char* ws = a.ws;
    volatile LAS unsigned* xst = (volatile LAS unsigned*)(lds + LDS_BYTES - 64);
    if (threadIdx.x < 16) xst[threadIdx.x] = 0u;
    __syncthreads();
    XcdBarrier xbar; xbar.bar = (unsigned*)(ws + WS_CTL); xbar.x = 0; xbar.st = nullptr;
    xbar = xcd_barrier_post((unsigned*)(ws + WS_CTL), xst);
    const int lo = a.ph_lo, hi = a.ph_hi;
#define IN(k) (lo <= (k) && (k) < hi)
#define SEAM(k) do { if (IN(k) && IN((k) + 1)) { if ((k) == 1) { __syncthreads(); grid.sync(); } else xcd_barrier(xbar); } } while (0)
    if (IN(0)) { if (PHMASK & 1) phase0(a, lds); if (REPMASK & 1) { __syncthreads(); phase0(a, lds); } }
    SEAM(0);
    if (IN(1)) { if (PHMASK & 2) {
        pg8::Gemm g{(const bf16_t*)(ws + WS_U), (const bf16_t*)(ws + WS_WT), SEQ + NMEM, INW + 2048, 4096};
        Sched1 S; S.init((int)gridDim.x, (int)blockIdx.x);
        Epi1 E{(bf16_t*)(ws + WS_PROJ), (bf16_t*)(ws + WS_VT), (bf16_t*)(ws + WS_MK), (bf16_t*)(ws + WS_MVT), (const float*)(ws + WS_ROPE)};
        pg8::gemm_phase<Epi1, Sched1, true, true>(lds, g, S, E);
        {
            const int G = (int)gridDim.x, nfull = 1160 % G, nidle = (nfull == 0) ? G : G - nfull;
            const int bi = (nfull == 0) ? (int)blockIdx.x : (int)blockIdx.x - nfull;
            if (bi >= 0) {
                int tid = threadIdx.x; asm volatile("" : "+v"(tid)); const int lane = tid & 63, w = tid >> 6;
                LAS float* scr = (LAS float*)(lds + w * 16384);
                p0_transpose_matrix(a.in[17], 4096, 4096, (bf16_t*)(ws + WS_WOUT), 0, scr, bi * 8 + w, nidle * 8, lane);
            }
        }
        if (REPMASK & 2) { __syncthreads(); pg8::gemm_phase<Epi1, Sched1, true, true>(lds, g, S, E); }
    } }
    SEAM(1);
    if (IN(2)) { if (PHMASK & 4) phase2(a, lds, P2MASK); }
    SEAM(2);
    if (IN(4)) { if (PHMASK & 16) phase4(a, lds); if (REPMASK & 16) { __syncthreads(); phase4(a, lds); } }
    SEAM(4);
    if (IN(5)) { if (PHMASK & 32) {
        pg8::Gemm g{(const bf16_t*)(ws + WS_Y), (const bf16_t*)(ws + WS_WOUT), SEQ, 4096, 4096};
        Sched2 S; S.c = (int)blockIdx.x;
        Epi3 E{a.out, (bf16_t*)(ws + WS_T0), (float*)(ws + WS_SS), a.in[0], a.in[18], xbar};
        pg8::gemm_phase<Epi3, Sched2, true, true>(lds, g, S, E);
    } }
#if N_LAUNCHES != 1
    if (lo >= 7 && lo < 10) phase2(a, lds, 1 << (lo - 7));
    if (lo == 11 || lo == 12) {
        pg8::Gemm g{(const bf16_t*)(ws + WS_U), (const bf16_t*)(ws + WS_WT), SEQ + NMEM, INW + 2048, 4096};
        Sched1 S; S.init((int)gridDim.x, (int)blockIdx.x); if (lo == 11) S.imax = 4; else S.ioff = 4;
        Epi1 E{(bf16_t*)(ws + WS_PROJ), (bf16_t*)(ws + WS_VT), (bf16_t*)(ws + WS_MK), (bf16_t*)(ws + WS_MVT), (const float*)(ws + WS_ROPE)};
        pg8::gemm_phase<Epi1, Sched1, true, true>(lds, g, S, E);
    }
    if (lo == 13) {
        pg8::Gemm g{(const bf16_t*)(ws + WS_U), (const bf16_t*)(ws + WS_WT), SEQ + NMEM, INW + 2048, 4096};
        Sched1 S; S.init((int)gridDim.x, (int)blockIdx.x); S.imax = 4;
        pg8::EpiBf16<0> E{(bf16_t*)(ws + WS_HS), INW, nullptr, 0, 0, 1.f};
        pg8::gemm_phase<pg8::EpiBf16<0>, Sched1, true, true>(lds, g, S, E);
    }
#ifdef LRUVAR
    if (lo == 10) lru_phase<LRUVAR>(lds, a, (int)(blockIdx.x & 7), (int)(blockIdx.x >> 3), (int)(gridDim.x >> 3));
#endif
#endif
#undef IN
#undef SEAM
}

extern "C" void kernel_launch(void* const* d_in, const int* in_sizes, int n_in, void* d_out, int out_size, void* d_ws, size_t ws_size, hipStream_t stream) {
    static int grid = 0;
    if (grid == 0) {
        if (n_in != 19 || ws_size < WS_END) { fprintf(stderr, "kernel_launch: unexpected n_in %d or ws_size %zu (need %zu)\n", n_in, ws_size, (size_t)WS_END); grid = -1; return; }
        int dev = 0, cus = 0, per_cu = 0;
        hipGetDevice(&dev); hipDeviceGetAttribute(&cus, hipDeviceAttributeMultiprocessorCount, dev);
        if (hipFuncSetAttribute((const void*)mega, hipFuncAttributeMaxDynamicSharedMemorySize, LDS_BYTES) != hipSuccess) { fprintf(stderr, "kernel_launch: hipFuncSetAttribute failed\n"); grid = -1; return; }
        if (hipOccupancyMaxActiveBlocksPerMultiprocessor(&per_cu, (const void*)mega, 512, LDS_BYTES) != hipSuccess || per_cu < 1) { fprintf(stderr, "kernel_launch: occupancy query says %d\n", per_cu); per_cu = 1; }
        (void)hipGetLastError();
        if (cus < 256) { fprintf(stderr, "kernel_launch: needs 256 CUs (one workgroup per CU), device has %d\n", cus); grid = -1; return; }
        grid = 256;
    }
    if (grid < 0) return;
    Args a{};
    for (int i = 0; i < 19; ++i) a.in[i] = (const float*)d_in[i];
    a.out = (float*)d_out; a.ws = (unsigned char*)d_ws;
#if N_LAUNCHES == 1
    (void)hipMemsetAsync((char*)d_ws + WS_CTL, 0, 65536, stream);
    a.ph_lo = 0; a.ph_hi = NPH;
    void* args[] = {&a};
    hipError_t e = hipLaunchCooperativeKernel((const void*)mega, dim3(grid), dim3(512), args, LDS_BYTES, stream);
    if (e != hipSuccess) fprintf(stderr, "cooperative launch failed: %s (grid %d)\n", hipGetErrorString(e), grid);
#else
#ifndef PHSEQ
#define PHSEQ 0,1,2,3,4,5,6
#endif
    { const int seq[] = {PHSEQ};
      for (unsigned i = 0; i < sizeof(seq) / sizeof(int); ++i) { a.ph_lo = seq[i]; a.ph_hi = seq[i] + 1; (void)hipMemsetAsync((char*)d_ws + WS_CTL, 0, 65536, stream); hipLaunchKernelGGL(mega, dim3(grid), dim3(512), LDS_BYTES, stream, a); } }
#endif
}
```

```cpp
#include <hip/hip_runtime.h>
#include <hip/hip_cooperative_groups.h>
#include <cstdio>
#include <cstdint>
namespace cg = cooperative_groups;
#define N_LAUNCHES 1
namespace pg8 {
#define PG8_LAS __attribute__((address_space(3)))
typedef unsigned short bf16_t;
typedef short bf16x8 __attribute__((ext_vector_type(8)));
typedef float f32x4 __attribute__((ext_vector_type(4)));
typedef unsigned u32x4 __attribute__((ext_vector_type(4)));
constexpr int BM = 256, BK = 64, HALF = 128, HTB = HALF * BK * 2  , STAGE_BYTES = 8 * HTB, NXCD = 8, WGM = 8;

__host__ __device__ __forceinline__ int lds_byte(int r, int c) { const int st = (r >> 4) * 2 + (c >> 5), rr = r & 15, cc = c & 31, ob = rr * 64 + cc * 2; return st * 1024 + (ob ^ (((ob >> 9) & 1) << 5)); }
__host__ __device__ __forceinline__ void stage_rc(int b, int& R, int& C) { const int st = b / 1024, sb = b % 1024, swz = sb ^ (((sb >> 9) & 1) << 5); R = (st >> 1) * 16 + swz / 64; C = (st & 1) * 32 + (swz % 64) / 2; }
__host__ __device__ __forceinline__ int perm32(int rho) { const int n = rho >> 4, i = rho & 15; return 8 * (i >> 2) + 4 * n + (i & 3); }

struct Unit { int pm, pn; };
struct Gemm { const bf16_t* A; const bf16_t* Bt; int M, N, K; };

struct StaticOrder {
    int nM, nN, nwg, G, c;
    __host__ __device__ void init(int M, int N, int G_, int c_) { nM = M / BM; nN = N / BM; nwg = nM * nN; G = G_; c = c_; }
    __host__ __device__ bool next(int i, Unit& u) const {
        const long L = (long)i * G + c; if (L >= nwg) return false;
        int wgid = (int)L; { const int q = nwg / NXCD, r = nwg % NXCD, xcd = wgid % NXCD, off = wgid / NXCD; wgid = (xcd < r ? xcd * (q + 1) : r * (q + 1) + (xcd - r) * q) + off; }
        const int nig = WGM * nN, gid = wgid / nig, fm = gid * WGM, gsz = (nM - fm) < WGM ? (nM - fm) : WGM;
        u.pm = fm + ((wgid % nig) % gsz); u.pn = (wgid % nig) / gsz; return true;
    }
    __device__ __forceinline__ void a_ready(const Unit&) const {}
    __device__ __forceinline__ void done(const Unit&) const {}
};

__device__ __forceinline__ unsigned cvt_pk_bf16(float lo, float hi) { unsigned r; asm volatile("v_cvt_pk_bf16_f32 %0, %1, %2" : "=v"(r) : "v"(lo), "v"(hi)); return r; }
typedef float f32x2 __attribute__((ext_vector_type(2)));
__device__ __forceinline__ f32x2 gelu_pk(f32x2 v) {
    const f32x2 av = __builtin_elementwise_abs(v), d = av * 0.2316418882f + 1.0f;
    f32x2 t; t.x = __builtin_amdgcn_rcpf(d.x); t.y = __builtin_amdgcn_rcpf(d.y);
    f32x2 q = t * 0.5307027145f + (-0.7265760135f); q = q * t + 0.7107068705f; q = q * t + (-0.142248368f); q = q * t + 0.127414796f; q = q * t;
    const f32x2 s = (v * v) * (-0.72134752044f);
    f32x2 e; e.x = __builtin_amdgcn_exp2f(s.x); e.y = __builtin_amdgcn_exp2f(s.y);
    const f32x2 m = v * (q * e), r = v - m;
    f32x2 o; o.x = v.x < 0.f ? m.x : r.x; o.y = v.y < 0.f ? m.y : r.y; return o;
}

template <int ACT  > struct EpiBf16 {
    static constexpr bool PERM = true, AFTER_DRAIN = false, HOLD_LAST = false; static_assert(ACT == 0 || ACT == 1, "EpiBf16: ACT is 0 (none) or 1 (gelu_pk)");
    bf16_t* O; int ldc; const float* bias; int split_cols; size_t split_stride; float scale0;
    __device__ __forceinline__ void operator()(const f32x4 (&acc)[2][2][4][2], const Unit& u, int wr, int wc, int fr, int fq) const {
        const int row0 = u.pm * BM + wr * 64 + fr; int colt = u.pn * BM; bf16_t* base = O;
        float sc = 1.f; if (split_cols) { const int t = colt / split_cols; base += (size_t)t * split_stride; colt -= t * split_cols; if (t == 0) sc = scale0; }
        const int col0 = colt + wc * 32 + 8 * fq, bcol0 = u.pn * BM + wc * 32 + 8 * fq;
        f32x4 bv[2][2];
#pragma unroll
        for (int bj = 0; bj < 2; ++bj)
#pragma unroll
            for (int n = 0; n < 2; ++n) bv[bj][n] = bias ? *(const f32x4*)(bias + bcol0 + bj * HALF + 4 * n) : (f32x4){0.f, 0.f, 0.f, 0.f};
#pragma unroll
        for (int ai = 0; ai < 2; ++ai)
#pragma unroll
            for (int m = 0; m < 4; ++m) { bf16_t* rowp = base + (size_t)(row0 + ai * HALF + m * 16) * ldc + col0;
#pragma unroll
                for (int bj = 0; bj < 2; ++bj) { f32x4 v0 = acc[ai][bj][m][0] + bv[bj][0], v1 = acc[ai][bj][m][1] + bv[bj][1];
                    if (ACT == 1) { f32x2 a = gelu_pk((f32x2){v0[0], v0[1]}), b = gelu_pk((f32x2){v0[2], v0[3]}), c = gelu_pk((f32x2){v1[0], v1[1]}), d = gelu_pk((f32x2){v1[2], v1[3]});
                        v0 = (f32x4){a.x, a.y, b.x, b.y}; v1 = (f32x4){c.x, c.y, d.x, d.y}; }
                    v0 = v0 * sc; v1 = v1 * sc; u32x4 w; w.x = cvt_pk_bf16(v0[0], v0[1]); w.y = cvt_pk_bf16(v0[2], v0[3]); w.z = cvt_pk_bf16(v1[0], v1[1]); w.w = cvt_pk_bf16(v1[2], v1[3]);
                    *(u32x4*)(rowp + bj * HALF) = w; } }
    }
};
template <class Epi, class Sched, bool ALIGN_EPI = false, bool SP2 = false>
__device__ __forceinline__ void gemm_phase(PG8_LAS unsigned char* lds, const Gemm g, const Sched& S, const Epi& E) {
    int tid_ = threadIdx.x; asm volatile("" : "+v"(tid_)); const int tid = tid_, wid = __builtin_amdgcn_readfirstlane(tid >> 6), lane = tid & 63, wr = wid >> 2, wc = wid & 3, fr = lane & 15, fq = lane >> 4;
    const int K = g.K, nt = K / BK;
    unsigned voffA[2], voffB[2];
#pragma unroll
    for (int i = 0; i < 2; ++i) { int R, C; stage_rc(tid * 16 + i * 8192, R, C); const int Rb = Epi::PERM ? ((R & ~31) + perm32(R & 31)) : R;
        voffA[i] = (unsigned)(R * K + C) * 2u; voffB[i] = (unsigned)(Rb * K + C) * 2u; }
    const size_t kstep = (size_t)(BK * 2);
    const size_t hstep = (size_t)HALF * K * 2;
    const size_t tstep = 2 * hstep;
    const unsigned ldsw = (unsigned)wid * 1024u;
    const int aoff = lds_byte(wr * 64 + fr, fq * 8), boff = lds_byte(wc * 32 + fr, fq * 8);
#define PG8_SA(b, h) (((b) * 2 + (h)) * HTB)
#define PG8_SB(b, h) ((4 + (b) * 2 + (h)) * HTB)
#define PG8_STAGE(bufoff, gbase, voff) do { _Pragma("unroll") for (int _i = 0; _i < 2; ++_i) \
        __builtin_amdgcn_global_load_lds((const unsigned*)((const char*)(gbase) + (voff)[_i]), (PG8_LAS unsigned*)(lds + (bufoff) + ldsw + _i * 8192), 16, 0, 0); } while (0)
#define PG8_LDA(dst, b, h) do { _Pragma("unroll") for (int m = 0; m < 4; ++m) _Pragma("unroll") for (int k = 0; k < 2; ++k) dst[m][k] = *(const PG8_LAS bf16x8*)(lds + PG8_SA(b, h) + aoff + m * 2048 + k * 1024); } while (0)
#define PG8_LDB(dst, b, h) do { _Pragma("unroll") for (int n = 0; n < 2; ++n) _Pragma("unroll") for (int k = 0; k < 2; ++k) dst[n][k] = *(const PG8_LAS bf16x8*)(lds + PG8_SB(b, h) + boff + n * 2048 + k * 1024); } while (0)
#define PG8_MMA(ai, bj, At, Bt) do { __builtin_amdgcn_s_setprio(1); _Pragma("unroll") for (int m = 0; m < 4; ++m) _Pragma("unroll") for (int n = 0; n < 2; ++n) _Pragma("unroll") for (int k = 0; k < 2; ++k) \
        acc[ai][bj][m][n] = __builtin_amdgcn_mfma_f32_16x16x32_bf16(Bt[n][k], At[m][k], acc[ai][bj][m][n], 0, 0, 0); __builtin_amdgcn_s_setprio(0); } while (0)
#define PG8_WAIT_V(n) asm volatile("s_waitcnt vmcnt(" #n ")" ::: "memory")
#define PG8_WAIT_L(n) asm volatile("s_waitcnt lgkmcnt(" #n ")" ::: "memory")
#define PG8_BAR __builtin_amdgcn_s_barrier()
#define PG8_SCHED __builtin_amdgcn_sched_barrier(0)
    Unit cur, nxt; int ui = 0;
    if (!S.next(0, cur)) return;
    f32x4 acc[2][2][4][2];
#pragma unroll
    for (int a = 0; a < 2; ++a)
#pragma unroll
        for (int b = 0; b < 2; ++b)
#pragma unroll
            for (int m = 0; m < 4; ++m)
#pragma unroll
                for (int n = 0; n < 2; ++n) acc[a][b][m][n] = (f32x4){0.f, 0.f, 0.f, 0.f};
    bf16x8 At[4][2], B0[2][2], B1[2][2];
    const char* cA = (const char*)g.A + (size_t)cur.pm * tstep; const char* cB = (const char*)g.Bt + (size_t)cur.pn * tstep;
    S.a_ready(cur);
    if constexpr (SP2) {
        PG8_STAGE(PG8_SB(0, 0), cB, voffB); PG8_STAGE(PG8_SB(0, 1), cB + hstep, voffB); PG8_STAGE(PG8_SA(0, 0), cA, voffA); PG8_STAGE(PG8_SA(0, 1), cA + hstep, voffA);
        if (wr == 1) PG8_BAR;
        PG8_WAIT_V(2); PG8_BAR;
        PG8_STAGE(PG8_SB(1, 0), cB + kstep, voffB); PG8_STAGE(PG8_SA(1, 0), cA + kstep, voffA); PG8_STAGE(PG8_SB(1, 1), cB + hstep + kstep, voffB);
        PG8_WAIT_V(6); PG8_BAR;
    } else {
        PG8_STAGE(PG8_SB(0, 0), cB, voffB); PG8_STAGE(PG8_SA(0, 0), cA, voffA); PG8_STAGE(PG8_SB(0, 1), cB + hstep, voffB); PG8_STAGE(PG8_SA(0, 1), cA + hstep, voffA);
        if (wr == 1) PG8_BAR;
        PG8_WAIT_V(4); PG8_BAR;
        PG8_STAGE(PG8_SB(1, 0), cB + kstep, voffB); PG8_STAGE(PG8_SA(1, 0), cA + kstep, voffA); PG8_STAGE(PG8_SB(1, 1), cB + hstep + kstep, voffB);
        PG8_WAIT_V(6); PG8_BAR;
    }
    for (;;) {
        const bool has_next = S.next(ui + 1, nxt);
        const char* nA = has_next ? (const char*)g.A + (size_t)nxt.pm * tstep : cA; const char* nB = has_next ? (const char*)g.Bt + (size_t)nxt.pn * tstep : cB;
        for (int t = 0; t < nt; t += 2) {
            const bool last = (t == nt - 2);
            const char* a1 = cA + (size_t)(t + 1) * kstep;
            const char* a2 = last ? nA : cA + (size_t)(t + 2) * kstep; const char* b2 = last ? nB : cB + (size_t)(t + 2) * kstep;
            const char* a3 = a2 + kstep; const char* b3 = b2 + kstep;
            if (last && has_next) S.a_ready(nxt);
            if constexpr (SP2) {
            PG8_LDB(B0, 0, 0); PG8_LDB(B1, 0, 1); PG8_SCHED; PG8_LDA(At, 0, 0); PG8_STAGE(PG8_SA(1, 1), a1 + hstep, voffA);
            PG8_WAIT_V(8); PG8_WAIT_L(0); PG8_BAR; PG8_MMA(0, 0, At, B0); PG8_MMA(0, 1, At, B1); PG8_BAR; PG8_SCHED;
            PG8_LDA(At, 0, 1); PG8_STAGE(PG8_SB(0, 0), b2, voffB); PG8_STAGE(PG8_SB(0, 1), b2 + hstep, voffB); PG8_STAGE(PG8_SA(0, 0), a2, voffA);
            PG8_WAIT_V(8); PG8_WAIT_L(0); PG8_BAR; PG8_MMA(1, 0, At, B0); PG8_MMA(1, 1, At, B1); PG8_BAR; PG8_SCHED;
            PG8_LDB(B0, 1, 0); PG8_LDB(B1, 1, 1); PG8_SCHED; PG8_LDA(At, 1, 0); PG8_STAGE(PG8_SA(0, 1), a2 + hstep, voffA);
            PG8_WAIT_V(8); PG8_WAIT_L(0); PG8_BAR; PG8_MMA(0, 0, At, B0); PG8_MMA(0, 1, At, B1); PG8_BAR; PG8_SCHED;
            PG8_LDA(At, 1, 1); PG8_STAGE(PG8_SB(1, 0), b3, voffB); PG8_STAGE(PG8_SB(1, 1), b3 + hstep, voffB); PG8_STAGE(PG8_SA(1, 0), a3, voffA);
            PG8_WAIT_V(8); PG8_WAIT_L(0); PG8_BAR; PG8_MMA(1, 0, At, B0); PG8_MMA(1, 1, At, B1); PG8_BAR; PG8_SCHED;
            } else {
            PG8_LDB(B0, 0, 0); PG8_SCHED; PG8_LDA(At, 0, 0); PG8_STAGE(PG8_SA(1, 1), a1 + hstep, voffA);
            PG8_WAIT_L(8); PG8_BAR; PG8_WAIT_L(0); PG8_MMA(0, 0, At, B0); PG8_BAR; PG8_SCHED;
            PG8_LDB(B1, 0, 1); PG8_STAGE(PG8_SB(0, 0), b2, voffB);
            PG8_BAR; PG8_WAIT_L(0); PG8_MMA(0, 1, At, B1); PG8_BAR;
            PG8_LDA(At, 0, 1); PG8_STAGE(PG8_SA(0, 0), a2, voffA);
            PG8_BAR; PG8_WAIT_L(0); PG8_MMA(1, 0, At, B0); PG8_BAR; PG8_SCHED;
            PG8_STAGE(PG8_SB(0, 1), b2 + hstep, voffB);
            PG8_WAIT_V(6); PG8_BAR; PG8_MMA(1, 1, At, B1); PG8_BAR;
            PG8_LDB(B0, 1, 0); PG8_SCHED; PG8_LDA(At, 1, 0); PG8_STAGE(PG8_SA(0, 1), a2 + hstep, voffA);
            PG8_WAIT_L(8); PG8_BAR; PG8_WAIT_L(0); PG8_MMA(0, 0, At, B0); PG8_BAR; PG8_SCHED;
            PG8_LDB(B1, 1, 1); PG8_STAGE(PG8_SB(1, 0), b3, voffB);
            PG8_BAR; PG8_WAIT_L(0); PG8_MMA(0, 1, At, B1); PG8_BAR;
            PG8_LDA(At, 1, 1); PG8_STAGE(PG8_SA(1, 0), a3, voffA);
            PG8_BAR; PG8_WAIT_L(0); PG8_MMA(1, 0, At, B0); PG8_BAR; PG8_SCHED;
            PG8_STAGE(PG8_SB(1, 1), b3 + hstep, voffB);
            PG8_WAIT_V(6); PG8_BAR; PG8_MMA(1, 1, At, B1); PG8_BAR;
            }
        }
        if constexpr (ALIGN_EPI) { if (wr == 0) PG8_BAR; }
        if constexpr (!Epi::AFTER_DRAIN) { if (!Epi::HOLD_LAST || has_next) { E(acc, cur, wr, wc, fr, fq); S.done(cur); } }
        if (!has_next) break;
#pragma unroll
        for (int a = 0; a < 2; ++a)
#pragma unroll
            for (int b = 0; b < 2; ++b)
#pragma unroll
                for (int m = 0; m < 4; ++m)
#pragma unroll
                    for (int n = 0; n < 2; ++n) acc[a][b][m][n] = (f32x4){0.f, 0.f, 0.f, 0.f};
        cur = nxt; cA = nA; cB = nB; ++ui;
        if constexpr (ALIGN_EPI) { if (wr == 1) PG8_BAR; }
    }
    PG8_WAIT_V(0);
    if constexpr (!ALIGN_EPI) { if (wr == 0) PG8_BAR; }
    PG8_BAR;
    if constexpr (Epi::AFTER_DRAIN || Epi::HOLD_LAST) { E.fused(acc, cur, wr, wc, fr, fq, lds, wid, lane); S.done(cur); }
#undef PG8_SA
#undef PG8_SB
#undef PG8_STAGE
#undef PG8_LDA
#undef PG8_LDB
#undef PG8_MMA
#undef PG8_WAIT_V
#undef PG8_WAIT_L
#undef PG8_BAR
#undef PG8_SCHED
}
}

#ifndef PHMASK
#define PHMASK 127
#endif
#ifndef REPMASK
#define REPMASK 0
#endif
#ifndef P2MASK
#define P2MASK 7
#endif
#ifndef N_LAUNCHES
#define N_LAUNCHES 1
#endif
using pg8::bf16_t; using pg8::bf16x8; using pg8::f32x4; using pg8::u32x4;
#define LAS __attribute__((address_space(3)))
typedef unsigned u32x2 __attribute__((ext_vector_type(2)));
typedef float f32x2 __attribute__((ext_vector_type(2)));

constexpr int SEQ = 8192, DMODEL = 4096, INW = 9216, NMEM = 256;
constexpr int C_QA = 0, C_KA = 2048, C_VA = 2560, C_XL = 3072, C_QM = 4096, C_ZA = 5120, C_ZL = 7168, C_ZM = 8192;
constexpr float EPSN = 1e-6f;
constexpr float LOG2E = 1.4426950408889634f;
constexpr float SC_ATT = 0.08838834764831845f * LOG2E;
constexpr float SC_MEM = 0.0625f * LOG2E;
constexpr int NPH = 7;
constexpr int LDS_BYTES = 147456;

constexpr size_t MiB = 1u << 20;
constexpr size_t WS_CTL = 0, WS_LRUW = 1 * MiB, WS_ROPE = 2 * MiB, WS_MK = 3 * MiB, WS_MVT = 3 * MiB + 512 * 1024, WS_SS = 4 * MiB,
                 WS_AGG1 = 6 * MiB, WS_AGG2 = 10 * MiB, WS_VT = 12 * MiB, WS_WOUT = 20 * MiB, WS_WT = 52 * MiB, WS_U = 140 * MiB,
                 WS_PROJ = 206 * MiB, WS_HS = 350 * MiB, WS_PP = 382 * MiB, WS_YATT = 414 * MiB, WS_YMEM = 446 * MiB, WS_T0 = 462 * MiB, WS_END = 494 * MiB;
constexpr size_t WS_Y = WS_U;

struct Args { const float* in[19]; float* out; unsigned char* ws; int ph_lo, ph_hi; };

__device__ __forceinline__ unsigned pk2(float lo, float hi) { return pg8::cvt_pk_bf16(lo, hi); }
__device__ __forceinline__ float bflo(unsigned u) { return __builtin_bit_cast(float, u << 16); }
__device__ __forceinline__ float bfhi(unsigned u) { return __builtin_bit_cast(float, u & 0xffff0000u); }
template <int CTRL> __device__ __forceinline__ float dpp_mov(float v) { return __uint_as_float(__builtin_amdgcn_update_dpp(0u, __float_as_uint(v), CTRL, 0xF, 0xF, true)); }
__device__ __forceinline__ float xor16_add(float v) { auto r = __builtin_amdgcn_permlane16_swap(__float_as_uint(v), __float_as_uint(v), false, false); return __uint_as_float(r[0]) + __uint_as_float(r[1]); }
__device__ __forceinline__ float xor32_add(float v) { auto r = __builtin_amdgcn_permlane32_swap(__float_as_uint(v), __float_as_uint(v), false, false); return __uint_as_float(r[0]) + __uint_as_float(r[1]); }
__device__ __forceinline__ float xor16_max(float v) { auto r = __builtin_amdgcn_permlane16_swap(__float_as_uint(v), __float_as_uint(v), false, false); return fmaxf(__uint_as_float(r[0]), __uint_as_float(r[1])); }
__device__ __forceinline__ float xor32_max(float v) { auto r = __builtin_amdgcn_permlane32_swap(__float_as_uint(v), __float_as_uint(v), false, false); return fmaxf(__uint_as_float(r[0]), __uint_as_float(r[1])); }
__device__ __forceinline__ float xor32_get(float v, bool upper) { auto r = __builtin_amdgcn_permlane32_swap(__float_as_uint(v), __float_as_uint(v), false, false); return __uint_as_float(upper ? r[0] : r[1]); }
__device__ __forceinline__ float wave_sum(float v) {
    v += dpp_mov<0xB1>(v);
    v += dpp_mov<0x4E>(v);
    v += dpp_mov<0x141>(v);
    v += dpp_mov<0x140>(v);
    v = xor16_add(v); v = xor32_add(v);
    return v;
}
__device__ __forceinline__ float fexp2(float x) { return __builtin_amdgcn_exp2f(x); }
__device__ __forceinline__ float sigmoidf_(float x) { return 1.f / (1.f + __expf(-x)); }
__device__ __forceinline__ float fsigmoid(float x) { return __builtin_amdgcn_rcpf(1.f + __builtin_amdgcn_exp2f(-x * 1.4426950408889634f)); }
__device__ __forceinline__ f32x4 mfma16(bf16x8 a, bf16x8 b, f32x4 c) { return __builtin_amdgcn_mfma_f32_16x16x32_bf16(a, b, c, 0, 0, 0); }

__device__ __forceinline__ void p0_item_load(const float* W, int N, int item, int lane, float (&r)[32]) {
    const int nblk = N / 32, kb = item / nblk, nb = item % nblk, k0 = 64 * kb, n0 = 32 * nb;
#pragma unroll
    for (int i = 0; i < 32; ++i) { const int kk = 2 * i + (lane >> 5); r[i] = __builtin_nontemporal_load(W + (size_t)(k0 + kk) * N + n0 + (lane & 31)); }
}
__device__ __forceinline__ void p0_item_lds_write(LAS float* scr, int lane, const float (&r)[32]) {
#pragma unroll
    for (int i = 0; i < 32; ++i) { const int kk = 2 * i + (lane >> 5); scr[kk * 33 + (lane & 31)] = r[i]; }
}
__device__ __forceinline__ void p0_item_store(int K, int N, bf16_t* WT, int row_off, LAS float* scr, int item, int lane) {
    const int nblk = N / 32, kb = item / nblk, nb = item % nblk, k0 = 64 * kb, n0 = 32 * nb;
    asm volatile("s_waitcnt lgkmcnt(0)" ::: "memory");
    const int c = lane & 7;
#pragma unroll
    for (int j = 0; j < 4; ++j) { const int n = (lane >> 3) + 8 * j; const LAS float* s = scr + (8 * c) * 33 + n;
        u32x4 o; o.x = pk2(s[0 * 33], s[1 * 33]); o.y = pk2(s[2 * 33], s[3 * 33]); o.z = pk2(s[4 * 33], s[5 * 33]); o.w = pk2(s[6 * 33], s[7 * 33]);
        *(u32x4*)(WT + (size_t)(row_off + n0 + n) * K + k0 + 8 * c) = o; }
    asm volatile("s_waitcnt lgkmcnt(0)" ::: "memory");
}
__device__ __forceinline__ void p0_transpose_item(const float* W, int K, int N, bf16_t* WT, int row_off, LAS float* scr, int item, int lane) {
    float r[32]; p0_item_load(W, N, item, lane, r); p0_item_lds_write(scr, lane, r); p0_item_store(K, N, WT, row_off, scr, item, lane);
}
template <bool SEL> __device__ __forceinline__ int win_item(int j) {
    if (SEL) { const int kb = j >> 5, e = j & 31; return kb * (INW / 32) + (e < 16 ? 128 + e : 272 + (e - 16)); }
    else { const int kb = j >> 8, c = j & 255; return kb * (INW / 32) + (c < 128 ? c : c + 16); }
}
template <bool SEL> __device__ __forceinline__ void p0_transpose_win(const float* W, bf16_t* WT, LAS float* scr, int first, int step, int lane) {
    constexpr int NJ = SEL ? 64 * 32 : 64 * 256;
    if (first >= NJ) return;
    float r[32]; p0_item_load(W, INW, win_item<SEL>(first), lane, r);
#pragma unroll 1
    for (int j = first; j < NJ; j += step) {
        p0_item_lds_write(scr, lane, r);
        if (j + step < NJ) p0_item_load(W, INW, win_item<SEL>(j + step), lane, r);
        p0_item_store(4096, INW, WT, 0, scr, win_item<SEL>(j), lane);
    }
}
__device__ __forceinline__ void p0_transpose_matrix(const float* W, int K, int N, bf16_t* WT, int row_off, LAS float* scr, int first, int step, int lane) {
    const int nitems = (K / 64) * (N / 32);
    if (first >= nitems) return;
    float r[32]; p0_item_load(W, N, first, lane, r);
#pragma unroll 1
    for (int it = first; it < nitems; it += step) {
        p0_item_lds_write(scr, lane, r);
        if (it + step < nitems) p0_item_load(W, N, it + step, lane, r);
        p0_item_store(K, N, WT, row_off, scr, it, lane);
    }
}
__device__ __forceinline__ void rms_row_to_bf16(const float* xrow, const f32x4 (&gv)[16], bf16_t* orow, int lane) {
    const f32x4* xr = (const f32x4*)xrow + lane;
    f32x4 v[16]; float s = 0.f;
#pragma unroll
    for (int k = 0; k < 16; ++k) { v[k] = __builtin_nontemporal_load(xr + 64 * k); s += (v[k].x * v[k].x + v[k].y * v[k].y) + (v[k].z * v[k].z + v[k].w * v[k].w); }
    const float rs = 1.f / sqrtf(wave_sum(s) * (1.f / 4096.f) + EPSN);
    u32x2* o8 = (u32x2*)orow + lane;
#pragma unroll
    for (int k = 0; k < 16; ++k) { const f32x4 g4 = gv[k]; u32x2 o; o.x = pk2(v[k].x * rs * g4.x, v[k].y * rs * g4.y); o.y = pk2(v[k].z * rs * g4.z, v[k].w * rs * g4.w); o8[64 * k] = o; }
}

__device__ __forceinline__ void phase0(const Args& a, LAS unsigned char* lds) {
    int tid = threadIdx.x; asm volatile("" : "+v"(tid)); const int lane = tid & 63, w = tid >> 6, G = gridDim.x;
    const int gw = blockIdx.x * 8 + w, NGW = G * 8;
    unsigned char* ws = a.ws;
    LAS float* scr = (LAS float*)(lds + w * 16384);
    bf16_t* WT = (bf16_t*)(ws + WS_WT); bf16_t* WOUT = (bf16_t*)(ws + WS_WOUT); bf16_t* LRUW = (bf16_t*)(ws + WS_LRUW);
    constexpr int I_IN = 64 * (INW / 32), I_MKV = 64 * (2048 / 32), I_OUT = 64 * (4096 / 32), I_LRU = 32 * 8;
    p0_transpose_win<true>(a.in[3], WT, scr, gw, NGW, lane);
    p0_transpose_matrix(a.in[13], 4096, 2048, WT, INW, scr, gw, NGW, lane);
    for (int r = gw; r < I_LRU; r += NGW) {
        const int mat = r >> 3, sub = r & 7, gate = mat >> 4, dn = mat & 15;
        const float* src = (gate ? a.in[9] : a.in[7]) + (size_t)dn * 16384;
        p0_transpose_item(src, 128, 128, LRUW + (size_t)mat * 16384, 0, scr, sub, lane);
    }
    bf16_t* U = (bf16_t*)(ws + WS_U);
    { f32x4 gv[16];
#pragma unroll
      for (int k = 0; k < 16; ++k) gv[k] = ((const f32x4*)a.in[2])[lane + 64 * k];
      for (int m = gw; m < SEQ; m += NGW) rms_row_to_bf16(a.in[0] + (size_t)m * 4096, gv, U + (size_t)m * 4096, lane);
#pragma unroll
      for (int k = 0; k < 16; ++k) gv[k] = ((const f32x4*)a.in[12])[lane + 64 * k];
      for (int m = gw; m < NMEM; m += NGW) rms_row_to_bf16(a.in[1] + (size_t)m * 4096, gv, U + (size_t)(SEQ + m) * 4096, lane); }
    f32x2* rope = (f32x2*)(ws + WS_ROPE);
    for (int e = blockIdx.x * 512 + tid; e < SEQ * 16; e += G * 512) {
        const int pos = e >> 4, i = e & 15;
        const float inv = powf(500000.0f, -(float)i * (1.0f / 16.0f));
        const float ang = (float)pos * inv;
        rope[e] = (f32x2){cosf(ang), sinf(ang)};
    }
}

struct Sched1 {
    pg8::StaticOrder so; int G, c, ioff, imax;
    __device__ void init(int G_, int c_) { so.init(SEQ, INW, G_, c_); G = G_; c = c_; ioff = 0; imax = 1 << 20; }
    __device__ bool next(int i0, pg8::Unit& u) const {
        if (i0 >= imax) return false;
        const int i = i0 + ioff;
        const long L = (long)i * G + c;
        if (L < 1152) return so.next(i, u);
        if (L < 1160) { u.pm = 32; u.pn = 36 + (int)(L - 1152); return true; }
        return false;
    }
    __device__ __forceinline__ void a_ready(const pg8::Unit&) const {}
    __device__ __forceinline__ void done(const pg8::Unit&) const {}
};
struct Epi1 {
    static constexpr bool PERM = true, AFTER_DRAIN = false, HOLD_LAST = false;
    bf16_t* proj; bf16_t* vt; bf16_t* mk; bf16_t* mvt; const float* rope;
    __device__ __forceinline__ void operator()(const f32x4 (&acc)[2][2][4][2], const pg8::Unit& u, int wr, int wc, int fr, int fq) const {
        const int rloc = wr * 64 + fr, cloc = wc * 32 + 8 * fq;
        if (u.pm == 32) {
            const int t = u.pn - 36;
            if (t < 4) {
#pragma unroll
                for (int ai = 0; ai < 2; ++ai)
#pragma unroll
                    for (int m = 0; m < 4; ++m) { const int row = rloc + ai * 128 + m * 16;
#pragma unroll
                        for (int bj = 0; bj < 2; ++bj) { const f32x4 v0 = acc[ai][bj][m][0], v1 = acc[ai][bj][m][1];
                            u32x4 wv; wv.x = pk2(v0[0], v0[1]); wv.y = pk2(v0[2], v0[3]); wv.z = pk2(v1[0], v1[1]); wv.w = pk2(v1[2], v1[3]);
                            *(u32x4*)(mk + (size_t)row * 1024 + t * 256 + bj * 128 + cloc) = wv; } asm volatile("" ::: "memory"); }
            } else {
#pragma unroll
                for (int ai = 0; ai < 2; ++ai)
#pragma unroll
                    for (int m = 0; m < 4; ++m) { const int row = rloc + ai * 128 + m * 16;
#pragma unroll
                        for (int bj = 0; bj < 2; ++bj)
#pragma unroll
                            for (int n = 0; n < 2; ++n)
#pragma unroll
                                for (int i = 0; i < 4; ++i) { const int col = (t - 4) * 256 + bj * 128 + cloc + 4 * n + i;
                                    mvt[(size_t)col * 256 + row] = (bf16_t)(pk2(acc[ai][bj][m][n][i], 0.f) & 0xffffu); } asm volatile("" ::: "memory"); }
            }
            return;
        }
        const int pn = u.pn, row0 = u.pm * 256 + rloc;
        if (pn == 10 || pn == 11) {
#pragma unroll
            for (int ai = 0; ai < 2; ++ai)
#pragma unroll
                for (int m = 0; m < 4; ++m) { const int row = row0 + ai * 128 + m * 16;
#pragma unroll
                    for (int bj = 0; bj < 2; ++bj)
#pragma unroll
                        for (int n = 0; n < 2; ++n)
#pragma unroll
                            for (int i = 0; i < 4; ++i) { const int col = (pn - 10) * 256 + bj * 128 + cloc + 4 * n + i;
                                vt[(size_t)col * SEQ + row] = (bf16_t)(pk2(acc[ai][bj][m][n][i], 0.f) & 0xffffu); } asm volatile("" ::: "memory"); }
            return;
        }
        float sc = 1.f; if (pn < 8) sc = SC_ATT; else if (pn >= 16 && pn < 20) sc = SC_MEM;
        const bool do_rope = (pn < 10) && (wc == 0);
        const float sgn = (fq < 2) ? -1.f : 1.f;
        f32x4 csA[2][2], cst[2][2];
        if (do_rope) {
#pragma unroll
            for (int n = 0; n < 2; ++n) { const int io = (8 * (fq & 1) + 4 * n) * 2;
                const float* ra = rope + (size_t)row0 * 32 + io; const float* rt = rope + 16 * 32 + io;
                csA[n][0] = *(const f32x4*)ra; csA[n][1] = *(const f32x4*)(ra + 4); cst[n][0] = *(const f32x4*)rt; cst[n][1] = *(const f32x4*)(rt + 4); }
        }
#pragma unroll
        for (int ai = 0; ai < 2; ++ai)
#pragma unroll
            for (int m = 0; m < 4; ++m) { const int row = row0 + ai * 128 + m * 16;
                f32x4 cs[2][2];
                if (do_rope) {
                    const int nrot = (ai == 0 && m == 3) ? 5 : 1;
#pragma unroll
                    for (int n = 0; n < 2; ++n)
#pragma unroll
                        for (int hh = 0; hh < 2; ++hh) { f32x4 cur = csA[n][hh]; cs[n][hh] = cur; const f32x4 t = cst[n][hh];
#pragma unroll
                            for (int rr = 0; rr < 5; ++rr) { if (rr < nrot) { f32x4 nx; nx[0] = cur[0] * t[0] - cur[1] * t[1]; nx[1] = cur[1] * t[0] + cur[0] * t[1]; nx[2] = cur[2] * t[2] - cur[3] * t[3]; nx[3] = cur[3] * t[2] + cur[2] * t[3]; cur = nx; } }
                            csA[n][hh] = cur; }
                }
#pragma unroll
                for (int bj = 0; bj < 2; ++bj) { f32x4 v[2]; v[0] = acc[ai][bj][m][0]; v[1] = acc[ai][bj][m][1];
                    if (do_rope) {
#pragma unroll
                        for (int n = 0; n < 2; ++n) { f32x4 p; p[0] = xor32_get(v[n][0], fq >= 2); p[1] = xor32_get(v[n][1], fq >= 2); p[2] = xor32_get(v[n][2], fq >= 2); p[3] = xor32_get(v[n][3], fq >= 2);
                            f32x4 r; r[0] = v[n][0] * cs[n][0][0] + sgn * p[0] * cs[n][0][1]; r[1] = v[n][1] * cs[n][0][2] + sgn * p[1] * cs[n][0][3];
                            r[2] = v[n][2] * cs[n][1][0] + sgn * p[2] * cs[n][1][1]; r[3] = v[n][3] * cs[n][1][2] + sgn * p[3] * cs[n][1][3]; v[n] = r; }
                    }
                    u32x4 wv; wv.x = pk2(v[0][0] * sc, v[0][1] * sc); wv.y = pk2(v[0][2] * sc, v[0][3] * sc); wv.z = pk2(v[1][0] * sc, v[1][1] * sc); wv.w = pk2(v[1][2] * sc, v[1][3] * sc);
                    __builtin_nontemporal_store(wv, (u32x4*)(proj + (size_t)row * INW + pn * 256 + bj * 128 + cloc)); } asm volatile("" ::: "memory"); }
    }
};

template <int DH, bool PF, bool DB>
__device__ __forceinline__ void attn_unit(LAS unsigned char* lds, const bf16_t* Qp, int ldq, bf16_t* Op, int ldo, const bf16_t* Kg, int ldk, const bf16_t* Vtg, int ldv,
                                          int cb_lo, int cb_hi, int cb_self, float m_init, float l_init) {
    constexpr int PR = DH / 8, KROW = DH * 2, KT = 128 * KROW, VROW = 288, NKI = (128 * PR) / 512, NVI = (DH * 16) / 512, NS = DH / 32, NDT = DH / 16;
    int tid = threadIdx.x; asm volatile("" : "+v"(tid)); const int lane = tid & 63, w = tid >> 6, q = lane & 15, g = lane >> 4;
    const int krow = 8 * (q >> 2) + (q & 3);
    bf16x8 qf[NS];
    { const unsigned qoff = (unsigned)(((16 * w + q) * ldq + 8 * g) * 2);
#pragma unroll
      for (int s = 0; s < NS; ++s) qf[s] = __builtin_nontemporal_load((const bf16x8*)((const char*)Qp + qoff + 64 * s)); }
    f32x4 o[NDT];
#pragma unroll
    for (int dt = 0; dt < NDT; ++dt) o[dt] = (f32x4){0.f, 0.f, 0.f, 0.f};
    float m_run = m_init, l_run = l_init;
    u32x4 kreg[NKI], vreg[NVI];
#define ATT_LOAD(cb) do { const int k0_ = (cb) * 128; \
        const char* kb_ = (const char*)Kg + (size_t)k0_ * ldk * 2; const char* vb_ = (const char*)Vtg + (size_t)k0_ * 2; \
        _Pragma("unroll") for (int it = 0; it < NKI; ++it) { const int e = tid + 512 * it; const int key = e / PR, pc = e % PR; \
            kreg[it] = *(const u32x4*)(kb_ + (unsigned)((key * ldk + pc * 8) * 2)); } \
        _Pragma("unroll") for (int it = 0; it < NVI; ++it) { const int e = tid + 512 * it; const int d = e >> 4, pc = e & 15; \
            vreg[it] = *(const u32x4*)(vb_ + (unsigned)((d * ldv + pc * 8) * 2)); } } while (0)
#define ATT_STORE() do { \
        _Pragma("unroll") for (int it = 0; it < NKI; ++it) { const int e = tid + 512 * it; const int key = e / PR, pc = e % PR; \
            *(LAS u32x4*)(lds + key * KROW + ((pc ^ ((((key >> 3) & 3) << 2) | (key & 3))) * 16)) = kreg[it]; } \
        _Pragma("unroll") for (int it = 0; it < NVI; ++it) { const int e = tid + 512 * it; const int d = e >> 4, pc = e & 15; \
            *(LAS u32x4*)(lds + KT + d * VROW + pc * 16) = vreg[it]; } } while (0)
    if (PF) ATT_LOAD(cb_lo);
    for (int cb = cb_lo; cb < cb_hi; ++cb) {
        if (!PF) ATT_LOAD(cb);
        __syncthreads();
        ATT_STORE();
        __syncthreads();
        if (PF) { if (cb + 1 < cb_hi) ATT_LOAD(cb + 1); }
        f32x4 s[8];
#pragma unroll
        for (int kt = 0; kt < 8; ++kt) s[kt] = (f32x4){0.f, 0.f, 0.f, 0.f};
        {
            bf16x8 ka[DB ? 2 : 1][8];
            if (DB) {
#pragma unroll
                for (int kt = 0; kt < 8; ++kt) ka[0][kt] = *(const LAS bf16x8*)(lds + (32 * (kt >> 1) + 4 * (kt & 1) + krow) * KROW + (((0 + g) ^ q) * 16));
            }
#pragma unroll
            for (int ss = 0; ss < NS; ++ss) {
                if (DB) { if (ss + 1 < NS) {
#pragma unroll
                    for (int kt = 0; kt < 8; ++kt) ka[(ss + 1) & 1][kt] = *(const LAS bf16x8*)(lds + (32 * (kt >> 1) + 4 * (kt & 1) + krow) * KROW + (((4 * (ss + 1) + g) ^ q) * 16)); }
                } else {
#pragma unroll
                    for (int kt = 0; kt < 8; ++kt) ka[0][kt] = *(const LAS bf16x8*)(lds + (32 * (kt >> 1) + 4 * (kt & 1) + krow) * KROW + (((4 * ss + g) ^ q) * 16));
                }
                __builtin_amdgcn_sched_barrier(0);
#pragma unroll
                for (int kt = 0; kt < 8; ++kt) s[kt] = mfma16(ka[DB ? (ss & 1) : 0][kt], qf[ss], s[kt]);
                __builtin_amdgcn_sched_barrier(0);
            }
        }
        if (cb != cb_self && cb_self >= 0) {
            const float sg = (cb < cb_self) ? 1.f : -1.f;
            const float dq = (float)(16 * w + q - 8 * g);
#pragma unroll
            for (int kt = 0; kt < 8; ++kt)
#pragma unroll
                for (int j = 0; j < 4; ++j) { const float v = sg * ((float)(32 * (kt >> 1) + 4 * (kt & 1) + j) - dq); s[kt][j] += fminf(v, 0.f) * 1e30f; }
        }
        float mx = s[0][0];
#pragma unroll
        for (int kt = 0; kt < 8; ++kt)
#pragma unroll
            for (int j = 0; j < 4; ++j) mx = fmaxf(mx, s[kt][j]);
        mx = xor16_max(mx); mx = xor32_max(mx);
        const float m_new = fmaxf(m_run, mx), alpha = fexp2(m_run - m_new); m_run = m_new;
        float rs = 0.f;
#pragma unroll
        for (int kt = 0; kt < 8; ++kt)
#pragma unroll
            for (int j = 0; j < 4; ++j) { const float p = fexp2(s[kt][j] - m_new); s[kt][j] = p; rs += p; }
        rs = xor16_add(rs); rs = xor32_add(rs);
        l_run = l_run * alpha + rs;
        bf16x8 pb[4];
#pragma unroll
        for (int u = 0; u < 4; ++u) { u32x4 t; t.x = pk2(s[2 * u][0], s[2 * u][1]); t.y = pk2(s[2 * u][2], s[2 * u][3]); t.z = pk2(s[2 * u + 1][0], s[2 * u + 1][1]); t.w = pk2(s[2 * u + 1][2], s[2 * u + 1][3]);
            pb[u] = __builtin_bit_cast(bf16x8, t); }
#pragma unroll
        for (int dt = 0; dt < NDT; ++dt) o[dt] = o[dt] * alpha;
        {
            constexpr int NG = (NDT / 8) * 4;
            u32x4 va[DB ? 2 : 1][8];
#define ATT_VLOAD(buf, gi) do { const int u_ = (gi) & 3, d0_ = 8 * ((gi) >> 2); \
            _Pragma("unroll") for (int i = 0; i < 8; ++i) { va[buf][i] = *(const LAS u32x4*)(lds + KT + (16 * (d0_ + i) + q) * VROW + (32 * u_ + 8 * g) * 2); } } while (0)
            if (DB) ATT_VLOAD(0, 0);
#pragma unroll
            for (int gi = 0; gi < NG; ++gi) {
                if (DB) { if (gi + 1 < NG) ATT_VLOAD((gi + 1) & 1, gi + 1); } else ATT_VLOAD(0, gi);
                __builtin_amdgcn_sched_barrier(0);
#pragma unroll
                for (int i = 0; i < 8; ++i) o[8 * (gi >> 2) + i] = mfma16(__builtin_bit_cast(bf16x8, va[DB ? (gi & 1) : 0][i]), pb[gi & 3], o[8 * (gi >> 2) + i]);
                __builtin_amdgcn_sched_barrier(0);
            }
#undef ATT_VLOAD
        }
    }
#undef ATT_LOAD
#undef ATT_STORE
    const float inv = 1.f / l_run;
    const unsigned ooff = (unsigned)(((16 * w + q) * ldo + 4 * g) * 2);
#pragma unroll
    for (int dt = 0; dt < NDT; ++dt) { u32x2 pkv; pkv.x = pk2(o[dt][0] * inv, o[dt][1] * inv); pkv.y = pk2(o[dt][2] * inv, o[dt][3] * inv); *(u32x2*)((char*)Op + ooff + 32 * dt) = pkv; }
}

__device__ __forceinline__ void windowed_stream(LAS unsigned char* lds0, const Args& a) {
    constexpr int DH = 128, PR = 16, KROW = 256, KT = 128 * KROW, VROW = 288, BUFB = KT + DH * VROW, NKI = 4, NVI = 4, NS = 4, NDT = 8;
    static_assert(2 * BUFB <= LDS_BYTES - 64, "two K/V tile buffers must fit under the barrier words");
    int tid = threadIdx.x; asm volatile("" : "+v"(tid)); const int lane = tid & 63, w = tid >> 6, q = lane & 15, g = lane >> 4;
    const int krow = 8 * (q >> 2) + (q & 3);
    unsigned char* ws = a.ws;
    const bf16_t* proj = (const bf16_t*)(ws + WS_PROJ); const bf16_t* vt = (const bf16_t*)(ws + WS_VT); bf16_t* yatt = (bf16_t*)(ws + WS_YATT);
    const int G = (int)gridDim.x;
    if ((int)blockIdx.x >= 1024) return;
    unsigned koff[NKI], voff[NVI], klds[NKI], vlds[NVI];
#pragma unroll
    for (int it = 0; it < NKI; ++it) { const int e = tid + 512 * it, key = e / PR, pc = e % PR; koff[it] = (unsigned)((key * INW + pc * 8) * 2); klds[it] = (unsigned)(key * KROW + ((pc ^ ((((key >> 3) & 3) << 2) | (key & 3))) * 16)); }
#pragma unroll
    for (int it = 0; it < NVI; ++it) { const int e = tid + 512 * it, d = e >> 4, pc = e & 15; voff[it] = (unsigned)((d * SEQ + pc * 8) * 2); vlds[it] = (unsigned)(KT + d * VROW + pc * 16); }
    u32x4 kreg[NKI], vreg[NVI];
#define WS_LOAD(v_, cb_) do { const int kvh_ = ((v_) & 15) >> 2; \
        const char* kb_ = (const char*)proj + ((size_t)((cb_) * 128) * INW + C_KA + kvh_ * 128) * 2; const char* vb_ = (const char*)vt + ((size_t)(kvh_ * 128) * SEQ + (cb_) * 128) * 2; \
        _Pragma("unroll") for (int it = 0; it < NKI; ++it) kreg[it] = *(const u32x4*)(kb_ + koff[it]); \
        _Pragma("unroll") for (int it = 0; it < NVI; ++it) vreg[it] = *(const u32x4*)(vb_ + voff[it]); } while (0)
#define WS_STORE(ldsb_) do { \
        _Pragma("unroll") for (int it = 0; it < NKI; ++it) *(LAS u32x4*)((ldsb_) + klds[it]) = kreg[it]; \
        _Pragma("unroll") for (int it = 0; it < NVI; ++it) *(LAS u32x4*)((ldsb_) + vlds[it]) = vreg[it]; } while (0)
#define WS_LO(v_) ((((v_) >> 4) > 0) ? ((v_) >> 4) - 1 : 0)
#define WS_HI(v_) ((((v_) >> 4) < 63) ? ((v_) >> 4) + 2 : 64)
    int Cv = (int)blockIdx.x, Ccb = WS_LO(Cv);
    int Lv = Cv, Lcb = Ccb; bool Lvalid = true;
#define WS_ADV_L() do { if (Lcb + 1 < WS_HI(Lv)) ++Lcb; else { Lv += G; if (Lv < 1024) Lcb = WS_LO(Lv); else Lvalid = false; } } while (0)
    __syncthreads();
    WS_LOAD(Lv, Lcb); WS_ADV_L();
    WS_STORE(lds0);
    bool have = false;
    if (Lvalid) { WS_LOAD(Lv, Lcb); WS_ADV_L(); have = true; }
    __syncthreads();
    int bsel = 0;
    bf16x8 qf[NS]; f32x4 o[NDT]; float m_run = 0.f, l_run = 1.f;
#pragma unroll 1
    for (;;) {
        const int qblk = Cv >> 4, hq = Cv & 15, lo = WS_LO(Cv), hi = WS_HI(Cv);
        LAS unsigned char* lds = lds0 + bsel * BUFB;
        if (Ccb == lo) {
            const unsigned qoff = (unsigned)(((16 * w + q) * INW + 8 * g) * 2);
            const char* qb = (const char*)proj + ((size_t)(qblk * 128) * INW + C_QA + hq * 128) * 2;
#pragma unroll
            for (int s = 0; s < NS; ++s) qf[s] = __builtin_nontemporal_load((const bf16x8*)(qb + qoff + 64 * s));
#pragma unroll
            for (int dt = 0; dt < NDT; ++dt) o[dt] = (f32x4){0.f, 0.f, 0.f, 0.f};
            m_run = a.in[4][hq] * LOG2E; l_run = 1.f;
        }
        if (have) { WS_STORE(lds0 + (bsel ^ 1) * BUFB); have = false; }
        if (Lvalid) { WS_LOAD(Lv, Lcb); WS_ADV_L(); have = true; }
        f32x4 s[8];
#pragma unroll
        for (int kt = 0; kt < 8; ++kt) s[kt] = (f32x4){0.f, 0.f, 0.f, 0.f};
        {
            bf16x8 ka[2][8];
#pragma unroll
            for (int kt = 0; kt < 8; ++kt) ka[0][kt] = *(const LAS bf16x8*)(lds + (32 * (kt >> 1) + 4 * (kt & 1) + krow) * KROW + (((0 + g) ^ q) * 16));
#pragma unroll
            for (int ss = 0; ss < NS; ++ss) {
                if (ss + 1 < NS) {
#pragma unroll
                    for (int kt = 0; kt < 8; ++kt) ka[(ss + 1) & 1][kt] = *(const LAS bf16x8*)(lds + (32 * (kt >> 1) + 4 * (kt & 1) + krow) * KROW + (((4 * (ss + 1) + g) ^ q) * 16)); }
                __builtin_amdgcn_sched_barrier(0);
#pragma unroll
                for (int kt = 0; kt < 8; ++kt) s[kt] = mfma16(ka[ss & 1][kt], qf[ss], s[kt]);
                __builtin_amdgcn_sched_barrier(0);
            }
        }
        if (Ccb != qblk) {
            const bool prev = Ccb < qblk; const int ud = __builtin_amdgcn_readfirstlane(w) >> 1;
            const float sg = prev ? 1.f : -1.f;
            const float dq = (float)(16 * w + q - 8 * g);
#pragma unroll
            for (int u = 0; u < 4; ++u) {
                if (prev ? (u < ud) : (u > ud)) {
#pragma unroll
                    for (int j = 0; j < 4; ++j) { s[2 * u][j] = -1e30f; s[2 * u + 1][j] = -1e30f; }
                } else if (u == ud) {
#pragma unroll
                    for (int h2 = 0; h2 < 2; ++h2)
#pragma unroll
                        for (int j = 0; j < 4; ++j) { const float v = sg * ((float)(32 * u + 4 * h2 + j) - dq); s[2 * u + h2][j] += fminf(v, 0.f) * 1e30f; }
                }
            }
        }
        float mx = s[0][0];
#pragma unroll
        for (int kt = 0; kt < 8; ++kt)
#pragma unroll
            for (int j = 0; j < 4; ++j) mx = fmaxf(mx, s[kt][j]);
        mx = xor16_max(mx); mx = xor32_max(mx);
        const float m_new = fmaxf(m_run, mx), alpha = fexp2(m_run - m_new); m_run = m_new;
        float rs = 0.f;
#pragma unroll
        for (int kt = 0; kt < 8; ++kt)
#pragma unroll
            for (int j = 0; j < 4; ++j) { const float p = fexp2(s[kt][j] - m_new); s[kt][j] = p; rs += p; }
        rs = xor16_add(rs); rs = xor32_add(rs);
        l_run = l_run * alpha + rs;
        bf16x8 pb[4];
#pragma unroll
        for (int u = 0; u < 4; ++u) { u32x4 t; t.x = pk2(s[2 * u][0], s[2 * u][1]); t.y = pk2(s[2 * u][2], s[2 * u][3]); t.z = pk2(s[2 * u + 1][0], s[2 * u + 1][1]); t.w = pk2(s[2 * u + 1][2], s[2 * u + 1][3]);
            pb[u] = __builtin_bit_cast(bf16x8, t); }
#pragma unroll
        for (int dt = 0; dt < NDT; ++dt) o[dt] = o[dt] * alpha;
        {
            u32x4 va[2][8];
#define WS_VLOAD(buf, gi) do { _Pragma("unroll") for (int i = 0; i < 8; ++i) { va[buf][i] = *(const LAS u32x4*)(lds + KT + (16 * i + q) * VROW + (32 * (gi) + 8 * g) * 2); } } while (0)
            WS_VLOAD(0, 0);
#pragma unroll
            for (int gi = 0; gi < 4; ++gi) {
                if (gi + 1 < 4) WS_VLOAD((gi + 1) & 1, gi + 1);
                __builtin_amdgcn_sched_barrier(0);
#pragma unroll
                for (int i = 0; i < 8; ++i) o[i] = mfma16(__builtin_bit_cast(bf16x8, va[gi & 1][i]), pb[gi], o[i]);
                __builtin_amdgcn_sched_barrier(0);
            }
#undef WS_VLOAD
        }
        bool done = false;
        if (Ccb + 1 < hi) ++Ccb;
        else {
            const float inv = 1.f / l_run;
            char* ob = (char*)yatt + ((size_t)(qblk * 128) * 2048 + hq * 128) * 2;
            const unsigned ooff = (unsigned)(((16 * w + q) * 2048 + 4 * g) * 2);
#pragma unroll
            for (int dt = 0; dt < NDT; ++dt) { u32x2 pkv; pkv.x = pk2(o[dt][0] * inv, o[dt][1] * inv); pkv.y = pk2(o[dt][2] * inv, o[dt][3] * inv); *(u32x2*)(ob + ooff + 32 * dt) = pkv; }
            Cv += G; if (Cv < 1024) Ccb = WS_LO(Cv); else done = true;
        }
        __syncthreads();
        bsel ^= 1;
        if (done) break;
    }
#undef WS_LOAD
#undef WS_STORE
#undef WS_LO
#undef WS_HI
#undef WS_ADV_L
}

constexpr int LR_XCB = 0, LR_TA = 16384, LR_TB = LR_TA + 64 * 528, LR_TH = LR_TB + 64 * 528, LR_AGS = LR_TH + 64 * 528;
template <int VAR>
__device__ __forceinline__ void lru_phase(LAS unsigned char* lds, const Args& a, const int n, const int tt_first, const int tt_step) {
    int tid = threadIdx.x; asm volatile("" : "+v"(tid)); const int lane = tid & 63, w0 = tid >> 6, q0 = lane & 15, g0 = lane >> 4;
    unsigned char* ws = a.ws;
    const bf16_t* proj = (const bf16_t*)(ws + WS_PROJ);
    LAS unsigned char* xcb = lds + LR_XCB;
    LAS float* TA = (LAS float*)(lds + LR_TA); LAS float* TB = (LAS float*)(lds + LR_TB); LAS float* TH = (LAS float*)(lds + LR_TH);
    LAS f32x2* AGS = (LAS f32x2*)(lds + LR_AGS);
    const bf16_t* lruw = (const bf16_t*)(ws + WS_LRUW);
    f32x2* agg1 = (f32x2*)(ws + (VAR ? WS_T0 : WS_AGG1));
    bf16_t* Pout = (bf16_t*)(ws + (VAR ? WS_U + 32 * MiB : WS_PP));
    bf16x8 fa[2][4], fx[2][4];
#pragma unroll
    for (int dir = 0; dir < 2; ++dir) {
        const bf16_t* wa = lruw + (size_t)((0 * 2 + dir) * 8 + n) * 16384 + (16 * w0 + q0) * 128 + 8 * g0;
        const bf16_t* wx = lruw + (size_t)((1 * 2 + dir) * 8 + n) * 16384 + (16 * w0 + q0) * 128 + 8 * g0;
#pragma unroll
        for (int s = 0; s < 4; ++s) { fa[dir][s] = *(const bf16x8*)(wa + 32 * s); fx[dir][s] = *(const bf16x8*)(wx + 32 * s); }
    }
    const int cg8 = tid & 15, t2 = tid >> 4, ch0 = n * 128 + cg8 * 8;
    LAS float* CW = (LAS float*)(lds + LR_AGS + 4096);
    __syncthreads();
    if (tid < 128) {
#pragma unroll
        for (int j = 0; j < 4; ++j) CW[j * 128 + tid] = a.in[5][j * 1024 + n * 128 + tid];
        CW[512 + tid] = a.in[6][n * 128 + tid];
    } else if (tid < 384) {
        const int d2 = (tid - 128) >> 7, c = tid & 127, cg = d2 * 1024 + n * 128 + c;
        const float xl = -a.in[11][cg];
        CW[640 + (d2 * 3 + 0) * 128 + c] = a.in[8][cg]; CW[640 + (d2 * 3 + 1) * 128 + c] = a.in[10][cg];
        CW[640 + (d2 * 3 + 2) * 128 + c] = fmaxf(xl, 0.f) + log1pf(expf(-fabsf(xl)));
    }
    u32x4 xr[5];
#define LRU_XLOAD(tt_) do { _Pragma("unroll") for (int r = 0; r < 5; ++r) { const int t = (tt_) * 64 + 2 * t2 - 2 + r; xr[r] = (u32x4){0u, 0u, 0u, 0u}; \
        if (t >= 0 && t < SEQ) xr[r] = __builtin_nontemporal_load((const u32x4*)((const char*)proj + (unsigned)((t * INW + C_XL + ch0) * 2))); } } while (0)
    float A2f = 1.f, H2f = 0.f, A2b = 1.f, H2b = 0.f;
    LRU_XLOAD(tt_first);
#pragma unroll 1
    for (int tt = tt_first; tt < tt_first + 4; ++tt) {
    const int t0 = tt * 64;
    __syncthreads();
    {
        float xin[5][8];
#pragma unroll
        for (int r = 0; r < 5; ++r) { const u32x4 v = xr[r];
            xin[r][0] = bflo(v.x); xin[r][1] = bfhi(v.x); xin[r][2] = bflo(v.y); xin[r][3] = bfhi(v.y); xin[r][4] = bflo(v.z); xin[r][5] = bfhi(v.z); xin[r][6] = bflo(v.w); xin[r][7] = bfhi(v.w); }
        float wv[4][8], bias[8];
#pragma unroll
        for (int j = 0; j < 4; ++j) { const f32x4 w0 = *(const LAS f32x4*)(CW + j * 128 + cg8 * 8), w1 = *(const LAS f32x4*)(CW + j * 128 + cg8 * 8 + 4);
            wv[j][0] = w0[0]; wv[j][1] = w0[1]; wv[j][2] = w0[2]; wv[j][3] = w0[3]; wv[j][4] = w1[0]; wv[j][5] = w1[1]; wv[j][6] = w1[2]; wv[j][7] = w1[3]; }
        { const f32x4 b0 = *(const LAS f32x4*)(CW + 512 + cg8 * 8), b1 = *(const LAS f32x4*)(CW + 512 + cg8 * 8 + 4);
          bias[0] = b0[0]; bias[1] = b0[1]; bias[2] = b0[2]; bias[3] = b0[3]; bias[4] = b1[0]; bias[5] = b1[1]; bias[6] = b1[2]; bias[7] = b1[3]; }
#pragma unroll
        for (int o = 0; o < 2; ++o) { float y[8];
#pragma unroll
            for (int e = 0; e < 8; ++e) { float v = bias[e];
#pragma unroll
                for (int j = 0; j < 4; ++j) v += wv[j][e] * xin[o + j][e];
                y[e] = v; }
            const int tok = 2 * t2 + o;
            u32x4 pk; pk.x = pk2(y[0], y[1]); pk.y = pk2(y[2], y[3]); pk.z = pk2(y[4], y[5]); pk.w = pk2(y[6], y[7]);
            *(LAS u32x4*)(xcb + tok * 256 + ((cg8 ^ (tok & 15)) * 16)) = pk; }
    }
    if (tt + 1 < tt_first + 4) LRU_XLOAD(tt + 1);
    __syncthreads();
    float hreg[16];
    int tl = tid; asm volatile("" : "+v"(tl));
    const int q = tl & 15, g = (tl >> 4) & 3, w = tl >> 6, chl = 16 * w + 4 * g;
    const int ch = 16 * w + q, sub = g;
#pragma unroll
    for (int dir = 0; dir < 2; ++dir) {
        LAS float* TAd = dir ? TH : TA;
        if (VAR != 3) {
            const f32x4 ba = *(const LAS f32x4*)(CW + 640 + (dir * 3 + 0) * 128 + chl), bx = *(const LAS f32x4*)(CW + 640 + (dir * 3 + 1) * 128 + chl), sp = *(const LAS f32x4*)(CW + 640 + (dir * 3 + 2) * 128 + chl);
#pragma unroll
            for (int tk = 0; tk < 4; ++tk) { const int tok = 16 * tk + q;
                f32x4 ar = (f32x4){0.f, 0.f, 0.f, 0.f}, ai = (f32x4){0.f, 0.f, 0.f, 0.f};
#pragma unroll
                for (int s = 0; s < 4; ++s) {
                    const bf16x8 xb = *(const LAS bf16x8*)(xcb + tok * 256 + (((4 * s + g) ^ q) * 16));
                    ar = mfma16(fa[dir][s], xb, ar); ai = mfma16(fx[dir][s], xb, ai); }
                const u32x2 xr2 = *(const LAS u32x2*)(xcb + tok * 256 + ((((chl >> 3)) ^ q) * 16) + (chl & 7) * 2);
                const float xc0 = bflo(xr2.x), xc1 = bfhi(xr2.x), xc2 = bflo(xr2.y), xc3 = bfhi(xr2.y);
                f32x4 av, bv;
#pragma unroll
                for (int j = 0; j < 4; ++j) { if (VAR == 1) { av[j] = ar[j] + ba[j] + sp[j]; bv[j] = ai[j] + bx[j] + (j == 0 ? xc0 : (j == 1 ? xc1 : (j == 2 ? xc2 : xc3))); continue; }
                    const float r = fsigmoid(ar[j] + ba[j]), ii = fsigmoid(ai[j] + bx[j]);
                    const float la = -8.0f * r * sp[j]; const float aa = fexp2(la * LOG2E); av[j] = aa;
                    const float x2 = 2.0f * la;
                    const float poly = x2 * (1.f + x2 * (0.5f + x2 * ((1.f / 6.f) + x2 * ((1.f / 24.f) + x2 * (1.f / 120.f)))));
                    const float om = (x2 > -0.25f) ? -poly : (1.f - aa * aa);
                    const float xcj = j == 0 ? xc0 : (j == 1 ? xc1 : (j == 2 ? xc2 : xc3));
                    bv[j] = __builtin_amdgcn_sqrtf(om) * ii * xcj; }
                *(LAS f32x4*)(TAd + tok * 132 + chl) = av; *(LAS f32x4*)(TB + tok * 132 + chl) = bv; }
        }
        asm volatile("s_waitcnt lgkmcnt(0)" ::: "memory");
        if (VAR != 2 && VAR != 3) {
            float h = 0.f, P = 1.f;
#pragma unroll
            for (int i = 0; i < 16; ++i) { const int t = 16 * sub + (dir ? 15 - i : i);
                const float av = TAd[t * 132 + ch], bv = TB[t * 132 + ch]; h = av * h + bv; P *= av; TB[t * 132 + ch] = h; TAd[t * 132 + ch] = P; }
            AGS[sub * 128 + ch] = (f32x2){P, h};
        }
        asm volatile("s_waitcnt lgkmcnt(0)" ::: "memory");
        if (VAR == 2 || VAR == 3) {
#pragma unroll
            for (int i = 0; i < 16; ++i) hreg[i] = 0.f;
        } else {
            float hc = 0.f, Pp = 1.f, At = 1.f, Ht = 0.f;
#pragma unroll
            for (int s = 0; s < 4; ++s) { const int s2 = dir ? 3 - s : s; const f32x2 e = AGS[s2 * 128 + ch];
                const bool before = dir ? (s2 > sub) : (s2 < sub);
                if (before) { hc = e.x * hc + e.y; Pp *= e.x; }
                Ht = e.x * Ht + e.y; At *= e.x; }
#pragma unroll
            for (int i = 0; i < 16; ++i) { const int t = 16 * sub + i;
                const float Pl = TAd[t * 132 + ch], hl = TB[t * 132 + ch];
                const float hfull = hl + Pl * hc;
                if (dir == 0) hreg[i] = hfull; else hreg[i] += hfull;
                TAd[t * 132 + ch] = Pl * Pp; }
            if (sub == 0) agg1[(size_t)(dir * 1024 + n * 128 + ch) * 128 + tt] = (f32x2){At, Ht};
            if (dir == 0) { H2f = At * H2f + Ht; A2f *= At; }
            else { H2b = A2b * Ht + H2b; A2b *= At; }
        }
        asm volatile("s_waitcnt lgkmcnt(0)" ::: "memory");
    }
#pragma unroll
    for (int i = 0; i < 16; ++i) TB[(16 * sub + i) * 132 + ch] = hreg[i];
    __syncthreads();
    {
        float* hs = (float*)(ws + (VAR ? WS_U : WS_HS));
#pragma unroll
        for (int i = 0; i < 4; ++i) { const int e = tid + 512 * i, t = e >> 5, c4 = e & 31;
            *(f32x4*)(hs + (size_t)(t0 + t) * 1024 + n * 128 + 4 * c4) = *(const LAS f32x4*)(TB + t * 132 + 4 * c4);
            const f32x4 p0 = *(const LAS f32x4*)(TA + t * 132 + 4 * c4), p1 = *(const LAS f32x4*)(TH + t * 132 + 4 * c4);
            u32x2 o0, o1; o0.x = pk2(p0[0], p0[1]); o0.y = pk2(p0[2], p0[3]); o1.x = pk2(p1[0], p1[1]); o1.y = pk2(p1[2], p1[3]);
            *(u32x2*)(Pout + (size_t)(t0 + t) * 1024 + n * 128 + 4 * c4) = o0;
            *(u32x2*)(Pout + (size_t)SEQ * 1024 + (size_t)(t0 + t) * 1024 + n * 128 + 4 * c4) = o1; }
    }
    }
    if (g0 == 0) { f32x2* agg2 = (f32x2*)(ws + (VAR ? WS_T0 + 8 * MiB : WS_AGG2)); const int chg2 = n * 128 + 16 * w0 + q0, sc2 = tt_first >> 2;
        agg2[(size_t)chg2 * 32 + sc2] = (f32x2){A2f, H2f}; agg2[(size_t)(1024 + chg2) * 32 + sc2] = (f32x2){A2b, H2b}; }
#undef LRU_XLOAD
}

__device__ __forceinline__ void phase2(const Args& a, LAS unsigned char* lds, int p2mask) {
    unsigned char* ws = a.ws;
    bf16_t* proj = (bf16_t*)(ws + WS_PROJ); const bf16_t* vt = (const bf16_t*)(ws + WS_VT);
    const bf16_t* mk = (const bf16_t*)(ws + WS_MK); const bf16_t* mvt = (const bf16_t*)(ws + WS_MVT);
    bf16_t* yatt = (bf16_t*)(ws + WS_YATT); bf16_t* ymem = (bf16_t*)(ws + WS_YMEM);
    if (p2mask & 1)
    for (int u = blockIdx.x; u < 256; u += gridDim.x) {
        const int qblk = u >> 2, hm = u & 3;
        attn_unit<256, false, false>(lds, proj + (size_t)(qblk * 128) * INW + C_QM + hm * 256, INW, ymem + (size_t)(qblk * 128) * 1024 + hm * 256, 1024, mk + hm * 256, 1024, mvt + (size_t)(hm * 256) * 256, 256, 0, 2, -100, -1e30f, 0.f);
    }
    if (p2mask & 2) windowed_stream(lds, a);
    if (p2mask & 4)
    lru_phase<0>(lds, a, (int)(blockIdx.x & 7), 4 * (int)(blockIdx.x >> 3), 1);
}

__device__ __forceinline__ void phase3(const Args& a, LAS unsigned char* lds) {
    unsigned char* ws = a.ws;
    const f32x2* agg1 = (const f32x2*)(ws + WS_AGG1); f32x2* agg2 = (f32x2*)(ws + WS_AGG2);
    for (int e = blockIdx.x * 512 + threadIdx.x; e < 2 * 1024 * 16; e += gridDim.x * 512) {
        const int sc = e & 15, dc = e >> 4, dir = dc >> 10;
        const f32x4* p = (const f32x4*)(agg1 + (size_t)dc * 128 + sc * 8);
        f32x4 v[4];
#pragma unroll
        for (int i = 0; i < 4; ++i) v[i] = p[i];
        float A = 1.f, H = 0.f;
        if (dir == 0) {
#pragma unroll
            for (int i = 0; i < 4; ++i) { H = v[i][0] * H + v[i][1]; A *= v[i][0]; H = v[i][2] * H + v[i][3]; A *= v[i][2]; }
        } else {
#pragma unroll
            for (int i = 3; i >= 0; --i) { H = v[i][2] * H + v[i][3]; A *= v[i][2]; H = v[i][0] * H + v[i][1]; A *= v[i][0]; }
        }
        agg2[(size_t)dc * 16 + sc] = (f32x2){A, H};
    }
}

__device__ __forceinline__ float silu_(float z) { return z * __builtin_amdgcn_rcpf(1.f + __builtin_amdgcn_exp2f(-z * 1.4426950408889634f)); }
__device__ __forceinline__ void phase4(const Args& a, LAS unsigned char* lds) {
    unsigned char* ws = a.ws;
    const f32x2* agg1 = (const f32x2*)(ws + WS_AGG1); const f32x2* agg2 = (const f32x2*)(ws + WS_AGG2);
    const bf16_t* proj = (const bf16_t*)(ws + WS_PROJ); bf16_t* Y = (bf16_t*)(ws + WS_Y);
    const bf16_t* yatt = (const bf16_t*)(ws + WS_YATT); const bf16_t* ymem = (const bf16_t*)(ws + WS_YMEM);
    const float* hs = (const float*)(ws + WS_HS); const bf16_t* Pf = (const bf16_t*)(ws + WS_PP); const bf16_t* Pb = Pf + (size_t)SEQ * 1024;
    LAS float* car = (LAS float*)lds;
    LAS float* gl = (LAS float*)(lds + 8192);
    int tid = threadIdx.x; asm volatile("" : "+v"(tid)); const int lane = tid & 63, w = tid >> 6;
    __syncthreads();
    for (int i = tid; i < 1024; i += 512) { *(LAS f32x4*)(gl + 4 * i) = (i < 512) ? ((const f32x4*)a.in[14])[i] : (i < 768 ? ((const f32x4*)a.in[15])[i - 512] : ((const f32x4*)a.in[16])[i - 768]); }
    for (int u = blockIdx.x; u < 256; u += gridDim.x) {
        const int tile = u >> 1, sc = tile >> 2, cj = tile & 3;
        __syncthreads();
#pragma unroll 1
        for (int half = 0; half < 2; ++half) {
            const int c = tid + 512 * half;
            float hf = 0.f, hb = 0.f;
            float scf = (float)sc, cjf = (float)cj; asm volatile("" : "+v"(scf), "+v"(cjf));
            { const f32x4* p2 = (const f32x4*)(agg2 + (size_t)c * 32); const f32x4* p1 = (const f32x4*)(agg1 + (size_t)c * 128 + sc * 4);
              f32x4 e2[16], e1[2];
#pragma unroll
              for (int i = 0; i < 16; ++i) e2[i] = p2[i];
#pragma unroll
              for (int i = 0; i < 2; ++i) e1[i] = p1[i];
#pragma unroll
              for (int i = 0; i < 16; ++i) { const float w0 = fminf(fmaxf(scf - (float)(2 * i), 0.f), 1.f), w1 = fminf(fmaxf(scf - (float)(2 * i + 1), 0.f), 1.f);
                  hf = (w0 * e2[i][0] + (1.f - w0)) * hf + w0 * e2[i][1]; hf = (w1 * e2[i][2] + (1.f - w1)) * hf + w1 * e2[i][3]; }
#pragma unroll
              for (int i = 0; i < 2; ++i) { const float w0 = fminf(fmaxf(cjf - (float)(2 * i), 0.f), 1.f), w1 = fminf(fmaxf(cjf - (float)(2 * i + 1), 0.f), 1.f);
                  hf = (w0 * e1[i][0] + (1.f - w0)) * hf + w0 * e1[i][1]; hf = (w1 * e1[i][2] + (1.f - w1)) * hf + w1 * e1[i][3]; } }
            { const f32x4* p2 = (const f32x4*)(agg2 + (size_t)(1024 + c) * 32); const f32x4* p1 = (const f32x4*)(agg1 + (size_t)(1024 + c) * 128 + sc * 4);
              f32x4 e2[16], e1[2];
#pragma unroll
              for (int i = 0; i < 16; ++i) e2[i] = p2[i];
#pragma unroll
              for (int i = 0; i < 2; ++i) e1[i] = p1[i];
#pragma unroll
              for (int i = 15; i >= 0; --i) { const float w1 = fminf(fmaxf((float)(2 * i + 1) - scf, 0.f), 1.f), w0 = fminf(fmaxf((float)(2 * i) - scf, 0.f), 1.f);
                  hb = (w1 * e2[i][2] + (1.f - w1)) * hb + w1 * e2[i][3]; hb = (w0 * e2[i][0] + (1.f - w0)) * hb + w0 * e2[i][1]; }
#pragma unroll
              for (int i = 1; i >= 0; --i) { const float w1 = fminf(fmaxf((float)(2 * i + 1) - cjf, 0.f), 1.f), w0 = fminf(fmaxf((float)(2 * i) - cjf, 0.f), 1.f);
                  hb = (w1 * e1[i][2] + (1.f - w1)) * hb + w1 * e1[i][3]; hb = (w0 * e1[i][0] + (1.f - w0)) * hb + w0 * e1[i][1]; } }
            car[c] = hf; car[1024 + c] = hb;
        }
        __syncthreads();
        f32x4 cf[4], cb[4];
#pragma unroll
        for (int k = 0; k < 4; ++k) { cf[k] = *(const LAS f32x4*)(car + 4 * lane + 256 * k); cb[k] = *(const LAS f32x4*)(car + 1024 + 4 * lane + 256 * k); }
#pragma unroll 1
        for (int tk = 0; tk < 4; ++tk) {
            const unsigned t = (unsigned)(u * 32 + 4 * w + tk);
            const char* hsb = (const char*)hs; const char* pfb = (const char*)Pf; const char* pbb = (const char*)Pb;
            const char* yab = (const char*)yatt; const char* ymb = (const char*)ymem; const char* prb = (const char*)proj; char* yb = (char*)Y;
            const unsigned o_h = t * 4096u + 16u * lane, o_p = t * 2048u + 8u * lane, o_m = t * 2048u + 16u * lane;
            const unsigned o_pr = t * (unsigned)(INW * 2), o_y = t * 8192u;
            f32x4 h4[4]; u32x2 pf[4], pb[4], zl[4]; u32x4 va[4], vm[2], za[4], zm[2];
#pragma unroll
            for (int k = 0; k < 4; ++k) { h4[k] = __builtin_nontemporal_load((const f32x4*)(hsb + o_h + 1024u * k)); pf[k] = __builtin_nontemporal_load((const u32x2*)(pfb + o_p + 512u * k)); pb[k] = __builtin_nontemporal_load((const u32x2*)(pbb + o_p + 512u * k)); va[k] = __builtin_nontemporal_load((const u32x4*)(yab + o_h + 1024u * k)); }
#pragma unroll
            for (int k = 0; k < 2; ++k) vm[k] = __builtin_nontemporal_load((const u32x4*)(ymb + o_m + 1024u * k));
#pragma unroll
            for (int k = 0; k < 4; ++k) { zl[k] = __builtin_nontemporal_load((const u32x2*)(prb + o_pr + (unsigned)((C_ZL + 4 * lane + 256 * k) * 2))); za[k] = __builtin_nontemporal_load((const u32x4*)(prb + o_pr + (unsigned)((C_ZA + 8 * lane + 512 * k) * 2))); }
#pragma unroll
            for (int k = 0; k < 2; ++k) zm[k] = __builtin_nontemporal_load((const u32x4*)(prb + o_pr + (unsigned)((C_ZM + 8 * lane + 512 * k) * 2)));
            __builtin_amdgcn_sched_barrier(0);
            f32x4 v[4]; float ssl = 0.f, ssa = 0.f, ssm = 0.f;
#pragma unroll
            for (int k = 0; k < 4; ++k) {
                v[k][0] = h4[k][0] + bflo(pf[k].x) * cf[k][0] + bflo(pb[k].x) * cb[k][0]; v[k][1] = h4[k][1] + bfhi(pf[k].x) * cf[k][1] + bfhi(pb[k].x) * cb[k][1];
                v[k][2] = h4[k][2] + bflo(pf[k].y) * cf[k][2] + bflo(pb[k].y) * cb[k][2]; v[k][3] = h4[k][3] + bfhi(pf[k].y) * cf[k][3] + bfhi(pb[k].y) * cb[k][3];
                ssl += (v[k][0] * v[k][0] + v[k][1] * v[k][1]) + (v[k][2] * v[k][2] + v[k][3] * v[k][3]);
                { const float f0 = bflo(va[k].x), f1 = bfhi(va[k].x), f2 = bflo(va[k].y), f3 = bfhi(va[k].y), f4 = bflo(va[k].z), f5 = bfhi(va[k].z), f6 = bflo(va[k].w), f7 = bfhi(va[k].w);
                  ssa += ((f0 * f0 + f1 * f1) + (f2 * f2 + f3 * f3)) + ((f4 * f4 + f5 * f5) + (f6 * f6 + f7 * f7)); } }
#pragma unroll
            for (int k = 0; k < 2; ++k) { const float f0 = bflo(vm[k].x), f1 = bfhi(vm[k].x), f2 = bflo(vm[k].y), f3 = bfhi(vm[k].y), f4 = bflo(vm[k].z), f5 = bfhi(vm[k].z), f6 = bflo(vm[k].w), f7 = bfhi(vm[k].w);
                ssm += ((f0 * f0 + f1 * f1) + (f2 * f2 + f3 * f3)) + ((f4 * f4 + f5 * f5) + (f6 * f6 + f7 * f7)); }
            ssl = wave_sum(ssl); ssa = wave_sum(ssa); ssm = wave_sum(ssm);
            const float rsl = 1.f / sqrtf(ssl * (1.f / 1024.f) + EPSN), rsa = 1.f / sqrtf(ssa * (1.f / 2048.f) + EPSN), rsm = 1.f / sqrtf(ssm * (1.f / 1024.f) + EPSN);
            __builtin_amdgcn_sched_barrier(0);
#pragma unroll
            for (int k = 0; k < 4; ++k) { const int c = 4 * lane + 256 * k; const f32x4 g4 = *(const LAS f32x4*)(gl + 2048 + c); const u32x2 z = zl[k];
                u32x2 o; o.x = pk2(v[k][0] * rsl * g4[0] * silu_(bflo(z.x)), v[k][1] * rsl * g4[1] * silu_(bfhi(z.x))); o.y = pk2(v[k][2] * rsl * g4[2] * silu_(bflo(z.y)), v[k][3] * rsl * g4[3] * silu_(bfhi(z.y)));
                *(u32x2*)(yb + o_y + (unsigned)((2048 + c) * 2)) = o; }
            __builtin_amdgcn_sched_barrier(0);
#pragma unroll
            for (int k = 0; k < 4; ++k) { const int c = 8 * lane + 512 * k; const f32x4 g0 = *(const LAS f32x4*)(gl + c), g1 = *(const LAS f32x4*)(gl + c + 4); const u32x4 z = za[k];
                u32x4 o; o.x = pk2(bflo(va[k].x) * rsa * g0[0] * silu_(bflo(z.x)), bfhi(va[k].x) * rsa * g0[1] * silu_(bfhi(z.x)));
                o.y = pk2(bflo(va[k].y) * rsa * g0[2] * silu_(bflo(z.y)), bfhi(va[k].y) * rsa * g0[3] * silu_(bfhi(z.y)));
                o.z = pk2(bflo(va[k].z) * rsa * g1[0] * silu_(bflo(z.z)), bfhi(va[k].z) * rsa * g1[1] * silu_(bfhi(z.z)));
                o.w = pk2(bflo(va[k].w) * rsa * g1[2] * silu_(bflo(z.w)), bfhi(va[k].w) * rsa * g1[3] * silu_(bfhi(z.w)));
                *(u32x4*)(yb + o_y + (unsigned)(c * 2)) = o; }
            __builtin_amdgcn_sched_barrier(0);
#pragma unroll
            for (int k = 0; k < 2; ++k) { const int c = 8 * lane + 512 * k; const f32x4 g0 = *(const LAS f32x4*)(gl + 3072 + c), g1 = *(const LAS f32x4*)(gl + 3072 + c + 4); const u32x4 z = zm[k];
                u32x4 o; o.x = pk2(bflo(vm[k].x) * rsm * g0[0] * silu_(bflo(z.x)), bfhi(vm[k].x) * rsm * g0[1] * silu_(bfhi(z.x)));
                o.y = pk2(bflo(vm[k].y) * rsm * g0[2] * silu_(bflo(z.y)), bfhi(vm[k].y) * rsm * g0[3] * silu_(bfhi(z.y)));
                o.z = pk2(bflo(vm[k].z) * rsm * g1[0] * silu_(bflo(z.z)), bfhi(vm[k].z) * rsm * g1[1] * silu_(bfhi(z.z)));
                o.w = pk2(bflo(vm[k].w) * rsm * g1[2] * silu_(bflo(z.w)), bfhi(vm[k].w) * rsm * g1[3] * silu_(bfhi(z.w)));
                *(u32x4*)(yb + o_y + (unsigned)((3072 + c) * 2)) = o; }
        }
    }
}

#define XB_TMO      128
#define XB_XCNT(j)  (256  + 64 * (j))
#define XB_XSUB(j)  (1280 + 64 * (j))
#define XB_XGEN(j)  (2304 + 64 * (j))
#define XB_TOP      3328
#define XB_TOPGEN   3392
#define XCD_BAR_WORDS 3456
#define XB_SPIN_CAP (1u << 18)

__device__ __forceinline__ unsigned xb_ld(unsigned* p)              { return __hip_atomic_load(p, __ATOMIC_RELAXED, __HIP_MEMORY_SCOPE_AGENT); }
__device__ __forceinline__ unsigned xb_add(unsigned* p, unsigned v) { return __hip_atomic_fetch_add(p, v, __ATOMIC_RELAXED, __HIP_MEMORY_SCOPE_AGENT); }
__device__ __forceinline__ unsigned xb_xcc_id() { return (unsigned)__builtin_amdgcn_s_getreg((3 << 11) | 20) & 0xFu; }
#define XB_SPIN(cond, bar) do { unsigned _sp = 0; while (cond) { __builtin_amdgcn_s_sleep(1); \
    if ((++_sp & 255u) == 0u) { if (xb_ld(&(bar)[XB_TMO])) break; if (_sp > XB_SPIN_CAP) { atomicAdd(&(bar)[XB_TMO], 1u); break; } } } } while (0)

struct XcdBarrier {
    unsigned* bar; unsigned x;
    volatile LAS unsigned* st;
};

__device__ __forceinline__ XcdBarrier xcd_barrier_post(unsigned* bar, volatile LAS unsigned* st) {
    XcdBarrier b; b.bar = bar; b.x = xb_xcc_id(); b.st = st;
    if (threadIdx.x == 0) (void)xb_add(&bar[XB_XCNT(b.x)], 1u);
    return b;
}
__device__ __forceinline__ void xcd_barrier_complete(unsigned* bar, unsigned x, unsigned& nloc, unsigned& nx) {
    const unsigned G = gridDim.x * gridDim.y * gridDim.z;
    unsigned sum, cnt, mine, sp = 0u;
    for (;;) {
        sum = 0u; cnt = 0u; mine = 0u;
#pragma unroll
        for (unsigned j = 0; j < 16; ++j) { const unsigned c = xb_ld(&bar[XB_XCNT(j)]); sum += c; cnt += (c > 0u) ? 1u : 0u; mine = (j == x) ? c : mine; }
        if (sum == G) break;
        __builtin_amdgcn_s_sleep(1);
        if ((++sp & 255u) == 0u) { if (xb_ld(&bar[XB_TMO])) break; if (sp > XB_SPIN_CAP) { atomicAdd(&bar[XB_TMO], 1u); break; } }
    }
    nloc = mine > 0u ? mine : 1u; nx = cnt > 0u ? cnt : 1u;
}

__device__ __forceinline__ void xcd_barrier(const XcdBarrier& b) {
    asm volatile("s_waitcnt vmcnt(0)" ::: "memory");
    __syncthreads();
    if (threadIdx.x == 0) {
        unsigned* bar = b.bar;
        __builtin_amdgcn_s_waitcnt(0);
        unsigned nloc = b.st[0], nx = b.st[1];
        if (nloc == 0u) { xcd_barrier_complete(bar, b.x, nloc, nx); b.st[0] = nloc; b.st[1] = nx; }
        const unsigned old = xb_add(&bar[XB_XSUB(b.x)], 1u);
        const unsigned gen = old / nloc;
        if (old + 1u == (gen + 1u) * nloc) {
            __builtin_amdgcn_fence(__ATOMIC_RELEASE, "agent");
            asm volatile("s_waitcnt vmcnt(0)" ::: "memory");
            const unsigned og = xb_add(&bar[XB_TOP], 1u);
            const unsigned tg = og / nx;
            if (og + 1u == (tg + 1u) * nx) xb_add(&bar[XB_TOPGEN], 1u);
            else XB_SPIN(xb_ld(&bar[XB_TOPGEN]) == tg, bar);
            __builtin_amdgcn_fence(__ATOMIC_ACQUIRE, "agent");
            xb_add(&bar[XB_XGEN(b.x)], 1u);
            asm volatile("s_waitcnt vmcnt(0)" ::: "memory");
        } else {
            XB_SPIN(xb_ld(&bar[XB_XGEN(b.x)]) == gen, bar);
            __builtin_amdgcn_fence(__ATOMIC_ACQUIRE, "agent");
            asm volatile("s_waitcnt vmcnt(0)" ::: "memory");
        }
    }
    __syncthreads();
}

struct Sched2 {
    int c;
    __device__ bool next(int i, pg8::Unit& u) const {
        if (i >= 2) return false;
        const int x = c & 7, j = c >> 3;
        u.pm = i * 16 + 4 * (x >> 1) + (j & 3); u.pn = 8 * (x & 1) + (j >> 2); return true;
    }
    __device__ __forceinline__ void a_ready(const pg8::Unit&) const {}
    __device__ __forceinline__ void done(const pg8::Unit&) const {}
};
struct Epi3 {
    static constexpr bool PERM = true, AFTER_DRAIN = false, HOLD_LAST = true;
    float* out; bf16_t* t0; float* sspart; const float* x; const float* gain; XcdBarrier xbar;
    __device__ __forceinline__ void operator()(const f32x4 (&acc)[2][2][4][2], const pg8::Unit& u, int wr, int wc, int fr, int fq) const {
#pragma unroll
        for (int ai = 0; ai < 2; ++ai)
#pragma unroll
            for (int m = 0; m < 4; ++m) { const int row = u.pm * 256 + ai * 128 + wr * 64 + m * 16 + fr; float ss = 0.f;
#pragma unroll
                for (int bj = 0; bj < 2; ++bj) { const f32x4 v0 = acc[ai][bj][m][0], v1 = acc[ai][bj][m][1]; const int col = u.pn * 256 + bj * 128 + wc * 32 + 8 * fq;
                    u32x4 pk; pk.x = pk2(v0[0], v0[1]); pk.y = pk2(v0[2], v0[3]); pk.z = pk2(v1[0], v1[1]); pk.w = pk2(v1[2], v1[3]); *(u32x4*)(t0 + (size_t)row * 4096 + col) = pk;
                    ss += ((v0[0] * v0[0] + v0[1] * v0[1]) + (v0[2] * v0[2] + v0[3] * v0[3])) + ((v1[0] * v1[0] + v1[1] * v1[1]) + (v1[2] * v1[2] + v1[3] * v1[3])); }
                ss = xor16_add(ss); ss = xor32_add(ss);
                if (fq == 0) sspart[(size_t)row * 64 + u.pn * 4 + wc] = ss; }
    }
    __device__ __forceinline__ void fused(f32x4 (&acc)[2][2][4][2], const pg8::Unit& u, int wr, int wc, int fr, int fq, LAS unsigned char* lds, int wid, int lane) const {
#pragma unroll
        for (int ai = 0; ai < 2; ++ai)
#pragma unroll
            for (int m = 0; m < 4; ++m) { const int row = u.pm * 256 + ai * 128 + wr * 64 + m * 16 + fr; float ss = 0.f;
#pragma unroll
                for (int bj = 0; bj < 2; ++bj)
#pragma unroll
                    for (int n = 0; n < 2; ++n) { const f32x4 v = acc[ai][bj][m][n]; ss += (v[0] * v[0] + v[1] * v[1]) + (v[2] * v[2] + v[3] * v[3]); }
                ss = xor16_add(ss); ss = xor32_add(ss);
                if (fq == 0) sspart[(size_t)row * 64 + u.pn * 4 + wc] = ss; }
        f32x4 xv0[16], xv1[16];
        const size_t gob = (size_t)(u.pm * 256 + wid * 16) * 4096 + u.pn * 256 + 4 * lane;
#pragma unroll
        for (int r = 0; r < 16; ++r) xv0[r] = __builtin_nontemporal_load((const f32x4*)(x + gob + (size_t)r * 4096));
        xcd_barrier(xbar);
        constexpr int TP = 260;
        LAS float* T = (LAS float*)lds;
        LAS float* rsT = (LAS float*)(lds + 128 * TP * 4);
        { const int tid = wid * 64 + lane, row = tid >> 1, hf = tid & 1;
          const f32x4* p = (const f32x4*)(sspart + (size_t)(u.pm * 256 + row) * 64 + hf * 32);
          float s = 0.f;
#pragma unroll
          for (int i = 0; i < 8; ++i) { const f32x4 v = p[i]; s += (v[0] + v[1]) + (v[2] + v[3]); }
          s += dpp_mov<0xB1>(s);
          if (hf == 0) rsT[row] = 1.f / sqrtf(s * (1.f / 4096.f) + EPSN); }
        const f32x4 gv = *(const f32x4*)(gain + u.pn * 256 + 4 * lane);
#pragma unroll
        for (int ai = 0; ai < 2; ++ai) {
            __syncthreads();
#pragma unroll
            for (int m = 0; m < 4; ++m)
#pragma unroll
                for (int bj = 0; bj < 2; ++bj)
#pragma unroll
                    for (int n = 0; n < 2; ++n) *(LAS f32x4*)(T + (wr * 64 + m * 16 + fr) * TP + bj * 128 + wc * 32 + 8 * fq + 4 * n) = acc[ai][bj][m][n];
            if (ai == 0) {
#pragma unroll
                for (int r = 0; r < 16; ++r) xv1[r] = __builtin_nontemporal_load((const f32x4*)(x + gob + (size_t)(128 + r) * 4096));
            }
            __syncthreads();
#pragma unroll
            for (int r = 0; r < 16; ++r) { const int rl = wid * 16 + r;
                const f32x4 tv = *(const LAS f32x4*)(T + rl * TP + 4 * lane); const float rs = rsT[ai * 128 + rl];
                __builtin_nontemporal_store((ai ? xv1[r] : xv0[r]) + tv * rs * gv, (f32x4*)(out + gob + (size_t)(ai * 128 + r) * 4096)); }
        }
        const int pm0 = u.pm - 16;
        __syncthreads();
        { const int tid = wid * 64 + lane, row = tid >> 1, hf = tid & 1;
          const f32x4* p = (const f32x4*)(sspart + (size_t)(pm0 * 256 + row) * 64 + hf * 32);
          float s = 0.f;
#pragma unroll
          for (int i = 0; i < 8; ++i) { const f32x4 v = p[i]; s += (v[0] + v[1]) + (v[2] + v[3]); }
          s += dpp_mov<0xB1>(s);
          if (hf == 0) rsT[row] = 1.f / sqrtf(s * (1.f / 4096.f) + EPSN); }
        __syncthreads();
#pragma unroll 1
        for (int hb = 0; hb < 2; ++hb) {
            const int r0 = wid * 32 + hb * 16;
            const size_t go = (size_t)(pm0 * 256 + r0) * 4096 + u.pn * 256 + 4 * lane;
            f32x4 xr[16]; u32x2 tr[16];
#pragma unroll
            for (int r = 0; r < 16; ++r) { xr[r] = __builtin_nontemporal_load((const f32x4*)(x + go + (size_t)r * 4096)); tr[r] = __builtin_nontemporal_load((const u32x2*)(t0 + go + (size_t)r * 4096)); }
#pragma unroll
            for (int r = 0; r < 16; ++r) { const float rs = rsT[r0 + r];
                f32x4 o; o[0] = xr[r][0] + bflo(tr[r].x) * rs * gv[0]; o[1] = xr[r][1] + bfhi(tr[r].x) * rs * gv[1]; o[2] = xr[r][2] + bflo(tr[r].y) * rs * gv[2]; o[3] = xr[r][3] + bfhi(tr[r].y) * rs * gv[3];
                __builtin_nontemporal_store(o, (f32x4*)(out + go + (size_t)r * 4096)); }
        }
    }
};
__device__ __forceinline__ void phase6(const Args& a) {
    int tid = threadIdx.x; asm volatile("" : "+v"(tid)); const int lane = tid & 63, w = tid >> 6;
    const float* sspart = (const float*)(a.ws + WS_SS); const bf16_t* t0 = (const bf16_t*)(a.ws + WS_T0);
    f32x4 gv[16];
#pragma unroll
    for (int k = 0; k < 16; ++k) gv[k] = ((const f32x4*)a.in[18])[2 * lane + 128 * (k >> 1) + (k & 1)];
    for (int row = blockIdx.x * 8 + w; row < 4096; row += gridDim.x * 8) {
        const u32x4* t4 = (const u32x4*)(t0 + (size_t)row * 4096) + lane; f32x4* o4 = (f32x4*)(a.out + (size_t)row * 4096) + 2 * lane;
        const f32x4* x4 = (const f32x4*)(a.in[0] + (size_t)row * 4096) + 2 * lane;
        u32x4 tv[8]; f32x4 xa[8], xb[8];
        const float sp = sspart[(size_t)row * 64 + lane];
#pragma unroll
        for (int k = 0; k < 8; ++k) { tv[k] = __builtin_nontemporal_load(t4 + 64 * k); xa[k] = __builtin_nontemporal_load(x4 + 128 * k); xb[k] = __builtin_nontemporal_load(x4 + 128 * k + 1); }
        const float rs = 1.f / sqrtf(wave_sum(sp) * (1.f / 4096.f) + EPSN);
#pragma unroll
        for (int k = 0; k < 8; ++k) { const f32x4 ga = gv[2 * k], gb = gv[2 * k + 1];
            f32x4 oa, ob; oa[0] = xa[k][0] + bflo(tv[k].x) * rs * ga[0]; oa[1] = xa[k][1] + bfhi(tv[k].x) * rs * ga[1]; oa[2] = xa[k][2] + bflo(tv[k].y) * rs * ga[2]; oa[3] = xa[k][3] + bfhi(tv[k].y) * rs * ga[3];
            ob[0] = xb[k][0] + bflo(tv[k].z) * rs * gb[0]; ob[1] = xb[k][1] + bfhi(tv[k].z) * rs * gb[1]; ob[2] = xb[k][2] + bflo(tv[k].w) * rs * gb[2]; ob[3] = xb[k][3] + bfhi(tv[k].w) * rs * gb[3];
            __builtin_nontemporal_store(oa, o4 + 128 * k); __builtin_nontemporal_store(ob, o4 + 128 * k + 1); }
    }
}

__global__ void __launch_bounds__(512, 2) mega(Args a) {
    extern __shared__ __attribute__((aligned(16))) unsigned char lds_raw[];
    LAS unsigned char* lds = (LAS unsigned char*)lds_raw;
    cg::grid_group grid = cg::this_grid();
    unsigned char* ws = a.ws;
    volatile LAS unsigned* xst = (volatile LAS unsigned*)(lds + LDS_BYTES - 64);
    if (threadIdx.x < 16) xst[threadIdx.x] = 0u;
    __syncthreads();
    XcdBarrier xbar; xbar.bar = (unsigned*)(ws + WS_CTL); xbar.x = 0; xbar.st = nullptr;
    xbar = xcd_barrier_post((unsigned*)(ws + WS_CTL), xst);
    const int lo = a.ph_lo, hi = a.ph_hi;
#define IN(k) (lo <= (k) && (k) < hi)
#define SEAM(k) do { if (IN(k) && IN((k) + 1)) xcd_barrier(xbar); } while (0)
    if (IN(0)) { if (PHMASK & 1) phase0(a, lds); if (REPMASK & 1) { __syncthreads(); phase0(a, lds); } }
    SEAM(0);
    if (IN(1)) { if (PHMASK & 2) {
        pg8::Gemm g{(const bf16_t*)(ws + WS_U), (const bf16_t*)(ws + WS_WT), SEQ + NMEM, INW + 2048, 4096};
        Epi1 E{(bf16_t*)(ws + WS_PROJ), (bf16_t*)(ws + WS_VT), (bf16_t*)(ws + WS_MK), (bf16_t*)(ws + WS_MVT), (const float*)(ws + WS_ROPE)};
        const int G = (int)gridDim.x, nfull = 1160 % G, nidle = G - nfull, bi = (int)blockIdx.x - nfull;
        if (bi < 0) {
            Sched1 S; S.init(G, (int)blockIdx.x); S.ioff = 4;
            pg8::gemm_phase<Epi1, Sched1, true, true>(lds, g, S, E);
        } else {
            int tid = threadIdx.x; asm volatile("" : "+v"(tid)); const int lane = tid & 63, w = tid >> 6;
            LAS float* scr = (LAS float*)(lds + w * 16384);
            p0_transpose_win<false>(a.in[3], (bf16_t*)(ws + WS_WT), scr, bi * 8 + w, nidle * 8, lane);
            p0_transpose_matrix(a.in[17], 4096, 4096, (bf16_t*)(ws + WS_WOUT), 0, scr, bi * 8 + w, nidle * 8, lane);
        }
        __syncthreads(); grid.sync();
        { Sched1 S; S.init(G, (int)blockIdx.x); S.imax = 4;
          pg8::gemm_phase<Epi1, Sched1, true, true>(lds, g, S, E); }
    } }
    SEAM(1);
    if (IN(2)) { if (PHMASK & 4) phase2(a, lds, P2MASK); }
    SEAM(2);
    if (IN(4)) { if (PHMASK & 16) phase4(a, lds); if (REPMASK & 16) { __syncthreads(); phase4(a, lds); } }
    SEAM(4);
    if (IN(5)) { if (PHMASK & 32) {
        pg8::Gemm g{(const bf16_t*)(ws + WS_Y), (const bf16_t*)(ws + WS_WOUT), SEQ, 4096, 4096};
        Sched2 S; S.c = (int)blockIdx.x;
        Epi3 E{a.out, (bf16_t*)(ws + WS_T0), (float*)(ws + WS_SS), a.in[0], a.in[18], xbar};
        pg8::gemm_phase<Epi3, Sched2, true, true>(lds, g, S, E);
    } }
#if N_LAUNCHES != 1
    if (lo >= 7 && lo < 10) phase2(a, lds, 1 << (lo - 7));
    if (lo == 11 || lo == 12) {
        pg8::Gemm g{(const bf16_t*)(ws + WS_U), (const bf16_t*)(ws + WS_WT), SEQ + NMEM, INW + 2048, 4096};
        Sched1 S; S.init((int)gridDim.x, (int)blockIdx.x); if (lo == 11) S.imax = 4; else S.ioff = 4;
        Epi1 E{(bf16_t*)(ws + WS_PROJ), (bf16_t*)(ws + WS_VT), (bf16_t*)(ws + WS_MK), (bf16_t*)(ws + WS_MVT), (const float*)(ws + WS_ROPE)};
        pg8::gemm_phase<Epi1, Sched1, true, true>(lds, g, S, E);
    }
    if (lo == 13) {
        pg8::Gemm g{(const bf16_t*)(ws + WS_U), (const bf16_t*)(ws + WS_WT), SEQ + NMEM, INW + 2048, 4096};
        Sched1 S; S.init((int)gridDim.x, (int)blockIdx.x); S.imax = 4;
        pg8::EpiBf16<0> E{(bf16_t*)(ws + WS_HS), INW, nullptr, 0, 0, 1.f};
        pg8::gemm_phase<pg8::EpiBf16<0>, Sched1, true, true>(lds, g, S, E);
    }
#ifdef LRUVAR
    if (lo == 10) lru_phase<LRUVAR>(lds, a, (int)(blockIdx.x & 7), (int)(blockIdx.x >> 3), (int)(gridDim.x >> 3));
#endif
#endif
#undef IN
#undef SEAM
}

extern "C" void kernel_launch(void* const* d_in, const int* in_sizes, int n_in, void* d_out, int out_size, void* d_ws, size_t ws_size, hipStream_t stream) {
    static int grid = 0;
    if (grid == 0) {
        if (n_in != 19 || ws_size < WS_END) { fprintf(stderr, "kernel_launch: unexpected n_in %d or ws_size %zu (need %zu)\n", n_in, ws_size, (size_t)WS_END); grid = -1; return; }
        int dev = 0, cus = 0, per_cu = 0;
        hipGetDevice(&dev); hipDeviceGetAttribute(&cus, hipDeviceAttributeMultiprocessorCount, dev);
        if (hipFuncSetAttribute((const void*)mega, hipFuncAttributeMaxDynamicSharedMemorySize, LDS_BYTES) != hipSuccess) { fprintf(stderr, "kernel_launch: hipFuncSetAttribute failed\n"); grid = -1; return; }
        if (hipOccupancyMaxActiveBlocksPerMultiprocessor(&per_cu, (const void*)mega, 512, LDS_BYTES) != hipSuccess || per_cu < 1) { fprintf(stderr, "kernel_launch: occupancy query says %d\n", per_cu); per_cu = 1; }
        (void)hipGetLastError();
        if (cus < 256) { fprintf(stderr, "kernel_launch: needs 256 CUs (one workgroup per CU), device has %d\n", cus); grid = -1; return; }
        grid = 256;
    }
    if (grid < 0) return;
    Args a{};
    for (int i = 0; i < 19; ++i) a.in[i] = (const float*)d_in[i];
    a.out = (float*)d_out; a.ws = (unsigned char*)d_ws;
#if N_LAUNCHES == 1
    (void)hipMemsetAsync((char*)d_ws + WS_CTL, 0, 65536, stream);
    a.ph_lo = 0; a.ph_hi = NPH;
    void* args[] = {&a};
    hipError_t e = hipLaunchCooperativeKernel((const void*)mega, dim3(grid), dim3(512), args, LDS_BYTES, stream);
    if (e != hipSuccess) fprintf(stderr, "cooperative launch failed: %s (grid %d)\n", hipGetErrorString(e), grid);
#else
#ifndef PHSEQ
#define PHSEQ 0,1,2,3,4,5,6
#endif
    { const int seq[] = {PHSEQ};
      for (unsigned i = 0; i < sizeof(seq) / sizeof(int); ++i) { a.ph_lo = seq[i]; a.ph_hi = seq[i] + 1; (void)hipMemsetAsync((char*)d_ws + WS_CTL, 0, 65536, stream); hipLaunchKernelGGL(mega, dim3(grid), dim3(512), LDS_BYTES, stream, a); } }
#endif
}
```

```cpp
#include <hip/hip_runtime.h>
#include <hip/hip_cooperative_groups.h>
#include <cstdio>
#include <cstdint>
namespace cg = cooperative_groups;
#define N_LAUNCHES 1
namespace pg8 {
#define PG8_LAS __attribute__((address_space(3)))
typedef unsigned short bf16_t;
typedef short bf16x8 __attribute__((ext_vector_type(8)));
typedef float f32x4 __attribute__((ext_vector_type(4)));
typedef unsigned u32x4 __attribute__((ext_vector_type(4)));
constexpr int BM = 256, BK = 64, HALF = 128, HTB = HALF * BK * 2  , STAGE_BYTES = 8 * HTB, NXCD = 8, WGM = 8;

__host__ __device__ __forceinline__ int lds_byte(int r, int c) { const int st = (r >> 4) * 2 + (c >> 5), rr = r & 15, cc = c & 31, ob = rr * 64 + cc * 2; return st * 1024 + (ob ^ (((ob >> 9) & 1) << 5)); }
__host__ __device__ __forceinline__ void stage_rc(int b, int& R, int& C) { const int st = b / 1024, sb = b % 1024, swz = sb ^ (((sb >> 9) & 1) << 5); R = (st >> 1) * 16 + swz / 64; C = (st & 1) * 32 + (swz % 64) / 2; }
__host__ __device__ __forceinline__ int perm32(int rho) { const int n = rho >> 4, i = rho & 15; return 8 * (i >> 2) + 4 * n + (i & 3); }

struct Unit { int pm, pn; };
struct Gemm { const bf16_t* A; const bf16_t* Bt; int M, N, K; };

struct StaticOrder {
    int nM, nN, nwg, G, c;
    __host__ __device__ void init(int M, int N, int G_, int c_) { nM = M / BM; nN = N / BM; nwg = nM * nN; G = G_; c = c_; }
    __host__ __device__ bool next(int i, Unit& u) const {
        const long L = (long)i * G + c; if (L >= nwg) return false;
        int wgid = (int)L; { const int q = nwg / NXCD, r = nwg % NXCD, xcd = wgid % NXCD, off = wgid / NXCD; wgid = (xcd < r ? xcd * (q + 1) : r * (q + 1) + (xcd - r) * q) + off; }
        const int nig = WGM * nN, gid = wgid / nig, fm = gid * WGM, gsz = (nM - fm) < WGM ? (nM - fm) : WGM;
        u.pm = fm + ((wgid % nig) % gsz); u.pn = (wgid % nig) / gsz; return true;
    }
    __device__ __forceinline__ void a_ready(const Unit&) const {}
    __device__ __forceinline__ void done(const Unit&) const {}
};

__device__ __forceinline__ unsigned cvt_pk_bf16(float lo, float hi) { unsigned r; asm volatile("v_cvt_pk_bf16_f32 %0, %1, %2" : "=v"(r) : "v"(lo), "v"(hi)); return r; }
typedef float f32x2 __attribute__((ext_vector_type(2)));
__device__ __forceinline__ f32x2 gelu_pk(f32x2 v) {
    const f32x2 av = __builtin_elementwise_abs(v), d = av * 0.2316418882f + 1.0f;
    f32x2 t; t.x = __builtin_amdgcn_rcpf(d.x); t.y = __builtin_amdgcn_rcpf(d.y);
    f32x2 q = t * 0.5307027145f + (-0.7265760135f); q = q * t + 0.7107068705f; q = q * t + (-0.142248368f); q = q * t + 0.127414796f; q = q * t;
    const f32x2 s = (v * v) * (-0.72134752044f);
    f32x2 e; e.x = __builtin_amdgcn_exp2f(s.x); e.y = __builtin_amdgcn_exp2f(s.y);
    const f32x2 m = v * (q * e), r = v - m;
    f32x2 o; o.x = v.x < 0.f ? m.x : r.x; o.y = v.y < 0.f ? m.y : r.y; return o;
}

template <int ACT  > struct EpiBf16 {
    static constexpr bool PERM = true, AFTER_DRAIN = false, HOLD_LAST = false; static_assert(ACT == 0 || ACT == 1, "EpiBf16: ACT is 0 (none) or 1 (gelu_pk)");
    bf16_t* O; int ldc; const float* bias; int split_cols; size_t split_stride; float scale0;
    __device__ __forceinline__ void operator()(const f32x4 (&acc)[2][2][4][2], const Unit& u, int wr, int wc, int fr, int fq) const {
        const int row0 = u.pm * BM + wr * 64 + fr; int colt = u.pn * BM; bf16_t* base = O;
        float sc = 1.f; if (split_cols) { const int t = colt / split_cols; base += (size_t)t * split_stride; colt -= t * split_cols; if (t == 0) sc = scale0; }
        const int col0 = colt + wc * 32 + 8 * fq, bcol0 = u.pn * BM + wc * 32 + 8 * fq;
        f32x4 bv[2][2];
#pragma unroll
        for (int bj = 0; bj < 2; ++bj)
#pragma unroll
            for (int n = 0; n < 2; ++n) bv[bj][n] = bias ? *(const f32x4*)(bias + bcol0 + bj * HALF + 4 * n) : (f32x4){0.f, 0.f, 0.f, 0.f};
#pragma unroll
        for (int ai = 0; ai < 2; ++ai)
#pragma unroll
            for (int m = 0; m < 4; ++m) { bf16_t* rowp = base + (size_t)(row0 + ai * HALF + m * 16) * ldc + col0;
#pragma unroll
                for (int bj = 0; bj < 2; ++bj) { f32x4 v0 = acc[ai][bj][m][0] + bv[bj][0], v1 = acc[ai][bj][m][1] + bv[bj][1];
                    if (ACT == 1) { f32x2 a = gelu_pk((f32x2){v0[0], v0[1]}), b = gelu_pk((f32x2){v0[2], v0[3]}), c = gelu_pk((f32x2){v1[0], v1[1]}), d = gelu_pk((f32x2){v1[2], v1[3]});
                        v0 = (f32x4){a.x, a.y, b.x, b.y}; v1 = (f32x4){c.x, c.y, d.x, d.y}; }
                    v0 = v0 * sc; v1 = v1 * sc; u32x4 w; w.x = cvt_pk_bf16(v0[0], v0[1]); w.y = cvt_pk_bf16(v0[2], v0[3]); w.z = cvt_pk_bf16(v1[0], v1[1]); w.w = cvt_pk_bf16(v1[2], v1[3]);
                    *(u32x4*)(rowp + bj * HALF) = w; } }
    }
};
template <class Epi, class Sched, bool ALIGN_EPI = false, bool SP2 = false>
__device__ __forceinline__ void gemm_phase(PG8_LAS unsigned char* lds, const Gemm g, const Sched& S, const Epi& E) {
    int tid_ = threadIdx.x; asm volatile("" : "+v"(tid_)); const int tid = tid_, wid = __builtin_amdgcn_readfirstlane(tid >> 6), lane = tid & 63, wr = wid >> 2, wc = wid & 3, fr = lane & 15, fq = lane >> 4;
    const int K = g.K, nt = K / BK;
    unsigned voffA[2], voffB[2];
#pragma unroll
    for (int i = 0; i < 2; ++i) { int R, C; stage_rc(tid * 16 + i * 8192, R, C); const int Rb = Epi::PERM ? ((R & ~31) + perm32(R & 31)) : R;
        voffA[i] = (unsigned)(R * K + C) * 2u; voffB[i] = (unsigned)(Rb * K + C) * 2u; }
    const size_t kstep = (size_t)(BK * 2);
    const size_t hstep = (size_t)HALF * K * 2;
    const size_t tstep = 2 * hstep;
    const unsigned ldsw = (unsigned)wid * 1024u;
    const int aoff = lds_byte(wr * 64 + fr, fq * 8), boff = lds_byte(wc * 32 + fr, fq * 8);
#define PG8_SA(b, h) (((b) * 2 + (h)) * HTB)
#define PG8_SB(b, h) ((4 + (b) * 2 + (h)) * HTB)
#define PG8_STAGE(bufoff, gbase, voff) do { _Pragma("unroll") for (int _i = 0; _i < 2; ++_i) \
        __builtin_amdgcn_global_load_lds((const unsigned*)((const char*)(gbase) + (voff)[_i]), (PG8_LAS unsigned*)(lds + (bufoff) + ldsw + _i * 8192), 16, 0, 0); } while (0)
#define PG8_LDA(dst, b, h) do { _Pragma("unroll") for (int m = 0; m < 4; ++m) _Pragma("unroll") for (int k = 0; k < 2; ++k) dst[m][k] = *(const PG8_LAS bf16x8*)(lds + PG8_SA(b, h) + aoff + m * 2048 + k * 1024); } while (0)
#define PG8_LDB(dst, b, h) do { _Pragma("unroll") for (int n = 0; n < 2; ++n) _Pragma("unroll") for (int k = 0; k < 2; ++k) dst[n][k] = *(const PG8_LAS bf16x8*)(lds + PG8_SB(b, h) + boff + n * 2048 + k * 1024); } while (0)
#define PG8_MMA(ai, bj, At, Bt) do { __builtin_amdgcn_s_setprio(1); _Pragma("unroll") for (int m = 0; m < 4; ++m) _Pragma("unroll") for (int n = 0; n < 2; ++n) _Pragma("unroll") for (int k = 0; k < 2; ++k) \
        acc[ai][bj][m][n] = __builtin_amdgcn_mfma_f32_16x16x32_bf16(Bt[n][k], At[m][k], acc[ai][bj][m][n], 0, 0, 0); __builtin_amdgcn_s_setprio(0); } while (0)
#define PG8_WAIT_V(n) asm volatile("s_waitcnt vmcnt(" #n ")" ::: "memory")
#define PG8_WAIT_L(n) asm volatile("s_waitcnt lgkmcnt(" #n ")" ::: "memory")
#define PG8_BAR __builtin_amdgcn_s_barrier()
#define PG8_SCHED __builtin_amdgcn_sched_barrier(0)
    Unit cur, nxt; int ui = 0;
    if (!S.next(0, cur)) return;
    f32x4 acc[2][2][4][2];
#pragma unroll
    for (int a = 0; a < 2; ++a)
#pragma unroll
        for (int b = 0; b < 2; ++b)
#pragma unroll
            for (int m = 0; m < 4; ++m)
#pragma unroll
                for (int n = 0; n < 2; ++n) acc[a][b][m][n] = (f32x4){0.f, 0.f, 0.f, 0.f};
    bf16x8 At[4][2], B0[2][2], B1[2][2];
    const char* cA = (const char*)g.A + (size_t)cur.pm * tstep; const char* cB = (const char*)g.Bt + (size_t)cur.pn * tstep;
    S.a_ready(cur);
    if constexpr (SP2) {
        PG8_STAGE(PG8_SB(0, 0), cB, voffB); PG8_STAGE(PG8_SB(0, 1), cB + hstep, voffB); PG8_STAGE(PG8_SA(0, 0), cA, voffA); PG8_STAGE(PG8_SA(0, 1), cA + hstep, voffA);
        if (wr == 1) PG8_BAR;
        PG8_WAIT_V(2); PG8_BAR;
        PG8_STAGE(PG8_SB(1, 0), cB + kstep, voffB); PG8_STAGE(PG8_SA(1, 0), cA + kstep, voffA); PG8_STAGE(PG8_SB(1, 1), cB + hstep + kstep, voffB);
        PG8_WAIT_V(6); PG8_BAR;
    } else {
        PG8_STAGE(PG8_SB(0, 0), cB, voffB); PG8_STAGE(PG8_SA(0, 0), cA, voffA); PG8_STAGE(PG8_SB(0, 1), cB + hstep, voffB); PG8_STAGE(PG8_SA(0, 1), cA + hstep, voffA);
        if (wr == 1) PG8_BAR;
        PG8_WAIT_V(4); PG8_BAR;
        PG8_STAGE(PG8_SB(1, 0), cB + kstep, voffB); PG8_STAGE(PG8_SA(1, 0), cA + kstep, voffA); PG8_STAGE(PG8_SB(1, 1), cB + hstep + kstep, voffB);
        PG8_WAIT_V(6); PG8_BAR;
    }
    for (;;) {
        const bool has_next = S.next(ui + 1, nxt);
        const char* nA = has_next ? (const char*)g.A + (size_t)nxt.pm * tstep : cA; const char* nB = has_next ? (const char*)g.Bt + (size_t)nxt.pn * tstep : cB;
        for (int t = 0; t < nt; t += 2) {
            const bool last = (t == nt - 2);
            const char* a1 = cA + (size_t)(t + 1) * kstep;
            const char* a2 = last ? nA : cA + (size_t)(t + 2) * kstep; const char* b2 = last ? nB : cB + (size_t)(t + 2) * kstep;
            const char* a3 = a2 + kstep; const char* b3 = b2 + kstep;
            if (last && has_next) S.a_ready(nxt);
            if constexpr (SP2) {
            PG8_LDB(B0, 0, 0); PG8_LDB(B1, 0, 1); PG8_SCHED; PG8_LDA(At, 0, 0); PG8_STAGE(PG8_SA(1, 1), a1 + hstep, voffA);
            PG8_WAIT_V(8); PG8_WAIT_L(0); PG8_BAR; PG8_MMA(0, 0, At, B0); PG8_MMA(0, 1, At, B1); PG8_BAR; PG8_SCHED;
            PG8_LDA(At, 0, 1); PG8_STAGE(PG8_SB(0, 0), b2, voffB); PG8_STAGE(PG8_SB(0, 1), b2 + hstep, voffB); PG8_STAGE(PG8_SA(0, 0), a2, voffA);
            PG8_WAIT_V(8); PG8_WAIT_L(0); PG8_BAR; PG8_MMA(1, 0, At, B0); PG8_MMA(1, 1, At, B1); PG8_BAR; PG8_SCHED;
            PG8_LDB(B0, 1, 0); PG8_LDB(B1, 1, 1); PG8_SCHED; PG8_LDA(At, 1, 0); PG8_STAGE(PG8_SA(0, 1), a2 + hstep, voffA);
            PG8_WAIT_V(8); PG8_WAIT_L(0); PG8_BAR; PG8_MMA(0, 0, At, B0); PG8_MMA(0, 1, At, B1); PG8_BAR; PG8_SCHED;
            PG8_LDA(At, 1, 1); PG8_STAGE(PG8_SB(1, 0), b3, voffB); PG8_STAGE(PG8_SB(1, 1), b3 + hstep, voffB); PG8_STAGE(PG8_SA(1, 0), a3, voffA);
            PG8_WAIT_V(8); PG8_WAIT_L(0); PG8_BAR; PG8_MMA(1, 0, At, B0); PG8_MMA(1, 1, At, B1); PG8_BAR; PG8_SCHED;
            } else {
            PG8_LDB(B0, 0, 0); PG8_SCHED; PG8_LDA(At, 0, 0); PG8_STAGE(PG8_SA(1, 1), a1 + hstep, voffA);
            PG8_WAIT_L(8); PG8_BAR; PG8_WAIT_L(0); PG8_MMA(0, 0, At, B0); PG8_BAR; PG8_SCHED;
            PG8_LDB(B1, 0, 1); PG8_STAGE(PG8_SB(0, 0), b2, voffB);
            PG8_BAR; PG8_WAIT_L(0); PG8_MMA(0, 1, At, B1); PG8_BAR;
            PG8_LDA(At, 0, 1); PG8_STAGE(PG8_SA(0, 0), a2, voffA);
            PG8_BAR; PG8_WAIT_L(0); PG8_MMA(1, 0, At, B0); PG8_BAR; PG8_SCHED;
            PG8_STAGE(PG8_SB(0, 1), b2 + hstep, voffB);
            PG8_WAIT_V(6); PG8_BAR; PG8_MMA(1, 1, At, B1); PG8_BAR;
            PG8_LDB(B0, 1, 0); PG8_SCHED; PG8_LDA(At, 1, 0); PG8_STAGE(PG8_SA(0, 1), a2 + hstep, voffA);
            PG8_WAIT_L(8); PG8_BAR; PG8_WAIT_L(0); PG8_MMA(0, 0, At, B0); PG8_BAR; PG8_SCHED;
            PG8_LDB(B1, 1, 1); PG8_STAGE(PG8_SB(1, 0), b3, voffB);
            PG8_BAR; PG8_WAIT_L(0); PG8_MMA(0, 1, At, B1); PG8_BAR;
            PG8_LDA(At, 1, 1); PG8_STAGE(PG8_SA(1, 0), a3, voffA);
            PG8_BAR; PG8_WAIT_L(0); PG8_MMA(1, 0, At, B0); PG8_BAR; PG8_SCHED;
            PG8_STAGE(PG8_SB(1, 1), b3 + hstep, voffB);
            PG8_WAIT_V(6); PG8_BAR; PG8_MMA(1, 1, At, B1); PG8_BAR;
            }
        }
        if constexpr (ALIGN_EPI) { if (wr == 0) PG8_BAR; }
        if constexpr (!Epi::AFTER_DRAIN) { if (!Epi::HOLD_LAST || has_next) { E(acc, cur, wr, wc, fr, fq); S.done(cur); } }
        if (!has_next) break;
#pragma unroll
        for (int a = 0; a < 2; ++a)
#pragma unroll
            for (int b = 0; b < 2; ++b)
#pragma unroll
                for (int m = 0; m < 4; ++m)
#pragma unroll
                    for (int n = 0; n < 2; ++n) acc[a][b][m][n] = (f32x4){0.f, 0.f, 0.f, 0.f};
        cur = nxt; cA = nA; cB = nB; ++ui;
        if constexpr (ALIGN_EPI) { if (wr == 1) PG8_BAR; }
    }
    PG8_WAIT_V(0);
    if constexpr (!ALIGN_EPI) { if (wr == 0) PG8_BAR; }
    PG8_BAR;
    if constexpr (Epi::AFTER_DRAIN || Epi::HOLD_LAST) { E.fused(acc, cur, wr, wc, fr, fq, lds, wid, lane); S.done(cur); }
#undef PG8_SA
#undef PG8_SB
#undef PG8_STAGE
#undef PG8_LDA
#undef PG8_LDB
#undef PG8_MMA
#undef PG8_WAIT_V
#undef PG8_WAIT_L
#undef PG8_BAR
#undef PG8_SCHED
}
}

#ifndef PHMASK
#define PHMASK 127
#endif
#ifndef REPMASK
#define REPMASK 0
#endif
#ifndef P2MASK
#define P2MASK 7
#endif
#ifndef N_LAUNCHES
#define N_LAUNCHES 1
#endif
using pg8::bf16_t; using pg8::bf16x8; using pg8::f32x4; using pg8::u32x4;
#define LAS __attribute__((address_space(3)))
typedef unsigned u32x2 __attribute__((ext_vector_type(2)));
typedef float f32x2 __attribute__((ext_vector_type(2)));

constexpr int SEQ = 8192, DMODEL = 4096, INW = 9216, NMEM = 256;
constexpr int C_QA = 0, C_KA = 2048, C_VA = 2560, C_XL = 3072, C_QM = 4096, C_ZA = 5120, C_ZL = 7168, C_ZM = 8192;
constexpr float EPSN = 1e-6f;
constexpr float LOG2E = 1.4426950408889634f;
constexpr float SC_ATT = 0.08838834764831845f * LOG2E;
constexpr float SC_MEM = 0.0625f * LOG2E;
constexpr int NPH = 7;
constexpr int LDS_BYTES = 147456;

constexpr size_t MiB = 1u << 20;
constexpr size_t WS_CTL = 0, WS_LRUW = 1 * MiB, WS_ROPE = 2 * MiB, WS_MK = 3 * MiB, WS_MVT = 3 * MiB + 512 * 1024, WS_SS = 4 * MiB,
                 WS_AGG1 = 6 * MiB, WS_AGG2 = 10 * MiB, WS_VT = 12 * MiB, WS_WOUT = 20 * MiB, WS_WT = 52 * MiB, WS_U = 140 * MiB,
                 WS_PROJ = 206 * MiB, WS_HS = 350 * MiB, WS_PP = 382 * MiB, WS_YATT = 414 * MiB, WS_YMEM = 446 * MiB, WS_T0 = 462 * MiB, WS_END = 494 * MiB;
constexpr size_t WS_Y = WS_U;

struct Args { const float* in[19]; float* out; unsigned char* ws; int ph_lo, ph_hi; };

__device__ __forceinline__ unsigned pk2(float lo, float hi) { return pg8::cvt_pk_bf16(lo, hi); }
__device__ __forceinline__ float bflo(unsigned u) { return __builtin_bit_cast(float, u << 16); }
__device__ __forceinline__ float bfhi(unsigned u) { return __builtin_bit_cast(float, u & 0xffff0000u); }
template <int CTRL> __device__ __forceinline__ float dpp_mov(float v) { return __uint_as_float(__builtin_amdgcn_update_dpp(0u, __float_as_uint(v), CTRL, 0xF, 0xF, true)); }
__device__ __forceinline__ float xor16_add(float v) { auto r = __builtin_amdgcn_permlane16_swap(__float_as_uint(v), __float_as_uint(v), false, false); return __uint_as_float(r[0]) + __uint_as_float(r[1]); }
__device__ __forceinline__ float xor32_add(float v) { auto r = __builtin_amdgcn_permlane32_swap(__float_as_uint(v), __float_as_uint(v), false, false); return __uint_as_float(r[0]) + __uint_as_float(r[1]); }
__device__ __forceinline__ float xor16_max(float v) { auto r = __builtin_amdgcn_permlane16_swap(__float_as_uint(v), __float_as_uint(v), false, false); return fmaxf(__uint_as_float(r[0]), __uint_as_float(r[1])); }
__device__ __forceinline__ float xor32_max(float v) { auto r = __builtin_amdgcn_permlane32_swap(__float_as_uint(v), __float_as_uint(v), false, false); return fmaxf(__uint_as_float(r[0]), __uint_as_float(r[1])); }
__device__ __forceinline__ float xor32_get(float v, bool upper) { auto r = __builtin_amdgcn_permlane32_swap(__float_as_uint(v), __float_as_uint(v), false, false); return __uint_as_float(upper ? r[0] : r[1]); }
__device__ __forceinline__ float wave_sum(float v) {
    v += dpp_mov<0xB1>(v);
    v += dpp_mov<0x4E>(v);
    v += dpp_mov<0x141>(v);
    v += dpp_mov<0x140>(v);
    v = xor16_add(v); v = xor32_add(v);
    return v;
}
__device__ __forceinline__ float fexp2(float x) { return __builtin_amdgcn_exp2f(x); }
__device__ __forceinline__ float sigmoidf_(float x) { return 1.f / (1.f + __expf(-x)); }
__device__ __forceinline__ float fsigmoid(float x) { return __builtin_amdgcn_rcpf(1.f + __builtin_amdgcn_exp2f(-x * 1.4426950408889634f)); }
__device__ __forceinline__ f32x4 mfma16(bf16x8 a, bf16x8 b, f32x4 c) { return __builtin_amdgcn_mfma_f32_16x16x32_bf16(a, b, c, 0, 0, 0); }

__device__ __forceinline__ void p0_item_load(const float* W, int N, int item, int lane, float (&r)[32]) {
    const int nblk = N / 32, kb = item / nblk, nb = item % nblk, k0 = 64 * kb, n0 = 32 * nb;
#pragma unroll
    for (int i = 0; i < 32; ++i) { const int kk = 2 * i + (lane >> 5); r[i] = __builtin_nontemporal_load(W + (size_t)(k0 + kk) * N + n0 + (lane & 31)); }
}
__device__ __forceinline__ void p0_item_lds_write(LAS float* scr, int lane, const float (&r)[32]) {
#pragma unroll
    for (int i = 0; i < 32; ++i) { const int kk = 2 * i + (lane >> 5); scr[kk * 33 + (lane & 31)] = r[i]; }
}
__device__ __forceinline__ void p0_item_store(int K, int N, bf16_t* WT, int row_off, LAS float* scr, int item, int lane) {
    const int nblk = N / 32, kb = item / nblk, nb = item % nblk, k0 = 64 * kb, n0 = 32 * nb;
    asm volatile("s_waitcnt lgkmcnt(0)" ::: "memory");
    const int c = lane & 7;
#pragma unroll
    for (int j = 0; j < 4; ++j) { const int n = (lane >> 3) + 8 * j; const LAS float* s = scr + (8 * c) * 33 + n;
        u32x4 o; o.x = pk2(s[0 * 33], s[1 * 33]); o.y = pk2(s[2 * 33], s[3 * 33]); o.z = pk2(s[4 * 33], s[5 * 33]); o.w = pk2(s[6 * 33], s[7 * 33]);
        *(u32x4*)(WT + (size_t)(row_off + n0 + n) * K + k0 + 8 * c) = o; }
    asm volatile("s_waitcnt lgkmcnt(0)" ::: "memory");
}
__device__ __forceinline__ void p0_transpose_item(const float* W, int K, int N, bf16_t* WT, int row_off, LAS float* scr, int item, int lane) {
    float r[32]; p0_item_load(W, N, item, lane, r); p0_item_lds_write(scr, lane, r); p0_item_store(K, N, WT, row_off, scr, item, lane);
}
template <bool SEL> __device__ __forceinline__ int win_item(int j) {
    if (SEL) { const int kb = j >> 5, e = j & 31; return kb * (INW / 32) + (e < 16 ? 128 + e : 272 + (e - 16)); }
    else { const int kb = j >> 8, c = j & 255; return kb * (INW / 32) + (c < 128 ? c : c + 16); }
}
template <bool SEL> __device__ __forceinline__ void p0_transpose_win(const float* W, bf16_t* WT, LAS float* scr, int first, int step, int lane) {
    constexpr int NJ = SEL ? 64 * 32 : 64 * 256;
    if (first >= NJ) return;
    float r[32]; p0_item_load(W, INW, win_item<SEL>(first), lane, r);
#pragma unroll 1
    for (int j = first; j < NJ; j += step) {
        p0_item_lds_write(scr, lane, r);
        if (j + step < NJ) p0_item_load(W, INW, win_item<SEL>(j + step), lane, r);
        p0_item_store(4096, INW, WT, 0, scr, win_item<SEL>(j), lane);
    }
}
__device__ __forceinline__ void p0_transpose_matrix(const float* W, int K, int N, bf16_t* WT, int row_off, LAS float* scr, int first, int step, int lane) {
    const int nitems = (K / 64) * (N / 32);
    if (first >= nitems) return;
    float r[32]; p0_item_load(W, N, first, lane, r);
#pragma unroll 1
    for (int it = first; it < nitems; it += step) {
        p0_item_lds_write(scr, lane, r);
        if (it + step < nitems) p0_item_load(W, N, it + step, lane, r);
        p0_item_store(K, N, WT, row_off, scr, it, lane);
    }
}
__device__ __forceinline__ void rms_row_to_bf16(const float* xrow, const f32x4 (&gv)[16], bf16_t* orow, int lane) {
    const f32x4* xr = (const f32x4*)xrow + lane;
    f32x4 v[16]; float s = 0.f;
#pragma unroll
    for (int k = 0; k < 16; ++k) { v[k] = __builtin_nontemporal_load(xr + 64 * k); s += (v[k].x * v[k].x + v[k].y * v[k].y) + (v[k].z * v[k].z + v[k].w * v[k].w); }
    const float rs = 1.f / sqrtf(wave_sum(s) * (1.f / 4096.f) + EPSN);
    u32x2* o8 = (u32x2*)orow + lane;
#pragma unroll
    for (int k = 0; k < 16; ++k) { const f32x4 g4 = gv[k]; u32x2 o; o.x = pk2(v[k].x * rs * g4.x, v[k].y * rs * g4.y); o.y = pk2(v[k].z * rs * g4.z, v[k].w * rs * g4.w); o8[64 * k] = o; }
}

__device__ __forceinline__ void phase0(const Args& a, LAS unsigned char* lds) {
    int tid = threadIdx.x; asm volatile("" : "+v"(tid)); const int lane = tid & 63, w = tid >> 6, G = gridDim.x;
    const int gw = blockIdx.x * 8 + w, NGW = G * 8;
    unsigned char* ws = a.ws;
    LAS float* scr = (LAS float*)(lds + w * 16384);
    bf16_t* WT = (bf16_t*)(ws + WS_WT); bf16_t* WOUT = (bf16_t*)(ws + WS_WOUT); bf16_t* LRUW = (bf16_t*)(ws + WS_LRUW);
    constexpr int I_IN = 64 * (INW / 32), I_MKV = 64 * (2048 / 32), I_OUT = 64 * (4096 / 32), I_LRU = 32 * 8;
    p0_transpose_win<true>(a.in[3], WT, scr, gw, NGW, lane);
    p0_transpose_matrix(a.in[13], 4096, 2048, WT, INW, scr, gw, NGW, lane);
    for (int r = gw; r < I_LRU; r += NGW) {
        const int mat = r >> 3, sub = r & 7, gate = mat >> 4, dn = mat & 15;
        const float* src = (gate ? a.in[9] : a.in[7]) + (size_t)dn * 16384;
        p0_transpose_item(src, 128, 128, LRUW + (size_t)mat * 16384, 0, scr, sub, lane);
    }
    bf16_t* U = (bf16_t*)(ws + WS_U);
    { f32x4 gv[16];
#pragma unroll
      for (int k = 0; k < 16; ++k) gv[k] = ((const f32x4*)a.in[2])[lane + 64 * k];
      if (G == 256) { const int b = (int)blockIdx.x, r0 = (b * (256 + b)) >> 4, r1 = ((b + 1) * (257 + b)) >> 4;
          for (int m = r0 + w; m < r1; m += 8) rms_row_to_bf16(a.in[0] + (size_t)m * 4096, gv, U + (size_t)m * 4096, lane); }
      else { for (int m = gw; m < SEQ; m += NGW) rms_row_to_bf16(a.in[0] + (size_t)m * 4096, gv, U + (size_t)m * 4096, lane); }
#pragma unroll
      for (int k = 0; k < 16; ++k) gv[k] = ((const f32x4*)a.in[12])[lane + 64 * k];
      for (int m = gw; m < NMEM; m += NGW) rms_row_to_bf16(a.in[1] + (size_t)m * 4096, gv, U + (size_t)(SEQ + m) * 4096, lane); }
    f32x2* rope = (f32x2*)(ws + WS_ROPE);
    for (int e = blockIdx.x * 512 + tid; e < SEQ * 16; e += G * 512) {
        const int pos = e >> 4, i = e & 15;
        const float inv = powf(500000.0f, -(float)i * (1.0f / 16.0f));
        const float ang = (float)pos * inv;
        rope[e] = (f32x2){cosf(ang), sinf(ang)};
    }
}

struct Sched1 {
    pg8::StaticOrder so; int G, c, ioff, imax;
    __device__ void init(int G_, int c_) { so.init(SEQ, INW, G_, c_); G = G_; c = c_; ioff = 0; imax = 1 << 20; }
    __device__ bool next(int i0, pg8::Unit& u) const {
        if (i0 >= imax) return false;
        const int i = i0 + ioff;
        const long L = (long)i * G + c;
        if (L < 1152) return so.next(i, u);
        if (L < 1160) { u.pm = 32; u.pn = 36 + (int)(L - 1152); return true; }
        return false;
    }
    __device__ __forceinline__ void a_ready(const pg8::Unit&) const {}
    __device__ __forceinline__ void done(const pg8::Unit&) const {}
};
struct Epi1 {
    static constexpr bool PERM = true, AFTER_DRAIN = false, HOLD_LAST = false;
    bf16_t* proj; bf16_t* vt; bf16_t* mk; bf16_t* mvt; const float* rope;
    __device__ __forceinline__ void operator()(const f32x4 (&acc)[2][2][4][2], const pg8::Unit& u, int wr, int wc, int fr, int fq) const {
        const int rloc = wr * 64 + fr, cloc = wc * 32 + 8 * fq;
        if (u.pm == 32) {
            const int t = u.pn - 36;
            if (t < 4) {
#pragma unroll
                for (int ai = 0; ai < 2; ++ai)
#pragma unroll
                    for (int m = 0; m < 4; ++m) { const int row = rloc + ai * 128 + m * 16;
#pragma unroll
                        for (int bj = 0; bj < 2; ++bj) { const f32x4 v0 = acc[ai][bj][m][0], v1 = acc[ai][bj][m][1];
                            u32x4 wv; wv.x = pk2(v0[0], v0[1]); wv.y = pk2(v0[2], v0[3]); wv.z = pk2(v1[0], v1[1]); wv.w = pk2(v1[2], v1[3]);
                            *(u32x4*)(mk + (size_t)row * 1024 + t * 256 + bj * 128 + cloc) = wv; } asm volatile("" ::: "memory"); }
            } else {
#pragma unroll
                for (int ai = 0; ai < 2; ++ai)
#pragma unroll
                    for (int m = 0; m < 4; ++m) { const int row = rloc + ai * 128 + m * 16;
#pragma unroll
                        for (int bj = 0; bj < 2; ++bj)
#pragma unroll
                            for (int n = 0; n < 2; ++n)
#pragma unroll
                                for (int i = 0; i < 4; ++i) { const int col = (t - 4) * 256 + bj * 128 + cloc + 4 * n + i;
                                    mvt[(size_t)col * 256 + row] = (bf16_t)(pk2(acc[ai][bj][m][n][i], 0.f) & 0xffffu); } asm volatile("" ::: "memory"); }
            }
            return;
        }
        const int pn = u.pn, row0 = u.pm * 256 + rloc;
        if (pn == 10 || pn == 11) {
#pragma unroll
            for (int ai = 0; ai < 2; ++ai)
#pragma unroll
                for (int m = 0; m < 4; ++m) { const int row = row0 + ai * 128 + m * 16;
#pragma unroll
                    for (int bj = 0; bj < 2; ++bj)
#pragma unroll
                        for (int n = 0; n < 2; ++n)
#pragma unroll
                            for (int i = 0; i < 4; ++i) { const int col = (pn - 10) * 256 + bj * 128 + cloc + 4 * n + i;
                                vt[(size_t)col * SEQ + row] = (bf16_t)(pk2(acc[ai][bj][m][n][i], 0.f) & 0xffffu); } asm volatile("" ::: "memory"); }
            return;
        }
        float sc = 1.f; if (pn < 8) sc = SC_ATT; else if (pn >= 16 && pn < 20) sc = SC_MEM;
        const bool do_rope = (pn < 10) && (wc == 0);
        const float sgn = (fq < 2) ? -1.f : 1.f;
        f32x4 csA[2][2], cst[2][2];
        if (do_rope) {
#pragma unroll
            for (int n = 0; n < 2; ++n) { const int io = (8 * (fq & 1) + 4 * n) * 2;
                const float* ra = rope + (size_t)row0 * 32 + io; const float* rt = rope + 16 * 32 + io;
                csA[n][0] = *(const f32x4*)ra; csA[n][1] = *(const f32x4*)(ra + 4); cst[n][0] = *(const f32x4*)rt; cst[n][1] = *(const f32x4*)(rt + 4); }
        }
#pragma unroll
        for (int ai = 0; ai < 2; ++ai)
#pragma unroll
            for (int m = 0; m < 4; ++m) { const int row = row0 + ai * 128 + m * 16;
                f32x4 cs[2][2];
                if (do_rope) {
                    const int nrot = (ai == 0 && m == 3) ? 5 : 1;
#pragma unroll
                    for (int n = 0; n < 2; ++n)
#pragma unroll
                        for (int hh = 0; hh < 2; ++hh) { f32x4 cur = csA[n][hh]; cs[n][hh] = cur; const f32x4 t = cst[n][hh];
#pragma unroll
                            for (int rr = 0; rr < 5; ++rr) { if (rr < nrot) { f32x4 nx; nx[0] = cur[0] * t[0] - cur[1] * t[1]; nx[1] = cur[1] * t[0] + cur[0] * t[1]; nx[2] = cur[2] * t[2] - cur[3] * t[3]; nx[3] = cur[3] * t[2] + cur[2] * t[3]; cur = nx; } }
                            csA[n][hh] = cur; }
                }
#pragma unroll
                for (int bj = 0; bj < 2; ++bj) { f32x4 v[2]; v[0] = acc[ai][bj][m][0]; v[1] = acc[ai][bj][m][1];
                    if (do_rope) {
#pragma unroll
                        for (int n = 0; n < 2; ++n) { f32x4 p; p[0] = xor32_get(v[n][0], fq >= 2); p[1] = xor32_get(v[n][1], fq >= 2); p[2] = xor32_get(v[n][2], fq >= 2); p[3] = xor32_get(v[n][3], fq >= 2);
                            f32x4 r; r[0] = v[n][0] * cs[n][0][0] + sgn * p[0] * cs[n][0][1]; r[1] = v[n][1] * cs[n][0][2] + sgn * p[1] * cs[n][0][3];
                            r[2] = v[n][2] * cs[n][1][0] + sgn * p[2] * cs[n][1][1]; r[3] = v[n][3] * cs[n][1][2] + sgn * p[3] * cs[n][1][3]; v[n] = r; }
                    }
                    u32x4 wv; wv.x = pk2(v[0][0] * sc, v[0][1] * sc); wv.y = pk2(v[0][2] * sc, v[0][3] * sc); wv.z = pk2(v[1][0] * sc, v[1][1] * sc); wv.w = pk2(v[1][2] * sc, v[1][3] * sc);
                    __builtin_nontemporal_store(wv, (u32x4*)(proj + (size_t)row * INW + pn * 256 + bj * 128 + cloc)); } asm volatile("" ::: "memory"); }
    }
};

template <int DH, bool PF, bool DB>
__device__ __forceinline__ void attn_unit(LAS unsigned char* lds, const bf16_t* Qp, int ldq, bf16_t* Op, int ldo, const bf16_t* Kg, int ldk, const bf16_t* Vtg, int ldv,
                                          int cb_lo, int cb_hi, int cb_self, float m_init, float l_init) {
    constexpr int PR = DH / 8, KROW = DH * 2, KT = 128 * KROW, VROW = 288, NKI = (128 * PR) / 512, NVI = (DH * 16) / 512, NS = DH / 32, NDT = DH / 16;
    int tid = threadIdx.x; asm volatile("" : "+v"(tid)); const int lane = tid & 63, w = tid >> 6, q = lane & 15, g = lane >> 4;
    const int krow = 8 * (q >> 2) + (q & 3);
    bf16x8 qf[NS];
    { const unsigned qoff = (unsigned)(((16 * w + q) * ldq + 8 * g) * 2);
#pragma unroll
      for (int s = 0; s < NS; ++s) qf[s] = __builtin_nontemporal_load((const bf16x8*)((const char*)Qp + qoff + 64 * s)); }
    f32x4 o[NDT];
#pragma unroll
    for (int dt = 0; dt < NDT; ++dt) o[dt] = (f32x4){0.f, 0.f, 0.f, 0.f};
    float m_run = m_init, l_run = l_init;
    u32x4 kreg[NKI], vreg[NVI];
#define ATT_LOAD(cb) do { const int k0_ = (cb) * 128; \
        const char* kb_ = (const char*)Kg + (size_t)k0_ * ldk * 2; const char* vb_ = (const char*)Vtg + (size_t)k0_ * 2; \
        _Pragma("unroll") for (int it = 0; it < NKI; ++it) { const int e = tid + 512 * it; const int key = e / PR, pc = e % PR; \
            kreg[it] = *(const u32x4*)(kb_ + (unsigned)((key * ldk + pc * 8) * 2)); } \
        _Pragma("unroll") for (int it = 0; it < NVI; ++it) { const int e = tid + 512 * it; const int d = e >> 4, pc = e & 15; \
            vreg[it] = *(const u32x4*)(vb_ + (unsigned)((d * ldv + pc * 8) * 2)); } } while (0)
#define ATT_STORE() do { \
        _Pragma("unroll") for (int it = 0; it < NKI; ++it) { const int e = tid + 512 * it; const int key = e / PR, pc = e % PR; \
            *(LAS u32x4*)(lds + key * KROW + ((pc ^ ((((key >> 3) & 3) << 2) | (key & 3))) * 16)) = kreg[it]; } \
        _Pragma("unroll") for (int it = 0; it < NVI; ++it) { const int e = tid + 512 * it; const int d = e >> 4, pc = e & 15; \
            *(LAS u32x4*)(lds + KT + d * VROW + pc * 16) = vreg[it]; } } while (0)
    if (PF) ATT_LOAD(cb_lo);
    for (int cb = cb_lo; cb < cb_hi; ++cb) {
        if (!PF) ATT_LOAD(cb);
        __syncthreads();
        ATT_STORE();
        __syncthreads();
        if (PF) { if (cb + 1 < cb_hi) ATT_LOAD(cb + 1); }
        f32x4 s[8];
#pragma unroll
        for (int kt = 0; kt < 8; ++kt) s[kt] = (f32x4){0.f, 0.f, 0.f, 0.f};
        {
            bf16x8 ka[DB ? 2 : 1][8];
            if (DB) {
#pragma unroll
                for (int kt = 0; kt < 8; ++kt) ka[0][kt] = *(const LAS bf16x8*)(lds + (32 * (kt >> 1) + 4 * (kt & 1) + krow) * KROW + (((0 + g) ^ q) * 16));
            }
#pragma unroll
            for (int ss = 0; ss < NS; ++ss) {
                if (DB) { if (ss + 1 < NS) {
#pragma unroll
                    for (int kt = 0; kt < 8; ++kt) ka[(ss + 1) & 1][kt] = *(const LAS bf16x8*)(lds + (32 * (kt >> 1) + 4 * (kt & 1) + krow) * KROW + (((4 * (ss + 1) + g) ^ q) * 16)); }
                } else {
#pragma unroll
                    for (int kt = 0; kt < 8; ++kt) ka[0][kt] = *(const LAS bf16x8*)(lds + (32 * (kt >> 1) + 4 * (kt & 1) + krow) * KROW + (((4 * ss + g) ^ q) * 16));
                }
                __builtin_amdgcn_sched_barrier(0);
#pragma unroll
                for (int kt = 0; kt < 8; ++kt) s[kt] = mfma16(ka[DB ? (ss & 1) : 0][kt], qf[ss], s[kt]);
                __builtin_amdgcn_sched_barrier(0);
            }
        }
        if (cb != cb_self && cb_self >= 0) {
            const float sg = (cb < cb_self) ? 1.f : -1.f;
            const float dq = (float)(16 * w + q - 8 * g);
#pragma unroll
            for (int kt = 0; kt < 8; ++kt)
#pragma unroll
                for (int j = 0; j < 4; ++j) { const float v = sg * ((float)(32 * (kt >> 1) + 4 * (kt & 1) + j) - dq); s[kt][j] += fminf(v, 0.f) * 1e30f; }
        }
        float mx = s[0][0];
#pragma unroll
        for (int kt = 0; kt < 8; ++kt)
#pragma unroll
            for (int j = 0; j < 4; ++j) mx = fmaxf(mx, s[kt][j]);
        mx = xor16_max(mx); mx = xor32_max(mx);
        const float m_new = fmaxf(m_run, mx), alpha = fexp2(m_run - m_new); m_run = m_new;
        float rs = 0.f;
#pragma unroll
        for (int kt = 0; kt < 8; ++kt)
#pragma unroll
            for (int j = 0; j < 4; ++j) { const float p = fexp2(s[kt][j] - m_new); s[kt][j] = p; rs += p; }
        rs = xor16_add(rs); rs = xor32_add(rs);
        l_run = l_run * alpha + rs;
        bf16x8 pb[4];
#pragma unroll
        for (int u = 0; u < 4; ++u) { u32x4 t; t.x = pk2(s[2 * u][0], s[2 * u][1]); t.y = pk2(s[2 * u][2], s[2 * u][3]); t.z = pk2(s[2 * u + 1][0], s[2 * u + 1][1]); t.w = pk2(s[2 * u + 1][2], s[2 * u + 1][3]);
            pb[u] = __builtin_bit_cast(bf16x8, t); }
#pragma unroll
        for (int dt = 0; dt < NDT; ++dt) o[dt] = o[dt] * alpha;
        {
            constexpr int NG = (NDT / 8) * 4;
            u32x4 va[DB ? 2 : 1][8];
#define ATT_VLOAD(buf, gi) do { const int u_ = (gi) & 3, d0_ = 8 * ((gi) >> 2); \
            _Pragma("unroll") for (int i = 0; i < 8; ++i) { va[buf][i] = *(const LAS u32x4*)(lds + KT + (16 * (d0_ + i) + q) * VROW + (32 * u_ + 8 * g) * 2); } } while (0)
            if (DB) ATT_VLOAD(0, 0);
#pragma unroll
            for (int gi = 0; gi < NG; ++gi) {
                if (DB) { if (gi + 1 < NG) ATT_VLOAD((gi + 1) & 1, gi + 1); } else ATT_VLOAD(0, gi);
                __builtin_amdgcn_sched_barrier(0);
#pragma unroll
                for (int i = 0; i < 8; ++i) o[8 * (gi >> 2) + i] = mfma16(__builtin_bit_cast(bf16x8, va[DB ? (gi & 1) : 0][i]), pb[gi & 3], o[8 * (gi >> 2) + i]);
                __builtin_amdgcn_sched_barrier(0);
            }
#undef ATT_VLOAD
        }
    }
#undef ATT_LOAD
#undef ATT_STORE
    const float inv = 1.f / l_run;
    const unsigned ooff = (unsigned)(((16 * w + q) * ldo + 4 * g) * 2);
#pragma unroll
    for (int dt = 0; dt < NDT; ++dt) { u32x2 pkv; pkv.x = pk2(o[dt][0] * inv, o[dt][1] * inv); pkv.y = pk2(o[dt][2] * inv, o[dt][3] * inv); *(u32x2*)((char*)Op + ooff + 32 * dt) = pkv; }
}

__device__ __forceinline__ void windowed_stream(LAS unsigned char* lds0, const Args& a) {
    constexpr int DH = 128, PR = 16, KROW = 256, KT = 128 * KROW, VROW = 288, BUFB = KT + DH * VROW, NKI = 4, NVI = 4, NS = 4, NDT = 8;
    static_assert(2 * BUFB <= LDS_BYTES - 64, "two K/V tile buffers must fit under the barrier words");
    int tid = threadIdx.x; asm volatile("" : "+v"(tid)); const int lane = tid & 63, w = tid >> 6, q = lane & 15, g = lane >> 4;
    const int krow = 8 * (q >> 2) + (q & 3);
    unsigned char* ws = a.ws;
    const bf16_t* proj = (const bf16_t*)(ws + WS_PROJ); const bf16_t* vt = (const bf16_t*)(ws + WS_VT); bf16_t* yatt = (bf16_t*)(ws + WS_YATT);
    const int G = (int)gridDim.x;
    if ((int)blockIdx.x >= 1024) return;
    unsigned koff[NKI], voff[NVI], klds[NKI], vlds[NVI];
#pragma unroll
    for (int it = 0; it < NKI; ++it) { const int e = tid + 512 * it, key = e / PR, pc = e % PR; koff[it] = (unsigned)((key * INW + pc * 8) * 2); klds[it] = (unsigned)(key * KROW + ((pc ^ ((((key >> 3) & 3) << 2) | (key & 3))) * 16)); }
#pragma unroll
    for (int it = 0; it < NVI; ++it) { const int e = tid + 512 * it, d = e >> 4, pc = e & 15; voff[it] = (unsigned)((d * SEQ + pc * 8) * 2); vlds[it] = (unsigned)(KT + d * VROW + pc * 16); }
    u32x4 kreg[NKI], vreg[NVI];
#define WS_LOAD(v_, cb_) do { const int kvh_ = ((v_) & 15) >> 2; \
        const char* kb_ = (const char*)proj + ((size_t)((cb_) * 128) * INW + C_KA + kvh_ * 128) * 2; const char* vb_ = (const char*)vt + ((size_t)(kvh_ * 128) * SEQ + (cb_) * 128) * 2; \
        _Pragma("unroll") for (int it = 0; it < NKI; ++it) kreg[it] = *(const u32x4*)(kb_ + koff[it]); \
        _Pragma("unroll") for (int it = 0; it < NVI; ++it) vreg[it] = *(const u32x4*)(vb_ + voff[it]); } while (0)
#define WS_STORE(ldsb_) do { \
        _Pragma("unroll") for (int it = 0; it < NKI; ++it) *(LAS u32x4*)((ldsb_) + klds[it]) = kreg[it]; \
        _Pragma("unroll") for (int it = 0; it < NVI; ++it) *(LAS u32x4*)((ldsb_) + vlds[it]) = vreg[it]; } while (0)
#define WS_LO(v_) ((((v_) >> 4) > 0) ? ((v_) >> 4) - 1 : 0)
#define WS_HI(v_) ((((v_) >> 4) < 63) ? ((v_) >> 4) + 2 : 64)
    int Cv = (int)blockIdx.x, Ccb = WS_LO(Cv);
    int Lv = Cv, Lcb = Ccb; bool Lvalid = true;
#define WS_ADV_L() do { if (Lcb + 1 < WS_HI(Lv)) ++Lcb; else { Lv += G; if (Lv < 1024) Lcb = WS_LO(Lv); else Lvalid = false; } } while (0)
    __syncthreads();
    WS_LOAD(Lv, Lcb); WS_ADV_L();
    WS_STORE(lds0);
    bool have = false;
    if (Lvalid) { WS_LOAD(Lv, Lcb); WS_ADV_L(); have = true; }
    __syncthreads();
    int bsel = 0;
    bf16x8 qf[NS]; f32x4 o[NDT]; float m_run = 0.f, l_run = 1.f;
#pragma unroll 1
    for (;;) {
        const int qblk = Cv >> 4, hq = Cv & 15, lo = WS_LO(Cv), hi = WS_HI(Cv);
        LAS unsigned char* lds = lds0 + bsel * BUFB;
        if (Ccb == lo) {
            const unsigned qoff = (unsigned)(((16 * w + q) * INW + 8 * g) * 2);
            const char* qb = (const char*)proj + ((size_t)(qblk * 128) * INW + C_QA + hq * 128) * 2;
#pragma unroll
            for (int s = 0; s < NS; ++s) qf[s] = __builtin_nontemporal_load((const bf16x8*)(qb + qoff + 64 * s));
#pragma unroll
            for (int dt = 0; dt < NDT; ++dt) o[dt] = (f32x4){0.f, 0.f, 0.f, 0.f};
            m_run = a.in[4][hq] * LOG2E; l_run = 1.f;
        }
        if (have) { WS_STORE(lds0 + (bsel ^ 1) * BUFB); have = false; }
        if (Lvalid) { WS_LOAD(Lv, Lcb); WS_ADV_L(); have = true; }
        f32x4 s[8];
#pragma unroll
        for (int kt = 0; kt < 8; ++kt) s[kt] = (f32x4){0.f, 0.f, 0.f, 0.f};
        {
            bf16x8 ka[2][8];
#pragma unroll
            for (int kt = 0; kt < 8; ++kt) ka[0][kt] = *(const LAS bf16x8*)(lds + (32 * (kt >> 1) + 4 * (kt & 1) + krow) * KROW + (((0 + g) ^ q) * 16));
#pragma unroll
            for (int ss = 0; ss < NS; ++ss) {
                if (ss + 1 < NS) {
#pragma unroll
                    for (int kt = 0; kt < 8; ++kt) ka[(ss + 1) & 1][kt] = *(const LAS bf16x8*)(lds + (32 * (kt >> 1) + 4 * (kt & 1) + krow) * KROW + (((4 * (ss + 1) + g) ^ q) * 16)); }
                __builtin_amdgcn_sched_barrier(0);
#pragma unroll
                for (int kt = 0; kt < 8; ++kt) s[kt] = mfma16(ka[ss & 1][kt], qf[ss], s[kt]);
                __builtin_amdgcn_sched_barrier(0);
            }
        }
        if (Ccb != qblk) {
            const bool prev = Ccb < qblk; const int ud = __builtin_amdgcn_readfirstlane(w) >> 1;
            const float sg = prev ? 1.f : -1.f;
            const float dq = (float)(16 * w + q - 8 * g);
#pragma unroll
            for (int u = 0; u < 4; ++u) {
                if (prev ? (u < ud) : (u > ud)) {
#pragma unroll
                    for (int j = 0; j < 4; ++j) { s[2 * u][j] = -1e30f; s[2 * u + 1][j] = -1e30f; }
                } else if (u == ud) {
#pragma unroll
                    for (int h2 = 0; h2 < 2; ++h2)
#pragma unroll
                        for (int j = 0; j < 4; ++j) { const float v = sg * ((float)(32 * u + 4 * h2 + j) - dq); s[2 * u + h2][j] += fminf(v, 0.f) * 1e30f; }
                }
            }
        }
        float mx = s[0][0];
#pragma unroll
        for (int kt = 0; kt < 8; ++kt)
#pragma unroll
            for (int j = 0; j < 4; ++j) mx = fmaxf(mx, s[kt][j]);
        mx = xor16_max(mx); mx = xor32_max(mx);
        const float m_new = fmaxf(m_run, mx), alpha = fexp2(m_run - m_new); m_run = m_new;
        float rs = 0.f;
#pragma unroll
        for (int kt = 0; kt < 8; ++kt)
#pragma unroll
            for (int j = 0; j < 4; ++j) { const float p = fexp2(s[kt][j] - m_new); s[kt][j] = p; rs += p; }
        rs = xor16_add(rs); rs = xor32_add(rs);
        l_run = l_run * alpha + rs;
        bf16x8 pb[4];
#pragma unroll
        for (int u = 0; u < 4; ++u) { u32x4 t; t.x = pk2(s[2 * u][0], s[2 * u][1]); t.y = pk2(s[2 * u][2], s[2 * u][3]); t.z = pk2(s[2 * u + 1][0], s[2 * u + 1][1]); t.w = pk2(s[2 * u + 1][2], s[2 * u + 1][3]);
            pb[u] = __builtin_bit_cast(bf16x8, t); }
#pragma unroll
        for (int dt = 0; dt < NDT; ++dt) o[dt] = o[dt] * alpha;
        {
            u32x4 va[2][8];
#define WS_VLOAD(buf, gi) do { _Pragma("unroll") for (int i = 0; i < 8; ++i) { va[buf][i] = *(const LAS u32x4*)(lds + KT + (16 * i + q) * VROW + (32 * (gi) + 8 * g) * 2); } } while (0)
            WS_VLOAD(0, 0);
#pragma unroll
            for (int gi = 0; gi < 4; ++gi) {
                if (gi + 1 < 4) WS_VLOAD((gi + 1) & 1, gi + 1);
                __builtin_amdgcn_sched_barrier(0);
#pragma unroll
                for (int i = 0; i < 8; ++i) o[i] = mfma16(__builtin_bit_cast(bf16x8, va[gi & 1][i]), pb[gi], o[i]);
                __builtin_amdgcn_sched_barrier(0);
            }
#undef WS_VLOAD
        }
        bool done = false;
        if (Ccb + 1 < hi) ++Ccb;
        else {
            const float inv = 1.f / l_run;
            char* ob = (char*)yatt + ((size_t)(qblk * 128) * 2048 + hq * 128) * 2;
            const unsigned ooff = (unsigned)(((16 * w + q) * 2048 + 4 * g) * 2);
#pragma unroll
            for (int dt = 0; dt < NDT; ++dt) { u32x2 pkv; pkv.x = pk2(o[dt][0] * inv, o[dt][1] * inv); pkv.y = pk2(o[dt][2] * inv, o[dt][3] * inv); *(u32x2*)(ob + ooff + 32 * dt) = pkv; }
            Cv += G; if (Cv < 1024) Ccb = WS_LO(Cv); else done = true;
        }
        __syncthreads();
        bsel ^= 1;
        if (done) break;
    }
#undef WS_LOAD
#undef WS_STORE
#undef WS_LO
#undef WS_HI
#undef WS_ADV_L
}

constexpr int LR_XCB = 0, LR_TA = 16384, LR_TB = LR_TA + 64 * 528, LR_TH = LR_TB + 64 * 528, LR_AGS = LR_TH + 64 * 528;
template <int VAR>
__device__ __forceinline__ void lru_phase(LAS unsigned char* lds, const Args& a, const int n, const int tt_first, const int tt_step) {
    int tid = threadIdx.x; asm volatile("" : "+v"(tid)); const int lane = tid & 63, w0 = tid >> 6, q0 = lane & 15, g0 = lane >> 4;
    unsigned char* ws = a.ws;
    const bf16_t* proj = (const bf16_t*)(ws + WS_PROJ);
    LAS unsigned char* xcb = lds + LR_XCB;
    LAS float* TA = (LAS float*)(lds + LR_TA); LAS float* TB = (LAS float*)(lds + LR_TB); LAS float* TH = (LAS float*)(lds + LR_TH);
    LAS f32x2* AGS = (LAS f32x2*)(lds + LR_AGS);
    const bf16_t* lruw = (const bf16_t*)(ws + WS_LRUW);
    f32x2* agg1 = (f32x2*)(ws + (VAR ? WS_T0 : WS_AGG1));
    bf16_t* Pout = (bf16_t*)(ws + (VAR ? WS_U + 32 * MiB : WS_PP));
    bf16x8 fa[2][4], fx[2][4];
#pragma unroll
    for (int dir = 0; dir < 2; ++dir) {
        const bf16_t* wa = lruw + (size_t)((0 * 2 + dir) * 8 + n) * 16384 + (16 * w0 + q0) * 128 + 8 * g0;
        const bf16_t* wx = lruw + (size_t)((1 * 2 + dir) * 8 + n) * 16384 + (16 * w0 + q0) * 128 + 8 * g0;
#pragma unroll
        for (int s = 0; s < 4; ++s) { fa[dir][s] = *(const bf16x8*)(wa + 32 * s); fx[dir][s] = *(const bf16x8*)(wx + 32 * s); }
    }
    const int cg8 = tid & 15, t2 = tid >> 4, ch0 = n * 128 + cg8 * 8;
    LAS float* CW = (LAS float*)(lds + LR_AGS + 4096);
    __syncthreads();
    if (tid < 128) {
#pragma unroll
        for (int j = 0; j < 4; ++j) CW[j * 128 + tid] = a.in[5][j * 1024 + n * 128 + tid];
        CW[512 + tid] = a.in[6][n * 128 + tid];
    } else if (tid < 384) {
        const int d2 = (tid - 128) >> 7, c = tid & 127, cg = d2 * 1024 + n * 128 + c;
        const float xl = -a.in[11][cg];
        CW[640 + (d2 * 3 + 0) * 128 + c] = a.in[8][cg]; CW[640 + (d2 * 3 + 1) * 128 + c] = a.in[10][cg];
        CW[640 + (d2 * 3 + 2) * 128 + c] = fmaxf(xl, 0.f) + log1pf(expf(-fabsf(xl)));
    }
    u32x4 xr[5];
#define LRU_XLOAD(tt_) do { _Pragma("unroll") for (int r = 0; r < 5; ++r) { const int t = (tt_) * 64 + 2 * t2 - 2 + r; xr[r] = (u32x4){0u, 0u, 0u, 0u}; \
        if (t >= 0 && t < SEQ) xr[r] = __builtin_nontemporal_load((const u32x4*)((const char*)proj + (unsigned)((t * INW + C_XL + ch0) * 2))); } } while (0)
    float A2f = 1.f, H2f = 0.f, A2b = 1.f, H2b = 0.f;
    LRU_XLOAD(tt_first);
#pragma unroll 1
    for (int tt = tt_first; tt < tt_first + 4; ++tt) {
    const int t0 = tt * 64;
    __syncthreads();
    {
        float xin[5][8];
#pragma unroll
        for (int r = 0; r < 5; ++r) { const u32x4 v = xr[r];
            xin[r][0] = bflo(v.x); xin[r][1] = bfhi(v.x); xin[r][2] = bflo(v.y); xin[r][3] = bfhi(v.y); xin[r][4] = bflo(v.z); xin[r][5] = bfhi(v.z); xin[r][6] = bflo(v.w); xin[r][7] = bfhi(v.w); }
        float wv[4][8], bias[8];
#pragma unroll
        for (int j = 0; j < 4; ++j) { const f32x4 w0 = *(const LAS f32x4*)(CW + j * 128 + cg8 * 8), w1 = *(const LAS f32x4*)(CW + j * 128 + cg8 * 8 + 4);
            wv[j][0] = w0[0]; wv[j][1] = w0[1]; wv[j][2] = w0[2]; wv[j][3] = w0[3]; wv[j][4] = w1[0]; wv[j][5] = w1[1]; wv[j][6] = w1[2]; wv[j][7] = w1[3]; }
        { const f32x4 b0 = *(const LAS f32x4*)(CW + 512 + cg8 * 8), b1 = *(const LAS f32x4*)(CW + 512 + cg8 * 8 + 4);
          bias[0] = b0[0]; bias[1] = b0[1]; bias[2] = b0[2]; bias[3] = b0[3]; bias[4] = b1[0]; bias[5] = b1[1]; bias[6] = b1[2]; bias[7] = b1[3]; }
#pragma unroll
        for (int o = 0; o < 2; ++o) { float y[8];
#pragma unroll
            for (int e = 0; e < 8; ++e) { float v = bias[e];
#pragma unroll
                for (int j = 0; j < 4; ++j) v += wv[j][e] * xin[o + j][e];
                y[e] = v; }
            const int tok = 2 * t2 + o;
            u32x4 pk; pk.x = pk2(y[0], y[1]); pk.y = pk2(y[2], y[3]); pk.z = pk2(y[4], y[5]); pk.w = pk2(y[6], y[7]);
            *(LAS u32x4*)(xcb + tok * 256 + ((cg8 ^ (tok & 15)) * 16)) = pk; }
    }
    if (tt + 1 < tt_first + 4) LRU_XLOAD(tt + 1);
    __syncthreads();
    float hreg[16];
    int tl = tid; asm volatile("" : "+v"(tl));
    const int q = tl & 15, g = (tl >> 4) & 3, w = tl >> 6, chl = 16 * w + 4 * g;
    const int ch = 16 * w + q, sub = g;
#pragma unroll
    for (int dir = 0; dir < 2; ++dir) {
        LAS float* TAd = dir ? TH : TA;
        if (VAR != 3) {
            const f32x4 ba = *(const LAS f32x4*)(CW + 640 + (dir * 3 + 0) * 128 + chl), bx = *(const LAS f32x4*)(CW + 640 + (dir * 3 + 1) * 128 + chl), sp = *(const LAS f32x4*)(CW + 640 + (dir * 3 + 2) * 128 + chl);
#pragma unroll
            for (int tk = 0; tk < 4; ++tk) { const int tok = 16 * tk + q;
                f32x4 ar = (f32x4){0.f, 0.f, 0.f, 0.f}, ai = (f32x4){0.f, 0.f, 0.f, 0.f};
#pragma unroll
                for (int s = 0; s < 4; ++s) {
                    const bf16x8 xb = *(const LAS bf16x8*)(xcb + tok * 256 + (((4 * s + g) ^ q) * 16));
                    ar = mfma16(fa[dir][s], xb, ar); ai = mfma16(fx[dir][s], xb, ai); }
                const u32x2 xr2 = *(const LAS u32x2*)(xcb + tok * 256 + ((((chl >> 3)) ^ q) * 16) + (chl & 7) * 2);
                const float xc0 = bflo(xr2.x), xc1 = bfhi(xr2.x), xc2 = bflo(xr2.y), xc3 = bfhi(xr2.y);
                f32x4 av, bv;
#pragma unroll
                for (int j = 0; j < 4; ++j) { if (VAR == 1) { av[j] = ar[j] + ba[j] + sp[j]; bv[j] = ai[j] + bx[j] + (j == 0 ? xc0 : (j == 1 ? xc1 : (j == 2 ? xc2 : xc3))); continue; }
                    const float r = fsigmoid(ar[j] + ba[j]), ii = fsigmoid(ai[j] + bx[j]);
                    const float la = -8.0f * r * sp[j]; const float aa = fexp2(la * LOG2E); av[j] = aa;
                    const float x2 = 2.0f * la;
                    const float poly = x2 * (1.f + x2 * (0.5f + x2 * ((1.f / 6.f) + x2 * ((1.f / 24.f) + x2 * (1.f / 120.f)))));
                    const float om = (x2 > -0.25f) ? -poly : (1.f - aa * aa);
                    const float xcj = j == 0 ? xc0 : (j == 1 ? xc1 : (j == 2 ? xc2 : xc3));
                    bv[j] = __builtin_amdgcn_sqrtf(om) * ii * xcj; }
                *(LAS f32x4*)(TAd + tok * 132 + chl) = av; *(LAS f32x4*)(TB + tok * 132 + chl) = bv; }
        }
        asm volatile("s_waitcnt lgkmcnt(0)" ::: "memory");
        if (VAR != 2 && VAR != 3) {
            float h = 0.f, P = 1.f;
#pragma unroll
            for (int i = 0; i < 16; ++i) { const int t = 16 * sub + (dir ? 15 - i : i);
                const float av = TAd[t * 132 + ch], bv = TB[t * 132 + ch]; h = av * h + bv; P *= av; TB[t * 132 + ch] = h; TAd[t * 132 + ch] = P; }
            AGS[sub * 128 + ch] = (f32x2){P, h};
        }
        asm volatile("s_waitcnt lgkmcnt(0)" ::: "memory");
        if (VAR == 2 || VAR == 3) {
#pragma unroll
            for (int i = 0; i < 16; ++i) hreg[i] = 0.f;
        } else {
            float hc = 0.f, Pp = 1.f, At = 1.f, Ht = 0.f;
#pragma unroll
            for (int s = 0; s < 4; ++s) { const int s2 = dir ? 3 - s : s; const f32x2 e = AGS[s2 * 128 + ch];
                const bool before = dir ? (s2 > sub) : (s2 < sub);
                if (before) { hc = e.x * hc + e.y; Pp *= e.x; }
                Ht = e.x * Ht + e.y; At *= e.x; }
#pragma unroll
            for (int i = 0; i < 16; ++i) { const int t = 16 * sub + i;
                const float Pl = TAd[t * 132 + ch], hl = TB[t * 132 + ch];
                const float hfull = hl + Pl * hc;
                if (dir == 0) hreg[i] = hfull; else hreg[i] += hfull;
                TAd[t * 132 + ch] = Pl * Pp; }
            if (sub == 0) agg1[(size_t)(dir * 1024 + n * 128 + ch) * 128 + tt] = (f32x2){At, Ht};
            if (dir == 0) { H2f = At * H2f + Ht; A2f *= At; }
            else { H2b = A2b * Ht + H2b; A2b *= At; }
        }
        asm volatile("s_waitcnt lgkmcnt(0)" ::: "memory");
    }
#pragma unroll
    for (int i = 0; i < 16; ++i) TB[(16 * sub + i) * 132 + ch] = hreg[i];
    __syncthreads();
    {
        float* hs = (float*)(ws + (VAR ? WS_U : WS_HS));
#pragma unroll
        for (int i = 0; i < 4; ++i) { const int e = tid + 512 * i, t = e >> 5, c4 = e & 31;
            *(f32x4*)(hs + (size_t)(t0 + t) * 1024 + n * 128 + 4 * c4) = *(const LAS f32x4*)(TB + t * 132 + 4 * c4);
            const f32x4 p0 = *(const LAS f32x4*)(TA + t * 132 + 4 * c4), p1 = *(const LAS f32x4*)(TH + t * 132 + 4 * c4);
            u32x2 o0, o1; o0.x = pk2(p0[0], p0[1]); o0.y = pk2(p0[2], p0[3]); o1.x = pk2(p1[0], p1[1]); o1.y = pk2(p1[2], p1[3]);
            *(u32x2*)(Pout + (size_t)(t0 + t) * 1024 + n * 128 + 4 * c4) = o0;
            *(u32x2*)(Pout + (size_t)SEQ * 1024 + (size_t)(t0 + t) * 1024 + n * 128 + 4 * c4) = o1; }
    }
    }
    if (g0 == 0) { f32x2* agg2 = (f32x2*)(ws + (VAR ? WS_T0 + 8 * MiB : WS_AGG2)); const int chg2 = n * 128 + 16 * w0 + q0, sc2 = tt_first >> 2;
        agg2[(size_t)chg2 * 32 + sc2] = (f32x2){A2f, H2f}; agg2[(size_t)(1024 + chg2) * 32 + sc2] = (f32x2){A2b, H2b}; }
#undef LRU_XLOAD
}

__device__ __forceinline__ void phase2(const Args& a, LAS unsigned char* lds, int p2mask) {
    unsigned char* ws = a.ws;
    bf16_t* proj = (bf16_t*)(ws + WS_PROJ); const bf16_t* vt = (const bf16_t*)(ws + WS_VT);
    const bf16_t* mk = (const bf16_t*)(ws + WS_MK); const bf16_t* mvt = (const bf16_t*)(ws + WS_MVT);
    bf16_t* yatt = (bf16_t*)(ws + WS_YATT); bf16_t* ymem = (bf16_t*)(ws + WS_YMEM);
    if (p2mask & 1)
    for (int u = blockIdx.x; u < 256; u += gridDim.x) {
        const int qblk = u >> 2, hm = u & 3;
        attn_unit<256, false, false>(lds, proj + (size_t)(qblk * 128) * INW + C_QM + hm * 256, INW, ymem + (size_t)(qblk * 128) * 1024 + hm * 256, 1024, mk + hm * 256, 1024, mvt + (size_t)(hm * 256) * 256, 256, 0, 2, -100, -1e30f, 0.f);
    }
    if (p2mask & 2) windowed_stream(lds, a);
    if (p2mask & 4)
    lru_phase<0>(lds, a, (int)(blockIdx.x & 7), 4 * (int)(blockIdx.x >> 3), 1);
}

__device__ __forceinline__ void phase3(const Args& a, LAS unsigned char* lds) {
    unsigned char* ws = a.ws;
    const f32x2* agg1 = (const f32x2*)(ws + WS_AGG1); f32x2* agg2 = (f32x2*)(ws + WS_AGG2);
    for (int e = blockIdx.x * 512 + threadIdx.x; e < 2 * 1024 * 16; e += gridDim.x * 512) {
        const int sc = e & 15, dc = e >> 4, dir = dc >> 10;
        const f32x4* p = (const f32x4*)(agg1 + (size_t)dc * 128 + sc * 8);
        f32x4 v[4];
#pragma unroll
        for (int i = 0; i < 4; ++i) v[i] = p[i];
        float A = 1.f, H = 0.f;
        if (dir == 0) {
#pragma unroll
            for (int i = 0; i < 4; ++i) { H = v[i][0] * H + v[i][1]; A *= v[i][0]; H = v[i][2] * H + v[i][3]; A *= v[i][2]; }
        } else {
#pragma unroll
            for (int i = 3; i >= 0; --i) { H = v[i][2] * H + v[i][3]; A *= v[i][2]; H = v[i][0] * H + v[i][1]; A *= v[i][0]; }
        }
        agg2[(size_t)dc * 16 + sc] = (f32x2){A, H};
    }
}

__device__ __forceinline__ float silu_(float z) { return z * __builtin_amdgcn_rcpf(1.f + __builtin_amdgcn_exp2f(-z * 1.4426950408889634f)); }
__device__ __forceinline__ void phase4(const Args& a, LAS unsigned char* lds) {
    unsigned char* ws = a.ws;
    const f32x2* agg1 = (const f32x2*)(ws + WS_AGG1); const f32x2* agg2 = (const f32x2*)(ws + WS_AGG2);
    const bf16_t* proj = (const bf16_t*)(ws + WS_PROJ); bf16_t* Y = (bf16_t*)(ws + WS_Y);
    const bf16_t* yatt = (const bf16_t*)(ws + WS_YATT); const bf16_t* ymem = (const bf16_t*)(ws + WS_YMEM);
    const float* hs = (const float*)(ws + WS_HS); const bf16_t* Pf = (const bf16_t*)(ws + WS_PP); const bf16_t* Pb = Pf + (size_t)SEQ * 1024;
    LAS float* car = (LAS float*)lds;
    LAS float* gl = (LAS float*)(lds + 8192);
    int tid = threadIdx.x; asm volatile("" : "+v"(tid)); const int lane = tid & 63, w = tid >> 6;
    __syncthreads();
    for (int i = tid; i < 1024; i += 512) { *(LAS f32x4*)(gl + 4 * i) = (i < 512) ? ((const f32x4*)a.in[14])[i] : (i < 768 ? ((const f32x4*)a.in[15])[i - 512] : ((const f32x4*)a.in[16])[i - 768]); }
    for (int u = blockIdx.x; u < 256; u += gridDim.x) {
        const int tile = u >> 1, sc = tile >> 2, cj = tile & 3;
        __syncthreads();
#pragma unroll 1
        for (int half = 0; half < 2; ++half) {
            const int c = tid + 512 * half;
            float hf = 0.f, hb = 0.f;
            float scf = (float)sc, cjf = (float)cj; asm volatile("" : "+v"(scf), "+v"(cjf));
            { const f32x4* p2 = (const f32x4*)(agg2 + (size_t)c * 32); const f32x4* p1 = (const f32x4*)(agg1 + (size_t)c * 128 + sc * 4);
              f32x4 e2[16], e1[2];
#pragma unroll
              for (int i = 0; i < 16; ++i) e2[i] = p2[i];
#pragma unroll
              for (int i = 0; i < 2; ++i) e1[i] = p1[i];
#pragma unroll
              for (int i = 0; i < 16; ++i) { const float w0 = fminf(fmaxf(scf - (float)(2 * i), 0.f), 1.f), w1 = fminf(fmaxf(scf - (float)(2 * i + 1), 0.f), 1.f);
                  hf = (w0 * e2[i][0] + (1.f - w0)) * hf + w0 * e2[i][1]; hf = (w1 * e2[i][2] + (1.f - w1)) * hf + w1 * e2[i][3]; }
#pragma unroll
              for (int i = 0; i < 2; ++i) { const float w0 = fminf(fmaxf(cjf - (float)(2 * i), 0.f), 1.f), w1 = fminf(fmaxf(cjf - (float)(2 * i + 1), 0.f), 1.f);
                  hf = (w0 * e1[i][0] + (1.f - w0)) * hf + w0 * e1[i][1]; hf = (w1 * e1[i][2] + (1.f - w1)) * hf + w1 * e1[i][3]; } }
            { const f32x4* p2 = (const f32x4*)(agg2 + (size_t)(1024 + c) * 32); const f32x4* p1 = (const f32x4*)(agg1 + (size_t)(1024 + c) * 128 + sc * 4);
              f32x4 e2[16], e1[2];
#pragma unroll
              for (int i = 0; i < 16; ++i) e2[i] = p2[i];
#pragma unroll
              for (int i = 0; i < 2; ++i) e1[i] = p1[i];
#pragma unroll
              for (int i = 15; i >= 0; --i) { const float w1 = fminf(fmaxf((float)(2 * i + 1) - scf, 0.f), 1.f), w0 = fminf(fmaxf((float)(2 * i) - scf, 0.f), 1.f);
                  hb = (w1 * e2[i][2] + (1.f - w1)) * hb + w1 * e2[i][3]; hb = (w0 * e2[i][0] + (1.f - w0)) * hb + w0 * e2[i][1]; }
#pragma unroll
              for (int i = 1; i >= 0; --i) { const float w1 = fminf(fmaxf((float)(2 * i + 1) - cjf, 0.f), 1.f), w0 = fminf(fmaxf((float)(2 * i) - cjf, 0.f), 1.f);
                  hb = (w1 * e1[i][2] + (1.f - w1)) * hb + w1 * e1[i][3]; hb = (w0 * e1[i][0] + (1.f - w0)) * hb + w0 * e1[i][1]; } }
            car[c] = hf; car[1024 + c] = hb;
        }
        __syncthreads();
        f32x4 cf[4], cb[4];
#pragma unroll
        for (int k = 0; k < 4; ++k) { cf[k] = *(const LAS f32x4*)(car + 4 * lane + 256 * k); cb[k] = *(const LAS f32x4*)(car + 1024 + 4 * lane + 256 * k); }
#pragma unroll 1
        for (int tk = 0; tk < 4; ++tk) {
            const unsigned t = (unsigned)(u * 32 + 4 * w + tk);
            const char* hsb = (const char*)hs; const char* pfb = (const char*)Pf; const char* pbb = (const char*)Pb;
            const char* yab = (const char*)yatt; const char* ymb = (const char*)ymem; const char* prb = (const char*)proj; char* yb = (char*)Y;
            const unsigned o_h = t * 4096u + 16u * lane, o_p = t * 2048u + 8u * lane, o_m = t * 2048u + 16u * lane;
            const unsigned o_pr = t * (unsigned)(INW * 2), o_y = t * 8192u;
            f32x4 h4[4]; u32x2 pf[4], pb[4], zl[4]; u32x4 va[4], vm[2], za[4], zm[2];
#pragma unroll
            for (int k = 0; k < 4; ++k) { h4[k] = __builtin_nontemporal_load((const f32x4*)(hsb + o_h + 1024u * k)); pf[k] = __builtin_nontemporal_load((const u32x2*)(pfb + o_p + 512u * k)); pb[k] = __builtin_nontemporal_load((const u32x2*)(pbb + o_p + 512u * k)); va[k] = __builtin_nontemporal_load((const u32x4*)(yab + o_h + 1024u * k)); }
#pragma unroll
            for (int k = 0; k < 2; ++k) vm[k] = __builtin_nontemporal_load((const u32x4*)(ymb + o_m + 1024u * k));
#pragma unroll
            for (int k = 0; k < 4; ++k) { zl[k] = __builtin_nontemporal_load((const u32x2*)(prb + o_pr + (unsigned)((C_ZL + 4 * lane + 256 * k) * 2))); za[k] = __builtin_nontemporal_load((const u32x4*)(prb + o_pr + (unsigned)((C_ZA + 8 * lane + 512 * k) * 2))); }
#pragma unroll
            for (int k = 0; k < 2; ++k) zm[k] = __builtin_nontemporal_load((const u32x4*)(prb + o_pr + (unsigned)((C_ZM + 8 * lane + 512 * k) * 2)));
            __builtin_amdgcn_sched_barrier(0);
            f32x4 v[4]; float ssl = 0.f, ssa = 0.f, ssm = 0.f;
#pragma unroll
            for (int k = 0; k < 4; ++k) {
                v[k][0] = h4[k][0] + bflo(pf[k].x) * cf[k][0] + bflo(pb[k].x) * cb[k][0]; v[k][1] = h4[k][1] + bfhi(pf[k].x) * cf[k][1] + bfhi(pb[k].x) * cb[k][1];
                v[k][2] = h4[k][2] + bflo(pf[k].y) * cf[k][2] + bflo(pb[k].y) * cb[k][2]; v[k][3] = h4[k][3] + bfhi(pf[k].y) * cf[k][3] + bfhi(pb[k].y) * cb[k][3];
                ssl += (v[k][0] * v[k][0] + v[k][1] * v[k][1]) + (v[k][2] * v[k][2] + v[k][3] * v[k][3]);
                { const float f0 = bflo(va[k].x), f1 = bfhi(va[k].x), f2 = bflo(va[k].y), f3 = bfhi(va[k].y), f4 = bflo(va[k].z), f5 = bfhi(va[k].z), f6 = bflo(va[k].w), f7 = bfhi(va[k].w);
                  ssa += ((f0 * f0 + f1 * f1) + (f2 * f2 + f3 * f3)) + ((f4 * f4 + f5 * f5) + (f6 * f6 + f7 * f7)); } }
#pragma unroll
            for (int k = 0; k < 2; ++k) { const float f0 = bflo(vm[k].x), f1 = bfhi(vm[k].x), f2 = bflo(vm[k].y), f3 = bfhi(vm[k].y), f4 = bflo(vm[k].z), f5 = bfhi(vm[k].z), f6 = bflo(vm[k].w), f7 = bfhi(vm[k].w);
                ssm += ((f0 * f0 + f1 * f1) + (f2 * f2 + f3 * f3)) + ((f4 * f4 + f5 * f5) + (f6 * f6 + f7 * f7)); }
            ssl = wave_sum(ssl); ssa = wave_sum(ssa); ssm = wave_sum(ssm);
            const float rsl = 1.f / sqrtf(ssl * (1.f / 1024.f) + EPSN), rsa = 1.f / sqrtf(ssa * (1.f / 2048.f) + EPSN), rsm = 1.f / sqrtf(ssm * (1.f / 1024.f) + EPSN);
            __builtin_amdgcn_sched_barrier(0);
#pragma unroll
            for (int k = 0; k < 4; ++k) { const int c = 4 * lane + 256 * k; const f32x4 g4 = *(const LAS f32x4*)(gl + 2048 + c); const u32x2 z = zl[k];
                u32x2 o; o.x = pk2(v[k][0] * rsl * g4[0] * silu_(bflo(z.x)), v[k][1] * rsl * g4[1] * silu_(bfhi(z.x))); o.y = pk2(v[k][2] * rsl * g4[2] * silu_(bflo(z.y)), v[k][3] * rsl * g4[3] * silu_(bfhi(z.y)));
                *(u32x2*)(yb + o_y + (unsigned)((2048 + c) * 2)) = o; }
            __builtin_amdgcn_sched_barrier(0);
#pragma unroll
            for (int k = 0; k < 4; ++k) { const int c = 8 * lane + 512 * k; const f32x4 g0 = *(const LAS f32x4*)(gl + c), g1 = *(const LAS f32x4*)(gl + c + 4); const u32x4 z = za[k];
                u32x4 o; o.x = pk2(bflo(va[k].x) * rsa * g0[0] * silu_(bflo(z.x)), bfhi(va[k].x) * rsa * g0[1] * silu_(bfhi(z.x)));
                o.y = pk2(bflo(va[k].y) * rsa * g0[2] * silu_(bflo(z.y)), bfhi(va[k].y) * rsa * g0[3] * silu_(bfhi(z.y)));
                o.z = pk2(bflo(va[k].z) * rsa * g1[0] * silu_(bflo(z.z)), bfhi(va[k].z) * rsa * g1[1] * silu_(bfhi(z.z)));
                o.w = pk2(bflo(va[k].w) * rsa * g1[2] * silu_(bflo(z.w)), bfhi(va[k].w) * rsa * g1[3] * silu_(bfhi(z.w)));
                *(u32x4*)(yb + o_y + (unsigned)(c * 2)) = o; }
            __builtin_amdgcn_sched_barrier(0);
#pragma unroll
            for (int k = 0; k < 2; ++k) { const int c = 8 * lane + 512 * k; const f32x4 g0 = *(const LAS f32x4*)(gl + 3072 + c), g1 = *(const LAS f32x4*)(gl + 3072 + c + 4); const u32x4 z = zm[k];
                u32x4 o; o.x = pk2(bflo(vm[k].x) * rsm * g0[0] * silu_(bflo(z.x)), bfhi(vm[k].x) * rsm * g0[1] * silu_(bfhi(z.x)));
                o.y = pk2(bflo(vm[k].y) * rsm * g0[2] * silu_(bflo(z.y)), bfhi(vm[k].y) * rsm * g0[3] * silu_(bfhi(z.y)));
                o.z = pk2(bflo(vm[k].z) * rsm * g1[0] * silu_(bflo(z.z)), bfhi(vm[k].z) * rsm * g1[1] * silu_(bfhi(z.z)));
                o.w = pk2(bflo(vm[k].w) * rsm * g1[2] * silu_(bflo(z.w)), bfhi(vm[k].w) * rsm * g1[3] * silu_(bfhi(z.w)));
                *(u32x4*)(yb + o_y + (unsigned)((3072 + c) * 2)) = o; }
        }
    }
}

#define XB_TMO      128
#define XB_XCNT(j)  (256  + 64 * (j))
#define XB_XSUB(j)  (1280 + 64 * (j))
#define XB_XGEN(j)  (2304 + 64 * (j))
#define XB_TOP      3328
#define XB_TOPGEN   3392
#define XCD_BAR_WORDS 3456
#define XB_SPIN_CAP (1u << 18)

__device__ __forceinline__ unsigned xb_ld(unsigned* p)              { return __hip_atomic_load(p, __ATOMIC_RELAXED, __HIP_MEMORY_SCOPE_AGENT); }
__device__ __forceinline__ unsigned xb_add(unsigned* p, unsigned v) { return __hip_atomic_fetch_add(p, v, __ATOMIC_RELAXED, __HIP_MEMORY_SCOPE_AGENT); }
__device__ __forceinline__ unsigned xb_xcc_id() { return (unsigned)__builtin_amdgcn_s_getreg((3 << 11) | 20) & 0xFu; }
#define XB_SPIN(cond, bar) do { unsigned _sp = 0; while (cond) { __builtin_amdgcn_s_sleep(1); \
    if ((++_sp & 255u) == 0u) { if (xb_ld(&(bar)[XB_TMO])) break; if (_sp > XB_SPIN_CAP) { atomicAdd(&(bar)[XB_TMO], 1u); break; } } } } while (0)

struct XcdBarrier {
    unsigned* bar; unsigned x;
    volatile LAS unsigned* st;
};

__device__ __forceinline__ XcdBarrier xcd_barrier_post(unsigned* bar, volatile LAS unsigned* st) {
    XcdBarrier b; b.bar = bar; b.x = xb_xcc_id(); b.st = st;
    if (threadIdx.x == 0) (void)xb_add(&bar[XB_XCNT(b.x)], 1u);
    return b;
}
__device__ __forceinline__ void xcd_barrier_complete(unsigned* bar, unsigned x, unsigned& nloc, unsigned& nx) {
    const unsigned G = gridDim.x * gridDim.y * gridDim.z;
    unsigned sum, cnt, mine, sp = 0u;
    for (;;) {
        sum = 0u; cnt = 0u; mine = 0u;
#pragma unroll
        for (unsigned j = 0; j < 16; ++j) { const unsigned c = xb_ld(&bar[XB_XCNT(j)]); sum += c; cnt += (c > 0u) ? 1u : 0u; mine = (j == x) ? c : mine; }
        if (sum == G) break;
        __builtin_amdgcn_s_sleep(1);
        if ((++sp & 255u) == 0u) { if (xb_ld(&bar[XB_TMO])) break; if (sp > XB_SPIN_CAP) { atomicAdd(&bar[XB_TMO], 1u); break; } }
    }
    nloc = mine > 0u ? mine : 1u; nx = cnt > 0u ? cnt : 1u;
}

__device__ __forceinline__ void xcd_barrier(const XcdBarrier& b) {
    asm volatile("s_waitcnt vmcnt(0)" ::: "memory");
    __syncthreads();
    if (threadIdx.x == 0) {
        unsigned* bar = b.bar;
        __builtin_amdgcn_s_waitcnt(0);
        unsigned nloc = b.st[0], nx = b.st[1];
        if (nloc == 0u) { xcd_barrier_complete(bar, b.x, nloc, nx); b.st[0] = nloc; b.st[1] = nx; }
        const unsigned old = xb_add(&bar[XB_XSUB(b.x)], 1u);
        const unsigned gen = old / nloc;
        if (old + 1u == (gen + 1u) * nloc) {
            __builtin_amdgcn_fence(__ATOMIC_RELEASE, "agent");
            asm volatile("s_waitcnt vmcnt(0)" ::: "memory");
            const unsigned og = xb_add(&bar[XB_TOP], 1u);
            const unsigned tg = og / nx;
            if (og + 1u == (tg + 1u) * nx) xb_add(&bar[XB_TOPGEN], 1u);
            else XB_SPIN(xb_ld(&bar[XB_TOPGEN]) == tg, bar);
            __builtin_amdgcn_fence(__ATOMIC_ACQUIRE, "agent");
            xb_add(&bar[XB_XGEN(b.x)], 1u);
            asm volatile("s_waitcnt vmcnt(0)" ::: "memory");
        } else {
            XB_SPIN(xb_ld(&bar[XB_XGEN(b.x)]) == gen, bar);
            __builtin_amdgcn_fence(__ATOMIC_ACQUIRE, "agent");
            asm volatile("s_waitcnt vmcnt(0)" ::: "memory");
        }
    }
    __syncthreads();
}

struct Sched2 {
    int c;
    __device__ bool next(int i, pg8::Unit& u) const {
        if (i >= 2) return false;
        const int x = c & 7, j = c >> 3;
        u.pm = i * 16 + 4 * (x >> 1) + (j & 3); u.pn = 8 * (x & 1) + (j >> 2); return true;
    }
    __device__ __forceinline__ void a_ready(const pg8::Unit&) const {}
    __device__ __forceinline__ void done(const pg8::Unit&) const {}
};
struct Epi3 {
    static constexpr bool PERM = true, AFTER_DRAIN = false, HOLD_LAST = true;
    float* out; bf16_t* t0; float* sspart; const float* x; const float* gain; XcdBarrier xbar;
    __device__ __forceinline__ void operator()(const f32x4 (&acc)[2][2][4][2], const pg8::Unit& u, int wr, int wc, int fr, int fq) const {
#pragma unroll
        for (int ai = 0; ai < 2; ++ai)
#pragma unroll
            for (int m = 0; m < 4; ++m) { const int row = u.pm * 256 + ai * 128 + wr * 64 + m * 16 + fr; float ss = 0.f;
#pragma unroll
                for (int bj = 0; bj < 2; ++bj) { const f32x4 v0 = acc[ai][bj][m][0], v1 = acc[ai][bj][m][1]; const int col = u.pn * 256 + bj * 128 + wc * 32 + 8 * fq;
                    u32x4 pk; pk.x = pk2(v0[0], v0[1]); pk.y = pk2(v0[2], v0[3]); pk.z = pk2(v1[0], v1[1]); pk.w = pk2(v1[2], v1[3]); *(u32x4*)(t0 + (size_t)row * 4096 + col) = pk;
                    ss += ((v0[0] * v0[0] + v0[1] * v0[1]) + (v0[2] * v0[2] + v0[3] * v0[3])) + ((v1[0] * v1[0] + v1[1] * v1[1]) + (v1[2] * v1[2] + v1[3] * v1[3])); }
                ss = xor16_add(ss); ss = xor32_add(ss);
                if (fq == 0) sspart[(size_t)row * 64 + u.pn * 4 + wc] = ss; }
    }
    __device__ __forceinline__ void fused(f32x4 (&acc)[2][2][4][2], const pg8::Unit& u, int wr, int wc, int fr, int fq, LAS unsigned char* lds, int wid, int lane) const {
#pragma unroll
        for (int ai = 0; ai < 2; ++ai)
#pragma unroll
            for (int m = 0; m < 4; ++m) { const int row = u.pm * 256 + ai * 128 + wr * 64 + m * 16 + fr; float ss = 0.f;
#pragma unroll
                for (int bj = 0; bj < 2; ++bj)
#pragma unroll
                    for (int n = 0; n < 2; ++n) { const f32x4 v = acc[ai][bj][m][n]; ss += (v[0] * v[0] + v[1] * v[1]) + (v[2] * v[2] + v[3] * v[3]); }
                ss = xor16_add(ss); ss = xor32_add(ss);
                if (fq == 0) sspart[(size_t)row * 64 + u.pn * 4 + wc] = ss; }
        f32x4 xv0[16], xv1[16];
        const size_t gob = (size_t)(u.pm * 256 + wid * 16) * 4096 + u.pn * 256 + 4 * lane;
#pragma unroll
        for (int r = 0; r < 16; ++r) xv0[r] = __builtin_nontemporal_load((const f32x4*)(x + gob + (size_t)r * 4096));
        xcd_barrier(xbar);
        constexpr int TP = 260;
        LAS float* T = (LAS float*)lds;
        LAS float* rsT = (LAS float*)(lds + 128 * TP * 4);
        { const int tid = wid * 64 + lane, row = tid >> 1, hf = tid & 1;
          const f32x4* p = (const f32x4*)(sspart + (size_t)(u.pm * 256 + row) * 64 + hf * 32);
          float s = 0.f;
#pragma unroll
          for (int i = 0; i < 8; ++i) { const f32x4 v = p[i]; s += (v[0] + v[1]) + (v[2] + v[3]); }
          s += dpp_mov<0xB1>(s);
          if (hf == 0) rsT[row] = 1.f / sqrtf(s * (1.f / 4096.f) + EPSN); }
        const f32x4 gv = *(const f32x4*)(gain + u.pn * 256 + 4 * lane);
#pragma unroll
        for (int ai = 0; ai < 2; ++ai) {
            __syncthreads();
#pragma unroll
            for (int m = 0; m < 4; ++m)
#pragma unroll
                for (int bj = 0; bj < 2; ++bj)
#pragma unroll
                    for (int n = 0; n < 2; ++n) *(LAS f32x4*)(T + (wr * 64 + m * 16 + fr) * TP + bj * 128 + wc * 32 + 8 * fq + 4 * n) = acc[ai][bj][m][n];
            if (ai == 0) {
#pragma unroll
                for (int r = 0; r < 16; ++r) xv1[r] = __builtin_nontemporal_load((const f32x4*)(x + gob + (size_t)(128 + r) * 4096));
            }
            __syncthreads();
#pragma unroll
            for (int r = 0; r < 16; ++r) { const int rl = wid * 16 + r;
                const f32x4 tv = *(const LAS f32x4*)(T + rl * TP + 4 * lane); const float rs = rsT[ai * 128 + rl];
                __builtin_nontemporal_store((ai ? xv1[r] : xv0[r]) + tv * rs * gv, (f32x4*)(out + gob + (size_t)(ai * 128 + r) * 4096)); }
        }
        const int pm0 = u.pm - 16;
        __syncthreads();
        { const int tid = wid * 64 + lane, row = tid >> 1, hf = tid & 1;
          const f32x4* p = (const f32x4*)(sspart + (size_t)(pm0 * 256 + row) * 64 + hf * 32);
          float s = 0.f;
#pragma unroll
          for (int i = 0; i < 8; ++i) { const f32x4 v = p[i]; s += (v[0] + v[1]) + (v[2] + v[3]); }
          s += dpp_mov<0xB1>(s);
          if (hf == 0) rsT[row] = 1.f / sqrtf(s * (1.f / 4096.f) + EPSN); }
        __syncthreads();
#pragma unroll 1
        for (int hb = 0; hb < 2; ++hb) {
            const int r0 = wid * 32 + hb * 16;
            const size_t go = (size_t)(pm0 * 256 + r0) * 4096 + u.pn * 256 + 4 * lane;
            f32x4 xr[16]; u32x2 tr[16];
#pragma unroll
            for (int r = 0; r < 16; ++r) { xr[r] = __builtin_nontemporal_load((const f32x4*)(x + go + (size_t)r * 4096)); tr[r] = __builtin_nontemporal_load((const u32x2*)(t0 + go + (size_t)r * 4096)); }
#pragma unroll
            for (int r = 0; r < 16; ++r) { const float rs = rsT[r0 + r];
                f32x4 o; o[0] = xr[r][0] + bflo(tr[r].x) * rs * gv[0]; o[1] = xr[r][1] + bfhi(tr[r].x) * rs * gv[1]; o[2] = xr[r][2] + bflo(tr[r].y) * rs * gv[2]; o[3] = xr[r][3] + bfhi(tr[r].y) * rs * gv[3];
                __builtin_nontemporal_store(o, (f32x4*)(out + go + (size_t)r * 4096)); }
        }
    }
};
__device__ __forceinline__ void phase6(const Args& a) {
    int tid = threadIdx.x; asm volatile("" : "+v"(tid)); const int lane = tid & 63, w = tid >> 6;
    const float* sspart = (const float*)(a.ws + WS_SS); const bf16_t* t0 = (const bf16_t*)(a.ws + WS_T0);
    f32x4 gv[16];
#pragma unroll
    for (int k = 0; k < 16; ++k) gv[k] = ((const f32x4*)a.in[18])[2 * lane + 128 * (k >> 1) + (k & 1)];
    for (int row = blockIdx.x * 8 + w; row < 4096; row += gridDim.x * 8) {
        const u32x4* t4 = (const u32x4*)(t0 + (size_t)row * 4096) + lane; f32x4* o4 = (f32x4*)(a.out + (size_t)row * 4096) + 2 * lane;
        const f32x4* x4 = (const f32x4*)(a.in[0] + (size_t)row * 4096) + 2 * lane;
        u32x4 tv[8]; f32x4 xa[8], xb[8];
        const float sp = sspart[(size_t)row * 64 + lane];
#pragma unroll
        for (int k = 0; k < 8; ++k) { tv[k] = __builtin_nontemporal_load(t4 + 64 * k); xa[k] = __builtin_nontemporal_load(x4 + 128 * k); xb[k] = __builtin_nontemporal_load(x4 + 128 * k + 1); }
        const float rs = 1.f / sqrtf(wave_sum(sp) * (1.f / 4096.f) + EPSN);
#pragma unroll
        for (int k = 0; k < 8; ++k) { const f32x4 ga = gv[2 * k], gb = gv[2 * k + 1];
            f32x4 oa, ob; oa[0] = xa[k][0] + bflo(tv[k].x) * rs * ga[0]; oa[1] = xa[k][1] + bfhi(tv[k].x) * rs * ga[1]; oa[2] = xa[k][2] + bflo(tv[k].y) * rs * ga[2]; oa[3] = xa[k][3] + bfhi(tv[k].y) * rs * ga[3];
            ob[0] = xb[k][0] + bflo(tv[k].z) * rs * gb[0]; ob[1] = xb[k][1] + bfhi(tv[k].z) * rs * gb[1]; ob[2] = xb[k][2] + bflo(tv[k].w) * rs * gb[2]; ob[3] = xb[k][3] + bfhi(tv[k].w) * rs * gb[3];
            __builtin_nontemporal_store(oa, o4 + 128 * k); __builtin_nontemporal_store(ob, o4 + 128 * k + 1); }
    }
}

__global__ void __launch_bounds__(512, 2) mega(Args a) {
    extern __shared__ __attribute__((aligned(16))) unsigned char lds_raw[];
    LAS unsigned char* lds = (LAS unsigned char*)lds_raw;
    cg::grid_group grid = cg::this_grid();
    unsigned char* ws = a.ws;
    volatile LAS unsigned* xst = (volatile LAS unsigned*)(lds + LDS_BYTES - 64);
    if (threadIdx.x < 16) xst[threadIdx.x] = 0u;
    __syncthreads();
    XcdBarrier xbar; xbar.bar = (unsigned*)(ws + WS_CTL); xbar.x = 0; xbar.st = nullptr;
    xbar = xcd_barrier_post((unsigned*)(ws + WS_CTL), xst);
    const int lo = a.ph_lo, hi = a.ph_hi;
#define IN(k) (lo <= (k) && (k) < hi)
#define SEAM(k) do { if (IN(k) && IN((k) + 1)) { if ((k) == 0) { __syncthreads(); grid.sync(); } else xcd_barrier(xbar); } } while (0)
    if (IN(0)) { if (PHMASK & 1) phase0(a, lds); if (REPMASK & 1) { __syncthreads(); phase0(a, lds); } }
    SEAM(0);
    if (IN(1)) { if (PHMASK & 2) {
        pg8::Gemm g{(const bf16_t*)(ws + WS_U), (const bf16_t*)(ws + WS_WT), SEQ + NMEM, INW + 2048, 4096};
        Epi1 E{(bf16_t*)(ws + WS_PROJ), (bf16_t*)(ws + WS_VT), (bf16_t*)(ws + WS_MK), (bf16_t*)(ws + WS_MVT), (const float*)(ws + WS_ROPE)};
        const int G = (int)gridDim.x, nfull = 1160 % G, nidle = G - nfull, bi = (int)blockIdx.x - nfull;
        if (bi < 0) {
            Sched1 S; S.init(G, (int)blockIdx.x); S.ioff = 4;
            pg8::gemm_phase<Epi1, Sched1, true, true>(lds, g, S, E);
        } else {
            int tid = threadIdx.x; asm volatile("" : "+v"(tid)); const int lane = tid & 63, w = tid >> 6;
            LAS float* scr = (LAS float*)(lds + w * 16384);
            p0_transpose_win<false>(a.in[3], (bf16_t*)(ws + WS_WT), scr, bi * 8 + w, nidle * 8, lane);
            p0_transpose_matrix(a.in[17], 4096, 4096, (bf16_t*)(ws + WS_WOUT), 0, scr, bi * 8 + w, nidle * 8, lane);
        }
        xcd_barrier(xbar);
        { Sched1 S; S.init(G, (int)blockIdx.x); S.imax = 4;
          pg8::gemm_phase<Epi1, Sched1, true, true>(lds, g, S, E); }
    } }
    SEAM(1);
    if (IN(2)) { if (PHMASK & 4) phase2(a, lds, P2MASK); }
    SEAM(2);
    if (IN(4)) { if (PHMASK & 16) phase4(a, lds); if (REPMASK & 16) { __syncthreads(); phase4(a, lds); } }
    SEAM(4);
    if (IN(5)) { if (PHMASK & 32) {
        pg8::Gemm g{(const bf16_t*)(ws + WS_Y), (const bf16_t*)(ws + WS_WOUT), SEQ, 4096, 4096};
        Sched2 S; S.c = (int)blockIdx.x;
        Epi3 E{a.out, (bf16_t*)(ws + WS_T0), (float*)(ws + WS_SS), a.in[0], a.in[18], xbar};
        pg8::gemm_phase<Epi3, Sched2, true, true>(lds, g, S, E);
    } }
#if N_LAUNCHES != 1
    if (lo >= 7 && lo < 10) phase2(a, lds, 1 << (lo - 7));
    if (lo == 11 || lo == 12) {
        pg8::Gemm g{(const bf16_t*)(ws + WS_U), (const bf16_t*)(ws + WS_WT), SEQ + NMEM, INW + 2048, 4096};
        Sched1 S; S.init((int)gridDim.x, (int)blockIdx.x); if (lo == 11) S.imax = 4; else S.ioff = 4;
        Epi1 E{(bf16_t*)(ws + WS_PROJ), (bf16_t*)(ws + WS_VT), (bf16_t*)(ws + WS_MK), (bf16_t*)(ws + WS_MVT), (const float*)(ws + WS_ROPE)};
        pg8::gemm_phase<Epi1, Sched1, true, true>(lds, g, S, E);
    }
    if (lo == 13) {
        pg8::Gemm g{(const bf16_t*)(ws + WS_U), (const bf16_t*)(ws + WS_WT), SEQ + NMEM, INW + 2048, 4096};
        Sched1 S; S.init((int)gridDim.x, (int)blockIdx.x); S.imax = 4;
        pg8::EpiBf16<0> E{(bf16_t*)(ws + WS_HS), INW, nullptr, 0, 0, 1.f};
        pg8::gemm_phase<pg8::EpiBf16<0>, Sched1, true, true>(lds, g, S, E);
    }
#ifdef LRUVAR
    if (lo == 10) lru_phase<LRUVAR>(lds, a, (int)(blockIdx.x & 7), (int)(blockIdx.x >> 3), (int)(gridDim.x >> 3));
#endif
#endif
#undef IN
#undef SEAM
}

extern "C" void kernel_launch(void* const* d_in, const int* in_sizes, int n_in, void* d_out, int out_size, void* d_ws, size_t ws_size, hipStream_t stream) {
    static int grid = 0;
    if (grid == 0) {
        if (n_in != 19 || ws_size < WS_END) { fprintf(stderr, "kernel_launch: unexpected n_in %d or ws_size %zu (need %zu)\n", n_in, ws_size, (size_t)WS_END); grid = -1; return; }
        int dev = 0, cus = 0, per_cu = 0;
        hipGetDevice(&dev); hipDeviceGetAttribute(&cus, hipDeviceAttributeMultiprocessorCount, dev);
        if (hipFuncSetAttribute((const void*)mega, hipFuncAttributeMaxDynamicSharedMemorySize, LDS_BYTES) != hipSuccess) { fprintf(stderr, "kernel_launch: hipFuncSetAttribute failed\n"); grid = -1; return; }
        if (hipOccupancyMaxActiveBlocksPerMultiprocessor(&per_cu, (const void*)mega, 512, LDS_BYTES) != hipSuccess || per_cu < 1) { fprintf(stderr, "kernel_launch: occupancy query says %d\n", per_cu); per_cu = 1; }
        (void)hipGetLastError();
        if (cus < 256) { fprintf(stderr, "kernel_launch: needs 256 CUs (one workgroup per CU), device has %d\n", cus); grid = -1; return; }
        grid = 256;
    }
    if (grid < 0) return;
    Args a{};
    for (int i = 0; i < 19; ++i) a.in[i] = (const float*)d_in[i];
    a.out = (float*)d_out; a.ws = (unsigned char*)d_ws;
#if N_LAUNCHES == 1
    (void)hipMemsetAsync((char*)d_ws + WS_CTL, 0, 65536, stream);
    a.ph_lo = 0; a.ph_hi = NPH;
    void* args[] = {&a};
    hipError_t e = hipLaunchCooperativeKernel((const void*)mega, dim3(grid), dim3(512), args, LDS_BYTES, stream);
    if (e != hipSuccess) fprintf(stderr, "cooperative launch failed: %s (grid %d)\n", hipGetErrorString(e), grid);
#else
#ifndef PHSEQ
#define PHSEQ 0,1,2,3,4,5,6
#endif
    { const int seq[] = {PHSEQ};
      for (unsigned i = 0; i < sizeof(seq) / sizeof(int); ++i) { a.ph_lo = seq[i]; a.ph_hi = seq[i] + 1; (void)hipMemsetAsync((char*)d_ws + WS_CTL, 0, 65536, stream); hipLaunchKernelGGL(mega, dim3(grid), dim3(512), LDS_BYTES, stream, a); } }
#endif
}
```

```cpp
#include <hip/hip_runtime.h>
#include <hip/hip_cooperative_groups.h>
#include <cstdio>
#include <cstdint>
namespace cg = cooperative_groups;
#define N_LAUNCHES 1
namespace pg8 {
#define PG8_LAS __attribute__((address_space(3)))
typedef unsigned short bf16_t;
typedef short bf16x8 __attribute__((ext_vector_type(8)));
typedef float f32x4 __attribute__((ext_vector_type(4)));
typedef unsigned u32x4 __attribute__((ext_vector_type(4)));
constexpr int BM = 256, BK = 64, HALF = 128, HTB = HALF * BK * 2  , STAGE_BYTES = 8 * HTB, NXCD = 8, WGM = 8;

__host__ __device__ __forceinline__ int lds_byte(int r, int c) { const int st = (r >> 4) * 2 + (c >> 5), rr = r & 15, cc = c & 31, ob = rr * 64 + cc * 2; return st * 1024 + (ob ^ (((ob >> 9) & 1) << 5)); }
__host__ __device__ __forceinline__ void stage_rc(int b, int& R, int& C) { const int st = b / 1024, sb = b % 1024, swz = sb ^ (((sb >> 9) & 1) << 5); R = (st >> 1) * 16 + swz / 64; C = (st & 1) * 32 + (swz % 64) / 2; }
__host__ __device__ __forceinline__ int perm32(int rho) { const int n = rho >> 4, i = rho & 15; return 8 * (i >> 2) + 4 * n + (i & 3); }

struct Unit { int pm, pn; };
struct Gemm { const bf16_t* A; const bf16_t* Bt; int M, N, K; };

struct StaticOrder {
    int nM, nN, nwg, G, c;
    __host__ __device__ void init(int M, int N, int G_, int c_) { nM = M / BM; nN = N / BM; nwg = nM * nN; G = G_; c = c_; }
    __host__ __device__ bool next(int i, Unit& u) const {
        const long L = (long)i * G + c; if (L >= nwg) return false;
        int wgid = (int)L; { const int q = nwg / NXCD, r = nwg % NXCD, xcd = wgid % NXCD, off = wgid / NXCD; wgid = (xcd < r ? xcd * (q + 1) : r * (q + 1) + (xcd - r) * q) + off; }
        const int nig = WGM * nN, gid = wgid / nig, fm = gid * WGM, gsz = (nM - fm) < WGM ? (nM - fm) : WGM;
        u.pm = fm + ((wgid % nig) % gsz); u.pn = (wgid % nig) / gsz; return true;
    }
    __device__ __forceinline__ void a_ready(const Unit&) const {}
    __device__ __forceinline__ void done(const Unit&) const {}
};

__device__ __forceinline__ unsigned cvt_pk_bf16(float lo, float hi) { unsigned r; asm volatile("v_cvt_pk_bf16_f32 %0, %1, %2" : "=v"(r) : "v"(lo), "v"(hi)); return r; }
typedef float f32x2 __attribute__((ext_vector_type(2)));
__device__ __forceinline__ f32x2 gelu_pk(f32x2 v) {
    const f32x2 av = __builtin_elementwise_abs(v), d = av * 0.2316418882f + 1.0f;
    f32x2 t; t.x = __builtin_amdgcn_rcpf(d.x); t.y = __builtin_amdgcn_rcpf(d.y);
    f32x2 q = t * 0.5307027145f + (-0.7265760135f); q = q * t + 0.7107068705f; q = q * t + (-0.142248368f); q = q * t + 0.127414796f; q = q * t;
    const f32x2 s = (v * v) * (-0.72134752044f);
    f32x2 e; e.x = __builtin_amdgcn_exp2f(s.x); e.y = __builtin_amdgcn_exp2f(s.y);
    const f32x2 m = v * (q * e), r = v - m;
    f32x2 o; o.x = v.x < 0.f ? m.x : r.x; o.y = v.y < 0.f ? m.y : r.y; return o;
}

template <int ACT  > struct EpiBf16 {
    static constexpr bool PERM = true, AFTER_DRAIN = false, HOLD_LAST = false; static_assert(ACT == 0 || ACT == 1, "EpiBf16: ACT is 0 (none) or 1 (gelu_pk)");
    bf16_t* O; int ldc; const float* bias; int split_cols; size_t split_stride; float scale0;
    __device__ __forceinline__ void operator()(const f32x4 (&acc)[2][2][4][2], const Unit& u, int wr, int wc, int fr, int fq) const {
        const int row0 = u.pm * BM + wr * 64 + fr; int colt = u.pn * BM; bf16_t* base = O;
        float sc = 1.f; if (split_cols) { const int t = colt / split_cols; base += (size_t)t * split_stride; colt -= t * split_cols; if (t == 0) sc = scale0; }
        const int col0 = colt + wc * 32 + 8 * fq, bcol0 = u.pn * BM + wc * 32 + 8 * fq;
        f32x4 bv[2][2];
#pragma unroll
        for (int bj = 0; bj < 2; ++bj)
#pragma unroll
            for (int n = 0; n < 2; ++n) bv[bj][n] = bias ? *(const f32x4*)(bias + bcol0 + bj * HALF + 4 * n) : (f32x4){0.f, 0.f, 0.f, 0.f};
#pragma unroll
        for (int ai = 0; ai < 2; ++ai)
#pragma unroll
            for (int m = 0; m < 4; ++m) { bf16_t* rowp = base + (size_t)(row0 + ai * HALF + m * 16) * ldc + col0;
#pragma unroll
                for (int bj = 0; bj < 2; ++bj) { f32x4 v0 = acc[ai][bj][m][0] + bv[bj][0], v1 = acc[ai][bj][m][1] + bv[bj][1];
                    if (ACT == 1) { f32x2 a = gelu_pk((f32x2){v0[0], v0[1]}), b = gelu_pk((f32x2){v0[2], v0[3]}), c = gelu_pk((f32x2){v1[0], v1[1]}), d = gelu_pk((f32x2){v1[2], v1[3]});
                        v0 = (f32x4){a.x, a.y, b.x, b.y}; v1 = (f32x4){c.x, c.y, d.x, d.y}; }
                    v0 = v0 * sc; v1 = v1 * sc; u32x4 w; w.x = cvt_pk_bf16(v0[0], v0[1]); w.y = cvt_pk_bf16(v0[2], v0[3]); w.z = cvt_pk_bf16(v1[0], v1[1]); w.w = cvt_pk_bf16(v1[2], v1[3]);
                    *(u32x4*)(rowp + bj * HALF) = w; } }
    }
};
template <class Epi, class Sched, bool ALIGN_EPI = false, bool SP2 = false>
__device__ __forceinline__ void gemm_phase(PG8_LAS unsigned char* lds, const Gemm g, const Sched& S, const Epi& E) {
    int tid_ = threadIdx.x; asm volatile("" : "+v"(tid_)); const int tid = tid_, wid = __builtin_amdgcn_readfirstlane(tid >> 6), lane = tid & 63, wr = wid >> 2, wc = wid & 3, fr = lane & 15, fq = lane >> 4;
    const int K = g.K, nt = K / BK;
    unsigned voffA[2], voffB[2];
#pragma unroll
    for (int i = 0; i < 2; ++i) { int R, C; stage_rc(tid * 16 + i * 8192, R, C); const int Rb = Epi::PERM ? ((R & ~31) + perm32(R & 31)) : R;
        voffA[i] = (unsigned)(R * K + C) * 2u; voffB[i] = (unsigned)(Rb * K + C) * 2u; }
    const size_t kstep = (size_t)(BK * 2);
    const size_t hstep = (size_t)HALF * K * 2;
    const size_t tstep = 2 * hstep;
    const unsigned ldsw = (unsigned)wid * 1024u;
    const int aoff = lds_byte(wr * 64 + fr, fq * 8), boff = lds_byte(wc * 32 + fr, fq * 8);
#define PG8_SA(b, h) (((b) * 2 + (h)) * HTB)
#define PG8_SB(b, h) ((4 + (b) * 2 + (h)) * HTB)
#define PG8_STAGE(bufoff, gbase, voff) do { _Pragma("unroll") for (int _i = 0; _i < 2; ++_i) \
        __builtin_amdgcn_global_load_lds((const unsigned*)((const char*)(gbase) + (voff)[_i]), (PG8_LAS unsigned*)(lds + (bufoff) + ldsw + _i * 8192), 16, 0, 0); } while (0)
#define PG8_LDA(dst, b, h) do { _Pragma("unroll") for (int m = 0; m < 4; ++m) _Pragma("unroll") for (int k = 0; k < 2; ++k) dst[m][k] = *(const PG8_LAS bf16x8*)(lds + PG8_SA(b, h) + aoff + m * 2048 + k * 1024); } while (0)
#define PG8_LDB(dst, b, h) do { _Pragma("unroll") for (int n = 0; n < 2; ++n) _Pragma("unroll") for (int k = 0; k < 2; ++k) dst[n][k] = *(const PG8_LAS bf16x8*)(lds + PG8_SB(b, h) + boff + n * 2048 + k * 1024); } while (0)
#define PG8_MMA(ai, bj, At, Bt) do { __builtin_amdgcn_s_setprio(1); _Pragma("unroll") for (int m = 0; m < 4; ++m) _Pragma("unroll") for (int n = 0; n < 2; ++n) _Pragma("unroll") for (int k = 0; k < 2; ++k) \
        acc[ai][bj][m][n] = __builtin_amdgcn_mfma_f32_16x16x32_bf16(Bt[n][k], At[m][k], acc[ai][bj][m][n], 0, 0, 0); __builtin_amdgcn_s_setprio(0); } while (0)
#define PG8_WAIT_V(n) asm volatile("s_waitcnt vmcnt(" #n ")" ::: "memory")
#define PG8_WAIT_L(n) asm volatile("s_waitcnt lgkmcnt(" #n ")" ::: "memory")
#define PG8_BAR __builtin_amdgcn_s_barrier()
#define PG8_SCHED __builtin_amdgcn_sched_barrier(0)
    Unit cur, nxt; int ui = 0;
    if (!S.next(0, cur)) return;
    f32x4 acc[2][2][4][2];
#pragma unroll
    for (int a = 0; a < 2; ++a)
#pragma unroll
        for (int b = 0; b < 2; ++b)
#pragma unroll
            for (int m = 0; m < 4; ++m)
#pragma unroll
                for (int n = 0; n < 2; ++n) acc[a][b][m][n] = (f32x4){0.f, 0.f, 0.f, 0.f};
    bf16x8 At[4][2], B0[2][2], B1[2][2];
    const char* cA = (const char*)g.A + (size_t)cur.pm * tstep; const char* cB = (const char*)g.Bt + (size_t)cur.pn * tstep;
    S.a_ready(cur);
    if constexpr (SP2) {
        PG8_STAGE(PG8_SB(0, 0), cB, voffB); PG8_STAGE(PG8_SB(0, 1), cB + hstep, voffB); PG8_STAGE(PG8_SA(0, 0), cA, voffA); PG8_STAGE(PG8_SA(0, 1), cA + hstep, voffA);
        if (wr == 1) PG8_BAR;
        PG8_WAIT_V(2); PG8_BAR;
        PG8_STAGE(PG8_SB(1, 0), cB + kstep, voffB); PG8_STAGE(PG8_SA(1, 0), cA + kstep, voffA); PG8_STAGE(PG8_SB(1, 1), cB + hstep + kstep, voffB);
        PG8_WAIT_V(6); PG8_BAR;
    } else {
        PG8_STAGE(PG8_SB(0, 0), cB, voffB); PG8_STAGE(PG8_SA(0, 0), cA, voffA); PG8_STAGE(PG8_SB(0, 1), cB + hstep, voffB); PG8_STAGE(PG8_SA(0, 1), cA + hstep, voffA);
        if (wr == 1) PG8_BAR;
        PG8_WAIT_V(4); PG8_BAR;
        PG8_STAGE(PG8_SB(1, 0), cB + kstep, voffB); PG8_STAGE(PG8_SA(1, 0), cA + kstep, voffA); PG8_STAGE(PG8_SB(1, 1), cB + hstep + kstep, voffB);
        PG8_WAIT_V(6); PG8_BAR;
    }
    for (;;) {
        const bool has_next = S.next(ui + 1, nxt);
        const char* nA = has_next ? (const char*)g.A + (size_t)nxt.pm * tstep : cA; const char* nB = has_next ? (const char*)g.Bt + (size_t)nxt.pn * tstep : cB;
        for (int t = 0; t < nt; t += 2) {
            const bool last = (t == nt - 2);
            const char* a1 = cA + (size_t)(t + 1) * kstep;
            const char* a2 = last ? nA : cA + (size_t)(t + 2) * kstep; const char* b2 = last ? nB : cB + (size_t)(t + 2) * kstep;
            const char* a3 = a2 + kstep; const char* b3 = b2 + kstep;
            if (last && has_next) S.a_ready(nxt);
            if constexpr (SP2) {
            PG8_LDB(B0, 0, 0); PG8_LDB(B1, 0, 1); PG8_SCHED; PG8_LDA(At, 0, 0); PG8_STAGE(PG8_SA(1, 1), a1 + hstep, voffA);
            PG8_WAIT_V(8); PG8_WAIT_L(0); PG8_BAR; PG8_MMA(0, 0, At, B0); PG8_MMA(0, 1, At, B1); PG8_BAR; PG8_SCHED;
            PG8_LDA(At, 0, 1); PG8_STAGE(PG8_SB(0, 0), b2, voffB); PG8_STAGE(PG8_SB(0, 1), b2 + hstep, voffB); PG8_STAGE(PG8_SA(0, 0), a2, voffA);
            PG8_WAIT_V(8); PG8_WAIT_L(0); PG8_BAR; PG8_MMA(1, 0, At, B0); PG8_MMA(1, 1, At, B1); PG8_BAR; PG8_SCHED;
            PG8_LDB(B0, 1, 0); PG8_LDB(B1, 1, 1); PG8_SCHED; PG8_LDA(At, 1, 0); PG8_STAGE(PG8_SA(0, 1), a2 + hstep, voffA);
            PG8_WAIT_V(8); PG8_WAIT_L(0); PG8_BAR; PG8_MMA(0, 0, At, B0); PG8_MMA(0, 1, At, B1); PG8_BAR; PG8_SCHED;
            PG8_LDA(At, 1, 1); PG8_STAGE(PG8_SB(1, 0), b3, voffB); PG8_STAGE(PG8_SB(1, 1), b3 + hstep, voffB); PG8_STAGE(PG8_SA(1, 0), a3, voffA);
            PG8_WAIT_V(8); PG8_WAIT_L(0); PG8_BAR; PG8_MMA(1, 0, At, B0); PG8_MMA(1, 1, At, B1); PG8_BAR; PG8_SCHED;
            } else {
            PG8_LDB(B0, 0, 0); PG8_SCHED; PG8_LDA(At, 0, 0); PG8_STAGE(PG8_SA(1, 1), a1 + hstep, voffA);
            PG8_WAIT_L(8); PG8_BAR; PG8_WAIT_L(0); PG8_MMA(0, 0, At, B0); PG8_BAR; PG8_SCHED;
            PG8_LDB(B1, 0, 1); PG8_STAGE(PG8_SB(0, 0), b2, voffB);
            PG8_BAR; PG8_WAIT_L(0); PG8_MMA(0, 1, At, B1); PG8_BAR;
            PG8_LDA(At, 0, 1); PG8_STAGE(PG8_SA(0, 0), a2, voffA);
            PG8_BAR; PG8_WAIT_L(0); PG8_MMA(1, 0, At, B0); PG8_BAR; PG8_SCHED;
            PG8_STAGE(PG8_SB(0, 1), b2 + hstep, voffB);
            PG8_WAIT_V(6); PG8_BAR; PG8_MMA(1, 1, At, B1); PG8_BAR;
            PG8_LDB(B0, 1, 0); PG8_SCHED; PG8_LDA(At, 1, 0); PG8_STAGE(PG8_SA(0, 1), a2 + hstep, voffA);
            PG8_WAIT_L(8); PG8_BAR; PG8_WAIT_L(0); PG8_MMA(0, 0, At, B0); PG8_BAR; PG8_SCHED;
            PG8_LDB(B1, 1, 1); PG8_STAGE(PG8_SB(1, 0), b3, voffB);
            PG8_BAR; PG8_WAIT_L(0); PG8_MMA(0, 1, At, B1); PG8_BAR;
            PG8_LDA(At, 1, 1); PG8_STAGE(PG8_SA(1, 0), a3, voffA);
            PG8_BAR; PG8_WAIT_L(0); PG8_MMA(1, 0, At, B0); PG8_BAR; PG8_SCHED;
            PG8_STAGE(PG8_SB(1, 1), b3 + hstep, voffB);
            PG8_WAIT_V(6); PG8_BAR; PG8_MMA(1, 1, At, B1); PG8_BAR;
            }
        }
        if constexpr (ALIGN_EPI) { if (wr == 0) PG8_BAR; }
        if constexpr (!Epi::AFTER_DRAIN) { if (!Epi::HOLD_LAST || has_next) { E(acc, cur, wr, wc, fr, fq); S.done(cur); } }
        if (!has_next) break;
#pragma unroll
        for (int a = 0; a < 2; ++a)
#pragma unroll
            for (int b = 0; b < 2; ++b)
#pragma unroll
                for (int m = 0; m < 4; ++m)
#pragma unroll
                    for (int n = 0; n < 2; ++n) acc[a][b][m][n] = (f32x4){0.f, 0.f, 0.f, 0.f};
        cur = nxt; cA = nA; cB = nB; ++ui;
        if constexpr (ALIGN_EPI) { if (wr == 1) PG8_BAR; }
    }
    PG8_WAIT_V(0);
    if constexpr (!ALIGN_EPI) { if (wr == 0) PG8_BAR; }
    PG8_BAR;
    if constexpr (Epi::AFTER_DRAIN || Epi::HOLD_LAST) { E.fused(acc, cur, wr, wc, fr, fq, lds, wid, lane); S.done(cur); }
#undef PG8_SA
#undef PG8_SB
#undef PG8_STAGE
#undef PG8_LDA
#undef PG8_LDB
#undef PG8_MMA
#undef PG8_WAIT_V
#undef PG8_WAIT_L
#undef PG8_BAR
#undef PG8_SCHED
}
}

#ifndef PHMASK
#define PHMASK 127
#endif
#ifndef REPMASK
#define REPMASK 0
#endif
#ifndef P2MASK
#define P2MASK 7
#endif
#ifndef N_LAUNCHES
#define N_LAUNCHES 1
#endif
using pg8::bf16_t; using pg8::bf16x8; using pg8::f32x4; using pg8::u32x4;
#define LAS __attribute__((address_space(3)))
typedef unsigned u32x2 __attribute__((ext_vector_type(2)));
typedef float f32x2 __attribute__((ext_vector_type(2)));

constexpr int SEQ = 8192, DMODEL = 4096, INW = 9216, NMEM = 256;
constexpr int C_QA = 0, C_KA = 2048, C_VA = 2560, C_XL = 3072, C_QM = 4096, C_ZA = 5120, C_ZL = 7168, C_ZM = 8192;
constexpr float EPSN = 1e-6f;
constexpr float LOG2E = 1.4426950408889634f;
constexpr float SC_ATT = 0.08838834764831845f * LOG2E;
constexpr float SC_MEM = 0.0625f * LOG2E;
constexpr int NPH = 7;
constexpr int LDS_BYTES = 147456;

constexpr size_t MiB = 1u << 20;
constexpr size_t WS_CTL = 0, WS_LRUW = 1 * MiB, WS_ROPE = 2 * MiB, WS_MK = 3 * MiB, WS_MVT = 3 * MiB + 512 * 1024, WS_SS = 4 * MiB,
                 WS_AGG1 = 6 * MiB, WS_AGG2 = 10 * MiB, WS_VT = 12 * MiB, WS_WOUT = 20 * MiB, WS_WT = 52 * MiB, WS_U = 140 * MiB,
                 WS_PROJ = 206 * MiB, WS_HS = 350 * MiB, WS_PP = 382 * MiB, WS_YATT = 414 * MiB, WS_YMEM = 446 * MiB, WS_T0 = 462 * MiB, WS_END = 494 * MiB;
constexpr size_t WS_Y = WS_U;

struct Args { const float* in[19]; float* out; unsigned char* ws; int ph_lo, ph_hi; };

__device__ __forceinline__ unsigned pk2(float lo, float hi) { return pg8::cvt_pk_bf16(lo, hi); }
__device__ __forceinline__ float bflo(unsigned u) { return __builtin_bit_cast(float, u << 16); }
__device__ __forceinline__ float bfhi(unsigned u) { return __builtin_bit_cast(float, u & 0xffff0000u); }
template <int CTRL> __device__ __forceinline__ float dpp_mov(float v) { return __uint_as_float(__builtin_amdgcn_update_dpp(0u, __float_as_uint(v), CTRL, 0xF, 0xF, true)); }
__device__ __forceinline__ float xor16_add(float v) { auto r = __builtin_amdgcn_permlane16_swap(__float_as_uint(v), __float_as_uint(v), false, false); return __uint_as_float(r[0]) + __uint_as_float(r[1]); }
__device__ __forceinline__ float xor32_add(float v) { auto r = __builtin_amdgcn_permlane32_swap(__float_as_uint(v), __float_as_uint(v), false, false); return __uint_as_float(r[0]) + __uint_as_float(r[1]); }
__device__ __forceinline__ float xor16_max(float v) { auto r = __builtin_amdgcn_permlane16_swap(__float_as_uint(v), __float_as_uint(v), false, false); return fmaxf(__uint_as_float(r[0]), __uint_as_float(r[1])); }
__device__ __forceinline__ float xor32_max(float v) { auto r = __builtin_amdgcn_permlane32_swap(__float_as_uint(v), __float_as_uint(v), false, false); return fmaxf(__uint_as_float(r[0]), __uint_as_float(r[1])); }
__device__ __forceinline__ float xor32_get(float v, bool upper) { auto r = __builtin_amdgcn_permlane32_swap(__float_as_uint(v), __float_as_uint(v), false, false); return __uint_as_float(upper ? r[0] : r[1]); }
__device__ __forceinline__ float wave_sum(float v) {
    v += dpp_mov<0xB1>(v);
    v += dpp_mov<0x4E>(v);
    v += dpp_mov<0x141>(v);
    v += dpp_mov<0x140>(v);
    v = xor16_add(v); v = xor32_add(v);
    return v;
}
__device__ __forceinline__ float fexp2(float x) { return __builtin_amdgcn_exp2f(x); }
__device__ __forceinline__ float sigmoidf_(float x) { return 1.f / (1.f + __expf(-x)); }
__device__ __forceinline__ float fsigmoid(float x) { return __builtin_amdgcn_rcpf(1.f + __builtin_amdgcn_exp2f(-x * 1.4426950408889634f)); }
__device__ __forceinline__ f32x4 mfma16(bf16x8 a, bf16x8 b, f32x4 c) { return __builtin_amdgcn_mfma_f32_16x16x32_bf16(a, b, c, 0, 0, 0); }

__device__ __forceinline__ void p0_item_load(const float* W, int N, int item, int lane, float (&r)[32]) {
    const int nblk = N / 32, kb = item / nblk, nb = item % nblk, k0 = 64 * kb, n0 = 32 * nb;
#pragma unroll
    for (int i = 0; i < 32; ++i) { const int kk = 2 * i + (lane >> 5); r[i] = __builtin_nontemporal_load(W + (size_t)(k0 + kk) * N + n0 + (lane & 31)); }
}
__device__ __forceinline__ void p0_item_lds_write(LAS float* scr, int lane, const float (&r)[32]) {
#pragma unroll
    for (int i = 0; i < 32; ++i) { const int kk = 2 * i + (lane >> 5); scr[kk * 33 + (lane & 31)] = r[i]; }
}
__device__ __forceinline__ void p0_item_store(int K, int N, bf16_t* WT, int row_off, LAS float* scr, int item, int lane) {
    const int nblk = N / 32, kb = item / nblk, nb = item % nblk, k0 = 64 * kb, n0 = 32 * nb;
    asm volatile("s_waitcnt lgkmcnt(0)" ::: "memory");
    const int c = lane & 7;
#pragma unroll
    for (int j = 0; j < 4; ++j) { const int n = (lane >> 3) + 8 * j; const LAS float* s = scr + (8 * c) * 33 + n;
        u32x4 o; o.x = pk2(s[0 * 33], s[1 * 33]); o.y = pk2(s[2 * 33], s[3 * 33]); o.z = pk2(s[4 * 33], s[5 * 33]); o.w = pk2(s[6 * 33], s[7 * 33]);
        *(u32x4*)(WT + (size_t)(row_off + n0 + n) * K + k0 + 8 * c) = o; }
    asm volatile("s_waitcnt lgkmcnt(0)" ::: "memory");
}
__device__ __forceinline__ void p0_transpose_item(const float* W, int K, int N, bf16_t* WT, int row_off, LAS float* scr, int item, int lane) {
    float r[32]; p0_item_load(W, N, item, lane, r); p0_item_lds_write(scr, lane, r); p0_item_store(K, N, WT, row_off, scr, item, lane);
}
template <bool SEL> __device__ __forceinline__ int win_item(int j) {
    if (SEL) { const int kb = j >> 5, e = j & 31; return kb * (INW / 32) + (e < 16 ? 128 + e : 272 + (e - 16)); }
    else { const int kb = j >> 8, c = j & 255; return kb * (INW / 32) + (c < 128 ? c : c + 16); }
}
template <bool SEL> __device__ __forceinline__ void p0_transpose_win(const float* W, bf16_t* WT, LAS float* scr, int first, int step, int lane) {
    constexpr int NJ = SEL ? 64 * 32 : 64 * 256;
    if (first >= NJ) return;
    float r[32]; p0_item_load(W, INW, win_item<SEL>(first), lane, r);
#pragma unroll 1
    for (int j = first; j < NJ; j += step) {
        p0_item_lds_write(scr, lane, r);
        if (j + step < NJ) p0_item_load(W, INW, win_item<SEL>(j + step), lane, r);
        p0_item_store(4096, INW, WT, 0, scr, win_item<SEL>(j), lane);
    }
}
__device__ __forceinline__ void p0_transpose_matrix(const float* W, int K, int N, bf16_t* WT, int row_off, LAS float* scr, int first, int step, int lane) {
    const int nitems = (K / 64) * (N / 32);
    if (first >= nitems) return;
    float r[32]; p0_item_load(W, N, first, lane, r);
#pragma unroll 1
    for (int it = first; it < nitems; it += step) {
        p0_item_lds_write(scr, lane, r);
        if (it + step < nitems) p0_item_load(W, N, it + step, lane, r);
        p0_item_store(K, N, WT, row_off, scr, it, lane);
    }
}
__device__ __forceinline__ void rms_row_to_bf16(const float* xrow, const f32x4 (&gv)[16], bf16_t* orow, int lane) {
    const f32x4* xr = (const f32x4*)xrow + lane;
    f32x4 v[16]; float s = 0.f;
#pragma unroll
    for (int k = 0; k < 16; ++k) { v[k] = __builtin_nontemporal_load(xr + 64 * k); s += (v[k].x * v[k].x + v[k].y * v[k].y) + (v[k].z * v[k].z + v[k].w * v[k].w); }
    const float rs = 1.f / sqrtf(wave_sum(s) * (1.f / 4096.f) + EPSN);
    u32x2* o8 = (u32x2*)orow + lane;
#pragma unroll
    for (int k = 0; k < 16; ++k) { const f32x4 g4 = gv[k]; u32x2 o; o.x = pk2(v[k].x * rs * g4.x, v[k].y * rs * g4.y); o.y = pk2(v[k].z * rs * g4.z, v[k].w * rs * g4.w); o8[64 * k] = o; }
}

__device__ __forceinline__ void phase0(const Args& a, LAS unsigned char* lds) {
    int tid = threadIdx.x; asm volatile("" : "+v"(tid)); const int lane = tid & 63, w = tid >> 6, G = gridDim.x;
    const int gw = blockIdx.x * 8 + w, NGW = G * 8;
    unsigned char* ws = a.ws;
    LAS float* scr = (LAS float*)(lds + w * 16384);
    bf16_t* WT = (bf16_t*)(ws + WS_WT); bf16_t* WOUT = (bf16_t*)(ws + WS_WOUT); bf16_t* LRUW = (bf16_t*)(ws + WS_LRUW);
    constexpr int I_IN = 64 * (INW / 32), I_MKV = 64 * (2048 / 32), I_OUT = 64 * (4096 / 32), I_LRU = 32 * 8;
    p0_transpose_win<true>(a.in[3], WT, scr, gw, NGW, lane);
    p0_transpose_matrix(a.in[13], 4096, 2048, WT, INW, scr, gw, NGW, lane);
    for (int r = gw; r < I_LRU; r += NGW) {
        const int mat = r >> 3, sub = r & 7, gate = mat >> 4, dn = mat & 15;
        const float* src = (gate ? a.in[9] : a.in[7]) + (size_t)dn * 16384;
        p0_transpose_item(src, 128, 128, LRUW + (size_t)mat * 16384, 0, scr, sub, lane);
    }
    bf16_t* U = (bf16_t*)(ws + WS_U);
    { f32x4 gv[16];
#pragma unroll
      for (int k = 0; k < 16; ++k) gv[k] = ((const f32x4*)a.in[2])[lane + 64 * k];
      if (G == 256) { const int b = (int)blockIdx.x, r0 = 8 * b + ((b * (b - 1) * 6168) >> 16), r1 = (b == 255) ? SEQ : 8 * (b + 1) + (((b + 1) * b * 6168) >> 16);
          for (int m = r0 + w; m < r1; m += 8) rms_row_to_bf16(a.in[0] + (size_t)m * 4096, gv, U + (size_t)m * 4096, lane); }
      else { for (int m = gw; m < SEQ; m += NGW) rms_row_to_bf16(a.in[0] + (size_t)m * 4096, gv, U + (size_t)m * 4096, lane); }
#pragma unroll
      for (int k = 0; k < 16; ++k) gv[k] = ((const f32x4*)a.in[12])[lane + 64 * k];
      for (int m = gw; m < NMEM; m += NGW) rms_row_to_bf16(a.in[1] + (size_t)m * 4096, gv, U + (size_t)(SEQ + m) * 4096, lane); }
    f32x2* rope = (f32x2*)(ws + WS_ROPE);
    for (int e = blockIdx.x * 512 + tid; e < SEQ * 16; e += G * 512) {
        const int pos = e >> 4, i = e & 15;
        const float inv = powf(500000.0f, -(float)i * (1.0f / 16.0f));
        const float ang = (float)pos * inv;
        rope[e] = (f32x2){cosf(ang), sinf(ang)};
    }
}

struct Sched1 {
    pg8::StaticOrder so; int G, c, ioff, imax;
    __device__ void init(int G_, int c_) { so.init(SEQ, INW, G_, c_); G = G_; c = c_; ioff = 0; imax = 1 << 20; }
    __device__ bool next(int i0, pg8::Unit& u) const {
        if (i0 >= imax) return false;
        const int i = i0 + ioff;
        const long L = (long)i * G + c;
        if (L < 1152) return so.next(i, u);
        if (L < 1160) { u.pm = 32; u.pn = 36 + (int)(L - 1152); return true; }
        return false;
    }
    __device__ __forceinline__ void a_ready(const pg8::Unit&) const {}
    __device__ __forceinline__ void done(const pg8::Unit&) const {}
};
struct Epi1 {
    static constexpr bool PERM = true, AFTER_DRAIN = false, HOLD_LAST = false;
    bf16_t* proj; bf16_t* vt; bf16_t* mk; bf16_t* mvt; const float* rope;
    __device__ __forceinline__ void operator()(const f32x4 (&acc)[2][2][4][2], const pg8::Unit& u, int wr, int wc, int fr, int fq) const {
        const int rloc = wr * 64 + fr, cloc = wc * 32 + 8 * fq;
        if (u.pm == 32) {
            const int t = u.pn - 36;
            if (t < 4) {
#pragma unroll
                for (int ai = 0; ai < 2; ++ai)
#pragma unroll
                    for (int m = 0; m < 4; ++m) { const int row = rloc + ai * 128 + m * 16;
#pragma unroll
                        for (int bj = 0; bj < 2; ++bj) { const f32x4 v0 = acc[ai][bj][m][0], v1 = acc[ai][bj][m][1];
                            u32x4 wv; wv.x = pk2(v0[0], v0[1]); wv.y = pk2(v0[2], v0[3]); wv.z = pk2(v1[0], v1[1]); wv.w = pk2(v1[2], v1[3]);
                            *(u32x4*)(mk + (size_t)row * 1024 + t * 256 + bj * 128 + cloc) = wv; } asm volatile("" ::: "memory"); }
            } else {
#pragma unroll
                for (int ai = 0; ai < 2; ++ai)
#pragma unroll
                    for (int m = 0; m < 4; ++m) { const int row = rloc + ai * 128 + m * 16;
#pragma unroll
                        for (int bj = 0; bj < 2; ++bj)
#pragma unroll
                            for (int n = 0; n < 2; ++n)
#pragma unroll
                                for (int i = 0; i < 4; ++i) { const int col = (t - 4) * 256 + bj * 128 + cloc + 4 * n + i;
                                    mvt[(size_t)col * 256 + row] = (bf16_t)(pk2(acc[ai][bj][m][n][i], 0.f) & 0xffffu); } asm volatile("" ::: "memory"); }
            }
            return;
        }
        const int pn = u.pn, row0 = u.pm * 256 + rloc;
        if (pn == 10 || pn == 11) {
#pragma unroll
            for (int ai = 0; ai < 2; ++ai)
#pragma unroll
                for (int m = 0; m < 4; ++m) { const int row = row0 + ai * 128 + m * 16;
#pragma unroll
                    for (int bj = 0; bj < 2; ++bj)
#pragma unroll
                        for (int n = 0; n < 2; ++n)
#pragma unroll
                            for (int i = 0; i < 4; ++i) { const int col = (pn - 10) * 256 + bj * 128 + cloc + 4 * n + i;
                                vt[(size_t)col * SEQ + row] = (bf16_t)(pk2(acc[ai][bj][m][n][i], 0.f) & 0xffffu); } asm volatile("" ::: "memory"); }
            return;
        }
        float sc = 1.f; if (pn < 8) sc = SC_ATT; else if (pn >= 16 && pn < 20) sc = SC_MEM;
        const bool do_rope = (pn < 10) && (wc == 0);
        const float sgn = (fq < 2) ? -1.f : 1.f;
        f32x4 csA[2][2], cst[2][2];
        if (do_rope) {
#pragma unroll
            for (int n = 0; n < 2; ++n) { const int io = (8 * (fq & 1) + 4 * n) * 2;
                const float* ra = rope + (size_t)row0 * 32 + io; const float* rt = rope + 16 * 32 + io;
                csA[n][0] = *(const f32x4*)ra; csA[n][1] = *(const f32x4*)(ra + 4); cst[n][0] = *(const f32x4*)rt; cst[n][1] = *(const f32x4*)(rt + 4); }
        }
#pragma unroll
        for (int ai = 0; ai < 2; ++ai)
#pragma unroll
            for (int m = 0; m < 4; ++m) { const int row = row0 + ai * 128 + m * 16;
                f32x4 cs[2][2];
                if (do_rope) {
                    const int nrot = (ai == 0 && m == 3) ? 5 : 1;
#pragma unroll
                    for (int n = 0; n < 2; ++n)
#pragma unroll
                        for (int hh = 0; hh < 2; ++hh) { f32x4 cur = csA[n][hh]; cs[n][hh] = cur; const f32x4 t = cst[n][hh];
#pragma unroll
                            for (int rr = 0; rr < 5; ++rr) { if (rr < nrot) { f32x4 nx; nx[0] = cur[0] * t[0] - cur[1] * t[1]; nx[1] = cur[1] * t[0] + cur[0] * t[1]; nx[2] = cur[2] * t[2] - cur[3] * t[3]; nx[3] = cur[3] * t[2] + cur[2] * t[3]; cur = nx; } }
                            csA[n][hh] = cur; }
                }
#pragma unroll
                for (int bj = 0; bj < 2; ++bj) { f32x4 v[2]; v[0] = acc[ai][bj][m][0]; v[1] = acc[ai][bj][m][1];
                    if (do_rope) {
#pragma unroll
                        for (int n = 0; n < 2; ++n) { f32x4 p; p[0] = xor32_get(v[n][0], fq >= 2); p[1] = xor32_get(v[n][1], fq >= 2); p[2] = xor32_get(v[n][2], fq >= 2); p[3] = xor32_get(v[n][3], fq >= 2);
                            f32x4 r; r[0] = v[n][0] * cs[n][0][0] + sgn * p[0] * cs[n][0][1]; r[1] = v[n][1] * cs[n][0][2] + sgn * p[1] * cs[n][0][3];
                            r[2] = v[n][2] * cs[n][1][0] + sgn * p[2] * cs[n][1][1]; r[3] = v[n][3] * cs[n][1][2] + sgn * p[3] * cs[n][1][3]; v[n] = r; }
                    }
                    u32x4 wv; wv.x = pk2(v[0][0] * sc, v[0][1] * sc); wv.y = pk2(v[0][2] * sc, v[0][3] * sc); wv.z = pk2(v[1][0] * sc, v[1][1] * sc); wv.w = pk2(v[1][2] * sc, v[1][3] * sc);
                    __builtin_nontemporal_store(wv, (u32x4*)(proj + (size_t)row * INW + pn * 256 + bj * 128 + cloc)); } asm volatile("" ::: "memory"); }
    }
};

template <int DH, bool PF, bool DB>
__device__ __forceinline__ void attn_unit(LAS unsigned char* lds, const bf16_t* Qp, int ldq, bf16_t* Op, int ldo, const bf16_t* Kg, int ldk, const bf16_t* Vtg, int ldv,
                                          int cb_lo, int cb_hi, int cb_self, float m_init, float l_init) {
    constexpr int PR = DH / 8, KROW = DH * 2, KT = 128 * KROW, VROW = 288, NKI = (128 * PR) / 512, NVI = (DH * 16) / 512, NS = DH / 32, NDT = DH / 16;
    int tid = threadIdx.x; asm volatile("" : "+v"(tid)); const int lane = tid & 63, w = tid >> 6, q = lane & 15, g = lane >> 4;
    const int krow = 8 * (q >> 2) + (q & 3);
    bf16x8 qf[NS];
    { const unsigned qoff = (unsigned)(((16 * w + q) * ldq + 8 * g) * 2);
#pragma unroll
      for (int s = 0; s < NS; ++s) qf[s] = __builtin_nontemporal_load((const bf16x8*)((const char*)Qp + qoff + 64 * s)); }
    f32x4 o[NDT];
#pragma unroll
    for (int dt = 0; dt < NDT; ++dt) o[dt] = (f32x4){0.f, 0.f, 0.f, 0.f};
    float m_run = m_init, l_run = l_init;
    u32x4 kreg[NKI], vreg[NVI];
#define ATT_LOAD(cb) do { const int k0_ = (cb) * 128; \
        const char* kb_ = (const char*)Kg + (size_t)k0_ * ldk * 2; const char* vb_ = (const char*)Vtg + (size_t)k0_ * 2; \
        _Pragma("unroll") for (int it = 0; it < NKI; ++it) { const int e = tid + 512 * it; const int key = e / PR, pc = e % PR; \
            kreg[it] = *(const u32x4*)(kb_ + (unsigned)((key * ldk + pc * 8) * 2)); } \
        _Pragma("unroll") for (int it = 0; it < NVI; ++it) { const int e = tid + 512 * it; const int d = e >> 4, pc = e & 15; \
            vreg[it] = *(const u32x4*)(vb_ + (unsigned)((d * ldv + pc * 8) * 2)); } } while (0)
#define ATT_STORE() do { \
        _Pragma("unroll") for (int it = 0; it < NKI; ++it) { const int e = tid + 512 * it; const int key = e / PR, pc = e % PR; \
            *(LAS u32x4*)(lds + key * KROW + ((pc ^ ((((key >> 3) & 3) << 2) | (key & 3))) * 16)) = kreg[it]; } \
        _Pragma("unroll") for (int it = 0; it < NVI; ++it) { const int e = tid + 512 * it; const int d = e >> 4, pc = e & 15; \
            *(LAS u32x4*)(lds + KT + d * VROW + pc * 16) = vreg[it]; } } while (0)
    if (PF) ATT_LOAD(cb_lo);
    for (int cb = cb_lo; cb < cb_hi; ++cb) {
        if (!PF) ATT_LOAD(cb);
        __syncthreads();
        ATT_STORE();
        __syncthreads();
        if (PF) { if (cb + 1 < cb_hi) ATT_LOAD(cb + 1); }
        f32x4 s[8];
#pragma unroll
        for (int kt = 0; kt < 8; ++kt) s[kt] = (f32x4){0.f, 0.f, 0.f, 0.f};
        {
            bf16x8 ka[DB ? 2 : 1][8];
            if (DB) {
#pragma unroll
                for (int kt = 0; kt < 8; ++kt) ka[0][kt] = *(const LAS bf16x8*)(lds + (32 * (kt >> 1) + 4 * (kt & 1) + krow) * KROW + (((0 + g) ^ q) * 16));
            }
#pragma unroll
            for (int ss = 0; ss < NS; ++ss) {
                if (DB) { if (ss + 1 < NS) {
#pragma unroll
                    for (int kt = 0; kt < 8; ++kt) ka[(ss + 1) & 1][kt] = *(const LAS bf16x8*)(lds + (32 * (kt >> 1) + 4 * (kt & 1) + krow) * KROW + (((4 * (ss + 1) + g) ^ q) * 16)); }
                } else {
#pragma unroll
                    for (int kt = 0; kt < 8; ++kt) ka[0][kt] = *(const LAS bf16x8*)(lds + (32 * (kt >> 1) + 4 * (kt & 1) + krow) * KROW + (((4 * ss + g) ^ q) * 16));
                }
                __builtin_amdgcn_sched_barrier(0);
#pragma unroll
                for (int kt = 0; kt < 8; ++kt) s[kt] = mfma16(ka[DB ? (ss & 1) : 0][kt], qf[ss], s[kt]);
                __builtin_amdgcn_sched_barrier(0);
            }
        }
        if (cb != cb_self && cb_self >= 0) {
            const float sg = (cb < cb_self) ? 1.f : -1.f;
            const float dq = (float)(16 * w + q - 8 * g);
#pragma unroll
            for (int kt = 0; kt < 8; ++kt)
#pragma unroll
                for (int j = 0; j < 4; ++j) { const float v = sg * ((float)(32 * (kt >> 1) + 4 * (kt & 1) + j) - dq); s[kt][j] += fminf(v, 0.f) * 1e30f; }
        }
        float mx = s[0][0];
#pragma unroll
        for (int kt = 0; kt < 8; ++kt)
#pragma unroll
            for (int j = 0; j < 4; ++j) mx = fmaxf(mx, s[kt][j]);
        mx = xor16_max(mx); mx = xor32_max(mx);
        const float m_new = fmaxf(m_run, mx), alpha = fexp2(m_run - m_new); m_run = m_new;
        float rs = 0.f;
#pragma unroll
        for (int kt = 0; kt < 8; ++kt)
#pragma unroll
            for (int j = 0; j < 4; ++j) { const float p = fexp2(s[kt][j] - m_new); s[kt][j] = p; rs += p; }
        rs = xor16_add(rs); rs = xor32_add(rs);
        l_run = l_run * alpha + rs;
        bf16x8 pb[4];
#pragma unroll
        for (int u = 0; u < 4; ++u) { u32x4 t; t.x = pk2(s[2 * u][0], s[2 * u][1]); t.y = pk2(s[2 * u][2], s[2 * u][3]); t.z = pk2(s[2 * u + 1][0], s[2 * u + 1][1]); t.w = pk2(s[2 * u + 1][2], s[2 * u + 1][3]);
            pb[u] = __builtin_bit_cast(bf16x8, t); }
#pragma unroll
        for (int dt = 0; dt < NDT; ++dt) o[dt] = o[dt] * alpha;
        {
            constexpr int NG = (NDT / 8) * 4;
            u32x4 va[DB ? 2 : 1][8];
#define ATT_VLOAD(buf, gi) do { const int u_ = (gi) & 3, d0_ = 8 * ((gi) >> 2); \
            _Pragma("unroll") for (int i = 0; i < 8; ++i) { va[buf][i] = *(const LAS u32x4*)(lds + KT + (16 * (d0_ + i) + q) * VROW + (32 * u_ + 8 * g) * 2); } } while (0)
            if (DB) ATT_VLOAD(0, 0);
#pragma unroll
            for (int gi = 0; gi < NG; ++gi) {
                if (DB) { if (gi + 1 < NG) ATT_VLOAD((gi + 1) & 1, gi + 1); } else ATT_VLOAD(0, gi);
                __builtin_amdgcn_sched_barrier(0);
#pragma unroll
                for (int i = 0; i < 8; ++i) o[8 * (gi >> 2) + i] = mfma16(__builtin_bit_cast(bf16x8, va[DB ? (gi & 1) : 0][i]), pb[gi & 3], o[8 * (gi >> 2) + i]);
                __builtin_amdgcn_sched_barrier(0);
            }
#undef ATT_VLOAD
        }
    }
#undef ATT_LOAD
#undef ATT_STORE
    const float inv = 1.f / l_run;
    const unsigned ooff = (unsigned)(((16 * w + q) * ldo + 4 * g) * 2);
#pragma unroll
    for (int dt = 0; dt < NDT; ++dt) { u32x2 pkv; pkv.x = pk2(o[dt][0] * inv, o[dt][1] * inv); pkv.y = pk2(o[dt][2] * inv, o[dt][3] * inv); *(u32x2*)((char*)Op + ooff + 32 * dt) = pkv; }
}

__device__ __forceinline__ void windowed_stream(LAS unsigned char* lds0, const Args& a) {
    constexpr int DH = 128, PR = 16, KROW = 256, KT = 128 * KROW, VROW = 288, BUFB = KT + DH * VROW, NKI = 4, NVI = 4, NS = 4, NDT = 8;
    static_assert(2 * BUFB <= LDS_BYTES - 64, "two K/V tile buffers must fit under the barrier words");
    int tid = threadIdx.x; asm volatile("" : "+v"(tid)); const int lane = tid & 63, w = tid >> 6, q = lane & 15, g = lane >> 4;
    const int krow = 8 * (q >> 2) + (q & 3);
    unsigned char* ws = a.ws;
    const bf16_t* proj = (const bf16_t*)(ws + WS_PROJ); const bf16_t* vt = (const bf16_t*)(ws + WS_VT); bf16_t* yatt = (bf16_t*)(ws + WS_YATT);
    const int G = (int)gridDim.x;
    if ((int)blockIdx.x >= 1024) return;
    unsigned koff[NKI], voff[NVI], klds[NKI], vlds[NVI];
#pragma unroll
    for (int it = 0; it < NKI; ++it) { const int e = tid + 512 * it, key = e / PR, pc = e % PR; koff[it] = (unsigned)((key * INW + pc * 8) * 2); klds[it] = (unsigned)(key * KROW + ((pc ^ ((((key >> 3) & 3) << 2) | (key & 3))) * 16)); }
#pragma unroll
    for (int it = 0; it < NVI; ++it) { const int e = tid + 512 * it, d = e >> 4, pc = e & 15; voff[it] = (unsigned)((d * SEQ + pc * 8) * 2); vlds[it] = (unsigned)(KT + d * VROW + pc * 16); }
    u32x4 kreg[NKI], vreg[NVI];
#define WS_LOAD(v_, cb_) do { const int kvh_ = ((v_) & 15) >> 2; \
        const char* kb_ = (const char*)proj + ((size_t)((cb_) * 128) * INW + C_KA + kvh_ * 128) * 2; const char* vb_ = (const char*)vt + ((size_t)(kvh_ * 128) * SEQ + (cb_) * 128) * 2; \
        _Pragma("unroll") for (int it = 0; it < NKI; ++it) kreg[it] = *(const u32x4*)(kb_ + koff[it]); \
        _Pragma("unroll") for (int it = 0; it < NVI; ++it) vreg[it] = *(const u32x4*)(vb_ + voff[it]); } while (0)
#define WS_STORE(ldsb_) do { \
        _Pragma("unroll") for (int it = 0; it < NKI; ++it) *(LAS u32x4*)((ldsb_) + klds[it]) = kreg[it]; \
        _Pragma("unroll") for (int it = 0; it < NVI; ++it) *(LAS u32x4*)((ldsb_) + vlds[it]) = vreg[it]; } while (0)
#define WS_LO(v_) ((((v_) >> 4) > 0) ? ((v_) >> 4) - 1 : 0)
#define WS_HI(v_) ((((v_) >> 4) < 63) ? ((v_) >> 4) + 2 : 64)
    int Cv = (int)blockIdx.x, Ccb = WS_LO(Cv);
    int Lv = Cv, Lcb = Ccb; bool Lvalid = true;
#define WS_ADV_L() do { if (Lcb + 1 < WS_HI(Lv)) ++Lcb; else { Lv += G; if (Lv < 1024) Lcb = WS_LO(Lv); else Lvalid = false; } } while (0)
    __syncthreads();
    WS_LOAD(Lv, Lcb); WS_ADV_L();
    WS_STORE(lds0);
    bool have = false;
    if (Lvalid) { WS_LOAD(Lv, Lcb); WS_ADV_L(); have = true; }
    __syncthreads();
    int bsel = 0;
    bf16x8 qf[NS]; f32x4 o[NDT]; float m_run = 0.f, l_run = 1.f;
#pragma unroll 1
    for (;;) {
        const int qblk = Cv >> 4, hq = Cv & 15, lo = WS_LO(Cv), hi = WS_HI(Cv);
        LAS unsigned char* lds = lds0 + bsel * BUFB;
        if (Ccb == lo) {
            const unsigned qoff = (unsigned)(((16 * w + q) * INW + 8 * g) * 2);
            const char* qb = (const char*)proj + ((size_t)(qblk * 128) * INW + C_QA + hq * 128) * 2;
#pragma unroll
            for (int s = 0; s < NS; ++s) qf[s] = __builtin_nontemporal_load((const bf16x8*)(qb + qoff + 64 * s));
#pragma unroll
            for (int dt = 0; dt < NDT; ++dt) o[dt] = (f32x4){0.f, 0.f, 0.f, 0.f};
            m_run = a.in[4][hq] * LOG2E; l_run = 1.f;
        }
        if (have) { WS_STORE(lds0 + (bsel ^ 1) * BUFB); have = false; }
        if (Lvalid) { WS_LOAD(Lv, Lcb); WS_ADV_L(); have = true; }
        f32x4 s[8];
#pragma unroll
        for (int kt = 0; kt < 8; ++kt) s[kt] = (f32x4){0.f, 0.f, 0.f, 0.f};
        {
            bf16x8 ka[2][8];
#pragma unroll
            for (int kt = 0; kt < 8; ++kt) ka[0][kt] = *(const LAS bf16x8*)(lds + (32 * (kt >> 1) + 4 * (kt & 1) + krow) * KROW + (((0 + g) ^ q) * 16));
#pragma unroll
            for (int ss = 0; ss < NS; ++ss) {
                if (ss + 1 < NS) {
#pragma unroll
                    for (int kt = 0; kt < 8; ++kt) ka[(ss + 1) & 1][kt] = *(const LAS bf16x8*)(lds + (32 * (kt >> 1) + 4 * (kt & 1) + krow) * KROW + (((4 * (ss + 1) + g) ^ q) * 16)); }
                __builtin_amdgcn_sched_barrier(0);
#pragma unroll
                for (int kt = 0; kt < 8; ++kt) s[kt] = mfma16(ka[ss & 1][kt], qf[ss], s[kt]);
                __builtin_amdgcn_sched_barrier(0);
            }
        }
        if (Ccb != qblk) {
            const bool prev = Ccb < qblk; const int ud = __builtin_amdgcn_readfirstlane(w) >> 1;
            const float sg = prev ? 1.f : -1.f;
            const float dq = (float)(16 * w + q - 8 * g);
#pragma unroll
            for (int u = 0; u < 4; ++u) {
                if (prev ? (u < ud) : (u > ud)) {
#pragma unroll
                    for (int j = 0; j < 4; ++j) { s[2 * u][j] = -1e30f; s[2 * u + 1][j] = -1e30f; }
                } else if (u == ud) {
#pragma unroll
                    for (int h2 = 0; h2 < 2; ++h2)
#pragma unroll
                        for (int j = 0; j < 4; ++j) { const float v = sg * ((float)(32 * u + 4 * h2 + j) - dq); s[2 * u + h2][j] += fminf(v, 0.f) * 1e30f; }
                }
            }
        }
        float mx = s[0][0];
#pragma unroll
        for (int kt = 0; kt < 8; ++kt)
#pragma unroll
            for (int j = 0; j < 4; ++j) mx = fmaxf(mx, s[kt][j]);
        mx = xor16_max(mx); mx = xor32_max(mx);
        const float m_new = fmaxf(m_run, mx), alpha = fexp2(m_run - m_new); m_run = m_new;
        float rs = 0.f;
#pragma unroll
        for (int kt = 0; kt < 8; ++kt)
#pragma unroll
            for (int j = 0; j < 4; ++j) { const float p = fexp2(s[kt][j] - m_new); s[kt][j] = p; rs += p; }
        rs = xor16_add(rs); rs = xor32_add(rs);
        l_run = l_run * alpha + rs;
        bf16x8 pb[4];
#pragma unroll
        for (int u = 0; u < 4; ++u) { u32x4 t; t.x = pk2(s[2 * u][0], s[2 * u][1]); t.y = pk2(s[2 * u][2], s[2 * u][3]); t.z = pk2(s[2 * u + 1][0], s[2 * u + 1][1]); t.w = pk2(s[2 * u + 1][2], s[2 * u + 1][3]);
            pb[u] = __builtin_bit_cast(bf16x8, t); }
#pragma unroll
        for (int dt = 0; dt < NDT; ++dt) o[dt] = o[dt] * alpha;
        {
            u32x4 va[2][8];
#define WS_VLOAD(buf, gi) do { _Pragma("unroll") for (int i = 0; i < 8; ++i) { va[buf][i] = *(const LAS u32x4*)(lds + KT + (16 * i + q) * VROW + (32 * (gi) + 8 * g) * 2); } } while (0)
            WS_VLOAD(0, 0);
#pragma unroll
            for (int gi = 0; gi < 4; ++gi) {
                if (gi + 1 < 4) WS_VLOAD((gi + 1) & 1, gi + 1);
                __builtin_amdgcn_sched_barrier(0);
#pragma unroll
                for (int i = 0; i < 8; ++i) o[i] = mfma16(__builtin_bit_cast(bf16x8, va[gi & 1][i]), pb[gi], o[i]);
                __builtin_amdgcn_sched_barrier(0);
            }
#undef WS_VLOAD
        }
        bool done = false;
        if (Ccb + 1 < hi) ++Ccb;
        else {
            const float inv = 1.f / l_run;
            char* ob = (char*)yatt + ((size_t)(qblk * 128) * 2048 + hq * 128) * 2;
            const unsigned ooff = (unsigned)(((16 * w + q) * 2048 + 4 * g) * 2);
#pragma unroll
            for (int dt = 0; dt < NDT; ++dt) { u32x2 pkv; pkv.x = pk2(o[dt][0] * inv, o[dt][1] * inv); pkv.y = pk2(o[dt][2] * inv, o[dt][3] * inv); *(u32x2*)(ob + ooff + 32 * dt) = pkv; }
            Cv += G; if (Cv < 1024) Ccb = WS_LO(Cv); else done = true;
        }
        __syncthreads();
        bsel ^= 1;
        if (done) break;
    }
#undef WS_LOAD
#undef WS_STORE
#undef WS_LO
#undef WS_HI
#undef WS_ADV_L
}

constexpr int LR_XCB = 0, LR_TA = 16384, LR_TB = LR_TA + 64 * 528, LR_TH = LR_TB + 64 * 528, LR_AGS = LR_TH + 64 * 528;
template <int VAR>
__device__ __forceinline__ void lru_phase(LAS unsigned char* lds, const Args& a, const int n, const int tt_first, const int tt_step) {
    int tid = threadIdx.x; asm volatile("" : "+v"(tid)); const int lane = tid & 63, w0 = tid >> 6, q0 = lane & 15, g0 = lane >> 4;
    unsigned char* ws = a.ws;
    const bf16_t* proj = (const bf16_t*)(ws + WS_PROJ);
    LAS unsigned char* xcb = lds + LR_XCB;
    LAS float* TA = (LAS float*)(lds + LR_TA); LAS float* TB = (LAS float*)(lds + LR_TB); LAS float* TH = (LAS float*)(lds + LR_TH);
    LAS f32x2* AGS = (LAS f32x2*)(lds + LR_AGS);
    const bf16_t* lruw = (const bf16_t*)(ws + WS_LRUW);
    f32x2* agg1 = (f32x2*)(ws + (VAR ? WS_T0 : WS_AGG1));
    bf16_t* Pout = (bf16_t*)(ws + (VAR ? WS_U + 32 * MiB : WS_PP));
    bf16x8 fa[2][4], fx[2][4];
#pragma unroll
    for (int dir = 0; dir < 2; ++dir) {
        const bf16_t* wa = lruw + (size_t)((0 * 2 + dir) * 8 + n) * 16384 + (16 * w0 + q0) * 128 + 8 * g0;
        const bf16_t* wx = lruw + (size_t)((1 * 2 + dir) * 8 + n) * 16384 + (16 * w0 + q0) * 128 + 8 * g0;
#pragma unroll
        for (int s = 0; s < 4; ++s) { fa[dir][s] = *(const bf16x8*)(wa + 32 * s); fx[dir][s] = *(const bf16x8*)(wx + 32 * s); }
    }
    const int cg8 = tid & 15, t2 = tid >> 4, ch0 = n * 128 + cg8 * 8;
    LAS float* CW = (LAS float*)(lds + LR_AGS + 4096);
    __syncthreads();
    if (tid < 128) {
#pragma unroll
        for (int j = 0; j < 4; ++j) CW[j * 128 + tid] = a.in[5][j * 1024 + n * 128 + tid];
        CW[512 + tid] = a.in[6][n * 128 + tid];
    } else if (tid < 384) {
        const int d2 = (tid - 128) >> 7, c = tid & 127, cg = d2 * 1024 + n * 128 + c;
        const float xl = -a.in[11][cg];
        CW[640 + (d2 * 3 + 0) * 128 + c] = a.in[8][cg]; CW[640 + (d2 * 3 + 1) * 128 + c] = a.in[10][cg];
        CW[640 + (d2 * 3 + 2) * 128 + c] = fmaxf(xl, 0.f) + log1pf(expf(-fabsf(xl)));
    }
    u32x4 xr[5];
#define LRU_XLOAD(tt_) do { _Pragma("unroll") for (int r = 0; r < 5; ++r) { const int t = (tt_) * 64 + 2 * t2 - 2 + r; xr[r] = (u32x4){0u, 0u, 0u, 0u}; \
        if (t >= 0 && t < SEQ) xr[r] = __builtin_nontemporal_load((const u32x4*)((const char*)proj + (unsigned)((t * INW + C_XL + ch0) * 2))); } } while (0)
    float A2f = 1.f, H2f = 0.f, A2b = 1.f, H2b = 0.f;
    LRU_XLOAD(tt_first);
#pragma unroll 1
    for (int tt = tt_first; tt < tt_first + 4; ++tt) {
    const int t0 = tt * 64;
    __syncthreads();
    {
        float xin[5][8];
#pragma unroll
        for (int r = 0; r < 5; ++r) { const u32x4 v = xr[r];
            xin[r][0] = bflo(v.x); xin[r][1] = bfhi(v.x); xin[r][2] = bflo(v.y); xin[r][3] = bfhi(v.y); xin[r][4] = bflo(v.z); xin[r][5] = bfhi(v.z); xin[r][6] = bflo(v.w); xin[r][7] = bfhi(v.w); }
        float wv[4][8], bias[8];
#pragma unroll
        for (int j = 0; j < 4; ++j) { const f32x4 w0 = *(const LAS f32x4*)(CW + j * 128 + cg8 * 8), w1 = *(const LAS f32x4*)(CW + j * 128 + cg8 * 8 + 4);
            wv[j][0] = w0[0]; wv[j][1] = w0[1]; wv[j][2] = w0[2]; wv[j][3] = w0[3]; wv[j][4] = w1[0]; wv[j][5] = w1[1]; wv[j][6] = w1[2]; wv[j][7] = w1[3]; }
        { const f32x4 b0 = *(const LAS f32x4*)(CW + 512 + cg8 * 8), b1 = *(const LAS f32x4*)(CW + 512 + cg8 * 8 + 4);
          bias[0] = b0[0]; bias[1] = b0[1]; bias[2] = b0[2]; bias[3] = b0[3]; bias[4] = b1[0]; bias[5] = b1[1]; bias[6] = b1[2]; bias[7] = b1[3]; }
#pragma unroll
        for (int o = 0; o < 2; ++o) { float y[8];
#pragma unroll
            for (int e = 0; e < 8; ++e) { float v = bias[e];
#pragma unroll
                for (int j = 0; j < 4; ++j) v += wv[j][e] * xin[o + j][e];
                y[e] = v; }
            const int tok = 2 * t2 + o;
            u32x4 pk; pk.x = pk2(y[0], y[1]); pk.y = pk2(y[2], y[3]); pk.z = pk2(y[4], y[5]); pk.w = pk2(y[6], y[7]);
            *(LAS u32x4*)(xcb + tok * 256 + ((cg8 ^ (tok & 15)) * 16)) = pk; }
    }
    if (tt + 1 < tt_first + 4) LRU_XLOAD(tt + 1);
    __syncthreads();
    float hreg[16];
    int tl = tid; asm volatile("" : "+v"(tl));
    const int q = tl & 15, g = (tl >> 4) & 3, w = tl >> 6, chl = 16 * w + 4 * g;
    const int ch = 16 * w + q, sub = g;
#pragma unroll
    for (int dir = 0; dir < 2; ++dir) {
        LAS float* TAd = dir ? TH : TA;
        if (VAR != 3) {
            const f32x4 ba = *(const LAS f32x4*)(CW + 640 + (dir * 3 + 0) * 128 + chl), bx = *(const LAS f32x4*)(CW + 640 + (dir * 3 + 1) * 128 + chl), sp = *(const LAS f32x4*)(CW + 640 + (dir * 3 + 2) * 128 + chl);
#pragma unroll
            for (int tk = 0; tk < 4; ++tk) { const int tok = 16 * tk + q;
                f32x4 ar = (f32x4){0.f, 0.f, 0.f, 0.f}, ai = (f32x4){0.f, 0.f, 0.f, 0.f};
#pragma unroll
                for (int s = 0; s < 4; ++s) {
                    const bf16x8 xb = *(const LAS bf16x8*)(xcb + tok * 256 + (((4 * s + g) ^ q) * 16));
                    ar = mfma16(fa[dir][s], xb, ar); ai = mfma16(fx[dir][s], xb, ai); }
                const u32x2 xr2 = *(const LAS u32x2*)(xcb + tok * 256 + ((((chl >> 3)) ^ q) * 16) + (chl & 7) * 2);
                const float xc0 = bflo(xr2.x), xc1 = bfhi(xr2.x), xc2 = bflo(xr2.y), xc3 = bfhi(xr2.y);
                f32x4 av, bv;
#pragma unroll
                for (int j = 0; j < 4; ++j) { if (VAR == 1) { av[j] = ar[j] + ba[j] + sp[j]; bv[j] = ai[j] + bx[j] + (j == 0 ? xc0 : (j == 1 ? xc1 : (j == 2 ? xc2 : xc3))); continue; }
                    const float r = fsigmoid(ar[j] + ba[j]), ii = fsigmoid(ai[j] + bx[j]);
                    const float la = -8.0f * r * sp[j]; const float aa = fexp2(la * LOG2E); av[j] = aa;
                    const float x2 = 2.0f * la;
                    const float poly = x2 * (1.f + x2 * (0.5f + x2 * ((1.f / 6.f) + x2 * ((1.f / 24.f) + x2 * (1.f / 120.f)))));
                    const float om = (x2 > -0.25f) ? -poly : (1.f - aa * aa);
                    const float xcj = j == 0 ? xc0 : (j == 1 ? xc1 : (j == 2 ? xc2 : xc3));
                    bv[j] = __builtin_amdgcn_sqrtf(om) * ii * xcj; }
                *(LAS f32x4*)(TAd + tok * 132 + chl) = av; *(LAS f32x4*)(TB + tok * 132 + chl) = bv; }
        }
        asm volatile("s_waitcnt lgkmcnt(0)" ::: "memory");
        if (VAR != 2 && VAR != 3) {
            float h = 0.f, P = 1.f;
#pragma unroll
            for (int i = 0; i < 16; ++i) { const int t = 16 * sub + (dir ? 15 - i : i);
                const float av = TAd[t * 132 + ch], bv = TB[t * 132 + ch]; h = av * h + bv; P *= av; TB[t * 132 + ch] = h; TAd[t * 132 + ch] = P; }
            AGS[sub * 128 + ch] = (f32x2){P, h};
        }
        asm volatile("s_waitcnt lgkmcnt(0)" ::: "memory");
        if (VAR == 2 || VAR == 3) {
#pragma unroll
            for (int i = 0; i < 16; ++i) hreg[i] = 0.f;
        } else {
            float hc = 0.f, Pp = 1.f, At = 1.f, Ht = 0.f;
#pragma unroll
            for (int s = 0; s < 4; ++s) { const int s2 = dir ? 3 - s : s; const f32x2 e = AGS[s2 * 128 + ch];
                const bool before = dir ? (s2 > sub) : (s2 < sub);
                if (before) { hc = e.x * hc + e.y; Pp *= e.x; }
                Ht = e.x * Ht + e.y; At *= e.x; }
#pragma unroll
            for (int i = 0; i < 16; ++i) { const int t = 16 * sub + i;
                const float Pl = TAd[t * 132 + ch], hl = TB[t * 132 + ch];
                const float hfull = hl + Pl * hc;
                if (dir == 0) hreg[i] = hfull; else hreg[i] += hfull;
                TAd[t * 132 + ch] = Pl * Pp; }
            if (sub == 0) agg1[(size_t)(dir * 1024 + n * 128 + ch) * 128 + tt] = (f32x2){At, Ht};
            if (dir == 0) { H2f = At * H2f + Ht; A2f *= At; }
            else { H2b = A2b * Ht + H2b; A2b *= At; }
        }
        asm volatile("s_waitcnt lgkmcnt(0)" ::: "memory");
    }
#pragma unroll
    for (int i = 0; i < 16; ++i) TB[(16 * sub + i) * 132 + ch] = hreg[i];
    __syncthreads();
    {
        float* hs = (float*)(ws + (VAR ? WS_U : WS_HS));
#pragma unroll
        for (int i = 0; i < 4; ++i) { const int e = tid + 512 * i, t = e >> 5, c4 = e & 31;
            *(f32x4*)(hs + (size_t)(t0 + t) * 1024 + n * 128 + 4 * c4) = *(const LAS f32x4*)(TB + t * 132 + 4 * c4);
            const f32x4 p0 = *(const LAS f32x4*)(TA + t * 132 + 4 * c4), p1 = *(const LAS f32x4*)(TH + t * 132 + 4 * c4);
            u32x2 o0, o1; o0.x = pk2(p0[0], p0[1]); o0.y = pk2(p0[2], p0[3]); o1.x = pk2(p1[0], p1[1]); o1.y = pk2(p1[2], p1[3]);
            *(u32x2*)(Pout + (size_t)(t0 + t) * 1024 + n * 128 + 4 * c4) = o0;
            *(u32x2*)(Pout + (size_t)SEQ * 1024 + (size_t)(t0 + t) * 1024 + n * 128 + 4 * c4) = o1; }
    }
    }
    if (g0 == 0) { f32x2* agg2 = (f32x2*)(ws + (VAR ? WS_T0 + 8 * MiB : WS_AGG2)); const int chg2 = n * 128 + 16 * w0 + q0, sc2 = tt_first >> 2;
        agg2[(size_t)chg2 * 32 + sc2] = (f32x2){A2f, H2f}; agg2[(size_t)(1024 + chg2) * 32 + sc2] = (f32x2){A2b, H2b}; }
#undef LRU_XLOAD
}

__device__ __forceinline__ void phase2(const Args& a, LAS unsigned char* lds, int p2mask) {
    unsigned char* ws = a.ws;
    bf16_t* proj = (bf16_t*)(ws + WS_PROJ); const bf16_t* vt = (const bf16_t*)(ws + WS_VT);
    const bf16_t* mk = (const bf16_t*)(ws + WS_MK); const bf16_t* mvt = (const bf16_t*)(ws + WS_MVT);
    bf16_t* yatt = (bf16_t*)(ws + WS_YATT); bf16_t* ymem = (bf16_t*)(ws + WS_YMEM);
    if (p2mask & 1)
    for (int u = blockIdx.x; u < 256; u += gridDim.x) {
        const int qblk = u >> 2, hm = u & 3;
        attn_unit<256, false, false>(lds, proj + (size_t)(qblk * 128) * INW + C_QM + hm * 256, INW, ymem + (size_t)(qblk * 128) * 1024 + hm * 256, 1024, mk + hm * 256, 1024, mvt + (size_t)(hm * 256) * 256, 256, 0, 2, -100, -1e30f, 0.f);
    }
    if (p2mask & 2) windowed_stream(lds, a);
    if (p2mask & 4)
    lru_phase<0>(lds, a, (int)(blockIdx.x & 7), 4 * (int)(blockIdx.x >> 3), 1);
}

__device__ __forceinline__ void phase3(const Args& a, LAS unsigned char* lds) {
    unsigned char* ws = a.ws;
    const f32x2* agg1 = (const f32x2*)(ws + WS_AGG1); f32x2* agg2 = (f32x2*)(ws + WS_AGG2);
    for (int e = blockIdx.x * 512 + threadIdx.x; e < 2 * 1024 * 16; e += gridDim.x * 512) {
        const int sc = e & 15, dc = e >> 4, dir = dc >> 10;
        const f32x4* p = (const f32x4*)(agg1 + (size_t)dc * 128 + sc * 8);
        f32x4 v[4];
#pragma unroll
        for (int i = 0; i < 4; ++i) v[i] = p[i];
        float A = 1.f, H = 0.f;
        if (dir == 0) {
#pragma unroll
            for (int i = 0; i < 4; ++i) { H = v[i][0] * H + v[i][1]; A *= v[i][0]; H = v[i][2] * H + v[i][3]; A *= v[i][2]; }
        } else {
#pragma unroll
            for (int i = 3; i >= 0; --i) { H = v[i][2] * H + v[i][3]; A *= v[i][2]; H = v[i][0] * H + v[i][1]; A *= v[i][0]; }
        }
        agg2[(size_t)dc * 16 + sc] = (f32x2){A, H};
    }
}

__device__ __forceinline__ float silu_(float z) { return z * __builtin_amdgcn_rcpf(1.f + __builtin_amdgcn_exp2f(-z * 1.4426950408889634f)); }
__device__ __forceinline__ void phase4(const Args& a, LAS unsigned char* lds) {
    unsigned char* ws = a.ws;
    const f32x2* agg1 = (const f32x2*)(ws + WS_AGG1); const f32x2* agg2 = (const f32x2*)(ws + WS_AGG2);
    const bf16_t* proj = (const bf16_t*)(ws + WS_PROJ); bf16_t* Y = (bf16_t*)(ws + WS_Y);
    const bf16_t* yatt = (const bf16_t*)(ws + WS_YATT); const bf16_t* ymem = (const bf16_t*)(ws + WS_YMEM);
    const float* hs = (const float*)(ws + WS_HS); const bf16_t* Pf = (const bf16_t*)(ws + WS_PP); const bf16_t* Pb = Pf + (size_t)SEQ * 1024;
    LAS float* car = (LAS float*)lds;
    LAS float* gl = (LAS float*)(lds + 8192);
    int tid = threadIdx.x; asm volatile("" : "+v"(tid)); const int lane = tid & 63, w = tid >> 6;
    __syncthreads();
    for (int i = tid; i < 1024; i += 512) { *(LAS f32x4*)(gl + 4 * i) = (i < 512) ? ((const f32x4*)a.in[14])[i] : (i < 768 ? ((const f32x4*)a.in[15])[i - 512] : ((const f32x4*)a.in[16])[i - 768]); }
    for (int u = blockIdx.x; u < 256; u += gridDim.x) {
        const int tile = u >> 1, sc = tile >> 2, cj = tile & 3;
        __syncthreads();
#pragma unroll 1
        for (int half = 0; half < 2; ++half) {
            const int c = tid + 512 * half;
            float hf = 0.f, hb = 0.f;
            float scf = (float)sc, cjf = (float)cj; asm volatile("" : "+v"(scf), "+v"(cjf));
            { const f32x4* p2 = (const f32x4*)(agg2 + (size_t)c * 32); const f32x4* p1 = (const f32x4*)(agg1 + (size_t)c * 128 + sc * 4);
              f32x4 e2[16], e1[2];
#pragma unroll
              for (int i = 0; i < 16; ++i) e2[i] = p2[i];
#pragma unroll
              for (int i = 0; i < 2; ++i) e1[i] = p1[i];
#pragma unroll
              for (int i = 0; i < 16; ++i) { const float w0 = fminf(fmaxf(scf - (float)(2 * i), 0.f), 1.f), w1 = fminf(fmaxf(scf - (float)(2 * i + 1), 0.f), 1.f);
                  hf = (w0 * e2[i][0] + (1.f - w0)) * hf + w0 * e2[i][1]; hf = (w1 * e2[i][2] + (1.f - w1)) * hf + w1 * e2[i][3]; }
#pragma unroll
              for (int i = 0; i < 2; ++i) { const float w0 = fminf(fmaxf(cjf - (float)(2 * i), 0.f), 1.f), w1 = fminf(fmaxf(cjf - (float)(2 * i + 1), 0.f), 1.f);
                  hf = (w0 * e1[i][0] + (1.f - w0)) * hf + w0 * e1[i][1]; hf = (w1 * e1[i][2] + (1.f - w1)) * hf + w1 * e1[i][3]; } }
            { const f32x4* p2 = (const f32x4*)(agg2 + (size_t)(1024 + c) * 32); const f32x4* p1 = (const f32x4*)(agg1 + (size_t)(1024 + c) * 128 + sc * 4);
              f32x4 e2[16], e1[2];
#pragma unroll
              for (int i = 0; i < 16; ++i) e2[i] = p2[i];
#pragma unroll
              for (int i = 0; i < 2; ++i) e1[i] = p1[i];
#pragma unroll
              for (int i = 15; i >= 0; --i) { const float w1 = fminf(fmaxf((float)(2 * i + 1) - scf, 0.f), 1.f), w0 = fminf(fmaxf((float)(2 * i) - scf, 0.f), 1.f);
                  hb = (w1 * e2[i][2] + (1.f - w1)) * hb + w1 * e2[i][3]; hb = (w0 * e2[i][0] + (1.f - w0)) * hb + w0 * e2[i][1]; }
#pragma unroll
              for (int i = 1; i >= 0; --i) { const float w1 = fminf(fmaxf((float)(2 * i + 1) - cjf, 0.f), 1.f), w0 = fminf(fmaxf((float)(2 * i) - cjf, 0.f), 1.f);
                  hb = (w1 * e1[i][2] + (1.f - w1)) * hb + w1 * e1[i][3]; hb = (w0 * e1[i][0] + (1.f - w0)) * hb + w0 * e1[i][1]; } }
            car[c] = hf; car[1024 + c] = hb;
        }
        __syncthreads();
        f32x4 cf[4], cb[4];
#pragma unroll
        for (int k = 0; k < 4; ++k) { cf[k] = *(const LAS f32x4*)(car + 4 * lane + 256 * k); cb[k] = *(const LAS f32x4*)(car + 1024 + 4 * lane + 256 * k); }
#pragma unroll 1
        for (int tk = 0; tk < 4; ++tk) {
            const unsigned t = (unsigned)(u * 32 + 4 * w + tk);
            const char* hsb = (const char*)hs; const char* pfb = (const char*)Pf; const char* pbb = (const char*)Pb;
            const char* yab = (const char*)yatt; const char* ymb = (const char*)ymem; const char* prb = (const char*)proj; char* yb = (char*)Y;
            const unsigned o_h = t * 4096u + 16u * lane, o_p = t * 2048u + 8u * lane, o_m = t * 2048u + 16u * lane;
            const unsigned o_pr = t * (unsigned)(INW * 2), o_y = t * 8192u;
            f32x4 h4[4]; u32x2 pf[4], pb[4], zl[4]; u32x4 va[4], vm[2], za[4], zm[2];
#pragma unroll
            for (int k = 0; k < 4; ++k) { h4[k] = __builtin_nontemporal_load((const f32x4*)(hsb + o_h + 1024u * k)); pf[k] = __builtin_nontemporal_load((const u32x2*)(pfb + o_p + 512u * k)); pb[k] = __builtin_nontemporal_load((const u32x2*)(pbb + o_p + 512u * k)); va[k] = __builtin_nontemporal_load((const u32x4*)(yab + o_h + 1024u * k)); }
#pragma unroll
            for (int k = 0; k < 2; ++k) vm[k] = __builtin_nontemporal_load((const u32x4*)(ymb + o_m + 1024u * k));
#pragma unroll
            for (int k = 0; k < 4; ++k) { zl[k] = __builtin_nontemporal_load((const u32x2*)(prb + o_pr + (unsigned)((C_ZL + 4 * lane + 256 * k) * 2))); za[k] = __builtin_nontemporal_load((const u32x4*)(prb + o_pr + (unsigned)((C_ZA + 8 * lane + 512 * k) * 2))); }
#pragma unroll
            for (int k = 0; k < 2; ++k) zm[k] = __builtin_nontemporal_load((const u32x4*)(prb + o_pr + (unsigned)((C_ZM + 8 * lane + 512 * k) * 2)));
            __builtin_amdgcn_sched_barrier(0);
            f32x4 v[4]; float ssl = 0.f, ssa = 0.f, ssm = 0.f;
#pragma unroll
            for (int k = 0; k < 4; ++k) {
                v[k][0] = h4[k][0] + bflo(pf[k].x) * cf[k][0] + bflo(pb[k].x) * cb[k][0]; v[k][1] = h4[k][1] + bfhi(pf[k].x) * cf[k][1] + bfhi(pb[k].x) * cb[k][1];
                v[k][2] = h4[k][2] + bflo(pf[k].y) * cf[k][2] + bflo(pb[k].y) * cb[k][2]; v[k][3] = h4[k][3] + bfhi(pf[k].y) * cf[k][3] + bfhi(pb[k].y) * cb[k][3];
                ssl += (v[k][0] * v[k][0] + v[k][1] * v[k][1]) + (v[k][2] * v[k][2] + v[k][3] * v[k][3]);
                { const float f0 = bflo(va[k].x), f1 = bfhi(va[k].x), f2 = bflo(va[k].y), f3 = bfhi(va[k].y), f4 = bflo(va[k].z), f5 = bfhi(va[k].z), f6 = bflo(va[k].w), f7 = bfhi(va[k].w);
                  ssa += ((f0 * f0 + f1 * f1) + (f2 * f2 + f3 * f3)) + ((f4 * f4 + f5 * f5) + (f6 * f6 + f7 * f7)); } }
#pragma unroll
            for (int k = 0; k < 2; ++k) { const float f0 = bflo(vm[k].x), f1 = bfhi(vm[k].x), f2 = bflo(vm[k].y), f3 = bfhi(vm[k].y), f4 = bflo(vm[k].z), f5 = bfhi(vm[k].z), f6 = bflo(vm[k].w), f7 = bfhi(vm[k].w);
                ssm += ((f0 * f0 + f1 * f1) + (f2 * f2 + f3 * f3)) + ((f4 * f4 + f5 * f5) + (f6 * f6 + f7 * f7)); }
            ssl = wave_sum(ssl); ssa = wave_sum(ssa); ssm = wave_sum(ssm);
            const float rsl = 1.f / sqrtf(ssl * (1.f / 1024.f) + EPSN), rsa = 1.f / sqrtf(ssa * (1.f / 2048.f) + EPSN), rsm = 1.f / sqrtf(ssm * (1.f / 1024.f) + EPSN);
            __builtin_amdgcn_sched_barrier(0);
#pragma unroll
            for (int k = 0; k < 4; ++k) { const int c = 4 * lane + 256 * k; const f32x4 g4 = *(const LAS f32x4*)(gl + 2048 + c); const u32x2 z = zl[k];
                u32x2 o; o.x = pk2(v[k][0] * rsl * g4[0] * silu_(bflo(z.x)), v[k][1] * rsl * g4[1] * silu_(bfhi(z.x))); o.y = pk2(v[k][2] * rsl * g4[2] * silu_(bflo(z.y)), v[k][3] * rsl * g4[3] * silu_(bfhi(z.y)));
                *(u32x2*)(yb + o_y + (unsigned)((2048 + c) * 2)) = o; }
            __builtin_amdgcn_sched_barrier(0);
#pragma unroll
            for (int k = 0; k < 4; ++k) { const int c = 8 * lane + 512 * k; const f32x4 g0 = *(const LAS f32x4*)(gl + c), g1 = *(const LAS f32x4*)(gl + c + 4); const u32x4 z = za[k];
                u32x4 o; o.x = pk2(bflo(va[k].x) * rsa * g0[0] * silu_(bflo(z.x)), bfhi(va[k].x) * rsa * g0[1] * silu_(bfhi(z.x)));
                o.y = pk2(bflo(va[k].y) * rsa * g0[2] * silu_(bflo(z.y)), bfhi(va[k].y) * rsa * g0[3] * silu_(bfhi(z.y)));
                o.z = pk2(bflo(va[k].z) * rsa * g1[0] * silu_(bflo(z.z)), bfhi(va[k].z) * rsa * g1[1] * silu_(bfhi(z.z)));
                o.w = pk2(bflo(va[k].w) * rsa * g1[2] * silu_(bflo(z.w)), bfhi(va[k].w) * rsa * g1[3] * silu_(bfhi(z.w)));
                *(u32x4*)(yb + o_y + (unsigned)(c * 2)) = o; }
            __builtin_amdgcn_sched_barrier(0);
#pragma unroll
            for (int k = 0; k < 2; ++k) { const int c = 8 * lane + 512 * k; const f32x4 g0 = *(const LAS f32x4*)(gl + 3072 + c), g1 = *(const LAS f32x4*)(gl + 3072 + c + 4); const u32x4 z = zm[k];
                u32x4 o; o.x = pk2(bflo(vm[k].x) * rsm * g0[0] * silu_(bflo(z.x)), bfhi(vm[k].x) * rsm * g0[1] * silu_(bfhi(z.x)));
                o.y = pk2(bflo(vm[k].y) * rsm * g0[2] * silu_(bflo(z.y)), bfhi(vm[k].y) * rsm * g0[3] * silu_(bfhi(z.y)));
                o.z = pk2(bflo(vm[k].z) * rsm * g1[0] * silu_(bflo(z.z)), bfhi(vm[k].z) * rsm * g1[1] * silu_(bfhi(z.z)));
                o.w = pk2(bflo(vm[k].w) * rsm * g1[2] * silu_(bflo(z.w)), bfhi(vm[k].w) * rsm * g1[3] * silu_(bfhi(z.w)));
                *(u32x4*)(yb + o_y + (unsigned)((3072 + c) * 2)) = o; }
        }
    }
}

#define XB_TMO      128
#define XB_XCNT(j)  (256  + 64 * (j))
#define XB_XSUB(j)  (1280 + 64 * (j))
#define XB_XGEN(j)  (2304 + 64 * (j))
#define XB_TOP      3328
#define XB_TOPGEN   3392
#define XCD_BAR_WORDS 3456
#define XB_SPIN_CAP (1u << 18)

__device__ __forceinline__ unsigned xb_ld(unsigned* p)              { return __hip_atomic_load(p, __ATOMIC_RELAXED, __HIP_MEMORY_SCOPE_AGENT); }
__device__ __forceinline__ unsigned xb_add(unsigned* p, unsigned v) { return __hip_atomic_fetch_add(p, v, __ATOMIC_RELAXED, __HIP_MEMORY_SCOPE_AGENT); }
__device__ __forceinline__ unsigned xb_xcc_id() { return (unsigned)__builtin_amdgcn_s_getreg((3 << 11) | 20) & 0xFu; }
#define XB_SPIN(cond, bar) do { unsigned _sp = 0; while (cond) { __builtin_amdgcn_s_sleep(1); \
    if ((++_sp & 255u) == 0u) { if (xb_ld(&(bar)[XB_TMO])) break; if (_sp > XB_SPIN_CAP) { atomicAdd(&(bar)[XB_TMO], 1u); break; } } } } while (0)

struct XcdBarrier {
    unsigned* bar; unsigned x;
    volatile LAS unsigned* st;
};

__device__ __forceinline__ XcdBarrier xcd_barrier_post(unsigned* bar, volatile LAS unsigned* st) {
    XcdBarrier b; b.bar = bar; b.x = xb_xcc_id(); b.st = st;
    if (threadIdx.x == 0) (void)xb_add(&bar[XB_XCNT(b.x)], 1u);
    return b;
}
__device__ __forceinline__ void xcd_barrier_complete(unsigned* bar, unsigned x, unsigned& nloc, unsigned& nx) {
    const unsigned G = gridDim.x * gridDim.y * gridDim.z;
    unsigned sum, cnt, mine, sp = 0u;
    for (;;) {
        sum = 0u; cnt = 0u; mine = 0u;
#pragma unroll
        for (unsigned j = 0; j < 16; ++j) { const unsigned c = xb_ld(&bar[XB_XCNT(j)]); sum += c; cnt += (c > 0u) ? 1u : 0u; mine = (j == x) ? c : mine; }
        if (sum == G) break;
        __builtin_amdgcn_s_sleep(1);
        if ((++sp & 255u) == 0u) { if (xb_ld(&bar[XB_TMO])) break; if (sp > XB_SPIN_CAP) { atomicAdd(&bar[XB_TMO], 1u); break; } }
    }
    nloc = mine > 0u ? mine : 1u; nx = cnt > 0u ? cnt : 1u;
}

__device__ __forceinline__ void xcd_barrier(const XcdBarrier& b) {
    asm volatile("s_waitcnt vmcnt(0)" ::: "memory");
    __syncthreads();
    if (threadIdx.x == 0) {
        unsigned* bar = b.bar;
        __builtin_amdgcn_s_waitcnt(0);
        unsigned nloc = b.st[0], nx = b.st[1];
        if (nloc == 0u) { xcd_barrier_complete(bar, b.x, nloc, nx); b.st[0] = nloc; b.st[1] = nx; }
        const unsigned old = xb_add(&bar[XB_XSUB(b.x)], 1u);
        const unsigned gen = old / nloc;
        if (old + 1u == (gen + 1u) * nloc) {
            __builtin_amdgcn_fence(__ATOMIC_RELEASE, "agent");
            asm volatile("s_waitcnt vmcnt(0)" ::: "memory");
            const unsigned og = xb_add(&bar[XB_TOP], 1u);
            const unsigned tg = og / nx;
            if (og + 1u == (tg + 1u) * nx) xb_add(&bar[XB_TOPGEN], 1u);
            else XB_SPIN(xb_ld(&bar[XB_TOPGEN]) == tg, bar);
            __builtin_amdgcn_fence(__ATOMIC_ACQUIRE, "agent");
            xb_add(&bar[XB_XGEN(b.x)], 1u);
            asm volatile("s_waitcnt vmcnt(0)" ::: "memory");
        } else {
            XB_SPIN(xb_ld(&bar[XB_XGEN(b.x)]) == gen, bar);
            __builtin_amdgcn_fence(__ATOMIC_ACQUIRE, "agent");
            asm volatile("s_waitcnt vmcnt(0)" ::: "memory");
        }
    }
    __syncthreads();
}

struct Sched2 {
    int c;
    __device__ bool next(int i, pg8::Unit& u) const {
        if (i >= 2) return false;
        const int x = c & 7, j = c >> 3;
        u.pm = i * 16 + 4 * (x >> 1) + (j & 3); u.pn = 8 * (x & 1) + (j >> 2); return true;
    }
    __device__ __forceinline__ void a_ready(const pg8::Unit&) const {}
    __device__ __forceinline__ void done(const pg8::Unit&) const {}
};
struct Epi3 {
    static constexpr bool PERM = true, AFTER_DRAIN = false, HOLD_LAST = true;
    float* out; bf16_t* t0; float* sspart; const float* x; const float* gain; XcdBarrier xbar;
    __device__ __forceinline__ void operator()(const f32x4 (&acc)[2][2][4][2], const pg8::Unit& u, int wr, int wc, int fr, int fq) const {
#pragma unroll
        for (int ai = 0; ai < 2; ++ai)
#pragma unroll
            for (int m = 0; m < 4; ++m) { const int row = u.pm * 256 + ai * 128 + wr * 64 + m * 16 + fr; float ss = 0.f;
#pragma unroll
                for (int bj = 0; bj < 2; ++bj) { const f32x4 v0 = acc[ai][bj][m][0], v1 = acc[ai][bj][m][1]; const int col = u.pn * 256 + bj * 128 + wc * 32 + 8 * fq;
                    u32x4 pk; pk.x = pk2(v0[0], v0[1]); pk.y = pk2(v0[2], v0[3]); pk.z = pk2(v1[0], v1[1]); pk.w = pk2(v1[2], v1[3]); *(u32x4*)(t0 + (size_t)row * 4096 + col) = pk;
                    ss += ((v0[0] * v0[0] + v0[1] * v0[1]) + (v0[2] * v0[2] + v0[3] * v0[3])) + ((v1[0] * v1[0] + v1[1] * v1[1]) + (v1[2] * v1[2] + v1[3] * v1[3])); }
                ss = xor16_add(ss); ss = xor32_add(ss);
                if (fq == 0) sspart[(size_t)row * 64 + u.pn * 4 + wc] = ss; }
    }
    __device__ __forceinline__ void fused(f32x4 (&acc)[2][2][4][2], const pg8::Unit& u, int wr, int wc, int fr, int fq, LAS unsigned char* lds, int wid, int lane) const {
#pragma unroll
        for (int ai = 0; ai < 2; ++ai)
#pragma unroll
            for (int m = 0; m < 4; ++m) { const int row = u.pm * 256 + ai * 128 + wr * 64 + m * 16 + fr; float ss = 0.f;
#pragma unroll
                for (int bj = 0; bj < 2; ++bj)
#pragma unroll
                    for (int n = 0; n < 2; ++n) { const f32x4 v = acc[ai][bj][m][n]; ss += (v[0] * v[0] + v[1] * v[1]) + (v[2] * v[2] + v[3] * v[3]); }
                ss = xor16_add(ss); ss = xor32_add(ss);
                if (fq == 0) sspart[(size_t)row * 64 + u.pn * 4 + wc] = ss; }
        f32x4 xv0[16], xv1[16];
        const size_t gob = (size_t)(u.pm * 256 + wid * 16) * 4096 + u.pn * 256 + 4 * lane;
#pragma unroll
        for (int r = 0; r < 16; ++r) xv0[r] = __builtin_nontemporal_load((const f32x4*)(x + gob + (size_t)r * 4096));
        xcd_barrier(xbar);
        constexpr int TP = 260;
        LAS float* T = (LAS float*)lds;
        LAS float* rsT = (LAS float*)(lds + 128 * TP * 4);
        { const int tid = wid * 64 + lane, row = tid >> 1, hf = tid & 1;
          const f32x4* p = (const f32x4*)(sspart + (size_t)(u.pm * 256 + row) * 64 + hf * 32);
          float s = 0.f;
#pragma unroll
          for (int i = 0; i < 8; ++i) { const f32x4 v = p[i]; s += (v[0] + v[1]) + (v[2] + v[3]); }
          s += dpp_mov<0xB1>(s);
          if (hf == 0) rsT[row] = 1.f / sqrtf(s * (1.f / 4096.f) + EPSN); }
        const f32x4 gv = *(const f32x4*)(gain + u.pn * 256 + 4 * lane);
#pragma unroll
        for (int ai = 0; ai < 2; ++ai) {
            __syncthreads();
#pragma unroll
            for (int m = 0; m < 4; ++m)
#pragma unroll
                for (int bj = 0; bj < 2; ++bj)
#pragma unroll
                    for (int n = 0; n < 2; ++n) *(LAS f32x4*)(T + (wr * 64 + m * 16 + fr) * TP + bj * 128 + wc * 32 + 8 * fq + 4 * n) = acc[ai][bj][m][n];
            if (ai == 0) {
#pragma unroll
                for (int r = 0; r < 16; ++r) xv1[r] = __builtin_nontemporal_load((const f32x4*)(x + gob + (size_t)(128 + r) * 4096));
            }
            __syncthreads();
#pragma unroll
            for (int r = 0; r < 16; ++r) { const int rl = wid * 16 + r;
                const f32x4 tv = *(const LAS f32x4*)(T + rl * TP + 4 * lane); const float rs = rsT[ai * 128 + rl];
                __builtin_nontemporal_store((ai ? xv1[r] : xv0[r]) + tv * rs * gv, (f32x4*)(out + gob + (size_t)(ai * 128 + r) * 4096)); }
        }
        const int pm0 = u.pm - 16;
        __syncthreads();
        { const int tid = wid * 64 + lane, row = tid >> 1, hf = tid & 1;
          const f32x4* p = (const f32x4*)(sspart + (size_t)(pm0 * 256 + row) * 64 + hf * 32);
          float s = 0.f;
#pragma unroll
          for (int i = 0; i < 8; ++i) { const f32x4 v = p[i]; s += (v[0] + v[1]) + (v[2] + v[3]); }
          s += dpp_mov<0xB1>(s);
          if (hf == 0) rsT[row] = 1.f / sqrtf(s * (1.f / 4096.f) + EPSN); }
        __syncthreads();
#pragma unroll 1
        for (int hb = 0; hb < 2; ++hb) {
            const int r0 = wid * 32 + hb * 16;
            const size_t go = (size_t)(pm0 * 256 + r0) * 4096 + u.pn * 256 + 4 * lane;
            f32x4 xr[16]; u32x2 tr[16];
#pragma unroll
            for (int r = 0; r < 16; ++r) { xr[r] = __builtin_nontemporal_load((const f32x4*)(x + go + (size_t)r * 4096)); tr[r] = __builtin_nontemporal_load((const u32x2*)(t0 + go + (size_t)r * 4096)); }
#pragma unroll
            for (int r = 0; r < 16; ++r) { const float rs = rsT[r0 + r];
                f32x4 o; o[0] = xr[r][0] + bflo(tr[r].x) * rs * gv[0]; o[1] = xr[r][1] + bfhi(tr[r].x) * rs * gv[1]; o[2] = xr[r][2] + bflo(tr[r].y) * rs * gv[2]; o[3] = xr[r][3] + bfhi(tr[r].y) * rs * gv[3];
                __builtin_nontemporal_store(o, (f32x4*)(out + go + (size_t)r * 4096)); }
        }
    }
};
__device__ __forceinline__ void phase6(const Args& a) {
    int tid = threadIdx.x; asm volatile("" : "+v"(tid)); const int lane = tid & 63, w = tid >> 6;
    const float* sspart = (const float*)(a.ws + WS_SS); const bf16_t* t0 = (const bf16_t*)(a.ws + WS_T0);
    f32x4 gv[16];
#pragma unroll
    for (int k = 0; k < 16; ++k) gv[k] = ((const f32x4*)a.in[18])[2 * lane + 128 * (k >> 1) + (k & 1)];
    for (int row = blockIdx.x * 8 + w; row < 4096; row += gridDim.x * 8) {
        const u32x4* t4 = (const u32x4*)(t0 + (size_t)row * 4096) + lane; f32x4* o4 = (f32x4*)(a.out + (size_t)row * 4096) + 2 * lane;
        const f32x4* x4 = (const f32x4*)(a.in[0] + (size_t)row * 4096) + 2 * lane;
        u32x4 tv[8]; f32x4 xa[8], xb[8];
        const float sp = sspart[(size_t)row * 64 + lane];
#pragma unroll
        for (int k = 0; k < 8; ++k) { tv[k] = __builtin_nontemporal_load(t4 + 64 * k); xa[k] = __builtin_nontemporal_load(x4 + 128 * k); xb[k] = __builtin_nontemporal_load(x4 + 128 * k + 1); }
        const float rs = 1.f / sqrtf(wave_sum(sp) * (1.f / 4096.f) + EPSN);
#pragma unroll
        for (int k = 0; k < 8; ++k) { const f32x4 ga = gv[2 * k], gb = gv[2 * k + 1];
            f32x4 oa, ob; oa[0] = xa[k][0] + bflo(tv[k].x) * rs * ga[0]; oa[1] = xa[k][1] + bfhi(tv[k].x) * rs * ga[1]; oa[2] = xa[k][2] + bflo(tv[k].y) * rs * ga[2]; oa[3] = xa[k][3] + bfhi(tv[k].y) * rs * ga[3];
            ob[0] = xb[k][0] + bflo(tv[k].z) * rs * gb[0]; ob[1] = xb[k][1] + bfhi(tv[k].z) * rs * gb[1]; ob[2] = xb[k][2] + bflo(tv[k].w) * rs * gb[2]; ob[3] = xb[k][3] + bfhi(tv[k].w) * rs * gb[3];
            __builtin_nontemporal_store(oa, o4 + 128 * k); __builtin_nontemporal_store(ob, o4 + 128 * k + 1); }
    }
}

__global__ void __launch_bounds__(512, 2) mega(Args a) {
    extern __shared__ __attribute__((aligned(16))) unsigned char lds_raw[];
    LAS unsigned char* lds = (LAS unsigned char*)lds_raw;
    cg::grid_group grid = cg::this_grid();
    unsigned char* ws = a.ws;
    volatile LAS unsigned* xst = (volatile LAS unsigned*)(lds + LDS_BYTES - 64);
    if (threadIdx.x < 16) xst[threadIdx.x] = 0u;
    __syncthreads();
    XcdBarrier xbar; xbar.bar = (unsigned*)(ws + WS_CTL); xbar.x = 0; xbar.st = nullptr;
    xbar = xcd_barrier_post((unsigned*)(ws + WS_CTL), xst);
    const int lo = a.ph_lo, hi = a.ph_hi;
#define IN(k) (lo <= (k) && (k) < hi)
#define SEAM(k) do { if (IN(k) && IN((k) + 1)) { if ((k) == 0) { __syncthreads(); grid.sync(); } else xcd_barrier(xbar); } } while (0)
    if (IN(0)) { if (PHMASK & 1) phase0(a, lds); if (REPMASK & 1) { __syncthreads(); phase0(a, lds); } }
    SEAM(0);
    if (IN(1)) { if (PHMASK & 2) {
        pg8::Gemm g{(const bf16_t*)(ws + WS_U), (const bf16_t*)(ws + WS_WT), SEQ + NMEM, INW + 2048, 4096};
        Epi1 E{(bf16_t*)(ws + WS_PROJ), (bf16_t*)(ws + WS_VT), (bf16_t*)(ws + WS_MK), (bf16_t*)(ws + WS_MVT), (const float*)(ws + WS_ROPE)};
        const int G = (int)gridDim.x, nfull = 1160 % G, nidle = G - nfull, bi = (int)blockIdx.x - nfull;
        if (bi < 0) {
            Sched1 S; S.init(G, (int)blockIdx.x); S.ioff = 4;
            pg8::gemm_phase<Epi1, Sched1, true, true>(lds, g, S, E);
        } else {
            int tid = threadIdx.x; asm volatile("" : "+v"(tid)); const int lane = tid & 63, w = tid >> 6;
            LAS float* scr = (LAS float*)(lds + w * 16384);
            p0_transpose_win<false>(a.in[3], (bf16_t*)(ws + WS_WT), scr, bi * 8 + w, nidle * 8, lane);
            p0_transpose_matrix(a.in[17], 4096, 4096, (bf16_t*)(ws + WS_WOUT), 0, scr, bi * 8 + w, nidle * 8, lane);
        }
        xcd_barrier(xbar);
        { Sched1 S; S.init(G, (int)blockIdx.x); S.imax = 4;
          pg8::gemm_phase<Epi1, Sched1, true, true>(lds, g, S, E); }
    } }
    SEAM(1);
    if (IN(2)) { if (PHMASK & 4) phase2(a, lds, P2MASK); }
    SEAM(2);
    if (IN(4)) { if (PHMASK & 16) phase4(a, lds); if (REPMASK & 16) { __syncthreads(); phase4(a, lds); } }
    SEAM(4);
    if (IN(5)) { if (PHMASK & 32) {
        pg8::Gemm g{(const bf16_t*)(ws + WS_Y), (const bf16_t*)(ws + WS_WOUT), SEQ, 4096, 4096};
        Sched2 S; S.c = (int)blockIdx.x;
        Epi3 E{a.out, (bf16_t*)(ws + WS_T0), (float*)(ws + WS_SS), a.in[0], a.in[18], xbar};
        pg8::gemm_phase<Epi3, Sched2, true, true>(lds, g, S, E);
    } }
#if N_LAUNCHES != 1
    if (lo >= 7 && lo < 10) phase2(a, lds, 1 << (lo - 7));
    if (lo == 11 || lo == 12) {
        pg8::Gemm g{(const bf16_t*)(ws + WS_U), (const bf16_t*)(ws + WS_WT), SEQ + NMEM, INW + 2048, 4096};
        Sched1 S; S.init((int)gridDim.x, (int)blockIdx.x); if (lo == 11) S.imax = 4; else S.ioff = 4;
        Epi1 E{(bf16_t*)(ws + WS_PROJ), (bf16_t*)(ws + WS_VT), (bf16_t*)(ws + WS_MK), (bf16_t*)(ws + WS_MVT), (const float*)(ws + WS_ROPE)};
        pg8::gemm_phase<Epi1, Sched1, true, true>(lds, g, S, E);
    }
    if (lo == 13) {
        pg8::Gemm g{(const bf16_t*)(ws + WS_U), (const bf16_t*)(ws + WS_WT), SEQ + NMEM, INW + 2048, 4096};
        Sched1 S; S.init((int)gridDim.x, (int)blockIdx.x); S.imax = 4;
        pg8::EpiBf16<0> E{(bf16_t*)(ws + WS_HS), INW, nullptr, 0, 0, 1.f};
        pg8::gemm_phase<pg8::EpiBf16<0>, Sched1, true, true>(lds, g, S, E);
    }
#ifdef LRUVAR
    if (lo == 10) lru_phase<LRUVAR>(lds, a, (int)(blockIdx.x & 7), (int)(blockIdx.x >> 3), (int)(gridDim.x >> 3));
#endif
#endif
#undef IN
#undef SEAM
}

extern "C" void kernel_launch(void* const* d_in, const int* in_sizes, int n_in, void* d_out, int out_size, void* d_ws, size_t ws_size, hipStream_t stream) {
    static int grid = 0;
    if (grid == 0) {
        if (n_in != 19 || ws_size < WS_END) { fprintf(stderr, "kernel_launch: unexpected n_in %d or ws_size %zu (need %zu)\n", n_in, ws_size, (size_t)WS_END); grid = -1; return; }
        int dev = 0, cus = 0, per_cu = 0;
        hipGetDevice(&dev); hipDeviceGetAttribute(&cus, hipDeviceAttributeMultiprocessorCount, dev);
        if (hipFuncSetAttribute((const void*)mega, hipFuncAttributeMaxDynamicSharedMemorySize, LDS_BYTES) != hipSuccess) { fprintf(stderr, "kernel_launch: hipFuncSetAttribute failed\n"); grid = -1; return; }
        if (hipOccupancyMaxActiveBlocksPerMultiprocessor(&per_cu, (const void*)mega, 512, LDS_BYTES) != hipSuccess || per_cu < 1) { fprintf(stderr, "kernel_launch: occupancy query says %d\n", per_cu); per_cu = 1; }
        (void)hipGetLastError();
        if (cus < 256) { fprintf(stderr, "kernel_launch: needs 256 CUs (one workgroup per CU), device has %d\n", cus); grid = -1; return; }
        grid = 256;
    }
    if (grid < 0) return;
    Args a{};
    for (int i = 0; i < 19; ++i) a.in[i] = (const float*)d_in[i];
    a.out = (float*)d_out; a.ws = (unsigned char*)d_ws;
#if N_LAUNCHES == 1
    (void)hipMemsetAsync((char*)d_ws + WS_CTL, 0, 65536, stream);
    a.ph_lo = 0; a.ph_hi = NPH;
    void* args[] = {&a};
    hipError_t e = hipLaunchCooperativeKernel((const void*)mega, dim3(grid), dim3(512), args, LDS_BYTES, stream);
    if (e != hipSuccess) fprintf(stderr, "cooperative launch failed: %s (grid %d)\n", hipGetErrorString(e), grid);
#else
#ifndef PHSEQ
#define PHSEQ 0,1,2,3,4,5,6
#endif
    { const int seq[] = {PHSEQ};
      for (unsigned i = 0; i < sizeof(seq) / sizeof(int); ++i) { a.ph_lo = seq[i]; a.ph_hi = seq[i] + 1; (void)hipMemsetAsync((char*)d_ws + WS_CTL, 0, 65536, stream); hipLaunchKernelGGL(mega, dim3(grid), dim3(512), LDS_BYTES, stream, a); } }
#endif
}
```

```cpp
#include <hip/hip_runtime.h>
#include <hip/hip_cooperative_groups.h>
#include <cstdio>
#include <cstdint>
namespace cg = cooperative_groups;
#define N_LAUNCHES 1
namespace pg8 {
#define PG8_LAS __attribute__((address_space(3)))
typedef unsigned short bf16_t;
typedef short bf16x8 __attribute__((ext_vector_type(8)));
typedef float f32x4 __attribute__((ext_vector_type(4)));
typedef unsigned u32x4 __attribute__((ext_vector_type(4)));
constexpr int BM = 256, BK = 64, HALF = 128, HTB = HALF * BK * 2  , STAGE_BYTES = 8 * HTB, NXCD = 8, WGM = 8;

__host__ __device__ __forceinline__ int lds_byte(int r, int c) { const int st = (r >> 4) * 2 + (c >> 5), rr = r & 15, cc = c & 31, ob = rr * 64 + cc * 2; return st * 1024 + (ob ^ (((ob >> 9) & 1) << 5)); }
__host__ __device__ __forceinline__ void stage_rc(int b, int& R, int& C) { const int st = b / 1024, sb = b % 1024, swz = sb ^ (((sb >> 9) & 1) << 5); R = (st >> 1) * 16 + swz / 64; C = (st & 1) * 32 + (swz % 64) / 2; }
__host__ __device__ __forceinline__ int perm32(int rho) { const int n = rho >> 4, i = rho & 15; return 8 * (i >> 2) + 4 * n + (i & 3); }

struct Unit { int pm, pn; };
struct Gemm { const bf16_t* A; const bf16_t* Bt; int M, N, K; };

struct StaticOrder {
    int nM, nN, nwg, G, c;
    __host__ __device__ void init(int M, int N, int G_, int c_) { nM = M / BM; nN = N / BM; nwg = nM * nN; G = G_; c = c_; }
    __host__ __device__ bool next(int i, Unit& u) const {
        const long L = (long)i * G + c; if (L >= nwg) return false;
        int wgid = (int)L; { const int q = nwg / NXCD, r = nwg % NXCD, xcd = wgid % NXCD, off = wgid / NXCD; wgid = (xcd < r ? xcd * (q + 1) : r * (q + 1) + (xcd - r) * q) + off; }
        const int nig = WGM * nN, gid = wgid / nig, fm = gid * WGM, gsz = (nM - fm) < WGM ? (nM - fm) : WGM;
        u.pm = fm + ((wgid % nig) % gsz); u.pn = (wgid % nig) / gsz; return true;
    }
    __device__ __forceinline__ void a_ready(const Unit&) const {}
    __device__ __forceinline__ void done(const Unit&) const {}
};

__device__ __forceinline__ unsigned cvt_pk_bf16(float lo, float hi) { unsigned r; asm volatile("v_cvt_pk_bf16_f32 %0, %1, %2" : "=v"(r) : "v"(lo), "v"(hi)); return r; }
typedef float f32x2 __attribute__((ext_vector_type(2)));
__device__ __forceinline__ f32x2 gelu_pk(f32x2 v) {
    const f32x2 av = __builtin_elementwise_abs(v), d = av * 0.2316418882f + 1.0f;
    f32x2 t; t.x = __builtin_amdgcn_rcpf(d.x); t.y = __builtin_amdgcn_rcpf(d.y);
    f32x2 q = t * 0.5307027145f + (-0.7265760135f); q = q * t + 0.7107068705f; q = q * t + (-0.142248368f); q = q * t + 0.127414796f; q = q * t;
    const f32x2 s = (v * v) * (-0.72134752044f);
    f32x2 e; e.x = __builtin_amdgcn_exp2f(s.x); e.y = __builtin_amdgcn_exp2f(s.y);
    const f32x2 m = v * (q * e), r = v - m;
    f32x2 o; o.x = v.x < 0.f ? m.x : r.x; o.y = v.y < 0.f ? m.y : r.y; return o;
}

template <int ACT  > struct EpiBf16 {
    static constexpr bool PERM = true, AFTER_DRAIN = false, HOLD_LAST = false; static_assert(ACT == 0 || ACT == 1, "EpiBf16: ACT is 0 (none) or 1 (gelu_pk)");
    bf16_t* O; int ldc; const float* bias; int split_cols; size_t split_stride; float scale0;
    __device__ __forceinline__ void operator()(const f32x4 (&acc)[2][2][4][2], const Unit& u, int wr, int wc, int fr, int fq) const {
        const int row0 = u.pm * BM + wr * 64 + fr; int colt = u.pn * BM; bf16_t* base = O;
        float sc = 1.f; if (split_cols) { const int t = colt / split_cols; base += (size_t)t * split_stride; colt -= t * split_cols; if (t == 0) sc = scale0; }
        const int col0 = colt + wc * 32 + 8 * fq, bcol0 = u.pn * BM + wc * 32 + 8 * fq;
        f32x4 bv[2][2];
#pragma unroll
        for (int bj = 0; bj < 2; ++bj)
#pragma unroll
            for (int n = 0; n < 2; ++n) bv[bj][n] = bias ? *(const f32x4*)(bias + bcol0 + bj * HALF + 4 * n) : (f32x4){0.f, 0.f, 0.f, 0.f};
#pragma unroll
        for (int ai = 0; ai < 2; ++ai)
#pragma unroll
            for (int m = 0; m < 4; ++m) { bf16_t* rowp = base + (size_t)(row0 + ai * HALF + m * 16) * ldc + col0;
#pragma unroll
                for (int bj = 0; bj < 2; ++bj) { f32x4 v0 = acc[ai][bj][m][0] + bv[bj][0], v1 = acc[ai][bj][m][1] + bv[bj][1];
                    if (ACT == 1) { f32x2 a = gelu_pk((f32x2){v0[0], v0[1]}), b = gelu_pk((f32x2){v0[2], v0[3]}), c = gelu_pk((f32x2){v1[0], v1[1]}), d = gelu_pk((f32x2){v1[2], v1[3]});
                        v0 = (f32x4){a.x, a.y, b.x, b.y}; v1 = (f32x4){c.x, c.y, d.x, d.y}; }
                    v0 = v0 * sc; v1 = v1 * sc; u32x4 w; w.x = cvt_pk_bf16(v0[0], v0[1]); w.y = cvt_pk_bf16(v0[2], v0[3]); w.z = cvt_pk_bf16(v1[0], v1[1]); w.w = cvt_pk_bf16(v1[2], v1[3]);
                    *(u32x4*)(rowp + bj * HALF) = w; } }
    }
};
template <class Epi, class Sched, bool ALIGN_EPI = false, bool SP2 = false>
__device__ __forceinline__ void gemm_phase(PG8_LAS unsigned char* lds, const Gemm g, const Sched& S, const Epi& E) {
    int tid_ = threadIdx.x; asm volatile("" : "+v"(tid_)); const int tid = tid_, wid = __builtin_amdgcn_readfirstlane(tid >> 6), lane = tid & 63, wr = wid >> 2, wc = wid & 3, fr = lane & 15, fq = lane >> 4;
    const int K = g.K, nt = K / BK;
    unsigned voffA[2], voffB[2];
#pragma unroll
    for (int i = 0; i < 2; ++i) { int R, C; stage_rc(tid * 16 + i * 8192, R, C); const int Rb = Epi::PERM ? ((R & ~31) + perm32(R & 31)) : R;
        voffA[i] = (unsigned)(R * K + C) * 2u; voffB[i] = (unsigned)(Rb * K + C) * 2u; }
    const size_t kstep = (size_t)(BK * 2);
    const size_t hstep = (size_t)HALF * K * 2;
    const size_t tstep = 2 * hstep;
    const unsigned ldsw = (unsigned)wid * 1024u;
    const int aoff = lds_byte(wr * 64 + fr, fq * 8), boff = lds_byte(wc * 32 + fr, fq * 8);
#define PG8_SA(b, h) (((b) * 2 + (h)) * HTB)
#define PG8_SB(b, h) ((4 + (b) * 2 + (h)) * HTB)
#define PG8_STAGE(bufoff, gbase, voff) do { _Pragma("unroll") for (int _i = 0; _i < 2; ++_i) \
        __builtin_amdgcn_global_load_lds((const unsigned*)((const char*)(gbase) + (voff)[_i]), (PG8_LAS unsigned*)(lds + (bufoff) + ldsw + _i * 8192), 16, 0, 0); } while (0)
#define PG8_LDA(dst, b, h) do { _Pragma("unroll") for (int m = 0; m < 4; ++m) _Pragma("unroll") for (int k = 0; k < 2; ++k) dst[m][k] = *(const PG8_LAS bf16x8*)(lds + PG8_SA(b, h) + aoff + m * 2048 + k * 1024); } while (0)
#define PG8_LDB(dst, b, h) do { _Pragma("unroll") for (int n = 0; n < 2; ++n) _Pragma("unroll") for (int k = 0; k < 2; ++k) dst[n][k] = *(const PG8_LAS bf16x8*)(lds + PG8_SB(b, h) + boff + n * 2048 + k * 1024); } while (0)
#define PG8_MMA(ai, bj, At, Bt) do { __builtin_amdgcn_s_setprio(1); _Pragma("unroll") for (int m = 0; m < 4; ++m) _Pragma("unroll") for (int n = 0; n < 2; ++n) _Pragma("unroll") for (int k = 0; k < 2; ++k) \
        acc[ai][bj][m][n] = __builtin_amdgcn_mfma_f32_16x16x32_bf16(Bt[n][k], At[m][k], acc[ai][bj][m][n], 0, 0, 0); __builtin_amdgcn_s_setprio(0); } while (0)
#define PG8_WAIT_V(n) asm volatile("s_waitcnt vmcnt(" #n ")" ::: "memory")
#define PG8_WAIT_L(n) asm volatile("s_waitcnt lgkmcnt(" #n ")" ::: "memory")
#define PG8_BAR __builtin_amdgcn_s_barrier()
#define PG8_SCHED __builtin_amdgcn_sched_barrier(0)
    Unit cur, nxt; int ui = 0;
    if (!S.next(0, cur)) return;
    f32x4 acc[2][2][4][2];
#pragma unroll
    for (int a = 0; a < 2; ++a)
#pragma unroll
        for (int b = 0; b < 2; ++b)
#pragma unroll
            for (int m = 0; m < 4; ++m)
#pragma unroll
                for (int n = 0; n < 2; ++n) acc[a][b][m][n] = (f32x4){0.f, 0.f, 0.f, 0.f};
    bf16x8 At[4][2], B0[2][2], B1[2][2];
    const char* cA = (const char*)g.A + (size_t)cur.pm * tstep; const char* cB = (const char*)g.Bt + (size_t)cur.pn * tstep;
    S.a_ready(cur);
    if constexpr (SP2) {
        PG8_STAGE(PG8_SB(0, 0), cB, voffB); PG8_STAGE(PG8_SB(0, 1), cB + hstep, voffB); PG8_STAGE(PG8_SA(0, 0), cA, voffA); PG8_STAGE(PG8_SA(0, 1), cA + hstep, voffA);
        if (wr == 1) PG8_BAR;
        PG8_WAIT_V(2); PG8_BAR;
        PG8_STAGE(PG8_SB(1, 0), cB + kstep, voffB); PG8_STAGE(PG8_SA(1, 0), cA + kstep, voffA); PG8_STAGE(PG8_SB(1, 1), cB + hstep + kstep, voffB);
        PG8_WAIT_V(6); PG8_BAR;
    } else {
        PG8_STAGE(PG8_SB(0, 0), cB, voffB); PG8_STAGE(PG8_SA(0, 0), cA, voffA); PG8_STAGE(PG8_SB(0, 1), cB + hstep, voffB); PG8_STAGE(PG8_SA(0, 1), cA + hstep, voffA);
        if (wr == 1) PG8_BAR;
        PG8_WAIT_V(4); PG8_BAR;
        PG8_STAGE(PG8_SB(1, 0), cB + kstep, voffB); PG8_STAGE(PG8_SA(1, 0), cA + kstep, voffA); PG8_STAGE(PG8_SB(1, 1), cB + hstep + kstep, voffB);
        PG8_WAIT_V(6); PG8_BAR;
    }
    for (;;) {
        const bool has_next = S.next(ui + 1, nxt);
        const char* nA = has_next ? (const char*)g.A + (size_t)nxt.pm * tstep : cA; const char* nB = has_next ? (const char*)g.Bt + (size_t)nxt.pn * tstep : cB;
        for (int t = 0; t < nt; t += 2) {
            const bool last = (t == nt - 2);
            const char* a1 = cA + (size_t)(t + 1) * kstep;
            const char* a2 = last ? nA : cA + (size_t)(t + 2) * kstep; const char* b2 = last ? nB : cB + (size_t)(t + 2) * kstep;
            const char* a3 = a2 + kstep; const char* b3 = b2 + kstep;
            if (last && has_next) S.a_ready(nxt);
            if constexpr (SP2) {
            PG8_LDB(B0, 0, 0); PG8_LDB(B1, 0, 1); PG8_SCHED; PG8_LDA(At, 0, 0); PG8_STAGE(PG8_SA(1, 1), a1 + hstep, voffA);
            PG8_WAIT_V(8); PG8_WAIT_L(0); PG8_BAR; PG8_MMA(0, 0, At, B0); PG8_MMA(0, 1, At, B1); PG8_BAR; PG8_SCHED;
            PG8_LDA(At, 0, 1); PG8_STAGE(PG8_SB(0, 0), b2, voffB); PG8_STAGE(PG8_SB(0, 1), b2 + hstep, voffB); PG8_STAGE(PG8_SA(0, 0), a2, voffA);
            PG8_WAIT_V(8); PG8_WAIT_L(0); PG8_BAR; PG8_MMA(1, 0, At, B0); PG8_MMA(1, 1, At, B1); PG8_BAR; PG8_SCHED;
            PG8_LDB(B0, 1, 0); PG8_LDB(B1, 1, 1); PG8_SCHED; PG8_LDA(At, 1, 0); PG8_STAGE(PG8_SA(0, 1), a2 + hstep, voffA);
            PG8_WAIT_V(8); PG8_WAIT_L(0); PG8_BAR; PG8_MMA(0, 0, At, B0); PG8_MMA(0, 1, At, B1); PG8_BAR; PG8_SCHED;
            PG8_LDA(At, 1, 1); PG8_STAGE(PG8_SB(1, 0), b3, voffB); PG8_STAGE(PG8_SB(1, 1), b3 + hstep, voffB); PG8_STAGE(PG8_SA(1, 0), a3, voffA);
            PG8_WAIT_V(8); PG8_WAIT_L(0); PG8_BAR; PG8_MMA(1, 0, At, B0); PG8_MMA(1, 1, At, B1); PG8_BAR; PG8_SCHED;
            } else {
            PG8_LDB(B0, 0, 0); PG8_SCHED; PG8_LDA(At, 0, 0); PG8_STAGE(PG8_SA(1, 1), a1 + hstep, voffA);
            PG8_WAIT_L(8); PG8_BAR; PG8_WAIT_L(0); PG8_MMA(0, 0, At, B0); PG8_BAR; PG8_SCHED;
            PG8_LDB(B1, 0, 1); PG8_STAGE(PG8_SB(0, 0), b2, voffB);
            PG8_BAR; PG8_WAIT_L(0); PG8_MMA(0, 1, At, B1); PG8_BAR;
            PG8_LDA(At, 0, 1); PG8_STAGE(PG8_SA(0, 0), a2, voffA);
            PG8_BAR; PG8_WAIT_L(0); PG8_MMA(1, 0, At, B0); PG8_BAR; PG8_SCHED;
            PG8_STAGE(PG8_SB(0, 1), b2 + hstep, voffB);
            PG8_WAIT_V(6); PG8_BAR; PG8_MMA(1, 1, At, B1); PG8_BAR;
            PG8_LDB(B0, 1, 0); PG8_SCHED; PG8_LDA(At, 1, 0); PG8_STAGE(PG8_SA(0, 1), a2 + hstep, voffA);
            PG8_WAIT_L(8); PG8_BAR; PG8_WAIT_L(0); PG8_MMA(0, 0, At, B0); PG8_BAR; PG8_SCHED;
            PG8_LDB(B1, 1, 1); PG8_STAGE(PG8_SB(1, 0), b3, voffB);
            PG8_BAR; PG8_WAIT_L(0); PG8_MMA(0, 1, At, B1); PG8_BAR;
            PG8_LDA(At, 1, 1); PG8_STAGE(PG8_SA(1, 0), a3, voffA);
            PG8_BAR; PG8_WAIT_L(0); PG8_MMA(1, 0, At, B0); PG8_BAR; PG8_SCHED;
            PG8_STAGE(PG8_SB(1, 1), b3 + hstep, voffB);
            PG8_WAIT_V(6); PG8_BAR; PG8_MMA(1, 1, At, B1); PG8_BAR;
            }
        }
        if constexpr (ALIGN_EPI) { if (wr == 0) PG8_BAR; }
        if constexpr (!Epi::AFTER_DRAIN) { if (!Epi::HOLD_LAST || has_next) { E(acc, cur, wr, wc, fr, fq); S.done(cur); } }
        if (!has_next) break;
#pragma unroll
        for (int a = 0; a < 2; ++a)
#pragma unroll
            for (int b = 0; b < 2; ++b)
#pragma unroll
                for (int m = 0; m < 4; ++m)
#pragma unroll
                    for (int n = 0; n < 2; ++n) acc[a][b][m][n] = (f32x4){0.f, 0.f, 0.f, 0.f};
        cur = nxt; cA = nA; cB = nB; ++ui;
        if constexpr (ALIGN_EPI) { if (wr == 1) PG8_BAR; }
    }
    PG8_WAIT_V(0);
    if constexpr (!ALIGN_EPI) { if (wr == 0) PG8_BAR; }
    PG8_BAR;
    if constexpr (Epi::AFTER_DRAIN || Epi::HOLD_LAST) { E.fused(acc, cur, wr, wc, fr, fq, lds, wid, lane); S.done(cur); }
#undef PG8_SA
#undef PG8_SB
#undef PG8_STAGE
#undef PG8_LDA
#undef PG8_LDB
#undef PG8_MMA
#undef PG8_WAIT_V
#undef PG8_WAIT_L
#undef PG8_BAR
#undef PG8_SCHED
}
}

#ifndef PHMASK
#define PHMASK 127
#endif
#ifndef REPMASK
#define REPMASK 0
#endif
#ifndef P2MASK
#define P2MASK 7
#endif
#ifndef N_LAUNCHES
#define N_LAUNCHES 1
#endif
using pg8::bf16_t; using pg8::bf16x8; using pg8::f32x4; using pg8::u32x4;
#define LAS __attribute__((address_space(3)))
typedef unsigned u32x2 __attribute__((ext_vector_type(2)));
typedef float f32x2 __attribute__((ext_vector_type(2)));

constexpr int SEQ = 8192, DMODEL = 4096, INW = 9216, NMEM = 256;
constexpr int C_QA = 0, C_KA = 2048, C_VA = 2560, C_XL = 3072, C_QM = 4096, C_ZA = 5120, C_ZL = 7168, C_ZM = 8192;
constexpr float EPSN = 1e-6f;
constexpr float LOG2E = 1.4426950408889634f;
constexpr float SC_ATT = 0.08838834764831845f * LOG2E;
constexpr float SC_MEM = 0.0625f * LOG2E;
constexpr int NPH = 7;
constexpr int LDS_BYTES = 147456;

constexpr size_t MiB = 1u << 20;
constexpr size_t WS_CTL = 0, WS_LRUW = 1 * MiB, WS_ROPE = 2 * MiB, WS_MK = 3 * MiB, WS_MVT = 3 * MiB + 512 * 1024, WS_SS = 4 * MiB,
                 WS_AGG1 = 6 * MiB, WS_AGG2 = 10 * MiB, WS_VT = 12 * MiB, WS_WOUT = 20 * MiB, WS_WT = 52 * MiB, WS_U = 140 * MiB,
                 WS_PROJ = 206 * MiB, WS_HS = 350 * MiB, WS_PP = 382 * MiB, WS_YATT = 414 * MiB, WS_YMEM = 446 * MiB, WS_T0 = 462 * MiB, WS_END = 494 * MiB;
constexpr size_t WS_Y = WS_U;

struct Args { const float* in[19]; float* out; unsigned char* ws; int ph_lo, ph_hi; };

__device__ __forceinline__ unsigned pk2(float lo, float hi) { return pg8::cvt_pk_bf16(lo, hi); }
__device__ __forceinline__ float bflo(unsigned u) { return __builtin_bit_cast(float, u << 16); }
__device__ __forceinline__ float bfhi(unsigned u) { return __builtin_bit_cast(float, u & 0xffff0000u); }
template <int CTRL> __device__ __forceinline__ float dpp_mov(float v) { return __uint_as_float(__builtin_amdgcn_update_dpp(0u, __float_as_uint(v), CTRL, 0xF, 0xF, true)); }
__device__ __forceinline__ float xor16_add(float v) { auto r = __builtin_amdgcn_permlane16_swap(__float_as_uint(v), __float_as_uint(v), false, false); return __uint_as_float(r[0]) + __uint_as_float(r[1]); }
__device__ __forceinline__ float xor32_add(float v) { auto r = __builtin_amdgcn_permlane32_swap(__float_as_uint(v), __float_as_uint(v), false, false); return __uint_as_float(r[0]) + __uint_as_float(r[1]); }
__device__ __forceinline__ float xor16_max(float v) { auto r = __builtin_amdgcn_permlane16_swap(__float_as_uint(v), __float_as_uint(v), false, false); return fmaxf(__uint_as_float(r[0]), __uint_as_float(r[1])); }
__device__ __forceinline__ float xor32_max(float v) { auto r = __builtin_amdgcn_permlane32_swap(__float_as_uint(v), __float_as_uint(v), false, false); return fmaxf(__uint_as_float(r[0]), __uint_as_float(r[1])); }
__device__ __forceinline__ float xor32_get(float v, bool upper) { auto r = __builtin_amdgcn_permlane32_swap(__float_as_uint(v), __float_as_uint(v), false, false); return __uint_as_float(upper ? r[0] : r[1]); }
__device__ __forceinline__ float wave_sum(float v) {
    v += dpp_mov<0xB1>(v);
    v += dpp_mov<0x4E>(v);
    v += dpp_mov<0x141>(v);
    v += dpp_mov<0x140>(v);
    v = xor16_add(v); v = xor32_add(v);
    return v;
}
__device__ __forceinline__ float fexp2(float x) { return __builtin_amdgcn_exp2f(x); }
__device__ __forceinline__ float sigmoidf_(float x) { return 1.f / (1.f + __expf(-x)); }
__device__ __forceinline__ float fsigmoid(float x) { return __builtin_amdgcn_rcpf(1.f + __builtin_amdgcn_exp2f(-x * 1.4426950408889634f)); }
__device__ __forceinline__ f32x4 mfma16(bf16x8 a, bf16x8 b, f32x4 c) { return __builtin_amdgcn_mfma_f32_16x16x32_bf16(a, b, c, 0, 0, 0); }

__device__ __forceinline__ void p0_item_load(const float* W, int N, int item, int lane, float (&r)[32]) {
    const int nblk = N / 32, kb = item / nblk, nb = item % nblk, k0 = 64 * kb, n0 = 32 * nb;
#pragma unroll
    for (int i = 0; i < 32; ++i) { const int kk = 2 * i + (lane >> 5); r[i] = __builtin_nontemporal_load(W + (size_t)(k0 + kk) * N + n0 + (lane & 31)); }
}
__device__ __forceinline__ void p0_item_lds_write(LAS float* scr, int lane, const float (&r)[32]) {
#pragma unroll
    for (int i = 0; i < 32; ++i) { const int kk = 2 * i + (lane >> 5); scr[kk * 33 + (lane & 31)] = r[i]; }
}
__device__ __forceinline__ void p0_item_store(int K, int N, bf16_t* WT, int row_off, LAS float* scr, int item, int lane) {
    const int nblk = N / 32, kb = item / nblk, nb = item % nblk, k0 = 64 * kb, n0 = 32 * nb;
    asm volatile("s_waitcnt lgkmcnt(0)" ::: "memory");
    const int c = lane & 7;
#pragma unroll
    for (int j = 0; j < 4; ++j) { const int n = (lane >> 3) + 8 * j; const LAS float* s = scr + (8 * c) * 33 + n;
        u32x4 o; o.x = pk2(s[0 * 33], s[1 * 33]); o.y = pk2(s[2 * 33], s[3 * 33]); o.z = pk2(s[4 * 33], s[5 * 33]); o.w = pk2(s[6 * 33], s[7 * 33]);
        *(u32x4*)(WT + (size_t)(row_off + n0 + n) * K + k0 + 8 * c) = o; }
    asm volatile("s_waitcnt lgkmcnt(0)" ::: "memory");
}
__device__ __forceinline__ void p0_transpose_item(const float* W, int K, int N, bf16_t* WT, int row_off, LAS float* scr, int item, int lane) {
    float r[32]; p0_item_load(W, N, item, lane, r); p0_item_lds_write(scr, lane, r); p0_item_store(K, N, WT, row_off, scr, item, lane);
}
template <bool SEL> __device__ __forceinline__ int win_item(int j) {
    if (SEL) { const int kb = j >> 5, e = j & 31; return kb * (INW / 32) + (e < 16 ? 128 + e : 272 + (e - 16)); }
    else { const int kb = j >> 8, c = j & 255; return kb * (INW / 32) + (c < 128 ? c : c + 16); }
}
template <bool SEL> __device__ __forceinline__ void p0_transpose_win(const float* W, bf16_t* WT, LAS float* scr, int first, int step, int lane) {
    constexpr int NJ = SEL ? 64 * 32 : 64 * 256;
    if (first >= NJ) return;
    float r[32]; p0_item_load(W, INW, win_item<SEL>(first), lane, r);
#pragma unroll 1
    for (int j = first; j < NJ; j += step) {
        p0_item_lds_write(scr, lane, r);
        if (j + step < NJ) p0_item_load(W, INW, win_item<SEL>(j + step), lane, r);
        p0_item_store(4096, INW, WT, 0, scr, win_item<SEL>(j), lane);
    }
}
__device__ __forceinline__ void p0_transpose_matrix(const float* W, int K, int N, bf16_t* WT, int row_off, LAS float* scr, int first, int step, int lane) {
    const int nitems = (K / 64) * (N / 32);
    if (first >= nitems) return;
    float r[32]; p0_item_load(W, N, first, lane, r);
#pragma unroll 1
    for (int it = first; it < nitems; it += step) {
        p0_item_lds_write(scr, lane, r);
        if (it + step < nitems) p0_item_load(W, N, it + step, lane, r);
        p0_item_store(K, N, WT, row_off, scr, it, lane);
    }
}
__device__ __forceinline__ void rms_row_to_bf16(const float* xrow, const f32x4 (&gv)[16], bf16_t* orow, int lane) {
    const f32x4* xr = (const f32x4*)xrow + lane;
    f32x4 v[16]; float s = 0.f;
#pragma unroll
    for (int k = 0; k < 16; ++k) { v[k] = __builtin_nontemporal_load(xr + 64 * k); s += (v[k].x * v[k].x + v[k].y * v[k].y) + (v[k].z * v[k].z + v[k].w * v[k].w); }
    const float rs = 1.f / sqrtf(wave_sum(s) * (1.f / 4096.f) + EPSN);
    u32x2* o8 = (u32x2*)orow + lane;
#pragma unroll
    for (int k = 0; k < 16; ++k) { const f32x4 g4 = gv[k]; u32x2 o; o.x = pk2(v[k].x * rs * g4.x, v[k].y * rs * g4.y); o.y = pk2(v[k].z * rs * g4.z, v[k].w * rs * g4.w); o8[64 * k] = o; }
}

__device__ __forceinline__ void phase0(const Args& a, LAS unsigned char* lds) {
    int tid = threadIdx.x; asm volatile("" : "+v"(tid)); const int lane = tid & 63, w = tid >> 6, G = gridDim.x;
    const int gw = blockIdx.x * 8 + w, NGW = G * 8;
    unsigned char* ws = a.ws;
    LAS float* scr = (LAS float*)(lds + w * 16384);
    bf16_t* WT = (bf16_t*)(ws + WS_WT); bf16_t* WOUT = (bf16_t*)(ws + WS_WOUT); bf16_t* LRUW = (bf16_t*)(ws + WS_LRUW);
    constexpr int I_IN = 64 * (INW / 32), I_MKV = 64 * (2048 / 32), I_OUT = 64 * (4096 / 32), I_LRU = 32 * 8;
    p0_transpose_win<true>(a.in[3], WT, scr, gw, NGW, lane);
    p0_transpose_matrix(a.in[13], 4096, 2048, WT, INW, scr, gw, NGW, lane);
    for (int r = gw; r < I_LRU; r += NGW) {
        const int mat = r >> 3, sub = r & 7, gate = mat >> 4, dn = mat & 15;
        const float* src = (gate ? a.in[9] : a.in[7]) + (size_t)dn * 16384;
        p0_transpose_item(src, 128, 128, LRUW + (size_t)mat * 16384, 0, scr, sub, lane);
    }
    bf16_t* U = (bf16_t*)(ws + WS_U);
    { f32x4 gv[16];
#pragma unroll
      for (int k = 0; k < 16; ++k) gv[k] = ((const f32x4*)a.in[2])[lane + 64 * k];
      if (G == 256) { const int b = (int)blockIdx.x, r0 = 8 * b + ((b * (b - 1) * 6168) >> 16), r1 = (b == 255) ? SEQ : 8 * (b + 1) + (((b + 1) * b * 6168) >> 16);
          for (int m = r0 + w; m < r1; m += 8) rms_row_to_bf16(a.in[0] + (size_t)m * 4096, gv, U + (size_t)m * 4096, lane); }
      else { for (int m = gw; m < SEQ; m += NGW) rms_row_to_bf16(a.in[0] + (size_t)m * 4096, gv, U + (size_t)m * 4096, lane); }
#pragma unroll
      for (int k = 0; k < 16; ++k) gv[k] = ((const f32x4*)a.in[12])[lane + 64 * k];
      for (int m = gw; m < NMEM; m += NGW) rms_row_to_bf16(a.in[1] + (size_t)m * 4096, gv, U + (size_t)(SEQ + m) * 4096, lane); }
    f32x2* rope = (f32x2*)(ws + WS_ROPE);
    for (int e = blockIdx.x * 512 + tid; e < SEQ * 16; e += G * 512) {
        const int pos = e >> 4, i = e & 15;
        const float inv = powf(500000.0f, -(float)i * (1.0f / 16.0f));
        const float ang = (float)pos * inv;
        rope[e] = (f32x2){cosf(ang), sinf(ang)};
    }
}

struct Sched1 {
    pg8::StaticOrder so; int G, c, ioff, imax;
    __device__ void init(int G_, int c_) { so.init(SEQ, INW, G_, c_); G = G_; c = c_; ioff = 0; imax = 1 << 20; }
    __device__ bool next(int i0, pg8::Unit& u) const {
        if (i0 >= imax) return false;
        const int i = i0 + ioff;
        const long L = (long)i * G + c;
        if (L < 1152) return so.next(i, u);
        if (L < 1160) { u.pm = 32; u.pn = 36 + (int)(L - 1152); return true; }
        return false;
    }
    __device__ __forceinline__ void a_ready(const pg8::Unit&) const {}
    __device__ __forceinline__ void done(const pg8::Unit&) const {}
};
struct Epi1 {
    static constexpr bool PERM = true, AFTER_DRAIN = false, HOLD_LAST = false;
    bf16_t* proj; bf16_t* vt; bf16_t* mk; bf16_t* mvt; const float* rope;
    __device__ __forceinline__ void operator()(const f32x4 (&acc)[2][2][4][2], const pg8::Unit& u, int wr, int wc, int fr, int fq) const {
        const int rloc = wr * 64 + fr, cloc = wc * 32 + 8 * fq;
        if (u.pm == 32) {
            const int t = u.pn - 36;
            if (t < 4) {
#pragma unroll
                for (int ai = 0; ai < 2; ++ai)
#pragma unroll
                    for (int m = 0; m < 4; ++m) { const int row = rloc + ai * 128 + m * 16;
#pragma unroll
                        for (int bj = 0; bj < 2; ++bj) { const f32x4 v0 = acc[ai][bj][m][0], v1 = acc[ai][bj][m][1];
                            u32x4 wv; wv.x = pk2(v0[0], v0[1]); wv.y = pk2(v0[2], v0[3]); wv.z = pk2(v1[0], v1[1]); wv.w = pk2(v1[2], v1[3]);
                            *(u32x4*)(mk + (size_t)row * 1024 + t * 256 + bj * 128 + cloc) = wv; } asm volatile("" ::: "memory"); }
            } else {
#pragma unroll
                for (int ai = 0; ai < 2; ++ai)
#pragma unroll
                    for (int m = 0; m < 4; ++m) { const int row = rloc + ai * 128 + m * 16;
#pragma unroll
                        for (int bj = 0; bj < 2; ++bj)
#pragma unroll
                            for (int n = 0; n < 2; ++n)
#pragma unroll
                                for (int i = 0; i < 4; ++i) { const int col = (t - 4) * 256 + bj * 128 + cloc + 4 * n + i;
                                    mvt[(size_t)col * 256 + row] = (bf16_t)(pk2(acc[ai][bj][m][n][i], 0.f) & 0xffffu); } asm volatile("" ::: "memory"); }
            }
            return;
        }
        const int pn = u.pn, row0 = u.pm * 256 + rloc;
        if (pn == 10 || pn == 11) {
#pragma unroll
            for (int ai = 0; ai < 2; ++ai)
#pragma unroll
                for (int m = 0; m < 4; ++m) { const int row = row0 + ai * 128 + m * 16;
#pragma unroll
                    for (int bj = 0; bj < 2; ++bj)
#pragma unroll
                        for (int n = 0; n < 2; ++n)
#pragma unroll
                            for (int i = 0; i < 4; ++i) { const int col = (pn - 10) * 256 + bj * 128 + cloc + 4 * n + i;
                                vt[(size_t)col * SEQ + row] = (bf16_t)(pk2(acc[ai][bj][m][n][i], 0.f) & 0xffffu); } asm volatile("" ::: "memory"); }
            return;
        }
        float sc = 1.f; if (pn < 8) sc = SC_ATT; else if (pn >= 16 && pn < 20) sc = SC_MEM;
        const bool do_rope = (pn < 10) && (wc == 0);
        const float sgn = (fq < 2) ? -1.f : 1.f;
        f32x4 csA[2][2], cst[2][2];
        if (do_rope) {
#pragma unroll
            for (int n = 0; n < 2; ++n) { const int io = (8 * (fq & 1) + 4 * n) * 2;
                const float* ra = rope + (size_t)row0 * 32 + io; const float* rt = rope + 16 * 32 + io;
                csA[n][0] = *(const f32x4*)ra; csA[n][1] = *(const f32x4*)(ra + 4); cst[n][0] = *(const f32x4*)rt; cst[n][1] = *(const f32x4*)(rt + 4); }
        }
#pragma unroll
        for (int ai = 0; ai < 2; ++ai)
#pragma unroll
            for (int m = 0; m < 4; ++m) { const int row = row0 + ai * 128 + m * 16;
                f32x4 cs[2][2];
                if (do_rope) {
                    const int nrot = (ai == 0 && m == 3) ? 5 : 1;
#pragma unroll
                    for (int n = 0; n < 2; ++n)
#pragma unroll
                        for (int hh = 0; hh < 2; ++hh) { f32x4 cur = csA[n][hh]; cs[n][hh] = cur; const f32x4 t = cst[n][hh];
#pragma unroll
                            for (int rr = 0; rr < 5; ++rr) { if (rr < nrot) { f32x4 nx; nx[0] = cur[0] * t[0] - cur[1] * t[1]; nx[1] = cur[1] * t[0] + cur[0] * t[1]; nx[2] = cur[2] * t[2] - cur[3] * t[3]; nx[3] = cur[3] * t[2] + cur[2] * t[3]; cur = nx; } }
                            csA[n][hh] = cur; }
                }
#pragma unroll
                for (int bj = 0; bj < 2; ++bj) { f32x4 v[2]; v[0] = acc[ai][bj][m][0]; v[1] = acc[ai][bj][m][1];
                    if (do_rope) {
#pragma unroll
                        for (int n = 0; n < 2; ++n) { f32x4 p; p[0] = xor32_get(v[n][0], fq >= 2); p[1] = xor32_get(v[n][1], fq >= 2); p[2] = xor32_get(v[n][2], fq >= 2); p[3] = xor32_get(v[n][3], fq >= 2);
                            f32x4 r; r[0] = v[n][0] * cs[n][0][0] + sgn * p[0] * cs[n][0][1]; r[1] = v[n][1] * cs[n][0][2] + sgn * p[1] * cs[n][0][3];
                            r[2] = v[n][2] * cs[n][1][0] + sgn * p[2] * cs[n][1][1]; r[3] = v[n][3] * cs[n][1][2] + sgn * p[3] * cs[n][1][3]; v[n] = r; }
                    }
                    u32x4 wv; wv.x = pk2(v[0][0] * sc, v[0][1] * sc); wv.y = pk2(v[0][2] * sc, v[0][3] * sc); wv.z = pk2(v[1][0] * sc, v[1][1] * sc); wv.w = pk2(v[1][2] * sc, v[1][3] * sc);
                    __builtin_nontemporal_store(wv, (u32x4*)(proj + (size_t)row * INW + pn * 256 + bj * 128 + cloc)); } asm volatile("" ::: "memory"); }
    }
};

template <int DH, bool PF, bool DB>
__device__ __forceinline__ void attn_unit(LAS unsigned char* lds, const bf16_t* Qp, int ldq, bf16_t* Op, int ldo, const bf16_t* Kg, int ldk, const bf16_t* Vtg, int ldv,
                                          int cb_lo, int cb_hi, int cb_self, float m_init, float l_init) {
    constexpr int PR = DH / 8, KROW = DH * 2, KT = 128 * KROW, VROW = 288, NKI = (128 * PR) / 512, NVI = (DH * 16) / 512, NS = DH / 32, NDT = DH / 16;
    int tid = threadIdx.x; asm volatile("" : "+v"(tid)); const int lane = tid & 63, w = tid >> 6, q = lane & 15, g = lane >> 4;
    const int krow = 8 * (q >> 2) + (q & 3);
    bf16x8 qf[NS];
    { const unsigned qoff = (unsigned)(((16 * w + q) * ldq + 8 * g) * 2);
#pragma unroll
      for (int s = 0; s < NS; ++s) qf[s] = __builtin_nontemporal_load((const bf16x8*)((const char*)Qp + qoff + 64 * s)); }
    f32x4 o[NDT];
#pragma unroll
    for (int dt = 0; dt < NDT; ++dt) o[dt] = (f32x4){0.f, 0.f, 0.f, 0.f};
    float m_run = m_init, l_run = l_init;
    u32x4 kreg[NKI], vreg[NVI];
#define ATT_LOAD(cb) do { const int k0_ = (cb) * 128; \
        const char* kb_ = (const char*)Kg + (size_t)k0_ * ldk * 2; const char* vb_ = (const char*)Vtg + (size_t)k0_ * 2; \
        _Pragma("unroll") for (int it = 0; it < NKI; ++it) { const int e = tid + 512 * it; const int key = e / PR, pc = e % PR; \
            kreg[it] = *(const u32x4*)(kb_ + (unsigned)((key * ldk + pc * 8) * 2)); } \
        _Pragma("unroll") for (int it = 0; it < NVI; ++it) { const int e = tid + 512 * it; const int d = e >> 4, pc = e & 15; \
            vreg[it] = *(const u32x4*)(vb_ + (unsigned)((d * ldv + pc * 8) * 2)); } } while (0)
#define ATT_STORE() do { \
        _Pragma("unroll") for (int it = 0; it < NKI; ++it) { const int e = tid + 512 * it; const int key = e / PR, pc = e % PR; \
            *(LAS u32x4*)(lds + key * KROW + ((pc ^ ((((key >> 3) & 3) << 2) | (key & 3))) * 16)) = kreg[it]; } \
        _Pragma("unroll") for (int it = 0; it < NVI; ++it) { const int e = tid + 512 * it; const int d = e >> 4, pc = e & 15; \
            *(LAS u32x4*)(lds + KT + d * VROW + pc * 16) = vreg[it]; } } while (0)
    if (PF) ATT_LOAD(cb_lo);
    for (int cb = cb_lo; cb < cb_hi; ++cb) {
        if (!PF) ATT_LOAD(cb);
        __syncthreads();
        ATT_STORE();
        __syncthreads();
        if (PF) { if (cb + 1 < cb_hi) ATT_LOAD(cb + 1); }
        f32x4 s[8];
#pragma unroll
        for (int kt = 0; kt < 8; ++kt) s[kt] = (f32x4){0.f, 0.f, 0.f, 0.f};
        {
            bf16x8 ka[DB ? 2 : 1][8];
            if (DB) {
#pragma unroll
                for (int kt = 0; kt < 8; ++kt) ka[0][kt] = *(const LAS bf16x8*)(lds + (32 * (kt >> 1) + 4 * (kt & 1) + krow) * KROW + (((0 + g) ^ q) * 16));
            }
#pragma unroll
            for (int ss = 0; ss < NS; ++ss) {
                if (DB) { if (ss + 1 < NS) {
#pragma unroll
                    for (int kt = 0; kt < 8; ++kt) ka[(ss + 1) & 1][kt] = *(const LAS bf16x8*)(lds + (32 * (kt >> 1) + 4 * (kt & 1) + krow) * KROW + (((4 * (ss + 1) + g) ^ q) * 16)); }
                } else {
#pragma unroll
                    for (int kt = 0; kt < 8; ++kt) ka[0][kt] = *(const LAS bf16x8*)(lds + (32 * (kt >> 1) + 4 * (kt & 1) + krow) * KROW + (((4 * ss + g) ^ q) * 16));
                }
                __builtin_amdgcn_sched_barrier(0);
#pragma unroll
                for (int kt = 0; kt < 8; ++kt) s[kt] = mfma16(ka[DB ? (ss & 1) : 0][kt], qf[ss], s[kt]);
                __builtin_amdgcn_sched_barrier(0);
            }
        }
        if (cb != cb_self && cb_self >= 0) {
            const float sg = (cb < cb_self) ? 1.f : -1.f;
            const float dq = (float)(16 * w + q - 8 * g);
#pragma unroll
            for (int kt = 0; kt < 8; ++kt)
#pragma unroll
                for (int j = 0; j < 4; ++j) { const float v = sg * ((float)(32 * (kt >> 1) + 4 * (kt & 1) + j) - dq); s[kt][j] += fminf(v, 0.f) * 1e30f; }
        }
        float mx = s[0][0];
#pragma unroll
        for (int kt = 0; kt < 8; ++kt)
#pragma unroll
            for (int j = 0; j < 4; ++j) mx = fmaxf(mx, s[kt][j]);
        mx = xor16_max(mx); mx = xor32_max(mx);
        const float m_new = fmaxf(m_run, mx), alpha = fexp2(m_run - m_new); m_run = m_new;
        float rs = 0.f;
#pragma unroll
        for (int kt = 0; kt < 8; ++kt)
#pragma unroll
            for (int j = 0; j < 4; ++j) { const float p = fexp2(s[kt][j] - m_new); s[kt][j] = p; rs += p; }
        rs = xor16_add(rs); rs = xor32_add(rs);
        l_run = l_run * alpha + rs;
        bf16x8 pb[4];
#pragma unroll
        for (int u = 0; u < 4; ++u) { u32x4 t; t.x = pk2(s[2 * u][0], s[2 * u][1]); t.y = pk2(s[2 * u][2], s[2 * u][3]); t.z = pk2(s[2 * u + 1][0], s[2 * u + 1][1]); t.w = pk2(s[2 * u + 1][2], s[2 * u + 1][3]);
            pb[u] = __builtin_bit_cast(bf16x8, t); }
#pragma unroll
        for (int dt = 0; dt < NDT; ++dt) o[dt] = o[dt] * alpha;
        {
            constexpr int NG = (NDT / 8) * 4;
            u32x4 va[DB ? 2 : 1][8];
#define ATT_VLOAD(buf, gi) do { const int u_ = (gi) & 3, d0_ = 8 * ((gi) >> 2); \
            _Pragma("unroll") for (int i = 0; i < 8; ++i) { va[buf][i] = *(const LAS u32x4*)(lds + KT + (16 * (d0_ + i) + q) * VROW + (32 * u_ + 8 * g) * 2); } } while (0)
            if (DB) ATT_VLOAD(0, 0);
#pragma unroll
            for (int gi = 0; gi < NG; ++gi) {
                if (DB) { if (gi + 1 < NG) ATT_VLOAD((gi + 1) & 1, gi + 1); } else ATT_VLOAD(0, gi);
                __builtin_amdgcn_sched_barrier(0);
#pragma unroll
                for (int i = 0; i < 8; ++i) o[8 * (gi >> 2) + i] = mfma16(__builtin_bit_cast(bf16x8, va[DB ? (gi & 1) : 0][i]), pb[gi & 3], o[8 * (gi >> 2) + i]);
                __builtin_amdgcn_sched_barrier(0);
            }
#undef ATT_VLOAD
        }
    }
#undef ATT_LOAD
#undef ATT_STORE
    const float inv = 1.f / l_run;
    const unsigned ooff = (unsigned)(((16 * w + q) * ldo + 4 * g) * 2);
#pragma unroll
    for (int dt = 0; dt < NDT; ++dt) { u32x2 pkv; pkv.x = pk2(o[dt][0] * inv, o[dt][1] * inv); pkv.y = pk2(o[dt][2] * inv, o[dt][3] * inv); *(u32x2*)((char*)Op + ooff + 32 * dt) = pkv; }
}

__device__ __forceinline__ void windowed_stream(LAS unsigned char* lds0, const Args& a) {
    constexpr int DH = 128, PR = 16, KROW = 256, KT = 128 * KROW, VROW = 288, BUFB = KT + DH * VROW, NKI = 4, NVI = 4, NS = 4, NDT = 8;
    static_assert(2 * BUFB <= LDS_BYTES - 64, "two K/V tile buffers must fit under the barrier words");
    int tid = threadIdx.x; asm volatile("" : "+v"(tid)); const int lane = tid & 63, w = tid >> 6, q = lane & 15, g = lane >> 4;
    const int krow = 8 * (q >> 2) + (q & 3);
    unsigned char* ws = a.ws;
    const bf16_t* proj = (const bf16_t*)(ws + WS_PROJ); const bf16_t* vt = (const bf16_t*)(ws + WS_VT); bf16_t* yatt = (bf16_t*)(ws + WS_YATT);
    const int G = (int)gridDim.x;
    if ((int)blockIdx.x >= 1024) return;
    unsigned koff[NKI], voff[NVI], klds[NKI], vlds[NVI];
#pragma unroll
    for (int it = 0; it < NKI; ++it) { const int e = tid + 512 * it, key = e / PR, pc = e % PR; koff[it] = (unsigned)((key * INW + pc * 8) * 2); klds[it] = (unsigned)(key * KROW + ((pc ^ ((((key >> 3) & 3) << 2) | (key & 3))) * 16)); }
#pragma unroll
    for (int it = 0; it < NVI; ++it) { const int e = tid + 512 * it, d = e >> 4, pc = e & 15; voff[it] = (unsigned)((d * SEQ + pc * 8) * 2); vlds[it] = (unsigned)(KT + d * VROW + pc * 16); }
    u32x4 kreg[NKI], vreg[NVI];
#define WS_LOAD(v_, cb_) do { const int kvh_ = ((v_) & 15) >> 2; \
        const char* kb_ = (const char*)proj + ((size_t)((cb_) * 128) * INW + C_KA + kvh_ * 128) * 2; const char* vb_ = (const char*)vt + ((size_t)(kvh_ * 128) * SEQ + (cb_) * 128) * 2; \
        _Pragma("unroll") for (int it = 0; it < NKI; ++it) kreg[it] = *(const u32x4*)(kb_ + koff[it]); \
        _Pragma("unroll") for (int it = 0; it < NVI; ++it) vreg[it] = *(const u32x4*)(vb_ + voff[it]); } while (0)
#define WS_STORE(ldsb_) do { \
        _Pragma("unroll") for (int it = 0; it < NKI; ++it) *(LAS u32x4*)((ldsb_) + klds[it]) = kreg[it]; \
        _Pragma("unroll") for (int it = 0; it < NVI; ++it) *(LAS u32x4*)((ldsb_) + vlds[it]) = vreg[it]; } while (0)
#define WS_LO(v_) ((((v_) >> 4) > 0) ? ((v_) >> 4) - 1 : 0)
#define WS_HI(v_) ((((v_) >> 4) < 63) ? ((v_) >> 4) + 2 : 64)
    int Cv = (int)blockIdx.x, Ccb = WS_LO(Cv);
    int Lv = Cv, Lcb = Ccb; bool Lvalid = true;
#define WS_ADV_L() do { if (Lcb + 1 < WS_HI(Lv)) ++Lcb; else { Lv += G; if (Lv < 1024) Lcb = WS_LO(Lv); else Lvalid = false; } } while (0)
    __syncthreads();
    WS_LOAD(Lv, Lcb); WS_ADV_L();
    WS_STORE(lds0);
    bool have = false;
    if (Lvalid) { WS_LOAD(Lv, Lcb); WS_ADV_L(); have = true; }
    __syncthreads();
    int bsel = 0;
    bf16x8 qf[NS]; f32x4 o[NDT]; float m_run = 0.f, l_run = 1.f;
#pragma unroll 1
    for (;;) {
        const int qblk = Cv >> 4, hq = Cv & 15, lo = WS_LO(Cv), hi = WS_HI(Cv);
        LAS unsigned char* lds = lds0 + bsel * BUFB;
        if (Ccb == lo) {
            const unsigned qoff = (unsigned)(((16 * w + q) * INW + 8 * g) * 2);
            const char* qb = (const char*)proj + ((size_t)(qblk * 128) * INW + C_QA + hq * 128) * 2;
#pragma unroll
            for (int s = 0; s < NS; ++s) qf[s] = __builtin_nontemporal_load((const bf16x8*)(qb + qoff + 64 * s));
#pragma unroll
            for (int dt = 0; dt < NDT; ++dt) o[dt] = (f32x4){0.f, 0.f, 0.f, 0.f};
            m_run = a.in[4][hq] * LOG2E; l_run = 1.f;
        }
        if (have) { WS_STORE(lds0 + (bsel ^ 1) * BUFB); have = false; }
        if (Lvalid) { WS_LOAD(Lv, Lcb); WS_ADV_L(); have = true; }
        f32x4 s[8];
#pragma unroll
        for (int kt = 0; kt < 8; ++kt) s[kt] = (f32x4){0.f, 0.f, 0.f, 0.f};
        {
            bf16x8 ka[2][8];
#pragma unroll
            for (int kt = 0; kt < 8; ++kt) ka[0][kt] = *(const LAS bf16x8*)(lds + (32 * (kt >> 1) + 4 * (kt & 1) + krow) * KROW + (((0 + g) ^ q) * 16));
#pragma unroll
            for (int ss = 0; ss < NS; ++ss) {
                if (ss + 1 < NS) {
#pragma unroll
                    for (int kt = 0; kt < 8; ++kt) ka[(ss + 1) & 1][kt] = *(const LAS bf16x8*)(lds + (32 * (kt >> 1) + 4 * (kt & 1) + krow) * KROW + (((4 * (ss + 1) + g) ^ q) * 16)); }
                __builtin_amdgcn_sched_barrier(0);
#pragma unroll
                for (int kt = 0; kt < 8; ++kt) s[kt] = mfma16(ka[ss & 1][kt], qf[ss], s[kt]);
                __builtin_amdgcn_sched_barrier(0);
            }
        }
        if (Ccb != qblk) {
            const bool prev = Ccb < qblk; const int ud = __builtin_amdgcn_readfirstlane(w) >> 1;
            const float sg = prev ? 1.f : -1.f;
            const float dq = (float)(16 * w + q - 8 * g);
#pragma unroll
            for (int u = 0; u < 4; ++u) {
                if (prev ? (u < ud) : (u > ud)) {
#pragma unroll
                    for (int j = 0; j < 4; ++j) { s[2 * u][j] = -1e30f; s[2 * u + 1][j] = -1e30f; }
                } else if (u == ud) {
#pragma unroll
                    for (int h2 = 0; h2 < 2; ++h2)
#pragma unroll
                        for (int j = 0; j < 4; ++j) { const float v = sg * ((float)(32 * u + 4 * h2 + j) - dq); s[2 * u + h2][j] += fminf(v, 0.f) * 1e30f; }
                }
            }
        }
        float mx = s[0][0];
#pragma unroll
        for (int kt = 0; kt < 8; ++kt)
#pragma unroll
            for (int j = 0; j < 4; ++j) mx = fmaxf(mx, s[kt][j]);
        mx = xor16_max(mx); mx = xor32_max(mx);
        const bool resc = __builtin_amdgcn_ballot_w64(mx > m_run + 8.0f) != 0ull;
        if (resc) { const float m_new = fmaxf(m_run, mx), alpha = fexp2(m_run - m_new); m_run = m_new; l_run *= alpha;
#pragma unroll
            for (int dt = 0; dt < NDT; ++dt) o[dt] = o[dt] * alpha; }
        float rs = 0.f;
#pragma unroll
        for (int kt = 0; kt < 8; ++kt)
#pragma unroll
            for (int j = 0; j < 4; ++j) { const float p = fexp2(s[kt][j] - m_run); s[kt][j] = p; rs += p; }
        rs = xor16_add(rs); rs = xor32_add(rs);
        l_run += rs;
        bf16x8 pb[4];
#pragma unroll
        for (int u = 0; u < 4; ++u) { u32x4 t; t.x = pk2(s[2 * u][0], s[2 * u][1]); t.y = pk2(s[2 * u][2], s[2 * u][3]); t.z = pk2(s[2 * u + 1][0], s[2 * u + 1][1]); t.w = pk2(s[2 * u + 1][2], s[2 * u + 1][3]);
            pb[u] = __builtin_bit_cast(bf16x8, t); }
        {
            u32x4 va[2][8];
#define WS_VLOAD(buf, gi) do { _Pragma("unroll") for (int i = 0; i < 8; ++i) { va[buf][i] = *(const LAS u32x4*)(lds + KT + (16 * i + q) * VROW + (32 * (gi) + 8 * g) * 2); } } while (0)
            WS_VLOAD(0, 0);
#pragma unroll
            for (int gi = 0; gi < 4; ++gi) {
                if (gi + 1 < 4) WS_VLOAD((gi + 1) & 1, gi + 1);
                __builtin_amdgcn_sched_barrier(0);
#pragma unroll
                for (int i = 0; i < 8; ++i) o[i] = mfma16(__builtin_bit_cast(bf16x8, va[gi & 1][i]), pb[gi], o[i]);
                __builtin_amdgcn_sched_barrier(0);
            }
#undef WS_VLOAD
        }
        bool done = false;
        if (Ccb + 1 < hi) ++Ccb;
        else {
            const float inv = 1.f / l_run;
            char* ob = (char*)yatt + ((size_t)(qblk * 128) * 2048 + hq * 128) * 2;
            const unsigned ooff = (unsigned)(((16 * w + q) * 2048 + 4 * g) * 2);
#pragma unroll
            for (int dt = 0; dt < NDT; ++dt) { u32x2 pkv; pkv.x = pk2(o[dt][0] * inv, o[dt][1] * inv); pkv.y = pk2(o[dt][2] * inv, o[dt][3] * inv); *(u32x2*)(ob + ooff + 32 * dt) = pkv; }
            Cv += G; if (Cv < 1024) Ccb = WS_LO(Cv); else done = true;
        }
        __syncthreads();
        bsel ^= 1;
        if (done) break;
    }
#undef WS_LOAD
#undef WS_STORE
#undef WS_LO
#undef WS_HI
#undef WS_ADV_L
}

constexpr int LR_XCB = 0, LR_TA = 16384, LR_TB = LR_TA + 64 * 528, LR_TH = LR_TB + 64 * 528, LR_AGS = LR_TH + 64 * 528;
template <int VAR>
__device__ __forceinline__ void lru_phase(LAS unsigned char* lds, const Args& a, const int n, const int tt_first, const int tt_step) {
    int tid = threadIdx.x; asm volatile("" : "+v"(tid)); const int lane = tid & 63, w0 = tid >> 6, q0 = lane & 15, g0 = lane >> 4;
    unsigned char* ws = a.ws;
    const bf16_t* proj = (const bf16_t*)(ws + WS_PROJ);
    LAS unsigned char* xcb = lds + LR_XCB;
    LAS float* TA = (LAS float*)(lds + LR_TA); LAS float* TB = (LAS float*)(lds + LR_TB); LAS float* TH = (LAS float*)(lds + LR_TH);
    LAS f32x2* AGS = (LAS f32x2*)(lds + LR_AGS);
    const bf16_t* lruw = (const bf16_t*)(ws + WS_LRUW);
    f32x2* agg1 = (f32x2*)(ws + (VAR ? WS_T0 : WS_AGG1));
    bf16_t* Pout = (bf16_t*)(ws + (VAR ? WS_U + 32 * MiB : WS_PP));
    bf16x8 fa[2][4], fx[2][4];
#pragma unroll
    for (int dir = 0; dir < 2; ++dir) {
        const bf16_t* wa = lruw + (size_t)((0 * 2 + dir) * 8 + n) * 16384 + (16 * w0 + q0) * 128 + 8 * g0;
        const bf16_t* wx = lruw + (size_t)((1 * 2 + dir) * 8 + n) * 16384 + (16 * w0 + q0) * 128 + 8 * g0;
#pragma unroll
        for (int s = 0; s < 4; ++s) { fa[dir][s] = *(const bf16x8*)(wa + 32 * s); fx[dir][s] = *(const bf16x8*)(wx + 32 * s); }
    }
    const int cg8 = tid & 15, t2 = tid >> 4, ch0 = n * 128 + cg8 * 8;
    LAS float* CW = (LAS float*)(lds + LR_AGS + 4096);
    __syncthreads();
    if (tid < 128) {
#pragma unroll
        for (int j = 0; j < 4; ++j) CW[j * 128 + tid] = a.in[5][j * 1024 + n * 128 + tid];
        CW[512 + tid] = a.in[6][n * 128 + tid];
    } else if (tid < 384) {
        const int d2 = (tid - 128) >> 7, c = tid & 127, cg = d2 * 1024 + n * 128 + c;
        const float xl = -a.in[11][cg];
        CW[640 + (d2 * 3 + 0) * 128 + c] = a.in[8][cg]; CW[640 + (d2 * 3 + 1) * 128 + c] = a.in[10][cg];
        CW[640 + (d2 * 3 + 2) * 128 + c] = fmaxf(xl, 0.f) + log1pf(expf(-fabsf(xl)));
    }
    u32x4 xr[5];
#define LRU_XLOAD(tt_) do { _Pragma("unroll") for (int r = 0; r < 5; ++r) { const int t = (tt_) * 64 + 2 * t2 - 2 + r; xr[r] = (u32x4){0u, 0u, 0u, 0u}; \
        if (t >= 0 && t < SEQ) xr[r] = __builtin_nontemporal_load((const u32x4*)((const char*)proj + (unsigned)((t * INW + C_XL + ch0) * 2))); } } while (0)
    float A2f = 1.f, H2f = 0.f, A2b = 1.f, H2b = 0.f;
    LRU_XLOAD(tt_first);
#pragma unroll 1
    for (int tt = tt_first; tt < tt_first + 4; ++tt) {
    const int t0 = tt * 64;
    __syncthreads();
    {
        float xin[5][8];
#pragma unroll
        for (int r = 0; r < 5; ++r) { const u32x4 v = xr[r];
            xin[r][0] = bflo(v.x); xin[r][1] = bfhi(v.x); xin[r][2] = bflo(v.y); xin[r][3] = bfhi(v.y); xin[r][4] = bflo(v.z); xin[r][5] = bfhi(v.z); xin[r][6] = bflo(v.w); xin[r][7] = bfhi(v.w); }
        float wv[4][8], bias[8];
#pragma unroll
        for (int j = 0; j < 4; ++j) { const f32x4 w0 = *(const LAS f32x4*)(CW + j * 128 + cg8 * 8), w1 = *(const LAS f32x4*)(CW + j * 128 + cg8 * 8 + 4);
            wv[j][0] = w0[0]; wv[j][1] = w0[1]; wv[j][2] = w0[2]; wv[j][3] = w0[3]; wv[j][4] = w1[0]; wv[j][5] = w1[1]; wv[j][6] = w1[2]; wv[j][7] = w1[3]; }
        { const f32x4 b0 = *(const LAS f32x4*)(CW + 512 + cg8 * 8), b1 = *(const LAS f32x4*)(CW + 512 + cg8 * 8 + 4);
          bias[0] = b0[0]; bias[1] = b0[1]; bias[2] = b0[2]; bias[3] = b0[3]; bias[4] = b1[0]; bias[5] = b1[1]; bias[6] = b1[2]; bias[7] = b1[3]; }
#pragma unroll
        for (int o = 0; o < 2; ++o) { float y[8];
#pragma unroll
            for (int e = 0; e < 8; ++e) { float v = bias[e];
#pragma unroll
                for (int j = 0; j < 4; ++j) v += wv[j][e] * xin[o + j][e];
                y[e] = v; }
            const int tok = 2 * t2 + o;
            u32x4 pk; pk.x = pk2(y[0], y[1]); pk.y = pk2(y[2], y[3]); pk.z = pk2(y[4], y[5]); pk.w = pk2(y[6], y[7]);
            *(LAS u32x4*)(xcb + tok * 256 + ((cg8 ^ (tok & 15)) * 16)) = pk; }
    }
    if (tt + 1 < tt_first + 4) LRU_XLOAD(tt + 1);
    __syncthreads();
    float hreg[16];
    int tl = tid; asm volatile("" : "+v"(tl));
    const int q = tl & 15, g = (tl >> 4) & 3, w = tl >> 6, chl = 16 * w + 4 * g;
    const int ch = 16 * w + q, sub = g;
#pragma unroll
    for (int dir = 0; dir < 2; ++dir) {
        LAS float* TAd = dir ? TH : TA;
        if (VAR != 3) {
            const f32x4 ba = *(const LAS f32x4*)(CW + 640 + (dir * 3 + 0) * 128 + chl), bx = *(const LAS f32x4*)(CW + 640 + (dir * 3 + 1) * 128 + chl), sp = *(const LAS f32x4*)(CW + 640 + (dir * 3 + 2) * 128 + chl);
#pragma unroll
            for (int tk = 0; tk < 4; ++tk) { const int tok = 16 * tk + q;
                f32x4 ar = (f32x4){0.f, 0.f, 0.f, 0.f}, ai = (f32x4){0.f, 0.f, 0.f, 0.f};
#pragma unroll
                for (int s = 0; s < 4; ++s) {
                    const bf16x8 xb = *(const LAS bf16x8*)(xcb + tok * 256 + (((4 * s + g) ^ q) * 16));
                    ar = mfma16(fa[dir][s], xb, ar); ai = mfma16(fx[dir][s], xb, ai); }
                const u32x2 xr2 = *(const LAS u32x2*)(xcb + tok * 256 + ((((chl >> 3)) ^ q) * 16) + (chl & 7) * 2);
                const float xc0 = bflo(xr2.x), xc1 = bfhi(xr2.x), xc2 = bflo(xr2.y), xc3 = bfhi(xr2.y);
                f32x4 av, bv;
#pragma unroll
                for (int j = 0; j < 4; ++j) { if (VAR == 1) { av[j] = ar[j] + ba[j] + sp[j]; bv[j] = ai[j] + bx[j] + (j == 0 ? xc0 : (j == 1 ? xc1 : (j == 2 ? xc2 : xc3))); continue; }
                    const float r = fsigmoid(ar[j] + ba[j]), ii = fsigmoid(ai[j] + bx[j]);
                    const float la = -8.0f * r * sp[j]; const float aa = fexp2(la * LOG2E); av[j] = aa;
                    const float x2 = 2.0f * la;
                    const float poly = x2 * (1.f + x2 * (0.5f + x2 * ((1.f / 6.f) + x2 * ((1.f / 24.f) + x2 * (1.f / 120.f)))));
                    const float om = (x2 > -0.25f) ? -poly : (1.f - aa * aa);
                    const float xcj = j == 0 ? xc0 : (j == 1 ? xc1 : (j == 2 ? xc2 : xc3));
                    bv[j] = __builtin_amdgcn_sqrtf(om) * ii * xcj; }
                *(LAS f32x4*)(TAd + tok * 132 + chl) = av; *(LAS f32x4*)(TB + tok * 132 + chl) = bv; }
        }
        asm volatile("s_waitcnt lgkmcnt(0)" ::: "memory");
        if (VAR != 2 && VAR != 3) {
            float h = 0.f, P = 1.f;
#pragma unroll
            for (int i = 0; i < 16; ++i) { const int t = 16 * sub + (dir ? 15 - i : i);
                const float av = TAd[t * 132 + ch], bv = TB[t * 132 + ch]; h = av * h + bv; P *= av; TB[t * 132 + ch] = h; TAd[t * 132 + ch] = P; }
            AGS[sub * 128 + ch] = (f32x2){P, h};
        }
        asm volatile("s_waitcnt lgkmcnt(0)" ::: "memory");
        if (VAR == 2 || VAR == 3) {
#pragma unroll
            for (int i = 0; i < 16; ++i) hreg[i] = 0.f;
        } else {
            float hc = 0.f, Pp = 1.f, At = 1.f, Ht = 0.f;
#pragma unroll
            for (int s = 0; s < 4; ++s) { const int s2 = dir ? 3 - s : s; const f32x2 e = AGS[s2 * 128 + ch];
                const bool before = dir ? (s2 > sub) : (s2 < sub);
                if (before) { hc = e.x * hc + e.y; Pp *= e.x; }
                Ht = e.x * Ht + e.y; At *= e.x; }
#pragma unroll
            for (int i = 0; i < 16; ++i) { const int t = 16 * sub + i;
                const float Pl = TAd[t * 132 + ch], hl = TB[t * 132 + ch];
                const float hfull = hl + Pl * hc;
                if (dir == 0) hreg[i] = hfull; else hreg[i] += hfull;
                TAd[t * 132 + ch] = Pl * Pp; }
            if (sub == 0) agg1[(size_t)(dir * 1024 + n * 128 + ch) * 128 + tt] = (f32x2){At, Ht};
            if (dir == 0) { H2f = At * H2f + Ht; A2f *= At; }
            else { H2b = A2b * Ht + H2b; A2b *= At; }
        }
        asm volatile("s_waitcnt lgkmcnt(0)" ::: "memory");
    }
#pragma unroll
    for (int i = 0; i < 16; ++i) TB[(16 * sub + i) * 132 + ch] = hreg[i];
    __syncthreads();
    {
        float* hs = (float*)(ws + (VAR ? WS_U : WS_HS));
#pragma unroll
        for (int i = 0; i < 4; ++i) { const int e = tid + 512 * i, t = e >> 5, c4 = e & 31;
            *(f32x4*)(hs + (size_t)(t0 + t) * 1024 + n * 128 + 4 * c4) = *(const LAS f32x4*)(TB + t * 132 + 4 * c4);
            const f32x4 p0 = *(const LAS f32x4*)(TA + t * 132 + 4 * c4), p1 = *(const LAS f32x4*)(TH + t * 132 + 4 * c4);
            u32x2 o0, o1; o0.x = pk2(p0[0], p0[1]); o0.y = pk2(p0[2], p0[3]); o1.x = pk2(p1[0], p1[1]); o1.y = pk2(p1[2], p1[3]);
            *(u32x2*)(Pout + (size_t)(t0 + t) * 1024 + n * 128 + 4 * c4) = o0;
            *(u32x2*)(Pout + (size_t)SEQ * 1024 + (size_t)(t0 + t) * 1024 + n * 128 + 4 * c4) = o1; }
    }
    }
    if (g0 == 0) { f32x2* agg2 = (f32x2*)(ws + (VAR ? WS_T0 + 8 * MiB : WS_AGG2)); const int chg2 = n * 128 + 16 * w0 + q0, sc2 = tt_first >> 2;
        agg2[(size_t)chg2 * 32 + sc2] = (f32x2){A2f, H2f}; agg2[(size_t)(1024 + chg2) * 32 + sc2] = (f32x2){A2b, H2b}; }
#undef LRU_XLOAD
}

__device__ __forceinline__ void phase2(const Args& a, LAS unsigned char* lds, int p2mask) {
    unsigned char* ws = a.ws;
    bf16_t* proj = (bf16_t*)(ws + WS_PROJ); const bf16_t* vt = (const bf16_t*)(ws + WS_VT);
    const bf16_t* mk = (const bf16_t*)(ws + WS_MK); const bf16_t* mvt = (const bf16_t*)(ws + WS_MVT);
    bf16_t* yatt = (bf16_t*)(ws + WS_YATT); bf16_t* ymem = (bf16_t*)(ws + WS_YMEM);
    if (p2mask & 1)
    for (int u = blockIdx.x; u < 256; u += gridDim.x) {
        const int qblk = u >> 2, hm = u & 3;
        attn_unit<256, false, false>(lds, proj + (size_t)(qblk * 128) * INW + C_QM + hm * 256, INW, ymem + (size_t)(qblk * 128) * 1024 + hm * 256, 1024, mk + hm * 256, 1024, mvt + (size_t)(hm * 256) * 256, 256, 0, 2, -100, -1e30f, 0.f);
    }
    if (p2mask & 2) windowed_stream(lds, a);
    if (p2mask & 4)
    lru_phase<0>(lds, a, (int)(blockIdx.x & 7), 4 * (int)(blockIdx.x >> 3), 1);
}

__device__ __forceinline__ void phase3(const Args& a, LAS unsigned char* lds) {
    unsigned char* ws = a.ws;
    const f32x2* agg1 = (const f32x2*)(ws + WS_AGG1); f32x2* agg2 = (f32x2*)(ws + WS_AGG2);
    for (int e = blockIdx.x * 512 + threadIdx.x; e < 2 * 1024 * 16; e += gridDim.x * 512) {
        const int sc = e & 15, dc = e >> 4, dir = dc >> 10;
        const f32x4* p = (const f32x4*)(agg1 + (size_t)dc * 128 + sc * 8);
        f32x4 v[4];
#pragma unroll
        for (int i = 0; i < 4; ++i) v[i] = p[i];
        float A = 1.f, H = 0.f;
        if (dir == 0) {
#pragma unroll
            for (int i = 0; i < 4; ++i) { H = v[i][0] * H + v[i][1]; A *= v[i][0]; H = v[i][2] * H + v[i][3]; A *= v[i][2]; }
        } else {
#pragma unroll
            for (int i = 3; i >= 0; --i) { H = v[i][2] * H + v[i][3]; A *= v[i][2]; H = v[i][0] * H + v[i][1]; A *= v[i][0]; }
        }
        agg2[(size_t)dc * 16 + sc] = (f32x2){A, H};
    }
}

__device__ __forceinline__ float silu_(float z) { return z * __builtin_amdgcn_rcpf(1.f + __builtin_amdgcn_exp2f(-z * 1.4426950408889634f)); }
__device__ __forceinline__ void phase4(const Args& a, LAS unsigned char* lds) {
    unsigned char* ws = a.ws;
    const f32x2* agg1 = (const f32x2*)(ws + WS_AGG1); const f32x2* agg2 = (const f32x2*)(ws + WS_AGG2);
    const bf16_t* proj = (const bf16_t*)(ws + WS_PROJ); bf16_t* Y = (bf16_t*)(ws + WS_Y);
    const bf16_t* yatt = (const bf16_t*)(ws + WS_YATT); const bf16_t* ymem = (const bf16_t*)(ws + WS_YMEM);
    const float* hs = (const float*)(ws + WS_HS); const bf16_t* Pf = (const bf16_t*)(ws + WS_PP); const bf16_t* Pb = Pf + (size_t)SEQ * 1024;
    LAS float* car = (LAS float*)lds;
    LAS float* gl = (LAS float*)(lds + 8192);
    int tid = threadIdx.x; asm volatile("" : "+v"(tid)); const int lane = tid & 63, w = tid >> 6;
    __syncthreads();
    for (int i = tid; i < 1024; i += 512) { *(LAS f32x4*)(gl + 4 * i) = (i < 512) ? ((const f32x4*)a.in[14])[i] : (i < 768 ? ((const f32x4*)a.in[15])[i - 512] : ((const f32x4*)a.in[16])[i - 768]); }
    for (int u = blockIdx.x; u < 256; u += gridDim.x) {
        const int tile = u >> 1, sc = tile >> 2, cj = tile & 3;
        __syncthreads();
#pragma unroll 1
        for (int half = 0; half < 2; ++half) {
            const int c = tid + 512 * half;
            float hf = 0.f, hb = 0.f;
            float scf = (float)sc, cjf = (float)cj; asm volatile("" : "+v"(scf), "+v"(cjf));
            { const f32x4* p2 = (const f32x4*)(agg2 + (size_t)c * 32); const f32x4* p1 = (const f32x4*)(agg1 + (size_t)c * 128 + sc * 4);
              f32x4 e2[16], e1[2];
#pragma unroll
              for (int i = 0; i < 16; ++i) e2[i] = p2[i];
#pragma unroll
              for (int i = 0; i < 2; ++i) e1[i] = p1[i];
#pragma unroll
              for (int i = 0; i < 16; ++i) { const float w0 = fminf(fmaxf(scf - (float)(2 * i), 0.f), 1.f), w1 = fminf(fmaxf(scf - (float)(2 * i + 1), 0.f), 1.f);
                  hf = (w0 * e2[i][0] + (1.f - w0)) * hf + w0 * e2[i][1]; hf = (w1 * e2[i][2] + (1.f - w1)) * hf + w1 * e2[i][3]; }
#pragma unroll
              for (int i = 0; i < 2; ++i) { const float w0 = fminf(fmaxf(cjf - (float)(2 * i), 0.f), 1.f), w1 = fminf(fmaxf(cjf - (float)(2 * i + 1), 0.f), 1.f);
                  hf = (w0 * e1[i][0] + (1.f - w0)) * hf + w0 * e1[i][1]; hf = (w1 * e1[i][2] + (1.f - w1)) * hf + w1 * e1[i][3]; } }
            { const f32x4* p2 = (const f32x4*)(agg2 + (size_t)(1024 + c) * 32); const f32x4* p1 = (const f32x4*)(agg1 + (size_t)(1024 + c) * 128 + sc * 4);
              f32x4 e2[16], e1[2];
#pragma unroll
              for (int i = 0; i < 16; ++i) e2[i] = p2[i];
#pragma unroll
              for (int i = 0; i < 2; ++i) e1[i] = p1[i];
#pragma unroll
              for (int i = 15; i >= 0; --i) { const float w1 = fminf(fmaxf((float)(2 * i + 1) - scf, 0.f), 1.f), w0 = fminf(fmaxf((float)(2 * i) - scf, 0.f), 1.f);
                  hb = (w1 * e2[i][2] + (1.f - w1)) * hb + w1 * e2[i][3]; hb = (w0 * e2[i][0] + (1.f - w0)) * hb + w0 * e2[i][1]; }
#pragma unroll
              for (int i = 1; i >= 0; --i) { const float w1 = fminf(fmaxf((float)(2 * i + 1) - cjf, 0.f), 1.f), w0 = fminf(fmaxf((float)(2 * i) - cjf, 0.f), 1.f);
                  hb = (w1 * e1[i][2] + (1.f - w1)) * hb + w1 * e1[i][3]; hb = (w0 * e1[i][0] + (1.f - w0)) * hb + w0 * e1[i][1]; } }
            car[c] = hf; car[1024 + c] = hb;
        }
        __syncthreads();
        f32x4 cf[4], cb[4];
#pragma unroll
        for (int k = 0; k < 4; ++k) { cf[k] = *(const LAS f32x4*)(car + 4 * lane + 256 * k); cb[k] = *(const LAS f32x4*)(car + 1024 + 4 * lane + 256 * k); }
#pragma unroll 1
        for (int tk = 0; tk < 4; ++tk) {
            const unsigned t = (unsigned)(u * 32 + 4 * w + tk);
            const char* hsb = (const char*)hs; const char* pfb = (const char*)Pf; const char* pbb = (const char*)Pb;
            const char* yab = (const char*)yatt; const char* ymb = (const char*)ymem; const char* prb = (const char*)proj; char* yb = (char*)Y;
            const unsigned o_h = t * 4096u + 16u * lane, o_p = t * 2048u + 8u * lane, o_m = t * 2048u + 16u * lane;
            const unsigned o_pr = t * (unsigned)(INW * 2), o_y = t * 8192u;
            f32x4 h4[4]; u32x2 pf[4], pb[4], zl[4]; u32x4 va[4], vm[2], za[4], zm[2];
#pragma unroll
            for (int k = 0; k < 4; ++k) { h4[k] = __builtin_nontemporal_load((const f32x4*)(hsb + o_h + 1024u * k)); pf[k] = __builtin_nontemporal_load((const u32x2*)(pfb + o_p + 512u * k)); pb[k] = __builtin_nontemporal_load((const u32x2*)(pbb + o_p + 512u * k)); va[k] = __builtin_nontemporal_load((const u32x4*)(yab + o_h + 1024u * k)); }
#pragma unroll
            for (int k = 0; k < 2; ++k) vm[k] = __builtin_nontemporal_load((const u32x4*)(ymb + o_m + 1024u * k));
#pragma unroll
            for (int k = 0; k < 4; ++k) { zl[k] = __builtin_nontemporal_load((const u32x2*)(prb + o_pr + (unsigned)((C_ZL + 4 * lane + 256 * k) * 2))); za[k] = __builtin_nontemporal_load((const u32x4*)(prb + o_pr + (unsigned)((C_ZA + 8 * lane + 512 * k) * 2))); }
#pragma unroll
            for (int k = 0; k < 2; ++k) zm[k] = __builtin_nontemporal_load((const u32x4*)(prb + o_pr + (unsigned)((C_ZM + 8 * lane + 512 * k) * 2)));
            __builtin_amdgcn_sched_barrier(0);
            f32x4 v[4]; float ssl = 0.f, ssa = 0.f, ssm = 0.f;
#pragma unroll
            for (int k = 0; k < 4; ++k) {
                v[k][0] = h4[k][0] + bflo(pf[k].x) * cf[k][0] + bflo(pb[k].x) * cb[k][0]; v[k][1] = h4[k][1] + bfhi(pf[k].x) * cf[k][1] + bfhi(pb[k].x) * cb[k][1];
                v[k][2] = h4[k][2] + bflo(pf[k].y) * cf[k][2] + bflo(pb[k].y) * cb[k][2]; v[k][3] = h4[k][3] + bfhi(pf[k].y) * cf[k][3] + bfhi(pb[k].y) * cb[k][3];
                ssl += (v[k][0] * v[k][0] + v[k][1] * v[k][1]) + (v[k][2] * v[k][2] + v[k][3] * v[k][3]);
                { const float f0 = bflo(va[k].x), f1 = bfhi(va[k].x), f2 = bflo(va[k].y), f3 = bfhi(va[k].y), f4 = bflo(va[k].z), f5 = bfhi(va[k].z), f6 = bflo(va[k].w), f7 = bfhi(va[k].w);
                  ssa += ((f0 * f0 + f1 * f1) + (f2 * f2 + f3 * f3)) + ((f4 * f4 + f5 * f5) + (f6 * f6 + f7 * f7)); } }
#pragma unroll
            for (int k = 0; k < 2; ++k) { const float f0 = bflo(vm[k].x), f1 = bfhi(vm[k].x), f2 = bflo(vm[k].y), f3 = bfhi(vm[k].y), f4 = bflo(vm[k].z), f5 = bfhi(vm[k].z), f6 = bflo(vm[k].w), f7 = bfhi(vm[k].w);
                ssm += ((f0 * f0 + f1 * f1) + (f2 * f2 + f3 * f3)) + ((f4 * f4 + f5 * f5) + (f6 * f6 + f7 * f7)); }
            ssl = wave_sum(ssl); ssa = wave_sum(ssa); ssm = wave_sum(ssm);
            const float rsl = 1.f / sqrtf(ssl * (1.f / 1024.f) + EPSN), rsa = 1.f / sqrtf(ssa * (1.f / 2048.f) + EPSN), rsm = 1.f / sqrtf(ssm * (1.f / 1024.f) + EPSN);
            __builtin_amdgcn_sched_barrier(0);
#pragma unroll
            for (int k = 0; k < 4; ++k) { const int c = 4 * lane + 256 * k; const f32x4 g4 = *(const LAS f32x4*)(gl + 2048 + c); const u32x2 z = zl[k];
                u32x2 o; o.x = pk2(v[k][0] * rsl * g4[0] * silu_(bflo(z.x)), v[k][1] * rsl * g4[1] * silu_(bfhi(z.x))); o.y = pk2(v[k][2] * rsl * g4[2] * silu_(bflo(z.y)), v[k][3] * rsl * g4[3] * silu_(bfhi(z.y)));
                *(u32x2*)(yb + o_y + (unsigned)((2048 + c) * 2)) = o; }
            __builtin_amdgcn_sched_barrier(0);
#pragma unroll
            for (int k = 0; k < 4; ++k) { const int c = 8 * lane + 512 * k; const f32x4 g0 = *(const LAS f32x4*)(gl + c), g1 = *(const LAS f32x4*)(gl + c + 4); const u32x4 z = za[k];
                u32x4 o; o.x = pk2(bflo(va[k].x) * rsa * g0[0] * silu_(bflo(z.x)), bfhi(va[k].x) * rsa * g0[1] * silu_(bfhi(z.x)));
                o.y = pk2(bflo(va[k].y) * rsa * g0[2] * silu_(bflo(z.y)), bfhi(va[k].y) * rsa * g0[3] * silu_(bfhi(z.y)));
                o.z = pk2(bflo(va[k].z) * rsa * g1[0] * silu_(bflo(z.z)), bfhi(va[k].z) * rsa * g1[1] * silu_(bfhi(z.z)));
                o.w = pk2(bflo(va[k].w) * rsa * g1[2] * silu_(bflo(z.w)), bfhi(va[k].w) * rsa * g1[3] * silu_(bfhi(z.w)));
                *(u32x4*)(yb + o_y + (unsigned)(c * 2)) = o; }
            __builtin_amdgcn_sched_barrier(0);
#pragma unroll
            for (int k = 0; k < 2; ++k) { const int c = 8 * lane + 512 * k; const f32x4 g0 = *(const LAS f32x4*)(gl + 3072 + c), g1 = *(const LAS f32x4*)(gl + 3072 + c + 4); const u32x4 z = zm[k];
                u32x4 o; o.x = pk2(bflo(vm[k].x) * rsm * g0[0] * silu_(bflo(z.x)), bfhi(vm[k].x) * rsm * g0[1] * silu_(bfhi(z.x)));
                o.y = pk2(bflo(vm[k].y) * rsm * g0[2] * silu_(bflo(z.y)), bfhi(vm[k].y) * rsm * g0[3] * silu_(bfhi(z.y)));
                o.z = pk2(bflo(vm[k].z) * rsm * g1[0] * silu_(bflo(z.z)), bfhi(vm[k].z) * rsm * g1[1] * silu_(bfhi(z.z)));
                o.w = pk2(bflo(vm[k].w) * rsm * g1[2] * silu_(bflo(z.w)), bfhi(vm[k].w) * rsm * g1[3] * silu_(bfhi(z.w)));
                *(u32x4*)(yb + o_y + (unsigned)((3072 + c) * 2)) = o; }
        }
    }
}

#define XB_TMO      128
#define XB_XCNT(j)  (256  + 64 * (j))
#define XB_XSUB(j)  (1280 + 64 * (j))
#define XB_XGEN(j)  (2304 + 64 * (j))
#define XB_TOP      3328
#define XB_TOPGEN   3392
#define XCD_BAR_WORDS 3456
#define XB_SPIN_CAP (1u << 18)

__device__ __forceinline__ unsigned xb_ld(unsigned* p)              { return __hip_atomic_load(p, __ATOMIC_RELAXED, __HIP_MEMORY_SCOPE_AGENT); }
__device__ __forceinline__ unsigned xb_add(unsigned* p, unsigned v) { return __hip_atomic_fetch_add(p, v, __ATOMIC_RELAXED, __HIP_MEMORY_SCOPE_AGENT); }
__device__ __forceinline__ unsigned xb_xcc_id() { return (unsigned)__builtin_amdgcn_s_getreg((3 << 11) | 20) & 0xFu; }
#define XB_SPIN(cond, bar) do { unsigned _sp = 0; while (cond) { __builtin_amdgcn_s_sleep(1); \
    if ((++_sp & 255u) == 0u) { if (xb_ld(&(bar)[XB_TMO])) break; if (_sp > XB_SPIN_CAP) { atomicAdd(&(bar)[XB_TMO], 1u); break; } } } } while (0)

struct XcdBarrier {
    unsigned* bar; unsigned x;
    volatile LAS unsigned* st;
};

__device__ __forceinline__ XcdBarrier xcd_barrier_post(unsigned* bar, volatile LAS unsigned* st) {
    XcdBarrier b; b.bar = bar; b.x = xb_xcc_id(); b.st = st;
    if (threadIdx.x == 0) (void)xb_add(&bar[XB_XCNT(b.x)], 1u);
    return b;
}
__device__ __forceinline__ void xcd_barrier_complete(unsigned* bar, unsigned x, unsigned& nloc, unsigned& nx) {
    const unsigned G = gridDim.x * gridDim.y * gridDim.z;
    unsigned sum, cnt, mine, sp = 0u;
    for (;;) {
        sum = 0u; cnt = 0u; mine = 0u;
#pragma unroll
        for (unsigned j = 0; j < 16; ++j) { const unsigned c = xb_ld(&bar[XB_XCNT(j)]); sum += c; cnt += (c > 0u) ? 1u : 0u; mine = (j == x) ? c : mine; }
        if (sum == G) break;
        __builtin_amdgcn_s_sleep(1);
        if ((++sp & 255u) == 0u) { if (xb_ld(&bar[XB_TMO])) break; if (sp > XB_SPIN_CAP) { atomicAdd(&bar[XB_TMO], 1u); break; } }
    }
    nloc = mine > 0u ? mine : 1u; nx = cnt > 0u ? cnt : 1u;
}

__device__ __forceinline__ void xcd_barrier(const XcdBarrier& b) {
    asm volatile("s_waitcnt vmcnt(0)" ::: "memory");
    __syncthreads();
    if (threadIdx.x == 0) {
        unsigned* bar = b.bar;
        __builtin_amdgcn_s_waitcnt(0);
        unsigned nloc = b.st[0], nx = b.st[1];
        if (nloc == 0u) { xcd_barrier_complete(bar, b.x, nloc, nx); b.st[0] = nloc; b.st[1] = nx; }
        const unsigned old = xb_add(&bar[XB_XSUB(b.x)], 1u);
        const unsigned gen = old / nloc;
        if (old + 1u == (gen + 1u) * nloc) {
            __builtin_amdgcn_fence(__ATOMIC_RELEASE, "agent");
            asm volatile("s_waitcnt vmcnt(0)" ::: "memory");
            const unsigned og = xb_add(&bar[XB_TOP], 1u);
            const unsigned tg = og / nx;
            if (og + 1u == (tg + 1u) * nx) xb_add(&bar[XB_TOPGEN], 1u);
            else XB_SPIN(xb_ld(&bar[XB_TOPGEN]) == tg, bar);
            __builtin_amdgcn_fence(__ATOMIC_ACQUIRE, "agent");
            xb_add(&bar[XB_XGEN(b.x)], 1u);
            asm volatile("s_waitcnt vmcnt(0)" ::: "memory");
        } else {
            XB_SPIN(xb_ld(&bar[XB_XGEN(b.x)]) == gen, bar);
            __builtin_amdgcn_fence(__ATOMIC_ACQUIRE, "agent");
            asm volatile("s_waitcnt vmcnt(0)" ::: "memory");
        }
    }
    __syncthreads();
}

struct Sched2 {
    int c;
    __device__ bool next(int i, pg8::Unit& u) const {
        if (i >= 2) return false;
        const int x = c & 7, j = c >> 3;
        u.pm = i * 16 + 4 * (x >> 1) + (j & 3); u.pn = 8 * (x & 1) + (j >> 2); return true;
    }
    __device__ __forceinline__ void a_ready(const pg8::Unit&) const {}
    __device__ __forceinline__ void done(const pg8::Unit&) const {}
};
struct Epi3 {
    static constexpr bool PERM = true, AFTER_DRAIN = false, HOLD_LAST = true;
    float* out; bf16_t* t0; float* sspart; const float* x; const float* gain; XcdBarrier xbar;
    __device__ __forceinline__ void operator()(const f32x4 (&acc)[2][2][4][2], const pg8::Unit& u, int wr, int wc, int fr, int fq) const {
#pragma unroll
        for (int ai = 0; ai < 2; ++ai)
#pragma unroll
            for (int m = 0; m < 4; ++m) { const int row = u.pm * 256 + ai * 128 + wr * 64 + m * 16 + fr; float ss = 0.f;
#pragma unroll
                for (int bj = 0; bj < 2; ++bj) { const f32x4 v0 = acc[ai][bj][m][0], v1 = acc[ai][bj][m][1]; const int col = u.pn * 256 + bj * 128 + wc * 32 + 8 * fq;
                    u32x4 pk; pk.x = pk2(v0[0], v0[1]); pk.y = pk2(v0[2], v0[3]); pk.z = pk2(v1[0], v1[1]); pk.w = pk2(v1[2], v1[3]); *(u32x4*)(t0 + (size_t)row * 4096 + col) = pk;
                    ss += ((v0[0] * v0[0] + v0[1] * v0[1]) + (v0[2] * v0[2] + v0[3] * v0[3])) + ((v1[0] * v1[0] + v1[1] * v1[1]) + (v1[2] * v1[2] + v1[3] * v1[3])); }
                ss = xor16_add(ss); ss = xor32_add(ss);
                if (fq == 0) sspart[(size_t)row * 64 + u.pn * 4 + wc] = ss; }
    }
    __device__ __forceinline__ void fused(f32x4 (&acc)[2][2][4][2], const pg8::Unit& u, int wr, int wc, int fr, int fq, LAS unsigned char* lds, int wid, int lane) const {
#pragma unroll
        for (int ai = 0; ai < 2; ++ai)
#pragma unroll
            for (int m = 0; m < 4; ++m) { const int row = u.pm * 256 + ai * 128 + wr * 64 + m * 16 + fr; float ss = 0.f;
#pragma unroll
                for (int bj = 0; bj < 2; ++bj)
#pragma unroll
                    for (int n = 0; n < 2; ++n) { const f32x4 v = acc[ai][bj][m][n]; ss += (v[0] * v[0] + v[1] * v[1]) + (v[2] * v[2] + v[3] * v[3]); }
                ss = xor16_add(ss); ss = xor32_add(ss);
                if (fq == 0) sspart[(size_t)row * 64 + u.pn * 4 + wc] = ss; }
        f32x4 xv0[16], xv1[16];
        const size_t gob = (size_t)(u.pm * 256 + wid * 16) * 4096 + u.pn * 256 + 4 * lane;
#pragma unroll
        for (int r = 0; r < 16; ++r) xv0[r] = __builtin_nontemporal_load((const f32x4*)(x + gob + (size_t)r * 4096));
        xcd_barrier(xbar);
        constexpr int TP = 260;
        LAS float* T = (LAS float*)lds;
        LAS float* rsT = (LAS float*)(lds + 128 * TP * 4);
        { const int tid = wid * 64 + lane, row = tid >> 1, hf = tid & 1;
          const f32x4* p = (const f32x4*)(sspart + (size_t)(u.pm * 256 + row) * 64 + hf * 32);
          float s = 0.f;
#pragma unroll
          for (int i = 0; i < 8; ++i) { const f32x4 v = p[i]; s += (v[0] + v[1]) + (v[2] + v[3]); }
          s += dpp_mov<0xB1>(s);
          if (hf == 0) rsT[row] = 1.f / sqrtf(s * (1.f / 4096.f) + EPSN); }
        const f32x4 gv = *(const f32x4*)(gain + u.pn * 256 + 4 * lane);
#pragma unroll
        for (int ai = 0; ai < 2; ++ai) {
            __syncthreads();
#pragma unroll
            for (int m = 0; m < 4; ++m)
#pragma unroll
                for (int bj = 0; bj < 2; ++bj)
#pragma unroll
                    for (int n = 0; n < 2; ++n) *(LAS f32x4*)(T + (wr * 64 + m * 16 + fr) * TP + bj * 128 + wc * 32 + 8 * fq + 4 * n) = acc[ai][bj][m][n];
            if (ai == 0) {
#pragma unroll
                for (int r = 0; r < 16; ++r) xv1[r] = __builtin_nontemporal_load((const f32x4*)(x + gob + (size_t)(128 + r) * 4096));
            }
            __syncthreads();
#pragma unroll
            for (int r = 0; r < 16; ++r) { const int rl = wid * 16 + r;
                const f32x4 tv = *(const LAS f32x4*)(T + rl * TP + 4 * lane); const float rs = rsT[ai * 128 + rl];
                __builtin_nontemporal_store((ai ? xv1[r] : xv0[r]) + tv * rs * gv, (f32x4*)(out + gob + (size_t)(ai * 128 + r) * 4096)); }
        }
        const int pm0 = u.pm - 16;
        __syncthreads();
        { const int tid = wid * 64 + lane, row = tid >> 1, hf = tid & 1;
          const f32x4* p = (const f32x4*)(sspart + (size_t)(pm0 * 256 + row) * 64 + hf * 32);
          float s = 0.f;
#pragma unroll
          for (int i = 0; i < 8; ++i) { const f32x4 v = p[i]; s += (v[0] + v[1]) + (v[2] + v[3]); }
          s += dpp_mov<0xB1>(s);
          if (hf == 0) rsT[row] = 1.f / sqrtf(s * (1.f / 4096.f) + EPSN); }
        __syncthreads();
#pragma unroll 1
        for (int hb = 0; hb < 2; ++hb) {
            const int r0 = wid * 32 + hb * 16;
            const size_t go = (size_t)(pm0 * 256 + r0) * 4096 + u.pn * 256 + 4 * lane;
            f32x4 xr[16]; u32x2 tr[16];
#pragma unroll
            for (int r = 0; r < 16; ++r) { xr[r] = __builtin_nontemporal_load((const f32x4*)(x + go + (size_t)r * 4096)); tr[r] = __builtin_nontemporal_load((const u32x2*)(t0 + go + (size_t)r * 4096)); }
#pragma unroll
            for (int r = 0; r < 16; ++r) { const float rs = rsT[r0 + r];
                f32x4 o; o[0] = xr[r][0] + bflo(tr[r].x) * rs * gv[0]; o[1] = xr[r][1] + bfhi(tr[r].x) * rs * gv[1]; o[2] = xr[r][2] + bflo(tr[r].y) * rs * gv[2]; o[3] = xr[r][3] + bfhi(tr[r].y) * rs * gv[3];
                __builtin_nontemporal_store(o, (f32x4*)(out + go + (size_t)r * 4096)); }
        }
    }
};
__device__ __forceinline__ void phase6(const Args& a) {
    int tid = threadIdx.x; asm volatile("" : "+v"(tid)); const int lane = tid & 63, w = tid >> 6;
    const float* sspart = (const float*)(a.ws + WS_SS); const bf16_t* t0 = (const bf16_t*)(a.ws + WS_T0);
    f32x4 gv[16];
#pragma unroll
    for (int k = 0; k < 16; ++k) gv[k] = ((const f32x4*)a.in[18])[2 * lane + 128 * (k >> 1) + (k & 1)];
    for (int row = blockIdx.x * 8 + w; row < 4096; row += gridDim.x * 8) {
        const u32x4* t4 = (const u32x4*)(t0 + (size_t)row * 4096) + lane; f32x4* o4 = (f32x4*)(a.out + (size_t)row * 4096) + 2 * lane;
        const f32x4* x4 = (const f32x4*)(a.in[0] + (size_t)row * 4096) + 2 * lane;
        u32x4 tv[8]; f32x4 xa[8], xb[8];
        const float sp = sspart[(size_t)row * 64 + lane];
#pragma unroll
        for (int k = 0; k < 8; ++k) { tv[k] = __builtin_nontemporal_load(t4 + 64 * k); xa[k] = __builtin_nontemporal_load(x4 + 128 * k); xb[k] = __builtin_nontemporal_load(x4 + 128 * k + 1); }
        const float rs = 1.f / sqrtf(wave_sum(sp) * (1.f / 4096.f) + EPSN);
#pragma unroll
        for (int k = 0; k < 8; ++k) { const f32x4 ga = gv[2 * k], gb = gv[2 * k + 1];
            f32x4 oa, ob; oa[0] = xa[k][0] + bflo(tv[k].x) * rs * ga[0]; oa[1] = xa[k][1] + bfhi(tv[k].x) * rs * ga[1]; oa[2] = xa[k][2] + bflo(tv[k].y) * rs * ga[2]; oa[3] = xa[k][3] + bfhi(tv[k].y) * rs * ga[3];
            ob[0] = xb[k][0] + bflo(tv[k].z) * rs * gb[0]; ob[1] = xb[k][1] + bfhi(tv[k].z) * rs * gb[1]; ob[2] = xb[k][2] + bflo(tv[k].w) * rs * gb[2]; ob[3] = xb[k][3] + bfhi(tv[k].w) * rs * gb[3];
            __builtin_nontemporal_store(oa, o4 + 128 * k); __builtin_nontemporal_store(ob, o4 + 128 * k + 1); }
    }
}

__global__ void __launch_bounds__(512, 2) mega(Args a) {
    extern __shared__ __attribute__((aligned(16))) unsigned char lds_raw[];
    LAS unsigned char* lds = (LAS unsigned char*)lds_raw;
    cg::grid_group grid = cg::this_grid();
    unsigned char* ws = a.ws;
    volatile LAS unsigned* xst = (volatile LAS unsigned*)(lds + LDS_BYTES - 64);
    if (threadIdx.x < 16) xst[threadIdx.x] = 0u;
    __syncthreads();
    XcdBarrier xbar; xbar.bar = (unsigned*)(ws + WS_CTL); xbar.x = 0; xbar.st = nullptr;
    xbar = xcd_barrier_post((unsigned*)(ws + WS_CTL), xst);
    const int lo = a.ph_lo, hi = a.ph_hi;
#define IN(k) (lo <= (k) && (k) < hi)
#define SEAM(k) do { if (IN(k) && IN((k) + 1)) { if ((k) == 0) { __syncthreads(); grid.sync(); } else xcd_barrier(xbar); } } while (0)
    if (IN(0)) { if (PHMASK & 1) phase0(a, lds); if (REPMASK & 1) { __syncthreads(); phase0(a, lds); } }
    SEAM(0);
    if (IN(1)) { if (PHMASK & 2) {
        pg8::Gemm g{(const bf16_t*)(ws + WS_U), (const bf16_t*)(ws + WS_WT), SEQ + NMEM, INW + 2048, 4096};
        Epi1 E{(bf16_t*)(ws + WS_PROJ), (bf16_t*)(ws + WS_VT), (bf16_t*)(ws + WS_MK), (bf16_t*)(ws + WS_MVT), (const float*)(ws + WS_ROPE)};
        const int G = (int)gridDim.x, nfull = 1160 % G, nidle = G - nfull, bi = (int)blockIdx.x - nfull;
        if (bi < 0) {
            Sched1 S; S.init(G, (int)blockIdx.x); S.ioff = 4;
            pg8::gemm_phase<Epi1, Sched1, true, true>(lds, g, S, E);
        } else {
            int tid = threadIdx.x; asm volatile("" : "+v"(tid)); const int lane = tid & 63, w = tid >> 6;
            LAS float* scr = (LAS float*)(lds + w * 16384);
            p0_transpose_win<false>(a.in[3], (bf16_t*)(ws + WS_WT), scr, bi * 8 + w, nidle * 8, lane);
            p0_transpose_matrix(a.in[17], 4096, 4096, (bf16_t*)(ws + WS_WOUT), 0, scr, bi * 8 + w, nidle * 8, lane);
        }
        xcd_barrier(xbar);
        { Sched1 S; S.init(G, (int)blockIdx.x); S.imax = 4;
          pg8::gemm_phase<Epi1, Sched1, true, true>(lds, g, S, E); }
    } }
    SEAM(1);
    if (IN(2)) { if (PHMASK & 4) phase2(a, lds, P2MASK); }
    SEAM(2);
    if (IN(4)) { if (PHMASK & 16) phase4(a, lds); if (REPMASK & 16) { __syncthreads(); phase4(a, lds); } }
    SEAM(4);
    if (IN(5)) { if (PHMASK & 32) {
        pg8::Gemm g{(const bf16_t*)(ws + WS_Y), (const bf16_t*)(ws + WS_WOUT), SEQ, 4096, 4096};
        Sched2 S; S.c = (int)blockIdx.x;
        Epi3 E{a.out, (bf16_t*)(ws + WS_T0), (float*)(ws + WS_SS), a.in[0], a.in[18], xbar};
        pg8::gemm_phase<Epi3, Sched2, true, true>(lds, g, S, E);
    } }
#if N_LAUNCHES != 1
    if (lo >= 7 && lo < 10) phase2(a, lds, 1 << (lo - 7));
    if (lo == 11 || lo == 12) {
        pg8::Gemm g{(const bf16_t*)(ws + WS_U), (const bf16_t*)(ws + WS_WT), SEQ + NMEM, INW + 2048, 4096};
        Sched1 S; S.init((int)gridDim.x, (int)blockIdx.x); if (lo == 11) S.imax = 4; else S.ioff = 4;
        Epi1 E{(bf16_t*)(ws + WS_PROJ), (bf16_t*)(ws + WS_VT), (bf16_t*)(ws + WS_MK), (bf16_t*)(ws + WS_MVT), (const float*)(ws + WS_ROPE)};
        pg8::gemm_phase<Epi1, Sched1, true, true>(lds, g, S, E);
    }
    if (lo == 13) {
        pg8::Gemm g{(const bf16_t*)(ws + WS_U), (const bf16_t*)(ws + WS_WT), SEQ + NMEM, INW + 2048, 4096};
        Sched1 S; S.init((int)gridDim.x, (int)blockIdx.x); S.imax = 4;
        pg8::EpiBf16<0> E{(bf16_t*)(ws + WS_HS), INW, nullptr, 0, 0, 1.f};
        pg8::gemm_phase<pg8::EpiBf16<0>, Sched1, true, true>(lds, g, S, E);
    }
#ifdef LRUVAR
    if (lo == 10) lru_phase<LRUVAR>(lds, a, (int)(blockIdx.x & 7), (int)(blockIdx.x >> 3), (int)(gridDim.x >> 3));
#endif
#endif
#undef IN
#undef SEAM
}

extern "C" void kernel_launch(void* const* d_in, const int* in_sizes, int n_in, void* d_out, int out_size, void* d_ws, size_t ws_size, hipStream_t stream) {
    static int grid = 0;
    if (grid == 0) {
        if (n_in != 19 || ws_size < WS_END) { fprintf(stderr, "kernel_launch: unexpected n_in %d or ws_size %zu (need %zu)\n", n_in, ws_size, (size_t)WS_END); grid = -1; return; }
        int dev = 0, cus = 0, per_cu = 0;
        hipGetDevice(&dev); hipDeviceGetAttribute(&cus, hipDeviceAttributeMultiprocessorCount, dev);
        if (hipFuncSetAttribute((const void*)mega, hipFuncAttributeMaxDynamicSharedMemorySize, LDS_BYTES) != hipSuccess) { fprintf(stderr, "kernel_launch: hipFuncSetAttribute failed\n"); grid = -1; return; }
        if (hipOccupancyMaxActiveBlocksPerMultiprocessor(&per_cu, (const void*)mega, 512, LDS_BYTES) != hipSuccess || per_cu < 1) { fprintf(stderr, "kernel_launch: occupancy query says %d\n", per_cu); per_cu = 1; }
        (void)hipGetLastError();
        if (cus < 256) { fprintf(stderr, "kernel_launch: needs 256 CUs (one workgroup per CU), device has %d\n", cus); grid = -1; return; }
        grid = 256;
    }
    if (grid < 0) return;
    Args a{};
    for (int i = 0; i < 19; ++i) a.in[i] = (const float*)d_in[i];
    a.out = (float*)d_out; a.ws = (unsigned char*)d_ws;
#if N_LAUNCHES == 1
    (void)hipMemsetAsync((char*)d_ws + WS_CTL, 0, 65536, stream);
    a.ph_lo = 0; a.ph_hi = NPH;
    void* args[] = {&a};
    hipError_t e = hipLaunchCooperativeKernel((const void*)mega, dim3(grid), dim3(512), args, LDS_BYTES, stream);
    if (e != hipSuccess) fprintf(stderr, "cooperative launch failed: %s (grid %d)\n", hipGetErrorString(e), grid);
#else
#ifndef PHSEQ
#define PHSEQ 0,1,2,3,4,5,6
#endif
    { const int seq[] = {PHSEQ};
      for (unsigned i = 0; i < sizeof(seq) / sizeof(int); ++i) { a.ph_lo = seq[i]; a.ph_hi = seq[i] + 1; (void)hipMemsetAsync((char*)d_ws + WS_CTL, 0, 65536, stream); hipLaunchKernelGGL(mega, dim3(grid), dim3(512), LDS_BYTES, stream, a); } }
#endif
}
```
